# Optimizing an MI355X kernel written in HIP

```python
import math
import jax, jax.numpy as jnp
from jax import lax
import numpy as np

D_MODEL = 1024
BATCH = 2
SEQ = 8192
DEPTH = 2

GRID_W = 64
CTX_LEN = 256

N_FOURIER_GROUPS = 4
FOURIER_GROUP = 128
FOURIER_WIDTH = N_FOURIER_GROUPS * FOURIER_GROUP

N_Q_HEADS = 8
N_KV_HEADS = 2
HEAD_DIM = 64
GROUP = N_Q_HEADS // N_KV_HEADS
ATTN_WIDTH = N_Q_HEADS * HEAD_DIM
KV_WIDTH = N_KV_HEADS * HEAD_DIM
WINDOW = 128
BLOCK = 128
ROPE_BASE = 10000.0

OFF_Q = FOURIER_WIDTH
OFF_K = OFF_Q + ATTN_WIDTH
OFF_V = OFF_K + KV_WIDTH
OFF_G = OFF_V + KV_WIDTH
IN_WIDTH = OFF_G + 2 * D_MODEL

D_FF_DENSE = 2816
N_EXPERTS = 8
TOP_K = 2
D_FF_EXPERT = 3584
N_DENSE = (DEPTH + 1) // 2
N_MOE = DEPTH // 2

N_MOD = 6
EPS = 1e-6
NEG = -1e30

kernel_name = "hybrid_fourier_swa_moe_dit"


def rmsnorm(x, g):
    xf = x.astype(jnp.float32)
    r = lax.rsqrt(jnp.mean(xf * xf, axis=-1, keepdims=True) + EPS)
    return (xf * r).astype(x.dtype) * g


def adaln(cvec, w_mod, b_mod, n_chunks):
    m = jax.nn.silu(cvec) @ w_mod[:, :n_chunks * D_MODEL] + b_mod[:n_chunks * D_MODEL]
    return jnp.split(m, n_chunks, axis=-1)


def modulate(h, shift, scale):
    return h * (1.0 + scale) + shift


def axial_rope_tables(n_rows):
    rows = jnp.broadcast_to(jnp.arange(n_rows)[:, None], (n_rows, GRID_W)).reshape(-1).astype(jnp.float32)
    cols = jnp.broadcast_to(jnp.arange(GRID_W)[None, :], (n_rows, GRID_W)).reshape(-1).astype(jnp.float32)
    n_freq = HEAD_DIM // 4
    inv = ROPE_BASE ** (-jnp.arange(n_freq, dtype=jnp.float32) / n_freq)
    ar = rows[:, None] * inv
    ac = cols[:, None] * inv
    return jnp.cos(ar), jnp.sin(ar), jnp.cos(ac), jnp.sin(ac)


def rope_rotate(x, cos, sin):
    h = x.shape[-1] // 2
    x1, x2 = x[..., :h], x[..., h:]
    c = cos[None, :, None, :].astype(x.dtype)
    s = sin[None, :, None, :].astype(x.dtype)
    return jnp.concatenate([x1 * c - x2 * s, x1 * s + x2 * c], axis=-1)


def axial_rope(x, tabs):
    cr, sr, cc, sc = tabs
    a = HEAD_DIM // 2
    return jnp.concatenate([rope_rotate(x[..., :a], cr, sr), rope_rotate(x[..., a:], cc, sc)], axis=-1)


def fourier_mix(u):
    b, t, _ = u.shape
    ug = u.astype(jnp.float32).reshape(b, t, N_FOURIER_GROUPS, FOURIER_GROUP)
    f = jnp.fft.fft2(ug, axes=(1, 3), norm="ortho").real
    return f.reshape(b, t, FOURIER_WIDTH).astype(u.dtype)


def sink_logits(sink, lead_shape, q_len):
    s = sink.astype(jnp.float32).reshape(N_KV_HEADS, GROUP)[:, :, None, None]
    return jnp.broadcast_to(s, lead_shape + (N_KV_HEADS, GROUP, q_len, 1))


def latent_attention(q, k, v, kc, vc, sink):
    b, t = q.shape[:2]
    nb = t // BLOCK
    scale = HEAD_DIM ** -0.5
    qb = q.reshape(b, nb, BLOCK, N_KV_HEADS, GROUP, HEAD_DIM)

    def band(a):
        ap = jnp.pad(a, ((0, 0), (BLOCK, BLOCK), (0, 0), (0, 0)))
        return jnp.concatenate(
            [ap[:, j * BLOCK:j * BLOCK + t].reshape(b, nb, BLOCK, N_KV_HEADS, HEAD_DIM) for j in range(3)],
            axis=2)

    kb, vb = band(k), band(v)
    s_loc = jnp.einsum('bnqhgd,bnkhd->bnhgqk', qb, kb).astype(jnp.float32) * scale
    qpos = jnp.arange(BLOCK)
    kpos = jnp.arange(3 * BLOCK) - BLOCK
    kabs = (jnp.arange(nb) * BLOCK)[:, None] + kpos[None, :]
    in_win = jnp.abs(kpos[None, :] - qpos[:, None]) <= WINDOW
    valid = in_win[None] & ((kabs >= 0) & (kabs < t))[:, None, :]
    s_loc = jnp.where(valid[None, :, None, None], s_loc, NEG)
    s_ctx = jnp.einsum('bnqhgd,bchd->bnhgqc', qb, kc).astype(jnp.float32) * scale
    s = jnp.concatenate([s_loc, s_ctx, sink_logits(sink, (b, nb), BLOCK)], axis=-1)
    p = jax.nn.softmax(s, axis=-1).astype(v.dtype)
    n_loc = 3 * BLOCK
    n_ctx = kc.shape[1]
    o = (jnp.einsum('bnhgqk,bnkhd->bnqhgd', p[..., :n_loc], vb)
         + jnp.einsum('bnhgqc,bchd->bnqhgd', p[..., n_loc:n_loc + n_ctx], vc))
    return o.reshape(b, t, ATTN_WIDTH)


def context_attention(qc, kc, vc, sink):
    b, c = qc.shape[:2]
    scale = HEAD_DIM ** -0.5
    q = qc.reshape(b, c, N_KV_HEADS, GROUP, HEAD_DIM)
    s = jnp.einsum('bqhgd,bkhd->bhgqk', q, kc).astype(jnp.float32) * scale
    s = jnp.concatenate([s, sink_logits(sink, (b,), c)], axis=-1)
    p = jax.nn.softmax(s, axis=-1).astype(vc.dtype)
    o = jnp.einsum('bhgqk,bkhd->bqhgd', p[..., :c], vc)
    return o.reshape(b, c, ATTN_WIDTH)


def split_heads(a, n_heads):
    return a.reshape(a.shape[:-1] + (n_heads, HEAD_DIM))


def merge_branches(u, o_attn, g_f, g_a, w_f, w_a, w_o):
    y = jax.nn.sigmoid(g_f) * (fourier_mix(u) @ w_f) + jax.nn.sigmoid(g_a) * (o_attn @ w_a)
    return y @ w_o


def swiglu(h, w_g, w_u, w_d):
    return (jax.nn.silu(h @ w_g) * (h @ w_u)) @ w_d


def moe_swiglu(h, w_router, w_g, w_u, w_d):
    shp = h.shape
    t = h.reshape(-1, shp[-1])
    logits = (t @ w_router).astype(jnp.float32)
    topv, topi = lax.top_k(logits, TOP_K)
    wts = jax.nn.softmax(topv, axis=-1)
    combine = jnp.sum(wts[..., None] * jax.nn.one_hot(topi, N_EXPERTS, dtype=jnp.float32), axis=1).astype(h.dtype)
    y = jnp.zeros_like(t)
    for e in range(N_EXPERTS):
        y = y + combine[:, e:e + 1] * swiglu(t, w_g[e], w_u[e], w_d[e])
    return y.reshape(shp)


def setup_inputs(seed: int = 0) -> dict:
    key = jax.random.key(seed)
    ks = jax.random.split(key, 21)
    f32 = jnp.float32
    nrm = lambda k, shp, s: jax.random.normal(k, shp, f32) * s
    D = D_MODEL
    return {
        "x": nrm(ks[0], (BATCH, SEQ, D), 1.0),
        "c": nrm(ks[1], (BATCH, D), 1.0),
        "ctx": nrm(ks[2], (BATCH, CTX_LEN, D), 1.0),
        "c_ctx": nrm(ks[3], (D,), 1.0),
        "w_mod": nrm(ks[4], (DEPTH, D, N_MOD * D), 0.5 * D ** -0.5),
        "b_mod": nrm(ks[5], (DEPTH, N_MOD * D), 0.02),
        "norm1_g": 1.0 + nrm(ks[6], (DEPTH, D), 0.02),
        "norm2_g": 1.0 + nrm(ks[7], (DEPTH, D), 0.02),
        "w_in": nrm(ks[8], (DEPTH, D, IN_WIDTH), D ** -0.5),
        "sink": nrm(ks[9], (DEPTH, N_Q_HEADS), 0.5),
        "w_fourier": nrm(ks[10], (DEPTH, FOURIER_WIDTH, D), FOURIER_WIDTH ** -0.5),
        "w_attn": nrm(ks[11], (DEPTH, ATTN_WIDTH, D), ATTN_WIDTH ** -0.5),
        "w_out": nrm(ks[12], (DEPTH, D, D), D ** -0.5),
        "w_gate_d": nrm(ks[13], (N_DENSE, D, D_FF_DENSE), D ** -0.5),
        "w_up_d": nrm(ks[14], (N_DENSE, D, D_FF_DENSE), D ** -0.5),
        "w_down_d": nrm(ks[15], (N_DENSE, D_FF_DENSE, D), D_FF_DENSE ** -0.5),
        "w_router": nrm(ks[16], (N_MOE, D, N_EXPERTS), D ** -0.5),
        "w_gate_e": nrm(ks[17], (N_MOE, N_EXPERTS, D, D_FF_EXPERT), D ** -0.5),
        "w_up_e": nrm(ks[18], (N_MOE, N_EXPERTS, D, D_FF_EXPERT), D ** -0.5),
        "w_down_e": nrm(ks[19], (N_MOE, N_EXPERTS, D_FF_EXPERT, D), D_FF_EXPERT ** -0.5),
        "final_g": 1.0 + nrm(ks[20], (D,), 0.02),
    }


def reference(x, c, ctx, c_ctx, w_mod, b_mod, norm1_g, norm2_g, w_in, sink, w_fourier, w_attn, w_out,
              w_gate_d, w_up_d, w_down_d, w_router, w_gate_e, w_up_e, w_down_e, final_g):
    xl, xc = x, ctx
    b, t = xl.shape[:2]
    n_rows = t // GRID_W
    tabs = axial_rope_tables(n_rows)
    c_lat = c[:, None, :]
    c_cx = c_ctx[None, None, :]
    for l in range(DEPTH):
        last = l == DEPTH - 1
        sh1, sc1, ga1, sh2, sc2, ga2 = adaln(c_lat, w_mod[l], b_mod[l], N_MOD)
        hl = modulate(rmsnorm(xl, norm1_g[l]), sh1, sc1)
        pl = hl @ w_in[l]
        q = axial_rope(split_heads(pl[..., OFF_Q:OFF_K], N_Q_HEADS), tabs)
        k = axial_rope(split_heads(pl[..., OFF_K:OFF_V], N_KV_HEADS), tabs)
        v = split_heads(pl[..., OFF_V:OFF_G], N_KV_HEADS)
        if last:
            csh1, csc1 = adaln(c_cx, w_mod[l], b_mod[l], 2)
            hc = modulate(rmsnorm(xc, norm1_g[l]), csh1, csc1)
            pkv = hc @ w_in[l][:, OFF_K:OFF_G]
            kc = split_heads(pkv[..., :KV_WIDTH], N_KV_HEADS)
            vc = split_heads(pkv[..., KV_WIDTH:], N_KV_HEADS)
        else:
            csh1, csc1, cga1, csh2, csc2, cga2 = adaln(c_cx, w_mod[l], b_mod[l], N_MOD)
            hc = modulate(rmsnorm(xc, norm1_g[l]), csh1, csc1)
            pc = hc @ w_in[l]
            qc = split_heads(pc[..., OFF_Q:OFF_K], N_Q_HEADS)
            kc = split_heads(pc[..., OFF_K:OFF_V], N_KV_HEADS)
            vc = split_heads(pc[..., OFF_V:OFF_G], N_KV_HEADS)
            oc = context_attention(qc, kc, vc, sink[l])
            yc = merge_branches(pc[..., :OFF_Q], oc, pc[..., OFF_G:OFF_G + D_MODEL], pc[..., OFF_G + D_MODEL:],
                                w_fourier[l], w_attn[l], w_out[l])
        ol = latent_attention(q, k, v, kc, vc, sink[l])
        yl = merge_branches(pl[..., :OFF_Q], ol, pl[..., OFF_G:OFF_G + D_MODEL], pl[..., OFF_G + D_MODEL:],
                            w_fourier[l], w_attn[l], w_out[l])
        xl = xl + ga1 * yl
        hl2 = modulate(rmsnorm(xl, norm2_g[l]), sh2, sc2)
        if l % 2 == 0:
            i = l // 2
            ffn = lambda h: swiglu(h, w_gate_d[i], w_up_d[i], w_down_d[i])
        else:
            i = l // 2
            ffn = lambda h: moe_swiglu(h, w_router[i], w_gate_e[i], w_up_e[i], w_down_e[i])
        xl = xl + ga2 * ffn(hl2)
        if not last:
            xc = xc + cga1 * yc
            hc2 = modulate(rmsnorm(xc, norm2_g[l]), csh2, csc2)
            xc = xc + cga2 * ffn(hc2)
    return rmsnorm(xl, final_g)
```

```cpp
#include <hip/hip_runtime.h>
#include <cstdio>
#include <cstdint>

#define LAS __attribute__((address_space(3)))
#define GAS __attribute__((address_space(1)))
typedef unsigned short bf16_t;
typedef short bf16x8 __attribute__((ext_vector_type(8)));
typedef short s16x4 __attribute__((ext_vector_type(4)));
typedef float f32x4 __attribute__((ext_vector_type(4)));
typedef float f32x2 __attribute__((ext_vector_type(2)));
typedef float f32x16 __attribute__((ext_vector_type(16)));
typedef unsigned u32x4 __attribute__((ext_vector_type(4)));
typedef unsigned u32x2 __attribute__((ext_vector_type(2)));

#ifndef MK_MULTI
#define MK_MULTI 0
#endif

constexpr int D = 1024, T = 8192, NB = 2, NL = NB * T, CTXL = 256, NC = NB * CTXL, NTOK = NL + NC;
constexpr int INW = 3328, OFFQ = 512, OFFK = 1024, OFFV = 1152, OFFG = 1280;
constexpr int DFF0 = 2816, DFFE = 3584, NE = 8;
constexpr int KM = 1152;
constexpr int MOE_ROWS = 2 * NL + NE * 256;
constexpr float EPS = 1e-6f;
constexpr float LOG2E = 1.4426950408889634f;
constexpr float QSCALE = 0.125f * LOG2E;

constexpr size_t MiB = 1u << 20, KiB = 1u << 10;
constexpr size_t WS_CTL = 0, CTL_BYTES = 1 * MiB;
constexpr size_t WS_ROPE = 1 * MiB, WS_TW = WS_ROPE + 32 * KiB, WS_FA64 = WS_ROPE + 96 * KiB, WS_TC = WS_ROPE + 160 * KiB, WS_TX = WS_ROPE + 288 * KiB;
constexpr size_t WS_TOKE = 2 * MiB, WS_TOKR = WS_TOKE + 128 * KiB, WS_TOKW = WS_TOKE + 256 * KiB, WS_LIST = WS_TOKE + 384 * KiB;
constexpr size_t WS_XC = 3 * MiB, WS_VCT = 5 * MiB;
constexpr size_t WS_WIN0 = 6 * MiB, WS_WM0 = WS_WIN0 + 13 * MiB / 2, WS_WO0 = 17 * MiB, WS_WGUD = 19 * MiB, WS_WDD = 30 * MiB;
constexpr size_t WS_WIN1 = 36 * MiB, WS_WM1 = WS_WIN1 + 13 * MiB / 2, WS_WO1 = 47 * MiB;
constexpr size_t WS_H = 49 * MiB;
constexpr size_t WS_DOUT = 6 * MiB;
constexpr size_t WS_WGUE = 82 * MiB, WS_WDE = 194 * MiB;
constexpr size_t WS_R1 = 250 * MiB;
constexpr size_t WS_UP = WS_R1, WS_Q = 266 * MiB, WS_KB = 283 * MiB, WS_VB = 288 * MiB, WS_GF = 293 * MiB, WS_GA = 326 * MiB, WS_GP = 359 * MiB, WS_FO = 375 * MiB, WS_Y = 413 * MiB;
constexpr size_t WS_ACT = WS_R1;
constexpr size_t WS_END = 490 * MiB;
static_assert(WS_DOUT + (size_t)MOE_ROWS * D * 2 <= WS_WGUE, "DOUT overlay");
static_assert(WS_ACT + (size_t)MOE_ROWS * DFFE * 2 <= WS_END, "ACT");
static_assert(WS_FO + (size_t)NTOK * KM * 2 <= WS_Y, "FO");
constexpr int CW_BAR = 4096, CW_CNT = 8192, CW_MOD = 16384;
constexpr int MODSZ = 6 * D;

constexpr int RING_BYTES = 131072, MISC_OFF = RING_BYTES + 320, LDS_BYTES = 147456;
constexpr int NWAVES = 8, NTHR = 512;

__device__ __forceinline__ unsigned f2bf(float f) { unsigned u = __builtin_bit_cast(unsigned, f); return (u + 0x7fffu + ((u >> 16) & 1u)) >> 16; }
__device__ __forceinline__ unsigned pk2(float lo, float hi) { return f2bf(lo) | (f2bf(hi) << 16); }
__device__ __forceinline__ unsigned cvt_pk_bf16(float lo, float hi) { unsigned r; asm volatile("v_cvt_pk_bf16_f32 %0, %1, %2" : "=v"(r) : "v"(lo), "v"(hi)); return r; }
__device__ __forceinline__ float bf2f(unsigned short h) { return __builtin_bit_cast(float, (unsigned)h << 16); }
__device__ __forceinline__ float bflo(unsigned w) { return __builtin_bit_cast(float, w << 16); }
__device__ __forceinline__ float bfhi(unsigned w) { return __builtin_bit_cast(float, w & 0xffff0000u); }
__device__ __forceinline__ float wave_sum(float v) {
#pragma unroll
    for (int o = 1; o < 64; o <<= 1) v += __shfl_xor(v, o);
    return v;
}
__device__ __forceinline__ float sigmoidf_(float x) { return __builtin_amdgcn_rcpf(1.0f + __builtin_amdgcn_exp2f(-x * LOG2E)); }
#define LDS_WAIT() asm volatile("s_waitcnt lgkmcnt(0)" ::: "memory")
#define VM_WAIT() asm volatile("s_waitcnt vmcnt(0)" ::: "memory")

#define XB_TMO      128
#define XB_XCNT(j)  (256  + 64 * (j))
#define XB_XSUB(j)  (1280 + 64 * (j))
#define XB_XGEN(j)  (2304 + 64 * (j))
#define XB_TOP      3328
#define XB_TOPGEN   3392
#define XCD_BAR_WORDS 3456
#define XB_SPIN_CAP (1u << 18)
__device__ __forceinline__ unsigned xb_ld(unsigned* p)              { return __hip_atomic_load(p, __ATOMIC_RELAXED, __HIP_MEMORY_SCOPE_AGENT); }
__device__ __forceinline__ unsigned xb_add(unsigned* p, unsigned v) { return __hip_atomic_fetch_add(p, v, __ATOMIC_RELAXED, __HIP_MEMORY_SCOPE_AGENT); }
__device__ __forceinline__ unsigned xb_xcc_id() { return (unsigned)__builtin_amdgcn_s_getreg((3 << 11) | 20) & 0xFu; }
#define XB_SPIN(cond, bar) do { unsigned _sp = 0; while (cond) { __builtin_amdgcn_s_sleep(1); \
    if ((++_sp & 255u) == 0u) { if (xb_ld(&(bar)[XB_TMO])) break; if (_sp > XB_SPIN_CAP) { atomicAdd(&(bar)[XB_TMO], 1u); break; } } } } while (0)
struct XcdBarrier { unsigned* bar; unsigned x; volatile LAS unsigned* st; };
__device__ __forceinline__ XcdBarrier xcd_barrier_post(unsigned* bar, volatile LAS unsigned* st) {
    XcdBarrier b; b.bar = bar; b.x = xb_xcc_id(); b.st = st;
    if (threadIdx.x == 0) (void)xb_add(&bar[XB_XCNT(b.x)], 1u);
    return b;
}
__device__ __forceinline__ void xcd_barrier_complete(unsigned* bar, unsigned x, unsigned& nloc, unsigned& nx) {
    const unsigned G = gridDim.x * gridDim.y * gridDim.z;
    unsigned sum, cnt, mine, sp = 0u;
    for (;;) {
        sum = 0u; cnt = 0u; mine = 0u;
#pragma unroll
        for (unsigned j = 0; j < 16; ++j) { const unsigned c = xb_ld(&bar[XB_XCNT(j)]); sum += c; cnt += (c > 0u) ? 1u : 0u; mine = (j == x) ? c : mine; }
        if (sum == G) break;
        __builtin_amdgcn_s_sleep(1);
        if ((++sp & 255u) == 0u) { if (xb_ld(&bar[XB_TMO])) break; if (sp > XB_SPIN_CAP) { atomicAdd(&bar[XB_TMO], 1u); break; } }
    }
    nloc = mine > 0u ? mine : 1u; nx = cnt > 0u ? cnt : 1u;
}
__device__ __forceinline__ void xcd_barrier(const XcdBarrier& b) {
    asm volatile("s_waitcnt vmcnt(0)" ::: "memory");
    __syncthreads();
    if (threadIdx.x == 0) {
        unsigned* bar = b.bar;
        __builtin_amdgcn_s_waitcnt(0);
        unsigned nloc = b.st[0], nx = b.st[1];
        if (nloc == 0u) { xcd_barrier_complete(bar, b.x, nloc, nx); b.st[0] = nloc; b.st[1] = nx; }
        const unsigned old = xb_add(&bar[XB_XSUB(b.x)], 1u);
        const unsigned gen = old / nloc;
        if (old + 1u == (gen + 1u) * nloc) {
            __builtin_amdgcn_fence(__ATOMIC_RELEASE, "agent");
            asm volatile("s_waitcnt vmcnt(0)" ::: "memory");
            const unsigned og = xb_add(&bar[XB_TOP], 1u);
            const unsigned tg = og / nx;
            if (og + 1u == (tg + 1u) * nx) xb_add(&bar[XB_TOPGEN], 1u);
            else XB_SPIN(xb_ld(&bar[XB_TOPGEN]) == tg, bar);
            __builtin_amdgcn_fence(__ATOMIC_ACQUIRE, "agent");
            xb_add(&bar[XB_XGEN(b.x)], 1u);
            asm volatile("s_waitcnt vmcnt(0)" ::: "memory");
        } else {
            XB_SPIN(xb_ld(&bar[XB_XGEN(b.x)]) == gen, bar);
            __builtin_amdgcn_fence(__ATOMIC_ACQUIRE, "agent");
            asm volatile("s_waitcnt vmcnt(0)" ::: "memory");
        }
    }
    __syncthreads();
}

namespace pg8 {
constexpr int BM = 256, BK = 64, HALF = 128, HTB = HALF * BK * 2, STAGE_BYTES = 8 * HTB, NXCD = 8, WGM = 8;
__host__ __device__ __forceinline__ int lds_byte(int r, int c) { const int st = (r >> 4) * 2 + (c >> 5), rr = r & 15, cc = c & 31, ob = rr * 64 + cc * 2; return st * 1024 + (ob ^ (((ob >> 9) & 1) << 5)); }
__host__ __device__ __forceinline__ void stage_rc(int b, int& R, int& C) { const int st = b / 1024, sb = b % 1024, swz = sb ^ (((sb >> 9) & 1) << 5); R = (st >> 1) * 16 + swz / 64; C = (st & 1) * 32 + (swz % 64) / 2; }
__host__ __device__ __forceinline__ int perm32(int rho) { const int n = rho >> 4, i = rho & 15; return 8 * (i >> 2) + 4 * n + (i & 3); }

struct Unit { unsigned aoff, boff; int pm, pn, kind, x0, x1; };
struct Gemm { const bf16_t* A; const bf16_t* Bt; int K; };

__device__ __forceinline__ void swz_map(int L, int nM, int nN, int& pm, int& pn) {
    const int nwg = nM * nN; int wgid = L;
    { const int q = nwg / NXCD, r = nwg % NXCD, xcd = wgid % NXCD, off = wgid / NXCD; wgid = (xcd < r ? xcd * (q + 1) : r * (q + 1) + (xcd - r) * q) + off; }
    const int nig = WGM * nN, gid = wgid / nig, fm = gid * WGM, gsz = (nM - fm) < WGM ? (nM - fm) : WGM;
    pm = fm + ((wgid % nig) % gsz); pn = (wgid % nig) / gsz;
}

struct NoGather { static constexpr bool GA = false, GB = false;
    __device__ __forceinline__ unsigned arow(const Unit&, int) const { return 0u; }
    __device__ __forceinline__ unsigned brow(const Unit&, int) const { return 0u; } };

template <class Epi, class Sched, class Rows>
__device__ __forceinline__ void gemm_phase(LAS unsigned char* lds, const Gemm g, const Sched& S, const Epi& E, const Rows& RW) {
    int tid_ = threadIdx.x; asm volatile("" : "+v"(tid_));
    const int tid = tid_, wid = __builtin_amdgcn_readfirstlane(tid >> 6), lane = tid & 63, wr = wid >> 2, wc = wid & 3, fr = lane & 15, fq = lane >> 4;
    int K_ = g.K; asm volatile("" : "+s"(K_));
    const int K = K_, nt = K / BK;
    int sR[2], sRb[2], sC[2];
#pragma unroll
    for (int i = 0; i < 2; ++i) { int R, C; stage_rc(tid * 16 + i * 8192, R, C); sR[i] = R; sC[i] = C; sRb[i] = (R & ~31) + perm32(R & 31); }
    unsigned voffA[2], voffB[2];
#pragma unroll
    for (int i = 0; i < 2; ++i) { voffA[i] = (unsigned)(sR[i] * K + sC[i]) * 2u; voffB[i] = (unsigned)(sRb[i] * K + sC[i]) * 2u; }
    const size_t kstep = (size_t)(BK * 2);
    const size_t hstep = (size_t)HALF * K * 2;
    const unsigned ldsw = (unsigned)wid * 1024u;
    const int aoff = lds_byte(wr * 64 + fr, fq * 8), boff = lds_byte(wc * 32 + fr, fq * 8);
    struct Side { const char* base[2]; unsigned off[2][2]; };
#define PG8_SA(b, h) (((b) * 2 + (h)) * HTB)
#define PG8_SB(b, h) ((4 + (b) * 2 + (h)) * HTB)
#define PG8_STAGE(bufoff, side, h, kt) do { _Pragma("unroll") for (int _i = 0; _i < 2; ++_i) \
        __builtin_amdgcn_global_load_lds((const unsigned*)((side).base[h] + (size_t)(kt) * kstep + (side).off[h][_i]), (LAS unsigned*)(lds + (bufoff) + ldsw + _i * 8192), 16, 0, 0); } while (0)
#define PG8_LDA(dst, b, h) do { _Pragma("unroll") for (int m = 0; m < 4; ++m) _Pragma("unroll") for (int k = 0; k < 2; ++k) dst[m][k] = *(const LAS bf16x8*)(lds + PG8_SA(b, h) + aoff + m * 2048 + k * 1024); } while (0)
#define PG8_LDB(dst, b, h) do { _Pragma("unroll") for (int n = 0; n < 2; ++n) _Pragma("unroll") for (int k = 0; k < 2; ++k) dst[n][k] = *(const LAS bf16x8*)(lds + PG8_SB(b, h) + boff + n * 2048 + k * 1024); } while (0)
#define PG8_MMA(ai, bj, At, Bt) do { __builtin_amdgcn_s_setprio(1); _Pragma("unroll") for (int m = 0; m < 4; ++m) _Pragma("unroll") for (int n = 0; n < 2; ++n) _Pragma("unroll") for (int k = 0; k < 2; ++k) \
        acc[ai][bj][m][n] = __builtin_amdgcn_mfma_f32_16x16x32_bf16(Bt[n][k], At[m][k], acc[ai][bj][m][n], 0, 0, 0); __builtin_amdgcn_s_setprio(0); } while (0)
#define PG8_WAIT_V(n) asm volatile("s_waitcnt vmcnt(" #n ")" ::: "memory")
#define PG8_WAIT_L(n) asm volatile("s_waitcnt lgkmcnt(" #n ")" ::: "memory")
#define PG8_BAR __builtin_amdgcn_s_barrier()
#define PG8_SCHED __builtin_amdgcn_sched_barrier(0)
#define PG8_MKSIDES(u, sa, sb) do { \
        if constexpr (Rows::GA) { sa.base[0] = sa.base[1] = (const char*)g.A; _Pragma("unroll") for (int h = 0; h < 2; ++h) _Pragma("unroll") for (int i = 0; i < 2; ++i) sa.off[h][i] = RW.arow(u, h * HALF + sR[i]) + (unsigned)sC[i] * 2u; } \
        else { sa.base[0] = (const char*)g.A + (u).aoff; sa.base[1] = sa.base[0] + hstep; _Pragma("unroll") for (int h = 0; h < 2; ++h) _Pragma("unroll") for (int i = 0; i < 2; ++i) sa.off[h][i] = voffA[i]; } \
        if constexpr (Rows::GB) { sb.base[0] = sb.base[1] = (const char*)g.Bt; _Pragma("unroll") for (int h = 0; h < 2; ++h) _Pragma("unroll") for (int i = 0; i < 2; ++i) sb.off[h][i] = RW.brow(u, h * HALF + sRb[i]) + (unsigned)sC[i] * 2u; } \
        else { sb.base[0] = (const char*)g.Bt + (u).boff; sb.base[1] = sb.base[0] + hstep; _Pragma("unroll") for (int h = 0; h < 2; ++h) _Pragma("unroll") for (int i = 0; i < 2; ++i) sb.off[h][i] = voffB[i]; } } while (0)
    Unit cur, nxt; int ui = 0;
    if (!S.next(0, cur)) return;
    f32x4 acc[2][2][4][2];
#pragma unroll
    for (int a = 0; a < 2; ++a)
#pragma unroll
        for (int b = 0; b < 2; ++b)
#pragma unroll
            for (int m = 0; m < 4; ++m)
#pragma unroll
                for (int n = 0; n < 2; ++n) acc[a][b][m][n] = (f32x4){0.f, 0.f, 0.f, 0.f};
    bf16x8 At[4][2], B0[2][2], B1[2][2];
    Side cA, cB, nA, nB;
    PG8_MKSIDES(cur, cA, cB);
    PG8_STAGE(PG8_SB(0, 0), cB, 0, 0); PG8_STAGE(PG8_SB(0, 1), cB, 1, 0); PG8_STAGE(PG8_SA(0, 0), cA, 0, 0); PG8_STAGE(PG8_SA(0, 1), cA, 1, 0);
    if (wr == 1) PG8_BAR;
    PG8_WAIT_V(2); PG8_BAR;
    PG8_STAGE(PG8_SB(1, 0), cB, 0, 1); PG8_STAGE(PG8_SA(1, 0), cA, 0, 1); PG8_STAGE(PG8_SB(1, 1), cB, 1, 1);
    PG8_WAIT_V(6); PG8_BAR;
    for (;;) {
        const bool has_next = S.next(ui + 1, nxt);
        if (has_next) { PG8_MKSIDES(nxt, nA, nB); } else { nA = cA; nB = cB; }
        for (int t = 0; t < nt; t += 2) {
            const bool last = (t == nt - 2);
            Side a2, b2;
            a2.base[0] = last ? nA.base[0] : cA.base[0]; a2.base[1] = last ? nA.base[1] : cA.base[1];
            b2.base[0] = last ? nB.base[0] : cB.base[0]; b2.base[1] = last ? nB.base[1] : cB.base[1];
#pragma unroll
            for (int h = 0; h < 2; ++h)
#pragma unroll
                for (int i = 0; i < 2; ++i) { a2.off[h][i] = (Rows::GA && last) ? nA.off[h][i] : cA.off[h][i]; b2.off[h][i] = (Rows::GB && last) ? nB.off[h][i] : cB.off[h][i]; }
            const int k2 = last ? 0 : t + 2, k3 = k2 + 1;
            PG8_LDB(B0, 0, 0); PG8_LDB(B1, 0, 1); PG8_SCHED; PG8_LDA(At, 0, 0); PG8_STAGE(PG8_SA(1, 1), cA, 1, t + 1);
            PG8_WAIT_V(8); PG8_WAIT_L(0); PG8_BAR; PG8_MMA(0, 0, At, B0); PG8_MMA(0, 1, At, B1); PG8_BAR; PG8_SCHED;
            PG8_LDA(At, 0, 1); PG8_STAGE(PG8_SB(0, 0), b2, 0, k2); PG8_STAGE(PG8_SB(0, 1), b2, 1, k2); PG8_STAGE(PG8_SA(0, 0), a2, 0, k2);
            PG8_WAIT_V(8); PG8_WAIT_L(0); PG8_BAR; PG8_MMA(1, 0, At, B0); PG8_MMA(1, 1, At, B1); PG8_BAR; PG8_SCHED;
            PG8_LDB(B0, 1, 0); PG8_LDB(B1, 1, 1); PG8_SCHED; PG8_LDA(At, 1, 0); PG8_STAGE(PG8_SA(0, 1), a2, 1, k2);
            PG8_WAIT_V(8); PG8_WAIT_L(0); PG8_BAR; PG8_MMA(0, 0, At, B0); PG8_MMA(0, 1, At, B1); PG8_BAR; PG8_SCHED;
            PG8_LDA(At, 1, 1); PG8_STAGE(PG8_SB(1, 0), b2, 0, k3); PG8_STAGE(PG8_SB(1, 1), b2, 1, k3); PG8_STAGE(PG8_SA(1, 0), a2, 0, k3);
            PG8_WAIT_V(8); PG8_WAIT_L(0); PG8_BAR; PG8_MMA(1, 0, At, B0); PG8_MMA(1, 1, At, B1); PG8_BAR; PG8_SCHED;
        }
        if (wr == 0) PG8_BAR;
        E(acc, cur, wr, wc, fr, fq);
        if (!has_next) break;
#pragma unroll
        for (int a = 0; a < 2; ++a)
#pragma unroll
            for (int b = 0; b < 2; ++b)
#pragma unroll
                for (int m = 0; m < 4; ++m)
#pragma unroll
                    for (int n = 0; n < 2; ++n) acc[a][b][m][n] = (f32x4){0.f, 0.f, 0.f, 0.f};
        cur = nxt; cA = nA; cB = nB; ++ui;
        if (wr == 1) PG8_BAR;
    }
    PG8_WAIT_V(0);
    PG8_BAR;
#undef PG8_SA
#undef PG8_SB
#undef PG8_STAGE
#undef PG8_LDA
#undef PG8_LDB
#undef PG8_MMA
#undef PG8_WAIT_V
#undef PG8_WAIT_L
#undef PG8_BAR
#undef PG8_SCHED
#undef PG8_MKSIDES
}
}
using pg8::Unit;

struct Args { const float* in[21]; float* out; unsigned char* ws; int ph_lo, ph_hi; };

struct Frame {
    LAS unsigned char* lds;
    unsigned char* ws;
    const float* const* in;
    float* out;
    int tid, lane, wave, G, bx;
};
__device__ __forceinline__ float* modp(const Frame& F, int l, int v) { return (float*)(F.ws + WS_CTL) + CW_MOD + (l * 3 + v) * MODSZ; }

__device__ __forceinline__ void p0_transpose_item(const float* W, int ldw, int k0, int c0, bf16_t* WT, int ldt, int drow0, int kdst0, bool rperm, LAS float* scr, int lane) {
#pragma unroll 8
    for (int i = 0; i < 32; ++i) { const int kk = 2 * i + (lane >> 5); scr[kk * 33 + (lane & 31)] = W[(size_t)(k0 + kk) * ldw + c0 + (lane & 31)]; }
    LDS_WAIT(); asm volatile("" ::: "memory");
    const int c = lane & 7;
#pragma unroll
    for (int j = 0; j < 4; ++j) { const int n = (lane >> 3) + 8 * j; const LAS float* s = scr + (8 * c) * 33 + n;
        u32x4 o; o.x = pk2(s[0 * 33], s[1 * 33]); o.y = pk2(s[2 * 33], s[3 * 33]); o.z = pk2(s[4 * 33], s[5 * 33]); o.w = pk2(s[6 * 33], s[7 * 33]);
        const int dn = rperm ? ((n < 16) ? 2 * n : 2 * (n - 16) + 1) : n;
        *(u32x4*)(WT + (size_t)(drow0 + dn) * ldt + kdst0 + k0 + 8 * c) = o; }
    LDS_WAIT(); asm volatile("" ::: "memory");
}

__device__ __forceinline__ void p0_prologue(Frame& F) {
    const float* const* in = F.in;
    LAS float* scr = (LAS float*)(F.lds + F.wave * 16384);
    const int gw = F.bx * NWAVES + F.wave, NGW = F.G * NWAVES;
    {
        constexpr int I_IN = 16 * 88, I_O = 16 * 32, I_GD = 16 * 88, I_DD = 44 * 32, I_GE = 16 * 112, I_DE = 56 * 32;
        constexpr int N_A = 2 * I_IN + 2 * I_O + 2 * I_GD + I_DD, N_E = NE * (2 * I_GE + I_DE), NITEMS = N_A + N_E;
        for (int it = gw; it < NITEMS; it += NGW) {
            int r = it;
            if (r < 2 * I_IN) { const int l = r / I_IN; r %= I_IN; const int kb = r / 88, nb = r % 88, c0 = 512 + 32 * nb;
                const bool rp = c0 < OFFV;
                p0_transpose_item(in[8] + (size_t)l * D * INW, INW, 64 * kb, c0, (bf16_t*)(F.ws + (l ? WS_WIN1 : WS_WIN0)), D, c0, 0, rp, scr, F.lane); continue; }
            r -= 2 * I_IN;
            if (r < 2 * I_O) { const int l = r / I_O; r %= I_O; const int kb = r / 32, nb = r % 32;
                p0_transpose_item(in[12] + (size_t)l * D * D, D, 64 * kb, 32 * nb, (bf16_t*)(F.ws + (l ? WS_WO1 : WS_WO0)), D, 32 * nb, 0, false, scr, F.lane); continue; }
            r -= 2 * I_O;
            if (r < 2 * I_GD) { const int up = r / I_GD; r %= I_GD; const int kb = r / 88, nb = r % 88, c0 = 32 * nb;
                p0_transpose_item(in[up ? 14 : 13], DFF0, 64 * kb, c0, (bf16_t*)(F.ws + WS_WGUD), D, (c0 >> 7) * 256 + up * 128 + (c0 & 127), 0, false, scr, F.lane); continue; }
            r -= 2 * I_GD;
            if (r < I_DD) { const int kb = r / 32, nb = r % 32;
                p0_transpose_item(in[15], D, 64 * kb, 32 * nb, (bf16_t*)(F.ws + WS_WDD), DFF0, 32 * nb, 0, false, scr, F.lane); continue; }
            r -= I_DD;
            { const int e = r / (2 * I_GE + I_DE); r %= (2 * I_GE + I_DE);
              if (r < 2 * I_GE) { const int up = r / I_GE; r %= I_GE; const int kb = r / 112, nb = r % 112, c0 = 32 * nb;
                  p0_transpose_item(in[up ? 18 : 17] + (size_t)e * D * DFFE, DFFE, 64 * kb, c0, (bf16_t*)(F.ws + WS_WGUE) + (size_t)e * 2 * DFFE * D, D, (c0 >> 7) * 256 + up * 128 + (c0 & 127), 0, false, scr, F.lane); continue; }
              r -= 2 * I_GE;
              { const int kb = r / 32, nb = r % 32;
                p0_transpose_item(in[19] + (size_t)e * DFFE * D, D, 64 * kb, 32 * nb, (bf16_t*)(F.ws + WS_WDE) + (size_t)e * D * DFFE, DFFE, 32 * nb, 0, false, scr, F.lane); } }
        }
    }
    __syncthreads();
    {
        LAS float* wrow = (LAS float*)F.lds;
        LAS float* ctab = wrow + 4096;
        if (F.tid < 128) ctab[F.tid] = cospif((float)F.tid / 64.0f);
        for (int it = F.bx; it < 2 * 128; it += F.G) {
            const int l = it >> 7, d0 = (it & 127) * 8;
            __syncthreads();
            for (int i = F.tid; i < 4096; i += NTHR) wrow[i] = in[8][(size_t)l * D * INW + (size_t)(d0 + (i >> 9)) * INW + (i & 511)];
            __syncthreads();
            const int r = F.tid, j = r >> 1, ri = r & 1, g = j >> 6, jj = j & 63;
            float a[8];
#pragma unroll
            for (int q = 0; q < 8; ++q) a[q] = 0.f;
            for (int cc = 0; cc < 128; ++cc) {
                float cf;
                if (jj == 0) cf = ri ? ((cc & 1) ? -1.f : 1.f) : 1.f;
                else { const int idx = (cc * jj) & 127; cf = ri ? -ctab[(idx - 32) & 127] : ctab[idx]; }
#pragma unroll
                for (int q = 0; q < 8; ++q) a[q] += cf * wrow[q * 512 + g * 128 + cc];
            }
            u32x4 o; o.x = pk2(a[0], a[1]); o.y = pk2(a[2], a[3]); o.z = pk2(a[4], a[5]); o.w = pk2(a[6], a[7]);
            *(u32x4*)((bf16_t*)(F.ws + (l ? WS_WIN1 : WS_WIN0)) + (size_t)r * D + d0) = o;
        }
        __syncthreads();
    }
    const int gt = F.bx * NTHR + F.tid, NGT = F.G * NTHR;
    for (int it = gt; it < 2 * 2048 * 144; it += NGT) {
        const int l = it / (2048 * 144), r = it % (2048 * 144), kc = r / 2048, np = r % 2048;
        const int pn = np >> 8, half = (np >> 7) & 1, o = 128 * pn + (np & 127);
        const float* wf = in[10] + (size_t)l * 512 * D; const float* wa = in[11] + (size_t)l * 512 * D;
        float v[8];
#pragma unroll
        for (int q = 0; q < 8; ++q) { const int k = kc * 8 + q; float x = 0.f;
            if (half == 0) { if (k < 512) { const int mm = k & 127; x = wf[(size_t)k * D + o] * ((mm == 0 || mm == 64) ? 0.5f : 1.f); }
                             else if (k < 520) { const int gg = (k - 512) >> 1, s = (k - 512) & 1; x = 0.5f * wf[(size_t)(gg * 128 + 64 * s) * D + o]; } }
            else { if (k >= 640) x = wa[(size_t)(k - 640) * D + o]; }
            v[q] = x; }
        u32x4 w; w.x = pk2(v[0], v[1]); w.y = pk2(v[2], v[3]); w.z = pk2(v[4], v[5]); w.w = pk2(v[6], v[7]);
        *(u32x4*)((bf16_t*)(F.ws + (l ? WS_WM1 : WS_WM0)) + (size_t)np * KM + kc * 8) = w;
    }
    for (int it = gt; it < 192 * 16; it += NGT) {
        const int i = it & 15, p = it >> 4, pos = p < 128 ? p : p - 128;
        const float inv = powf(10000.0f, -(float)i / 16.0f), a = (float)pos * inv;
        ((f32x2*)(F.ws + WS_ROPE))[it] = (f32x2){cosf(a), sinf(a)};
    }
    for (int it = gt; it < 128 * 64; it += NGT) {
        const int t2 = it >> 6, k1 = it & 63; float s, c; sincospif((float)(t2 * k1) / 4096.0f, &s, &c);
        ((f32x2*)(F.ws + WS_TW))[it] = (f32x2){c, s};
    }
    for (int it = gt; it < 256 * 128; it += NGT) {
        const int nu = it >> 7, ka = it & 127; float v = 0.f;
        if (nu < 128) { const int k1 = nu >> 1, ro = nu & 1, ri = ka >> 6, t1 = ka & 63; float s, c; sincospif((float)((t1 * k1) & 63) / 32.0f, &s, &c);
            v = ro == 0 ? (ri == 0 ? c : s) : (ri == 0 ? -s : c); }
        ((bf16_t*)(F.ws + WS_FA64))[it] = (bf16_t)f2bf(v);
    }
    for (int it = gt; it < 256 * 256; it += NGT) {
        const int mu = it >> 8, la = it & 255, k2 = mu >> 1, ro = mu & 1, ri = la >> 7, t2 = la & 127; float s, c; sincospif((float)((t2 * k2) & 127) / 64.0f, &s, &c);
        const float v = (ro == 0 ? (ri == 0 ? c : s) : (ri == 0 ? -s : c)) * 0.0009765625f;
        ((bf16_t*)(F.ws + WS_TC))[it] = (bf16_t)f2bf(v);
    }
    for (int it = gt; it < 512 * 512; it += NGT) {
        const int mu = it >> 9, la = it & 511, k = mu >> 1, ro = mu & 1, ri = la >> 8, t = la & 255; float s, c; sincospif((float)((t * k) & 255) / 128.0f, &s, &c);
        const float v = (ro == 0 ? (ri == 0 ? c : s) : (ri == 0 ? -s : c)) * 0.005524271728019903f;
        ((bf16_t*)(F.ws + WS_TX))[it] = (bf16_t)f2bf(v);
    }
    __syncthreads();
    for (int it = F.bx; it < 2 * 96; it += F.G) {
        const int l = it / 96, n = (it % 96) * 64 + F.lane;
        const float* wm = in[4] + (size_t)l * D * MODSZ;
        float a0 = 0.f, a1 = 0.f, a2 = 0.f;
        for (int dd = 0; dd < 128; ++dd) { const int d = F.wave * 128 + dd;
            const float c0 = in[1][d], c1 = in[1][D + d], c2 = in[3][d];
            const float s0 = c0 / (1.0f + __expf(-c0)), s1 = c1 / (1.0f + __expf(-c1)), s2 = c2 / (1.0f + __expf(-c2));
            const float w = wm[(size_t)d * MODSZ + n];
            a0 += s0 * w; a1 += s1 * w; a2 += s2 * w; }
        LAS float* part = (LAS float*)F.lds;
        __syncthreads();
        part[(F.wave * 3 + 0) * 64 + F.lane] = a0; part[(F.wave * 3 + 1) * 64 + F.lane] = a1; part[(F.wave * 3 + 2) * 64 + F.lane] = a2;
        __syncthreads();
        if (F.tid < 192) { const int v = F.tid >> 6, ln = F.tid & 63; float sacc = in[5][l * MODSZ + (it % 96) * 64 + ln];
#pragma unroll
            for (int w = 0; w < 8; ++w) sacc += part[(w * 3 + v) * 64 + ln];
            modp(F, l, v)[(it % 96) * 64 + ln] = sacc; }
    }
    for (int it = gt; it < NTOK * 15; it += NGT) { const int row = it / 15, c = it % 15;
        *(u32x4*)((bf16_t*)(F.ws + WS_FO) + (size_t)row * KM + 520 + c * 8) = (u32x4){0u, 0u, 0u, 0u}; }
}

__device__ __forceinline__ const float* xrow_ptr(const Frame& F, int row, const float* xl) { return row < NL ? xl + (size_t)row * D : (const float*)(F.ws + WS_XC) + (size_t)(row - NL) * D; }

template <bool ROUTE>
__device__ __forceinline__ void norm_phase(Frame& F, int l, int which  , const float* xl, const float* xc, int nrows) {
    const float* gvec = F.in[which ? 7 : 6] + l * D;
    LAS float* wr_l = (LAS float*)F.lds;
    if (ROUTE) { for (int i = F.tid; i < D * NE; i += NTHR) wr_l[i] = F.in[16][i]; __syncthreads(); }
    const int gw = F.bx * NWAVES + F.wave, NGW = F.G * NWAVES;
    for (int row = gw; row < nrows; row += NGW) {
        const int v = row < T ? 0 : (row < NL ? 1 : 2);
        const float* xr = row < NL ? xl + (size_t)row * D : xc + (size_t)(row - NL) * D;
        const float* sh = modp(F, l, v) + (which ? 3 : 0) * D; const float* sc = sh + D;
        f32x4 x[4]; float s = 0.f;
#pragma unroll
        for (int j = 0; j < 4; ++j) { x[j] = *(const f32x4*)(xr + 256 * j + 4 * F.lane); s += (x[j].x * x[j].x + x[j].y * x[j].y) + (x[j].z * x[j].z + x[j].w * x[j].w); }
        const float r = 1.0f / sqrtf(wave_sum(s) * (1.f / D) + EPS);
        float lg[NE];
        if (ROUTE) {
#pragma unroll
            for (int e = 0; e < NE; ++e) lg[e] = 0.f; }
        bf16_t* hr = (bf16_t*)(F.ws + WS_H) + (size_t)row * D;
#pragma unroll
        for (int j = 0; j < 4; ++j) { const int c = 256 * j + 4 * F.lane;
            const f32x4 gg = *(const f32x4*)(gvec + c), s4 = *(const f32x4*)(sh + c), c4 = *(const f32x4*)(sc + c);
            f32x4 h = (x[j] * r) * gg; h = h * (c4 + 1.0f) + s4;
            u32x2 o; o.x = pk2(h.x, h.y); o.y = pk2(h.z, h.w); *(u32x2*)(hr + c) = o;
            if (ROUTE) {
#pragma unroll
                for (int q = 0; q < 4; ++q) { const float hv = h[q]; const LAS f32x4* w = (const LAS f32x4*)(wr_l + (c + q) * NE); const f32x4 w0 = w[0], w1 = w[1];
                    lg[0] += hv * w0.x; lg[1] += hv * w0.y; lg[2] += hv * w0.z; lg[3] += hv * w0.w; lg[4] += hv * w1.x; lg[5] += hv * w1.y; lg[6] += hv * w1.z; lg[7] += hv * w1.w; } }
        }
        if (ROUTE) {
#pragma unroll
            for (int e = 0; e < NE; ++e) lg[e] = wave_sum(lg[e]);
            if (F.lane == 0) {
                int e1 = 0; float v1 = lg[0];
#pragma unroll
                for (int e = 1; e < NE; ++e) if (lg[e] > v1) { v1 = lg[e]; e1 = e; }
                int e2 = -1; float v2 = -3.0e38f;
#pragma unroll
                for (int e = 0; e < NE; ++e) if (e != e1 && lg[e] > v2) { v2 = lg[e]; e2 = e; }
                const float p2 = __expf(v2 - v1), w1 = 1.f / (1.f + p2), w2 = p2 * w1;
                unsigned* cnt = (unsigned*)(F.ws + WS_CTL) + CW_CNT;
                const unsigned r1 = atomicAdd(cnt + 64 * e1, 1u), r2 = atomicAdd(cnt + 64 * e2, 1u);
                int* toke = (int*)(F.ws + WS_TOKE); int* tokr = (int*)(F.ws + WS_TOKR); float* tokw = (float*)(F.ws + WS_TOKW); int* list = (int*)(F.ws + WS_LIST);
                toke[2 * row] = e1; toke[2 * row + 1] = e2; tokr[2 * row] = (int)r1; tokr[2 * row + 1] = (int)r2; tokw[2 * row] = w1; tokw[2 * row + 1] = w2;
                list[e1 * NL + r1] = row; list[e2 * NL + r2] = row;
            }
        }
    }
}

__device__ __forceinline__ void final_phase(Frame& F) {
    const int gw = F.bx * NWAVES + F.wave, NGW = F.G * NWAVES;
    const unsigned* cnt = (const unsigned*)(F.ws + WS_CTL) + CW_CNT;
    int base[NE]; { int b = 0;
#pragma unroll
        for (int e = 0; e < NE; ++e) { base[e] = b; b += ((int)cnt[64 * e] + 255) & ~255; } }
    const int* toke = (const int*)(F.ws + WS_TOKE); const int* tokr = (const int*)(F.ws + WS_TOKR); const float* tokw = (const float*)(F.ws + WS_TOKW);
    const bf16_t* dout = (const bf16_t*)(F.ws + WS_DOUT);
    for (int row = gw; row < NL; row += NGW) {
        const int v = row < T ? 0 : 1;
        const float* ga2 = modp(F, 1, v) + 5 * D;
        const int e1 = toke[2 * row], e2 = toke[2 * row + 1];
        int b1 = 0, b2 = 0;
#pragma unroll
        for (int e = 0; e < NE; ++e) { if (e == e1) b1 = base[e]; if (e == e2) b2 = base[e]; }
        const bf16_t* d1 = dout + (size_t)(b1 + tokr[2 * row]) * D; const bf16_t* d2 = dout + (size_t)(b2 + tokr[2 * row + 1]) * D;
        const float w1 = tokw[2 * row], w2 = tokw[2 * row + 1];
        float* xr = F.out + (size_t)row * D;
        f32x4 x[4]; float s = 0.f;
#pragma unroll
        for (int j = 0; j < 4; ++j) { const int c = 256 * j + 4 * F.lane;
            const u32x2 a = *(const u32x2*)(d1 + c), b = *(const u32x2*)(d2 + c); const f32x4 g4 = *(const f32x4*)(ga2 + c);
            f32x4 y; y.x = w1 * bflo(a.x) + w2 * bflo(b.x); y.y = w1 * bfhi(a.x) + w2 * bfhi(b.x); y.z = w1 * bflo(a.y) + w2 * bflo(b.y); y.w = w1 * bfhi(a.y) + w2 * bfhi(b.y);
            x[j] = *(const f32x4*)(xr + c) + g4 * y;
            s += (x[j].x * x[j].x + x[j].y * x[j].y) + (x[j].z * x[j].z + x[j].w * x[j].w); }
        const float r = 1.0f / sqrtf(wave_sum(s) * (1.f / D) + EPS);
#pragma unroll
        for (int j = 0; j < 4; ++j) { const int c = 256 * j + 4 * F.lane; *(f32x4*)(xr + c) = (x[j] * r) * *(const f32x4*)(F.in[20] + c); }
    }
}

struct GridSched { int nM, nN, G, c; unsigned abytes, bbytes;
    __device__ __forceinline__ bool next(int i, Unit& u) const { const int L = i * G + c; if (L >= nM * nN) return false; pg8::swz_map(L, nM, nN, u.pm, u.pn); u.aoff = (unsigned)u.pm * abytes; u.boff = (unsigned)u.pn * bbytes; u.kind = 0; u.x0 = 0; u.x1 = 0; return true; } };

struct InprojSched { int G, c, l;
    __device__ __forceinline__ bool next(int i, Unit& u) const { const int L = i * G + c; const int nmain = 64 * 11;
        if (L < nmain) { pg8::swz_map(L, 64, 11, u.pm, u.pn); }
        else { const int r = L - nmain; if (l == 0) { if (r >= 22) return false; u.pm = 64 + r / 11; u.pn = r % 11; } else { if (r >= 2) return false; u.pm = 64 + r; u.pn = 2; } }
        u.aoff = (unsigned)u.pm * (256u * D * 2u); u.boff = (unsigned)u.pn * (256u * D * 2u); u.kind = 0; u.x0 = 0; u.x1 = 0; return true; } };

struct EpiInproj {
    static constexpr bool PERM = true;
    unsigned char* ws;
    __device__ __forceinline__ void operator()(const f32x4 (&acc)[2][2][4][2], const Unit& u, int wr, int wc, int fr, int fq) const {
        const int row0 = u.pm * 256 + wr * 64 + fr;
        const bool lat = u.pm < 64;
        const f32x2* rope = (const f32x2*)(ws + WS_ROPE);
#pragma unroll
        for (int ai = 0; ai < 2; ++ai)
#pragma unroll
            for (int m = 0; m < 4; ++m) {
                const int row = row0 + ai * 128 + m * 16;
                const int t = row & (T - 1), prow = t >> 6, pcol = t & 63;
#pragma unroll
                for (int bj = 0; bj < 2; ++bj) {
                    const int cl = u.pn * 256 + bj * 128 + wc * 32 + 8 * fq;
                    f32x4 v0 = acc[ai][bj][m][0], v1 = acc[ai][bj][m][1];
                    bf16_t* dst;
                    if (cl < 640) {
                        if (lat) { const int dh = cl & 63, i0 = (dh & 31) >> 1; const f32x2* rp = rope + ((dh < 32 ? prow : 128 + pcol) * 16 + i0);
                            const f32x2 c0 = rp[0], c1 = rp[1], c2 = rp[2], c3 = rp[3];
                            f32x4 w0, w1; w0.x = v0.x * c0.x - v0.y * c0.y; w0.y = v0.x * c0.y + v0.y * c0.x; w0.z = v0.z * c1.x - v0.w * c1.y; w0.w = v0.z * c1.y + v0.w * c1.x;
                            w1.x = v1.x * c2.x - v1.y * c2.y; w1.y = v1.x * c2.y + v1.y * c2.x; w1.z = v1.z * c3.x - v1.w * c3.y; w1.w = v1.z * c3.y + v1.w * c3.x; v0 = w0; v1 = w1; }
                        if (cl < 512) { v0 = v0 * QSCALE; v1 = v1 * QSCALE; dst = (bf16_t*)(ws + WS_Q) + (size_t)row * 512 + cl; }
                        else dst = (bf16_t*)(ws + WS_KB) + (size_t)row * 128 + (cl - 512);
                    } else if (cl < 768) { dst = (bf16_t*)(ws + WS_VB) + (size_t)row * 128 + (cl - 640); }
                    else { const int cg = cl - 768;
#pragma unroll
                        for (int q = 0; q < 4; ++q) { v0[q] = sigmoidf_(v0[q]); v1[q] = sigmoidf_(v1[q]); }
                        dst = (cg < 1024 ? (bf16_t*)(ws + WS_GF) + (size_t)row * D + cg : (bf16_t*)(ws + WS_GA) + (size_t)row * D + (cg - 1024)); }
                    u32x4 w; w.x = cvt_pk_bf16(v0[0], v0[1]); w.y = cvt_pk_bf16(v0[2], v0[3]); w.z = cvt_pk_bf16(v1[0], v1[1]); w.w = cvt_pk_bf16(v1[2], v1[3]);
                    *(u32x4*)dst = w;
                }
            }
    }
};

struct UpermSched { int G, c, l;
    __device__ __forceinline__ bool next(int i, Unit& u) const { const int L = i * G + c; const int nn = l == 0 ? 66 : 64; if (L >= 2 * nn) return false;
        u.pm = L & 1; u.pn = L >> 1; u.aoff = (unsigned)u.pm * (256u * D * 2u); u.boff = 0; u.kind = 0; u.x0 = 0; u.x1 = 0; return true; } };
struct UpermRows { static constexpr bool GA = false, GB = true;
    __device__ __forceinline__ unsigned arow(const Unit&, int) const { return 0u; }
    __device__ __forceinline__ unsigned brow(const Unit& u, int c) const { const int n = u.pn; int row;
        if (n < 64) { const int b = n >> 5, q = n & 31; row = b * T + 128 * (c & 63) + 4 * q + (c >> 6); } else row = NL + (n - 64) * 256 + c;
        return (unsigned)row * (D * 2u); } };
struct EpiUperm {
    static constexpr bool PERM = true;
    unsigned char* ws;
    __device__ __forceinline__ void operator()(const f32x4 (&acc)[2][2][4][2], const Unit& u, int wr, int wc, int fr, int fq) const {
        const int n = u.pn;
#pragma unroll
        for (int ai = 0; ai < 2; ++ai)
#pragma unroll
            for (int m = 0; m < 4; ++m) { const int r = u.pm * 256 + ai * 128 + wr * 64 + m * 16 + fr, j = r >> 1, ri = r & 1;
#pragma unroll
                for (int bj = 0; bj < 2; ++bj) { const int c = bj * 128 + wc * 32 + 8 * fq;
                    const f32x4 v0 = acc[ai][bj][m][0], v1 = acc[ai][bj][m][1];
                    u32x4 w; w.x = cvt_pk_bf16(v0[0], v0[1]); w.y = cvt_pk_bf16(v0[2], v0[3]); w.z = cvt_pk_bf16(v1[0], v1[1]); w.w = cvt_pk_bf16(v1[2], v1[3]);
                    bf16_t* dst;
                    if (n < 64) { const int b = n >> 5, q = n & 31, t2 = 4 * q + (c >> 6), t1 = c & 63; dst = (bf16_t*)(ws + WS_UP) + ((size_t)((j * 2 + b) * 128 + t2) * 128 + ri * 64 + t1); }
                    else { const int b = n - 64; dst = (bf16_t*)(ws + WS_VCT) + ((size_t)((b * 256 + j) * 2 + ri) * 256 + c); }
                    *(u32x4*)dst = w; } }
    }
};

struct EpiStepA {
    static constexpr bool PERM = true;
    unsigned char* ws;
    __device__ __forceinline__ void operator()(const f32x4 (&acc)[2][2][4][2], const Unit& u, int wr, int wc, int fr, int fq) const {
        const f32x2* tw = (const f32x2*)(ws + WS_TW); bf16_t* gp = (bf16_t*)(ws + WS_GP);
        const int j = u.pm;
#pragma unroll
        for (int ai = 0; ai < 2; ++ai)
#pragma unroll
            for (int m = 0; m < 4; ++m) { const int t2 = wr * 64 + m * 16 + fr, b = ai;
#pragma unroll
                for (int n = 0; n < 2; ++n) { const f32x4 v = acc[ai][0][m][n];
#pragma unroll
                    for (int p = 0; p < 2; ++p) { const int k1 = 16 * wc + 4 * fq + 2 * n + p; const f32x2 w = tw[t2 * 64 + k1];
                        const float gr = v[2 * p], gi = v[2 * p + 1];
                        const float orr = gr * w.x + gi * w.y, oi = gi * w.x - gr * w.y;
                        bf16_t* d = gp + ((size_t)((b * 64 + k1) * 256 + j) * 256 + t2);
                        d[0] = (bf16_t)f2bf(orr); d[128] = (bf16_t)f2bf(oi); } } }
    }
};
template <bool CTXV> struct EpiStepC {
    static constexpr bool PERM = true;
    unsigned char* ws;
    __device__ __forceinline__ void operator()(const f32x4 (&acc)[2][2][4][2], const Unit& u, int wr_, int wc_, int fr_, int fq_) const {
        int wr = wr_, wc = wc_, fr = fr_, fq = fq_, upm = u.pm, upn = u.pn;
        asm volatile("" : "+s"(wr), "+s"(wc), "+v"(fr), "+v"(fq), "+s"(upm), "+s"(upn));
        bf16_t* fo = (bf16_t*)(ws + WS_FO);
        const int NN = CTXV ? 256 : T;
        const int b = CTXV ? upm : (upm >> 6), k1 = CTXV ? 0 : (upm & 63), rowb = CTXV ? NL + b * 256 : b * T;
        const int own0 = wr * 128 + fr, mir0 = wr * 128 + 128 - fr;
        const int kk0 = (CTXV ? 128 * upn : 0) + 16 * wc + 4 * fq;
#pragma unroll
        for (int bj = 0; bj < 2; ++bj)
#pragma unroll
            for (int n = 0; n < 2; ++n)
#pragma unroll
                for (int p = 0; p < 2; ++p) {
                    const int kk = kk0 + 64 * bj + 2 * n + p;
                    const int k = CTXV ? kk : (k1 + 64 * kk), km = (NN - k) & (NN - 1);
                    const unsigned oo = (unsigned)(rowb + k) * KM, om = (unsigned)(rowb + km) * KM;
#pragma unroll
                    for (int ai = 0; ai < 2; ++ai)
#pragma unroll
                        for (int m = 0; m < 4; ++m) {
                            const f32x4 v = acc[ai][bj][m][n];
                            const bf16_t re = (bf16_t)f2bf(v[2 * p]);
                            if (m == 0 && fr == 0) { const int g = 2 * ai + wr; const bf16_t im = (bf16_t)f2bf(v[2 * p + 1]);
                                fo[oo + g * 128] = re; fo[om + 512 + 2 * g] = re; fo[oo + g * 128 + 64] = im; fo[om + 512 + 2 * g + 1] = im; }
                            else { fo[oo + own0 + ai * 256 + 16 * m] = re; fo[om + mir0 + ai * 256 - 16 * m] = re; }
                        }
                    asm volatile("" ::: "memory"); __builtin_amdgcn_sched_barrier(0);
                }
    }
};

struct EpiMerge {
    static constexpr bool PERM = true;
    unsigned char* ws;
    __device__ __forceinline__ void operator()(const f32x4 (&acc)[2][2][4][2], const Unit& u, int wr, int wc, int fr, int fq) const {
        const int col = u.pn * 128 + wc * 32 + 8 * fq;
#pragma unroll
        for (int ai = 0; ai < 2; ++ai)
#pragma unroll
            for (int m = 0; m < 4; ++m) { const size_t row = (size_t)(u.pm * 256 + ai * 128 + wr * 64 + m * 16 + fr);
                const u32x4 gf = *(const u32x4*)((const bf16_t*)(ws + WS_GF) + row * D + col), ga = *(const u32x4*)((const bf16_t*)(ws + WS_GA) + row * D + col);
                const f32x4 f0 = acc[ai][0][m][0], f1 = acc[ai][0][m][1], a0 = acc[ai][1][m][0], a1 = acc[ai][1][m][1];
                u32x4 w;
                w.x = cvt_pk_bf16(bflo(gf.x) * f0[0] + bflo(ga.x) * a0[0], bfhi(gf.x) * f0[1] + bfhi(ga.x) * a0[1]);
                w.y = cvt_pk_bf16(bflo(gf.y) * f0[2] + bflo(ga.y) * a0[2], bfhi(gf.y) * f0[3] + bfhi(ga.y) * a0[3]);
                w.z = cvt_pk_bf16(bflo(gf.z) * f1[0] + bflo(ga.z) * a1[0], bfhi(gf.z) * f1[1] + bfhi(ga.z) * a1[1]);
                w.w = cvt_pk_bf16(bflo(gf.w) * f1[2] + bflo(ga.w) * a1[2], bfhi(gf.w) * f1[3] + bfhi(ga.w) * a1[3]);
                *(u32x4*)((bf16_t*)(ws + WS_Y) + row * D + col) = w; }
    }
};

struct EpiResid {
    static constexpr bool PERM = true;
    const float* xl_in; float* xl_out; const float* xc_in; float* xc_out; const float* mod_l; int chunk;
    __device__ __forceinline__ void operator()(const f32x4 (&acc)[2][2][4][2], const Unit& u, int wr, int wc, int fr, int fq) const {
        const int v = u.pm < 32 ? 0 : (u.pm < 64 ? 1 : 2);
        const float* gate = mod_l + v * MODSZ + chunk * D;
        const bool lat = u.pm < 64; const int rbase = lat ? u.pm * 256 : (u.pm - 64) * 256;
        const float* xi = lat ? xl_in : xc_in; float* xo = lat ? xl_out : xc_out;
#pragma unroll
        for (int bj = 0; bj < 2; ++bj) { const int col = u.pn * 256 + bj * 128 + wc * 32 + 8 * fq;
            const f32x4 g0 = *(const f32x4*)(gate + col), g1 = *(const f32x4*)(gate + col + 4);
#pragma unroll
            for (int ai = 0; ai < 2; ++ai)
#pragma unroll
                for (int m = 0; m < 4; ++m) { const size_t o = (size_t)(rbase + ai * 128 + wr * 64 + m * 16 + fr) * D + col;
                    *(f32x4*)(xo + o) = *(const f32x4*)(xi + o) + g0 * acc[ai][bj][m][0];
                    *(f32x4*)(xo + o + 4) = *(const f32x4*)(xi + o + 4) + g1 * acc[ai][bj][m][1]; } }
    }
};

struct EpiSwiglu {
    static constexpr bool PERM = true;
    bf16_t* act; int ld;
    __device__ __forceinline__ void operator()(const f32x4 (&acc)[2][2][4][2], const Unit& u, int wr, int wc, int fr, int fq) const {
        const int col = u.pn * 128 + wc * 32 + 8 * fq;
#pragma unroll
        for (int ai = 0; ai < 2; ++ai)
#pragma unroll
            for (int m = 0; m < 4; ++m) { const size_t row = (size_t)(u.x0 + ai * 128 + wr * 64 + m * 16 + fr);
                float o[8];
#pragma unroll
                for (int n = 0; n < 2; ++n)
#pragma unroll
                    for (int q = 0; q < 4; ++q) { const float gv = acc[ai][0][m][n][q], uv = acc[ai][1][m][n][q]; o[4 * n + q] = gv * sigmoidf_(gv) * uv; }
                u32x4 w; w.x = cvt_pk_bf16(o[0], o[1]); w.y = cvt_pk_bf16(o[2], o[3]); w.z = cvt_pk_bf16(o[4], o[5]); w.w = cvt_pk_bf16(o[6], o[7]);
                *(u32x4*)(act + row * ld + col) = w; }
    }
};
struct EpiBf16 {
    static constexpr bool PERM = true;
    bf16_t* O; int ld;
    __device__ __forceinline__ void operator()(const f32x4 (&acc)[2][2][4][2], const Unit& u, int wr, int wc, int fr, int fq) const {
#pragma unroll
        for (int ai = 0; ai < 2; ++ai)
#pragma unroll
            for (int m = 0; m < 4; ++m) { const size_t row = (size_t)(u.x0 + ai * 128 + wr * 64 + m * 16 + fr);
#pragma unroll
                for (int bj = 0; bj < 2; ++bj) { const int col = u.pn * 256 + bj * 128 + wc * 32 + 8 * fq; const f32x4 v0 = acc[ai][bj][m][0], v1 = acc[ai][bj][m][1];
                    u32x4 w; w.x = cvt_pk_bf16(v0[0], v0[1]); w.y = cvt_pk_bf16(v0[2], v0[3]); w.z = cvt_pk_bf16(v1[0], v1[1]); w.w = cvt_pk_bf16(v1[2], v1[3]);
                    *(u32x4*)(O + row * ld + col) = w; } }
    }
};

struct RowSched { int nM, nN, G, c; unsigned abytes, bbytes;
    __device__ __forceinline__ bool next(int i, Unit& u) const { const int L = i * G + c; if (L >= nM * nN) return false; pg8::swz_map(L, nM, nN, u.pm, u.pn); u.aoff = (unsigned)u.pm * abytes; u.boff = (unsigned)u.pn * bbytes; u.kind = 0; u.x0 = u.pm * 256; u.x1 = 0; return true; } };

struct MoeSched { int G, c, nN; unsigned bexp, bbytes, arow_bytes; bool a_slots; int cnt[NE], base[NE];
    __device__ __forceinline__ void init(const unsigned* cw) { int b = 0;
#pragma unroll
        for (int e = 0; e < NE; ++e) { cnt[e] = (int)cw[64 * e]; base[e] = b; b += (cnt[e] + 255) & ~255; } }
    __device__ __forceinline__ bool next(int i, Unit& u) const { int L = i * G + c; int e = 0;
        for (; e < NE; ++e) { const int nu = ((cnt[e] + 255) >> 8) * nN; if (L < nu) break; L -= nu; }
        if (e >= NE) return false;
        int cn = 0, bs = 0;
#pragma unroll
        for (int q = 0; q < NE; ++q) if (q == e) { cn = cnt[q]; bs = base[q]; }
        pg8::swz_map(L, (cn + 255) >> 8, nN, u.pm, u.pn);
        u.kind = e; u.x1 = cn; u.x0 = bs + u.pm * 256;
        u.aoff = a_slots ? (unsigned)u.x0 * arow_bytes : 0u; u.boff = (unsigned)e * bexp + (unsigned)u.pn * bbytes; return true; } };
struct MoeRows { static constexpr bool GA = true, GB = false; const int* list;
    __device__ __forceinline__ unsigned arow(const Unit& u, int r) const { int idx = u.pm * 256 + r; idx = idx < u.x1 ? idx : u.x1 - 1; return (unsigned)list[u.kind * NL + idx] * (D * 2u); }
    __device__ __forceinline__ unsigned brow(const Unit&, int) const { return 0u; } };

__device__ __forceinline__ int crow(int r, int hi) { return (r & 3) + 8 * (r >> 2) + 4 * hi; }
__device__ __forceinline__ s16x4 vtr(const LAS unsigned char* p) { typedef short v4i16_t __attribute__((ext_vector_type(4))); return __builtin_bit_cast(s16x4, __builtin_amdgcn_ds_read_tr16_b64_v4i16((LAS v4i16_t*)p)); }

__device__ __forceinline__ void attn_unit(Frame& F, int l, int b, int hkv, int qb, bool ctxq) {
    const int tid = F.tid, lane = F.lane, wid = F.wave, r32 = lane & 31, hi = lane >> 5;
    const int g = wid >> 1, qs = wid & 1, head = hkv * 4 + g;
    const bf16_t* Q = (const bf16_t*)(F.ws + WS_Q); const bf16_t* KB = (const bf16_t*)(F.ws + WS_KB); const bf16_t* VB = (const bf16_t*)(F.ws + WS_VB);
    const int q0 = qb * 64;
    const int qrow = (ctxq ? NL + b * CTXL : b * T) + q0 + qs * 32 + r32;
    bf16x8 qr[4];
#pragma unroll
    for (int d0 = 0; d0 < 4; ++d0) qr[d0] = *(const bf16x8*)(Q + (size_t)qrow * 512 + head * 64 + d0 * 16 + hi * 8);
    int jlo = 0, jhi = -1;
    if (!ctxq) { jlo = -2; jhi = 2; if (q0 + 64 * jlo < 0) jlo = -(q0 / 64); if (q0 + 64 * jhi >= T) jhi = (T - 64 - q0) / 64; }
    const int nloc = jhi - jlo + 1, ntile = nloc + 4;
    const float sinkv = F.in[9][l * 8 + head] * LOG2E;
    float mrun = sinkv, lrun = 1.0f;
    f32x16 o[2]; o[0] = f32x16{}; o[1] = f32x16{};
    const int kkey = lane, vkey = 16 * (wid & 3) + (lane >> 2);
    auto tile_row = [&](int ti) -> int { return ti < nloc ? b * T + q0 + 64 * (jlo + ti) : NL + b * CTXL + 64 * (ti - nloc); };
    u32x4 kreg, vreg;
    { const int r0 = tile_row(0); kreg = *(const u32x4*)(KB + (size_t)(r0 + kkey) * 128 + hkv * 64 + wid * 8); vreg = *(const u32x4*)(VB + (size_t)(r0 + vkey) * 128 + hkv * 64 + (wid >> 2) * 32 + (lane & 3) * 8); }
    for (int ti = 0; ti < ntile; ++ti) {
        LAS unsigned char* slot = F.lds + (ti & 1) * 16384;
        *(LAS u32x4*)(slot + wid * 1024 + lane * 16) = kreg;
        *(LAS u32x4*)(slot + 8192 + wid * 1024 + lane * 16) = vreg;
        __syncthreads();
        if (ti + 1 < ntile) { const int r0 = tile_row(ti + 1); kreg = *(const u32x4*)(KB + (size_t)(r0 + kkey) * 128 + hkv * 64 + wid * 8); vreg = *(const u32x4*)(VB + (size_t)(r0 + vkey) * 128 + hkv * 64 + (wid >> 2) * 32 + (lane & 3) * 8); }
        f32x16 p0 = f32x16{}, p1 = f32x16{};
        { const LAS unsigned char* kb = slot + hi * 1024 + r32 * 16;
#pragma unroll
          for (int d0 = 0; d0 < 4; ++d0) { const bf16x8 k0 = *(const LAS bf16x8*)(kb + d0 * 2048), k1 = *(const LAS bf16x8*)(kb + d0 * 2048 + 512);
              p0 = __builtin_amdgcn_mfma_f32_32x32x16_bf16(k0, qr[d0], p0, 0, 0, 0); p1 = __builtin_amdgcn_mfma_f32_32x32x16_bf16(k1, qr[d0], p1, 0, 0, 0); } }
        if (ti < nloc) { const int j = jlo + ti; const int qq = qs * 32 + r32;
            if (j == -2) {
#pragma unroll
                for (int r = 0; r < 16; ++r) { const int kk = crow(r, hi); if (kk < qq) p0[r] = -INFINITY; if (kk + 32 < qq) p1[r] = -INFINITY; } }
            else if (j == 2) {
#pragma unroll
                for (int r = 0; r < 16; ++r) { const int kk = crow(r, hi); if (kk > qq) p0[r] = -INFINITY; if (kk + 32 > qq) p1[r] = -INFINITY; } } }
        float mx = p0[0];
#pragma unroll
        for (int r = 1; r < 16; ++r) mx = fmaxf(mx, p0[r]);
#pragma unroll
        for (int r = 0; r < 16; ++r) mx = fmaxf(mx, p1[r]);
        mx = fmaxf(mx, __shfl_xor(mx, 32));
        const float mnew = fmaxf(mrun, mx), fsc = __builtin_amdgcn_exp2f(mrun - mnew);
        mrun = mnew;
        float rs = 0.f;
#pragma unroll
        for (int r = 0; r < 16; ++r) { p0[r] = __builtin_amdgcn_exp2f(p0[r] - mnew); p1[r] = __builtin_amdgcn_exp2f(p1[r] - mnew); rs += p0[r] + p1[r]; }
        rs += __shfl_xor(rs, 32);
        lrun = lrun * fsc + rs;
#pragma unroll
        for (int r = 0; r < 16; ++r) { o[0][r] *= fsc; o[1][r] *= fsc; }
        u32x4 pw[4];
        pw[0] = (u32x4){cvt_pk_bf16(p0[0], p0[1]), cvt_pk_bf16(p0[2], p0[3]), cvt_pk_bf16(p0[4], p0[5]), cvt_pk_bf16(p0[6], p0[7])};
        pw[1] = (u32x4){cvt_pk_bf16(p0[8], p0[9]), cvt_pk_bf16(p0[10], p0[11]), cvt_pk_bf16(p0[12], p0[13]), cvt_pk_bf16(p0[14], p0[15])};
        pw[2] = (u32x4){cvt_pk_bf16(p1[0], p1[1]), cvt_pk_bf16(p1[2], p1[3]), cvt_pk_bf16(p1[4], p1[5]), cvt_pk_bf16(p1[6], p1[7])};
        pw[3] = (u32x4){cvt_pk_bf16(p1[8], p1[9]), cvt_pk_bf16(p1[10], p1[11]), cvt_pk_bf16(p1[12], p1[13]), cvt_pk_bf16(p1[14], p1[15])};
        { const LAS unsigned char* vb = slot + 8192 + ((lane >> 4) & 1) * 32 + (lane & 3) * 8 + (4 * hi + ((lane & 15) >> 2)) * 64;
#pragma unroll
          for (int d0 = 0; d0 < 2; ++d0)
#pragma unroll
              for (int ks = 0; ks < 4; ++ks) { const s16x4 lo = vtr(vb + d0 * 4096 + ks * 1024), hh = vtr(vb + d0 * 4096 + ks * 1024 + 512);
                  const bf16x8 vf = (bf16x8){lo[0], lo[1], lo[2], lo[3], hh[0], hh[1], hh[2], hh[3]};
                  o[d0] = __builtin_amdgcn_mfma_f32_32x32x16_bf16(vf, __builtin_bit_cast(bf16x8, pw[ks]), o[d0], 0, 0, 0); } }
    }
    const float rl = 1.0f / lrun;
    bf16_t* orow = (bf16_t*)(F.ws + WS_FO) + (size_t)qrow * KM + 640 + head * 64;
#pragma unroll
    for (int d0 = 0; d0 < 2; ++d0)
#pragma unroll
        for (int rq = 0; rq < 4; ++rq) { u32x2 w; w.x = cvt_pk_bf16(o[d0][4 * rq] * rl, o[d0][4 * rq + 1] * rl); w.y = cvt_pk_bf16(o[d0][4 * rq + 2] * rl, o[d0][4 * rq + 3] * rl);
            *(u32x2*)(orow + 32 * d0 + 8 * rq + 4 * hi) = w; }
    __syncthreads();
}

__device__ __forceinline__ void attn_phase(Frame& F, int l) {
    const int nlat = NB * 2 * 128, nall = nlat + (l == 0 ? NB * 2 * 4 : 0);
    for (int it = F.bx; it < nall; it += F.G) {
        if (it < nlat) { const int qb = it & 127, hkv = (it >> 7) & 1, b = it >> 8; attn_unit(F, l, b, hkv, qb, false); }
        else { const int r = it - nlat; const int qb = r & 3, hkv = (r >> 2) & 1, b = r >> 3; attn_unit(F, l, b, hkv, qb, true); }
    }
}

#if !MK_MULTI
#define GRID_BAR() xcd_barrier(bar)
#else
#define GRID_BAR() do {} while (0)
#endif
#ifndef PH_MASK
#define PH_MASK 0xFFFFFu
#endif
#define IN(k) (((PH_MASK >> (k)) & 1u) && lo <= (k) && (k) < hi)
#define SEAM(k) do { if (IN((k) + 1)) GRID_BAR(); } while (0)
template <int l, class BarT>
__device__ __forceinline__ void layer_phases(Frame& F, unsigned* ctl, const int lo, const int hi, const BarT& bar) {
        const int pb = 1 + 9 * l;
        bf16_t* H = (bf16_t*)(F.ws + WS_H);
        const float* xl_in = l == 0 ? F.in[0] : F.out;
        const float* xc_in = l == 0 ? F.in[2] : (const float*)(F.ws + WS_XC);
        float* xc = (float*)(F.ws + WS_XC);
        const float* mod_l = (const float*)ctl + CW_MOD + l * 3 * MODSZ;
        if (IN(pb + 0)) { norm_phase<false>(F, l, 0, xl_in, xc_in, NTOK); SEAM(pb + 0); }
        if (IN(pb + 1)) {
            { pg8::Gemm g{H, (const bf16_t*)(F.ws + (l ? WS_WIN1 : WS_WIN0)) + (size_t)512 * D, D}; InprojSched S{F.G, F.bx, l}; EpiInproj E{F.ws}; pg8::NoGather R;
              pg8::gemm_phase(F.lds, g, S, E, R); }
            { pg8::Gemm g{(const bf16_t*)(F.ws + (l ? WS_WIN1 : WS_WIN0)), H, D}; UpermSched S{F.G, F.bx, l}; EpiUperm E{F.ws}; UpermRows R;
              pg8::gemm_phase(F.lds, g, S, E, R); }
            SEAM(pb + 1);
        }
        if (IN(pb + 2)) {
            attn_phase(F, l);
            { pg8::Gemm g{(const bf16_t*)(F.ws + WS_UP), (const bf16_t*)(F.ws + WS_FA64), 128}; GridSched S{256, 1, F.G, F.bx, 256u * 128u * 2u, 0u}; EpiStepA E{F.ws}; pg8::NoGather R;
              pg8::gemm_phase(F.lds, g, S, E, R); }
            SEAM(pb + 2);
        }
        if (IN(pb + 3)) {
            { pg8::Gemm g{(const bf16_t*)(F.ws + WS_GP), (const bf16_t*)(F.ws + WS_TC), 256}; GridSched S{128, 1, F.G, F.bx, 256u * 256u * 2u, 0u}; EpiStepC<false> E{F.ws}; pg8::NoGather R;
              pg8::gemm_phase(F.lds, g, S, E, R); }
            if (l == 0) { pg8::Gemm g{(const bf16_t*)(F.ws + WS_VCT), (const bf16_t*)(F.ws + WS_TX), 512}; GridSched S{2, 2, F.G, (F.bx + 128) % F.G, 256u * 512u * 2u, 256u * 512u * 2u}; EpiStepC<true> E{F.ws}; pg8::NoGather R;
              pg8::gemm_phase(F.lds, g, S, E, R); }
            SEAM(pb + 3);
        }
        if (IN(pb + 4)) {
            const int nM = l == 0 ? 66 : 64;
            pg8::Gemm g{(const bf16_t*)(F.ws + WS_FO), (const bf16_t*)(F.ws + (l ? WS_WM1 : WS_WM0)), KM}; GridSched S{nM, 8, F.G, F.bx, 256u * KM * 2u, 256u * KM * 2u}; EpiMerge E{F.ws}; pg8::NoGather R;
            pg8::gemm_phase(F.lds, g, S, E, R);
            SEAM(pb + 4);
        }
        if (IN(pb + 5)) {
            const int nM = l == 0 ? 66 : 64;
            pg8::Gemm g{(const bf16_t*)(F.ws + WS_Y), (const bf16_t*)(F.ws + (l ? WS_WO1 : WS_WO0)), D}; GridSched S{nM, 4, F.G, F.bx, 256u * D * 2u, 256u * D * 2u};
            EpiResid E{xl_in, F.out, xc_in, xc, mod_l, 2}; pg8::NoGather R;
            pg8::gemm_phase(F.lds, g, S, E, R);
            SEAM(pb + 5);
        }
        if (IN(pb + 6)) {
            if (l == 0) norm_phase<false>(F, l, 1, F.out, xc, NTOK); else norm_phase<true>(F, l, 1, F.out, xc, NL);
            SEAM(pb + 6);
        }
        if (l == 0) {
            if (IN(pb + 7)) {
                pg8::Gemm g{H, (const bf16_t*)(F.ws + WS_WGUD), D}; RowSched S{66, 22, F.G, F.bx, 256u * D * 2u, 256u * D * 2u}; EpiSwiglu E{(bf16_t*)(F.ws + WS_ACT), DFF0}; pg8::NoGather R;
                pg8::gemm_phase(F.lds, g, S, E, R);
                SEAM(pb + 7);
            }
            if (IN(pb + 8)) {
                pg8::Gemm g{(const bf16_t*)(F.ws + WS_ACT), (const bf16_t*)(F.ws + WS_WDD), DFF0}; GridSched S{66, 4, F.G, F.bx, 256u * DFF0 * 2u, 256u * DFF0 * 2u};
                EpiResid E{F.out, F.out, xc, xc, mod_l, 5}; pg8::NoGather R;
                pg8::gemm_phase(F.lds, g, S, E, R);
                SEAM(pb + 8);
            }
        } else {
            if (IN(pb + 7)) {
                pg8::Gemm g{H, (const bf16_t*)(F.ws + WS_WGUE), D}; MoeSched S; S.G = F.G; S.c = F.bx; S.nN = 28; S.bexp = 2u * DFFE * D * 2u; S.bbytes = 256u * D * 2u; S.arow_bytes = 0; S.a_slots = false; S.init(ctl + CW_CNT);
                EpiSwiglu E{(bf16_t*)(F.ws + WS_ACT), DFFE}; MoeRows R{(const int*)(F.ws + WS_LIST)};
                pg8::gemm_phase(F.lds, g, S, E, R);
                SEAM(pb + 7);
            }
            if (IN(pb + 8)) {
                pg8::Gemm g{(const bf16_t*)(F.ws + WS_ACT), (const bf16_t*)(F.ws + WS_WDE), DFFE}; MoeSched S; S.G = F.G; S.c = F.bx; S.nN = 4; S.bexp = (unsigned)D * DFFE * 2u; S.bbytes = 256u * DFFE * 2u; S.arow_bytes = DFFE * 2u; S.a_slots = true; S.init(ctl + CW_CNT);
                EpiBf16 E{(bf16_t*)(F.ws + WS_DOUT), D}; pg8::NoGather R;
                pg8::gemm_phase(F.lds, g, S, E, R);
                SEAM(pb + 8);
            }
        }
    }

constexpr int NPHASE = 20;
__global__ void __launch_bounds__(NTHR, 2) fwd_kernel(Args args) {
    extern __shared__ __attribute__((aligned(16))) unsigned char lds_raw[];
    Frame F;
    F.lds = (LAS unsigned char*)lds_raw; F.ws = args.ws; F.in = args.in; F.out = args.out;
    F.tid = threadIdx.x; F.lane = F.tid & 63; F.wave = __builtin_amdgcn_readfirstlane(F.tid >> 6); F.G = gridDim.x; F.bx = blockIdx.x;
    volatile LAS unsigned* MISC = (volatile LAS unsigned*)(F.lds + MISC_OFF);
    if (F.tid < 32) MISC[F.tid] = 0u;
    __syncthreads();
    unsigned* ctl = (unsigned*)(F.ws + WS_CTL);
#if !MK_MULTI
    XcdBarrier bar = xcd_barrier_post(ctl + CW_BAR, MISC + 8);
#else
    XcdBarrier bar; bar.bar = ctl + CW_BAR; bar.x = 0; bar.st = MISC + 8;
#endif
    const int lo = args.ph_lo, hi = args.ph_hi;
    if (IN(0)) { p0_prologue(F); SEAM(0); }
    layer_phases<0>(F, ctl, lo, hi, bar);
    layer_phases<1>(F, ctl, lo, hi, bar);
    if (IN(19)) final_phase(F);
}

extern "C" void kernel_launch(void* const* d_in, const int* in_sizes, int n_in, void* d_out, int out_size, void* d_ws, size_t ws_size, hipStream_t stream) {
    static int grid = 0;
    if (grid == 0) {
        if (n_in != 21 || out_size != NL * D || ws_size < WS_END) { fprintf(stderr, "kernel_launch: unexpected problem (n_in %d out %d ws %zu)\n", n_in, out_size, ws_size); grid = -1; return; }
        int dev = 0, cus = 0;
        hipGetDevice(&dev); hipDeviceGetAttribute(&cus, hipDeviceAttributeMultiprocessorCount, dev);
        if (hipFuncSetAttribute((const void*)fwd_kernel, hipFuncAttributeMaxDynamicSharedMemorySize, LDS_BYTES) != hipSuccess) { fprintf(stderr, "kernel_launch: hipFuncSetAttribute failed\n"); grid = -1; return; }
        int per_cu = 0; (void)hipOccupancyMaxActiveBlocksPerMultiprocessor(&per_cu, (const void*)fwd_kernel, NTHR, LDS_BYTES); (void)hipGetLastError();
        grid = cus;
    }
    if (grid < 0) return;
    hipMemsetAsync((char*)d_ws + WS_CTL, 0, CTL_BYTES, stream);
#ifdef DBG_SCRUB
    hipMemsetAsync((char*)d_ws + CTL_BYTES, 0, WS_END - CTL_BYTES, stream);
#endif
    Args a{};
    for (int i = 0; i < 21; ++i) a.in[i] = (const float*)d_in[i];
    a.out = (float*)d_out; a.ws = (unsigned char*)d_ws;
#if MK_MULTI
    for (int p = 0; p < NPHASE; ++p) { a.ph_lo = p; a.ph_hi = p + 1; hipLaunchKernelGGL(fwd_kernel, dim3(grid), dim3(NTHR), LDS_BYTES, stream, a); }
#else
    a.ph_lo = 0; a.ph_hi = NPHASE;
    hipLaunchKernelGGL(fwd_kernel, dim3(grid), dim3(NTHR), LDS_BYTES, stream, a);
#endif
}
```

```cpp
#include <hip/hip_runtime.h>
#include <cstdio>
#include <cstdint>

#define LAS __attribute__((address_space(3)))
#define GAS __attribute__((address_space(1)))
typedef unsigned short bf16_t;
typedef short bf16x8 __attribute__((ext_vector_type(8)));
typedef short s16x4 __attribute__((ext_vector_type(4)));
typedef float f32x4 __attribute__((ext_vector_type(4)));
typedef float f32x2 __attribute__((ext_vector_type(2)));
typedef float f32x16 __attribute__((ext_vector_type(16)));
typedef unsigned u32x4 __attribute__((ext_vector_type(4)));
typedef unsigned u32x2 __attribute__((ext_vector_type(2)));

#ifndef MK_MULTI
#define MK_MULTI 0
#endif

constexpr int D = 1024, T = 8192, NB = 2, NL = NB * T, CTXL = 256, NC = NB * CTXL, NTOK = NL + NC;
constexpr int INW = 3328, OFFQ = 512, OFFK = 1024, OFFV = 1152, OFFG = 1280;
constexpr int DFF0 = 2816, DFFE = 3584, NE = 8;
constexpr int KM = 1152;
constexpr int MOE_ROWS = 2 * NL + NE * 256;
constexpr float EPS = 1e-6f;
constexpr float LOG2E = 1.4426950408889634f;
constexpr float QSCALE = 0.125f * LOG2E;

constexpr size_t MiB = 1u << 20, KiB = 1u << 10;
constexpr size_t WS_CTL = 0, CTL_BYTES = 1 * MiB;
constexpr size_t WS_ROPE = 1 * MiB, WS_TW = WS_ROPE + 32 * KiB, WS_FA64 = WS_ROPE + 96 * KiB, WS_TC = WS_ROPE + 160 * KiB, WS_TX = WS_ROPE + 288 * KiB;
constexpr size_t WS_TOKE = 2 * MiB, WS_TOKR = WS_TOKE + 128 * KiB, WS_TOKW = WS_TOKE + 256 * KiB, WS_LIST = WS_TOKE + 384 * KiB;
constexpr size_t WS_XC = 3 * MiB, WS_VCT = 5 * MiB;
constexpr size_t WS_WIN0 = 6 * MiB, WS_WM0 = WS_WIN0 + 13 * MiB / 2, WS_WO0 = 17 * MiB, WS_WGUD = 19 * MiB, WS_WDD = 30 * MiB;
constexpr size_t WS_WIN1 = 36 * MiB, WS_WM1 = WS_WIN1 + 13 * MiB / 2, WS_WO1 = 47 * MiB;
constexpr size_t WS_H = 49 * MiB;
constexpr size_t WS_DOUT = 6 * MiB;
constexpr size_t WS_WGUE = 82 * MiB, WS_WDE = 194 * MiB;
constexpr size_t WS_DOUT1 = WS_WGUE;
constexpr size_t WS_R1 = 250 * MiB;
constexpr size_t WS_UP = WS_R1, WS_Q = 266 * MiB, WS_KB = 283 * MiB, WS_VB = 288 * MiB, WS_GF = 293 * MiB, WS_GA = 326 * MiB, WS_GP = 359 * MiB, WS_FO = 375 * MiB, WS_Y = 413 * MiB;
constexpr size_t WS_ACT = WS_R1;
constexpr size_t WS_TMPC1 = 446 * MiB, WS_TMPC2 = 448 * MiB;
constexpr size_t WS_XB = 490 * MiB;
constexpr size_t WS_END = 523 * MiB;
static_assert(WS_DOUT + (size_t)MOE_ROWS * D * 2 <= WS_WGUE, "DOUT overlay");
static_assert(WS_ACT + (size_t)MOE_ROWS * DFFE * 2 <= WS_END, "ACT");
static_assert(WS_FO + (size_t)NTOK * KM * 2 <= WS_Y, "FO");
constexpr int CW_BAR = 4096, CW_CNT = 8192, CW_MOD = 16384;
constexpr int MODSZ = 6 * D;

constexpr int RING_BYTES = 131072, MISC_OFF = RING_BYTES + 320, LDS_BYTES = 147456;
constexpr int NWAVES = 8, NTHR = 512;

__device__ __forceinline__ unsigned f2bf(float f) { unsigned u = __builtin_bit_cast(unsigned, f); return (u + 0x7fffu + ((u >> 16) & 1u)) >> 16; }
__device__ __forceinline__ unsigned pk2(float lo, float hi) { return f2bf(lo) | (f2bf(hi) << 16); }
__device__ __forceinline__ unsigned cvt_pk_bf16(float lo, float hi) { unsigned r; asm volatile("v_cvt_pk_bf16_f32 %0, %1, %2" : "=v"(r) : "v"(lo), "v"(hi)); return r; }
__device__ __forceinline__ float bf2f(unsigned short h) { return __builtin_bit_cast(float, (unsigned)h << 16); }
__device__ __forceinline__ float bflo(unsigned w) { return __builtin_bit_cast(float, w << 16); }
__device__ __forceinline__ float bfhi(unsigned w) { return __builtin_bit_cast(float, w & 0xffff0000u); }
__device__ __forceinline__ float wave_sum(float v) {
#pragma unroll
    for (int o = 1; o < 64; o <<= 1) v += __shfl_xor(v, o);
    return v;
}
__device__ __forceinline__ float sigmoidf_(float x) { return __builtin_amdgcn_rcpf(1.0f + __builtin_amdgcn_exp2f(-x * LOG2E)); }
#define LDS_WAIT() asm volatile("s_waitcnt lgkmcnt(0)" ::: "memory")
#define VM_WAIT() asm volatile("s_waitcnt vmcnt(0)" ::: "memory")

#define XB_TMO      128
#define XB_XCNT(j)  (256  + 64 * (j))
#define XB_XSUB(j)  (1280 + 64 * (j))
#define XB_XGEN(j)  (2304 + 64 * (j))
#define XB_TOP      3328
#define XB_TOPGEN   3392
#define XCD_BAR_WORDS 3456
#define XB_SPIN_CAP (1u << 18)
__device__ __forceinline__ unsigned xb_ld(unsigned* p)              { return __hip_atomic_load(p, __ATOMIC_RELAXED, __HIP_MEMORY_SCOPE_AGENT); }
__device__ __forceinline__ unsigned xb_add(unsigned* p, unsigned v) { return __hip_atomic_fetch_add(p, v, __ATOMIC_RELAXED, __HIP_MEMORY_SCOPE_AGENT); }
__device__ __forceinline__ unsigned xb_xcc_id() { return (unsigned)__builtin_amdgcn_s_getreg((3 << 11) | 20) & 0xFu; }
#define XB_SPIN(cond, bar) do { unsigned _sp = 0; while (cond) { __builtin_amdgcn_s_sleep(1); \
    if ((++_sp & 255u) == 0u) { if (xb_ld(&(bar)[XB_TMO])) break; if (_sp > XB_SPIN_CAP) { atomicAdd(&(bar)[XB_TMO], 1u); break; } } } } while (0)
struct XcdBarrier { unsigned* bar; unsigned x; volatile LAS unsigned* st; };
__device__ __forceinline__ XcdBarrier xcd_barrier_post(unsigned* bar, volatile LAS unsigned* st) {
    XcdBarrier b; b.bar = bar; b.x = xb_xcc_id(); b.st = st;
    if (threadIdx.x == 0) (void)xb_add(&bar[XB_XCNT(b.x)], 1u);
    return b;
}
__device__ __forceinline__ void xcd_barrier_complete(unsigned* bar, unsigned x, unsigned& nloc, unsigned& nx) {
    const unsigned G = gridDim.x * gridDim.y * gridDim.z;
    unsigned sum, cnt, mine, sp = 0u;
    for (;;) {
        sum = 0u; cnt = 0u; mine = 0u;
#pragma unroll
        for (unsigned j = 0; j < 16; ++j) { const unsigned c = xb_ld(&bar[XB_XCNT(j)]); sum += c; cnt += (c > 0u) ? 1u : 0u; mine = (j == x) ? c : mine; }
        if (sum == G) break;
        __builtin_amdgcn_s_sleep(1);
        if ((++sp & 255u) == 0u) { if (xb_ld(&bar[XB_TMO])) break; if (sp > XB_SPIN_CAP) { atomicAdd(&bar[XB_TMO], 1u); break; } }
    }
    nloc = mine > 0u ? mine : 1u; nx = cnt > 0u ? cnt : 1u;
}
__device__ __forceinline__ void xcd_barrier(const XcdBarrier& b) {
    asm volatile("s_waitcnt vmcnt(0)" ::: "memory");
    __syncthreads();
    if (threadIdx.x == 0) {
        unsigned* bar = b.bar;
        __builtin_amdgcn_s_waitcnt(0);
        unsigned nloc = b.st[0], nx = b.st[1];
        if (nloc == 0u) { xcd_barrier_complete(bar, b.x, nloc, nx); b.st[0] = nloc; b.st[1] = nx; }
        const unsigned old = xb_add(&bar[XB_XSUB(b.x)], 1u);
        const unsigned gen = old / nloc;
        if (old + 1u == (gen + 1u) * nloc) {
            __builtin_amdgcn_fence(__ATOMIC_RELEASE, "agent");
            asm volatile("s_waitcnt vmcnt(0)" ::: "memory");
            const unsigned og = xb_add(&bar[XB_TOP], 1u);
            const unsigned tg = og / nx;
            if (og + 1u == (tg + 1u) * nx) xb_add(&bar[XB_TOPGEN], 1u);
            else XB_SPIN(xb_ld(&bar[XB_TOPGEN]) == tg, bar);
            __builtin_amdgcn_fence(__ATOMIC_ACQUIRE, "agent");
            xb_add(&bar[XB_XGEN(b.x)], 1u);
            asm volatile("s_waitcnt vmcnt(0)" ::: "memory");
        } else {
            XB_SPIN(xb_ld(&bar[XB_XGEN(b.x)]) == gen, bar);
            __builtin_amdgcn_fence(__ATOMIC_ACQUIRE, "agent");
            asm volatile("s_waitcnt vmcnt(0)" ::: "memory");
        }
    }
    __syncthreads();
}

namespace pg8 {
constexpr int BM = 256, BK = 64, HALF = 128, HTB = HALF * BK * 2, STAGE_BYTES = 8 * HTB, NXCD = 8, WGM = 8;
__host__ __device__ __forceinline__ int lds_byte(int r, int c) { const int st = (r >> 4) * 2 + (c >> 5), rr = r & 15, cc = c & 31, ob = rr * 64 + cc * 2; return st * 1024 + (ob ^ (((ob >> 9) & 1) << 5)); }
__host__ __device__ __forceinline__ void stage_rc(int b, int& R, int& C) { const int st = b / 1024, sb = b % 1024, swz = sb ^ (((sb >> 9) & 1) << 5); R = (st >> 1) * 16 + swz / 64; C = (st & 1) * 32 + (swz % 64) / 2; }
__host__ __device__ __forceinline__ int perm32(int rho) { const int n = rho >> 4, i = rho & 15; return 8 * (i >> 2) + 4 * n + (i & 3); }

struct Unit { unsigned aoff, boff; int pm, pn, kind, x0, x1, kh; };
struct Gemm { const bf16_t* A; const bf16_t* Bt; int K; int ld; };

__device__ __forceinline__ void swz_map(int L, int nM, int nN, int& pm, int& pn) {
    const int nwg = nM * nN; int wgid = L;
    { const int q = nwg / NXCD, r = nwg % NXCD, xcd = wgid % NXCD, off = wgid / NXCD; wgid = (xcd < r ? xcd * (q + 1) : r * (q + 1) + (xcd - r) * q) + off; }
    const int nig = WGM * nN, gid = wgid / nig, fm = gid * WGM, gsz = (nM - fm) < WGM ? (nM - fm) : WGM;
    pm = fm + ((wgid % nig) % gsz); pn = (wgid % nig) / gsz;
}

struct NoGather { static constexpr bool GA = false, GB = false;
    __device__ __forceinline__ unsigned arow(const Unit&, int) const { return 0u; }
    __device__ __forceinline__ unsigned brow(const Unit&, int) const { return 0u; } };

template <class Epi, class Sched, class Rows>
__device__ __forceinline__ void gemm_phase(LAS unsigned char* lds, const Gemm g, const Sched& S, const Epi& E, const Rows& RW) {
    int tid_ = threadIdx.x; asm volatile("" : "+v"(tid_));
    const int tid = tid_, wid = __builtin_amdgcn_readfirstlane(tid >> 6), lane = tid & 63, wr = wid >> 2, wc = wid & 3, fr = lane & 15, fq = lane >> 4;
    int K_ = g.K; asm volatile("" : "+s"(K_));
    const int K = K_, nt = K / BK;
    int sR[2], sRb[2], sC[2];
#pragma unroll
    for (int i = 0; i < 2; ++i) { int R, C; stage_rc(tid * 16 + i * 8192, R, C); sR[i] = R; sC[i] = C; sRb[i] = (R & ~31) + perm32(R & 31); }
    unsigned voffA[2], voffB[2];
    const int LD = g.ld;
#pragma unroll
    for (int i = 0; i < 2; ++i) { voffA[i] = (unsigned)(sR[i] * LD + sC[i]) * 2u; voffB[i] = (unsigned)(sRb[i] * LD + sC[i]) * 2u; }
    const size_t kstep = (size_t)(BK * 2);
    const size_t hstep = (size_t)HALF * LD * 2;
    const unsigned ldsw = (unsigned)wid * 1024u;
    const int aoff = lds_byte(wr * 64 + fr, fq * 8), boff = lds_byte(wc * 32 + fr, fq * 8);
    struct Side { const char* base[2]; unsigned off[2][2]; };
#define PG8_SA(b, h) (((b) * 2 + (h)) * HTB)
#define PG8_SB(b, h) ((4 + (b) * 2 + (h)) * HTB)
#define PG8_STAGE(bufoff, side, h, kt) do { _Pragma("unroll") for (int _i = 0; _i < 2; ++_i) \
        __builtin_amdgcn_global_load_lds((const unsigned*)((side).base[h] + (size_t)(kt) * kstep + (side).off[h][_i]), (LAS unsigned*)(lds + (bufoff) + ldsw + _i * 8192), 16, 0, 0); } while (0)
#define PG8_LDA(dst, b, h) do { _Pragma("unroll") for (int m = 0; m < 4; ++m) _Pragma("unroll") for (int k = 0; k < 2; ++k) dst[m][k] = *(const LAS bf16x8*)(lds + PG8_SA(b, h) + aoff + m * 2048 + k * 1024); } while (0)
#define PG8_LDB(dst, b, h) do { _Pragma("unroll") for (int n = 0; n < 2; ++n) _Pragma("unroll") for (int k = 0; k < 2; ++k) dst[n][k] = *(const LAS bf16x8*)(lds + PG8_SB(b, h) + boff + n * 2048 + k * 1024); } while (0)
#define PG8_MMA(ai, bj, At, Bt) do { __builtin_amdgcn_s_setprio(1); _Pragma("unroll") for (int m = 0; m < 4; ++m) _Pragma("unroll") for (int n = 0; n < 2; ++n) _Pragma("unroll") for (int k = 0; k < 2; ++k) \
        acc[ai][bj][m][n] = __builtin_amdgcn_mfma_f32_16x16x32_bf16(Bt[n][k], At[m][k], acc[ai][bj][m][n], 0, 0, 0); __builtin_amdgcn_s_setprio(0); } while (0)
#define PG8_WAIT_V(n) asm volatile("s_waitcnt vmcnt(" #n ")" ::: "memory")
#define PG8_WAIT_L(n) asm volatile("s_waitcnt lgkmcnt(" #n ")" ::: "memory")
#define PG8_BAR __builtin_amdgcn_s_barrier()
#define PG8_SCHED __builtin_amdgcn_sched_barrier(0)
#define PG8_MKSIDES(u, sa, sb) do { \
        if constexpr (Rows::GA) { sa.base[0] = sa.base[1] = (const char*)g.A; _Pragma("unroll") for (int h = 0; h < 2; ++h) _Pragma("unroll") for (int i = 0; i < 2; ++i) sa.off[h][i] = RW.arow(u, h * HALF + sR[i]) + (unsigned)sC[i] * 2u; } \
        else { sa.base[0] = (const char*)g.A + (u).aoff; sa.base[1] = sa.base[0] + hstep; _Pragma("unroll") for (int h = 0; h < 2; ++h) _Pragma("unroll") for (int i = 0; i < 2; ++i) sa.off[h][i] = voffA[i]; } \
        if constexpr (Rows::GB) { sb.base[0] = sb.base[1] = (const char*)g.Bt; _Pragma("unroll") for (int h = 0; h < 2; ++h) _Pragma("unroll") for (int i = 0; i < 2; ++i) sb.off[h][i] = RW.brow(u, h * HALF + sRb[i]) + (unsigned)sC[i] * 2u; } \
        else { sb.base[0] = (const char*)g.Bt + (u).boff; sb.base[1] = sb.base[0] + hstep; _Pragma("unroll") for (int h = 0; h < 2; ++h) _Pragma("unroll") for (int i = 0; i < 2; ++i) sb.off[h][i] = voffB[i]; } } while (0)
    Unit cur, nxt; int ui = 0;
    if (!S.next(0, cur)) return;
    f32x4 acc[2][2][4][2];
#pragma unroll
    for (int a = 0; a < 2; ++a)
#pragma unroll
        for (int b = 0; b < 2; ++b)
#pragma unroll
            for (int m = 0; m < 4; ++m)
#pragma unroll
                for (int n = 0; n < 2; ++n) acc[a][b][m][n] = (f32x4){0.f, 0.f, 0.f, 0.f};
    bf16x8 At[4][2], B0[2][2], B1[2][2];
    Side cA, cB, nA, nB;
    PG8_MKSIDES(cur, cA, cB);
    PG8_STAGE(PG8_SB(0, 0), cB, 0, 0); PG8_STAGE(PG8_SB(0, 1), cB, 1, 0); PG8_STAGE(PG8_SA(0, 0), cA, 0, 0); PG8_STAGE(PG8_SA(0, 1), cA, 1, 0);
    if (wr == 1) PG8_BAR;
    PG8_WAIT_V(2); PG8_BAR;
    PG8_STAGE(PG8_SB(1, 0), cB, 0, 1); PG8_STAGE(PG8_SA(1, 0), cA, 0, 1); PG8_STAGE(PG8_SB(1, 1), cB, 1, 1);
    PG8_WAIT_V(6); PG8_BAR;
    for (;;) {
        const bool has_next = S.next(ui + 1, nxt);
        if (has_next) { PG8_MKSIDES(nxt, nA, nB); } else { nA = cA; nB = cB; }
        for (int t = 0; t < nt; t += 2) {
            const bool last = (t == nt - 2);
            if constexpr (Epi::MIDK > 0) { if (t == Epi::MIDK) E.mid(acc, cur, wr, wc, fr, fq); }
            Side a2, b2;
            a2.base[0] = last ? nA.base[0] : cA.base[0]; a2.base[1] = last ? nA.base[1] : cA.base[1];
            b2.base[0] = last ? nB.base[0] : cB.base[0]; b2.base[1] = last ? nB.base[1] : cB.base[1];
#pragma unroll
            for (int h = 0; h < 2; ++h)
#pragma unroll
                for (int i = 0; i < 2; ++i) { a2.off[h][i] = (Rows::GA && last) ? nA.off[h][i] : cA.off[h][i]; b2.off[h][i] = (Rows::GB && last) ? nB.off[h][i] : cB.off[h][i]; }
            const int k2 = last ? 0 : t + 2, k3 = k2 + 1;
            PG8_LDB(B0, 0, 0); PG8_LDB(B1, 0, 1); PG8_SCHED; PG8_LDA(At, 0, 0); PG8_STAGE(PG8_SA(1, 1), cA, 1, t + 1);
            PG8_WAIT_V(8); PG8_WAIT_L(0); PG8_BAR; PG8_MMA(0, 0, At, B0); PG8_MMA(0, 1, At, B1); PG8_BAR; PG8_SCHED;
            PG8_LDA(At, 0, 1); PG8_STAGE(PG8_SB(0, 0), b2, 0, k2); PG8_STAGE(PG8_SB(0, 1), b2, 1, k2); PG8_STAGE(PG8_SA(0, 0), a2, 0, k2);
            PG8_WAIT_V(8); PG8_WAIT_L(0); PG8_BAR; PG8_MMA(1, 0, At, B0); PG8_MMA(1, 1, At, B1); PG8_BAR; PG8_SCHED;
            PG8_LDB(B0, 1, 0); PG8_LDB(B1, 1, 1); PG8_SCHED; PG8_LDA(At, 1, 0); PG8_STAGE(PG8_SA(0, 1), a2, 1, k2);
            PG8_WAIT_V(8); PG8_WAIT_L(0); PG8_BAR; PG8_MMA(0, 0, At, B0); PG8_MMA(0, 1, At, B1); PG8_BAR; PG8_SCHED;
            PG8_LDA(At, 1, 1); PG8_STAGE(PG8_SB(1, 0), b2, 0, k3); PG8_STAGE(PG8_SB(1, 1), b2, 1, k3); PG8_STAGE(PG8_SA(1, 0), a2, 0, k3);
            PG8_WAIT_V(8); PG8_WAIT_L(0); PG8_BAR; PG8_MMA(1, 0, At, B0); PG8_MMA(1, 1, At, B1); PG8_BAR; PG8_SCHED;
        }
        if (wr == 0) PG8_BAR;
        E(acc, cur, wr, wc, fr, fq);
        if (!has_next) break;
#pragma unroll
        for (int a = 0; a < 2; ++a)
#pragma unroll
            for (int b = 0; b < 2; ++b)
#pragma unroll
                for (int m = 0; m < 4; ++m)
#pragma unroll
                    for (int n = 0; n < 2; ++n) acc[a][b][m][n] = (f32x4){0.f, 0.f, 0.f, 0.f};
        cur = nxt; cA = nA; cB = nB; ++ui;
        if (wr == 1) PG8_BAR;
    }
    PG8_WAIT_V(0);
    PG8_BAR;
#undef PG8_SA
#undef PG8_SB
#undef PG8_STAGE
#undef PG8_LDA
#undef PG8_LDB
#undef PG8_MMA
#undef PG8_WAIT_V
#undef PG8_WAIT_L
#undef PG8_BAR
#undef PG8_SCHED
#undef PG8_MKSIDES
}

struct SUnit { unsigned aoff, boff; int K; int pm, pn, kind, x0, x1, grp, dep, sig; };
__device__ __forceinline__ void st16_wt(unsigned char* wsbase, unsigned off, u32x4 v) {
    const __amdgpu_buffer_rsrc_t rsrc = __builtin_amdgcn_make_buffer_rsrc((void*)wsbase, 0, 0x7fffffff, 0x00020000);
    __builtin_amdgcn_raw_buffer_store_b128(v, rsrc, off, 0, 16); }

template <class Epi, class Sched, class Rows>
__device__ __forceinline__ void gemm_stream(LAS unsigned char* lds, const char* base, const Sched& S, const Epi& E, const Rows& RW) {
    int tid_ = threadIdx.x; asm volatile("" : "+v"(tid_));
    const int tid = tid_, wid = __builtin_amdgcn_readfirstlane(tid >> 6), lane = tid & 63, wr = wid >> 2, wc = wid & 3, fr = lane & 15, fq = lane >> 4;
    int sR[2], sRb[2], sC[2];
#pragma unroll
    for (int i = 0; i < 2; ++i) { int R, C; stage_rc(tid * 16 + i * 8192, R, C); sR[i] = R; sC[i] = C; sRb[i] = (R & ~31) + perm32(R & 31); }
    const size_t kstep = (size_t)(BK * 2);
    const unsigned ldsw = (unsigned)wid * 1024u;
    const int aoff = lds_byte(wr * 64 + fr, fq * 8), boff = lds_byte(wc * 32 + fr, fq * 8);
    struct Side { const char* base[2]; unsigned off[2][2]; };
#define PG8_SA(b, h) (((b) * 2 + (h)) * HTB)
#define PG8_SB(b, h) ((4 + (b) * 2 + (h)) * HTB)
#define PG8_STAGE(bufoff, side, h, kt) do { _Pragma("unroll") for (int _i = 0; _i < 2; ++_i) \
        __builtin_amdgcn_global_load_lds((const unsigned*)((side).base[h] + (size_t)(kt) * kstep + (side).off[h][_i]), (LAS unsigned*)(lds + (bufoff) + ldsw + _i * 8192), 16, 0, 0); } while (0)
#define PG8_LDA(dst, b, h) do { _Pragma("unroll") for (int m = 0; m < 4; ++m) _Pragma("unroll") for (int k = 0; k < 2; ++k) dst[m][k] = *(const LAS bf16x8*)(lds + PG8_SA(b, h) + aoff + m * 2048 + k * 1024); } while (0)
#define PG8_LDB(dst, b, h) do { _Pragma("unroll") for (int n = 0; n < 2; ++n) _Pragma("unroll") for (int k = 0; k < 2; ++k) dst[n][k] = *(const LAS bf16x8*)(lds + PG8_SB(b, h) + boff + n * 2048 + k * 1024); } while (0)
#define PG8_MMA(ai, bj, At, Bt) do { __builtin_amdgcn_s_setprio(1); _Pragma("unroll") for (int m = 0; m < 4; ++m) _Pragma("unroll") for (int n = 0; n < 2; ++n) _Pragma("unroll") for (int k = 0; k < 2; ++k) \
        acc[ai][bj][m][n] = __builtin_amdgcn_mfma_f32_16x16x32_bf16(Bt[n][k], At[m][k], acc[ai][bj][m][n], 0, 0, 0); __builtin_amdgcn_s_setprio(0); } while (0)
#define PG8_WAIT_V(n) asm volatile("s_waitcnt vmcnt(" #n ")" ::: "memory")
#define PG8_WAIT_L(n) asm volatile("s_waitcnt lgkmcnt(" #n ")" ::: "memory")
#define PG8_BAR __builtin_amdgcn_s_barrier()
#define PG8_SCHED __builtin_amdgcn_sched_barrier(0)
#define PG8_MKSIDES(un, sa, sb) do { const int K_ = (un).K; \
        if (RW.a_gather(un)) { sa.base[0] = sa.base[1] = base; _Pragma("unroll") for (int h = 0; h < 2; ++h) _Pragma("unroll") for (int i = 0; i < 2; ++i) sa.off[h][i] = RW.arow(un, h * HALF + sR[i]) + (unsigned)sC[i] * 2u; } \
        else { sa.base[0] = base + (un).aoff; sa.base[1] = sa.base[0] + (size_t)HALF * K_ * 2; _Pragma("unroll") for (int h = 0; h < 2; ++h) _Pragma("unroll") for (int i = 0; i < 2; ++i) sa.off[h][i] = (unsigned)(sR[i] * K_ + sC[i]) * 2u; } \
        sb.base[0] = base + (un).boff; sb.base[1] = sb.base[0] + (size_t)HALF * K_ * 2; _Pragma("unroll") for (int h = 0; h < 2; ++h) _Pragma("unroll") for (int i = 0; i < 2; ++i) sb.off[h][i] = (unsigned)(sRb[i] * K_ + sC[i]) * 2u; } while (0)
#define PG8_SIGNAL(idx) do { if (lane == 0) __hip_atomic_fetch_add(S.rdy + 64 * (idx), 1u, __ATOMIC_RELAXED, __HIP_MEMORY_SCOPE_AGENT); } while (0)
    SUnit cur, nxt;
    unsigned pend = 0u;
    const unsigned lw_addr = (unsigned)(size_t)S.lw;
    if (tid == 0) { S.lw[0] = __hip_atomic_fetch_add(S.q, 1u, __ATOMIC_RELAXED, __HIP_MEMORY_SCOPE_AGENT); pend = __hip_atomic_fetch_add(S.q, 1u, __ATOMIC_RELAXED, __HIP_MEMORY_SCOPE_AGENT); }
    __syncthreads();
    { const int L0 = __builtin_amdgcn_readfirstlane((int)S.lw[0]); if (!S.decode(L0, cur)) return; }
    f32x4 acc[2][2][4][2];
#pragma unroll
    for (int a = 0; a < 2; ++a)
#pragma unroll
        for (int b = 0; b < 2; ++b)
#pragma unroll
            for (int m = 0; m < 4; ++m)
#pragma unroll
                for (int n = 0; n < 2; ++n) acc[a][b][m][n] = (f32x4){0.f, 0.f, 0.f, 0.f};
    bf16x8 At[4][2], B0[2][2], B1[2][2];
    Side cA, cB, nA, nB;
    bool need_pro = true; int sig_idx = -1;
    PG8_MKSIDES(cur, cA, cB);
    for (;;) {
        if (need_pro) {
            if (cur.dep >= 0) S.a_ready(cur);
            PG8_STAGE(PG8_SB(0, 0), cB, 0, 0); PG8_STAGE(PG8_SB(0, 1), cB, 1, 0); PG8_STAGE(PG8_SA(0, 0), cA, 0, 0); PG8_STAGE(PG8_SA(0, 1), cA, 1, 0);
            if (wr == 1) PG8_BAR;
            PG8_WAIT_V(2); PG8_BAR;
            PG8_STAGE(PG8_SB(1, 0), cB, 0, 1); PG8_STAGE(PG8_SA(1, 0), cA, 0, 1); PG8_STAGE(PG8_SB(1, 1), cB, 1, 1);
            PG8_WAIT_V(6); PG8_BAR;
        }
        if (tid == 0) { asm volatile("s_nop 7\n\tds_write_b32 %1, %0\n\tglobal_atomic_add %0, %2, %3, %4 sc0" : "+v"(pend) : "v"(lw_addr), "v"(0u), "v"(1u), "s"(S.q) : "memory"); }
        PG8_WAIT_L(0); PG8_BAR; asm volatile("" ::: "memory");
        const int Ln = __builtin_amdgcn_readfirstlane((int)S.lw[0]);
        const bool has_next = S.decode(Ln, nxt), pre = has_next && nxt.dep < 0;
        if (pre) { PG8_MKSIDES(nxt, nA, nB); } else { nA = cA; nB = cB; }
        const int nt = cur.K / BK;
        for (int t = 0; t < nt; t += 2) {
            const bool last = (t == nt - 2);
            Side a2, b2;
            a2.base[0] = last ? nA.base[0] : cA.base[0]; a2.base[1] = last ? nA.base[1] : cA.base[1];
            b2.base[0] = last ? nB.base[0] : cB.base[0]; b2.base[1] = last ? nB.base[1] : cB.base[1];
#pragma unroll
            for (int h = 0; h < 2; ++h)
#pragma unroll
                for (int i = 0; i < 2; ++i) { a2.off[h][i] = last ? nA.off[h][i] : cA.off[h][i]; b2.off[h][i] = last ? nB.off[h][i] : cB.off[h][i]; }
            const int k2 = last ? 0 : t + 2, k3 = k2 + 1;
            if (t == 2 && sig_idx >= 0) { PG8_SIGNAL(sig_idx); sig_idx = -1; }
            PG8_LDB(B0, 0, 0); PG8_LDB(B1, 0, 1); PG8_SCHED; PG8_LDA(At, 0, 0); PG8_STAGE(PG8_SA(1, 1), cA, 1, t + 1);
            PG8_WAIT_V(8); PG8_WAIT_L(0); PG8_BAR; PG8_MMA(0, 0, At, B0); PG8_MMA(0, 1, At, B1); PG8_BAR; PG8_SCHED;
            PG8_LDA(At, 0, 1); PG8_STAGE(PG8_SB(0, 0), b2, 0, k2); PG8_STAGE(PG8_SB(0, 1), b2, 1, k2); PG8_STAGE(PG8_SA(0, 0), a2, 0, k2);
            PG8_WAIT_V(8); PG8_WAIT_L(0); PG8_BAR; PG8_MMA(1, 0, At, B0); PG8_MMA(1, 1, At, B1); PG8_BAR; PG8_SCHED;
            PG8_LDB(B0, 1, 0); PG8_LDB(B1, 1, 1); PG8_SCHED; PG8_LDA(At, 1, 0); PG8_STAGE(PG8_SA(0, 1), a2, 1, k2);
            PG8_WAIT_V(8); PG8_WAIT_L(0); PG8_BAR; PG8_MMA(0, 0, At, B0); PG8_MMA(0, 1, At, B1); PG8_BAR; PG8_SCHED;
            PG8_LDA(At, 1, 1); PG8_STAGE(PG8_SB(1, 0), b2, 0, k3); PG8_STAGE(PG8_SB(1, 1), b2, 1, k3); PG8_STAGE(PG8_SA(1, 0), a2, 0, k3);
            PG8_WAIT_V(8); PG8_WAIT_L(0); PG8_BAR; PG8_MMA(1, 0, At, B0); PG8_MMA(1, 1, At, B1); PG8_BAR; PG8_SCHED;
        }
        if (wr == 0) PG8_BAR;
        E(acc, cur, wr, wc, fr, fq);
        if (!has_next) { PG8_WAIT_V(0); if (cur.sig >= 0) PG8_SIGNAL(cur.sig); break; }
#pragma unroll
        for (int a = 0; a < 2; ++a)
#pragma unroll
            for (int b = 0; b < 2; ++b)
#pragma unroll
                for (int m = 0; m < 4; ++m)
#pragma unroll
                    for (int n = 0; n < 2; ++n) acc[a][b][m][n] = (f32x4){0.f, 0.f, 0.f, 0.f};
        if (pre) {
            sig_idx = cur.sig; need_pro = false; cur = nxt; cA = nA; cB = nB;
            if (wr == 1) PG8_BAR;
        } else {
            PG8_WAIT_V(0); if (cur.sig >= 0) PG8_SIGNAL(cur.sig);
            PG8_BAR; need_pro = true; cur = nxt; PG8_MKSIDES(cur, cA, cB);
        }
    }
    PG8_BAR;
#undef PG8_SA
#undef PG8_SB
#undef PG8_STAGE
#undef PG8_LDA
#undef PG8_LDB
#undef PG8_MMA
#undef PG8_WAIT_V
#undef PG8_WAIT_L
#undef PG8_BAR
#undef PG8_SCHED
#undef PG8_MKSIDES
#undef PG8_SIGNAL
}
}
using pg8::Unit;
using pg8::SUnit;

struct Args { const float* in[21]; float* out; unsigned char* ws; int ph_lo, ph_hi; };

struct Frame {
    LAS unsigned char* lds;
    unsigned char* ws;
    const float* const* in;
    float* out;
    int tid, lane, wave, G, bx;
};
__device__ __forceinline__ float* modp(const Frame& F, int l, int v) { return (float*)(F.ws + WS_CTL) + CW_MOD + (l * 3 + v) * MODSZ; }

__device__ __forceinline__ void p0_transpose_item(const float* W, int ldw, int k0, int c0, bf16_t* WT, int ldt, int drow, int lane) {
    const float* src = W + (size_t)k0 * ldw + c0 + lane;
    float v[64];
#pragma unroll
    for (int i = 0; i < 64; ++i) v[i] = src[(size_t)i * ldw];
    bf16_t* dst = WT + (size_t)drow * ldt + k0;
#pragma unroll
    for (int j = 0; j < 8; ++j) { u32x4 o; o.x = pk2(v[8 * j], v[8 * j + 1]); o.y = pk2(v[8 * j + 2], v[8 * j + 3]); o.z = pk2(v[8 * j + 4], v[8 * j + 5]); o.w = pk2(v[8 * j + 6], v[8 * j + 7]);
        *(u32x4*)(dst + 8 * j) = o; }
}

constexpr int CW_CONVQ = 12288 + 128;
constexpr int MOE_I_GE = 16 * 56, MOE_I_DE = 56 * 16, MOE_ITEMS = NE * (2 * MOE_I_GE + MOE_I_DE), MOE_BATCHES = MOE_ITEMS / 8;
__device__ __forceinline__ void moe_convert_batch(Frame& F, int which, int idx) {
    const float* const* in = F.in; const int ln = F.lane;
    int r = idx * 8 + F.wave;
    if (which == 0) { const int e = r / (2 * MOE_I_GE); r %= (2 * MOE_I_GE); const int up = r / MOE_I_GE; r %= MOE_I_GE; const int kb = r / 56, nb = r % 56, c0 = 64 * nb;
        p0_transpose_item(in[up ? 18 : 17] + (size_t)e * D * DFFE, DFFE, 64 * kb, c0, (bf16_t*)(F.ws + WS_WGUE) + (size_t)e * 2 * DFFE * D, D, (c0 >> 7) * 256 + up * 128 + (c0 & 127) + ln, ln); }
    else { const int e = r / MOE_I_DE; r %= MOE_I_DE; const int kb = r / 16, nb = r % 16;
        p0_transpose_item(in[19] + (size_t)e * DFFE * D, D, 64 * kb, 64 * nb, (bf16_t*)(F.ws + WS_WDE) + (size_t)e * D * DFFE, DFFE, 64 * nb + ln, ln); }
}
__device__ __forceinline__ void moe_convert(Frame& F, int which) {
    volatile LAS unsigned* lw = (volatile LAS unsigned*)(F.lds + MISC_OFF) + 20;
    unsigned* q = (unsigned*)(F.ws + WS_CTL) + CW_CONVQ + 64 * which;
    const int nb = which == 0 ? NE * 2 * MOE_I_GE / 8 : NE * MOE_I_DE / 8;
    for (;;) {
        __syncthreads();
        if (F.tid == 0) lw[0] = __hip_atomic_fetch_add(q, 1u, __ATOMIC_RELAXED, __HIP_MEMORY_SCOPE_AGENT);
        __syncthreads();
        const int idx = (int)lw[0];
        if (idx >= nb) break;
        moe_convert_batch(F, which, idx);
    }
    __syncthreads();
}

__device__ __forceinline__ void p0_prologue(Frame& F) {
    const float* const* in = F.in;
    const int gw = F.bx * NWAVES + F.wave, NGW = F.G * NWAVES;
    {
        constexpr int I_IN = 16 * 44, I_O = 16 * 16, I_GD = 16 * 44, I_DD = 44 * 16;
        constexpr int N_A = 2 * I_IN + 2 * I_O + 2 * I_GD + I_DD;
        const int ln = F.lane;
        for (int it = gw; it < N_A; it += NGW) {
            int r = it;
            if (r < 2 * I_IN) { const int l = r / I_IN; r %= I_IN; const int kb = r / 44, nb = r % 44, c0 = 512 + 64 * nb;
                const int n32 = ln & 31; const int dn = c0 < OFFV ? (ln & 32) + ((n32 < 16) ? 2 * n32 : 2 * (n32 - 16) + 1) : ln;
                p0_transpose_item(in[8] + (size_t)l * D * INW, INW, 64 * kb, c0, (bf16_t*)(F.ws + (l ? WS_WIN1 : WS_WIN0)), D, c0 + dn, ln); continue; }
            r -= 2 * I_IN;
            if (r < 2 * I_O) { const int l = r / I_O; r %= I_O; const int kb = r / 16, nb = r % 16;
                p0_transpose_item(in[12] + (size_t)l * D * D, D, 64 * kb, 64 * nb, (bf16_t*)(F.ws + (l ? WS_WO1 : WS_WO0)), D, 64 * nb + ln, ln); continue; }
            r -= 2 * I_O;
            if (r < 2 * I_GD) { const int up = r / I_GD; r %= I_GD; const int kb = r / 44, nb = r % 44, c0 = 64 * nb;
                p0_transpose_item(in[up ? 14 : 13], DFF0, 64 * kb, c0, (bf16_t*)(F.ws + WS_WGUD), D, (c0 >> 7) * 256 + up * 128 + (c0 & 127) + ln, ln); continue; }
            r -= 2 * I_GD;
            { const int kb = r / 16, nb = r % 16;
              p0_transpose_item(in[15], D, 64 * kb, 64 * nb, (bf16_t*)(F.ws + WS_WDD), DFF0, 64 * nb + ln, ln); }
        }
    }
    __syncthreads();
    {
        LAS float* wrow = (LAS float*)F.lds;
        LAS float* ctab = wrow + 4096;
        if (F.tid < 128) ctab[F.tid] = cospif((float)F.tid / 64.0f);
        for (int it = F.bx; it < 2 * 128; it += F.G) {
            const int l = it >> 7, d0 = (it & 127) * 8;
            __syncthreads();
            for (int i = F.tid; i < 4096; i += NTHR) wrow[i] = in[8][(size_t)l * D * INW + (size_t)(d0 + (i >> 9)) * INW + (i & 511)];
            __syncthreads();
            const int r = F.tid, j = r >> 1, ri = r & 1, g = j >> 6, jj = j & 63;
            float a[8];
#pragma unroll
            for (int q = 0; q < 8; ++q) a[q] = 0.f;
            for (int cc = 0; cc < 128; ++cc) {
                float cf;
                if (jj == 0) cf = ri ? ((cc & 1) ? -1.f : 1.f) : 1.f;
                else { const int idx = (cc * jj) & 127; cf = ri ? -ctab[(idx - 32) & 127] : ctab[idx]; }
#pragma unroll
                for (int q = 0; q < 8; ++q) a[q] += cf * wrow[q * 512 + g * 128 + cc];
            }
            u32x4 o; o.x = pk2(a[0], a[1]); o.y = pk2(a[2], a[3]); o.z = pk2(a[4], a[5]); o.w = pk2(a[6], a[7]);
            *(u32x4*)((bf16_t*)(F.ws + (l ? WS_WIN1 : WS_WIN0)) + (size_t)r * D + d0) = o;
        }
        __syncthreads();
    }
    const int gt = F.bx * NTHR + F.tid, NGT = F.G * NTHR;
    for (int it = gt; it < 2 * 1024 * 144; it += NGT) {
        const int l = it / (1024 * 144), r = it % (1024 * 144), kc = r / 1024, o = r % 1024;
        const float* wf = in[10] + (size_t)l * 512 * D; const float* wa = in[11] + (size_t)l * 512 * D;
        float v[8];
#pragma unroll
        for (int q = 0; q < 8; ++q) { const int k = kc * 8 + q; float x = 0.f;
            if (k < 512) { const int mm = k & 127; x = wf[(size_t)k * D + o] * ((mm == 0 || mm == 64) ? 0.5f : 1.f); }
            else if (k < 520) { const int gg = (k - 512) >> 1, sgn = (k - 512) & 1; x = 0.5f * wf[(size_t)(gg * 128 + 64 * sgn) * D + o]; }
            else if (k >= 640) x = wa[(size_t)(k - 640) * D + o];
            v[q] = x; }
        u32x4 w; w.x = pk2(v[0], v[1]); w.y = pk2(v[2], v[3]); w.z = pk2(v[4], v[5]); w.w = pk2(v[6], v[7]);
        *(u32x4*)((bf16_t*)(F.ws + (l ? WS_WM1 : WS_WM0)) + (size_t)o * KM + kc * 8) = w;
    }
    for (int it = gt; it < 192 * 16; it += NGT) {
        const int i = it & 15, p = it >> 4, pos = p < 128 ? p : p - 128;
        const float inv = powf(10000.0f, -(float)i / 16.0f), a = (float)pos * inv;
        ((f32x2*)(F.ws + WS_ROPE))[it] = (f32x2){cosf(a), sinf(a)};
    }
    for (int it = gt; it < 128 * 64; it += NGT) {
        const int t2 = it >> 6, k1 = it & 63; float s, c; sincospif((float)(t2 * k1) / 4096.0f, &s, &c);
        ((f32x2*)(F.ws + WS_TW))[it] = (f32x2){c, s};
    }
    for (int it = gt; it < 256 * 128; it += NGT) {
        const int nu = it >> 7, ka = it & 127; float v = 0.f;
        if (nu < 128) { const int k1 = nu >> 1, ro = nu & 1, ri = ka >> 6, t1 = ka & 63; float s, c; sincospif((float)((t1 * k1) & 63) / 32.0f, &s, &c);
            v = ro == 0 ? (ri == 0 ? c : s) : (ri == 0 ? -s : c); }
        ((bf16_t*)(F.ws + WS_FA64))[it] = (bf16_t)f2bf(v);
    }
    for (int it = gt; it < 256 * 256; it += NGT) {
        const int mu = it >> 8, la = it & 255, k2 = mu >> 1, ro = mu & 1, ri = la >> 7, t2 = la & 127; float s, c; sincospif((float)((t2 * k2) & 127) / 64.0f, &s, &c);
        const float v = (ro == 0 ? (ri == 0 ? c : s) : (ri == 0 ? -s : c)) * 0.0009765625f;
        ((bf16_t*)(F.ws + WS_TC))[it] = (bf16_t)f2bf(v);
    }
    for (int it = gt; it < 512 * 512; it += NGT) {
        const int mu = it >> 9, la = it & 511, k = mu >> 1, ro = mu & 1, ri = la >> 8, t = la & 255; float s, c; sincospif((float)((t * k) & 255) / 128.0f, &s, &c);
        const float v = (ro == 0 ? (ri == 0 ? c : s) : (ri == 0 ? -s : c)) * 0.005524271728019903f;
        ((bf16_t*)(F.ws + WS_TX))[it] = (bf16_t)f2bf(v);
    }
    __syncthreads();
    {
        LAS float* sl = (LAS float*)F.lds;
        LAS float* part = sl + 3 * D;
        for (int i = F.tid; i < 3 * D; i += NTHR) { const float c = i < 2 * D ? in[1][i] : in[3][i - 2 * D]; sl[i] = c / (1.0f + __expf(-c)); }
        __syncthreads();
        for (int it = F.bx; it < 2 * 96; it += F.G) {
            const int l = it / 96, n = (it % 96) * 64 + F.lane;
            const float* wm = in[4] + (size_t)l * D * MODSZ + (size_t)(F.wave * 128) * MODSZ + n;
            float a0 = 0.f, a1 = 0.f, a2 = 0.f;
#pragma unroll
            for (int d0 = 0; d0 < 128; d0 += 32) { float w[32];
#pragma unroll
                for (int q = 0; q < 32; ++q) w[q] = wm[(size_t)(d0 + q) * MODSZ];
#pragma unroll
                for (int q = 0; q < 32; ++q) { const int d = F.wave * 128 + d0 + q; a0 += sl[d] * w[q]; a1 += sl[D + d] * w[q]; a2 += sl[2 * D + d] * w[q]; } }
            __syncthreads();
            part[(F.wave * 3 + 0) * 64 + F.lane] = a0; part[(F.wave * 3 + 1) * 64 + F.lane] = a1; part[(F.wave * 3 + 2) * 64 + F.lane] = a2;
            __syncthreads();
            if (F.tid < 192) { const int v = F.tid >> 6, ln = F.tid & 63; float sacc = in[5][l * MODSZ + (it % 96) * 64 + ln];
#pragma unroll
                for (int w = 0; w < 8; ++w) sacc += part[(w * 3 + v) * 64 + ln];
                modp(F, l, v)[(it % 96) * 64 + ln] = sacc; }
        }
    }
    for (int it = gt; it < NTOK * 15; it += NGT) { const int row = it / 15, c = it % 15;
        *(u32x4*)((bf16_t*)(F.ws + WS_FO) + (size_t)row * KM + 520 + c * 8) = (u32x4){0u, 0u, 0u, 0u}; }
}

__device__ __forceinline__ const float* xrow_ptr(const Frame& F, int row, const float* xl) { return row < NL ? xl + (size_t)row * D : (const float*)(F.ws + WS_XC) + (size_t)(row - NL) * D; }

template <bool ROUTE>
__device__ __forceinline__ void norm_phase(Frame& F, int l, int which  , const float* xl, const float* xc, int nrows, const float* xcadd = nullptr, float* xcwb = nullptr) {
    const float* gvec = F.in[which ? 7 : 6] + l * D;
    LAS float* wr_l = (LAS float*)F.lds;
    if (ROUTE) { for (int i = F.tid; i < D * NE; i += NTHR) wr_l[i] = F.in[16][i]; __syncthreads(); }
    const int gw = F.bx * NWAVES + F.wave, NGW = F.G * NWAVES;
    for (int row = gw; row < nrows; row += NGW) {
        const int v = row < T ? 0 : (row < NL ? 1 : 2);
        const bool fromb = row < NL && xl == nullptr;
        const float* xr = row < NL ? (fromb ? xc : xl + (size_t)row * D) : xc + (size_t)(row - NL) * D;
        const bf16_t* xbr = (const bf16_t*)(F.ws + WS_XB) + (size_t)row * D;
        const float* sh = modp(F, l, v) + (which ? 3 : 0) * D; const float* sc = sh + D;
        f32x4 x[4]; float s = 0.f;
#pragma unroll
        for (int j = 0; j < 4; ++j) {
            if (fromb) { const u32x2 xb = *(const u32x2*)(xbr + 256 * j + 4 * F.lane); x[j] = (f32x4){bflo(xb.x), bfhi(xb.x), bflo(xb.y), bfhi(xb.y)}; }
            else x[j] = *(const f32x4*)(xr + 256 * j + 4 * F.lane);
            if (row >= NL && xcadd) { x[j] = x[j] + *(const f32x4*)(xcadd + (size_t)(row - NL) * D + 256 * j + 4 * F.lane); if (xcwb) *(f32x4*)(xcwb + (size_t)(row - NL) * D + 256 * j + 4 * F.lane) = x[j]; }
            s += (x[j].x * x[j].x + x[j].y * x[j].y) + (x[j].z * x[j].z + x[j].w * x[j].w); }
        const float r = 1.0f / sqrtf(wave_sum(s) * (1.f / D) + EPS);
        float lg[NE];
        if (ROUTE) {
#pragma unroll
            for (int e = 0; e < NE; ++e) lg[e] = 0.f; }
        bf16_t* hr = (bf16_t*)(F.ws + WS_H) + (size_t)row * D;
#pragma unroll
        for (int j = 0; j < 4; ++j) { const int c = 256 * j + 4 * F.lane;
            const f32x4 gg = *(const f32x4*)(gvec + c), s4 = *(const f32x4*)(sh + c), c4 = *(const f32x4*)(sc + c);
            f32x4 h = (x[j] * r) * gg; h = h * (c4 + 1.0f) + s4;
            u32x2 o; o.x = pk2(h.x, h.y); o.y = pk2(h.z, h.w); *(u32x2*)(hr + c) = o;
            if (ROUTE) {
#pragma unroll
                for (int q = 0; q < 4; ++q) { const float hv = h[q]; const LAS f32x4* w = (const LAS f32x4*)(wr_l + (c + q) * NE); const f32x4 w0 = w[0], w1 = w[1];
                    lg[0] += hv * w0.x; lg[1] += hv * w0.y; lg[2] += hv * w0.z; lg[3] += hv * w0.w; lg[4] += hv * w1.x; lg[5] += hv * w1.y; lg[6] += hv * w1.z; lg[7] += hv * w1.w; } }
        }
        if (ROUTE) {
#pragma unroll
            for (int e = 0; e < NE; ++e) lg[e] = wave_sum(lg[e]);
            if (F.lane == 0) {
                int e1 = 0; float v1 = lg[0];
#pragma unroll
                for (int e = 1; e < NE; ++e) if (lg[e] > v1) { v1 = lg[e]; e1 = e; }
                int e2 = -1; float v2 = -3.0e38f;
#pragma unroll
                for (int e = 0; e < NE; ++e) if (e != e1 && lg[e] > v2) { v2 = lg[e]; e2 = e; }
                const float p2 = __expf(v2 - v1), w1 = 1.f / (1.f + p2), w2 = p2 * w1;
                unsigned* cnt = (unsigned*)(F.ws + WS_CTL) + CW_CNT;
                const unsigned r1 = atomicAdd(cnt + 64 * e1, 1u), r2 = atomicAdd(cnt + 64 * e2, 1u);
                int* toke = (int*)(F.ws + WS_TOKE); int* tokr = (int*)(F.ws + WS_TOKR); float* tokw = (float*)(F.ws + WS_TOKW); int* list = (int*)(F.ws + WS_LIST);
                toke[2 * row] = e1; toke[2 * row + 1] = e2; tokr[2 * row] = (int)r1; tokr[2 * row + 1] = (int)r2; tokw[2 * row] = w1; tokw[2 * row + 1] = w2;
                list[e1 * NL + r1] = row; list[e2 * NL + r2] = row;
            }
        }
    }
}

constexpr int TAILQ_ROWS = 8 * 256;
__device__ __forceinline__ int moe_tail_panels(const unsigned* cw, int G) { int ptot = 0, plast = 0;
#pragma unroll
    for (int e = 0; e < NE; ++e) { const int p_ = ((int)cw[64 * e] + 255) >> 8; ptot += p_; plast = p_; }
    const int left = (4 * ptot) % G; int t = (left + 3) >> 2; if (4 * ptot < G) t = 0; if (t > plast) t = plast; if (t > 8) t = 8; return t; }
__device__ __forceinline__ void final_phase(Frame& F) {
    const int gw = F.bx * NWAVES + F.wave, NGW = F.G * NWAVES;
    const unsigned* cnt = (const unsigned*)(F.ws + WS_CTL) + CW_CNT;
    int base[NE]; { int b = 0;
#pragma unroll
        for (int e = 0; e < NE; ++e) { base[e] = b; b += ((int)cnt[64 * e] + 255) & ~255; } }
    const int* toke = (const int*)(F.ws + WS_TOKE); const int* tokr = (const int*)(F.ws + WS_TOKR); const float* tokw = (const float*)(F.ws + WS_TOKW);
    const bf16_t* dout = (const bf16_t*)(F.ws + WS_DOUT); const bf16_t* tq = (const bf16_t*)(F.ws + WS_DOUT1);
    const int trim_ = moe_tail_panels(cnt, F.G), trow0 = trim_ > 0 ? base[NE - 1] + ((((int)cnt[64 * (NE - 1)] + 255) >> 8) - trim_) * 256 : 0x7fffffff;
    for (int row = gw; row < NL; row += NGW) {
        const int v = row < T ? 0 : 1;
        const float* ga2 = modp(F, 1, v) + 5 * D;
        const int e1 = toke[2 * row], e2 = toke[2 * row + 1];
        int b1 = 0, b2 = 0;
#pragma unroll
        for (int e = 0; e < NE; ++e) { if (e == e1) b1 = base[e]; if (e == e2) b2 = base[e]; }
        const bf16_t* d1 = dout + (size_t)(b1 + tokr[2 * row]) * D; const bf16_t* d2 = dout + (size_t)(b2 + tokr[2 * row + 1]) * D;
        const int r1_ = b1 + tokr[2 * row], r2_ = b2 + tokr[2 * row + 1];
        const bool t1 = r1_ >= trow0, t2 = r2_ >= trow0;
        const bf16_t* q1 = tq + (size_t)(t1 ? r1_ - trow0 : 0) * D; const bf16_t* q2 = tq + (size_t)(t2 ? r2_ - trow0 : 0) * D;
        const float w1 = tokw[2 * row], w2 = tokw[2 * row + 1];
        float* xr = F.out + (size_t)row * D;
        f32x4 x[4]; float s = 0.f;
#pragma unroll
        for (int j = 0; j < 4; ++j) { const int c = 256 * j + 4 * F.lane;
            const u32x2 a = *(const u32x2*)(d1 + c), b = *(const u32x2*)(d2 + c); const f32x4 g4 = *(const f32x4*)(ga2 + c);
            f32x4 ya = (f32x4){bflo(a.x), bfhi(a.x), bflo(a.y), bfhi(a.y)}, yb = (f32x4){bflo(b.x), bfhi(b.x), bflo(b.y), bfhi(b.y)};
            if (t1) {
#pragma unroll
                for (int k = 0; k < 3; ++k) { const u32x2 e_ = *(const u32x2*)(q1 + (size_t)k * TAILQ_ROWS * D + c); ya = ya + (f32x4){bflo(e_.x), bfhi(e_.x), bflo(e_.y), bfhi(e_.y)}; } }
            if (t2) {
#pragma unroll
                for (int k = 0; k < 3; ++k) { const u32x2 e_ = *(const u32x2*)(q2 + (size_t)k * TAILQ_ROWS * D + c); yb = yb + (f32x4){bflo(e_.x), bfhi(e_.x), bflo(e_.y), bfhi(e_.y)}; } }
            const f32x4 y = ya * w1 + yb * w2;
            { const u32x2 xb = *(const u32x2*)((const bf16_t*)(F.ws + WS_XB) + (size_t)row * D + c); x[j] = (f32x4){bflo(xb.x), bfhi(xb.x), bflo(xb.y), bfhi(xb.y)} + g4 * y; }
            s += (x[j].x * x[j].x + x[j].y * x[j].y) + (x[j].z * x[j].z + x[j].w * x[j].w); }
        const float r = 1.0f / sqrtf(wave_sum(s) * (1.f / D) + EPS);
#pragma unroll
        for (int j = 0; j < 4; ++j) { const int c = 256 * j + 4 * F.lane; *(f32x4*)(xr + c) = (x[j] * r) * *(const f32x4*)(F.in[20] + c); }
    }
}

struct GridSched { int nM, nN, G, c; unsigned abytes, bbytes;
    __device__ __forceinline__ bool next(int i, Unit& u) const { const int L = i * G + c; if (L >= nM * nN) return false; pg8::swz_map(L, nM, nN, u.pm, u.pn); u.aoff = (unsigned)u.pm * abytes; u.boff = (unsigned)u.pn * bbytes; u.kind = 0; u.x0 = 0; u.x1 = 0; u.kh = 0; return true; } };

struct CtxSched { int G, c, nN; unsigned abytes, bbytes; int ksplit; unsigned khbytes;
    __device__ __forceinline__ bool next(int i, Unit& u) const { int L = i * G + c; if (L >= 2 * nN * ksplit) return false; u.kh = L / (2 * nN); L -= u.kh * 2 * nN; u.pm = 64 + L / nN; u.pn = L % nN;
        u.aoff = (unsigned)u.pm * abytes + (unsigned)u.kh * khbytes; u.boff = (unsigned)u.pn * bbytes + (unsigned)u.kh * khbytes; u.kind = 0; u.x0 = u.pm * 256; u.x1 = 0; return true; } };

struct InprojSched { int G, c, l;
    __device__ __forceinline__ bool next(int i, Unit& u) const { const int L = i * G + c; const int nmain = 64 * 11;
        if (L < nmain) { pg8::swz_map(L, 64, 11, u.pm, u.pn); }
        else { const int r = L - nmain; if (l == 0) { if (r >= 22) return false; u.pm = 64 + r / 11; u.pn = r % 11; } else { if (r >= 2) return false; u.pm = 64 + r; u.pn = 2; } }
        u.aoff = (unsigned)u.pm * (256u * D * 2u); u.boff = (unsigned)u.pn * (256u * D * 2u); u.kind = 0; u.x0 = 0; u.x1 = 0; u.kh = 0; return true; } };

struct EpiInproj {
    static constexpr bool PERM = true; static constexpr int MIDK = 0;
    unsigned char* ws;
    __device__ __forceinline__ void operator()(const f32x4 (&acc)[2][2][4][2], const Unit& u, int wr, int wc, int fr, int fq) const {
        const int row0 = u.pm * 256 + wr * 64 + fr;
        const bool lat = u.pm < 64;
        const f32x2* rope = (const f32x2*)(ws + WS_ROPE);
#pragma unroll
        for (int ai = 0; ai < 2; ++ai)
#pragma unroll
            for (int m = 0; m < 4; ++m) {
                const int row = row0 + ai * 128 + m * 16;
                const int t = row & (T - 1), prow = t >> 6, pcol = t & 63;
#pragma unroll
                for (int bj = 0; bj < 2; ++bj) {
                    const int cl = u.pn * 256 + bj * 128 + wc * 32 + 8 * fq;
                    f32x4 v0 = acc[ai][bj][m][0], v1 = acc[ai][bj][m][1];
                    bf16_t* dst;
                    if (cl < 640) {
                        if (lat) { const int dh = cl & 63, i0 = (dh & 31) >> 1; const f32x2* rp = rope + ((dh < 32 ? prow : 128 + pcol) * 16 + i0);
                            const f32x2 c0 = rp[0], c1 = rp[1], c2 = rp[2], c3 = rp[3];
                            f32x4 w0, w1; w0.x = v0.x * c0.x - v0.y * c0.y; w0.y = v0.x * c0.y + v0.y * c0.x; w0.z = v0.z * c1.x - v0.w * c1.y; w0.w = v0.z * c1.y + v0.w * c1.x;
                            w1.x = v1.x * c2.x - v1.y * c2.y; w1.y = v1.x * c2.y + v1.y * c2.x; w1.z = v1.z * c3.x - v1.w * c3.y; w1.w = v1.z * c3.y + v1.w * c3.x; v0 = w0; v1 = w1; }
                        if (cl < 512) { v0 = v0 * QSCALE; v1 = v1 * QSCALE; dst = (bf16_t*)(ws + WS_Q) + (size_t)row * 512 + cl; }
                        else dst = (bf16_t*)(ws + WS_KB) + (size_t)row * 128 + (cl - 512);
                    } else if (cl < 768) { dst = (bf16_t*)(ws + WS_VB) + (size_t)row * 128 + (cl - 640); }
                    else { const int cg = cl - 768;
#pragma unroll
                        for (int q = 0; q < 4; ++q) { v0[q] = sigmoidf_(v0[q]); v1[q] = sigmoidf_(v1[q]); }
                        dst = (cg < 1024 ? (bf16_t*)(ws + WS_GF) + (size_t)row * D + cg : (bf16_t*)(ws + WS_GA) + (size_t)row * D + (cg - 1024)); }
                    u32x4 w; w.x = cvt_pk_bf16(v0[0], v0[1]); w.y = cvt_pk_bf16(v0[2], v0[3]); w.z = cvt_pk_bf16(v1[0], v1[1]); w.w = cvt_pk_bf16(v1[2], v1[3]);
                    *(u32x4*)dst = w;
                }
            }
    }
};

struct UpermSched { int G, c, l;
    __device__ __forceinline__ bool next(int i, Unit& u) const { const int L = i * G + c; const int nn = l == 0 ? 66 : 64; if (L >= 2 * nn) return false;
        u.pm = L & 1; u.pn = L >> 1; u.aoff = (unsigned)u.pm * (256u * D * 2u); u.boff = 0; u.kind = 0; u.x0 = 0; u.x1 = 0; u.kh = 0; return true; } };
struct UpermRows { static constexpr bool GA = false, GB = true;
    __device__ __forceinline__ unsigned arow(const Unit&, int) const { return 0u; }
    __device__ __forceinline__ unsigned brow(const Unit& u, int c) const { const int n = u.pn; int row;
        if (n < 64) { const int b = n >> 5, q = n & 31; row = b * T + 128 * (c & 63) + 4 * q + (c >> 6); } else row = NL + (n - 64) * 256 + c;
        return (unsigned)row * (D * 2u); } };
struct EpiUperm {
    static constexpr bool PERM = true; static constexpr int MIDK = 0;
    unsigned char* ws;
    __device__ __forceinline__ void operator()(const f32x4 (&acc)[2][2][4][2], const Unit& u, int wr, int wc, int fr, int fq) const {
        const int n = u.pn;
#pragma unroll
        for (int ai = 0; ai < 2; ++ai)
#pragma unroll
            for (int m = 0; m < 4; ++m) { const int r = u.pm * 256 + ai * 128 + wr * 64 + m * 16 + fr, j = r >> 1, ri = r & 1;
#pragma unroll
                for (int bj = 0; bj < 2; ++bj) { const int c = bj * 128 + wc * 32 + 8 * fq;
                    const f32x4 v0 = acc[ai][bj][m][0], v1 = acc[ai][bj][m][1];
                    u32x4 w; w.x = cvt_pk_bf16(v0[0], v0[1]); w.y = cvt_pk_bf16(v0[2], v0[3]); w.z = cvt_pk_bf16(v1[0], v1[1]); w.w = cvt_pk_bf16(v1[2], v1[3]);
                    bf16_t* dst;
                    if (n < 64) { const int b = n >> 5, q = n & 31, t2 = 4 * q + (c >> 6), t1 = c & 63; dst = (bf16_t*)(ws + WS_UP) + ((size_t)((j * 2 + b) * 128 + t2) * 128 + ri * 64 + t1); }
                    else { const int b = n - 64; dst = (bf16_t*)(ws + WS_VCT) + ((size_t)((b * 256 + j) * 2 + ri) * 256 + c); }
                    *(u32x4*)dst = w; } }
    }
};

struct EpiStepA {
    static constexpr bool PERM = true; static constexpr int MIDK = 0;
    unsigned char* ws;
    __device__ __forceinline__ void operator()(const f32x4 (&acc)[2][2][4][2], const Unit& u, int wr, int wc, int fr, int fq) const {
        const f32x2* tw = (const f32x2*)(ws + WS_TW); bf16_t* gp = (bf16_t*)(ws + WS_GP);
        const int j = u.pm;
#pragma unroll
        for (int ai = 0; ai < 2; ++ai)
#pragma unroll
            for (int m = 0; m < 4; ++m) { const int t2 = wr * 64 + m * 16 + fr, b = ai;
#pragma unroll
                for (int n = 0; n < 2; ++n) { const f32x4 v = acc[ai][0][m][n];
#pragma unroll
                    for (int p = 0; p < 2; ++p) { const int k1 = 16 * wc + 4 * fq + 2 * n + p; const f32x2 w = tw[t2 * 64 + k1];
                        const float gr = v[2 * p], gi = v[2 * p + 1];
                        const float orr = gr * w.x + gi * w.y, oi = gi * w.x - gr * w.y;
                        bf16_t* d = gp + ((size_t)((b * 64 + k1) * 256 + j) * 256 + t2);
                        d[0] = (bf16_t)f2bf(orr); d[128] = (bf16_t)f2bf(oi); } } }
    }
};
template <bool CTXV> struct EpiStepC {
    static constexpr bool PERM = true; static constexpr int MIDK = 0;
    unsigned char* ws;
    __device__ __forceinline__ void operator()(const f32x4 (&acc)[2][2][4][2], const Unit& u, int wr_, int wc_, int fr_, int fq_) const {
        int wr = wr_, wc = wc_, fr = fr_, fq = fq_, upm = u.pm, upn = u.pn;
        asm volatile("" : "+s"(wr), "+s"(wc), "+v"(fr), "+v"(fq), "+s"(upm), "+s"(upn));
        bf16_t* fo = (bf16_t*)(ws + WS_FO);
        const int NN = CTXV ? 256 : T;
        const int b = CTXV ? upm : (upm >> 6), k1 = CTXV ? 0 : (upm & 63), rowb = CTXV ? NL + b * 256 : b * T;
        const int own0 = wr * 128 + fr, mir0 = wr * 128 + 128 - fr;
        const int kk0 = (CTXV ? 128 * upn : 0) + 16 * wc + 4 * fq;
#pragma unroll
        for (int bj = 0; bj < 2; ++bj)
#pragma unroll
            for (int n = 0; n < 2; ++n)
#pragma unroll
                for (int p = 0; p < 2; ++p) {
                    const int kk = kk0 + 64 * bj + 2 * n + p;
                    const int k = CTXV ? kk : (k1 + 64 * kk), km = (NN - k) & (NN - 1);
                    const unsigned oo = (unsigned)(rowb + k) * KM, om = (unsigned)(rowb + km) * KM;
#pragma unroll
                    for (int ai = 0; ai < 2; ++ai)
#pragma unroll
                        for (int m = 0; m < 4; ++m) {
                            const f32x4 v = acc[ai][bj][m][n];
                            const bf16_t re = (bf16_t)f2bf(v[2 * p]);
                            if (m == 0 && fr == 0) { const int g = 2 * ai + wr; const bf16_t im = (bf16_t)f2bf(v[2 * p + 1]);
                                fo[oo + g * 128] = re; fo[om + 512 + 2 * g] = re; fo[oo + g * 128 + 64] = im; fo[om + 512 + 2 * g + 1] = im; }
                            else { fo[oo + own0 + ai * 256 + 16 * m] = re; fo[om + mir0 + ai * 256 - 16 * m] = re; }
                        }
                    asm volatile("" ::: "memory"); __builtin_amdgcn_sched_barrier(0);
                }
    }
};

struct EpiMerge {
    static constexpr bool PERM = true; static constexpr int MIDK = 10;
    unsigned char* ws;
    __device__ __forceinline__ void mid(f32x4 (&acc)[2][2][4][2], const Unit& u, int wr, int wc, int fr, int fq) const {
        asm volatile("" : "+v"(fr), "+v"(fq));
#pragma unroll
        for (int ai = 0; ai < 2; ++ai)
#pragma unroll
            for (int m = 0; m < 4; ++m) { const size_t row = (size_t)(u.pm * 256 + ai * 128 + wr * 64 + m * 16 + fr);
#pragma unroll
                for (int bj = 0; bj < 2; ++bj) { const int col = u.pn * 256 + bj * 128 + wc * 32 + 8 * fq;
                    const u32x4 gf = *(const u32x4*)((const bf16_t*)(ws + WS_GF) + row * D + col), ga = *(const u32x4*)((const bf16_t*)(ws + WS_GA) + row * D + col);
                    f32x4 r0, r1;
                    r0[0] = bflo(gf.x) * __builtin_amdgcn_rcpf(bflo(ga.x)); r0[1] = bfhi(gf.x) * __builtin_amdgcn_rcpf(bfhi(ga.x)); r0[2] = bflo(gf.y) * __builtin_amdgcn_rcpf(bflo(ga.y)); r0[3] = bfhi(gf.y) * __builtin_amdgcn_rcpf(bfhi(ga.y));
                    r1[0] = bflo(gf.z) * __builtin_amdgcn_rcpf(bflo(ga.z)); r1[1] = bfhi(gf.z) * __builtin_amdgcn_rcpf(bfhi(ga.z)); r1[2] = bflo(gf.w) * __builtin_amdgcn_rcpf(bflo(ga.w)); r1[3] = bfhi(gf.w) * __builtin_amdgcn_rcpf(bfhi(ga.w));
                    acc[ai][bj][m][0] = acc[ai][bj][m][0] * r0; acc[ai][bj][m][1] = acc[ai][bj][m][1] * r1; } }
    }
    __device__ __forceinline__ void operator()(const f32x4 (&acc)[2][2][4][2], const Unit& u, int wr, int wc, int fr, int fq) const {
#pragma unroll
        for (int ai = 0; ai < 2; ++ai)
#pragma unroll
            for (int m = 0; m < 4; ++m) { const size_t row = (size_t)(u.pm * 256 + ai * 128 + wr * 64 + m * 16 + fr);
#pragma unroll
                for (int bj = 0; bj < 2; ++bj) { const int col = u.pn * 256 + bj * 128 + wc * 32 + 8 * fq;
                    const u32x4 ga = *(const u32x4*)((const bf16_t*)(ws + WS_GA) + row * D + col);
                    const f32x4 a0 = acc[ai][bj][m][0], a1 = acc[ai][bj][m][1];
                    u32x4 w;
                    w.x = cvt_pk_bf16(bflo(ga.x) * a0[0], bfhi(ga.x) * a0[1]); w.y = cvt_pk_bf16(bflo(ga.y) * a0[2], bfhi(ga.y) * a0[3]);
                    w.z = cvt_pk_bf16(bflo(ga.z) * a1[0], bfhi(ga.z) * a1[1]); w.w = cvt_pk_bf16(bflo(ga.w) * a1[2], bfhi(ga.w) * a1[3]);
                    *(u32x4*)((bf16_t*)(ws + WS_Y) + row * D + col) = w; } }
    }
};

struct EpiResid {
    static constexpr bool PERM = true; static constexpr int MIDK = 0;
    const float* xl_in32; const bf16_t* xl_inb; bf16_t* xl_out; const float* xc_in; float* xc_out; const float* mod_l; int chunk; float* tmpc;
    __device__ __forceinline__ void operator()(const f32x4 (&acc)[2][2][4][2], const Unit& u, int wr, int wc, int fr, int fq) const {
        const int v = u.pm < 32 ? 0 : (u.pm < 64 ? 1 : 2);
        const float* gate = mod_l + v * MODSZ + chunk * D;
        const bool lat = u.pm < 64; const int rbase = lat ? u.pm * 256 : (u.pm - 64) * 256;
#pragma unroll
        for (int bj = 0; bj < 2; ++bj) { const int col = u.pn * 256 + bj * 128 + wc * 32 + 8 * fq;
            const f32x4 g0 = *(const f32x4*)(gate + col), g1 = *(const f32x4*)(gate + col + 4);
#pragma unroll
            for (int ai = 0; ai < 2; ++ai)
#pragma unroll
                for (int m = 0; m < 4; ++m) { const size_t o = (size_t)(rbase + ai * 128 + wr * 64 + m * 16 + fr) * D + col;
                    if (lat) {
                        f32x4 x0, x1;
                        if (xl_in32) { x0 = *(const f32x4*)(xl_in32 + o); x1 = *(const f32x4*)(xl_in32 + o + 4); }
                        else { const u32x4 xb = *(const u32x4*)(xl_inb + o); x0 = (f32x4){bflo(xb.x), bfhi(xb.x), bflo(xb.y), bfhi(xb.y)}; x1 = (f32x4){bflo(xb.z), bfhi(xb.z), bflo(xb.w), bfhi(xb.w)}; }
                        x0 = x0 + g0 * acc[ai][bj][m][0]; x1 = x1 + g1 * acc[ai][bj][m][1];
                        u32x4 w; w.x = cvt_pk_bf16(x0[0], x0[1]); w.y = cvt_pk_bf16(x0[2], x0[3]); w.z = cvt_pk_bf16(x1[0], x1[1]); w.w = cvt_pk_bf16(x1[2], x1[3]);
                        *(u32x4*)(xl_out + o) = w;
                    } else if (u.kh) { *(f32x4*)(tmpc + o) = g0 * acc[ai][bj][m][0]; *(f32x4*)(tmpc + o + 4) = g1 * acc[ai][bj][m][1]; }
                    else { *(f32x4*)(xc_out + o) = *(const f32x4*)(xc_in + o) + g0 * acc[ai][bj][m][0];
                           *(f32x4*)(xc_out + o + 4) = *(const f32x4*)(xc_in + o + 4) + g1 * acc[ai][bj][m][1]; } } }
    }
};

struct EpiSwiglu {
    static constexpr bool PERM = true; static constexpr int MIDK = 0;
    bf16_t* act; int ld;
    __device__ __forceinline__ void operator()(const f32x4 (&acc)[2][2][4][2], const Unit& u, int wr, int wc, int fr, int fq) const {
        const int col = u.pn * 128 + wc * 32 + 8 * fq;
#pragma unroll
        for (int ai = 0; ai < 2; ++ai)
#pragma unroll
            for (int m = 0; m < 4; ++m) { const size_t row = (size_t)(u.x0 + ai * 128 + wr * 64 + m * 16 + fr);
                float o[8];
#pragma unroll
                for (int n = 0; n < 2; ++n)
#pragma unroll
                    for (int q = 0; q < 4; ++q) { const float gv = acc[ai][0][m][n][q], uv = acc[ai][1][m][n][q]; o[4 * n + q] = gv * sigmoidf_(gv) * uv; }
                u32x4 w; w.x = cvt_pk_bf16(o[0], o[1]); w.y = cvt_pk_bf16(o[2], o[3]); w.z = cvt_pk_bf16(o[4], o[5]); w.w = cvt_pk_bf16(o[6], o[7]);
                *(u32x4*)(act + row * ld + col) = w; }
    }
};
struct EpiBf16 {
    static constexpr bool PERM = true; static constexpr int MIDK = 0;
    bf16_t* O0; bf16_t* O1; int ld;
    __device__ __forceinline__ void operator()(const f32x4 (&acc)[2][2][4][2], const Unit& u, int wr, int wc, int fr, int fq) const {
#pragma unroll
        for (int ai = 0; ai < 2; ++ai)
#pragma unroll
            for (int m = 0; m < 4; ++m) { const size_t row = (size_t)(u.x0 + ai * 128 + wr * 64 + m * 16 + fr);
#pragma unroll
                for (int bj = 0; bj < 2; ++bj) { const int col = u.pn * 256 + bj * 128 + wc * 32 + 8 * fq; const f32x4 v0 = acc[ai][bj][m][0], v1 = acc[ai][bj][m][1];
                    u32x4 w; w.x = cvt_pk_bf16(v0[0], v0[1]); w.y = cvt_pk_bf16(v0[2], v0[3]); w.z = cvt_pk_bf16(v1[0], v1[1]); w.w = cvt_pk_bf16(v1[2], v1[3]);
                    *(u32x4*)((u.kh ? O1 : O0) + row * ld + col) = w; } }
    }
};

struct RowSched { int nM, nN, G, c; unsigned abytes, bbytes;
    __device__ __forceinline__ bool next(int i, Unit& u) const { const int L = i * G + c; if (L >= nM * nN) return false; pg8::swz_map(L, nM, nN, u.pm, u.pn); u.aoff = (unsigned)u.pm * abytes; u.boff = (unsigned)u.pn * bbytes; u.kind = 0; u.x0 = u.pm * 256; u.x1 = 0; u.kh = 0; return true; } };

struct MoeSched { int G, c, nN, ksplit, trim; unsigned bexp, bbytes, arow_bytes, khbytes; bool a_slots; int cnt[NE], base[NE];
    __device__ __forceinline__ void init(const unsigned* cw) { int b = 0;
#pragma unroll
        for (int e = 0; e < NE; ++e) { cnt[e] = (int)cw[64 * e]; base[e] = b; b += (cnt[e] + 255) & ~255; } }
    __device__ __forceinline__ bool next(int i, Unit& u) const { int L = i * G + c; int e = 0;
        for (; e < NE; ++e) { const int nu = (((cnt[e] + 255) >> 8) - (e == NE - 1 ? trim : 0)) * nN * ksplit; if (L < nu) break; L -= nu; }
        if (e >= NE) return false;
        int cn = 0, bs = 0;
#pragma unroll
        for (int q = 0; q < NE; ++q) if (q == e) { cn = cnt[q]; bs = base[q]; }
        const int np_ = ((cn + 255) >> 8) - (e == NE - 1 ? trim : 0); const int nt_ = np_ * nN; u.kh = L / nt_; L -= u.kh * nt_;
        pg8::swz_map(L, np_, nN, u.pm, u.pn);
        u.kind = e; u.x1 = cn; u.x0 = bs + u.pm * 256;
        u.aoff = (a_slots ? (unsigned)u.x0 * arow_bytes : 0u) + (unsigned)u.kh * khbytes; u.boff = (unsigned)e * bexp + (unsigned)u.pn * bbytes + (unsigned)u.kh * khbytes; return true; } };
struct MoeTailSched { int G, c, trim, plast, rbase; unsigned bexp;
    __device__ __forceinline__ bool next(int i, Unit& u) const { int L = i * G + c; if (L >= 16 * trim) return false; u.kh = L / (4 * trim); L -= u.kh * 4 * trim;
        u.pm = plast - trim + (L >> 2); u.pn = L & 3; u.kind = NE - 1; u.x1 = 0; u.x0 = rbase + u.pm * 256;
        u.aoff = (unsigned)u.x0 * (DFFE * 2u) + (unsigned)u.kh * (DFFE / 4 * 2u); u.boff = (unsigned)(NE - 1) * bexp + (unsigned)u.pn * (256u * DFFE * 2u) + (unsigned)u.kh * (DFFE / 4 * 2u); return true; } };
struct EpiTail {
    static constexpr bool PERM = true; static constexpr int MIDK = 0;
    bf16_t* O0; bf16_t* Q; int row0;
    __device__ __forceinline__ void operator()(const f32x4 (&acc)[2][2][4][2], const Unit& u, int wr, int wc, int fr, int fq) const {
#pragma unroll
        for (int ai = 0; ai < 2; ++ai)
#pragma unroll
            for (int m = 0; m < 4; ++m) { const int row = u.x0 + ai * 128 + wr * 64 + m * 16 + fr;
                bf16_t* dst = u.kh == 0 ? O0 + (size_t)row * D : Q + ((size_t)(u.kh - 1) * TAILQ_ROWS + (size_t)(row - row0)) * D;
#pragma unroll
                for (int bj = 0; bj < 2; ++bj) { const int col = u.pn * 256 + bj * 128 + wc * 32 + 8 * fq; const f32x4 v0 = acc[ai][bj][m][0], v1 = acc[ai][bj][m][1];
                    u32x4 w; w.x = cvt_pk_bf16(v0[0], v0[1]); w.y = cvt_pk_bf16(v0[2], v0[3]); w.z = cvt_pk_bf16(v1[0], v1[1]); w.w = cvt_pk_bf16(v1[2], v1[3]);
                    *(u32x4*)(dst + col) = w; } }
    }
};
struct MoeRows { static constexpr bool GA = true, GB = false; const int* list;
    __device__ __forceinline__ unsigned arow(const Unit& u, int r) const { int idx = u.pm * 256 + r; idx = idx < u.x1 ? idx : u.x1 - 1; return (unsigned)list[u.kind * NL + idx] * (D * 2u); }
    __device__ __forceinline__ unsigned brow(const Unit&, int) const { return 0u; } };


constexpr int CW_QUEUE = 12288, CW_RDY = 65536;
template <int NG, bool MOE> struct FfnStream {
    int P[NG], rb[NG], cn[NG];
    int f, nNgu, Kdn; unsigned need;
    unsigned* q; volatile LAS unsigned* lw; unsigned* rdy; unsigned* tmo;
    __device__ __forceinline__ void finish_init(int G) { int sacc = 0; f = NG;
#pragma unroll
        for (int g = NG - 1; g >= 0; --g) { if (f == g + 1 && sacc + P[g] * 4 <= G) { sacc += P[g] * 4; f = g; } }
        if (f > NG - 1) f = NG - 1; }
    __device__ __forceinline__ bool decode(int L, SUnit& u) const {
        int pos = L, kind = -1, grp = 0, j = 0;
#pragma unroll
        for (int g = 0; g < NG; ++g) {
            { const int n = P[g] * nNgu; if (kind < 0) { if (pos < n) { kind = 0; grp = g; j = pos; } else pos -= n; } }
            if (g >= 1 && (g - 1) < f) { const int n = P[g - 1] * 4; if (kind < 0) { if (pos < n) { kind = 1; grp = g - 1; j = pos; } else pos -= n; } }
        }
#pragma unroll
        for (int g = 0; g < NG; ++g) if (g >= f) { const int n = P[g] * 4; if (kind < 0) { if (pos < n) { kind = 1; grp = g; j = pos; } else pos -= n; } }
        if (kind < 0) return false;
        int nM = 0, rbase = 0, cnt = 0;
#pragma unroll
        for (int g = 0; g < NG; ++g) if (g == grp) { nM = P[g]; rbase = rb[g]; cnt = cn[g]; }
        const int nN = kind == 0 ? nNgu : 4;
        const int nig = 8 * nN, gid = j / nig, fm = gid * 8, gsz = (nM - fm) < 8 ? (nM - fm) : 8;
        u.pm = fm + ((j % nig) % gsz); u.pn = (j % nig) / gsz; u.kind = kind; u.grp = grp; u.x0 = rbase + u.pm * 256; u.x1 = cnt;
        const int gp = u.x0 >> 8;
        if (kind == 0) { u.K = D; u.dep = -1; u.sig = gp;
            u.aoff = (unsigned)WS_H + (unsigned)u.x0 * (D * 2u);
            u.boff = (MOE ? (unsigned)WS_WGUE + (unsigned)grp * (2u * DFFE * D * 2u) : (unsigned)WS_WGUD) + (unsigned)u.pn * (256u * D * 2u); }
        else { u.K = Kdn; u.dep = gp; u.sig = -1;
            u.aoff = (unsigned)WS_ACT + (unsigned)u.x0 * ((unsigned)Kdn * 2u);
            u.boff = (MOE ? (unsigned)WS_WDE + (unsigned)grp * ((unsigned)D * DFFE * 2u) : (unsigned)WS_WDD) + (unsigned)u.pn * (256u * (unsigned)Kdn * 2u); }
        return true;
    }
    __device__ __forceinline__ void a_ready(const SUnit& u) const {
        if (threadIdx.x < 64) {
            const unsigned long long t0 = __builtin_amdgcn_s_memrealtime(); unsigned polls = 0;
            while ((unsigned)__builtin_amdgcn_readfirstlane(__hip_atomic_load(rdy + 64 * u.dep, __ATOMIC_RELAXED, __HIP_MEMORY_SCOPE_AGENT)) < need) {
                if ((++polls & 255u) == 0u && __builtin_amdgcn_readfirstlane(__hip_atomic_load(tmo, __ATOMIC_RELAXED, __HIP_MEMORY_SCOPE_AGENT)) != 0u) break;
                if (__builtin_amdgcn_s_memrealtime() - t0 > 2000000ull) { if (threadIdx.x == 0) __hip_atomic_store(tmo, 1u, __ATOMIC_RELAXED, __HIP_MEMORY_SCOPE_AGENT); break; }
                __builtin_amdgcn_s_sleep(2); }
            __builtin_amdgcn_fence(__ATOMIC_ACQUIRE, "agent");
            asm volatile("s_waitcnt vmcnt(0)" ::: "memory");
        }
        asm volatile("" ::: "memory"); __builtin_amdgcn_s_barrier(); asm volatile("" ::: "memory");
    }
};
template <bool MOE> struct FfnRows { const int* list;
    __device__ __forceinline__ bool a_gather(const SUnit& u) const { return MOE && u.kind == 0; }
    __device__ __forceinline__ unsigned arow(const SUnit& u, int r) const { int idx = u.pm * 256 + r; idx = idx < u.x1 ? idx : u.x1 - 1; return (unsigned)WS_H + (unsigned)list[u.grp * NL + idx] * (D * 2u); } };

template <bool MOE> struct EpiFfn {
    static constexpr bool PERM = true; static constexpr int MIDK = 0;
    unsigned char* ws; float* xl; const float* mod_l;
    __device__ __forceinline__ void operator()(const f32x4 (&acc)[2][2][4][2], const SUnit& u, int wr, int wc, int fr, int fq) const {
        if (u.kind == 0) {
            constexpr int ld = MOE ? DFFE : DFF0;
            bf16_t* act = (bf16_t*)(ws + WS_ACT);
            const int col = u.pn * 128 + wc * 32 + 8 * fq;
#pragma unroll
            for (int ai = 0; ai < 2; ++ai)
#pragma unroll
                for (int m = 0; m < 4; ++m) { const size_t row = (size_t)(u.x0 + ai * 128 + wr * 64 + m * 16 + fr);
                    float o[8];
#pragma unroll
                    for (int n = 0; n < 2; ++n)
#pragma unroll
                        for (int q = 0; q < 4; ++q) { const float gv = acc[ai][0][m][n][q], uv = acc[ai][1][m][n][q]; o[4 * n + q] = gv * sigmoidf_(gv) * uv; }
                    u32x4 w; w.x = cvt_pk_bf16(o[0], o[1]); w.y = cvt_pk_bf16(o[2], o[3]); w.z = cvt_pk_bf16(o[4], o[5]); w.w = cvt_pk_bf16(o[6], o[7]);
                    pg8::st16_wt(ws, (unsigned)WS_ACT + ((unsigned)row * (unsigned)ld + (unsigned)col) * 2u, w); }
        } else if (MOE) {
            bf16_t* O = (bf16_t*)(ws + WS_DOUT);
#pragma unroll
            for (int ai = 0; ai < 2; ++ai)
#pragma unroll
                for (int m = 0; m < 4; ++m) { const size_t row = (size_t)(u.x0 + ai * 128 + wr * 64 + m * 16 + fr);
#pragma unroll
                    for (int bj = 0; bj < 2; ++bj) { const int col = u.pn * 256 + bj * 128 + wc * 32 + 8 * fq; const f32x4 v0 = acc[ai][bj][m][0], v1 = acc[ai][bj][m][1];
                        u32x4 w; w.x = cvt_pk_bf16(v0[0], v0[1]); w.y = cvt_pk_bf16(v0[2], v0[3]); w.z = cvt_pk_bf16(v1[0], v1[1]); w.w = cvt_pk_bf16(v1[2], v1[3]);
                        *(u32x4*)(O + row * D + col) = w; } }
        } else {
            asm volatile("" : "+v"(fr), "+v"(fq));
            const int pmg = u.x0 >> 8;
            const int v = pmg < 32 ? 0 : (pmg < 64 ? 1 : 2);
            const float* gate = mod_l + v * MODSZ + 5 * D;
            float* xo = pmg < 64 ? xl + (size_t)u.x0 * D : (float*)(ws + WS_XC) + (size_t)(u.x0 - NL) * D;
#pragma unroll
            for (int bj = 0; bj < 2; ++bj) { const int col = u.pn * 256 + bj * 128 + wc * 32 + 8 * fq;
                const f32x4 g0 = *(const f32x4*)(gate + col), g1 = *(const f32x4*)(gate + col + 4);
#pragma unroll
                for (int ai = 0; ai < 2; ++ai)
#pragma unroll
                    for (int m = 0; m < 4; ++m) { const size_t o = (size_t)(ai * 128 + wr * 64 + m * 16 + fr) * D + col;
                        *(f32x4*)(xo + o) = *(const f32x4*)(xo + o) + g0 * acc[ai][bj][m][0];
                        *(f32x4*)(xo + o + 4) = *(const f32x4*)(xo + o + 4) + g1 * acc[ai][bj][m][1];
                        asm volatile("" ::: "memory"); __builtin_amdgcn_sched_barrier(0); } }
        }
    }
};

__device__ __forceinline__ int crow(int r, int hi) { return (r & 3) + 8 * (r >> 2) + 4 * hi; }
__device__ __forceinline__ s16x4 vtr(const LAS unsigned char* p) { typedef short v4i16_t __attribute__((ext_vector_type(4))); return __builtin_bit_cast(s16x4, __builtin_amdgcn_ds_read_tr16_b64_v4i16((LAS v4i16_t*)p)); }

__device__ __forceinline__ void attn_unit(Frame& F, int l, int b, int hkv, int qb, bool ctxq) {
    const int tid = F.tid, lane = F.lane, wid = F.wave, r32 = lane & 31, hi = lane >> 5;
    const int g = wid >> 1, qs = wid & 1, head = hkv * 4 + g;
    const bf16_t* Q = (const bf16_t*)(F.ws + WS_Q); const bf16_t* KB = (const bf16_t*)(F.ws + WS_KB); const bf16_t* VB = (const bf16_t*)(F.ws + WS_VB);
    const int q0 = qb * 64;
    const int qrow = (ctxq ? NL + b * CTXL : b * T) + q0 + qs * 32 + r32;
    bf16x8 qr[4];
#pragma unroll
    for (int d0 = 0; d0 < 4; ++d0) qr[d0] = *(const bf16x8*)(Q + (size_t)qrow * 512 + head * 64 + d0 * 16 + hi * 8);
    int jlo = 0, jhi = -1;
    if (!ctxq) { jlo = -2; jhi = 2; if (q0 + 64 * jlo < 0) jlo = -(q0 / 64); if (q0 + 64 * jhi >= T) jhi = (T - 64 - q0) / 64; }
    const int nloc = jhi - jlo + 1, ntile = nloc + 4;
    const float sinkv = F.in[9][l * 8 + head] * LOG2E;
    float mrun = sinkv, lrun = 1.0f;
    f32x16 o[2]; o[0] = f32x16{}; o[1] = f32x16{};
    const int kkey = lane, vkey = 16 * (wid & 3) + (lane >> 2);
    auto tile_row = [&](int ti) -> int { return ti < nloc ? b * T + q0 + 64 * (jlo + ti) : NL + b * CTXL + 64 * (ti - nloc); };
    u32x4 kreg, vreg;
    { const int r0 = tile_row(0); kreg = *(const u32x4*)(KB + (size_t)(r0 + kkey) * 128 + hkv * 64 + wid * 8); vreg = *(const u32x4*)(VB + (size_t)(r0 + vkey) * 128 + hkv * 64 + (wid >> 2) * 32 + (lane & 3) * 8); }
    for (int ti = 0; ti < ntile; ++ti) {
        LAS unsigned char* slot = F.lds + (ti & 1) * 16384;
        *(LAS u32x4*)(slot + wid * 1024 + lane * 16) = kreg;
        *(LAS u32x4*)(slot + 8192 + wid * 1024 + lane * 16) = vreg;
        __syncthreads();
        if (ti + 1 < ntile) { const int r0 = tile_row(ti + 1); kreg = *(const u32x4*)(KB + (size_t)(r0 + kkey) * 128 + hkv * 64 + wid * 8); vreg = *(const u32x4*)(VB + (size_t)(r0 + vkey) * 128 + hkv * 64 + (wid >> 2) * 32 + (lane & 3) * 8); }
        f32x16 p0 = f32x16{}, p1 = f32x16{};
        { const LAS unsigned char* kb = slot + hi * 1024 + r32 * 16;
#pragma unroll
          for (int d0 = 0; d0 < 4; ++d0) { const bf16x8 k0 = *(const LAS bf16x8*)(kb + d0 * 2048), k1 = *(const LAS bf16x8*)(kb + d0 * 2048 + 512);
              p0 = __builtin_amdgcn_mfma_f32_32x32x16_bf16(k0, qr[d0], p0, 0, 0, 0); p1 = __builtin_amdgcn_mfma_f32_32x32x16_bf16(k1, qr[d0], p1, 0, 0, 0); } }
        if (ti < nloc) { const int j = jlo + ti; const int qq = qs * 32 + r32;
            if (j == -2) {
#pragma unroll
                for (int r = 0; r < 16; ++r) { const int kk = crow(r, hi); if (kk < qq) p0[r] = -INFINITY; if (kk + 32 < qq) p1[r] = -INFINITY; } }
            else if (j == 2) {
#pragma unroll
                for (int r = 0; r < 16; ++r) { const int kk = crow(r, hi); if (kk > qq) p0[r] = -INFINITY; if (kk + 32 > qq) p1[r] = -INFINITY; } } }
        float mx = p0[0];
#pragma unroll
        for (int r = 1; r < 16; ++r) mx = fmaxf(mx, p0[r]);
#pragma unroll
        for (int r = 0; r < 16; ++r) mx = fmaxf(mx, p1[r]);
        mx = fmaxf(mx, __shfl_xor(mx, 32));
        const float mnew = fmaxf(mrun, mx), fsc = __builtin_amdgcn_exp2f(mrun - mnew);
        mrun = mnew;
        float rs = 0.f;
#pragma unroll
        for (int r = 0; r < 16; ++r) { p0[r] = __builtin_amdgcn_exp2f(p0[r] - mnew); p1[r] = __builtin_amdgcn_exp2f(p1[r] - mnew); rs += p0[r] + p1[r]; }
        rs += __shfl_xor(rs, 32);
        lrun = lrun * fsc + rs;
#pragma unroll
        for (int r = 0; r < 16; ++r) { o[0][r] *= fsc; o[1][r] *= fsc; }
        u32x4 pw[4];
        pw[0] = (u32x4){cvt_pk_bf16(p0[0], p0[1]), cvt_pk_bf16(p0[2], p0[3]), cvt_pk_bf16(p0[4], p0[5]), cvt_pk_bf16(p0[6], p0[7])};
        pw[1] = (u32x4){cvt_pk_bf16(p0[8], p0[9]), cvt_pk_bf16(p0[10], p0[11]), cvt_pk_bf16(p0[12], p0[13]), cvt_pk_bf16(p0[14], p0[15])};
        pw[2] = (u32x4){cvt_pk_bf16(p1[0], p1[1]), cvt_pk_bf16(p1[2], p1[3]), cvt_pk_bf16(p1[4], p1[5]), cvt_pk_bf16(p1[6], p1[7])};
        pw[3] = (u32x4){cvt_pk_bf16(p1[8], p1[9]), cvt_pk_bf16(p1[10], p1[11]), cvt_pk_bf16(p1[12], p1[13]), cvt_pk_bf16(p1[14], p1[15])};
        { const LAS unsigned char* vb = slot + 8192 + ((lane >> 4) & 1) * 32 + (lane & 3) * 8 + (4 * hi + ((lane & 15) >> 2)) * 64;
#pragma unroll
          for (int d0 = 0; d0 < 2; ++d0)
#pragma unroll
              for (int ks = 0; ks < 4; ++ks) { const s16x4 lo = vtr(vb + d0 * 4096 + ks * 1024), hh = vtr(vb + d0 * 4096 + ks * 1024 + 512);
                  const bf16x8 vf = (bf16x8){lo[0], lo[1], lo[2], lo[3], hh[0], hh[1], hh[2], hh[3]};
                  o[d0] = __builtin_amdgcn_mfma_f32_32x32x16_bf16(vf, __builtin_bit_cast(bf16x8, pw[ks]), o[d0], 0, 0, 0); } }
    }
    const float rl = 1.0f / lrun;
    bf16_t* orow = (bf16_t*)(F.ws + WS_FO) + (size_t)qrow * KM + 640 + head * 64;
#pragma unroll
    for (int d0 = 0; d0 < 2; ++d0)
#pragma unroll
        for (int rq = 0; rq < 4; ++rq) { u32x2 w; w.x = cvt_pk_bf16(o[d0][4 * rq] * rl, o[d0][4 * rq + 1] * rl); w.y = cvt_pk_bf16(o[d0][4 * rq + 2] * rl, o[d0][4 * rq + 3] * rl);
            *(u32x2*)(orow + 32 * d0 + 8 * rq + 4 * hi) = w; }
    __syncthreads();
}

__device__ __forceinline__ void attn_phase(Frame& F, int l) {
    const int nlat = NB * 2 * 128, nall = nlat + (l == 0 ? NB * 2 * 4 : 0);
    for (int it = F.bx; it < nall; it += F.G) {
        if (it < nlat) { const int qb = it & 127, hkv = (it >> 7) & 1, b = it >> 8; attn_unit(F, l, b, hkv, qb, false); }
        else { const int r = it - nlat; const int qb = r & 3, hkv = (r >> 2) & 1, b = r >> 3; attn_unit(F, l, b, hkv, qb, true); }
    }
}

#if !MK_MULTI
#define GRID_BAR() xcd_barrier(bar)
#else
#define GRID_BAR() do {} while (0)
#endif
#ifndef PH_MASK
#define PH_MASK 0xFFFFFu
#endif
#define IN(k) (((PH_MASK >> (k)) & 1u) && lo <= (k) && (k) < hi)
#define SEAM(k) do { if (IN((k) + 1)) GRID_BAR(); } while (0)
#ifndef REP_MASK
#define REP_MASK 0u
#endif
#define REPS(k) ((((REP_MASK) >> (k)) & 1u) ? 2 : 1)
template <int l, class BarT>
__device__ __forceinline__ void layer_phases(Frame& F, unsigned* ctl, const int lo, const int hi, const BarT& bar) {
        const int pb = 1 + 8 * l;
        bf16_t* H = (bf16_t*)(F.ws + WS_H);
        const float* xl_in = l == 0 ? F.in[0] : nullptr;
        bf16_t* XB = (bf16_t*)(F.ws + WS_XB);
        const float* xc_in = l == 0 ? F.in[2] : (const float*)(F.ws + WS_XC);
        float* xc = (float*)(F.ws + WS_XC);
        const float* mod_l = (const float*)ctl + CW_MOD + l * 3 * MODSZ;
        if (IN(pb + 0)) { for (int rep = 0; rep < REPS(pb + 0); ++rep) norm_phase<false>(F, l, 0, xl_in, xc_in, NTOK, l == 1 ? (const float*)(F.ws + WS_TMPC2) : nullptr, nullptr); SEAM(pb + 0); }
        if (IN(pb + 1)) {
            for (int rep = 0; rep < REPS(pb + 1); ++rep) {
            { pg8::Gemm g{H, (const bf16_t*)(F.ws + (l ? WS_WIN1 : WS_WIN0)) + (size_t)512 * D, D, D}; InprojSched S{F.G, F.bx, l}; EpiInproj E{F.ws}; pg8::NoGather R;
              pg8::gemm_phase(F.lds, g, S, E, R); }
            { pg8::Gemm g{(const bf16_t*)(F.ws + (l ? WS_WIN1 : WS_WIN0)), H, D, D}; UpermSched S{F.G, F.bx, l}; EpiUperm E{F.ws}; UpermRows R;
              pg8::gemm_phase(F.lds, g, S, E, R); }
            }
            SEAM(pb + 1);
        }
        if (IN(pb + 2)) {
            for (int rep = 0; rep < REPS(pb + 2); ++rep) {
            attn_phase(F, l);
            { pg8::Gemm g{(const bf16_t*)(F.ws + WS_UP), (const bf16_t*)(F.ws + WS_FA64), 128, 128}; GridSched S{256, 1, F.G, F.bx, 256u * 128u * 2u, 0u}; EpiStepA E{F.ws}; pg8::NoGather R;
              pg8::gemm_phase(F.lds, g, S, E, R); }
            if (l == 0) { pg8::Gemm g{(const bf16_t*)(F.ws + WS_VCT), (const bf16_t*)(F.ws + WS_TX), 512, 512}; GridSched S{2, 2, F.G, (F.bx + F.G - 16) % F.G, 256u * 512u * 2u, 256u * 512u * 2u}; EpiStepC<true> E{F.ws}; pg8::NoGather R;
              pg8::gemm_phase(F.lds, g, S, E, R); }
            }
            SEAM(pb + 2);
        }
        if (IN(pb + 3)) {
            for (int rep = 0; rep < REPS(pb + 3); ++rep) {
            { pg8::Gemm g{(const bf16_t*)(F.ws + WS_GP), (const bf16_t*)(F.ws + WS_TC), 256, 256}; GridSched S{128, 1, F.G, F.bx, 256u * 256u * 2u, 0u}; EpiStepC<false> E{F.ws}; pg8::NoGather R;
              pg8::gemm_phase(F.lds, g, S, E, R); }
            if (l == 0) { pg8::Gemm g{(const bf16_t*)(F.ws + WS_FO), (const bf16_t*)(F.ws + WS_WM0), KM, KM}; CtxSched S{F.G, (F.bx + F.G - 128) % F.G, 4, 256u * KM * 2u, 256u * KM * 2u, 1, 0u}; EpiMerge E{F.ws}; pg8::NoGather R;
              pg8::gemm_phase(F.lds, g, S, E, R); }
            }
            SEAM(pb + 3);
        }
        if (IN(pb + 4)) {
            const int nM = 64;
            pg8::Gemm g{(const bf16_t*)(F.ws + WS_FO), (const bf16_t*)(F.ws + (l ? WS_WM1 : WS_WM0)), KM, KM}; GridSched S{nM, 4, F.G, F.bx, 256u * KM * 2u, 256u * KM * 2u}; EpiMerge E{F.ws}; pg8::NoGather R;
            for (int rep = 0; rep < REPS(pb + 4); ++rep) pg8::gemm_phase(F.lds, g, S, E, R);
            SEAM(pb + 4);
        }
        if (IN(pb + 5)) {
            EpiResid E{xl_in, XB, XB, xc_in, xc, mod_l, 2, (float*)(F.ws + WS_TMPC1)}; pg8::NoGather R;
            { pg8::Gemm g{(const bf16_t*)(F.ws + WS_Y), (const bf16_t*)(F.ws + (l ? WS_WO1 : WS_WO0)), D, D}; GridSched S{64, 4, F.G, F.bx, 256u * D * 2u, 256u * D * 2u};
              pg8::gemm_phase(F.lds, g, S, E, R); }
            if (l == 0) { pg8::Gemm g{(const bf16_t*)(F.ws + WS_Y), (const bf16_t*)(F.ws + WS_WO0), D / 2, D}; CtxSched S{F.G, F.bx, 4, 256u * D * 2u, 256u * D * 2u, 2, (unsigned)D};
              pg8::gemm_phase(F.lds, g, S, E, R); }
            SEAM(pb + 5);
        }
        if (IN(pb + 6)) {
            if (l == 0) norm_phase<false>(F, l, 1, nullptr, xc, NTOK, (const float*)(F.ws + WS_TMPC1), xc); else { norm_phase<true>(F, l, 1, nullptr, xc, NL); moe_convert(F, 0); }
            SEAM(pb + 6);
        }
#ifndef STREAM0
#define STREAM0 0
#endif
#ifndef STREAM1
#define STREAM1 0
#endif
        if (IN(pb + 7)) {
            volatile LAS unsigned* lw = (volatile LAS unsigned*)(F.lds + MISC_OFF) + 16;
            if (l == 0) {
#if STREAM0
                FfnStream<9, false> S;
#pragma unroll
                for (int g = 0; g < 9; ++g) { S.P[g] = g < 8 ? 8 : 2; S.rb[g] = 2048 * g; S.cn[g] = g < 8 ? 2048 : 512; }
                S.nNgu = 22; S.Kdn = DFF0; S.need = 22u * 8u; S.q = ctl + CW_QUEUE; S.lw = lw; S.rdy = ctl + CW_RDY; S.tmo = ctl + 2; S.finish_init(F.G);
                EpiFfn<false> E{F.ws, F.out, mod_l}; FfnRows<false> R{nullptr};
                pg8::gemm_stream(F.lds, (const char*)F.ws, S, E, R);
#else
                { pg8::Gemm g{H, (const bf16_t*)(F.ws + WS_WGUD), D, D}; RowSched S{66, 22, F.G, F.bx, 256u * D * 2u, 256u * D * 2u}; EpiSwiglu E{(bf16_t*)(F.ws + WS_ACT), DFF0}; pg8::NoGather R;
                  pg8::gemm_phase(F.lds, g, S, E, R); }
                GRID_BAR();
                { EpiResid E{nullptr, XB, XB, xc, xc, mod_l, 5, (float*)(F.ws + WS_TMPC2)}; pg8::NoGather R;
                  { pg8::Gemm g{(const bf16_t*)(F.ws + WS_ACT), (const bf16_t*)(F.ws + WS_WDD), DFF0, DFF0}; GridSched S{64, 4, F.G, F.bx, 256u * DFF0 * 2u, 256u * DFF0 * 2u};
                    pg8::gemm_phase(F.lds, g, S, E, R); }
                  { pg8::Gemm g{(const bf16_t*)(F.ws + WS_ACT), (const bf16_t*)(F.ws + WS_WDD), DFF0 / 2, DFF0}; CtxSched S{F.G, F.bx, 4, 256u * DFF0 * 2u, 256u * DFF0 * 2u, 2, (unsigned)DFF0};
                    pg8::gemm_phase(F.lds, g, S, E, R); } }

#endif
            } else {
#if STREAM1
                FfnStream<8, true> S; { int bacc = 0;
#pragma unroll
                for (int e = 0; e < NE; ++e) { const int c = (int)ctl[CW_CNT + 64 * e]; S.cn[e] = c; S.P[e] = (c + 255) >> 8; S.rb[e] = bacc; bacc += ((c + 255) >> 8) << 8; } }
                S.nNgu = 28; S.Kdn = DFFE; S.need = 28u * 8u; S.q = ctl + CW_QUEUE + 64; S.lw = lw; S.rdy = ctl + CW_RDY + 64 * 80; S.tmo = ctl + 2; S.finish_init(F.G);
                EpiFfn<true> E{F.ws, F.out, mod_l}; FfnRows<true> R{(const int*)(F.ws + WS_LIST)};
                pg8::gemm_stream(F.lds, (const char*)F.ws, S, E, R);
#else
                { pg8::Gemm g{H, (const bf16_t*)(F.ws + WS_WGUE), D, D}; MoeSched S; S.G = F.G; S.c = F.bx; S.nN = 28; S.ksplit = 1; S.trim = 0; S.khbytes = 0; S.bexp = 2u * DFFE * D * 2u; S.bbytes = 256u * D * 2u; S.arow_bytes = 0; S.a_slots = false; S.init(ctl + CW_CNT);
                  EpiSwiglu E{(bf16_t*)(F.ws + WS_ACT), DFFE}; MoeRows R{(const int*)(F.ws + WS_LIST)};
                  pg8::gemm_phase(F.lds, g, S, E, R); }
                moe_convert(F, 1);
                GRID_BAR();
                { const int trim = moe_tail_panels(ctl + CW_CNT, F.G);
                  MoeSched S; S.G = F.G; S.c = F.bx; S.nN = 4; S.ksplit = 1; S.trim = trim; S.khbytes = 0; S.bexp = (unsigned)D * DFFE * 2u; S.bbytes = 256u * DFFE * 2u; S.arow_bytes = DFFE * 2u; S.a_slots = true; S.init(ctl + CW_CNT);
                  { pg8::Gemm g{(const bf16_t*)(F.ws + WS_ACT), (const bf16_t*)(F.ws + WS_WDE), DFFE, DFFE};
                    EpiBf16 E{(bf16_t*)(F.ws + WS_DOUT), (bf16_t*)(F.ws + WS_DOUT), D}; pg8::NoGather R;
                    pg8::gemm_phase(F.lds, g, S, E, R); }
                  if (trim > 0) {
                    const int plast = (S.cnt[NE - 1] + 255) >> 8;
                    pg8::Gemm g{(const bf16_t*)(F.ws + WS_ACT), (const bf16_t*)(F.ws + WS_WDE), DFFE / 4, DFFE};
                    MoeTailSched T{F.G, F.bx, trim, plast, S.base[NE - 1], (unsigned)D * DFFE * 2u};
                    EpiTail E{(bf16_t*)(F.ws + WS_DOUT), (bf16_t*)(F.ws + WS_DOUT1), S.base[NE - 1] + (plast - trim) * 256}; pg8::NoGather R;
                    pg8::gemm_phase(F.lds, g, T, E, R); } }
#endif
            }
            SEAM(pb + 7);
        }
}

constexpr int NPHASE = 18;
__global__ void __launch_bounds__(NTHR, 2) fwd_kernel(Args args) {
    extern __shared__ __attribute__((aligned(16))) unsigned char lds_raw[];
    Frame F;
    F.lds = (LAS unsigned char*)lds_raw; F.ws = args.ws; F.in = args.in; F.out = args.out;
    F.tid = threadIdx.x; F.lane = F.tid & 63; F.wave = __builtin_amdgcn_readfirstlane(F.tid >> 6); F.G = gridDim.x; F.bx = blockIdx.x;
    volatile LAS unsigned* MISC = (volatile LAS unsigned*)(F.lds + MISC_OFF);
    if (F.tid < 32) MISC[F.tid] = 0u;
    __syncthreads();
    unsigned* ctl = (unsigned*)(F.ws + WS_CTL);
#if !MK_MULTI
    XcdBarrier bar = xcd_barrier_post(ctl + CW_BAR, MISC + 8);
#else
    XcdBarrier bar; bar.bar = ctl + CW_BAR; bar.x = 0; bar.st = MISC + 8;
#endif
    const int lo = args.ph_lo, hi = args.ph_hi;
    if (IN(0)) { for (int rep = 0; rep < REPS(0); ++rep) { p0_prologue(F); __syncthreads(); } SEAM(0); }
    layer_phases<0>(F, ctl, lo, hi, bar);
    layer_phases<1>(F, ctl, lo, hi, bar);
    if (IN(17)) final_phase(F);
}

extern "C" void kernel_launch(void* const* d_in, const int* in_sizes, int n_in, void* d_out, int out_size, void* d_ws, size_t ws_size, hipStream_t stream) {
    static int grid = 0;
    if (grid == 0) {
        if (n_in != 21 || out_size != NL * D || ws_size < WS_END) { fprintf(stderr, "kernel_launch: unexpected problem (n_in %d out %d ws %zu)\n", n_in, out_size, ws_size); grid = -1; return; }
        int dev = 0, cus = 0;
        hipGetDevice(&dev); hipDeviceGetAttribute(&cus, hipDeviceAttributeMultiprocessorCount, dev);
        if (hipFuncSetAttribute((const void*)fwd_kernel, hipFuncAttributeMaxDynamicSharedMemorySize, LDS_BYTES) != hipSuccess) { fprintf(stderr, "kernel_launch: hipFuncSetAttribute failed\n"); grid = -1; return; }
        int per_cu = 0; (void)hipOccupancyMaxActiveBlocksPerMultiprocessor(&per_cu, (const void*)fwd_kernel, NTHR, LDS_BYTES); (void)hipGetLastError();
        grid = cus;
    }
    if (grid < 0) return;
    hipMemsetAsync((char*)d_ws + WS_CTL, 0, CTL_BYTES, stream);
#ifdef DBG_SCRUB
    hipMemsetAsync((char*)d_ws + CTL_BYTES, 0, WS_END - CTL_BYTES, stream);
#endif
    Args a{};
    for (int i = 0; i < 21; ++i) a.in[i] = (const float*)d_in[i];
    a.out = (float*)d_out; a.ws = (unsigned char*)d_ws;
#if MK_MULTI
    for (int p = 0; p < NPHASE; ++p) { a.ph_lo = p; a.ph_hi = p + 1; hipLaunchKernelGGL(fwd_kernel, dim3(grid), dim3(NTHR), LDS_BYTES, stream, a); }
#else
    a.ph_lo = 0; a.ph_hi = NPHASE;
    hipLaunchKernelGGL(fwd_kernel, dim3(grid), dim3(NTHR), LDS_BYTES, stream, a);
#endif
}
```

```cpp
#include <hip/hip_runtime.h>
#include <cstdio>
#include <cstdint>

#define LAS __attribute__((address_space(3)))
#define GAS __attribute__((address_space(1)))
typedef unsigned short bf16_t;
typedef short bf16x8 __attribute__((ext_vector_type(8)));
typedef short s16x4 __attribute__((ext_vector_type(4)));
typedef float f32x4 __attribute__((ext_vector_type(4)));
typedef float f32x2 __attribute__((ext_vector_type(2)));
typedef float f32x16 __attribute__((ext_vector_type(16)));
typedef unsigned u32x4 __attribute__((ext_vector_type(4)));
typedef unsigned u32x2 __attribute__((ext_vector_type(2)));

#ifndef MK_MULTI
#define MK_MULTI 0
#endif

constexpr int D = 1024, T = 8192, NB = 2, NL = NB * T, CTXL = 256, NC = NB * CTXL, NTOK = NL + NC;
constexpr int INW = 3328, OFFQ = 512, OFFK = 1024, OFFV = 1152, OFFG = 1280;
constexpr int DFF0 = 2816, DFFE = 3584, NE = 8;
constexpr int KM = 1152;
constexpr int MOE_ROWS = 2 * NL + NE * 256;
constexpr float EPS = 1e-6f;
constexpr float LOG2E = 1.4426950408889634f;
constexpr float QSCALE = 0.125f * LOG2E;

constexpr size_t MiB = 1u << 20, KiB = 1u << 10;
constexpr size_t WS_CTL = 0, CTL_BYTES = 1 * MiB;
constexpr size_t WS_ROPE = 1 * MiB, WS_TW = WS_ROPE + 32 * KiB, WS_FA64 = WS_ROPE + 96 * KiB, WS_TC = WS_ROPE + 160 * KiB, WS_TX = WS_ROPE + 288 * KiB;
constexpr size_t WS_TOKE = 2 * MiB, WS_TOKR = WS_TOKE + 128 * KiB, WS_TOKW = WS_TOKE + 256 * KiB, WS_LIST = WS_TOKE + 384 * KiB;
constexpr size_t WS_XC = 3 * MiB, WS_VCT = 5 * MiB;
constexpr size_t WS_WIN0 = 6 * MiB, WS_WM0 = WS_WIN0 + 13 * MiB / 2, WS_WO0 = 17 * MiB, WS_WGUD = 19 * MiB, WS_WDD = 30 * MiB;
constexpr size_t WS_WIN1 = 36 * MiB, WS_WM1 = WS_WIN1 + 13 * MiB / 2, WS_WO1 = 47 * MiB;
constexpr size_t WS_H = 49 * MiB;
constexpr size_t WS_DOUT = 6 * MiB;
constexpr size_t WS_WGUE = 82 * MiB, WS_WDE = 194 * MiB;
constexpr size_t WS_DOUT1 = WS_WGUE;
constexpr size_t WS_R1 = 250 * MiB;
constexpr size_t WS_UP = WS_R1, WS_Q = 266 * MiB, WS_KB = 283 * MiB, WS_VB = 288 * MiB, WS_GF = 293 * MiB, WS_GA = 326 * MiB, WS_GP = 359 * MiB, WS_FO = 375 * MiB, WS_Y = 413 * MiB;
constexpr size_t WS_ACT = WS_R1;
constexpr size_t WS_TMPC1 = 446 * MiB, WS_TMPC2 = 448 * MiB;
constexpr size_t WS_XB = 490 * MiB;
constexpr size_t WS_END = 523 * MiB;
static_assert(WS_DOUT + (size_t)MOE_ROWS * D * 2 <= WS_WGUE, "DOUT overlay");
static_assert(WS_ACT + (size_t)MOE_ROWS * DFFE * 2 <= WS_END, "ACT");
static_assert(WS_FO + (size_t)NTOK * KM * 2 <= WS_Y, "FO");
constexpr int CW_BAR = 4096, CW_CNT = 8192, CW_MOD = 16384;
constexpr int MODSZ = 6 * D;

constexpr int RING_BYTES = 131072, MISC_OFF = RING_BYTES + 320, LDS_BYTES = 147456;
constexpr int NWAVES = 8, NTHR = 512;

__device__ __forceinline__ unsigned f2bf(float f) { unsigned u = __builtin_bit_cast(unsigned, f); return (u + 0x7fffu + ((u >> 16) & 1u)) >> 16; }
__device__ __forceinline__ unsigned pk2(float lo, float hi) { return f2bf(lo) | (f2bf(hi) << 16); }
__device__ __forceinline__ unsigned cvt_pk_bf16(float lo, float hi) { unsigned r; asm volatile("v_cvt_pk_bf16_f32 %0, %1, %2" : "=v"(r) : "v"(lo), "v"(hi)); return r; }
__device__ __forceinline__ float bf2f(unsigned short h) { return __builtin_bit_cast(float, (unsigned)h << 16); }
__device__ __forceinline__ float bflo(unsigned w) { return __builtin_bit_cast(float, w << 16); }
__device__ __forceinline__ float bfhi(unsigned w) { return __builtin_bit_cast(float, w & 0xffff0000u); }
__device__ __forceinline__ float wave_sum(float v) {
#pragma unroll
    for (int o = 1; o < 64; o <<= 1) v += __shfl_xor(v, o);
    return v;
}
__device__ __forceinline__ float sigmoidf_(float x) { return __builtin_amdgcn_rcpf(1.0f + __builtin_amdgcn_exp2f(-x * LOG2E)); }
#define LDS_WAIT() asm volatile("s_waitcnt lgkmcnt(0)" ::: "memory")
#define VM_WAIT() asm volatile("s_waitcnt vmcnt(0)" ::: "memory")

#define XB_TMO      128
#define XB_XCNT(j)  (256  + 64 * (j))
#define XB_XSUB(j)  (1280 + 64 * (j))
#define XB_XGEN(j)  (2304 + 64 * (j))
#define XB_TOP      3328
#define XB_TOPGEN   3392
#define XCD_BAR_WORDS 3456
#define XB_SPIN_CAP (1u << 18)
__device__ __forceinline__ unsigned xb_ld(unsigned* p)              { return __hip_atomic_load(p, __ATOMIC_RELAXED, __HIP_MEMORY_SCOPE_AGENT); }
__device__ __forceinline__ unsigned xb_add(unsigned* p, unsigned v) { return __hip_atomic_fetch_add(p, v, __ATOMIC_RELAXED, __HIP_MEMORY_SCOPE_AGENT); }
__device__ __forceinline__ unsigned xb_xcc_id() { return (unsigned)__builtin_amdgcn_s_getreg((3 << 11) | 20) & 0xFu; }
#define XB_SPIN(cond, bar) do { unsigned _sp = 0; while (cond) { __builtin_amdgcn_s_sleep(1); \
    if ((++_sp & 255u) == 0u) { if (xb_ld(&(bar)[XB_TMO])) break; if (_sp > XB_SPIN_CAP) { atomicAdd(&(bar)[XB_TMO], 1u); break; } } } } while (0)
struct XcdBarrier { unsigned* bar; unsigned x; volatile LAS unsigned* st; };
__device__ __forceinline__ XcdBarrier xcd_barrier_post(unsigned* bar, volatile LAS unsigned* st) {
    XcdBarrier b; b.bar = bar; b.x = xb_xcc_id(); b.st = st;
    if (threadIdx.x == 0) (void)xb_add(&bar[XB_XCNT(b.x)], 1u);
    return b;
}
__device__ __forceinline__ void xcd_barrier_complete(unsigned* bar, unsigned x, unsigned& nloc, unsigned& nx) {
    const unsigned G = gridDim.x * gridDim.y * gridDim.z;
    unsigned sum, cnt, mine, sp = 0u;
    for (;;) {
        sum = 0u; cnt = 0u; mine = 0u;
#pragma unroll
        for (unsigned j = 0; j < 16; ++j) { const unsigned c = xb_ld(&bar[XB_XCNT(j)]); sum += c; cnt += (c > 0u) ? 1u : 0u; mine = (j == x) ? c : mine; }
        if (sum == G) break;
        __builtin_amdgcn_s_sleep(1);
        if ((++sp & 255u) == 0u) { if (xb_ld(&bar[XB_TMO])) break; if (sp > XB_SPIN_CAP) { atomicAdd(&bar[XB_TMO], 1u); break; } }
    }
    nloc = mine > 0u ? mine : 1u; nx = cnt > 0u ? cnt : 1u;
}
__device__ __forceinline__ void xcd_barrier(const XcdBarrier& b) {
    asm volatile("s_waitcnt vmcnt(0)" ::: "memory");
    __syncthreads();
    if (threadIdx.x == 0) {
        unsigned* bar = b.bar;
        __builtin_amdgcn_s_waitcnt(0);
        unsigned nloc = b.st[0], nx = b.st[1];
        if (nloc == 0u) { xcd_barrier_complete(bar, b.x, nloc, nx); b.st[0] = nloc; b.st[1] = nx; }
        const unsigned old = xb_add(&bar[XB_XSUB(b.x)], 1u);
        const unsigned gen = old / nloc;
        if (old + 1u == (gen + 1u) * nloc) {
            __builtin_amdgcn_fence(__ATOMIC_RELEASE, "agent");
            asm volatile("s_waitcnt vmcnt(0)" ::: "memory");
            const unsigned og = xb_add(&bar[XB_TOP], 1u);
            const unsigned tg = og / nx;
            if (og + 1u == (tg + 1u) * nx) xb_add(&bar[XB_TOPGEN], 1u);
            else XB_SPIN(xb_ld(&bar[XB_TOPGEN]) == tg, bar);
            __builtin_amdgcn_fence(__ATOMIC_ACQUIRE, "agent");
            xb_add(&bar[XB_XGEN(b.x)], 1u);
            asm volatile("s_waitcnt vmcnt(0)" ::: "memory");
        } else {
            XB_SPIN(xb_ld(&bar[XB_XGEN(b.x)]) == gen, bar);
            __builtin_amdgcn_fence(__ATOMIC_ACQUIRE, "agent");
            asm volatile("s_waitcnt vmcnt(0)" ::: "memory");
        }
    }
    __syncthreads();
}

namespace pg8 {
constexpr int BM = 256, BK = 64, HALF = 128, HTB = HALF * BK * 2, STAGE_BYTES = 8 * HTB, NXCD = 8, WGM = 8;
__host__ __device__ __forceinline__ int lds_byte(int r, int c) { const int st = (r >> 4) * 2 + (c >> 5), rr = r & 15, cc = c & 31, ob = rr * 64 + cc * 2; return st * 1024 + (ob ^ (((ob >> 9) & 1) << 5)); }
__host__ __device__ __forceinline__ void stage_rc(int b, int& R, int& C) { const int st = b / 1024, sb = b % 1024, swz = sb ^ (((sb >> 9) & 1) << 5); R = (st >> 1) * 16 + swz / 64; C = (st & 1) * 32 + (swz % 64) / 2; }
__host__ __device__ __forceinline__ int perm32(int rho) { const int n = rho >> 4, i = rho & 15; return 8 * (i >> 2) + 4 * n + (i & 3); }

struct Unit { unsigned aoff, boff; int pm, pn, kind, x0, x1, kh; };
struct Gemm { const bf16_t* A; const bf16_t* Bt; int K; int ld; };

__device__ __forceinline__ void swz_map(int L, int nM, int nN, int& pm, int& pn) {
    const int nwg = nM * nN; int wgid = L;
    { const int q = nwg / NXCD, r = nwg % NXCD, xcd = wgid % NXCD, off = wgid / NXCD; wgid = (xcd < r ? xcd * (q + 1) : r * (q + 1) + (xcd - r) * q) + off; }
    const int nig = WGM * nN, gid = wgid / nig, fm = gid * WGM, gsz = (nM - fm) < WGM ? (nM - fm) : WGM;
    pm = fm + ((wgid % nig) % gsz); pn = (wgid % nig) / gsz;
}

struct NoGather { static constexpr bool GA = false, GB = false;
    __device__ __forceinline__ unsigned arow(const Unit&, int) const { return 0u; }
    __device__ __forceinline__ unsigned brow(const Unit&, int) const { return 0u; } };

template <class Epi, class Sched, class Rows>
__device__ __forceinline__ void gemm_phase(LAS unsigned char* lds, const Gemm g, const Sched& S, const Epi& E, const Rows& RW) {
    int tid_ = threadIdx.x; asm volatile("" : "+v"(tid_));
    const int tid = tid_, wid = __builtin_amdgcn_readfirstlane(tid >> 6), lane = tid & 63, wr = wid >> 2, wc = wid & 3, fr = lane & 15, fq = lane >> 4;
    int K_ = g.K; asm volatile("" : "+s"(K_));
    const int K = K_, nt = K / BK;
    int sR[2], sRb[2], sC[2];
#pragma unroll
    for (int i = 0; i < 2; ++i) { int R, C; stage_rc(tid * 16 + i * 8192, R, C); sR[i] = R; sC[i] = C; sRb[i] = (R & ~31) + perm32(R & 31); }
    unsigned voffA[2], voffB[2];
    const int LD = g.ld;
#pragma unroll
    for (int i = 0; i < 2; ++i) { voffA[i] = (unsigned)(sR[i] * LD + sC[i]) * 2u; voffB[i] = (unsigned)(sRb[i] * LD + sC[i]) * 2u; }
    const size_t kstep = (size_t)(BK * 2);
    const size_t hstep = (size_t)HALF * LD * 2;
    const unsigned ldsw = (unsigned)wid * 1024u;
    const int aoff = lds_byte(wr * 64 + fr, fq * 8), boff = lds_byte(wc * 32 + fr, fq * 8);
    struct Side { const char* base[2]; unsigned off[2][2]; };
#define PG8_SA(b, h) (((b) * 2 + (h)) * HTB)
#define PG8_SB(b, h) ((4 + (b) * 2 + (h)) * HTB)
#define PG8_STAGE(bufoff, side, h, kt) do { _Pragma("unroll") for (int _i = 0; _i < 2; ++_i) \
        __builtin_amdgcn_global_load_lds((const unsigned*)((side).base[h] + (size_t)(kt) * kstep + (side).off[h][_i]), (LAS unsigned*)(lds + (bufoff) + ldsw + _i * 8192), 16, 0, 0); } while (0)
#define PG8_LDA(dst, b, h) do { _Pragma("unroll") for (int m = 0; m < 4; ++m) _Pragma("unroll") for (int k = 0; k < 2; ++k) dst[m][k] = *(const LAS bf16x8*)(lds + PG8_SA(b, h) + aoff + m * 2048 + k * 1024); } while (0)
#define PG8_LDB(dst, b, h) do { _Pragma("unroll") for (int n = 0; n < 2; ++n) _Pragma("unroll") for (int k = 0; k < 2; ++k) dst[n][k] = *(const LAS bf16x8*)(lds + PG8_SB(b, h) + boff + n * 2048 + k * 1024); } while (0)
#define PG8_MMA(ai, bj, At, Bt) do { __builtin_amdgcn_s_setprio(1); _Pragma("unroll") for (int m = 0; m < 4; ++m) _Pragma("unroll") for (int n = 0; n < 2; ++n) _Pragma("unroll") for (int k = 0; k < 2; ++k) \
        acc[ai][bj][m][n] = __builtin_amdgcn_mfma_f32_16x16x32_bf16(Bt[n][k], At[m][k], acc[ai][bj][m][n], 0, 0, 0); __builtin_amdgcn_s_setprio(0); } while (0)
#define PG8_WAIT_V(n) asm volatile("s_waitcnt vmcnt(" #n ")" ::: "memory")
#define PG8_WAIT_L(n) asm volatile("s_waitcnt lgkmcnt(" #n ")" ::: "memory")
#define PG8_BAR __builtin_amdgcn_s_barrier()
#define PG8_SCHED __builtin_amdgcn_sched_barrier(0)
#define PG8_MKSIDES(u, sa, sb) do { \
        if constexpr (Rows::GA) { sa.base[0] = sa.base[1] = (const char*)g.A; _Pragma("unroll") for (int h = 0; h < 2; ++h) _Pragma("unroll") for (int i = 0; i < 2; ++i) sa.off[h][i] = RW.arow(u, h * HALF + sR[i]) + (unsigned)sC[i] * 2u; } \
        else { sa.base[0] = (const char*)g.A + (u).aoff; sa.base[1] = sa.base[0] + hstep; _Pragma("unroll") for (int h = 0; h < 2; ++h) _Pragma("unroll") for (int i = 0; i < 2; ++i) sa.off[h][i] = voffA[i]; } \
        if constexpr (Rows::GB) { sb.base[0] = sb.base[1] = (const char*)g.Bt; _Pragma("unroll") for (int h = 0; h < 2; ++h) _Pragma("unroll") for (int i = 0; i < 2; ++i) sb.off[h][i] = RW.brow(u, h * HALF + sRb[i]) + (unsigned)sC[i] * 2u; } \
        else { sb.base[0] = (const char*)g.Bt + (u).boff; sb.base[1] = sb.base[0] + hstep; _Pragma("unroll") for (int h = 0; h < 2; ++h) _Pragma("unroll") for (int i = 0; i < 2; ++i) sb.off[h][i] = voffB[i]; } } while (0)
    Unit cur, nxt; int ui = 0;
    if (!S.next(0, cur)) return;
    f32x4 acc[2][2][4][2];
#pragma unroll
    for (int a = 0; a < 2; ++a)
#pragma unroll
        for (int b = 0; b < 2; ++b)
#pragma unroll
            for (int m = 0; m < 4; ++m)
#pragma unroll
                for (int n = 0; n < 2; ++n) acc[a][b][m][n] = (f32x4){0.f, 0.f, 0.f, 0.f};
    bf16x8 At[4][2], B0[2][2], B1[2][2];
    Side cA, cB, nA, nB;
    PG8_MKSIDES(cur, cA, cB);
    PG8_STAGE(PG8_SB(0, 0), cB, 0, 0); PG8_STAGE(PG8_SB(0, 1), cB, 1, 0); PG8_STAGE(PG8_SA(0, 0), cA, 0, 0); PG8_STAGE(PG8_SA(0, 1), cA, 1, 0);
    if (wr == 1) PG8_BAR;
    PG8_WAIT_V(2); PG8_BAR;
    PG8_STAGE(PG8_SB(1, 0), cB, 0, 1); PG8_STAGE(PG8_SA(1, 0), cA, 0, 1); PG8_STAGE(PG8_SB(1, 1), cB, 1, 1);
    PG8_WAIT_V(6); PG8_BAR;
    for (;;) {
        const bool has_next = S.next(ui + 1, nxt);
        if (has_next) { PG8_MKSIDES(nxt, nA, nB); } else { nA = cA; nB = cB; }
        for (int t = 0; t < nt; t += 2) {
            const bool last = (t == nt - 2);
            if constexpr (Epi::MIDK > 0) { if (t == Epi::MIDK) E.mid(acc, cur, wr, wc, fr, fq); }
            Side a2, b2;
            a2.base[0] = last ? nA.base[0] : cA.base[0]; a2.base[1] = last ? nA.base[1] : cA.base[1];
            b2.base[0] = last ? nB.base[0] : cB.base[0]; b2.base[1] = last ? nB.base[1] : cB.base[1];
#pragma unroll
            for (int h = 0; h < 2; ++h)
#pragma unroll
                for (int i = 0; i < 2; ++i) { a2.off[h][i] = (Rows::GA && last) ? nA.off[h][i] : cA.off[h][i]; b2.off[h][i] = (Rows::GB && last) ? nB.off[h][i] : cB.off[h][i]; }
            const int k2 = last ? 0 : t + 2, k3 = k2 + 1;
            PG8_LDB(B0, 0, 0); PG8_LDB(B1, 0, 1); PG8_SCHED; PG8_LDA(At, 0, 0); PG8_STAGE(PG8_SA(1, 1), cA, 1, t + 1);
            PG8_WAIT_V(8); PG8_WAIT_L(0); PG8_BAR; PG8_MMA(0, 0, At, B0); PG8_MMA(0, 1, At, B1); PG8_BAR; PG8_SCHED;
            PG8_LDA(At, 0, 1); PG8_STAGE(PG8_SB(0, 0), b2, 0, k2); PG8_STAGE(PG8_SB(0, 1), b2, 1, k2); PG8_STAGE(PG8_SA(0, 0), a2, 0, k2);
            PG8_WAIT_V(8); PG8_WAIT_L(0); PG8_BAR; PG8_MMA(1, 0, At, B0); PG8_MMA(1, 1, At, B1); PG8_BAR; PG8_SCHED;
            PG8_LDB(B0, 1, 0); PG8_LDB(B1, 1, 1); PG8_SCHED; PG8_LDA(At, 1, 0); PG8_STAGE(PG8_SA(0, 1), a2, 1, k2);
            PG8_WAIT_V(8); PG8_WAIT_L(0); PG8_BAR; PG8_MMA(0, 0, At, B0); PG8_MMA(0, 1, At, B1); PG8_BAR; PG8_SCHED;
            PG8_LDA(At, 1, 1); PG8_STAGE(PG8_SB(1, 0), b2, 0, k3); PG8_STAGE(PG8_SB(1, 1), b2, 1, k3); PG8_STAGE(PG8_SA(1, 0), a2, 0, k3);
            PG8_WAIT_V(8); PG8_WAIT_L(0); PG8_BAR; PG8_MMA(1, 0, At, B0); PG8_MMA(1, 1, At, B1); PG8_BAR; PG8_SCHED;
        }
        if (wr == 0) PG8_BAR;
        E(acc, cur, wr, wc, fr, fq);
        if (!has_next) break;
#pragma unroll
        for (int a = 0; a < 2; ++a)
#pragma unroll
            for (int b = 0; b < 2; ++b)
#pragma unroll
                for (int m = 0; m < 4; ++m)
#pragma unroll
                    for (int n = 0; n < 2; ++n) acc[a][b][m][n] = (f32x4){0.f, 0.f, 0.f, 0.f};
        cur = nxt; cA = nA; cB = nB; ++ui;
        if (wr == 1) PG8_BAR;
    }
    PG8_WAIT_V(0);
    PG8_BAR;
#undef PG8_SA
#undef PG8_SB
#undef PG8_STAGE
#undef PG8_LDA
#undef PG8_LDB
#undef PG8_MMA
#undef PG8_WAIT_V
#undef PG8_WAIT_L
#undef PG8_BAR
#undef PG8_SCHED
#undef PG8_MKSIDES
}

struct SUnit { unsigned aoff, boff; int K; int pm, pn, kind, x0, x1, grp, dep, sig; };
__device__ __forceinline__ void st16_wt(unsigned char* wsbase, unsigned off, u32x4 v) {
    const __amdgpu_buffer_rsrc_t rsrc = __builtin_amdgcn_make_buffer_rsrc((void*)wsbase, 0, 0x7fffffff, 0x00020000);
    __builtin_amdgcn_raw_buffer_store_b128(v, rsrc, off, 0, 16); }

template <class Epi, class Sched, class Rows>
__device__ __forceinline__ void gemm_stream(LAS unsigned char* lds, const char* base, const Sched& S, const Epi& E, const Rows& RW) {
    int tid_ = threadIdx.x; asm volatile("" : "+v"(tid_));
    const int tid = tid_, wid = __builtin_amdgcn_readfirstlane(tid >> 6), lane = tid & 63, wr = wid >> 2, wc = wid & 3, fr = lane & 15, fq = lane >> 4;
    int sR[2], sRb[2], sC[2];
#pragma unroll
    for (int i = 0; i < 2; ++i) { int R, C; stage_rc(tid * 16 + i * 8192, R, C); sR[i] = R; sC[i] = C; sRb[i] = (R & ~31) + perm32(R & 31); }
    const size_t kstep = (size_t)(BK * 2);
    const unsigned ldsw = (unsigned)wid * 1024u;
    const int aoff = lds_byte(wr * 64 + fr, fq * 8), boff = lds_byte(wc * 32 + fr, fq * 8);
    struct Side { const char* base[2]; unsigned off[2][2]; };
#define PG8_SA(b, h) (((b) * 2 + (h)) * HTB)
#define PG8_SB(b, h) ((4 + (b) * 2 + (h)) * HTB)
#define PG8_STAGE(bufoff, side, h, kt) do { _Pragma("unroll") for (int _i = 0; _i < 2; ++_i) \
        __builtin_amdgcn_global_load_lds((const unsigned*)((side).base[h] + (size_t)(kt) * kstep + (side).off[h][_i]), (LAS unsigned*)(lds + (bufoff) + ldsw + _i * 8192), 16, 0, 0); } while (0)
#define PG8_LDA(dst, b, h) do { _Pragma("unroll") for (int m = 0; m < 4; ++m) _Pragma("unroll") for (int k = 0; k < 2; ++k) dst[m][k] = *(const LAS bf16x8*)(lds + PG8_SA(b, h) + aoff + m * 2048 + k * 1024); } while (0)
#define PG8_LDB(dst, b, h) do { _Pragma("unroll") for (int n = 0; n < 2; ++n) _Pragma("unroll") for (int k = 0; k < 2; ++k) dst[n][k] = *(const LAS bf16x8*)(lds + PG8_SB(b, h) + boff + n * 2048 + k * 1024); } while (0)
#define PG8_MMA(ai, bj, At, Bt) do { __builtin_amdgcn_s_setprio(1); _Pragma("unroll") for (int m = 0; m < 4; ++m) _Pragma("unroll") for (int n = 0; n < 2; ++n) _Pragma("unroll") for (int k = 0; k < 2; ++k) \
        acc[ai][bj][m][n] = __builtin_amdgcn_mfma_f32_16x16x32_bf16(Bt[n][k], At[m][k], acc[ai][bj][m][n], 0, 0, 0); __builtin_amdgcn_s_setprio(0); } while (0)
#define PG8_WAIT_V(n) asm volatile("s_waitcnt vmcnt(" #n ")" ::: "memory")
#define PG8_WAIT_L(n) asm volatile("s_waitcnt lgkmcnt(" #n ")" ::: "memory")
#define PG8_BAR __builtin_amdgcn_s_barrier()
#define PG8_SCHED __builtin_amdgcn_sched_barrier(0)
#define PG8_MKSIDES(un, sa, sb) do { const int K_ = (un).K; \
        if (RW.a_gather(un)) { sa.base[0] = sa.base[1] = base; _Pragma("unroll") for (int h = 0; h < 2; ++h) _Pragma("unroll") for (int i = 0; i < 2; ++i) sa.off[h][i] = RW.arow(un, h * HALF + sR[i]) + (unsigned)sC[i] * 2u; } \
        else { sa.base[0] = base + (un).aoff; sa.base[1] = sa.base[0] + (size_t)HALF * K_ * 2; _Pragma("unroll") for (int h = 0; h < 2; ++h) _Pragma("unroll") for (int i = 0; i < 2; ++i) sa.off[h][i] = (unsigned)(sR[i] * K_ + sC[i]) * 2u; } \
        sb.base[0] = base + (un).boff; sb.base[1] = sb.base[0] + (size_t)HALF * K_ * 2; _Pragma("unroll") for (int h = 0; h < 2; ++h) _Pragma("unroll") for (int i = 0; i < 2; ++i) sb.off[h][i] = (unsigned)(sRb[i] * K_ + sC[i]) * 2u; } while (0)
#define PG8_SIGNAL(idx) do { if (lane == 0) __hip_atomic_fetch_add(S.rdy + 64 * (idx), 1u, __ATOMIC_RELAXED, __HIP_MEMORY_SCOPE_AGENT); } while (0)
    SUnit cur, nxt;
    unsigned pend = 0u;
    const unsigned lw_addr = (unsigned)(size_t)S.lw;
    if (tid == 0) { S.lw[0] = __hip_atomic_fetch_add(S.q, 1u, __ATOMIC_RELAXED, __HIP_MEMORY_SCOPE_AGENT); pend = __hip_atomic_fetch_add(S.q, 1u, __ATOMIC_RELAXED, __HIP_MEMORY_SCOPE_AGENT); }
    __syncthreads();
    { const int L0 = __builtin_amdgcn_readfirstlane((int)S.lw[0]); if (!S.decode(L0, cur)) return; }
    f32x4 acc[2][2][4][2];
#pragma unroll
    for (int a = 0; a < 2; ++a)
#pragma unroll
        for (int b = 0; b < 2; ++b)
#pragma unroll
            for (int m = 0; m < 4; ++m)
#pragma unroll
                for (int n = 0; n < 2; ++n) acc[a][b][m][n] = (f32x4){0.f, 0.f, 0.f, 0.f};
    bf16x8 At[4][2], B0[2][2], B1[2][2];
    Side cA, cB, nA, nB;
    bool need_pro = true; int sig_idx = -1;
    PG8_MKSIDES(cur, cA, cB);
    for (;;) {
        if (need_pro) {
            if (cur.dep >= 0) S.a_ready(cur);
            PG8_STAGE(PG8_SB(0, 0), cB, 0, 0); PG8_STAGE(PG8_SB(0, 1), cB, 1, 0); PG8_STAGE(PG8_SA(0, 0), cA, 0, 0); PG8_STAGE(PG8_SA(0, 1), cA, 1, 0);
            if (wr == 1) PG8_BAR;
            PG8_WAIT_V(2); PG8_BAR;
            PG8_STAGE(PG8_SB(1, 0), cB, 0, 1); PG8_STAGE(PG8_SA(1, 0), cA, 0, 1); PG8_STAGE(PG8_SB(1, 1), cB, 1, 1);
            PG8_WAIT_V(6); PG8_BAR;
        }
        if (tid == 0) { asm volatile("s_nop 7\n\tds_write_b32 %1, %0\n\tglobal_atomic_add %0, %2, %3, %4 sc0" : "+v"(pend) : "v"(lw_addr), "v"(0u), "v"(1u), "s"(S.q) : "memory"); }
        PG8_WAIT_L(0); PG8_BAR; asm volatile("" ::: "memory");
        const int Ln = __builtin_amdgcn_readfirstlane((int)S.lw[0]);
        const bool has_next = S.decode(Ln, nxt), pre = has_next && nxt.dep < 0;
        if (pre) { PG8_MKSIDES(nxt, nA, nB); } else { nA = cA; nB = cB; }
        const int nt = cur.K / BK;
        for (int t = 0; t < nt; t += 2) {
            const bool last = (t == nt - 2);
            Side a2, b2;
            a2.base[0] = last ? nA.base[0] : cA.base[0]; a2.base[1] = last ? nA.base[1] : cA.base[1];
            b2.base[0] = last ? nB.base[0] : cB.base[0]; b2.base[1] = last ? nB.base[1] : cB.base[1];
#pragma unroll
            for (int h = 0; h < 2; ++h)
#pragma unroll
                for (int i = 0; i < 2; ++i) { a2.off[h][i] = last ? nA.off[h][i] : cA.off[h][i]; b2.off[h][i] = last ? nB.off[h][i] : cB.off[h][i]; }
            const int k2 = last ? 0 : t + 2, k3 = k2 + 1;
            if (t == 2 && sig_idx >= 0) { PG8_SIGNAL(sig_idx); sig_idx = -1; }
            PG8_LDB(B0, 0, 0); PG8_LDB(B1, 0, 1); PG8_SCHED; PG8_LDA(At, 0, 0); PG8_STAGE(PG8_SA(1, 1), cA, 1, t + 1);
            PG8_WAIT_V(8); PG8_WAIT_L(0); PG8_BAR; PG8_MMA(0, 0, At, B0); PG8_MMA(0, 1, At, B1); PG8_BAR; PG8_SCHED;
            PG8_LDA(At, 0, 1); PG8_STAGE(PG8_SB(0, 0), b2, 0, k2); PG8_STAGE(PG8_SB(0, 1), b2, 1, k2); PG8_STAGE(PG8_SA(0, 0), a2, 0, k2);
            PG8_WAIT_V(8); PG8_WAIT_L(0); PG8_BAR; PG8_MMA(1, 0, At, B0); PG8_MMA(1, 1, At, B1); PG8_BAR; PG8_SCHED;
            PG8_LDB(B0, 1, 0); PG8_LDB(B1, 1, 1); PG8_SCHED; PG8_LDA(At, 1, 0); PG8_STAGE(PG8_SA(0, 1), a2, 1, k2);
            PG8_WAIT_V(8); PG8_WAIT_L(0); PG8_BAR; PG8_MMA(0, 0, At, B0); PG8_MMA(0, 1, At, B1); PG8_BAR; PG8_SCHED;
            PG8_LDA(At, 1, 1); PG8_STAGE(PG8_SB(1, 0), b2, 0, k3); PG8_STAGE(PG8_SB(1, 1), b2, 1, k3); PG8_STAGE(PG8_SA(1, 0), a2, 0, k3);
            PG8_WAIT_V(8); PG8_WAIT_L(0); PG8_BAR; PG8_MMA(1, 0, At, B0); PG8_MMA(1, 1, At, B1); PG8_BAR; PG8_SCHED;
        }
        if (wr == 0) PG8_BAR;
        E(acc, cur, wr, wc, fr, fq);
        if (!has_next) { PG8_WAIT_V(0); if (cur.sig >= 0) PG8_SIGNAL(cur.sig); break; }
#pragma unroll
        for (int a = 0; a < 2; ++a)
#pragma unroll
            for (int b = 0; b < 2; ++b)
#pragma unroll
                for (int m = 0; m < 4; ++m)
#pragma unroll
                    for (int n = 0; n < 2; ++n) acc[a][b][m][n] = (f32x4){0.f, 0.f, 0.f, 0.f};
        if (pre) {
            sig_idx = cur.sig; need_pro = false; cur = nxt; cA = nA; cB = nB;
            if (wr == 1) PG8_BAR;
        } else {
            PG8_WAIT_V(0); if (cur.sig >= 0) PG8_SIGNAL(cur.sig);
            PG8_BAR; need_pro = true; cur = nxt; PG8_MKSIDES(cur, cA, cB);
        }
    }
    PG8_BAR;
#undef PG8_SA
#undef PG8_SB
#undef PG8_STAGE
#undef PG8_LDA
#undef PG8_LDB
#undef PG8_MMA
#undef PG8_WAIT_V
#undef PG8_WAIT_L
#undef PG8_BAR
#undef PG8_SCHED
#undef PG8_MKSIDES
#undef PG8_SIGNAL
}
}
using pg8::Unit;
using pg8::SUnit;

struct Args { const float* in[21]; float* out; unsigned char* ws; int ph_lo, ph_hi; };

struct Frame {
    LAS unsigned char* lds;
    unsigned char* ws;
    const float* const* in;
    float* out;
    int tid, lane, wave, G, bx;
};
__device__ __forceinline__ float* modp(const Frame& F, int l, int v) { return (float*)(F.ws + WS_CTL) + CW_MOD + (l * 3 + v) * MODSZ; }

__device__ __forceinline__ void p0_transpose_item(const float* W, int ldw, int k0, int c0, bf16_t* WT, int ldt, int drow, int lane) {
    const float* src = W + (size_t)k0 * ldw + c0 + lane;
    float v[64];
#pragma unroll
    for (int i = 0; i < 64; ++i) v[i] = src[(size_t)i * ldw];
    bf16_t* dst = WT + (size_t)drow * ldt + k0;
#pragma unroll
    for (int j = 0; j < 8; ++j) { u32x4 o; o.x = pk2(v[8 * j], v[8 * j + 1]); o.y = pk2(v[8 * j + 2], v[8 * j + 3]); o.z = pk2(v[8 * j + 4], v[8 * j + 5]); o.w = pk2(v[8 * j + 6], v[8 * j + 7]);
        *(u32x4*)(dst + 8 * j) = o; }
}

constexpr int CW_CONVQ = 12288 + 128;
constexpr int MOE_I_GE = 16 * 56, MOE_I_DE = 56 * 16, MOE_ITEMS = NE * (2 * MOE_I_GE + MOE_I_DE), MOE_BATCHES = MOE_ITEMS / 8;
__device__ __forceinline__ void moe_convert_batch(Frame& F, int which, int idx) {
    const float* const* in = F.in; const int ln = F.lane;
    int r = idx * 8 + F.wave;
    if (which == 0) { const int e = r / (2 * MOE_I_GE); r %= (2 * MOE_I_GE); const int up = r / MOE_I_GE; r %= MOE_I_GE; const int kb = r / 56, nb = r % 56, c0 = 64 * nb;
        p0_transpose_item(in[up ? 18 : 17] + (size_t)e * D * DFFE, DFFE, 64 * kb, c0, (bf16_t*)(F.ws + WS_WGUE) + (size_t)e * 2 * DFFE * D, D, (c0 >> 7) * 256 + up * 128 + (c0 & 127) + ln, ln); }
    else { const int e = r / MOE_I_DE; r %= MOE_I_DE; const int kb = r / 16, nb = r % 16;
        p0_transpose_item(in[19] + (size_t)e * DFFE * D, D, 64 * kb, 64 * nb, (bf16_t*)(F.ws + WS_WDE) + (size_t)e * D * DFFE, DFFE, 64 * nb + ln, ln); }
}
__device__ __forceinline__ void moe_convert(Frame& F, int which) {
    volatile LAS unsigned* lw = (volatile LAS unsigned*)(F.lds + MISC_OFF) + 20;
    unsigned* q = (unsigned*)(F.ws + WS_CTL) + CW_CONVQ + 64 * which;
    const int nb = which == 0 ? NE * 2 * MOE_I_GE / 8 : NE * MOE_I_DE / 8;
    for (;;) {
        __syncthreads();
        if (F.tid == 0) lw[0] = __hip_atomic_fetch_add(q, 1u, __ATOMIC_RELAXED, __HIP_MEMORY_SCOPE_AGENT);
        __syncthreads();
        const int idx = (int)lw[0];
        if (idx >= nb) break;
        moe_convert_batch(F, which, idx);
    }
    __syncthreads();
}

__device__ __forceinline__ void p0_prologue(Frame& F) {
    const float* const* in = F.in;
    const int gw = F.bx * NWAVES + F.wave, NGW = F.G * NWAVES;
    {
        constexpr int I_IN = 16 * 44, I_O = 16 * 16, I_GD = 16 * 44, I_DD = 44 * 16;
        constexpr int N_A = 2 * I_IN + 2 * I_O + 2 * I_GD + I_DD;
        const int ln = F.lane;
        for (int it = gw; it < N_A; it += NGW) {
            int r = it;
            if (r < 2 * I_IN) { const int l = r / I_IN; r %= I_IN; const int kb = r / 44, nb = r % 44, c0 = 512 + 64 * nb;
                const int n32 = ln & 31; const int dn = c0 < OFFV ? (ln & 32) + ((n32 < 16) ? 2 * n32 : 2 * (n32 - 16) + 1) : ln;
                p0_transpose_item(in[8] + (size_t)l * D * INW, INW, 64 * kb, c0, (bf16_t*)(F.ws + (l ? WS_WIN1 : WS_WIN0)), D, c0 + dn, ln); continue; }
            r -= 2 * I_IN;
            if (r < 2 * I_O) { const int l = r / I_O; r %= I_O; const int kb = r / 16, nb = r % 16;
                p0_transpose_item(in[12] + (size_t)l * D * D, D, 64 * kb, 64 * nb, (bf16_t*)(F.ws + (l ? WS_WO1 : WS_WO0)), D, 64 * nb + ln, ln); continue; }
            r -= 2 * I_O;
            if (r < 2 * I_GD) { const int up = r / I_GD; r %= I_GD; const int kb = r / 44, nb = r % 44, c0 = 64 * nb;
                p0_transpose_item(in[up ? 14 : 13], DFF0, 64 * kb, c0, (bf16_t*)(F.ws + WS_WGUD), D, (c0 >> 7) * 256 + up * 128 + (c0 & 127) + ln, ln); continue; }
            r -= 2 * I_GD;
            { const int kb = r / 16, nb = r % 16;
              p0_transpose_item(in[15], D, 64 * kb, 64 * nb, (bf16_t*)(F.ws + WS_WDD), DFF0, 64 * nb + ln, ln); }
        }
    }
    __syncthreads();
    {
        LAS float* wrow = (LAS float*)F.lds;
        LAS float* ctab = wrow + 4096;
        if (F.tid < 128) ctab[F.tid] = cospif((float)F.tid / 64.0f);
        for (int it = F.bx; it < 2 * 128; it += F.G) {
            const int l = it >> 7, d0 = (it & 127) * 8;
            __syncthreads();
            for (int i = F.tid; i < 4096; i += NTHR) wrow[i] = in[8][(size_t)l * D * INW + (size_t)(d0 + (i >> 9)) * INW + (i & 511)];
            __syncthreads();
            const int r = F.tid, j = r >> 1, ri = r & 1, g = j >> 6, jj = j & 63;
            float a[8];
#pragma unroll
            for (int q = 0; q < 8; ++q) a[q] = 0.f;
            for (int cc = 0; cc < 128; ++cc) {
                float cf;
                if (jj == 0) cf = ri ? ((cc & 1) ? -1.f : 1.f) : 1.f;
                else { const int idx = (cc * jj) & 127; cf = ri ? -ctab[(idx - 32) & 127] : ctab[idx]; }
#pragma unroll
                for (int q = 0; q < 8; ++q) a[q] += cf * wrow[q * 512 + g * 128 + cc];
            }
            u32x4 o; o.x = pk2(a[0], a[1]); o.y = pk2(a[2], a[3]); o.z = pk2(a[4], a[5]); o.w = pk2(a[6], a[7]);
            *(u32x4*)((bf16_t*)(F.ws + (l ? WS_WIN1 : WS_WIN0)) + (size_t)r * D + d0) = o;
        }
        __syncthreads();
    }
    const int gt = F.bx * NTHR + F.tid, NGT = F.G * NTHR;
    for (int it = gt; it < 2 * 1024 * 144; it += NGT) {
        const int l = it / (1024 * 144), r = it % (1024 * 144), kc = r / 1024, o = r % 1024;
        const float* wf = in[10] + (size_t)l * 512 * D; const float* wa = in[11] + (size_t)l * 512 * D;
        float v[8];
#pragma unroll
        for (int q = 0; q < 8; ++q) { const int k = kc * 8 + q; float x = 0.f;
            if (k < 512) { const int mm = k & 127; x = wf[(size_t)k * D + o] * ((mm == 0 || mm == 64) ? 0.5f : 1.f); }
            else if (k < 520) { const int gg = (k - 512) >> 1, sgn = (k - 512) & 1; x = 0.5f * wf[(size_t)(gg * 128 + 64 * sgn) * D + o]; }
            else if (k >= 640) x = wa[(size_t)(k - 640) * D + o];
            v[q] = x; }
        u32x4 w; w.x = pk2(v[0], v[1]); w.y = pk2(v[2], v[3]); w.z = pk2(v[4], v[5]); w.w = pk2(v[6], v[7]);
        *(u32x4*)((bf16_t*)(F.ws + (l ? WS_WM1 : WS_WM0)) + (size_t)o * KM + kc * 8) = w;
    }
    for (int it = gt; it < 192 * 16; it += NGT) {
        const int i = it & 15, p = it >> 4, pos = p < 128 ? p : p - 128;
        const float inv = powf(10000.0f, -(float)i / 16.0f), a = (float)pos * inv;
        ((f32x2*)(F.ws + WS_ROPE))[it] = (f32x2){cosf(a), sinf(a)};
    }
    for (int it = gt; it < 128 * 64; it += NGT) {
        const int t2 = it >> 6, k1 = it & 63; float s, c; sincospif((float)(t2 * k1) / 4096.0f, &s, &c);
        ((f32x2*)(F.ws + WS_TW))[it] = (f32x2){c, s};
    }
    for (int it = gt; it < 256 * 128; it += NGT) {
        const int nu = it >> 7, ka = it & 127; float v = 0.f;
        if (nu < 128) { const int k1 = nu >> 1, ro = nu & 1, ri = ka >> 6, t1 = ka & 63; float s, c; sincospif((float)((t1 * k1) & 63) / 32.0f, &s, &c);
            v = ro == 0 ? (ri == 0 ? c : s) : (ri == 0 ? -s : c); }
        ((bf16_t*)(F.ws + WS_FA64))[it] = (bf16_t)f2bf(v);
    }
    for (int it = gt; it < 256 * 256; it += NGT) {
        const int mu = it >> 8, la = it & 255, k2 = mu >> 1, ro = mu & 1, ri = la >> 7, t2 = la & 127; float s, c; sincospif((float)((t2 * k2) & 127) / 64.0f, &s, &c);
        const float v = (ro == 0 ? (ri == 0 ? c : s) : (ri == 0 ? -s : c)) * 0.0009765625f;
        ((bf16_t*)(F.ws + WS_TC))[it] = (bf16_t)f2bf(v);
    }
    for (int it = gt; it < 512 * 512; it += NGT) {
        const int mu = it >> 9, la = it & 511, k = mu >> 1, ro = mu & 1, ri = la >> 8, t = la & 255; float s, c; sincospif((float)((t * k) & 255) / 128.0f, &s, &c);
        const float v = (ro == 0 ? (ri == 0 ? c : s) : (ri == 0 ? -s : c)) * 0.005524271728019903f;
        ((bf16_t*)(F.ws + WS_TX))[it] = (bf16_t)f2bf(v);
    }
    __syncthreads();
    {
        LAS float* sl = (LAS float*)F.lds;
        LAS float* part = sl + 3 * D;
        for (int i = F.tid; i < 3 * D; i += NTHR) { const float c = i < 2 * D ? in[1][i] : in[3][i - 2 * D]; sl[i] = c / (1.0f + __expf(-c)); }
        __syncthreads();
        for (int it = F.bx; it < 2 * 96; it += F.G) {
            const int l = it / 96, n = (it % 96) * 64 + F.lane;
            const float* wm = in[4] + (size_t)l * D * MODSZ + (size_t)(F.wave * 128) * MODSZ + n;
            float a0 = 0.f, a1 = 0.f, a2 = 0.f;
#pragma unroll
            for (int d0 = 0; d0 < 128; d0 += 32) { float w[32];
#pragma unroll
                for (int q = 0; q < 32; ++q) w[q] = wm[(size_t)(d0 + q) * MODSZ];
#pragma unroll
                for (int q = 0; q < 32; ++q) { const int d = F.wave * 128 + d0 + q; a0 += sl[d] * w[q]; a1 += sl[D + d] * w[q]; a2 += sl[2 * D + d] * w[q]; } }
            __syncthreads();
            part[(F.wave * 3 + 0) * 64 + F.lane] = a0; part[(F.wave * 3 + 1) * 64 + F.lane] = a1; part[(F.wave * 3 + 2) * 64 + F.lane] = a2;
            __syncthreads();
            if (F.tid < 192) { const int v = F.tid >> 6, ln = F.tid & 63; float sacc = in[5][l * MODSZ + (it % 96) * 64 + ln];
#pragma unroll
                for (int w = 0; w < 8; ++w) sacc += part[(w * 3 + v) * 64 + ln];
                modp(F, l, v)[(it % 96) * 64 + ln] = sacc; }
        }
    }
    for (int it = gt; it < NTOK * 15; it += NGT) { const int row = it / 15, c = it % 15;
        *(u32x4*)((bf16_t*)(F.ws + WS_FO) + (size_t)row * KM + 520 + c * 8) = (u32x4){0u, 0u, 0u, 0u}; }
}

__device__ __forceinline__ const float* xrow_ptr(const Frame& F, int row, const float* xl) { return row < NL ? xl + (size_t)row * D : (const float*)(F.ws + WS_XC) + (size_t)(row - NL) * D; }

template <bool ROUTE>
__device__ __forceinline__ void norm_phase(Frame& F, int l, int which  , const float* xl, const float* xc, int nrows, const float* xcadd = nullptr, float* xcwb = nullptr) {
    const float* gvec = F.in[which ? 7 : 6] + l * D;
    LAS float* wr_l = (LAS float*)F.lds;
    if (ROUTE) { for (int i = F.tid; i < D * NE; i += NTHR) wr_l[i] = F.in[16][i]; __syncthreads(); }
    const int gw = F.bx * NWAVES + F.wave, NGW = F.G * NWAVES;
    for (int row = gw; row < nrows; row += NGW) {
        const int v = row < T ? 0 : (row < NL ? 1 : 2);
        const bool fromb = row < NL && xl == nullptr;
        const float* xr = row < NL ? (fromb ? xc : xl + (size_t)row * D) : xc + (size_t)(row - NL) * D;
        const bf16_t* xbr = (const bf16_t*)(F.ws + WS_XB) + (size_t)row * D;
        const float* sh = modp(F, l, v) + (which ? 3 : 0) * D; const float* sc = sh + D;
        f32x4 x[4]; float s = 0.f;
#pragma unroll
        for (int j = 0; j < 4; ++j) {
            if (fromb) { const u32x2 xb = *(const u32x2*)(xbr + 256 * j + 4 * F.lane); x[j] = (f32x4){bflo(xb.x), bfhi(xb.x), bflo(xb.y), bfhi(xb.y)}; }
            else x[j] = *(const f32x4*)(xr + 256 * j + 4 * F.lane);
            if (row >= NL && xcadd) { x[j] = x[j] + *(const f32x4*)(xcadd + (size_t)(row - NL) * D + 256 * j + 4 * F.lane); if (xcwb) *(f32x4*)(xcwb + (size_t)(row - NL) * D + 256 * j + 4 * F.lane) = x[j]; }
            s += (x[j].x * x[j].x + x[j].y * x[j].y) + (x[j].z * x[j].z + x[j].w * x[j].w); }
        const float r = 1.0f / sqrtf(wave_sum(s) * (1.f / D) + EPS);
        float lg[NE];
        if (ROUTE) {
#pragma unroll
            for (int e = 0; e < NE; ++e) lg[e] = 0.f; }
        bf16_t* hr = (bf16_t*)(F.ws + WS_H) + (size_t)row * D;
#pragma unroll
        for (int j = 0; j < 4; ++j) { const int c = 256 * j + 4 * F.lane;
            const f32x4 gg = *(const f32x4*)(gvec + c), s4 = *(const f32x4*)(sh + c), c4 = *(const f32x4*)(sc + c);
            f32x4 h = (x[j] * r) * gg; h = h * (c4 + 1.0f) + s4;
            u32x2 o; o.x = pk2(h.x, h.y); o.y = pk2(h.z, h.w); *(u32x2*)(hr + c) = o;
            if (ROUTE) {
#pragma unroll
                for (int q = 0; q < 4; ++q) { const float hv = h[q]; const LAS f32x4* w = (const LAS f32x4*)(wr_l + (c + q) * NE); const f32x4 w0 = w[0], w1 = w[1];
                    lg[0] += hv * w0.x; lg[1] += hv * w0.y; lg[2] += hv * w0.z; lg[3] += hv * w0.w; lg[4] += hv * w1.x; lg[5] += hv * w1.y; lg[6] += hv * w1.z; lg[7] += hv * w1.w; } }
        }
        if (ROUTE) {
#pragma unroll
            for (int e = 0; e < NE; ++e) lg[e] = wave_sum(lg[e]);
            if (F.lane == 0) {
                int e1 = 0; float v1 = lg[0];
#pragma unroll
                for (int e = 1; e < NE; ++e) if (lg[e] > v1) { v1 = lg[e]; e1 = e; }
                int e2 = -1; float v2 = -3.0e38f;
#pragma unroll
                for (int e = 0; e < NE; ++e) if (e != e1 && lg[e] > v2) { v2 = lg[e]; e2 = e; }
                const float p2 = __expf(v2 - v1), w1 = 1.f / (1.f + p2), w2 = p2 * w1;
                unsigned* cnt = (unsigned*)(F.ws + WS_CTL) + CW_CNT;
                const unsigned r1 = atomicAdd(cnt + 64 * e1, 1u), r2 = atomicAdd(cnt + 64 * e2, 1u);
                int* toke = (int*)(F.ws + WS_TOKE); int* tokr = (int*)(F.ws + WS_TOKR); float* tokw = (float*)(F.ws + WS_TOKW); int* list = (int*)(F.ws + WS_LIST);
                toke[2 * row] = e1; toke[2 * row + 1] = e2; tokr[2 * row] = (int)r1; tokr[2 * row + 1] = (int)r2; tokw[2 * row] = w1; tokw[2 * row + 1] = w2;
                list[e1 * NL + r1] = row; list[e2 * NL + r2] = row;
            }
        }
    }
}

constexpr int TAILQ_ROWS = 8 * 256;
__device__ __forceinline__ int moe_tail_panels(const unsigned* cw, int G) { int ptot = 0, plast = 0;
#pragma unroll
    for (int e = 0; e < NE; ++e) { const int p_ = ((int)cw[64 * e] + 255) >> 8; ptot += p_; plast = p_; }
    const int left = (4 * ptot) % G; int t = (left + 3) >> 2; if (4 * ptot < G) t = 0; if (t > plast) t = plast; if (t > 8) t = 8; return t; }
__device__ __forceinline__ void final_phase(Frame& F) {
    const int gw = F.bx * NWAVES + F.wave, NGW = F.G * NWAVES;
    const unsigned* cnt = (const unsigned*)(F.ws + WS_CTL) + CW_CNT;
    int base[NE]; { int b = 0;
#pragma unroll
        for (int e = 0; e < NE; ++e) { base[e] = b; b += ((int)cnt[64 * e] + 255) & ~255; } }
    const int* toke = (const int*)(F.ws + WS_TOKE); const int* tokr = (const int*)(F.ws + WS_TOKR); const float* tokw = (const float*)(F.ws + WS_TOKW);
    const bf16_t* dout = (const bf16_t*)(F.ws + WS_DOUT); const bf16_t* tq = (const bf16_t*)(F.ws + WS_DOUT1);
    const int trim_ = moe_tail_panels(cnt, F.G), trow0 = trim_ > 0 ? base[NE - 1] + ((((int)cnt[64 * (NE - 1)] + 255) >> 8) - trim_) * 256 : 0x7fffffff;
    for (int row = gw; row < NL; row += NGW) {
        const int v = row < T ? 0 : 1;
        const float* ga2 = modp(F, 1, v) + 5 * D;
        const int e1 = toke[2 * row], e2 = toke[2 * row + 1];
        int b1 = 0, b2 = 0;
#pragma unroll
        for (int e = 0; e < NE; ++e) { if (e == e1) b1 = base[e]; if (e == e2) b2 = base[e]; }
        const bf16_t* d1 = dout + (size_t)(b1 + tokr[2 * row]) * D; const bf16_t* d2 = dout + (size_t)(b2 + tokr[2 * row + 1]) * D;
        const int r1_ = b1 + tokr[2 * row], r2_ = b2 + tokr[2 * row + 1];
        const bool t1 = r1_ >= trow0, t2 = r2_ >= trow0;
        const bf16_t* q1 = tq + (size_t)(t1 ? r1_ - trow0 : 0) * D; const bf16_t* q2 = tq + (size_t)(t2 ? r2_ - trow0 : 0) * D;
        const float w1 = tokw[2 * row], w2 = tokw[2 * row + 1];
        float* xr = F.out + (size_t)row * D;
        f32x4 x[4]; float s = 0.f;
#pragma unroll
        for (int j = 0; j < 4; ++j) { const int c = 256 * j + 4 * F.lane;
            const u32x2 a = *(const u32x2*)(d1 + c), b = *(const u32x2*)(d2 + c); const f32x4 g4 = *(const f32x4*)(ga2 + c);
            f32x4 ya = (f32x4){bflo(a.x), bfhi(a.x), bflo(a.y), bfhi(a.y)}, yb = (f32x4){bflo(b.x), bfhi(b.x), bflo(b.y), bfhi(b.y)};
            if (t1) {
#pragma unroll
                for (int k = 0; k < 3; ++k) { const u32x2 e_ = *(const u32x2*)(q1 + (size_t)k * TAILQ_ROWS * D + c); ya = ya + (f32x4){bflo(e_.x), bfhi(e_.x), bflo(e_.y), bfhi(e_.y)}; } }
            if (t2) {
#pragma unroll
                for (int k = 0; k < 3; ++k) { const u32x2 e_ = *(const u32x2*)(q2 + (size_t)k * TAILQ_ROWS * D + c); yb = yb + (f32x4){bflo(e_.x), bfhi(e_.x), bflo(e_.y), bfhi(e_.y)}; } }
            const f32x4 y = ya * w1 + yb * w2;
            { const u32x2 xb = *(const u32x2*)((const bf16_t*)(F.ws + WS_XB) + (size_t)row * D + c); x[j] = (f32x4){bflo(xb.x), bfhi(xb.x), bflo(xb.y), bfhi(xb.y)} + g4 * y; }
            s += (x[j].x * x[j].x + x[j].y * x[j].y) + (x[j].z * x[j].z + x[j].w * x[j].w); }
        const float r = 1.0f / sqrtf(wave_sum(s) * (1.f / D) + EPS);
#pragma unroll
        for (int j = 0; j < 4; ++j) { const int c = 256 * j + 4 * F.lane; *(f32x4*)(xr + c) = (x[j] * r) * *(const f32x4*)(F.in[20] + c); }
    }
}

struct GridSched { int nM, nN, G, c; unsigned abytes, bbytes;
    __device__ __forceinline__ bool next(int i, Unit& u) const { const int L = i * G + c; if (L >= nM * nN) return false; pg8::swz_map(L, nM, nN, u.pm, u.pn); u.aoff = (unsigned)u.pm * abytes; u.boff = (unsigned)u.pn * bbytes; u.kind = 0; u.x0 = 0; u.x1 = 0; u.kh = 0; return true; } };

struct CtxSched { int G, c, nN; unsigned abytes, bbytes; int ksplit; unsigned khbytes;
    __device__ __forceinline__ bool next(int i, Unit& u) const { int L = i * G + c; if (L >= 2 * nN * ksplit) return false; u.kh = L / (2 * nN); L -= u.kh * 2 * nN; u.pm = 64 + L / nN; u.pn = L % nN;
        u.aoff = (unsigned)u.pm * abytes + (unsigned)u.kh * khbytes; u.boff = (unsigned)u.pn * bbytes + (unsigned)u.kh * khbytes; u.kind = 0; u.x0 = u.pm * 256; u.x1 = 0; return true; } };

struct InprojSched { int G, c, l;
    __device__ __forceinline__ bool next(int i, Unit& u) const { const int L = i * G + c; const int nmain = 64 * 11;
        if (L < nmain) { pg8::swz_map(L, 64, 11, u.pm, u.pn); }
        else { const int r = L - nmain; if (l == 0) { if (r >= 22) return false; u.pm = 64 + r / 11; u.pn = r % 11; } else { if (r >= 2) return false; u.pm = 64 + r; u.pn = 2; } }
        u.aoff = (unsigned)u.pm * (256u * D * 2u); u.boff = (unsigned)u.pn * (256u * D * 2u); u.kind = 0; u.x0 = 0; u.x1 = 0; u.kh = 0; return true; } };

struct EpiInproj {
    static constexpr bool PERM = true; static constexpr int MIDK = 0;
    unsigned char* ws;
    __device__ __forceinline__ void operator()(const f32x4 (&acc)[2][2][4][2], const Unit& u, int wr, int wc, int fr, int fq) const {
        const int row0 = u.pm * 256 + wr * 64 + fr;
        const bool lat = u.pm < 64;
        const f32x2* rope = (const f32x2*)(ws + WS_ROPE);
#pragma unroll
        for (int ai = 0; ai < 2; ++ai)
#pragma unroll
            for (int m = 0; m < 4; ++m) {
                const int row = row0 + ai * 128 + m * 16;
                const int t = row & (T - 1), prow = t >> 6, pcol = t & 63;
#pragma unroll
                for (int bj = 0; bj < 2; ++bj) {
                    const int cl = u.pn * 256 + bj * 128 + wc * 32 + 8 * fq;
                    f32x4 v0 = acc[ai][bj][m][0], v1 = acc[ai][bj][m][1];
                    bf16_t* dst;
                    if (cl < 640) {
                        if (lat) { const int dh = cl & 63, i0 = (dh & 31) >> 1; const f32x2* rp = rope + ((dh < 32 ? prow : 128 + pcol) * 16 + i0);
                            const f32x2 c0 = rp[0], c1 = rp[1], c2 = rp[2], c3 = rp[3];
                            f32x4 w0, w1; w0.x = v0.x * c0.x - v0.y * c0.y; w0.y = v0.x * c0.y + v0.y * c0.x; w0.z = v0.z * c1.x - v0.w * c1.y; w0.w = v0.z * c1.y + v0.w * c1.x;
                            w1.x = v1.x * c2.x - v1.y * c2.y; w1.y = v1.x * c2.y + v1.y * c2.x; w1.z = v1.z * c3.x - v1.w * c3.y; w1.w = v1.z * c3.y + v1.w * c3.x; v0 = w0; v1 = w1; }
                        if (cl < 512) { v0 = v0 * QSCALE; v1 = v1 * QSCALE; dst = (bf16_t*)(ws + WS_Q) + (size_t)row * 512 + cl; }
                        else dst = (bf16_t*)(ws + WS_KB) + (size_t)row * 128 + (cl - 512);
                    } else if (cl < 768) { dst = (bf16_t*)(ws + WS_VB) + (size_t)row * 128 + (cl - 640); }
                    else { const int cg = cl - 768;
#pragma unroll
                        for (int q = 0; q < 4; ++q) { v0[q] = sigmoidf_(v0[q]); v1[q] = sigmoidf_(v1[q]); }
                        dst = (cg < 1024 ? (bf16_t*)(ws + WS_GF) + (size_t)row * D + cg : (bf16_t*)(ws + WS_GA) + (size_t)row * D + (cg - 1024)); }
                    u32x4 w; w.x = cvt_pk_bf16(v0[0], v0[1]); w.y = cvt_pk_bf16(v0[2], v0[3]); w.z = cvt_pk_bf16(v1[0], v1[1]); w.w = cvt_pk_bf16(v1[2], v1[3]);
                    *(u32x4*)dst = w;
                }
            }
    }
};

struct UpermSched { int G, c, l;
    __device__ __forceinline__ bool next(int i, Unit& u) const { const int L = i * G + c; const int nn = l == 0 ? 66 : 64; if (L >= 2 * nn) return false;
        u.pm = L & 1; u.pn = L >> 1; u.aoff = (unsigned)u.pm * (256u * D * 2u); u.boff = 0; u.kind = 0; u.x0 = 0; u.x1 = 0; u.kh = 0; return true; } };
struct UpermRows { static constexpr bool GA = false, GB = true;
    __device__ __forceinline__ unsigned arow(const Unit&, int) const { return 0u; }
    __device__ __forceinline__ unsigned brow(const Unit& u, int c) const { const int n = u.pn; int row;
        if (n < 64) { const int b = n >> 5, q = n & 31; row = b * T + 128 * (c & 63) + 4 * q + (c >> 6); } else row = NL + (n - 64) * 256 + c;
        return (unsigned)row * (D * 2u); } };
struct EpiUperm {
    static constexpr bool PERM = true; static constexpr int MIDK = 0;
    unsigned char* ws;
    __device__ __forceinline__ void operator()(const f32x4 (&acc)[2][2][4][2], const Unit& u, int wr, int wc, int fr, int fq) const {
        const int n = u.pn;
#pragma unroll
        for (int ai = 0; ai < 2; ++ai)
#pragma unroll
            for (int m = 0; m < 4; ++m) { const int r = u.pm * 256 + ai * 128 + wr * 64 + m * 16 + fr, j = r >> 1, ri = r & 1;
#pragma unroll
                for (int bj = 0; bj < 2; ++bj) { const int c = bj * 128 + wc * 32 + 8 * fq;
                    const f32x4 v0 = acc[ai][bj][m][0], v1 = acc[ai][bj][m][1];
                    u32x4 w; w.x = cvt_pk_bf16(v0[0], v0[1]); w.y = cvt_pk_bf16(v0[2], v0[3]); w.z = cvt_pk_bf16(v1[0], v1[1]); w.w = cvt_pk_bf16(v1[2], v1[3]);
                    bf16_t* dst;
                    if (n < 64) { const int b = n >> 5, q = n & 31, t2 = 4 * q + (c >> 6), t1 = c & 63; dst = (bf16_t*)(ws + WS_UP) + ((size_t)((j * 2 + b) * 128 + t2) * 128 + ri * 64 + t1); }
                    else { const int b = n - 64; dst = (bf16_t*)(ws + WS_VCT) + ((size_t)((b * 256 + j) * 2 + ri) * 256 + c); }
                    *(u32x4*)dst = w; } }
    }
};

struct EpiStepA {
    static constexpr bool PERM = true; static constexpr int MIDK = 0;
    unsigned char* ws;
    __device__ __forceinline__ void operator()(const f32x4 (&acc)[2][2][4][2], const Unit& u, int wr, int wc, int fr, int fq) const {
        const f32x2* tw = (const f32x2*)(ws + WS_TW); bf16_t* gp = (bf16_t*)(ws + WS_GP);
        const int j = u.pm;
#pragma unroll
        for (int ai = 0; ai < 2; ++ai)
#pragma unroll
            for (int m = 0; m < 4; ++m) { const int t2 = wr * 64 + m * 16 + fr, b = ai;
#pragma unroll
                for (int n = 0; n < 2; ++n) { const f32x4 v = acc[ai][0][m][n];
#pragma unroll
                    for (int p = 0; p < 2; ++p) { const int k1 = 16 * wc + 4 * fq + 2 * n + p; const f32x2 w = tw[t2 * 64 + k1];
                        const float gr = v[2 * p], gi = v[2 * p + 1];
                        const float orr = gr * w.x + gi * w.y, oi = gi * w.x - gr * w.y;
                        bf16_t* d = gp + ((size_t)((b * 64 + k1) * 256 + j) * 256 + t2);
                        d[0] = (bf16_t)f2bf(orr); d[128] = (bf16_t)f2bf(oi); } } }
    }
};
template <bool CTXV> struct EpiStepC {
    static constexpr bool PERM = true; static constexpr int MIDK = 0;
    unsigned char* ws;
    __device__ __forceinline__ void operator()(const f32x4 (&acc)[2][2][4][2], const Unit& u, int wr_, int wc_, int fr_, int fq_) const {
        int wr = wr_, wc = wc_, fr = fr_, fq = fq_, upm = u.pm, upn = u.pn;
        asm volatile("" : "+s"(wr), "+s"(wc), "+v"(fr), "+v"(fq), "+s"(upm), "+s"(upn));
        bf16_t* fo = (bf16_t*)(ws + WS_FO);
        const int NN = CTXV ? 256 : T;
        const int b = CTXV ? upm : (upm >> 6), k1 = CTXV ? 0 : (upm & 63), rowb = CTXV ? NL + b * 256 : b * T;
        const int own0 = wr * 128 + fr, mir0 = wr * 128 + 128 - fr;
        const int kk0 = (CTXV ? 128 * upn : 0) + 16 * wc + 4 * fq;
#pragma unroll
        for (int bj = 0; bj < 2; ++bj)
#pragma unroll
            for (int n = 0; n < 2; ++n)
#pragma unroll
                for (int p = 0; p < 2; ++p) {
                    const int kk = kk0 + 64 * bj + 2 * n + p;
                    const int k = CTXV ? kk : (k1 + 64 * kk), km = (NN - k) & (NN - 1);
                    const unsigned oo = (unsigned)(rowb + k) * KM, om = (unsigned)(rowb + km) * KM;
#pragma unroll
                    for (int ai = 0; ai < 2; ++ai)
#pragma unroll
                        for (int m = 0; m < 4; ++m) {
                            const f32x4 v = acc[ai][bj][m][n];
                            const bf16_t re = (bf16_t)f2bf(v[2 * p]);
                            if (m == 0 && fr == 0) { const int g = 2 * ai + wr; const bf16_t im = (bf16_t)f2bf(v[2 * p + 1]);
                                fo[oo + g * 128] = re; fo[om + 512 + 2 * g] = re; fo[oo + g * 128 + 64] = im; fo[om + 512 + 2 * g + 1] = im; }
                            else { fo[oo + own0 + ai * 256 + 16 * m] = re; fo[om + mir0 + ai * 256 - 16 * m] = re; }
                        }
                    asm volatile("" ::: "memory"); __builtin_amdgcn_sched_barrier(0);
                }
    }
};

struct EpiMerge {
    static constexpr bool PERM = true; static constexpr int MIDK = 10;
    unsigned char* ws;
    __device__ __forceinline__ void mid(f32x4 (&acc)[2][2][4][2], const Unit& u, int wr, int wc, int fr, int fq) const {
        asm volatile("" : "+v"(fr), "+v"(fq));
#pragma unroll
        for (int ai = 0; ai < 2; ++ai)
#pragma unroll
            for (int m = 0; m < 4; ++m) { const size_t row = (size_t)(u.pm * 256 + ai * 128 + wr * 64 + m * 16 + fr);
#pragma unroll
                for (int bj = 0; bj < 2; ++bj) { const int col = u.pn * 256 + bj * 128 + wc * 32 + 8 * fq;
                    const u32x4 gf = *(const u32x4*)((const bf16_t*)(ws + WS_GF) + row * D + col), ga = *(const u32x4*)((const bf16_t*)(ws + WS_GA) + row * D + col);
                    f32x4 r0, r1;
                    r0[0] = bflo(gf.x) * __builtin_amdgcn_rcpf(bflo(ga.x)); r0[1] = bfhi(gf.x) * __builtin_amdgcn_rcpf(bfhi(ga.x)); r0[2] = bflo(gf.y) * __builtin_amdgcn_rcpf(bflo(ga.y)); r0[3] = bfhi(gf.y) * __builtin_amdgcn_rcpf(bfhi(ga.y));
                    r1[0] = bflo(gf.z) * __builtin_amdgcn_rcpf(bflo(ga.z)); r1[1] = bfhi(gf.z) * __builtin_amdgcn_rcpf(bfhi(ga.z)); r1[2] = bflo(gf.w) * __builtin_amdgcn_rcpf(bflo(ga.w)); r1[3] = bfhi(gf.w) * __builtin_amdgcn_rcpf(bfhi(ga.w));
                    acc[ai][bj][m][0] = acc[ai][bj][m][0] * r0; acc[ai][bj][m][1] = acc[ai][bj][m][1] * r1; } }
    }
    __device__ __forceinline__ void operator()(const f32x4 (&acc)[2][2][4][2], const Unit& u, int wr, int wc, int fr, int fq) const {
#pragma unroll
        for (int ai = 0; ai < 2; ++ai)
#pragma unroll
            for (int m = 0; m < 4; ++m) { const size_t row = (size_t)(u.pm * 256 + ai * 128 + wr * 64 + m * 16 + fr);
#pragma unroll
                for (int bj = 0; bj < 2; ++bj) { const int col = u.pn * 256 + bj * 128 + wc * 32 + 8 * fq;
                    const u32x4 ga = *(const u32x4*)((const bf16_t*)(ws + WS_GA) + row * D + col);
                    const f32x4 a0 = acc[ai][bj][m][0], a1 = acc[ai][bj][m][1];
                    u32x4 w;
                    w.x = cvt_pk_bf16(bflo(ga.x) * a0[0], bfhi(ga.x) * a0[1]); w.y = cvt_pk_bf16(bflo(ga.y) * a0[2], bfhi(ga.y) * a0[3]);
                    w.z = cvt_pk_bf16(bflo(ga.z) * a1[0], bfhi(ga.z) * a1[1]); w.w = cvt_pk_bf16(bflo(ga.w) * a1[2], bfhi(ga.w) * a1[3]);
                    *(u32x4*)((bf16_t*)(ws + WS_Y) + row * D + col) = w; } }
    }
};

struct EpiResid {
    static constexpr bool PERM = true; static constexpr int MIDK = 0;
    const float* xl_in32; const bf16_t* xl_inb; bf16_t* xl_out; const float* xc_in; float* xc_out; const float* mod_l; int chunk; float* tmpc;
    __device__ __forceinline__ void operator()(const f32x4 (&acc)[2][2][4][2], const Unit& u, int wr, int wc, int fr, int fq) const {
        const int v = u.pm < 32 ? 0 : (u.pm < 64 ? 1 : 2);
        const float* gate = mod_l + v * MODSZ + chunk * D;
        const bool lat = u.pm < 64; const int rbase = lat ? u.pm * 256 : (u.pm - 64) * 256;
#pragma unroll
        for (int bj = 0; bj < 2; ++bj) { const int col = u.pn * 256 + bj * 128 + wc * 32 + 8 * fq;
            const f32x4 g0 = *(const f32x4*)(gate + col), g1 = *(const f32x4*)(gate + col + 4);
#pragma unroll
            for (int ai = 0; ai < 2; ++ai)
#pragma unroll
                for (int m = 0; m < 4; ++m) { const size_t o = (size_t)(rbase + ai * 128 + wr * 64 + m * 16 + fr) * D + col;
                    if (lat) {
                        f32x4 x0, x1;
                        if (xl_in32) { x0 = *(const f32x4*)(xl_in32 + o); x1 = *(const f32x4*)(xl_in32 + o + 4); }
                        else { const u32x4 xb = *(const u32x4*)(xl_inb + o); x0 = (f32x4){bflo(xb.x), bfhi(xb.x), bflo(xb.y), bfhi(xb.y)}; x1 = (f32x4){bflo(xb.z), bfhi(xb.z), bflo(xb.w), bfhi(xb.w)}; }
                        x0 = x0 + g0 * acc[ai][bj][m][0]; x1 = x1 + g1 * acc[ai][bj][m][1];
                        u32x4 w; w.x = cvt_pk_bf16(x0[0], x0[1]); w.y = cvt_pk_bf16(x0[2], x0[3]); w.z = cvt_pk_bf16(x1[0], x1[1]); w.w = cvt_pk_bf16(x1[2], x1[3]);
                        *(u32x4*)(xl_out + o) = w;
                    } else if (u.kh) { *(f32x4*)(tmpc + o) = g0 * acc[ai][bj][m][0]; *(f32x4*)(tmpc + o + 4) = g1 * acc[ai][bj][m][1]; }
                    else { *(f32x4*)(xc_out + o) = *(const f32x4*)(xc_in + o) + g0 * acc[ai][bj][m][0];
                           *(f32x4*)(xc_out + o + 4) = *(const f32x4*)(xc_in + o + 4) + g1 * acc[ai][bj][m][1]; } } }
    }
};

struct EpiSwiglu {
    static constexpr bool PERM = true; static constexpr int MIDK = 0;
    bf16_t* act; int ld;
    __device__ __forceinline__ void operator()(const f32x4 (&acc)[2][2][4][2], const Unit& u, int wr, int wc, int fr, int fq) const {
        const int col = u.pn * 128 + wc * 32 + 8 * fq;
#pragma unroll
        for (int ai = 0; ai < 2; ++ai)
#pragma unroll
            for (int m = 0; m < 4; ++m) { const size_t row = (size_t)(u.x0 + ai * 128 + wr * 64 + m * 16 + fr);
                float o[8];
#pragma unroll
                for (int n = 0; n < 2; ++n)
#pragma unroll
                    for (int q = 0; q < 4; ++q) { const float gv = acc[ai][0][m][n][q], uv = acc[ai][1][m][n][q]; o[4 * n + q] = gv * sigmoidf_(gv) * uv; }
                u32x4 w; w.x = cvt_pk_bf16(o[0], o[1]); w.y = cvt_pk_bf16(o[2], o[3]); w.z = cvt_pk_bf16(o[4], o[5]); w.w = cvt_pk_bf16(o[6], o[7]);
                *(u32x4*)(act + row * ld + col) = w; }
    }
};
struct EpiBf16 {
    static constexpr bool PERM = true; static constexpr int MIDK = 0;
    bf16_t* O0; bf16_t* O1; int ld;
    __device__ __forceinline__ void operator()(const f32x4 (&acc)[2][2][4][2], const Unit& u, int wr, int wc, int fr, int fq) const {
#pragma unroll
        for (int ai = 0; ai < 2; ++ai)
#pragma unroll
            for (int m = 0; m < 4; ++m) { const size_t row = (size_t)(u.x0 + ai * 128 + wr * 64 + m * 16 + fr);
#pragma unroll
                for (int bj = 0; bj < 2; ++bj) { const int col = u.pn * 256 + bj * 128 + wc * 32 + 8 * fq; const f32x4 v0 = acc[ai][bj][m][0], v1 = acc[ai][bj][m][1];
                    u32x4 w; w.x = cvt_pk_bf16(v0[0], v0[1]); w.y = cvt_pk_bf16(v0[2], v0[3]); w.z = cvt_pk_bf16(v1[0], v1[1]); w.w = cvt_pk_bf16(v1[2], v1[3]);
                    *(u32x4*)((u.kh ? O1 : O0) + row * ld + col) = w; } }
    }
};

struct RowSched { int nM, nN, G, c; unsigned abytes, bbytes;
    __device__ __forceinline__ bool next(int i, Unit& u) const { const int L = i * G + c; if (L >= nM * nN) return false; pg8::swz_map(L, nM, nN, u.pm, u.pn); u.aoff = (unsigned)u.pm * abytes; u.boff = (unsigned)u.pn * bbytes; u.kind = 0; u.x0 = u.pm * 256; u.x1 = 0; u.kh = 0; return true; } };

struct MoeSched { int G, c, nN, ksplit, trim; unsigned bexp, bbytes, arow_bytes, khbytes; bool a_slots; int cnt[NE], base[NE];
    __device__ __forceinline__ void init(const unsigned* cw) { int b = 0;
#pragma unroll
        for (int e = 0; e < NE; ++e) { cnt[e] = (int)cw[64 * e]; base[e] = b; b += (cnt[e] + 255) & ~255; } }
    __device__ __forceinline__ bool next(int i, Unit& u) const { int L = i * G + c; int e = 0;
        for (; e < NE; ++e) { const int nu = (((cnt[e] + 255) >> 8) - (e == NE - 1 ? trim : 0)) * nN * ksplit; if (L < nu) break; L -= nu; }
        if (e >= NE) return false;
        int cn = 0, bs = 0;
#pragma unroll
        for (int q = 0; q < NE; ++q) if (q == e) { cn = cnt[q]; bs = base[q]; }
        const int np_ = ((cn + 255) >> 8) - (e == NE - 1 ? trim : 0); const int nt_ = np_ * nN; u.kh = L / nt_; L -= u.kh * nt_;
        pg8::swz_map(L, np_, nN, u.pm, u.pn);
        u.kind = e; u.x1 = cn; u.x0 = bs + u.pm * 256;
        u.aoff = (a_slots ? (unsigned)u.x0 * arow_bytes : 0u) + (unsigned)u.kh * khbytes; u.boff = (unsigned)e * bexp + (unsigned)u.pn * bbytes + (unsigned)u.kh * khbytes; return true; } };
struct MoeTailSched { int G, c, trim, plast, rbase; unsigned bexp;
    __device__ __forceinline__ bool next(int i, Unit& u) const { int L = i * G + c; if (L >= 16 * trim) return false; u.kh = L / (4 * trim); L -= u.kh * 4 * trim;
        u.pm = plast - trim + (L >> 2); u.pn = L & 3; u.kind = NE - 1; u.x1 = 0; u.x0 = rbase + u.pm * 256;
        u.aoff = (unsigned)u.x0 * (DFFE * 2u) + (unsigned)u.kh * (DFFE / 4 * 2u); u.boff = (unsigned)(NE - 1) * bexp + (unsigned)u.pn * (256u * DFFE * 2u) + (unsigned)u.kh * (DFFE / 4 * 2u); return true; } };
struct EpiTail {
    static constexpr bool PERM = true; static constexpr int MIDK = 0;
    bf16_t* O0; bf16_t* Q; int row0;
    __device__ __forceinline__ void operator()(const f32x4 (&acc)[2][2][4][2], const Unit& u, int wr, int wc, int fr, int fq) const {
#pragma unroll
        for (int ai = 0; ai < 2; ++ai)
#pragma unroll
            for (int m = 0; m < 4; ++m) { const int row = u.x0 + ai * 128 + wr * 64 + m * 16 + fr;
                bf16_t* dst = u.kh == 0 ? O0 + (size_t)row * D : Q + ((size_t)(u.kh - 1) * TAILQ_ROWS + (size_t)(row - row0)) * D;
#pragma unroll
                for (int bj = 0; bj < 2; ++bj) { const int col = u.pn * 256 + bj * 128 + wc * 32 + 8 * fq; const f32x4 v0 = acc[ai][bj][m][0], v1 = acc[ai][bj][m][1];
                    u32x4 w; w.x = cvt_pk_bf16(v0[0], v0[1]); w.y = cvt_pk_bf16(v0[2], v0[3]); w.z = cvt_pk_bf16(v1[0], v1[1]); w.w = cvt_pk_bf16(v1[2], v1[3]);
                    *(u32x4*)(dst + col) = w; } }
    }
};
struct MoeRows { static constexpr bool GA = true, GB = false; const int* list;
    __device__ __forceinline__ unsigned arow(const Unit& u, int r) const { int idx = u.pm * 256 + r; idx = idx < u.x1 ? idx : u.x1 - 1; return (unsigned)list[u.kind * NL + idx] * (D * 2u); }
    __device__ __forceinline__ unsigned brow(const Unit&, int) const { return 0u; } };


constexpr int CW_QUEUE = 12288, CW_RDY = 65536;
template <int NG, bool MOE> struct FfnStream {
    int P[NG], rb[NG], cn[NG];
    int f, nNgu, Kdn; unsigned need;
    unsigned* q; volatile LAS unsigned* lw; unsigned* rdy; unsigned* tmo;
    __device__ __forceinline__ void finish_init(int G) { int sacc = 0; f = NG;
#pragma unroll
        for (int g = NG - 1; g >= 0; --g) { if (f == g + 1 && sacc + P[g] * 4 <= G) { sacc += P[g] * 4; f = g; } }
        if (f > NG - 1) f = NG - 1; }
    __device__ __forceinline__ bool decode(int L, SUnit& u) const {
        int pos = L, kind = -1, grp = 0, j = 0;
#pragma unroll
        for (int g = 0; g < NG; ++g) {
            { const int n = P[g] * nNgu; if (kind < 0) { if (pos < n) { kind = 0; grp = g; j = pos; } else pos -= n; } }
            if (g >= 1 && (g - 1) < f) { const int n = P[g - 1] * 4; if (kind < 0) { if (pos < n) { kind = 1; grp = g - 1; j = pos; } else pos -= n; } }
        }
#pragma unroll
        for (int g = 0; g < NG; ++g) if (g >= f) { const int n = P[g] * 4; if (kind < 0) { if (pos < n) { kind = 1; grp = g; j = pos; } else pos -= n; } }
        if (kind < 0) return false;
        int nM = 0, rbase = 0, cnt = 0;
#pragma unroll
        for (int g = 0; g < NG; ++g) if (g == grp) { nM = P[g]; rbase = rb[g]; cnt = cn[g]; }
        const int nN = kind == 0 ? nNgu : 4;
        const int nig = 8 * nN, gid = j / nig, fm = gid * 8, gsz = (nM - fm) < 8 ? (nM - fm) : 8;
        u.pm = fm + ((j % nig) % gsz); u.pn = (j % nig) / gsz; u.kind = kind; u.grp = grp; u.x0 = rbase + u.pm * 256; u.x1 = cnt;
        const int gp = u.x0 >> 8;
        if (kind == 0) { u.K = D; u.dep = -1; u.sig = gp;
            u.aoff = (unsigned)WS_H + (unsigned)u.x0 * (D * 2u);
            u.boff = (MOE ? (unsigned)WS_WGUE + (unsigned)grp * (2u * DFFE * D * 2u) : (unsigned)WS_WGUD) + (unsigned)u.pn * (256u * D * 2u); }
        else { u.K = Kdn; u.dep = gp; u.sig = -1;
            u.aoff = (unsigned)WS_ACT + (unsigned)u.x0 * ((unsigned)Kdn * 2u);
            u.boff = (MOE ? (unsigned)WS_WDE + (unsigned)grp * ((unsigned)D * DFFE * 2u) : (unsigned)WS_WDD) + (unsigned)u.pn * (256u * (unsigned)Kdn * 2u); }
        return true;
    }
    __device__ __forceinline__ void a_ready(const SUnit& u) const {
        if (threadIdx.x < 64) {
            const unsigned long long t0 = __builtin_amdgcn_s_memrealtime(); unsigned polls = 0;
            while ((unsigned)__builtin_amdgcn_readfirstlane(__hip_atomic_load(rdy + 64 * u.dep, __ATOMIC_RELAXED, __HIP_MEMORY_SCOPE_AGENT)) < need) {
                if ((++polls & 255u) == 0u && __builtin_amdgcn_readfirstlane(__hip_atomic_load(tmo, __ATOMIC_RELAXED, __HIP_MEMORY_SCOPE_AGENT)) != 0u) break;
                if (__builtin_amdgcn_s_memrealtime() - t0 > 2000000ull) { if (threadIdx.x == 0) __hip_atomic_store(tmo, 1u, __ATOMIC_RELAXED, __HIP_MEMORY_SCOPE_AGENT); break; }
                __builtin_amdgcn_s_sleep(2); }
            __builtin_amdgcn_fence(__ATOMIC_ACQUIRE, "agent");
            asm volatile("s_waitcnt vmcnt(0)" ::: "memory");
        }
        asm volatile("" ::: "memory"); __builtin_amdgcn_s_barrier(); asm volatile("" ::: "memory");
    }
};
template <bool MOE> struct FfnRows { const int* list;
    __device__ __forceinline__ bool a_gather(const SUnit& u) const { return MOE && u.kind == 0; }
    __device__ __forceinline__ unsigned arow(const SUnit& u, int r) const { int idx = u.pm * 256 + r; idx = idx < u.x1 ? idx : u.x1 - 1; return (unsigned)WS_H + (unsigned)list[u.grp * NL + idx] * (D * 2u); } };

template <bool MOE> struct EpiFfn {
    static constexpr bool PERM = true; static constexpr int MIDK = 0;
    unsigned char* ws; float* xl; const float* mod_l;
    __device__ __forceinline__ void operator()(const f32x4 (&acc)[2][2][4][2], const SUnit& u, int wr, int wc, int fr, int fq) const {
        if (u.kind == 0) {
            constexpr int ld = MOE ? DFFE : DFF0;
            bf16_t* act = (bf16_t*)(ws + WS_ACT);
            const int col = u.pn * 128 + wc * 32 + 8 * fq;
#pragma unroll
            for (int ai = 0; ai < 2; ++ai)
#pragma unroll
                for (int m = 0; m < 4; ++m) { const size_t row = (size_t)(u.x0 + ai * 128 + wr * 64 + m * 16 + fr);
                    float o[8];
#pragma unroll
                    for (int n = 0; n < 2; ++n)
#pragma unroll
                        for (int q = 0; q < 4; ++q) { const float gv = acc[ai][0][m][n][q], uv = acc[ai][1][m][n][q]; o[4 * n + q] = gv * sigmoidf_(gv) * uv; }
                    u32x4 w; w.x = cvt_pk_bf16(o[0], o[1]); w.y = cvt_pk_bf16(o[2], o[3]); w.z = cvt_pk_bf16(o[4], o[5]); w.w = cvt_pk_bf16(o[6], o[7]);
                    pg8::st16_wt(ws, (unsigned)WS_ACT + ((unsigned)row * (unsigned)ld + (unsigned)col) * 2u, w); }
        } else if (MOE) {
            bf16_t* O = (bf16_t*)(ws + WS_DOUT);
#pragma unroll
            for (int ai = 0; ai < 2; ++ai)
#pragma unroll
                for (int m = 0; m < 4; ++m) { const size_t row = (size_t)(u.x0 + ai * 128 + wr * 64 + m * 16 + fr);
#pragma unroll
                    for (int bj = 0; bj < 2; ++bj) { const int col = u.pn * 256 + bj * 128 + wc * 32 + 8 * fq; const f32x4 v0 = acc[ai][bj][m][0], v1 = acc[ai][bj][m][1];
                        u32x4 w; w.x = cvt_pk_bf16(v0[0], v0[1]); w.y = cvt_pk_bf16(v0[2], v0[3]); w.z = cvt_pk_bf16(v1[0], v1[1]); w.w = cvt_pk_bf16(v1[2], v1[3]);
                        *(u32x4*)(O + row * D + col) = w; } }
        } else {
            asm volatile("" : "+v"(fr), "+v"(fq));
            const int pmg = u.x0 >> 8;
            const int v = pmg < 32 ? 0 : (pmg < 64 ? 1 : 2);
            const float* gate = mod_l + v * MODSZ + 5 * D;
            float* xo = pmg < 64 ? xl + (size_t)u.x0 * D : (float*)(ws + WS_XC) + (size_t)(u.x0 - NL) * D;
#pragma unroll
            for (int bj = 0; bj < 2; ++bj) { const int col = u.pn * 256 + bj * 128 + wc * 32 + 8 * fq;
                const f32x4 g0 = *(const f32x4*)(gate + col), g1 = *(const f32x4*)(gate + col + 4);
#pragma unroll
                for (int ai = 0; ai < 2; ++ai)
#pragma unroll
                    for (int m = 0; m < 4; ++m) { const size_t o = (size_t)(ai * 128 + wr * 64 + m * 16 + fr) * D + col;
                        *(f32x4*)(xo + o) = *(const f32x4*)(xo + o) + g0 * acc[ai][bj][m][0];
                        *(f32x4*)(xo + o + 4) = *(const f32x4*)(xo + o + 4) + g1 * acc[ai][bj][m][1];
                        asm volatile("" ::: "memory"); __builtin_amdgcn_sched_barrier(0); } }
        }
    }
};

__device__ __forceinline__ int crow(int r, int hi) { return (r & 3) + 8 * (r >> 2) + 4 * hi; }
__device__ __forceinline__ s16x4 vtr(const LAS unsigned char* p) { typedef short v4i16_t __attribute__((ext_vector_type(4))); return __builtin_bit_cast(s16x4, __builtin_amdgcn_ds_read_tr16_b64_v4i16((LAS v4i16_t*)p)); }

__device__ __forceinline__ void attn_unit(Frame& F, int l, int b, int hkv, int qb, bool ctxq) {
    const int tid = F.tid, lane = F.lane, wid = F.wave, r32 = lane & 31, hi = lane >> 5;
    const int g = wid >> 1, qs = wid & 1, head = hkv * 4 + g;
    const bf16_t* Q = (const bf16_t*)(F.ws + WS_Q); const bf16_t* KB = (const bf16_t*)(F.ws + WS_KB); const bf16_t* VB = (const bf16_t*)(F.ws + WS_VB);
    const int q0 = qb * 64;
    const int qrow = (ctxq ? NL + b * CTXL : b * T) + q0 + qs * 32 + r32;
    bf16x8 qr[4];
#pragma unroll
    for (int d0 = 0; d0 < 4; ++d0) qr[d0] = *(const bf16x8*)(Q + (size_t)qrow * 512 + head * 64 + d0 * 16 + hi * 8);
    int jlo = 0, jhi = -1;
    if (!ctxq) { jlo = -2; jhi = 2; if (q0 + 64 * jlo < 0) jlo = -(q0 / 64); if (q0 + 64 * jhi >= T) jhi = (T - 64 - q0) / 64; }
    const int nloc = jhi - jlo + 1, ntile = nloc + 4;
    const float sinkv = F.in[9][l * 8 + head] * LOG2E;
    float mrun = sinkv, lrun = 1.0f;
    f32x16 o[2]; o[0] = f32x16{}; o[1] = f32x16{};
    const int kkey = lane, vkey = 16 * (wid & 3) + (lane >> 2);
    auto tile_row = [&](int ti) -> int { return ti < nloc ? b * T + q0 + 64 * (jlo + ti) : NL + b * CTXL + 64 * (ti - nloc); };
    u32x4 kreg, vreg;
    { const int r0 = tile_row(0); kreg = *(const u32x4*)(KB + (size_t)(r0 + kkey) * 128 + hkv * 64 + wid * 8); vreg = *(const u32x4*)(VB + (size_t)(r0 + vkey) * 128 + hkv * 64 + (wid >> 2) * 32 + (lane & 3) * 8); }
    for (int ti = 0; ti < ntile; ++ti) {
        LAS unsigned char* slot = F.lds + (ti & 1) * 16384;
        *(LAS u32x4*)(slot + wid * 1024 + lane * 16) = kreg;
        *(LAS u32x4*)(slot + 8192 + wid * 1024 + lane * 16) = vreg;
        __syncthreads();
        if (ti + 1 < ntile) { const int r0 = tile_row(ti + 1); kreg = *(const u32x4*)(KB + (size_t)(r0 + kkey) * 128 + hkv * 64 + wid * 8); vreg = *(const u32x4*)(VB + (size_t)(r0 + vkey) * 128 + hkv * 64 + (wid >> 2) * 32 + (lane & 3) * 8); }
        f32x16 p0 = f32x16{}, p1 = f32x16{};
        { const LAS unsigned char* kb = slot + hi * 1024 + r32 * 16;
#pragma unroll
          for (int d0 = 0; d0 < 4; ++d0) { const bf16x8 k0 = *(const LAS bf16x8*)(kb + d0 * 2048), k1 = *(const LAS bf16x8*)(kb + d0 * 2048 + 512);
              p0 = __builtin_amdgcn_mfma_f32_32x32x16_bf16(k0, qr[d0], p0, 0, 0, 0); p1 = __builtin_amdgcn_mfma_f32_32x32x16_bf16(k1, qr[d0], p1, 0, 0, 0); } }
        if (ti < nloc) { const int j = jlo + ti; const int qq = qs * 32 + r32;
            if (j == -2) {
#pragma unroll
                for (int r = 0; r < 16; ++r) { const int kk = crow(r, hi); if (kk < qq) p0[r] = -INFINITY; if (kk + 32 < qq) p1[r] = -INFINITY; } }
            else if (j == 2) {
#pragma unroll
                for (int r = 0; r < 16; ++r) { const int kk = crow(r, hi); if (kk > qq) p0[r] = -INFINITY; if (kk + 32 > qq) p1[r] = -INFINITY; } } }
        float mx = p0[0];
#pragma unroll
        for (int r = 1; r < 16; ++r) mx = fmaxf(mx, p0[r]);
#pragma unroll
        for (int r = 0; r < 16; ++r) mx = fmaxf(mx, p1[r]);
        mx = fmaxf(mx, __shfl_xor(mx, 32));
        const float mnew = fmaxf(mrun, mx), fsc = __builtin_amdgcn_exp2f(mrun - mnew);
        mrun = mnew;
        float rs = 0.f;
#pragma unroll
        for (int r = 0; r < 16; ++r) { p0[r] = __builtin_amdgcn_exp2f(p0[r] - mnew); p1[r] = __builtin_amdgcn_exp2f(p1[r] - mnew); rs += p0[r] + p1[r]; }
        rs += __shfl_xor(rs, 32);
        lrun = lrun * fsc + rs;
#pragma unroll
        for (int r = 0; r < 16; ++r) { o[0][r] *= fsc; o[1][r] *= fsc; }
        u32x4 pw[4];
        pw[0] = (u32x4){cvt_pk_bf16(p0[0], p0[1]), cvt_pk_bf16(p0[2], p0[3]), cvt_pk_bf16(p0[4], p0[5]), cvt_pk_bf16(p0[6], p0[7])};
        pw[1] = (u32x4){cvt_pk_bf16(p0[8], p0[9]), cvt_pk_bf16(p0[10], p0[11]), cvt_pk_bf16(p0[12], p0[13]), cvt_pk_bf16(p0[14], p0[15])};
        pw[2] = (u32x4){cvt_pk_bf16(p1[0], p1[1]), cvt_pk_bf16(p1[2], p1[3]), cvt_pk_bf16(p1[4], p1[5]), cvt_pk_bf16(p1[6], p1[7])};
        pw[3] = (u32x4){cvt_pk_bf16(p1[8], p1[9]), cvt_pk_bf16(p1[10], p1[11]), cvt_pk_bf16(p1[12], p1[13]), cvt_pk_bf16(p1[14], p1[15])};
        { const LAS unsigned char* vb = slot + 8192 + ((lane >> 4) & 1) * 32 + (lane & 3) * 8 + (4 * hi + ((lane & 15) >> 2)) * 64;
#pragma unroll
          for (int d0 = 0; d0 < 2; ++d0)
#pragma unroll
              for (int ks = 0; ks < 4; ++ks) { const s16x4 lo = vtr(vb + d0 * 4096 + ks * 1024), hh = vtr(vb + d0 * 4096 + ks * 1024 + 512);
                  const bf16x8 vf = (bf16x8){lo[0], lo[1], lo[2], lo[3], hh[0], hh[1], hh[2], hh[3]};
                  o[d0] = __builtin_amdgcn_mfma_f32_32x32x16_bf16(vf, __builtin_bit_cast(bf16x8, pw[ks]), o[d0], 0, 0, 0); } }
    }
    const float rl = 1.0f / lrun;
    bf16_t* orow = (bf16_t*)(F.ws + WS_FO) + (size_t)qrow * KM + 640 + head * 64;
#pragma unroll
    for (int d0 = 0; d0 < 2; ++d0)
#pragma unroll
        for (int rq = 0; rq < 4; ++rq) { u32x2 w; w.x = cvt_pk_bf16(o[d0][4 * rq] * rl, o[d0][4 * rq + 1] * rl); w.y = cvt_pk_bf16(o[d0][4 * rq + 2] * rl, o[d0][4 * rq + 3] * rl);
            *(u32x2*)(orow + 32 * d0 + 8 * rq + 4 * hi) = w; }
    __syncthreads();
}

__device__ __forceinline__ void attn_phase(Frame& F, int l, int part) {
    const int nlat = NB * 2 * 128;
    auto lat_unit = [&](int it) { const int qb = it & 127, hkv = (it >> 7) & 1, b = it >> 8; attn_unit(F, l, b, hkv, qb, false); };
    if (part == 0) {
        for (int it = F.bx; it < 256; it += F.G) lat_unit(it);
        if (l == 0) for (int r = (F.bx + F.G - 240) % F.G; r < NB * 2 * 4; r += F.G) { const int qb = r & 3, hkv = (r >> 2) & 1, b = r >> 3; attn_unit(F, l, b, hkv, qb, true); }
    } else {
        const bool busy = (l == 0) && F.bx >= 128 && F.bx < 136;
        if (!busy) for (int it = 256 + F.bx; it < nlat; it += F.G) lat_unit(it);
        if (l == 0 && F.bx >= 136 && F.bx < 144) lat_unit(256 + F.bx - 8);
    }
}

#if !MK_MULTI
#define GRID_BAR() xcd_barrier(bar)
#else
#define GRID_BAR() do {} while (0)
#endif
#ifndef PH_MASK
#define PH_MASK 0xFFFFFu
#endif
#define IN(k) (((PH_MASK >> (k)) & 1u) && lo <= (k) && (k) < hi)
#define SEAM(k) do { if (IN((k) + 1)) GRID_BAR(); } while (0)
#ifndef REP_MASK
#define REP_MASK 0u
#endif
#define REPS(k) ((((REP_MASK) >> (k)) & 1u) ? 2 : 1)
template <int l, class BarT>
__device__ __forceinline__ void layer_phases(Frame& F, unsigned* ctl, const int lo, const int hi, const BarT& bar) {
        const int pb = 1 + 8 * l;
        bf16_t* H = (bf16_t*)(F.ws + WS_H);
        const float* xl_in = l == 0 ? F.in[0] : nullptr;
        bf16_t* XB = (bf16_t*)(F.ws + WS_XB);
        const float* xc_in = l == 0 ? F.in[2] : (const float*)(F.ws + WS_XC);
        float* xc = (float*)(F.ws + WS_XC);
        const float* mod_l = (const float*)ctl + CW_MOD + l * 3 * MODSZ;
        if (IN(pb + 0)) { for (int rep = 0; rep < REPS(pb + 0); ++rep) norm_phase<false>(F, l, 0, xl_in, xc_in, NTOK, l == 1 ? (const float*)(F.ws + WS_TMPC2) : nullptr, nullptr); SEAM(pb + 0); }
        if (IN(pb + 1)) {
            for (int rep = 0; rep < REPS(pb + 1); ++rep) {
            { pg8::Gemm g{H, (const bf16_t*)(F.ws + (l ? WS_WIN1 : WS_WIN0)) + (size_t)512 * D, D, D}; InprojSched S{F.G, F.bx, l}; EpiInproj E{F.ws}; pg8::NoGather R;
              pg8::gemm_phase(F.lds, g, S, E, R); }
            { pg8::Gemm g{(const bf16_t*)(F.ws + (l ? WS_WIN1 : WS_WIN0)), H, D, D}; UpermSched S{F.G, F.bx, l}; EpiUperm E{F.ws}; UpermRows R;
              pg8::gemm_phase(F.lds, g, S, E, R); }
            }
            SEAM(pb + 1);
        }
        if (IN(pb + 2)) {
            for (int rep = 0; rep < REPS(pb + 2); ++rep) {
            attn_phase(F, l, 0);
            { pg8::Gemm g{(const bf16_t*)(F.ws + WS_UP), (const bf16_t*)(F.ws + WS_FA64), 128, 128}; GridSched S{256, 1, F.G, F.bx, 256u * 128u * 2u, 0u}; EpiStepA E{F.ws}; pg8::NoGather R;
              pg8::gemm_phase(F.lds, g, S, E, R); }
            if (l == 0) { pg8::Gemm g{(const bf16_t*)(F.ws + WS_VCT), (const bf16_t*)(F.ws + WS_TX), 512, 512}; GridSched S{2, 2, F.G, (F.bx + F.G - 16) % F.G, 256u * 512u * 2u, 256u * 512u * 2u}; EpiStepC<true> E{F.ws}; pg8::NoGather R;
              pg8::gemm_phase(F.lds, g, S, E, R); }
            }
            SEAM(pb + 2);
        }
        if (IN(pb + 3)) {
            for (int rep = 0; rep < REPS(pb + 3); ++rep) {
            { pg8::Gemm g{(const bf16_t*)(F.ws + WS_GP), (const bf16_t*)(F.ws + WS_TC), 256, 256}; GridSched S{128, 1, F.G, F.bx, 256u * 256u * 2u, 0u}; EpiStepC<false> E{F.ws}; pg8::NoGather R;
              pg8::gemm_phase(F.lds, g, S, E, R); }
            if (l == 0) { pg8::Gemm g{(const bf16_t*)(F.ws + WS_FO), (const bf16_t*)(F.ws + WS_WM0), KM, KM}; CtxSched S{F.G, (F.bx + F.G - 128) % F.G, 4, 256u * KM * 2u, 256u * KM * 2u, 1, 0u}; EpiMerge E{F.ws}; pg8::NoGather R;
              pg8::gemm_phase(F.lds, g, S, E, R); }
            attn_phase(F, l, 1);
            }
            SEAM(pb + 3);
        }
        if (IN(pb + 4)) {
            const int nM = 64;
            pg8::Gemm g{(const bf16_t*)(F.ws + WS_FO), (const bf16_t*)(F.ws + (l ? WS_WM1 : WS_WM0)), KM, KM}; GridSched S{nM, 4, F.G, F.bx, 256u * KM * 2u, 256u * KM * 2u}; EpiMerge E{F.ws}; pg8::NoGather R;
            for (int rep = 0; rep < REPS(pb + 4); ++rep) pg8::gemm_phase(F.lds, g, S, E, R);
            SEAM(pb + 4);
        }
        if (IN(pb + 5)) {
            EpiResid E{xl_in, XB, XB, xc_in, xc, mod_l, 2, (float*)(F.ws + WS_TMPC1)}; pg8::NoGather R;
            { pg8::Gemm g{(const bf16_t*)(F.ws + WS_Y), (const bf16_t*)(F.ws + (l ? WS_WO1 : WS_WO0)), D, D}; GridSched S{64, 4, F.G, F.bx, 256u * D * 2u, 256u * D * 2u};
              pg8::gemm_phase(F.lds, g, S, E, R); }
            if (l == 0) { pg8::Gemm g{(const bf16_t*)(F.ws + WS_Y), (const bf16_t*)(F.ws + WS_WO0), D / 2, D}; CtxSched S{F.G, F.bx, 4, 256u * D * 2u, 256u * D * 2u, 2, (unsigned)D};
              pg8::gemm_phase(F.lds, g, S, E, R); }
            SEAM(pb + 5);
        }
        if (IN(pb + 6)) {
            if (l == 0) norm_phase<false>(F, l, 1, nullptr, xc, NTOK, (const float*)(F.ws + WS_TMPC1), xc); else { norm_phase<true>(F, l, 1, nullptr, xc, NL); moe_convert(F, 0); }
            SEAM(pb + 6);
        }
#ifndef STREAM0
#define STREAM0 0
#endif
#ifndef STREAM1
#define STREAM1 0
#endif
        if (IN(pb + 7)) {
            volatile LAS unsigned* lw = (volatile LAS unsigned*)(F.lds + MISC_OFF) + 16;
            if (l == 0) {
#if STREAM0
                FfnStream<9, false> S;
#pragma unroll
                for (int g = 0; g < 9; ++g) { S.P[g] = g < 8 ? 8 : 2; S.rb[g] = 2048 * g; S.cn[g] = g < 8 ? 2048 : 512; }
                S.nNgu = 22; S.Kdn = DFF0; S.need = 22u * 8u; S.q = ctl + CW_QUEUE; S.lw = lw; S.rdy = ctl + CW_RDY; S.tmo = ctl + 2; S.finish_init(F.G);
                EpiFfn<false> E{F.ws, F.out, mod_l}; FfnRows<false> R{nullptr};
                pg8::gemm_stream(F.lds, (const char*)F.ws, S, E, R);
#else
                { pg8::Gemm g{H, (const bf16_t*)(F.ws + WS_WGUD), D, D}; RowSched S{66, 22, F.G, F.bx, 256u * D * 2u, 256u * D * 2u}; EpiSwiglu E{(bf16_t*)(F.ws + WS_ACT), DFF0}; pg8::NoGather R;
                  pg8::gemm_phase(F.lds, g, S, E, R); }
                GRID_BAR();
                { EpiResid E{nullptr, XB, XB, xc, xc, mod_l, 5, (float*)(F.ws + WS_TMPC2)}; pg8::NoGather R;
                  { pg8::Gemm g{(const bf16_t*)(F.ws + WS_ACT), (const bf16_t*)(F.ws + WS_WDD), DFF0, DFF0}; GridSched S{64, 4, F.G, F.bx, 256u * DFF0 * 2u, 256u * DFF0 * 2u};
                    pg8::gemm_phase(F.lds, g, S, E, R); }
                  { pg8::Gemm g{(const bf16_t*)(F.ws + WS_ACT), (const bf16_t*)(F.ws + WS_WDD), DFF0 / 2, DFF0}; CtxSched S{F.G, F.bx, 4, 256u * DFF0 * 2u, 256u * DFF0 * 2u, 2, (unsigned)DFF0};
                    pg8::gemm_phase(F.lds, g, S, E, R); } }

#endif
            } else {
#if STREAM1
                FfnStream<8, true> S; { int bacc = 0;
#pragma unroll
                for (int e = 0; e < NE; ++e) { const int c = (int)ctl[CW_CNT + 64 * e]; S.cn[e] = c; S.P[e] = (c + 255) >> 8; S.rb[e] = bacc; bacc += ((c + 255) >> 8) << 8; } }
                S.nNgu = 28; S.Kdn = DFFE; S.need = 28u * 8u; S.q = ctl + CW_QUEUE + 64; S.lw = lw; S.rdy = ctl + CW_RDY + 64 * 80; S.tmo = ctl + 2; S.finish_init(F.G);
                EpiFfn<true> E{F.ws, F.out, mod_l}; FfnRows<true> R{(const int*)(F.ws + WS_LIST)};
                pg8::gemm_stream(F.lds, (const char*)F.ws, S, E, R);
#else
                { pg8::Gemm g{H, (const bf16_t*)(F.ws + WS_WGUE), D, D}; MoeSched S; S.G = F.G; S.c = F.bx; S.nN = 28; S.ksplit = 1; S.trim = 0; S.khbytes = 0; S.bexp = 2u * DFFE * D * 2u; S.bbytes = 256u * D * 2u; S.arow_bytes = 0; S.a_slots = false; S.init(ctl + CW_CNT);
                  EpiSwiglu E{(bf16_t*)(F.ws + WS_ACT), DFFE}; MoeRows R{(const int*)(F.ws + WS_LIST)};
                  pg8::gemm_phase(F.lds, g, S, E, R); }
                moe_convert(F, 1);
                GRID_BAR();
                { const int trim = moe_tail_panels(ctl + CW_CNT, F.G);
                  MoeSched S; S.G = F.G; S.c = F.bx; S.nN = 4; S.ksplit = 1; S.trim = trim; S.khbytes = 0; S.bexp = (unsigned)D * DFFE * 2u; S.bbytes = 256u * DFFE * 2u; S.arow_bytes = DFFE * 2u; S.a_slots = true; S.init(ctl + CW_CNT);
                  { pg8::Gemm g{(const bf16_t*)(F.ws + WS_ACT), (const bf16_t*)(F.ws + WS_WDE), DFFE, DFFE};
                    EpiBf16 E{(bf16_t*)(F.ws + WS_DOUT), (bf16_t*)(F.ws + WS_DOUT), D}; pg8::NoGather R;
                    pg8::gemm_phase(F.lds, g, S, E, R); }
                  if (trim > 0) {
                    const int plast = (S.cnt[NE - 1] + 255) >> 8;
                    pg8::Gemm g{(const bf16_t*)(F.ws + WS_ACT), (const bf16_t*)(F.ws + WS_WDE), DFFE / 4, DFFE};
                    MoeTailSched T{F.G, F.bx, trim, plast, S.base[NE - 1], (unsigned)D * DFFE * 2u};
                    EpiTail E{(bf16_t*)(F.ws + WS_DOUT), (bf16_t*)(F.ws + WS_DOUT1), S.base[NE - 1] + (plast - trim) * 256}; pg8::NoGather R;
                    pg8::gemm_phase(F.lds, g, T, E, R); } }
#endif
            }
            SEAM(pb + 7);
        }
}

constexpr int NPHASE = 18;
__global__ void __launch_bounds__(NTHR, 2) fwd_kernel(Args args) {
    extern __shared__ __attribute__((aligned(16))) unsigned char lds_raw[];
    Frame F;
    F.lds = (LAS unsigned char*)lds_raw; F.ws = args.ws; F.in = args.in; F.out = args.out;
    F.tid = threadIdx.x; F.lane = F.tid & 63; F.wave = __builtin_amdgcn_readfirstlane(F.tid >> 6); F.G = gridDim.x; F.bx = blockIdx.x;
    volatile LAS unsigned* MISC = (volatile LAS unsigned*)(F.lds + MISC_OFF);
    if (F.tid < 32) MISC[F.tid] = 0u;
    __syncthreads();
    unsigned* ctl = (unsigned*)(F.ws + WS_CTL);
#if !MK_MULTI
    XcdBarrier bar = xcd_barrier_post(ctl + CW_BAR, MISC + 8);
#else
    XcdBarrier bar; bar.bar = ctl + CW_BAR; bar.x = 0; bar.st = MISC + 8;
#endif
    const int lo = args.ph_lo, hi = args.ph_hi;
    if (IN(0)) { for (int rep = 0; rep < REPS(0); ++rep) { p0_prologue(F); __syncthreads(); } SEAM(0); }
    layer_phases<0>(F, ctl, lo, hi, bar);
    layer_phases<1>(F, ctl, lo, hi, bar);
    if (IN(17)) final_phase(F);
}

extern "C" void kernel_launch(void* const* d_in, const int* in_sizes, int n_in, void* d_out, int out_size, void* d_ws, size_t ws_size, hipStream_t stream) {
    static int grid = 0;
    if (grid == 0) {
        if (n_in != 21 || out_size != NL * D || ws_size < WS_END) { fprintf(stderr, "kernel_launch: unexpected problem (n_in %d out %d ws %zu)\n", n_in, out_size, ws_size); grid = -1; return; }
        int dev = 0, cus = 0;
        hipGetDevice(&dev); hipDeviceGetAttribute(&cus, hipDeviceAttributeMultiprocessorCount, dev);
        if (hipFuncSetAttribute((const void*)fwd_kernel, hipFuncAttributeMaxDynamicSharedMemorySize, LDS_BYTES) != hipSuccess) { fprintf(stderr, "kernel_launch: hipFuncSetAttribute failed\n"); grid = -1; return; }
        int per_cu = 0; (void)hipOccupancyMaxActiveBlocksPerMultiprocessor(&per_cu, (const void*)fwd_kernel, NTHR, LDS_BYTES); (void)hipGetLastError();
        grid = cus;
    }
    if (grid < 0) return;
    hipMemsetAsync((char*)d_ws + WS_CTL, 0, CTL_BYTES, stream);
#ifdef DBG_SCRUB
    hipMemsetAsync((char*)d_ws + CTL_BYTES, 0, WS_END - CTL_BYTES, stream);
#endif
    Args a{};
    for (int i = 0; i < 21; ++i) a.in[i] = (const float*)d_in[i];
    a.out = (float*)d_out; a.ws = (unsigned char*)d_ws;
#if MK_MULTI
    for (int p = 0; p < NPHASE; ++p) { a.ph_lo = p; a.ph_hi = p + 1; hipLaunchKernelGGL(fwd_kernel, dim3(grid), dim3(NTHR), LDS_BYTES, stream, a); }
#else
    a.ph_lo = 0; a.ph_hi = NPHASE;
    hipLaunchKernelGGL(fwd_kernel, dim3(grid), dim3(NTHR), LDS_BYTES, stream, a);
#endif
}
```

```cpp
#include <hip/hip_runtime.h>
#include <cstdio>
#include <cstdint>

#define LAS __attribute__((address_space(3)))
#define GAS __attribute__((address_space(1)))
typedef unsigned short bf16_t;
typedef short bf16x8 __attribute__((ext_vector_type(8)));
typedef short s16x4 __attribute__((ext_vector_type(4)));
typedef float f32x4 __attribute__((ext_vector_type(4)));
typedef float f32x2 __attribute__((ext_vector_type(2)));
typedef float f32x16 __attribute__((ext_vector_type(16)));
typedef unsigned u32x4 __attribute__((ext_vector_type(4)));
typedef unsigned u32x2 __attribute__((ext_vector_type(2)));

#ifndef MK_MULTI
#define MK_MULTI 0
#endif

constexpr int D = 1024, T = 8192, NB = 2, NL = NB * T, CTXL = 256, NC = NB * CTXL, NTOK = NL + NC;
constexpr int INW = 3328, OFFQ = 512, OFFK = 1024, OFFV = 1152, OFFG = 1280;
constexpr int DFF0 = 2816, DFFE = 3584, NE = 8;
constexpr int KM = 1152;
constexpr int MOE_ROWS = 2 * NL + NE * 256;
constexpr float EPS = 1e-6f;
constexpr float LOG2E = 1.4426950408889634f;
constexpr float QSCALE = 0.125f * LOG2E;

constexpr size_t MiB = 1u << 20, KiB = 1u << 10;
constexpr size_t WS_CTL = 0, CTL_BYTES = 1 * MiB;
constexpr size_t WS_ROPE = 1 * MiB, WS_TW = WS_ROPE + 32 * KiB, WS_FA64 = WS_ROPE + 96 * KiB, WS_TC = WS_ROPE + 160 * KiB, WS_TX = WS_ROPE + 288 * KiB;
constexpr size_t WS_TOKE = 2 * MiB, WS_TOKR = WS_TOKE + 128 * KiB, WS_TOKW = WS_TOKE + 256 * KiB, WS_LIST = WS_TOKE + 384 * KiB;
constexpr size_t WS_XC = 3 * MiB, WS_VCT = 5 * MiB;
constexpr size_t WS_WIN0 = 6 * MiB, WS_WM0 = WS_WIN0 + 13 * MiB / 2, WS_WO0 = 17 * MiB, WS_WGUD = 19 * MiB, WS_WDD = 30 * MiB;
constexpr size_t WS_WIN1 = 36 * MiB, WS_WM1 = WS_WIN1 + 13 * MiB / 2, WS_WO1 = 47 * MiB;
constexpr size_t WS_H = 49 * MiB;
constexpr size_t WS_DOUT = 6 * MiB;
constexpr size_t WS_WGUE = 82 * MiB, WS_WDE = 194 * MiB;
constexpr size_t WS_DOUT1 = WS_WGUE;
constexpr size_t WS_R1 = 250 * MiB;
constexpr size_t WS_UP = WS_R1, WS_Q = 266 * MiB, WS_KB = 283 * MiB, WS_VB = 288 * MiB, WS_GF = 293 * MiB, WS_GA = 326 * MiB, WS_GP = 359 * MiB, WS_FO = 375 * MiB, WS_Y = 413 * MiB;
constexpr size_t WS_ACT = WS_R1;
constexpr size_t WS_TMPC1 = 446 * MiB, WS_TMPC2 = 448 * MiB;
constexpr size_t WS_XB = 490 * MiB;
constexpr size_t WS_END = 523 * MiB;
static_assert(WS_DOUT + (size_t)MOE_ROWS * D * 2 <= WS_WGUE, "DOUT overlay");
static_assert(WS_ACT + (size_t)MOE_ROWS * DFFE * 2 <= WS_END, "ACT");
static_assert(WS_FO + (size_t)NTOK * KM * 2 <= WS_Y, "FO");
constexpr int CW_BAR = 4096, CW_CNT = 8192, CW_MOD = 16384;
constexpr int MODSZ = 6 * D;

constexpr int RING_BYTES = 131072, MISC_OFF = RING_BYTES + 320, LDS_BYTES = 147456;
constexpr int NWAVES = 8, NTHR = 512;

__device__ __forceinline__ unsigned f2bf(float f) { unsigned u = __builtin_bit_cast(unsigned, f); return (u + 0x7fffu + ((u >> 16) & 1u)) >> 16; }
__device__ __forceinline__ unsigned pk2(float lo, float hi) { return f2bf(lo) | (f2bf(hi) << 16); }
__device__ __forceinline__ unsigned cvt_pk_bf16(float lo, float hi) { unsigned r; asm volatile("v_cvt_pk_bf16_f32 %0, %1, %2" : "=v"(r) : "v"(lo), "v"(hi)); return r; }
__device__ __forceinline__ float bf2f(unsigned short h) { return __builtin_bit_cast(float, (unsigned)h << 16); }
__device__ __forceinline__ float bflo(unsigned w) { return __builtin_bit_cast(float, w << 16); }
__device__ __forceinline__ float bfhi(unsigned w) { return __builtin_bit_cast(float, w & 0xffff0000u); }
__device__ __forceinline__ float wave_sum(float v) {
#pragma unroll
    for (int o = 1; o < 64; o <<= 1) v += __shfl_xor(v, o);
    return v;
}
__device__ __forceinline__ float sigmoidf_(float x) { return __builtin_amdgcn_rcpf(1.0f + __builtin_amdgcn_exp2f(-x * LOG2E)); }
#define LDS_WAIT() asm volatile("s_waitcnt lgkmcnt(0)" ::: "memory")
#define VM_WAIT() asm volatile("s_waitcnt vmcnt(0)" ::: "memory")

#define XB_TMO      128
#define XB_XCNT(j)  (256  + 64 * (j))
#define XB_XSUB(j)  (1280 + 64 * (j))
#define XB_XGEN(j)  (2304 + 64 * (j))
#define XB_TOP      3328
#define XB_TOPGEN   3392
#define XCD_BAR_WORDS 3456
#define XB_SPIN_CAP (1u << 18)
__device__ __forceinline__ unsigned xb_ld(unsigned* p)              { return __hip_atomic_load(p, __ATOMIC_RELAXED, __HIP_MEMORY_SCOPE_AGENT); }
__device__ __forceinline__ unsigned xb_add(unsigned* p, unsigned v) { return __hip_atomic_fetch_add(p, v, __ATOMIC_RELAXED, __HIP_MEMORY_SCOPE_AGENT); }
__device__ __forceinline__ unsigned xb_xcc_id() { return (unsigned)__builtin_amdgcn_s_getreg((3 << 11) | 20) & 0xFu; }
#define XB_SPIN(cond, bar) do { unsigned _sp = 0; while (cond) { __builtin_amdgcn_s_sleep(1); \
    if ((++_sp & 255u) == 0u) { if (xb_ld(&(bar)[XB_TMO])) break; if (_sp > XB_SPIN_CAP) { atomicAdd(&(bar)[XB_TMO], 1u); break; } } } } while (0)
struct XcdBarrier { unsigned* bar; unsigned x; volatile LAS unsigned* st; };
__device__ __forceinline__ XcdBarrier xcd_barrier_post(unsigned* bar, volatile LAS unsigned* st) {
    XcdBarrier b; b.bar = bar; b.x = xb_xcc_id(); b.st = st;
    if (threadIdx.x == 0) (void)xb_add(&bar[XB_XCNT(b.x)], 1u);
    return b;
}
__device__ __forceinline__ void xcd_barrier_complete(unsigned* bar, unsigned x, unsigned& nloc, unsigned& nx) {
    const unsigned G = gridDim.x * gridDim.y * gridDim.z;
    unsigned sum, cnt, mine, sp = 0u;
    for (;;) {
        sum = 0u; cnt = 0u; mine = 0u;
#pragma unroll
        for (unsigned j = 0; j < 16; ++j) { const unsigned c = xb_ld(&bar[XB_XCNT(j)]); sum += c; cnt += (c > 0u) ? 1u : 0u; mine = (j == x) ? c : mine; }
        if (sum == G) break;
        __builtin_amdgcn_s_sleep(1);
        if ((++sp & 255u) == 0u) { if (xb_ld(&bar[XB_TMO])) break; if (sp > XB_SPIN_CAP) { atomicAdd(&bar[XB_TMO], 1u); break; } }
    }
    nloc = mine > 0u ? mine : 1u; nx = cnt > 0u ? cnt : 1u;
}
__device__ __forceinline__ void xcd_barrier(const XcdBarrier& b) {
    asm volatile("s_waitcnt vmcnt(0)" ::: "memory");
    __syncthreads();
    if (threadIdx.x == 0) {
        unsigned* bar = b.bar;
        __builtin_amdgcn_s_waitcnt(0);
        unsigned nloc = b.st[0], nx = b.st[1];
        if (nloc == 0u) { xcd_barrier_complete(bar, b.x, nloc, nx); b.st[0] = nloc; b.st[1] = nx; }
        const unsigned old = xb_add(&bar[XB_XSUB(b.x)], 1u);
        const unsigned gen = old / nloc;
        if (old + 1u == (gen + 1u) * nloc) {
            __builtin_amdgcn_fence(__ATOMIC_RELEASE, "agent");
            asm volatile("s_waitcnt vmcnt(0)" ::: "memory");
            const unsigned og = xb_add(&bar[XB_TOP], 1u);
            const unsigned tg = og / nx;
            if (og + 1u == (tg + 1u) * nx) xb_add(&bar[XB_TOPGEN], 1u);
            else XB_SPIN(xb_ld(&bar[XB_TOPGEN]) == tg, bar);
            __builtin_amdgcn_fence(__ATOMIC_ACQUIRE, "agent");
            xb_add(&bar[XB_XGEN(b.x)], 1u);
            asm volatile("s_waitcnt vmcnt(0)" ::: "memory");
        } else {
            XB_SPIN(xb_ld(&bar[XB_XGEN(b.x)]) == gen, bar);
            __builtin_amdgcn_fence(__ATOMIC_ACQUIRE, "agent");
            asm volatile("s_waitcnt vmcnt(0)" ::: "memory");
        }
    }
    __syncthreads();
}

namespace pg8 {
constexpr int BM = 256, BK = 64, HALF = 128, HTB = HALF * BK * 2, STAGE_BYTES = 8 * HTB, NXCD = 8, WGM = 8;
__host__ __device__ __forceinline__ int lds_byte(int r, int c) { const int st = (r >> 4) * 2 + (c >> 5), rr = r & 15, cc = c & 31, ob = rr * 64 + cc * 2; return st * 1024 + (ob ^ (((ob >> 9) & 1) << 5)); }
__host__ __device__ __forceinline__ void stage_rc(int b, int& R, int& C) { const int st = b / 1024, sb = b % 1024, swz = sb ^ (((sb >> 9) & 1) << 5); R = (st >> 1) * 16 + swz / 64; C = (st & 1) * 32 + (swz % 64) / 2; }
__host__ __device__ __forceinline__ int perm32(int rho) { const int n = rho >> 4, i = rho & 15; return 8 * (i >> 2) + 4 * n + (i & 3); }

struct Unit { unsigned aoff, boff; int pm, pn, kind, x0, x1, kh; };
struct Gemm { const bf16_t* A; const bf16_t* Bt; int K; int ld; };

__device__ __forceinline__ void swz_map(int L, int nM, int nN, int& pm, int& pn) {
    const int nwg = nM * nN; int wgid = L;
    { const int q = nwg / NXCD, r = nwg % NXCD, xcd = wgid % NXCD, off = wgid / NXCD; wgid = (xcd < r ? xcd * (q + 1) : r * (q + 1) + (xcd - r) * q) + off; }
    const int nig = WGM * nN, gid = wgid / nig, fm = gid * WGM, gsz = (nM - fm) < WGM ? (nM - fm) : WGM;
    pm = fm + ((wgid % nig) % gsz); pn = (wgid % nig) / gsz;
}

struct NoGather { static constexpr bool GA = false, GB = false;
    __device__ __forceinline__ unsigned arow(const Unit&, int) const { return 0u; }
    __device__ __forceinline__ unsigned brow(const Unit&, int) const { return 0u; } };

template <class Epi, class Sched, class Rows>
__device__ __forceinline__ void gemm_phase(LAS unsigned char* lds, const Gemm g, const Sched& S, const Epi& E, const Rows& RW) {
    int tid_ = threadIdx.x; asm volatile("" : "+v"(tid_));
    const int tid = tid_, wid = __builtin_amdgcn_readfirstlane(tid >> 6), lane = tid & 63, wr = wid >> 2, wc = wid & 3, fr = lane & 15, fq = lane >> 4;
    int K_ = g.K; asm volatile("" : "+s"(K_));
    const int K = K_, nt = K / BK;
    int sR[2], sRb[2], sC[2];
#pragma unroll
    for (int i = 0; i < 2; ++i) { int R, C; stage_rc(tid * 16 + i * 8192, R, C); sR[i] = R; sC[i] = C; sRb[i] = (R & ~31) + perm32(R & 31); }
    unsigned voffA[2], voffB[2];
    const int LD = g.ld;
#pragma unroll
    for (int i = 0; i < 2; ++i) { voffA[i] = (unsigned)(sR[i] * LD + sC[i]) * 2u; voffB[i] = (unsigned)(sRb[i] * LD + sC[i]) * 2u; }
    const size_t kstep = (size_t)(BK * 2);
    const size_t hstep = (size_t)HALF * LD * 2;
    const unsigned ldsw = (unsigned)wid * 1024u;
    const int aoff = lds_byte(wr * 64 + fr, fq * 8), boff = lds_byte(wc * 32 + fr, fq * 8);
    struct Side { const char* base[2]; unsigned off[2][2]; };
#define PG8_SA(b, h) (((b) * 2 + (h)) * HTB)
#define PG8_SB(b, h) ((4 + (b) * 2 + (h)) * HTB)
#define PG8_STAGE(bufoff, side, h, kt) do { _Pragma("unroll") for (int _i = 0; _i < 2; ++_i) \
        __builtin_amdgcn_global_load_lds((const unsigned*)((side).base[h] + (size_t)(kt) * kstep + (side).off[h][_i]), (LAS unsigned*)(lds + (bufoff) + ldsw + _i * 8192), 16, 0, 0); } while (0)
#define PG8_LDA(dst, b, h) do { _Pragma("unroll") for (int m = 0; m < 4; ++m) _Pragma("unroll") for (int k = 0; k < 2; ++k) dst[m][k] = *(const LAS bf16x8*)(lds + PG8_SA(b, h) + aoff + m * 2048 + k * 1024); } while (0)
#define PG8_LDB(dst, b, h) do { _Pragma("unroll") for (int n = 0; n < 2; ++n) _Pragma("unroll") for (int k = 0; k < 2; ++k) dst[n][k] = *(const LAS bf16x8*)(lds + PG8_SB(b, h) + boff + n * 2048 + k * 1024); } while (0)
#define PG8_MMA(ai, bj, At, Bt) do { __builtin_amdgcn_s_setprio(1); _Pragma("unroll") for (int m = 0; m < 4; ++m) _Pragma("unroll") for (int n = 0; n < 2; ++n) _Pragma("unroll") for (int k = 0; k < 2; ++k) \
        acc[ai][bj][m][n] = __builtin_amdgcn_mfma_f32_16x16x32_bf16(Bt[n][k], At[m][k], acc[ai][bj][m][n], 0, 0, 0); __builtin_amdgcn_s_setprio(0); } while (0)
#define PG8_WAIT_V(n) asm volatile("s_waitcnt vmcnt(" #n ")" ::: "memory")
#define PG8_WAIT_L(n) asm volatile("s_waitcnt lgkmcnt(" #n ")" ::: "memory")
#define PG8_BAR __builtin_amdgcn_s_barrier()
#define PG8_SCHED __builtin_amdgcn_sched_barrier(0)
#define PG8_MKSIDES(u, sa, sb) do { \
        if constexpr (Rows::GA) { sa.base[0] = sa.base[1] = (const char*)g.A; _Pragma("unroll") for (int h = 0; h < 2; ++h) _Pragma("unroll") for (int i = 0; i < 2; ++i) sa.off[h][i] = RW.arow(u, h * HALF + sR[i]) + (unsigned)sC[i] * 2u; } \
        else { sa.base[0] = (const char*)g.A + (u).aoff; sa.base[1] = sa.base[0] + hstep; _Pragma("unroll") for (int h = 0; h < 2; ++h) _Pragma("unroll") for (int i = 0; i < 2; ++i) sa.off[h][i] = voffA[i]; } \
        if constexpr (Rows::GB) { sb.base[0] = sb.base[1] = (const char*)g.Bt; _Pragma("unroll") for (int h = 0; h < 2; ++h) _Pragma("unroll") for (int i = 0; i < 2; ++i) sb.off[h][i] = RW.brow(u, h * HALF + sRb[i]) + (unsigned)sC[i] * 2u; } \
        else { sb.base[0] = (const char*)g.Bt + (u).boff; sb.base[1] = sb.base[0] + hstep; _Pragma("unroll") for (int h = 0; h < 2; ++h) _Pragma("unroll") for (int i = 0; i < 2; ++i) sb.off[h][i] = voffB[i]; } } while (0)
    Unit cur, nxt; int ui = 0;
    if (!S.next(0, cur)) return;
    f32x4 acc[2][2][4][2];
#pragma unroll
    for (int a = 0; a < 2; ++a)
#pragma unroll
        for (int b = 0; b < 2; ++b)
#pragma unroll
            for (int m = 0; m < 4; ++m)
#pragma unroll
                for (int n = 0; n < 2; ++n) acc[a][b][m][n] = (f32x4){0.f, 0.f, 0.f, 0.f};
    bf16x8 At[4][2], B0[2][2], B1[2][2];
    Side cA, cB, nA, nB;
    PG8_MKSIDES(cur, cA, cB);
    PG8_STAGE(PG8_SB(0, 0), cB, 0, 0); PG8_STAGE(PG8_SB(0, 1), cB, 1, 0); PG8_STAGE(PG8_SA(0, 0), cA, 0, 0); PG8_STAGE(PG8_SA(0, 1), cA, 1, 0);
    if (wr == 1) PG8_BAR;
    PG8_WAIT_V(2); PG8_BAR;
    PG8_STAGE(PG8_SB(1, 0), cB, 0, 1); PG8_STAGE(PG8_SA(1, 0), cA, 0, 1); PG8_STAGE(PG8_SB(1, 1), cB, 1, 1);
    PG8_WAIT_V(6); PG8_BAR;
    for (;;) {
        const bool has_next = S.next(ui + 1, nxt);
        if (has_next) { PG8_MKSIDES(nxt, nA, nB); } else { nA = cA; nB = cB; }
        for (int t = 0; t < nt; t += 2) {
            const bool last = (t == nt - 2);
            if constexpr (Epi::MIDK > 0) { if (t == Epi::MIDK) E.mid(acc, cur, wr, wc, fr, fq); }
            Side a2, b2;
            a2.base[0] = last ? nA.base[0] : cA.base[0]; a2.base[1] = last ? nA.base[1] : cA.base[1];
            b2.base[0] = last ? nB.base[0] : cB.base[0]; b2.base[1] = last ? nB.base[1] : cB.base[1];
#pragma unroll
            for (int h = 0; h < 2; ++h)
#pragma unroll
                for (int i = 0; i < 2; ++i) { a2.off[h][i] = (Rows::GA && last) ? nA.off[h][i] : cA.off[h][i]; b2.off[h][i] = (Rows::GB && last) ? nB.off[h][i] : cB.off[h][i]; }
            const int k2 = last ? 0 : t + 2, k3 = k2 + 1;
            PG8_LDB(B0, 0, 0); PG8_LDB(B1, 0, 1); PG8_SCHED; PG8_LDA(At, 0, 0); PG8_STAGE(PG8_SA(1, 1), cA, 1, t + 1);
            PG8_WAIT_V(8); PG8_WAIT_L(0); PG8_BAR; PG8_MMA(0, 0, At, B0); PG8_MMA(0, 1, At, B1); PG8_BAR; PG8_SCHED;
            PG8_LDA(At, 0, 1); PG8_STAGE(PG8_SB(0, 0), b2, 0, k2); PG8_STAGE(PG8_SB(0, 1), b2, 1, k2); PG8_STAGE(PG8_SA(0, 0), a2, 0, k2);
            PG8_WAIT_V(8); PG8_WAIT_L(0); PG8_BAR; PG8_MMA(1, 0, At, B0); PG8_MMA(1, 1, At, B1); PG8_BAR; PG8_SCHED;
            PG8_LDB(B0, 1, 0); PG8_LDB(B1, 1, 1); PG8_SCHED; PG8_LDA(At, 1, 0); PG8_STAGE(PG8_SA(0, 1), a2, 1, k2);
            PG8_WAIT_V(8); PG8_WAIT_L(0); PG8_BAR; PG8_MMA(0, 0, At, B0); PG8_MMA(0, 1, At, B1); PG8_BAR; PG8_SCHED;
            PG8_LDA(At, 1, 1); PG8_STAGE(PG8_SB(1, 0), b2, 0, k3); PG8_STAGE(PG8_SB(1, 1), b2, 1, k3); PG8_STAGE(PG8_SA(1, 0), a2, 0, k3);
            PG8_WAIT_V(8); PG8_WAIT_L(0); PG8_BAR; PG8_MMA(1, 0, At, B0); PG8_MMA(1, 1, At, B1); PG8_BAR; PG8_SCHED;
        }
        if (wr == 0) PG8_BAR;
        E(acc, cur, wr, wc, fr, fq);
        if (!has_next) break;
#pragma unroll
        for (int a = 0; a < 2; ++a)
#pragma unroll
            for (int b = 0; b < 2; ++b)
#pragma unroll
                for (int m = 0; m < 4; ++m)
#pragma unroll
                    for (int n = 0; n < 2; ++n) acc[a][b][m][n] = (f32x4){0.f, 0.f, 0.f, 0.f};
        cur = nxt; cA = nA; cB = nB; ++ui;
        if (wr == 1) PG8_BAR;
    }
    PG8_WAIT_V(0);
    PG8_BAR;
#undef PG8_SA
#undef PG8_SB
#undef PG8_STAGE
#undef PG8_LDA
#undef PG8_LDB
#undef PG8_MMA
#undef PG8_WAIT_V
#undef PG8_WAIT_L
#undef PG8_BAR
#undef PG8_SCHED
#undef PG8_MKSIDES
}

struct SUnit { unsigned aoff, boff; int K; int pm, pn, kind, x0, x1, grp, dep, sig; };
__device__ __forceinline__ void st16_wt(unsigned char* wsbase, unsigned off, u32x4 v) {
    const __amdgpu_buffer_rsrc_t rsrc = __builtin_amdgcn_make_buffer_rsrc((void*)wsbase, 0, 0x7fffffff, 0x00020000);
    __builtin_amdgcn_raw_buffer_store_b128(v, rsrc, off, 0, 16); }

template <class Epi, class Sched, class Rows>
__device__ __forceinline__ void gemm_stream(LAS unsigned char* lds, const char* base, const Sched& S, const Epi& E, const Rows& RW) {
    int tid_ = threadIdx.x; asm volatile("" : "+v"(tid_));
    const int tid = tid_, wid = __builtin_amdgcn_readfirstlane(tid >> 6), lane = tid & 63, wr = wid >> 2, wc = wid & 3, fr = lane & 15, fq = lane >> 4;
    int sR[2], sRb[2], sC[2];
#pragma unroll
    for (int i = 0; i < 2; ++i) { int R, C; stage_rc(tid * 16 + i * 8192, R, C); sR[i] = R; sC[i] = C; sRb[i] = (R & ~31) + perm32(R & 31); }
    const size_t kstep = (size_t)(BK * 2);
    const unsigned ldsw = (unsigned)wid * 1024u;
    const int aoff = lds_byte(wr * 64 + fr, fq * 8), boff = lds_byte(wc * 32 + fr, fq * 8);
    struct Side { const char* base[2]; unsigned off[2][2]; };
#define PG8_SA(b, h) (((b) * 2 + (h)) * HTB)
#define PG8_SB(b, h) ((4 + (b) * 2 + (h)) * HTB)
#define PG8_STAGE(bufoff, side, h, kt) do { _Pragma("unroll") for (int _i = 0; _i < 2; ++_i) \
        __builtin_amdgcn_global_load_lds((const unsigned*)((side).base[h] + (size_t)(kt) * kstep + (side).off[h][_i]), (LAS unsigned*)(lds + (bufoff) + ldsw + _i * 8192), 16, 0, 0); } while (0)
#define PG8_LDA(dst, b, h) do { _Pragma("unroll") for (int m = 0; m < 4; ++m) _Pragma("unroll") for (int k = 0; k < 2; ++k) dst[m][k] = *(const LAS bf16x8*)(lds + PG8_SA(b, h) + aoff + m * 2048 + k * 1024); } while (0)
#define PG8_LDB(dst, b, h) do { _Pragma("unroll") for (int n = 0; n < 2; ++n) _Pragma("unroll") for (int k = 0; k < 2; ++k) dst[n][k] = *(const LAS bf16x8*)(lds + PG8_SB(b, h) + boff + n * 2048 + k * 1024); } while (0)
#define PG8_MMA(ai, bj, At, Bt) do { __builtin_amdgcn_s_setprio(1); _Pragma("unroll") for (int m = 0; m < 4; ++m) _Pragma("unroll") for (int n = 0; n < 2; ++n) _Pragma("unroll") for (int k = 0; k < 2; ++k) \
        acc[ai][bj][m][n] = __builtin_amdgcn_mfma_f32_16x16x32_bf16(Bt[n][k], At[m][k], acc[ai][bj][m][n], 0, 0, 0); __builtin_amdgcn_s_setprio(0); } while (0)
#define PG8_WAIT_V(n) asm volatile("s_waitcnt vmcnt(" #n ")" ::: "memory")
#define PG8_WAIT_L(n) asm volatile("s_waitcnt lgkmcnt(" #n ")" ::: "memory")
#define PG8_BAR __builtin_amdgcn_s_barrier()
#define PG8_SCHED __builtin_amdgcn_sched_barrier(0)
#define PG8_MKSIDES(un, sa, sb) do { const int K_ = (un).K; \
        if (RW.a_gather(un)) { sa.base[0] = sa.base[1] = base; _Pragma("unroll") for (int h = 0; h < 2; ++h) _Pragma("unroll") for (int i = 0; i < 2; ++i) sa.off[h][i] = RW.arow(un, h * HALF + sR[i]) + (unsigned)sC[i] * 2u; } \
        else { sa.base[0] = base + (un).aoff; sa.base[1] = sa.base[0] + (size_t)HALF * K_ * 2; _Pragma("unroll") for (int h = 0; h < 2; ++h) _Pragma("unroll") for (int i = 0; i < 2; ++i) sa.off[h][i] = (unsigned)(sR[i] * K_ + sC[i]) * 2u; } \
        sb.base[0] = base + (un).boff; sb.base[1] = sb.base[0] + (size_t)HALF * K_ * 2; _Pragma("unroll") for (int h = 0; h < 2; ++h) _Pragma("unroll") for (int i = 0; i < 2; ++i) sb.off[h][i] = (unsigned)(sRb[i] * K_ + sC[i]) * 2u; } while (0)
#define PG8_SIGNAL(idx) do { if (lane == 0) __hip_atomic_fetch_add(S.rdy + 64 * (idx), 1u, __ATOMIC_RELAXED, __HIP_MEMORY_SCOPE_AGENT); } while (0)
    SUnit cur, nxt;
    unsigned pend = 0u;
    const unsigned lw_addr = (unsigned)(size_t)S.lw;
    if (tid == 0) { S.lw[0] = __hip_atomic_fetch_add(S.q, 1u, __ATOMIC_RELAXED, __HIP_MEMORY_SCOPE_AGENT); pend = __hip_atomic_fetch_add(S.q, 1u, __ATOMIC_RELAXED, __HIP_MEMORY_SCOPE_AGENT); }
    __syncthreads();
    { const int L0 = __builtin_amdgcn_readfirstlane((int)S.lw[0]); if (!S.decode(L0, cur)) return; }
    f32x4 acc[2][2][4][2];
#pragma unroll
    for (int a = 0; a < 2; ++a)
#pragma unroll
        for (int b = 0; b < 2; ++b)
#pragma unroll
            for (int m = 0; m < 4; ++m)
#pragma unroll
                for (int n = 0; n < 2; ++n) acc[a][b][m][n] = (f32x4){0.f, 0.f, 0.f, 0.f};
    bf16x8 At[4][2], B0[2][2], B1[2][2];
    Side cA, cB, nA, nB;
    bool need_pro = true; int sig_idx = -1;
    PG8_MKSIDES(cur, cA, cB);
    for (;;) {
        if (need_pro) {
            if (cur.dep >= 0) S.a_ready(cur);
            PG8_STAGE(PG8_SB(0, 0), cB, 0, 0); PG8_STAGE(PG8_SB(0, 1), cB, 1, 0); PG8_STAGE(PG8_SA(0, 0), cA, 0, 0); PG8_STAGE(PG8_SA(0, 1), cA, 1, 0);
            if (wr == 1) PG8_BAR;
            PG8_WAIT_V(2); PG8_BAR;
            PG8_STAGE(PG8_SB(1, 0), cB, 0, 1); PG8_STAGE(PG8_SA(1, 0), cA, 0, 1); PG8_STAGE(PG8_SB(1, 1), cB, 1, 1);
            PG8_WAIT_V(6); PG8_BAR;
        }
        if (tid == 0) { asm volatile("s_nop 7\n\tds_write_b32 %1, %0\n\tglobal_atomic_add %0, %2, %3, %4 sc0" : "+v"(pend) : "v"(lw_addr), "v"(0u), "v"(1u), "s"(S.q) : "memory"); }
        PG8_WAIT_L(0); PG8_BAR; asm volatile("" ::: "memory");
        const int Ln = __builtin_amdgcn_readfirstlane((int)S.lw[0]);
        const bool has_next = S.decode(Ln, nxt), pre = has_next && nxt.dep < 0;
        if (pre) { PG8_MKSIDES(nxt, nA, nB); } else { nA = cA; nB = cB; }
        const int nt = cur.K / BK;
        for (int t = 0; t < nt; t += 2) {
            const bool last = (t == nt - 2);
            Side a2, b2;
            a2.base[0] = last ? nA.base[0] : cA.base[0]; a2.base[1] = last ? nA.base[1] : cA.base[1];
            b2.base[0] = last ? nB.base[0] : cB.base[0]; b2.base[1] = last ? nB.base[1] : cB.base[1];
#pragma unroll
            for (int h = 0; h < 2; ++h)
#pragma unroll
                for (int i = 0; i < 2; ++i) { a2.off[h][i] = last ? nA.off[h][i] : cA.off[h][i]; b2.off[h][i] = last ? nB.off[h][i] : cB.off[h][i]; }
            const int k2 = last ? 0 : t + 2, k3 = k2 + 1;
            if (t == 2 && sig_idx >= 0) { PG8_SIGNAL(sig_idx); sig_idx = -1; }
            PG8_LDB(B0, 0, 0); PG8_LDB(B1, 0, 1); PG8_SCHED; PG8_LDA(At, 0, 0); PG8_STAGE(PG8_SA(1, 1), cA, 1, t + 1);
            PG8_WAIT_V(8); PG8_WAIT_L(0); PG8_BAR; PG8_MMA(0, 0, At, B0); PG8_MMA(0, 1, At, B1); PG8_BAR; PG8_SCHED;
            PG8_LDA(At, 0, 1); PG8_STAGE(PG8_SB(0, 0), b2, 0, k2); PG8_STAGE(PG8_SB(0, 1), b2, 1, k2); PG8_STAGE(PG8_SA(0, 0), a2, 0, k2);
            PG8_WAIT_V(8); PG8_WAIT_L(0); PG8_BAR; PG8_MMA(1, 0, At, B0); PG8_MMA(1, 1, At, B1); PG8_BAR; PG8_SCHED;
            PG8_LDB(B0, 1, 0); PG8_LDB(B1, 1, 1); PG8_SCHED; PG8_LDA(At, 1, 0); PG8_STAGE(PG8_SA(0, 1), a2, 1, k2);
            PG8_WAIT_V(8); PG8_WAIT_L(0); PG8_BAR; PG8_MMA(0, 0, At, B0); PG8_MMA(0, 1, At, B1); PG8_BAR; PG8_SCHED;
            PG8_LDA(At, 1, 1); PG8_STAGE(PG8_SB(1, 0), b2, 0, k3); PG8_STAGE(PG8_SB(1, 1), b2, 1, k3); PG8_STAGE(PG8_SA(1, 0), a2, 0, k3);
            PG8_WAIT_V(8); PG8_WAIT_L(0); PG8_BAR; PG8_MMA(1, 0, At, B0); PG8_MMA(1, 1, At, B1); PG8_BAR; PG8_SCHED;
        }
        if (wr == 0) PG8_BAR;
        E(acc, cur, wr, wc, fr, fq);
        if (!has_next) { PG8_WAIT_V(0); if (cur.sig >= 0) PG8_SIGNAL(cur.sig); break; }
#pragma unroll
        for (int a = 0; a < 2; ++a)
#pragma unroll
            for (int b = 0; b < 2; ++b)
#pragma unroll
                for (int m = 0; m < 4; ++m)
#pragma unroll
                    for (int n = 0; n < 2; ++n) acc[a][b][m][n] = (f32x4){0.f, 0.f, 0.f, 0.f};
        if (pre) {
            sig_idx = cur.sig; need_pro = false; cur = nxt; cA = nA; cB = nB;
            if (wr == 1) PG8_BAR;
        } else {
            PG8_WAIT_V(0); if (cur.sig >= 0) PG8_SIGNAL(cur.sig);
            PG8_BAR; need_pro = true; cur = nxt; PG8_MKSIDES(cur, cA, cB);
        }
    }
    PG8_BAR;
#undef PG8_SA
#undef PG8_SB
#undef PG8_STAGE
#undef PG8_LDA
#undef PG8_LDB
#undef PG8_MMA
#undef PG8_WAIT_V
#undef PG8_WAIT_L
#undef PG8_BAR
#undef PG8_SCHED
#undef PG8_MKSIDES
#undef PG8_SIGNAL
}
}
using pg8::Unit;
using pg8::SUnit;

struct Args { const float* in[21]; float* out; unsigned char* ws; int ph_lo, ph_hi; };

struct Frame {
    LAS unsigned char* lds;
    unsigned char* ws;
    const float* const* in;
    float* out;
    int tid, lane, wave, G, bx;
};
__device__ __forceinline__ float* modp(const Frame& F, int l, int v) { return (float*)(F.ws + WS_CTL) + CW_MOD + (l * 3 + v) * MODSZ; }

__device__ __forceinline__ void p0_transpose_item(const float* W, int ldw, int k0, int c0, bf16_t* WT, int ldt, int drow, int lane) {
    const float* src = W + (size_t)k0 * ldw + c0 + lane;
    float v[64];
#pragma unroll
    for (int i = 0; i < 64; ++i) v[i] = src[(size_t)i * ldw];
    bf16_t* dst = WT + (size_t)drow * ldt + k0;
#pragma unroll
    for (int j = 0; j < 8; ++j) { u32x4 o; o.x = pk2(v[8 * j], v[8 * j + 1]); o.y = pk2(v[8 * j + 2], v[8 * j + 3]); o.z = pk2(v[8 * j + 4], v[8 * j + 5]); o.w = pk2(v[8 * j + 6], v[8 * j + 7]);
        *(u32x4*)(dst + 8 * j) = o; }
}

constexpr int CW_CONVQ = 12288 + 128;
constexpr int MOE_I_GE = 16 * 56, MOE_I_DE = 56 * 16, MOE_ITEMS = NE * (2 * MOE_I_GE + MOE_I_DE), MOE_BATCHES = MOE_ITEMS / 8;
__device__ __forceinline__ void moe_convert_batch(Frame& F, int which, int idx) {
    const float* const* in = F.in; const int ln = F.lane;
    int r = idx * 8 + F.wave;
    if (which == 0) { const int e = r / (2 * MOE_I_GE); r %= (2 * MOE_I_GE); const int up = r / MOE_I_GE; r %= MOE_I_GE; const int kb = r / 56, nb = r % 56, c0 = 64 * nb;
        p0_transpose_item(in[up ? 18 : 17] + (size_t)e * D * DFFE, DFFE, 64 * kb, c0, (bf16_t*)(F.ws + WS_WGUE) + (size_t)e * 2 * DFFE * D, D, (c0 >> 7) * 256 + up * 128 + (c0 & 127) + ln, ln); }
    else { const int e = r / MOE_I_DE; r %= MOE_I_DE; const int kb = r / 16, nb = r % 16;
        p0_transpose_item(in[19] + (size_t)e * DFFE * D, D, 64 * kb, 64 * nb, (bf16_t*)(F.ws + WS_WDE) + (size_t)e * D * DFFE, DFFE, 64 * nb + ln, ln); }
}
__device__ __forceinline__ void moe_convert(Frame& F, int which) {
    volatile LAS unsigned* lw = (volatile LAS unsigned*)(F.lds + MISC_OFF) + 20;
    unsigned* q = (unsigned*)(F.ws + WS_CTL) + CW_CONVQ + 64 * which;
    const int nb = which == 0 ? NE * 2 * MOE_I_GE / 8 : NE * MOE_I_DE / 8;
    for (;;) {
        __syncthreads();
        if (F.tid == 0) lw[0] = __hip_atomic_fetch_add(q, 1u, __ATOMIC_RELAXED, __HIP_MEMORY_SCOPE_AGENT);
        __syncthreads();
        const int idx = (int)lw[0];
        if (idx >= nb) break;
        moe_convert_batch(F, which, idx);
    }
    __syncthreads();
}

__device__ __forceinline__ void p0_prologue(Frame& F) {
    const float* const* in = F.in;
    const int gw = F.bx * NWAVES + F.wave, NGW = F.G * NWAVES;
    {
        constexpr int I_IN = 16 * 44, I_O = 16 * 16, I_GD = 16 * 44, I_DD = 44 * 16;
        constexpr int N_A = 2 * I_IN + 2 * I_O + 2 * I_GD + I_DD;
        const int ln = F.lane;
        for (int it = gw; it < N_A; it += NGW) {
            int r = it;
            if (r < 2 * I_IN) { const int l = r / I_IN; r %= I_IN; const int kb = r / 44, nb = r % 44, c0 = 512 + 64 * nb;
                const int n32 = ln & 31; const int dn = c0 < OFFV ? (ln & 32) + ((n32 < 16) ? 2 * n32 : 2 * (n32 - 16) + 1) : ln;
                p0_transpose_item(in[8] + (size_t)l * D * INW, INW, 64 * kb, c0, (bf16_t*)(F.ws + (l ? WS_WIN1 : WS_WIN0)), D, c0 + dn, ln); continue; }
            r -= 2 * I_IN;
            if (r < 2 * I_O) { const int l = r / I_O; r %= I_O; const int kb = r / 16, nb = r % 16;
                p0_transpose_item(in[12] + (size_t)l * D * D, D, 64 * kb, 64 * nb, (bf16_t*)(F.ws + (l ? WS_WO1 : WS_WO0)), D, 64 * nb + ln, ln); continue; }
            r -= 2 * I_O;
            if (r < 2 * I_GD) { const int up = r / I_GD; r %= I_GD; const int kb = r / 44, nb = r % 44, c0 = 64 * nb;
                p0_transpose_item(in[up ? 14 : 13], DFF0, 64 * kb, c0, (bf16_t*)(F.ws + WS_WGUD), D, (c0 >> 7) * 256 + up * 128 + (c0 & 127) + ln, ln); continue; }
            r -= 2 * I_GD;
            { const int kb = r / 16, nb = r % 16;
              p0_transpose_item(in[15], D, 64 * kb, 64 * nb, (bf16_t*)(F.ws + WS_WDD), DFF0, 64 * nb + ln, ln); }
        }
    }
    __syncthreads();
    {
        LAS float* wrow = (LAS float*)F.lds;
        LAS float* ctab = wrow + 4096;
        if (F.tid < 128) ctab[F.tid] = cospif((float)F.tid / 64.0f);
        for (int it = F.bx; it < 2 * 128; it += F.G) {
            const int l = it >> 7, d0 = (it & 127) * 8;
            __syncthreads();
            for (int i = F.tid; i < 4096; i += NTHR) wrow[i] = in[8][(size_t)l * D * INW + (size_t)(d0 + (i >> 9)) * INW + (i & 511)];
            __syncthreads();
            const int r = F.tid, j = r >> 1, ri = r & 1, g = j >> 6, jj = j & 63;
            float a[8];
#pragma unroll
            for (int q = 0; q < 8; ++q) a[q] = 0.f;
            for (int cc = 0; cc < 128; ++cc) {
                float cf;
                if (jj == 0) cf = ri ? ((cc & 1) ? -1.f : 1.f) : 1.f;
                else { const int idx = (cc * jj) & 127; cf = ri ? -ctab[(idx - 32) & 127] : ctab[idx]; }
#pragma unroll
                for (int q = 0; q < 8; ++q) a[q] += cf * wrow[q * 512 + g * 128 + cc];
            }
            u32x4 o; o.x = pk2(a[0], a[1]); o.y = pk2(a[2], a[3]); o.z = pk2(a[4], a[5]); o.w = pk2(a[6], a[7]);
            *(u32x4*)((bf16_t*)(F.ws + (l ? WS_WIN1 : WS_WIN0)) + (size_t)r * D + d0) = o;
        }
        __syncthreads();
    }
    const int gt = F.bx * NTHR + F.tid, NGT = F.G * NTHR;
    for (int it = gt; it < 2 * 1024 * 144; it += NGT) {
        const int l = it / (1024 * 144), r = it % (1024 * 144), kc = r / 1024, o = r % 1024;
        const float* wf = in[10] + (size_t)l * 512 * D; const float* wa = in[11] + (size_t)l * 512 * D;
        float v[8];
#pragma unroll
        for (int q = 0; q < 8; ++q) { const int k = kc * 8 + q; float x = 0.f;
            if (k < 512) { const int mm = k & 127; x = wf[(size_t)k * D + o] * ((mm == 0 || mm == 64) ? 0.5f : 1.f); }
            else if (k < 520) { const int gg = (k - 512) >> 1, sgn = (k - 512) & 1; x = 0.5f * wf[(size_t)(gg * 128 + 64 * sgn) * D + o]; }
            else if (k >= 640) x = wa[(size_t)(k - 640) * D + o];
            v[q] = x; }
        u32x4 w; w.x = pk2(v[0], v[1]); w.y = pk2(v[2], v[3]); w.z = pk2(v[4], v[5]); w.w = pk2(v[6], v[7]);
        *(u32x4*)((bf16_t*)(F.ws + (l ? WS_WM1 : WS_WM0)) + (size_t)o * KM + kc * 8) = w;
    }
    for (int it = gt; it < 192 * 16; it += NGT) {
        const int i = it & 15, p = it >> 4, pos = p < 128 ? p : p - 128;
        const float inv = powf(10000.0f, -(float)i / 16.0f), a = (float)pos * inv;
        ((f32x2*)(F.ws + WS_ROPE))[it] = (f32x2){cosf(a), sinf(a)};
    }
    for (int it = gt; it < 128 * 64; it += NGT) {
        const int t2 = it >> 6, k1 = it & 63; float s, c; sincospif((float)(t2 * k1) / 4096.0f, &s, &c);
        ((f32x2*)(F.ws + WS_TW))[it] = (f32x2){c, s};
    }
    for (int it = gt; it < 256 * 128; it += NGT) {
        const int nu = it >> 7, ka = it & 127; float v = 0.f;
        if (nu < 128) { const int k1 = nu >> 1, ro = nu & 1, ri = ka >> 6, t1 = ka & 63; float s, c; sincospif((float)((t1 * k1) & 63) / 32.0f, &s, &c);
            v = ro == 0 ? (ri == 0 ? c : s) : (ri == 0 ? -s : c); }
        ((bf16_t*)(F.ws + WS_FA64))[it] = (bf16_t)f2bf(v);
    }
    for (int it = gt; it < 256 * 256; it += NGT) {
        const int mu = it >> 8, la = it & 255, k2 = mu >> 1, ro = mu & 1, ri = la >> 7, t2 = la & 127; float s, c; sincospif((float)((t2 * k2) & 127) / 64.0f, &s, &c);
        const float v = (ro == 0 ? (ri == 0 ? c : s) : (ri == 0 ? -s : c)) * 0.0009765625f;
        ((bf16_t*)(F.ws + WS_TC))[it] = (bf16_t)f2bf(v);
    }
    for (int it = gt; it < 512 * 512; it += NGT) {
        const int mu = it >> 9, la = it & 511, k = mu >> 1, ro = mu & 1, ri = la >> 8, t = la & 255; float s, c; sincospif((float)((t * k) & 255) / 128.0f, &s, &c);
        const float v = (ro == 0 ? (ri == 0 ? c : s) : (ri == 0 ? -s : c)) * 0.005524271728019903f;
        ((bf16_t*)(F.ws + WS_TX))[it] = (bf16_t)f2bf(v);
    }
    __syncthreads();
    {
        LAS float* sl = (LAS float*)F.lds;
        LAS float* part = sl + 3 * D;
        for (int i = F.tid; i < 3 * D; i += NTHR) { const float c = i < 2 * D ? in[1][i] : in[3][i - 2 * D]; sl[i] = c / (1.0f + __expf(-c)); }
        __syncthreads();
        for (int it = F.bx; it < 2 * 96; it += F.G) {
            const int l = it / 96, n = (it % 96) * 64 + F.lane;
            const float* wm = in[4] + (size_t)l * D * MODSZ + (size_t)(F.wave * 128) * MODSZ + n;
            float a0 = 0.f, a1 = 0.f, a2 = 0.f;
#pragma unroll
            for (int d0 = 0; d0 < 128; d0 += 32) { float w[32];
#pragma unroll
                for (int q = 0; q < 32; ++q) w[q] = wm[(size_t)(d0 + q) * MODSZ];
#pragma unroll
                for (int q = 0; q < 32; ++q) { const int d = F.wave * 128 + d0 + q; a0 += sl[d] * w[q]; a1 += sl[D + d] * w[q]; a2 += sl[2 * D + d] * w[q]; } }
            __syncthreads();
            part[(F.wave * 3 + 0) * 64 + F.lane] = a0; part[(F.wave * 3 + 1) * 64 + F.lane] = a1; part[(F.wave * 3 + 2) * 64 + F.lane] = a2;
            __syncthreads();
            if (F.tid < 192) { const int v = F.tid >> 6, ln = F.tid & 63; float sacc = in[5][l * MODSZ + (it % 96) * 64 + ln];
#pragma unroll
                for (int w = 0; w < 8; ++w) sacc += part[(w * 3 + v) * 64 + ln];
                modp(F, l, v)[(it % 96) * 64 + ln] = sacc; }
        }
    }
    for (int it = gt; it < NTOK * 15; it += NGT) { const int row = it / 15, c = it % 15;
        *(u32x4*)((bf16_t*)(F.ws + WS_FO) + (size_t)row * KM + 520 + c * 8) = (u32x4){0u, 0u, 0u, 0u}; }
}

__device__ __forceinline__ const float* xrow_ptr(const Frame& F, int row, const float* xl) { return row < NL ? xl + (size_t)row * D : (const float*)(F.ws + WS_XC) + (size_t)(row - NL) * D; }

template <bool ROUTE>
__device__ __forceinline__ void norm_phase(Frame& F, int l, int which  , const float* xl, const float* xc, int nrows, const float* xcadd = nullptr, float* xcwb = nullptr) {
    const float* gvec = F.in[which ? 7 : 6] + l * D;
    LAS float* wr_l = (LAS float*)F.lds;
    if (ROUTE) { for (int i = F.tid; i < D * NE; i += NTHR) wr_l[i] = F.in[16][i]; __syncthreads(); }
    const int gw = F.bx * NWAVES + F.wave, NGW = F.G * NWAVES;
    for (int row = gw; row < nrows; row += NGW) {
        const int v = row < T ? 0 : (row < NL ? 1 : 2);
        const bool fromb = row < NL && xl == nullptr;
        const float* xr = row < NL ? (fromb ? xc : xl + (size_t)row * D) : xc + (size_t)(row - NL) * D;
        const bf16_t* xbr = (const bf16_t*)(F.ws + WS_XB) + (size_t)row * D;
        const float* sh = modp(F, l, v) + (which ? 3 : 0) * D; const float* sc = sh + D;
        f32x4 x[4]; float s = 0.f;
#pragma unroll
        for (int j = 0; j < 4; ++j) {
            if (fromb) { const u32x2 xb = *(const u32x2*)(xbr + 256 * j + 4 * F.lane); x[j] = (f32x4){bflo(xb.x), bfhi(xb.x), bflo(xb.y), bfhi(xb.y)}; }
            else x[j] = *(const f32x4*)(xr + 256 * j + 4 * F.lane);
            if (row >= NL && xcadd) { x[j] = x[j] + *(const f32x4*)(xcadd + (size_t)(row - NL) * D + 256 * j + 4 * F.lane); if (xcwb) *(f32x4*)(xcwb + (size_t)(row - NL) * D + 256 * j + 4 * F.lane) = x[j]; }
            s += (x[j].x * x[j].x + x[j].y * x[j].y) + (x[j].z * x[j].z + x[j].w * x[j].w); }
        const float r = 1.0f / sqrtf(wave_sum(s) * (1.f / D) + EPS);
        float lg[NE];
        if (ROUTE) {
#pragma unroll
            for (int e = 0; e < NE; ++e) lg[e] = 0.f; }
        bf16_t* hr = (bf16_t*)(F.ws + WS_H) + (size_t)row * D;
#pragma unroll
        for (int j = 0; j < 4; ++j) { const int c = 256 * j + 4 * F.lane;
            const f32x4 gg = *(const f32x4*)(gvec + c), s4 = *(const f32x4*)(sh + c), c4 = *(const f32x4*)(sc + c);
            f32x4 h = (x[j] * r) * gg; h = h * (c4 + 1.0f) + s4;
            u32x2 o; o.x = pk2(h.x, h.y); o.y = pk2(h.z, h.w); *(u32x2*)(hr + c) = o;
            if (ROUTE) {
#pragma unroll
                for (int q = 0; q < 4; ++q) { const float hv = h[q]; const LAS f32x4* w = (const LAS f32x4*)(wr_l + (c + q) * NE); const f32x4 w0 = w[0], w1 = w[1];
                    lg[0] += hv * w0.x; lg[1] += hv * w0.y; lg[2] += hv * w0.z; lg[3] += hv * w0.w; lg[4] += hv * w1.x; lg[5] += hv * w1.y; lg[6] += hv * w1.z; lg[7] += hv * w1.w; } }
        }
        if (ROUTE) {
#pragma unroll
            for (int e = 0; e < NE; ++e) lg[e] = wave_sum(lg[e]);
            if (F.lane == 0) {
                int e1 = 0; float v1 = lg[0];
#pragma unroll
                for (int e = 1; e < NE; ++e) if (lg[e] > v1) { v1 = lg[e]; e1 = e; }
                int e2 = -1; float v2 = -3.0e38f;
#pragma unroll
                for (int e = 0; e < NE; ++e) if (e != e1 && lg[e] > v2) { v2 = lg[e]; e2 = e; }
                const float p2 = __expf(v2 - v1), w1 = 1.f / (1.f + p2), w2 = p2 * w1;
                unsigned* cnt = (unsigned*)(F.ws + WS_CTL) + CW_CNT;
                const unsigned r1 = atomicAdd(cnt + 64 * e1, 1u), r2 = atomicAdd(cnt + 64 * e2, 1u);
                int* toke = (int*)(F.ws + WS_TOKE); int* tokr = (int*)(F.ws + WS_TOKR); float* tokw = (float*)(F.ws + WS_TOKW); int* list = (int*)(F.ws + WS_LIST);
                toke[2 * row] = e1; toke[2 * row + 1] = e2; tokr[2 * row] = (int)r1; tokr[2 * row + 1] = (int)r2; tokw[2 * row] = w1; tokw[2 * row + 1] = w2;
                list[e1 * NL + r1] = row; list[e2 * NL + r2] = row;
            }
        }
    }
}

constexpr int TAILQ_ROWS = 8 * 256;
__device__ __forceinline__ int moe_tail_panels(const unsigned* cw, int G) { int ptot = 0, plast = 0;
#pragma unroll
    for (int e = 0; e < NE; ++e) { const int p_ = ((int)cw[64 * e] + 255) >> 8; ptot += p_; plast = p_; }
    const int left = (4 * ptot) % G; int t = (left + 3) >> 2; if (4 * ptot < G) t = 0; if (t > plast) t = plast; if (t > 8) t = 8; return t; }
__device__ __forceinline__ void final_phase(Frame& F) {
    const int gw = F.bx * NWAVES + F.wave, NGW = F.G * NWAVES;
    const unsigned* cnt = (const unsigned*)(F.ws + WS_CTL) + CW_CNT;
    int base[NE]; { int b = 0;
#pragma unroll
        for (int e = 0; e < NE; ++e) { base[e] = b; b += ((int)cnt[64 * e] + 255) & ~255; } }
    const int* toke = (const int*)(F.ws + WS_TOKE); const int* tokr = (const int*)(F.ws + WS_TOKR); const float* tokw = (const float*)(F.ws + WS_TOKW);
    const bf16_t* dout = (const bf16_t*)(F.ws + WS_DOUT); const bf16_t* tq = (const bf16_t*)(F.ws + WS_DOUT1);
    const int trim_ = moe_tail_panels(cnt, F.G), trow0 = trim_ > 0 ? base[NE - 1] + ((((int)cnt[64 * (NE - 1)] + 255) >> 8) - trim_) * 256 : 0x7fffffff;
    for (int row = gw; row < NL; row += NGW) {
        const int v = row < T ? 0 : 1;
        const float* ga2 = modp(F, 1, v) + 5 * D;
        const int e1 = toke[2 * row], e2 = toke[2 * row + 1];
        int b1 = 0, b2 = 0;
#pragma unroll
        for (int e = 0; e < NE; ++e) { if (e == e1) b1 = base[e]; if (e == e2) b2 = base[e]; }
        const bf16_t* d1 = dout + (size_t)(b1 + tokr[2 * row]) * D; const bf16_t* d2 = dout + (size_t)(b2 + tokr[2 * row + 1]) * D;
        const int r1_ = b1 + tokr[2 * row], r2_ = b2 + tokr[2 * row + 1];
        const bool t1 = r1_ >= trow0, t2 = r2_ >= trow0;
        const bf16_t* q1 = tq + (size_t)(t1 ? r1_ - trow0 : 0) * D; const bf16_t* q2 = tq + (size_t)(t2 ? r2_ - trow0 : 0) * D;
        const float w1 = tokw[2 * row], w2 = tokw[2 * row + 1];
        float* xr = F.out + (size_t)row * D;
        f32x4 x[4]; float s = 0.f;
#pragma unroll
        for (int j = 0; j < 4; ++j) { const int c = 256 * j + 4 * F.lane;
            const u32x2 a = *(const u32x2*)(d1 + c), b = *(const u32x2*)(d2 + c); const f32x4 g4 = *(const f32x4*)(ga2 + c);
            f32x4 ya = (f32x4){bflo(a.x), bfhi(a.x), bflo(a.y), bfhi(a.y)}, yb = (f32x4){bflo(b.x), bfhi(b.x), bflo(b.y), bfhi(b.y)};
            if (t1) {
#pragma unroll
                for (int k = 0; k < 3; ++k) { const u32x2 e_ = *(const u32x2*)(q1 + (size_t)k * TAILQ_ROWS * D + c); ya = ya + (f32x4){bflo(e_.x), bfhi(e_.x), bflo(e_.y), bfhi(e_.y)}; } }
            if (t2) {
#pragma unroll
                for (int k = 0; k < 3; ++k) { const u32x2 e_ = *(const u32x2*)(q2 + (size_t)k * TAILQ_ROWS * D + c); yb = yb + (f32x4){bflo(e_.x), bfhi(e_.x), bflo(e_.y), bfhi(e_.y)}; } }
            const f32x4 y = ya * w1 + yb * w2;
            { const u32x2 xb = *(const u32x2*)((const bf16_t*)(F.ws + WS_XB) + (size_t)row * D + c); x[j] = (f32x4){bflo(xb.x), bfhi(xb.x), bflo(xb.y), bfhi(xb.y)} + g4 * y; }
            s += (x[j].x * x[j].x + x[j].y * x[j].y) + (x[j].z * x[j].z + x[j].w * x[j].w); }
        const float r = 1.0f / sqrtf(wave_sum(s) * (1.f / D) + EPS);
#pragma unroll
        for (int j = 0; j < 4; ++j) { const int c = 256 * j + 4 * F.lane; *(f32x4*)(xr + c) = (x[j] * r) * *(const f32x4*)(F.in[20] + c); }
    }
}

struct GridSched { int nM, nN, G, c; unsigned abytes, bbytes;
    __device__ __forceinline__ bool next(int i, Unit& u) const { const int L = i * G + c; if (L >= nM * nN) return false; pg8::swz_map(L, nM, nN, u.pm, u.pn); u.aoff = (unsigned)u.pm * abytes; u.boff = (unsigned)u.pn * bbytes; u.kind = 0; u.x0 = 0; u.x1 = 0; u.kh = 0; return true; } };

struct CtxSched { int G, c, nN; unsigned abytes, bbytes; int ksplit; unsigned khbytes;
    __device__ __forceinline__ bool next(int i, Unit& u) const { int L = i * G + c; if (L >= 2 * nN * ksplit) return false; u.kh = L / (2 * nN); L -= u.kh * 2 * nN; u.pm = 64 + L / nN; u.pn = L % nN;
        u.aoff = (unsigned)u.pm * abytes + (unsigned)u.kh * khbytes; u.boff = (unsigned)u.pn * bbytes + (unsigned)u.kh * khbytes; u.kind = 0; u.x0 = u.pm * 256; u.x1 = 0; return true; } };

struct InprojSched { int G, c, l;
    __device__ __forceinline__ bool next(int i, Unit& u) const { const int L = i * G + c; const int nmain = 64 * 11;
        if (L < nmain) { pg8::swz_map(L, 64, 11, u.pm, u.pn); }
        else { const int r = L - nmain; if (l == 0) { if (r >= 22) return false; u.pm = 64 + r / 11; u.pn = r % 11; } else { if (r >= 2) return false; u.pm = 64 + r; u.pn = 2; } }
        u.aoff = (unsigned)u.pm * (256u * D * 2u); u.boff = (unsigned)u.pn * (256u * D * 2u); u.kind = 0; u.x0 = 0; u.x1 = 0; u.kh = 0; return true; } };

struct EpiInproj {
    static constexpr bool PERM = true; static constexpr int MIDK = 0;
    unsigned char* ws;
    __device__ __forceinline__ void operator()(const f32x4 (&acc)[2][2][4][2], const Unit& u, int wr, int wc, int fr, int fq) const {
        const int row0 = u.pm * 256 + wr * 64 + fr;
        const bool lat = u.pm < 64;
        const f32x2* rope = (const f32x2*)(ws + WS_ROPE);
#pragma unroll
        for (int ai = 0; ai < 2; ++ai)
#pragma unroll
            for (int m = 0; m < 4; ++m) {
                const int row = row0 + ai * 128 + m * 16;
                const int t = row & (T - 1), prow = t >> 6, pcol = t & 63;
#pragma unroll
                for (int bj = 0; bj < 2; ++bj) {
                    const int cl = u.pn * 256 + bj * 128 + wc * 32 + 8 * fq;
                    f32x4 v0 = acc[ai][bj][m][0], v1 = acc[ai][bj][m][1];
                    bf16_t* dst;
                    if (cl < 640) {
                        if (lat) { const int dh = cl & 63, i0 = (dh & 31) >> 1; const f32x2* rp = rope + ((dh < 32 ? prow : 128 + pcol) * 16 + i0);
                            const f32x2 c0 = rp[0], c1 = rp[1], c2 = rp[2], c3 = rp[3];
                            f32x4 w0, w1; w0.x = v0.x * c0.x - v0.y * c0.y; w0.y = v0.x * c0.y + v0.y * c0.x; w0.z = v0.z * c1.x - v0.w * c1.y; w0.w = v0.z * c1.y + v0.w * c1.x;
                            w1.x = v1.x * c2.x - v1.y * c2.y; w1.y = v1.x * c2.y + v1.y * c2.x; w1.z = v1.z * c3.x - v1.w * c3.y; w1.w = v1.z * c3.y + v1.w * c3.x; v0 = w0; v1 = w1; }
                        if (cl < 512) { v0 = v0 * QSCALE; v1 = v1 * QSCALE; dst = (bf16_t*)(ws + WS_Q) + (size_t)row * 512 + cl; }
                        else dst = (bf16_t*)(ws + WS_KB) + (size_t)row * 128 + (cl - 512);
                    } else if (cl < 768) { dst = (bf16_t*)(ws + WS_VB) + (size_t)row * 128 + (cl - 640); }
                    else { const int cg = cl - 768;
#pragma unroll
                        for (int q = 0; q < 4; ++q) { v0[q] = sigmoidf_(v0[q]); v1[q] = sigmoidf_(v1[q]); }
                        dst = (cg < 1024 ? (bf16_t*)(ws + WS_GF) + (size_t)row * D + cg : (bf16_t*)(ws + WS_GA) + (size_t)row * D + (cg - 1024)); }
                    u32x4 w; w.x = cvt_pk_bf16(v0[0], v0[1]); w.y = cvt_pk_bf16(v0[2], v0[3]); w.z = cvt_pk_bf16(v1[0], v1[1]); w.w = cvt_pk_bf16(v1[2], v1[3]);
                    *(u32x4*)dst = w;
                }
            }
    }
};

struct UpermSched { int G, c, l;
    __device__ __forceinline__ bool next(int i, Unit& u) const { const int L = i * G + c; const int nn = l == 0 ? 66 : 64; if (L >= 2 * nn) return false;
        u.pm = L & 1; u.pn = L >> 1; u.aoff = (unsigned)u.pm * (256u * D * 2u); u.boff = 0; u.kind = 0; u.x0 = 0; u.x1 = 0; u.kh = 0; return true; } };
struct UpermRows { static constexpr bool GA = false, GB = true;
    __device__ __forceinline__ unsigned arow(const Unit&, int) const { return 0u; }
    __device__ __forceinline__ unsigned brow(const Unit& u, int c) const { const int n = u.pn; int row;
        if (n < 64) { const int b = n >> 5, q = n & 31; row = b * T + 128 * (c & 63) + 4 * q + (c >> 6); } else row = NL + (n - 64) * 256 + c;
        return (unsigned)row * (D * 2u); } };
struct EpiUperm {
    static constexpr bool PERM = true; static constexpr int MIDK = 0;
    unsigned char* ws;
    __device__ __forceinline__ void operator()(const f32x4 (&acc)[2][2][4][2], const Unit& u, int wr, int wc, int fr, int fq) const {
        const int n = u.pn;
#pragma unroll
        for (int ai = 0; ai < 2; ++ai)
#pragma unroll
            for (int m = 0; m < 4; ++m) { const int r = u.pm * 256 + ai * 128 + wr * 64 + m * 16 + fr, j = r >> 1, ri = r & 1;
#pragma unroll
                for (int bj = 0; bj < 2; ++bj) { const int c = bj * 128 + wc * 32 + 8 * fq;
                    const f32x4 v0 = acc[ai][bj][m][0], v1 = acc[ai][bj][m][1];
                    u32x4 w; w.x = cvt_pk_bf16(v0[0], v0[1]); w.y = cvt_pk_bf16(v0[2], v0[3]); w.z = cvt_pk_bf16(v1[0], v1[1]); w.w = cvt_pk_bf16(v1[2], v1[3]);
                    bf16_t* dst;
                    if (n < 64) { const int b = n >> 5, q = n & 31, t2 = 4 * q + (c >> 6), t1 = c & 63; dst = (bf16_t*)(ws + WS_UP) + ((size_t)((j * 2 + b) * 128 + t2) * 128 + ri * 64 + t1); }
                    else { const int b = n - 64; dst = (bf16_t*)(ws + WS_VCT) + ((size_t)((b * 256 + j) * 2 + ri) * 256 + c); }
                    *(u32x4*)dst = w; } }
    }
};

struct StepASched { int G, c, l;
    __device__ __forceinline__ bool next(int i, Unit& u) const { int L = i * G + c;
        if (l == 0 && G == 256) { if (c >= 16 && c < 20) return false; if (c >= 20 && c < 24) { if (i > 1) return false; L = i == 0 ? c : c - 4; } else if (i > 0) return false; }
        if (L >= 256) return false; pg8::swz_map(L, 256, 1, u.pm, u.pn); u.aoff = (unsigned)u.pm * (256u * 128u * 2u); u.boff = 0u; u.kind = 0; u.x0 = 0; u.x1 = 0; u.kh = 0; return true; } };

struct EpiStepA {
    static constexpr bool PERM = true; static constexpr int MIDK = 0;
    unsigned char* ws;
    __device__ __forceinline__ void operator()(const f32x4 (&acc)[2][2][4][2], const Unit& u, int wr, int wc, int fr, int fq) const {
        const f32x2* tw = (const f32x2*)(ws + WS_TW); bf16_t* gp = (bf16_t*)(ws + WS_GP);
        const int j = u.pm;
#pragma unroll
        for (int ai = 0; ai < 2; ++ai)
#pragma unroll
            for (int m = 0; m < 4; ++m) { const int t2 = wr * 64 + m * 16 + fr, b = ai;
#pragma unroll
                for (int n = 0; n < 2; ++n) { const f32x4 v = acc[ai][0][m][n];
#pragma unroll
                    for (int p = 0; p < 2; ++p) { const int k1 = 16 * wc + 4 * fq + 2 * n + p; const f32x2 w = tw[t2 * 64 + k1];
                        const float gr = v[2 * p], gi = v[2 * p + 1];
                        const float orr = gr * w.x + gi * w.y, oi = gi * w.x - gr * w.y;
                        bf16_t* d = gp + ((size_t)((b * 64 + k1) * 256 + j) * 256 + t2);
                        d[0] = (bf16_t)f2bf(orr); d[128] = (bf16_t)f2bf(oi); } } }
    }
};
template <bool CTXV> struct EpiStepC {
    static constexpr bool PERM = true; static constexpr int MIDK = 0;
    unsigned char* ws;
    __device__ __forceinline__ void operator()(const f32x4 (&acc)[2][2][4][2], const Unit& u, int wr_, int wc_, int fr_, int fq_) const {
        int wr = wr_, wc = wc_, fr = fr_, fq = fq_, upm = u.pm, upn = u.pn;
        asm volatile("" : "+s"(wr), "+s"(wc), "+v"(fr), "+v"(fq), "+s"(upm), "+s"(upn));
        bf16_t* fo = (bf16_t*)(ws + WS_FO);
        const int NN = CTXV ? 256 : T;
        const int b = CTXV ? upm : (upm >> 6), k1 = CTXV ? 0 : (upm & 63), rowb = CTXV ? NL + b * 256 : b * T;
        const int own0 = wr * 128 + fr, mir0 = wr * 128 + 128 - fr;
        const int kk0 = (CTXV ? 128 * upn : 0) + 16 * wc + 4 * fq;
#pragma unroll
        for (int bj = 0; bj < 2; ++bj)
#pragma unroll
            for (int n = 0; n < 2; ++n)
#pragma unroll
                for (int p = 0; p < 2; ++p) {
                    const int kk = kk0 + 64 * bj + 2 * n + p;
                    const int k = CTXV ? kk : (k1 + 64 * kk), km = (NN - k) & (NN - 1);
                    const unsigned oo = (unsigned)(rowb + k) * KM, om = (unsigned)(rowb + km) * KM;
#pragma unroll
                    for (int ai = 0; ai < 2; ++ai)
#pragma unroll
                        for (int m = 0; m < 4; ++m) {
                            const f32x4 v = acc[ai][bj][m][n];
                            const bf16_t re = (bf16_t)f2bf(v[2 * p]);
                            if (m == 0 && fr == 0) { const int g = 2 * ai + wr; const bf16_t im = (bf16_t)f2bf(v[2 * p + 1]);
                                fo[oo + g * 128] = re; fo[om + 512 + 2 * g] = re; fo[oo + g * 128 + 64] = im; fo[om + 512 + 2 * g + 1] = im; }
                            else { fo[oo + own0 + ai * 256 + 16 * m] = re; fo[om + mir0 + ai * 256 - 16 * m] = re; }
                        }
                    asm volatile("" ::: "memory"); __builtin_amdgcn_sched_barrier(0);
                }
    }
};

struct EpiMerge {
    static constexpr bool PERM = true; static constexpr int MIDK = 10;
    unsigned char* ws;
    __device__ __forceinline__ void mid(f32x4 (&acc)[2][2][4][2], const Unit& u, int wr, int wc, int fr, int fq) const {
        asm volatile("" : "+v"(fr), "+v"(fq));
#pragma unroll
        for (int ai = 0; ai < 2; ++ai)
#pragma unroll
            for (int m = 0; m < 4; ++m) { const size_t row = (size_t)(u.pm * 256 + ai * 128 + wr * 64 + m * 16 + fr);
#pragma unroll
                for (int bj = 0; bj < 2; ++bj) { const int col = u.pn * 256 + bj * 128 + wc * 32 + 8 * fq;
                    const u32x4 gf = *(const u32x4*)((const bf16_t*)(ws + WS_GF) + row * D + col), ga = *(const u32x4*)((const bf16_t*)(ws + WS_GA) + row * D + col);
                    f32x4 r0, r1;
                    r0[0] = bflo(gf.x) * __builtin_amdgcn_rcpf(bflo(ga.x)); r0[1] = bfhi(gf.x) * __builtin_amdgcn_rcpf(bfhi(ga.x)); r0[2] = bflo(gf.y) * __builtin_amdgcn_rcpf(bflo(ga.y)); r0[3] = bfhi(gf.y) * __builtin_amdgcn_rcpf(bfhi(ga.y));
                    r1[0] = bflo(gf.z) * __builtin_amdgcn_rcpf(bflo(ga.z)); r1[1] = bfhi(gf.z) * __builtin_amdgcn_rcpf(bfhi(ga.z)); r1[2] = bflo(gf.w) * __builtin_amdgcn_rcpf(bflo(ga.w)); r1[3] = bfhi(gf.w) * __builtin_amdgcn_rcpf(bfhi(ga.w));
                    acc[ai][bj][m][0] = acc[ai][bj][m][0] * r0; acc[ai][bj][m][1] = acc[ai][bj][m][1] * r1; } }
    }
    __device__ __forceinline__ void operator()(const f32x4 (&acc)[2][2][4][2], const Unit& u, int wr, int wc, int fr, int fq) const {
#pragma unroll
        for (int ai = 0; ai < 2; ++ai)
#pragma unroll
            for (int m = 0; m < 4; ++m) { const size_t row = (size_t)(u.pm * 256 + ai * 128 + wr * 64 + m * 16 + fr);
#pragma unroll
                for (int bj = 0; bj < 2; ++bj) { const int col = u.pn * 256 + bj * 128 + wc * 32 + 8 * fq;
                    const u32x4 ga = *(const u32x4*)((const bf16_t*)(ws + WS_GA) + row * D + col);
                    const f32x4 a0 = acc[ai][bj][m][0], a1 = acc[ai][bj][m][1];
                    u32x4 w;
                    w.x = cvt_pk_bf16(bflo(ga.x) * a0[0], bfhi(ga.x) * a0[1]); w.y = cvt_pk_bf16(bflo(ga.y) * a0[2], bfhi(ga.y) * a0[3]);
                    w.z = cvt_pk_bf16(bflo(ga.z) * a1[0], bfhi(ga.z) * a1[1]); w.w = cvt_pk_bf16(bflo(ga.w) * a1[2], bfhi(ga.w) * a1[3]);
                    *(u32x4*)((bf16_t*)(ws + WS_Y) + row * D + col) = w; } }
    }
};

struct EpiResid {
    static constexpr bool PERM = true; static constexpr int MIDK = 0;
    const float* xl_in32; const bf16_t* xl_inb; bf16_t* xl_out; const float* xc_in; float* xc_out; const float* mod_l; int chunk; float* tmpc;
    __device__ __forceinline__ void operator()(const f32x4 (&acc)[2][2][4][2], const Unit& u, int wr, int wc, int fr, int fq) const {
        const int v = u.pm < 32 ? 0 : (u.pm < 64 ? 1 : 2);
        const float* gate = mod_l + v * MODSZ + chunk * D;
        const bool lat = u.pm < 64; const int rbase = lat ? u.pm * 256 : (u.pm - 64) * 256;
#pragma unroll
        for (int bj = 0; bj < 2; ++bj) { const int col = u.pn * 256 + bj * 128 + wc * 32 + 8 * fq;
            const f32x4 g0 = *(const f32x4*)(gate + col), g1 = *(const f32x4*)(gate + col + 4);
#pragma unroll
            for (int ai = 0; ai < 2; ++ai)
#pragma unroll
                for (int m = 0; m < 4; ++m) { const size_t o = (size_t)(rbase + ai * 128 + wr * 64 + m * 16 + fr) * D + col;
                    if (lat) {
                        f32x4 x0, x1;
                        if (xl_in32) { x0 = *(const f32x4*)(xl_in32 + o); x1 = *(const f32x4*)(xl_in32 + o + 4); }
                        else { const u32x4 xb = *(const u32x4*)(xl_inb + o); x0 = (f32x4){bflo(xb.x), bfhi(xb.x), bflo(xb.y), bfhi(xb.y)}; x1 = (f32x4){bflo(xb.z), bfhi(xb.z), bflo(xb.w), bfhi(xb.w)}; }
                        x0 = x0 + g0 * acc[ai][bj][m][0]; x1 = x1 + g1 * acc[ai][bj][m][1];
                        u32x4 w; w.x = cvt_pk_bf16(x0[0], x0[1]); w.y = cvt_pk_bf16(x0[2], x0[3]); w.z = cvt_pk_bf16(x1[0], x1[1]); w.w = cvt_pk_bf16(x1[2], x1[3]);
                        *(u32x4*)(xl_out + o) = w;
                    } else if (u.kh) { *(f32x4*)(tmpc + o) = g0 * acc[ai][bj][m][0]; *(f32x4*)(tmpc + o + 4) = g1 * acc[ai][bj][m][1]; }
                    else { *(f32x4*)(xc_out + o) = *(const f32x4*)(xc_in + o) + g0 * acc[ai][bj][m][0];
                           *(f32x4*)(xc_out + o + 4) = *(const f32x4*)(xc_in + o + 4) + g1 * acc[ai][bj][m][1]; } } }
    }
};

struct EpiSwiglu {
    static constexpr bool PERM = true; static constexpr int MIDK = 0;
    bf16_t* act; int ld;
    __device__ __forceinline__ void operator()(const f32x4 (&acc)[2][2][4][2], const Unit& u, int wr, int wc, int fr, int fq) const {
        const int col = u.pn * 128 + wc * 32 + 8 * fq;
#pragma unroll
        for (int ai = 0; ai < 2; ++ai)
#pragma unroll
            for (int m = 0; m < 4; ++m) { const size_t row = (size_t)(u.x0 + ai * 128 + wr * 64 + m * 16 + fr);
                float o[8];
#pragma unroll
                for (int n = 0; n < 2; ++n)
#pragma unroll
                    for (int q = 0; q < 4; ++q) { const float gv = acc[ai][0][m][n][q], uv = acc[ai][1][m][n][q]; o[4 * n + q] = gv * sigmoidf_(gv) * uv; }
                u32x4 w; w.x = cvt_pk_bf16(o[0], o[1]); w.y = cvt_pk_bf16(o[2], o[3]); w.z = cvt_pk_bf16(o[4], o[5]); w.w = cvt_pk_bf16(o[6], o[7]);
                *(u32x4*)(act + row * ld + col) = w; }
    }
};
struct EpiBf16 {
    static constexpr bool PERM = true; static constexpr int MIDK = 0;
    bf16_t* O0; bf16_t* O1; int ld;
    __device__ __forceinline__ void operator()(const f32x4 (&acc)[2][2][4][2], const Unit& u, int wr, int wc, int fr, int fq) const {
#pragma unroll
        for (int ai = 0; ai < 2; ++ai)
#pragma unroll
            for (int m = 0; m < 4; ++m) { const size_t row = (size_t)(u.x0 + ai * 128 + wr * 64 + m * 16 + fr);
#pragma unroll
                for (int bj = 0; bj < 2; ++bj) { const int col = u.pn * 256 + bj * 128 + wc * 32 + 8 * fq; const f32x4 v0 = acc[ai][bj][m][0], v1 = acc[ai][bj][m][1];
                    u32x4 w; w.x = cvt_pk_bf16(v0[0], v0[1]); w.y = cvt_pk_bf16(v0[2], v0[3]); w.z = cvt_pk_bf16(v1[0], v1[1]); w.w = cvt_pk_bf16(v1[2], v1[3]);
                    *(u32x4*)((u.kh ? O1 : O0) + row * ld + col) = w; } }
    }
};

struct RowSched { int nM, nN, G, c; unsigned abytes, bbytes;
    __device__ __forceinline__ bool next(int i, Unit& u) const { const int L = i * G + c; if (L >= nM * nN) return false; pg8::swz_map(L, nM, nN, u.pm, u.pn); u.aoff = (unsigned)u.pm * abytes; u.boff = (unsigned)u.pn * bbytes; u.kind = 0; u.x0 = u.pm * 256; u.x1 = 0; u.kh = 0; return true; } };

struct MoeSched { int G, c, nN, ksplit, trim; unsigned bexp, bbytes, arow_bytes, khbytes; bool a_slots; int cnt[NE], base[NE];
    __device__ __forceinline__ void init(const unsigned* cw) { int b = 0;
#pragma unroll
        for (int e = 0; e < NE; ++e) { cnt[e] = (int)cw[64 * e]; base[e] = b; b += (cnt[e] + 255) & ~255; } }
    __device__ __forceinline__ bool next(int i, Unit& u) const { int L = i * G + c; int e = 0;
        for (; e < NE; ++e) { const int nu = (((cnt[e] + 255) >> 8) - (e == NE - 1 ? trim : 0)) * nN * ksplit; if (L < nu) break; L -= nu; }
        if (e >= NE) return false;
        int cn = 0, bs = 0;
#pragma unroll
        for (int q = 0; q < NE; ++q) if (q == e) { cn = cnt[q]; bs = base[q]; }
        const int np_ = ((cn + 255) >> 8) - (e == NE - 1 ? trim : 0); const int nt_ = np_ * nN; u.kh = L / nt_; L -= u.kh * nt_;
        pg8::swz_map(L, np_, nN, u.pm, u.pn);
        u.kind = e; u.x1 = cn; u.x0 = bs + u.pm * 256;
        u.aoff = (a_slots ? (unsigned)u.x0 * arow_bytes : 0u) + (unsigned)u.kh * khbytes; u.boff = (unsigned)e * bexp + (unsigned)u.pn * bbytes + (unsigned)u.kh * khbytes; return true; } };
struct MoeTailSched { int G, c, trim, plast, rbase; unsigned bexp;
    __device__ __forceinline__ bool next(int i, Unit& u) const { int L = i * G + c; if (L >= 16 * trim) return false; u.kh = L / (4 * trim); L -= u.kh * 4 * trim;
        u.pm = plast - trim + (L >> 2); u.pn = L & 3; u.kind = NE - 1; u.x1 = 0; u.x0 = rbase + u.pm * 256;
        u.aoff = (unsigned)u.x0 * (DFFE * 2u) + (unsigned)u.kh * (DFFE / 4 * 2u); u.boff = (unsigned)(NE - 1) * bexp + (unsigned)u.pn * (256u * DFFE * 2u) + (unsigned)u.kh * (DFFE / 4 * 2u); return true; } };
struct EpiTail {
    static constexpr bool PERM = true; static constexpr int MIDK = 0;
    bf16_t* O0; bf16_t* Q; int row0;
    __device__ __forceinline__ void operator()(const f32x4 (&acc)[2][2][4][2], const Unit& u, int wr, int wc, int fr, int fq) const {
#pragma unroll
        for (int ai = 0; ai < 2; ++ai)
#pragma unroll
            for (int m = 0; m < 4; ++m) { const int row = u.x0 + ai * 128 + wr * 64 + m * 16 + fr;
                bf16_t* dst = u.kh == 0 ? O0 + (size_t)row * D : Q + ((size_t)(u.kh - 1) * TAILQ_ROWS + (size_t)(row - row0)) * D;
#pragma unroll
                for (int bj = 0; bj < 2; ++bj) { const int col = u.pn * 256 + bj * 128 + wc * 32 + 8 * fq; const f32x4 v0 = acc[ai][bj][m][0], v1 = acc[ai][bj][m][1];
                    u32x4 w; w.x = cvt_pk_bf16(v0[0], v0[1]); w.y = cvt_pk_bf16(v0[2], v0[3]); w.z = cvt_pk_bf16(v1[0], v1[1]); w.w = cvt_pk_bf16(v1[2], v1[3]);
                    *(u32x4*)(dst + col) = w; } }
    }
};
struct MoeRows { static constexpr bool GA = true, GB = false; const int* list;
    __device__ __forceinline__ unsigned arow(const Unit& u, int r) const { int idx = u.pm * 256 + r; idx = idx < u.x1 ? idx : u.x1 - 1; return (unsigned)list[u.kind * NL + idx] * (D * 2u); }
    __device__ __forceinline__ unsigned brow(const Unit&, int) const { return 0u; } };


constexpr int CW_QUEUE = 12288, CW_RDY = 65536;
template <int NG, bool MOE> struct FfnStream {
    int P[NG], rb[NG], cn[NG];
    int f, nNgu, Kdn; unsigned need;
    unsigned* q; volatile LAS unsigned* lw; unsigned* rdy; unsigned* tmo;
    __device__ __forceinline__ void finish_init(int G) { int sacc = 0; f = NG;
#pragma unroll
        for (int g = NG - 1; g >= 0; --g) { if (f == g + 1 && sacc + P[g] * 4 <= G) { sacc += P[g] * 4; f = g; } }
        if (f > NG - 1) f = NG - 1; }
    __device__ __forceinline__ bool decode(int L, SUnit& u) const {
        int pos = L, kind = -1, grp = 0, j = 0;
#pragma unroll
        for (int g = 0; g < NG; ++g) {
            { const int n = P[g] * nNgu; if (kind < 0) { if (pos < n) { kind = 0; grp = g; j = pos; } else pos -= n; } }
            if (g >= 1 && (g - 1) < f) { const int n = P[g - 1] * 4; if (kind < 0) { if (pos < n) { kind = 1; grp = g - 1; j = pos; } else pos -= n; } }
        }
#pragma unroll
        for (int g = 0; g < NG; ++g) if (g >= f) { const int n = P[g] * 4; if (kind < 0) { if (pos < n) { kind = 1; grp = g; j = pos; } else pos -= n; } }
        if (kind < 0) return false;
        int nM = 0, rbase = 0, cnt = 0;
#pragma unroll
        for (int g = 0; g < NG; ++g) if (g == grp) { nM = P[g]; rbase = rb[g]; cnt = cn[g]; }
        const int nN = kind == 0 ? nNgu : 4;
        const int nig = 8 * nN, gid = j / nig, fm = gid * 8, gsz = (nM - fm) < 8 ? (nM - fm) : 8;
        u.pm = fm + ((j % nig) % gsz); u.pn = (j % nig) / gsz; u.kind = kind; u.grp = grp; u.x0 = rbase + u.pm * 256; u.x1 = cnt;
        const int gp = u.x0 >> 8;
        if (kind == 0) { u.K = D; u.dep = -1; u.sig = gp;
            u.aoff = (unsigned)WS_H + (unsigned)u.x0 * (D * 2u);
            u.boff = (MOE ? (unsigned)WS_WGUE + (unsigned)grp * (2u * DFFE * D * 2u) : (unsigned)WS_WGUD) + (unsigned)u.pn * (256u * D * 2u); }
        else { u.K = Kdn; u.dep = gp; u.sig = -1;
            u.aoff = (unsigned)WS_ACT + (unsigned)u.x0 * ((unsigned)Kdn * 2u);
            u.boff = (MOE ? (unsigned)WS_WDE + (unsigned)grp * ((unsigned)D * DFFE * 2u) : (unsigned)WS_WDD) + (unsigned)u.pn * (256u * (unsigned)Kdn * 2u); }
        return true;
    }
    __device__ __forceinline__ void a_ready(const SUnit& u) const {
        if (threadIdx.x < 64) {
            const unsigned long long t0 = __builtin_amdgcn_s_memrealtime(); unsigned polls = 0;
            while ((unsigned)__builtin_amdgcn_readfirstlane(__hip_atomic_load(rdy + 64 * u.dep, __ATOMIC_RELAXED, __HIP_MEMORY_SCOPE_AGENT)) < need) {
                if ((++polls & 255u) == 0u && __builtin_amdgcn_readfirstlane(__hip_atomic_load(tmo, __ATOMIC_RELAXED, __HIP_MEMORY_SCOPE_AGENT)) != 0u) break;
                if (__builtin_amdgcn_s_memrealtime() - t0 > 2000000ull) { if (threadIdx.x == 0) __hip_atomic_store(tmo, 1u, __ATOMIC_RELAXED, __HIP_MEMORY_SCOPE_AGENT); break; }
                __builtin_amdgcn_s_sleep(2); }
            __builtin_amdgcn_fence(__ATOMIC_ACQUIRE, "agent");
            asm volatile("s_waitcnt vmcnt(0)" ::: "memory");
        }
        asm volatile("" ::: "memory"); __builtin_amdgcn_s_barrier(); asm volatile("" ::: "memory");
    }
};
template <bool MOE> struct FfnRows { const int* list;
    __device__ __forceinline__ bool a_gather(const SUnit& u) const { return MOE && u.kind == 0; }
    __device__ __forceinline__ unsigned arow(const SUnit& u, int r) const { int idx = u.pm * 256 + r; idx = idx < u.x1 ? idx : u.x1 - 1; return (unsigned)WS_H + (unsigned)list[u.grp * NL + idx] * (D * 2u); } };

template <bool MOE> struct EpiFfn {
    static constexpr bool PERM = true; static constexpr int MIDK = 0;
    unsigned char* ws; float* xl; const float* mod_l;
    __device__ __forceinline__ void operator()(const f32x4 (&acc)[2][2][4][2], const SUnit& u, int wr, int wc, int fr, int fq) const {
        if (u.kind == 0) {
            constexpr int ld = MOE ? DFFE : DFF0;
            bf16_t* act = (bf16_t*)(ws + WS_ACT);
            const int col = u.pn * 128 + wc * 32 + 8 * fq;
#pragma unroll
            for (int ai = 0; ai < 2; ++ai)
#pragma unroll
                for (int m = 0; m < 4; ++m) { const size_t row = (size_t)(u.x0 + ai * 128 + wr * 64 + m * 16 + fr);
                    float o[8];
#pragma unroll
                    for (int n = 0; n < 2; ++n)
#pragma unroll
                        for (int q = 0; q < 4; ++q) { const float gv = acc[ai][0][m][n][q], uv = acc[ai][1][m][n][q]; o[4 * n + q] = gv * sigmoidf_(gv) * uv; }
                    u32x4 w; w.x = cvt_pk_bf16(o[0], o[1]); w.y = cvt_pk_bf16(o[2], o[3]); w.z = cvt_pk_bf16(o[4], o[5]); w.w = cvt_pk_bf16(o[6], o[7]);
                    pg8::st16_wt(ws, (unsigned)WS_ACT + ((unsigned)row * (unsigned)ld + (unsigned)col) * 2u, w); }
        } else if (MOE) {
            bf16_t* O = (bf16_t*)(ws + WS_DOUT);
#pragma unroll
            for (int ai = 0; ai < 2; ++ai)
#pragma unroll
                for (int m = 0; m < 4; ++m) { const size_t row = (size_t)(u.x0 + ai * 128 + wr * 64 + m * 16 + fr);
#pragma unroll
                    for (int bj = 0; bj < 2; ++bj) { const int col = u.pn * 256 + bj * 128 + wc * 32 + 8 * fq; const f32x4 v0 = acc[ai][bj][m][0], v1 = acc[ai][bj][m][1];
                        u32x4 w; w.x = cvt_pk_bf16(v0[0], v0[1]); w.y = cvt_pk_bf16(v0[2], v0[3]); w.z = cvt_pk_bf16(v1[0], v1[1]); w.w = cvt_pk_bf16(v1[2], v1[3]);
                        *(u32x4*)(O + row * D + col) = w; } }
        } else {
            asm volatile("" : "+v"(fr), "+v"(fq));
            const int pmg = u.x0 >> 8;
            const int v = pmg < 32 ? 0 : (pmg < 64 ? 1 : 2);
            const float* gate = mod_l + v * MODSZ + 5 * D;
            float* xo = pmg < 64 ? xl + (size_t)u.x0 * D : (float*)(ws + WS_XC) + (size_t)(u.x0 - NL) * D;
#pragma unroll
            for (int bj = 0; bj < 2; ++bj) { const int col = u.pn * 256 + bj * 128 + wc * 32 + 8 * fq;
                const f32x4 g0 = *(const f32x4*)(gate + col), g1 = *(const f32x4*)(gate + col + 4);
#pragma unroll
                for (int ai = 0; ai < 2; ++ai)
#pragma unroll
                    for (int m = 0; m < 4; ++m) { const size_t o = (size_t)(ai * 128 + wr * 64 + m * 16 + fr) * D + col;
                        *(f32x4*)(xo + o) = *(const f32x4*)(xo + o) + g0 * acc[ai][bj][m][0];
                        *(f32x4*)(xo + o + 4) = *(const f32x4*)(xo + o + 4) + g1 * acc[ai][bj][m][1];
                        asm volatile("" ::: "memory"); __builtin_amdgcn_sched_barrier(0); } }
        }
    }
};

__device__ __forceinline__ int crow(int r, int hi) { return (r & 3) + 8 * (r >> 2) + 4 * hi; }
__device__ __forceinline__ s16x4 vtr(const LAS unsigned char* p) { typedef short v4i16_t __attribute__((ext_vector_type(4))); return __builtin_bit_cast(s16x4, __builtin_amdgcn_ds_read_tr16_b64_v4i16((LAS v4i16_t*)p)); }

__device__ __forceinline__ void attn_unit(Frame& F, int l, int b, int hkv, int qb, bool ctxq) {
    const int tid = F.tid, lane = F.lane, wid = F.wave, r32 = lane & 31, hi = lane >> 5;
    const int g = wid >> 1, qs = wid & 1, head = hkv * 4 + g;
    const bf16_t* Q = (const bf16_t*)(F.ws + WS_Q); const bf16_t* KB = (const bf16_t*)(F.ws + WS_KB); const bf16_t* VB = (const bf16_t*)(F.ws + WS_VB);
    const int q0 = qb * 64;
    const int qrow = (ctxq ? NL + b * CTXL : b * T) + q0 + qs * 32 + r32;
    bf16x8 qr[4];
#pragma unroll
    for (int d0 = 0; d0 < 4; ++d0) qr[d0] = *(const bf16x8*)(Q + (size_t)qrow * 512 + head * 64 + d0 * 16 + hi * 8);
    int jlo = 0, jhi = -1;
    if (!ctxq) { jlo = -2; jhi = 2; if (q0 + 64 * jlo < 0) jlo = -(q0 / 64); if (q0 + 64 * jhi >= T) jhi = (T - 64 - q0) / 64; }
    const int nloc = jhi - jlo + 1, ntile = nloc + 4;
    const float sinkv = F.in[9][l * 8 + head] * LOG2E;
    float mrun = sinkv, lrun = 1.0f;
    f32x16 o[2]; o[0] = f32x16{}; o[1] = f32x16{};
    const int kkey = lane, vkey = 16 * (wid & 3) + (lane >> 2);
    auto tile_row = [&](int ti) -> int { return ti < nloc ? b * T + q0 + 64 * (jlo + ti) : NL + b * CTXL + 64 * (ti - nloc); };
    u32x4 kreg, vreg;
    { const int r0 = tile_row(0); kreg = *(const u32x4*)(KB + (size_t)(r0 + kkey) * 128 + hkv * 64 + wid * 8); vreg = *(const u32x4*)(VB + (size_t)(r0 + vkey) * 128 + hkv * 64 + (wid >> 2) * 32 + (lane & 3) * 8); }
    for (int ti = 0; ti < ntile; ++ti) {
        LAS unsigned char* slot = F.lds + (ti & 1) * 16384;
        *(LAS u32x4*)(slot + wid * 1024 + lane * 16) = kreg;
        *(LAS u32x4*)(slot + 8192 + wid * 1024 + lane * 16) = vreg;
        __syncthreads();
        if (ti + 1 < ntile) { const int r0 = tile_row(ti + 1); kreg = *(const u32x4*)(KB + (size_t)(r0 + kkey) * 128 + hkv * 64 + wid * 8); vreg = *(const u32x4*)(VB + (size_t)(r0 + vkey) * 128 + hkv * 64 + (wid >> 2) * 32 + (lane & 3) * 8); }
        f32x16 p0 = f32x16{}, p1 = f32x16{};
        { const LAS unsigned char* kb = slot + hi * 1024 + r32 * 16;
#pragma unroll
          for (int d0 = 0; d0 < 4; ++d0) { const bf16x8 k0 = *(const LAS bf16x8*)(kb + d0 * 2048), k1 = *(const LAS bf16x8*)(kb + d0 * 2048 + 512);
              p0 = __builtin_amdgcn_mfma_f32_32x32x16_bf16(k0, qr[d0], p0, 0, 0, 0); p1 = __builtin_amdgcn_mfma_f32_32x32x16_bf16(k1, qr[d0], p1, 0, 0, 0); } }
        if (ti < nloc) { const int j = jlo + ti; const int qq = qs * 32 + r32;
            if (j == -2) {
#pragma unroll
                for (int r = 0; r < 16; ++r) { const int kk = crow(r, hi); if (kk < qq) p0[r] = -INFINITY; if (kk + 32 < qq) p1[r] = -INFINITY; } }
            else if (j == 2) {
#pragma unroll
                for (int r = 0; r < 16; ++r) { const int kk = crow(r, hi); if (kk > qq) p0[r] = -INFINITY; if (kk + 32 > qq) p1[r] = -INFINITY; } } }
        float mx = p0[0];
#pragma unroll
        for (int r = 1; r < 16; ++r) mx = fmaxf(mx, p0[r]);
#pragma unroll
        for (int r = 0; r < 16; ++r) mx = fmaxf(mx, p1[r]);
        mx = fmaxf(mx, __shfl_xor(mx, 32));
        const float mnew = fmaxf(mrun, mx), fsc = __builtin_amdgcn_exp2f(mrun - mnew);
        mrun = mnew;
        float rs = 0.f;
#pragma unroll
        for (int r = 0; r < 16; ++r) { p0[r] = __builtin_amdgcn_exp2f(p0[r] - mnew); p1[r] = __builtin_amdgcn_exp2f(p1[r] - mnew); rs += p0[r] + p1[r]; }
        rs += __shfl_xor(rs, 32);
        lrun = lrun * fsc + rs;
#pragma unroll
        for (int r = 0; r < 16; ++r) { o[0][r] *= fsc; o[1][r] *= fsc; }
        u32x4 pw[4];
        pw[0] = (u32x4){cvt_pk_bf16(p0[0], p0[1]), cvt_pk_bf16(p0[2], p0[3]), cvt_pk_bf16(p0[4], p0[5]), cvt_pk_bf16(p0[6], p0[7])};
        pw[1] = (u32x4){cvt_pk_bf16(p0[8], p0[9]), cvt_pk_bf16(p0[10], p0[11]), cvt_pk_bf16(p0[12], p0[13]), cvt_pk_bf16(p0[14], p0[15])};
        pw[2] = (u32x4){cvt_pk_bf16(p1[0], p1[1]), cvt_pk_bf16(p1[2], p1[3]), cvt_pk_bf16(p1[4], p1[5]), cvt_pk_bf16(p1[6], p1[7])};
        pw[3] = (u32x4){cvt_pk_bf16(p1[8], p1[9]), cvt_pk_bf16(p1[10], p1[11]), cvt_pk_bf16(p1[12], p1[13]), cvt_pk_bf16(p1[14], p1[15])};
        { const LAS unsigned char* vb = slot + 8192 + ((lane >> 4) & 1) * 32 + (lane & 3) * 8 + (4 * hi + ((lane & 15) >> 2)) * 64;
#pragma unroll
          for (int d0 = 0; d0 < 2; ++d0)
#pragma unroll
              for (int ks = 0; ks < 4; ++ks) { const s16x4 lo = vtr(vb + d0 * 4096 + ks * 1024), hh = vtr(vb + d0 * 4096 + ks * 1024 + 512);
                  const bf16x8 vf = (bf16x8){lo[0], lo[1], lo[2], lo[3], hh[0], hh[1], hh[2], hh[3]};
                  o[d0] = __builtin_amdgcn_mfma_f32_32x32x16_bf16(vf, __builtin_bit_cast(bf16x8, pw[ks]), o[d0], 0, 0, 0); } }
    }
    const float rl = 1.0f / lrun;
    bf16_t* orow = (bf16_t*)(F.ws + WS_FO) + (size_t)qrow * KM + 640 + head * 64;
#pragma unroll
    for (int d0 = 0; d0 < 2; ++d0)
#pragma unroll
        for (int rq = 0; rq < 4; ++rq) { u32x2 w; w.x = cvt_pk_bf16(o[d0][4 * rq] * rl, o[d0][4 * rq + 1] * rl); w.y = cvt_pk_bf16(o[d0][4 * rq + 2] * rl, o[d0][4 * rq + 3] * rl);
            *(u32x2*)(orow + 32 * d0 + 8 * rq + 4 * hi) = w; }
    __syncthreads();
}

__device__ __forceinline__ void attn_phase(Frame& F, int l, int part) {
    const int nlat = NB * 2 * 128;
    auto lat_unit = [&](int it) { const int qb = it & 127, hkv = (it >> 7) & 1, b = it >> 8; attn_unit(F, l, b, hkv, qb, false); };
    if (part == 0) {
        const bool extra = (l == 0) && F.G == 256 && ((F.bx >= 16 && F.bx < 24) || F.bx >= 240);
        if (!extra) for (int it = F.bx; it < 256; it += F.G) lat_unit(it);
        if (l == 0) for (int r = (F.bx + F.G - 240) % F.G; r < NB * 2 * 4; r += F.G) { const int qb = r & 3, hkv = (r >> 2) & 1, b = r >> 3; attn_unit(F, l, b, hkv, qb, true); }
    } else {
        const bool busy = (l == 0) && F.bx >= 128 && F.bx < 136;
        if (!busy) for (int it = 256 + F.bx; it < nlat; it += F.G) lat_unit(it);
        if (l == 0 && F.bx >= 136 && F.bx < 144) lat_unit(256 + F.bx - 8);
        if (l == 0 && F.G == 256 && F.bx >= 144 && F.bx < 168) { const int k = F.bx - 144; lat_unit(k < 8 ? 16 + k : 240 + (k - 8)); }
    }
}

#if !MK_MULTI
#define GRID_BAR() xcd_barrier(bar)
#else
#define GRID_BAR() do {} while (0)
#endif
#ifndef PH_MASK
#define PH_MASK 0xFFFFFu
#endif
#define IN(k) (((PH_MASK >> (k)) & 1u) && lo <= (k) && (k) < hi)
#define SEAM(k) do { if (IN((k) + 1)) GRID_BAR(); } while (0)
#ifndef REP_MASK
#define REP_MASK 0u
#endif
#define REPS(k) ((((REP_MASK) >> (k)) & 1u) ? 2 : 1)
template <int l, class BarT>
__device__ __forceinline__ void layer_phases(Frame& F, unsigned* ctl, const int lo, const int hi, const BarT& bar) {
        const int pb = 1 + 8 * l;
        bf16_t* H = (bf16_t*)(F.ws + WS_H);
        const float* xl_in = l == 0 ? F.in[0] : nullptr;
        bf16_t* XB = (bf16_t*)(F.ws + WS_XB);
        const float* xc_in = l == 0 ? F.in[2] : (const float*)(F.ws + WS_XC);
        float* xc = (float*)(F.ws + WS_XC);
        const float* mod_l = (const float*)ctl + CW_MOD + l * 3 * MODSZ;
        if (IN(pb + 0)) { for (int rep = 0; rep < REPS(pb + 0); ++rep) norm_phase<false>(F, l, 0, xl_in, xc_in, NTOK, l == 1 ? (const float*)(F.ws + WS_TMPC2) : nullptr, nullptr); SEAM(pb + 0); }
        if (IN(pb + 1)) {
            for (int rep = 0; rep < REPS(pb + 1); ++rep) {
            { pg8::Gemm g{H, (const bf16_t*)(F.ws + (l ? WS_WIN1 : WS_WIN0)) + (size_t)512 * D, D, D}; InprojSched S{F.G, F.bx, l}; EpiInproj E{F.ws}; pg8::NoGather R;
              pg8::gemm_phase(F.lds, g, S, E, R); }
            { pg8::Gemm g{(const bf16_t*)(F.ws + (l ? WS_WIN1 : WS_WIN0)), H, D, D}; UpermSched S{F.G, F.bx, l}; EpiUperm E{F.ws}; UpermRows R;
              pg8::gemm_phase(F.lds, g, S, E, R); }
            }
            SEAM(pb + 1);
        }
        if (IN(pb + 2)) {
            for (int rep = 0; rep < REPS(pb + 2); ++rep) {
            attn_phase(F, l, 0);
            { pg8::Gemm g{(const bf16_t*)(F.ws + WS_UP), (const bf16_t*)(F.ws + WS_FA64), 128, 128}; StepASched S{F.G, F.bx, l}; EpiStepA E{F.ws}; pg8::NoGather R;
              pg8::gemm_phase(F.lds, g, S, E, R); }
            if (l == 0) { pg8::Gemm g{(const bf16_t*)(F.ws + WS_VCT), (const bf16_t*)(F.ws + WS_TX), 512, 512}; GridSched S{2, 2, F.G, (F.bx + F.G - 16) % F.G, 256u * 512u * 2u, 256u * 512u * 2u}; EpiStepC<true> E{F.ws}; pg8::NoGather R;
              pg8::gemm_phase(F.lds, g, S, E, R); }
            }
            SEAM(pb + 2);
        }
        if (IN(pb + 3)) {
            for (int rep = 0; rep < REPS(pb + 3); ++rep) {
            { pg8::Gemm g{(const bf16_t*)(F.ws + WS_GP), (const bf16_t*)(F.ws + WS_TC), 256, 256}; GridSched S{128, 1, F.G, F.bx, 256u * 256u * 2u, 0u}; EpiStepC<false> E{F.ws}; pg8::NoGather R;
              pg8::gemm_phase(F.lds, g, S, E, R); }
            if (l == 0) { pg8::Gemm g{(const bf16_t*)(F.ws + WS_FO), (const bf16_t*)(F.ws + WS_WM0), KM, KM}; CtxSched S{F.G, (F.bx + F.G - 128) % F.G, 4, 256u * KM * 2u, 256u * KM * 2u, 1, 0u}; EpiMerge E{F.ws}; pg8::NoGather R;
              pg8::gemm_phase(F.lds, g, S, E, R); }
            attn_phase(F, l, 1);
            }
            SEAM(pb + 3);
        }
        if (IN(pb + 4)) {
            const int nM = 64;
            pg8::Gemm g{(const bf16_t*)(F.ws + WS_FO), (const bf16_t*)(F.ws + (l ? WS_WM1 : WS_WM0)), KM, KM}; GridSched S{nM, 4, F.G, F.bx, 256u * KM * 2u, 256u * KM * 2u}; EpiMerge E{F.ws}; pg8::NoGather R;
            for (int rep = 0; rep < REPS(pb + 4); ++rep) pg8::gemm_phase(F.lds, g, S, E, R);
            SEAM(pb + 4);
        }
        if (IN(pb + 5)) {
            EpiResid E{xl_in, XB, XB, xc_in, xc, mod_l, 2, (float*)(F.ws + WS_TMPC1)}; pg8::NoGather R;
            { pg8::Gemm g{(const bf16_t*)(F.ws + WS_Y), (const bf16_t*)(F.ws + (l ? WS_WO1 : WS_WO0)), D, D}; GridSched S{64, 4, F.G, F.bx, 256u * D * 2u, 256u * D * 2u};
              pg8::gemm_phase(F.lds, g, S, E, R); }
            if (l == 0) { pg8::Gemm g{(const bf16_t*)(F.ws + WS_Y), (const bf16_t*)(F.ws + WS_WO0), D / 2, D}; CtxSched S{F.G, F.bx, 4, 256u * D * 2u, 256u * D * 2u, 2, (unsigned)D};
              pg8::gemm_phase(F.lds, g, S, E, R); }
            SEAM(pb + 5);
        }
        if (IN(pb + 6)) {
            if (l == 0) norm_phase<false>(F, l, 1, nullptr, xc, NTOK, (const float*)(F.ws + WS_TMPC1), xc); else { norm_phase<true>(F, l, 1, nullptr, xc, NL); moe_convert(F, 0); }
            SEAM(pb + 6);
        }
#ifndef STREAM0
#define STREAM0 0
#endif
#ifndef STREAM1
#define STREAM1 0
#endif
        if (IN(pb + 7)) {
            volatile LAS unsigned* lw = (volatile LAS unsigned*)(F.lds + MISC_OFF) + 16;
            if (l == 0) {
#if STREAM0
                FfnStream<9, false> S;
#pragma unroll
                for (int g = 0; g < 9; ++g) { S.P[g] = g < 8 ? 8 : 2; S.rb[g] = 2048 * g; S.cn[g] = g < 8 ? 2048 : 512; }
                S.nNgu = 22; S.Kdn = DFF0; S.need = 22u * 8u; S.q = ctl + CW_QUEUE; S.lw = lw; S.rdy = ctl + CW_RDY; S.tmo = ctl + 2; S.finish_init(F.G);
                EpiFfn<false> E{F.ws, F.out, mod_l}; FfnRows<false> R{nullptr};
                pg8::gemm_stream(F.lds, (const char*)F.ws, S, E, R);
#else
                { pg8::Gemm g{H, (const bf16_t*)(F.ws + WS_WGUD), D, D}; RowSched S{66, 22, F.G, F.bx, 256u * D * 2u, 256u * D * 2u}; EpiSwiglu E{(bf16_t*)(F.ws + WS_ACT), DFF0}; pg8::NoGather R;
                  pg8::gemm_phase(F.lds, g, S, E, R); }
                GRID_BAR();
                { EpiResid E{nullptr, XB, XB, xc, xc, mod_l, 5, (float*)(F.ws + WS_TMPC2)}; pg8::NoGather R;
                  { pg8::Gemm g{(const bf16_t*)(F.ws + WS_ACT), (const bf16_t*)(F.ws + WS_WDD), DFF0, DFF0}; GridSched S{64, 4, F.G, F.bx, 256u * DFF0 * 2u, 256u * DFF0 * 2u};
                    pg8::gemm_phase(F.lds, g, S, E, R); }
                  { pg8::Gemm g{(const bf16_t*)(F.ws + WS_ACT), (const bf16_t*)(F.ws + WS_WDD), DFF0 / 2, DFF0}; CtxSched S{F.G, F.bx, 4, 256u * DFF0 * 2u, 256u * DFF0 * 2u, 2, (unsigned)DFF0};
                    pg8::gemm_phase(F.lds, g, S, E, R); } }

#endif
            } else {
#if STREAM1
                FfnStream<8, true> S; { int bacc = 0;
#pragma unroll
                for (int e = 0; e < NE; ++e) { const int c = (int)ctl[CW_CNT + 64 * e]; S.cn[e] = c; S.P[e] = (c + 255) >> 8; S.rb[e] = bacc; bacc += ((c + 255) >> 8) << 8; } }
                S.nNgu = 28; S.Kdn = DFFE; S.need = 28u * 8u; S.q = ctl + CW_QUEUE + 64; S.lw = lw; S.rdy = ctl + CW_RDY + 64 * 80; S.tmo = ctl + 2; S.finish_init(F.G);
                EpiFfn<true> E{F.ws, F.out, mod_l}; FfnRows<true> R{(const int*)(F.ws + WS_LIST)};
                pg8::gemm_stream(F.lds, (const char*)F.ws, S, E, R);
#else
                { pg8::Gemm g{H, (const bf16_t*)(F.ws + WS_WGUE), D, D}; MoeSched S; S.G = F.G; S.c = F.bx; S.nN = 28; S.ksplit = 1; S.trim = 0; S.khbytes = 0; S.bexp = 2u * DFFE * D * 2u; S.bbytes = 256u * D * 2u; S.arow_bytes = 0; S.a_slots = false; S.init(ctl + CW_CNT);
                  EpiSwiglu E{(bf16_t*)(F.ws + WS_ACT), DFFE}; MoeRows R{(const int*)(F.ws + WS_LIST)};
                  pg8::gemm_phase(F.lds, g, S, E, R); }
                moe_convert(F, 1);
                GRID_BAR();
                { const int trim = moe_tail_panels(ctl + CW_CNT, F.G);
                  MoeSched S; S.G = F.G; S.c = F.bx; S.nN = 4; S.ksplit = 1; S.trim = trim; S.khbytes = 0; S.bexp = (unsigned)D * DFFE * 2u; S.bbytes = 256u * DFFE * 2u; S.arow_bytes = DFFE * 2u; S.a_slots = true; S.init(ctl + CW_CNT);
                  { pg8::Gemm g{(const bf16_t*)(F.ws + WS_ACT), (const bf16_t*)(F.ws + WS_WDE), DFFE, DFFE};
                    EpiBf16 E{(bf16_t*)(F.ws + WS_DOUT), (bf16_t*)(F.ws + WS_DOUT), D}; pg8::NoGather R;
                    pg8::gemm_phase(F.lds, g, S, E, R); }
                  if (trim > 0) {
                    const int plast = (S.cnt[NE - 1] + 255) >> 8;
                    pg8::Gemm g{(const bf16_t*)(F.ws + WS_ACT), (const bf16_t*)(F.ws + WS_WDE), DFFE / 4, DFFE};
                    MoeTailSched T{F.G, F.bx, trim, plast, S.base[NE - 1], (unsigned)D * DFFE * 2u};
                    EpiTail E{(bf16_t*)(F.ws + WS_DOUT), (bf16_t*)(F.ws + WS_DOUT1), S.base[NE - 1] + (plast - trim) * 256}; pg8::NoGather R;
                    pg8::gemm_phase(F.lds, g, T, E, R); } }
#endif
            }
            SEAM(pb + 7);
        }
}

constexpr int NPHASE = 18;
__global__ void __launch_bounds__(NTHR, 2) fwd_kernel(Args args) {
    extern __shared__ __attribute__((aligned(16))) unsigned char lds_raw[];
    Frame F;
    F.lds = (LAS unsigned char*)lds_raw; F.ws = args.ws; F.in = args.in; F.out = args.out;
    F.tid = threadIdx.x; F.lane = F.tid & 63; F.wave = __builtin_amdgcn_readfirstlane(F.tid >> 6); F.G = gridDim.x; F.bx = blockIdx.x;
    volatile LAS unsigned* MISC = (volatile LAS unsigned*)(F.lds + MISC_OFF);
    if (F.tid < 32) MISC[F.tid] = 0u;
    __syncthreads();
    unsigned* ctl = (unsigned*)(F.ws + WS_CTL);
#if !MK_MULTI
    XcdBarrier bar = xcd_barrier_post(ctl + CW_BAR, MISC + 8);
#else
    XcdBarrier bar; bar.bar = ctl + CW_BAR; bar.x = 0; bar.st = MISC + 8;
#endif
    const int lo = args.ph_lo, hi = args.ph_hi;
    if (IN(0)) { for (int rep = 0; rep < REPS(0); ++rep) { p0_prologue(F); __syncthreads(); } SEAM(0); }
    layer_phases<0>(F, ctl, lo, hi, bar);
    layer_phases<1>(F, ctl, lo, hi, bar);
    if (IN(17)) final_phase(F);
}

extern "C" void kernel_launch(void* const* d_in, const int* in_sizes, int n_in, void* d_out, int out_size, void* d_ws, size_t ws_size, hipStream_t stream) {
    static int grid = 0;
    if (grid == 0) {
        if (n_in != 21 || out_size != NL * D || ws_size < WS_END) { fprintf(stderr, "kernel_launch: unexpected problem (n_in %d out %d ws %zu)\n", n_in, out_size, ws_size); grid = -1; return; }
        int dev = 0, cus = 0;
        hipGetDevice(&dev); hipDeviceGetAttribute(&cus, hipDeviceAttributeMultiprocessorCount, dev);
        if (hipFuncSetAttribute((const void*)fwd_kernel, hipFuncAttributeMaxDynamicSharedMemorySize, LDS_BYTES) != hipSuccess) { fprintf(stderr, "kernel_launch: hipFuncSetAttribute failed\n"); grid = -1; return; }
        int per_cu = 0; (void)hipOccupancyMaxActiveBlocksPerMultiprocessor(&per_cu, (const void*)fwd_kernel, NTHR, LDS_BYTES); (void)hipGetLastError();
        grid = cus;
    }
    if (grid < 0) return;
    hipMemsetAsync((char*)d_ws + WS_CTL, 0, CTL_BYTES, stream);
#ifdef DBG_SCRUB
    hipMemsetAsync((char*)d_ws + CTL_BYTES, 0, WS_END - CTL_BYTES, stream);
#endif
    Args a{};
    for (int i = 0; i < 21; ++i) a.in[i] = (const float*)d_in[i];
    a.out = (float*)d_out; a.ws = (unsigned char*)d_ws;
#if MK_MULTI
    for (int p = 0; p < NPHASE; ++p) { a.ph_lo = p; a.ph_hi = p + 1; hipLaunchKernelGGL(fwd_kernel, dim3(grid), dim3(NTHR), LDS_BYTES, stream, a); }
#else
    a.ph_lo = 0; a.ph_hi = NPHASE;
    hipLaunchKernelGGL(fwd_kernel, dim3(grid), dim3(NTHR), LDS_BYTES, stream, a);
#endif
}
```

```cpp
#include <hip/hip_runtime.h>
#include <cstdio>
#include <cstdint>

#define LAS __attribute__((address_space(3)))
#define GAS __attribute__((address_space(1)))
typedef unsigned short bf16_t;
typedef short bf16x8 __attribute__((ext_vector_type(8)));
typedef short s16x4 __attribute__((ext_vector_type(4)));
typedef float f32x4 __attribute__((ext_vector_type(4)));
typedef float f32x2 __attribute__((ext_vector_type(2)));
typedef float f32x16 __attribute__((ext_vector_type(16)));
typedef unsigned u32x4 __attribute__((ext_vector_type(4)));
typedef unsigned u32x2 __attribute__((ext_vector_type(2)));

#ifndef MK_MULTI
#define MK_MULTI 0
#endif

constexpr int D = 1024, T = 8192, NB = 2, NL = NB * T, CTXL = 256, NC = NB * CTXL, NTOK = NL + NC;
constexpr int INW = 3328, OFFQ = 512, OFFK = 1024, OFFV = 1152, OFFG = 1280;
constexpr int DFF0 = 2816, DFFE = 3584, NE = 8;
constexpr int KM = 1152;
constexpr int MOE_ROWS = 2 * NL + NE * 256;
constexpr float EPS = 1e-6f;
constexpr float LOG2E = 1.4426950408889634f;
constexpr float QSCALE = 0.125f * LOG2E;

constexpr size_t MiB = 1u << 20, KiB = 1u << 10;
constexpr size_t WS_CTL = 0, CTL_BYTES = 1 * MiB;
constexpr size_t WS_ROPE = 1 * MiB, WS_TW = WS_ROPE + 32 * KiB, WS_FA64 = WS_ROPE + 96 * KiB, WS_TC = WS_ROPE + 160 * KiB, WS_TX = WS_ROPE + 288 * KiB;
constexpr size_t WS_TOKE = 2 * MiB, WS_TOKR = WS_TOKE + 128 * KiB, WS_TOKW = WS_TOKE + 256 * KiB, WS_LIST = WS_TOKE + 384 * KiB;
constexpr size_t WS_XC = 3 * MiB, WS_VCT = 5 * MiB;
constexpr size_t WS_WIN0 = 6 * MiB, WS_WM0 = WS_WIN0 + 13 * MiB / 2, WS_WO0 = 17 * MiB, WS_WGUD = 19 * MiB, WS_WDD = 30 * MiB;
constexpr size_t WS_WIN1 = 36 * MiB, WS_WM1 = WS_WIN1 + 13 * MiB / 2, WS_WO1 = 47 * MiB;
constexpr size_t WS_H = 49 * MiB;
constexpr size_t WS_DOUT = 6 * MiB;
constexpr size_t WS_WGUE = 82 * MiB, WS_WDE = 194 * MiB;
constexpr size_t WS_DOUT1 = WS_WGUE;
constexpr size_t WS_R1 = 250 * MiB;
constexpr size_t WS_UP = WS_R1, WS_Q = 266 * MiB, WS_KB = 283 * MiB, WS_VB = 288 * MiB, WS_GF = 293 * MiB, WS_GA = 326 * MiB, WS_GP = 359 * MiB, WS_FO = 375 * MiB, WS_Y = 413 * MiB;
constexpr size_t WS_ACT = WS_R1;
constexpr size_t WS_TMPC1 = 446 * MiB, WS_TMPC2 = 448 * MiB;
constexpr size_t WS_XB = 490 * MiB;
constexpr size_t WS_END = 523 * MiB;
static_assert(WS_DOUT + (size_t)MOE_ROWS * D * 2 <= WS_WGUE, "DOUT overlay");
static_assert(WS_ACT + (size_t)MOE_ROWS * DFFE * 2 <= WS_END, "ACT");
static_assert(WS_FO + (size_t)NTOK * KM * 2 <= WS_Y, "FO");
constexpr int CW_BAR = 4096, CW_CNT = 8192, CW_MOD = 16384;
constexpr int MODSZ = 6 * D;

constexpr int RING_BYTES = 131072, MISC_OFF = RING_BYTES + 320, LDS_BYTES = 147456;
constexpr int NWAVES = 8, NTHR = 512;

__device__ __forceinline__ unsigned f2bf(float f) { unsigned u = __builtin_bit_cast(unsigned, f); return (u + 0x7fffu + ((u >> 16) & 1u)) >> 16; }
__device__ __forceinline__ unsigned pk2(float lo, float hi) { return f2bf(lo) | (f2bf(hi) << 16); }
__device__ __forceinline__ unsigned cvt_pk_bf16(float lo, float hi) { unsigned r; asm volatile("v_cvt_pk_bf16_f32 %0, %1, %2" : "=v"(r) : "v"(lo), "v"(hi)); return r; }
__device__ __forceinline__ float bf2f(unsigned short h) { return __builtin_bit_cast(float, (unsigned)h << 16); }
__device__ __forceinline__ float bflo(unsigned w) { return __builtin_bit_cast(float, w << 16); }
__device__ __forceinline__ float bfhi(unsigned w) { return __builtin_bit_cast(float, w & 0xffff0000u); }
__device__ __forceinline__ float wave_sum(float v) {
#pragma unroll
    for (int o = 1; o < 64; o <<= 1) v += __shfl_xor(v, o);
    return v;
}
__device__ __forceinline__ float sigmoidf_(float x) { return __builtin_amdgcn_rcpf(1.0f + __builtin_amdgcn_exp2f(-x * LOG2E)); }
#define LDS_WAIT() asm volatile("s_waitcnt lgkmcnt(0)" ::: "memory")
#define VM_WAIT() asm volatile("s_waitcnt vmcnt(0)" ::: "memory")

#define XB_TMO      128
#define XB_XCNT(j)  (256  + 64 * (j))
#define XB_XSUB(j)  (1280 + 64 * (j))
#define XB_XGEN(j)  (2304 + 64 * (j))
#define XB_TOP      3328
#define XB_TOPGEN   3392
#define XCD_BAR_WORDS 3456
#define XB_SPIN_CAP (1u << 18)
__device__ __forceinline__ unsigned xb_ld(unsigned* p)              { return __hip_atomic_load(p, __ATOMIC_RELAXED, __HIP_MEMORY_SCOPE_AGENT); }
__device__ __forceinline__ unsigned xb_add(unsigned* p, unsigned v) { return __hip_atomic_fetch_add(p, v, __ATOMIC_RELAXED, __HIP_MEMORY_SCOPE_AGENT); }
__device__ __forceinline__ unsigned xb_xcc_id() { return (unsigned)__builtin_amdgcn_s_getreg((3 << 11) | 20) & 0xFu; }
#define XB_SPIN(cond, bar) do { unsigned _sp = 0; while (cond) { __builtin_amdgcn_s_sleep(1); \
    if ((++_sp & 255u) == 0u) { if (xb_ld(&(bar)[XB_TMO])) break; if (_sp > XB_SPIN_CAP) { atomicAdd(&(bar)[XB_TMO], 1u); break; } } } } while (0)
struct XcdBarrier { unsigned* bar; unsigned x; volatile LAS unsigned* st; };
__device__ __forceinline__ XcdBarrier xcd_barrier_post(unsigned* bar, volatile LAS unsigned* st) {
    XcdBarrier b; b.bar = bar; b.x = xb_xcc_id(); b.st = st;
    if (threadIdx.x == 0) (void)xb_add(&bar[XB_XCNT(b.x)], 1u);
    return b;
}
__device__ __forceinline__ void xcd_barrier_complete(unsigned* bar, unsigned x, unsigned& nloc, unsigned& nx) {
    const unsigned G = gridDim.x * gridDim.y * gridDim.z;
    unsigned sum, cnt, mine, sp = 0u;
    for (;;) {
        sum = 0u; cnt = 0u; mine = 0u;
#pragma unroll
        for (unsigned j = 0; j < 16; ++j) { const unsigned c = xb_ld(&bar[XB_XCNT(j)]); sum += c; cnt += (c > 0u) ? 1u : 0u; mine = (j == x) ? c : mine; }
        if (sum == G) break;
        __builtin_amdgcn_s_sleep(1);
        if ((++sp & 255u) == 0u) { if (xb_ld(&bar[XB_TMO])) break; if (sp > XB_SPIN_CAP) { atomicAdd(&bar[XB_TMO], 1u); break; } }
    }
    nloc = mine > 0u ? mine : 1u; nx = cnt > 0u ? cnt : 1u;
}
__device__ __forceinline__ void xcd_barrier(const XcdBarrier& b) {
    asm volatile("s_waitcnt vmcnt(0)" ::: "memory");
    __syncthreads();
    if (threadIdx.x == 0) {
        unsigned* bar = b.bar;
        __builtin_amdgcn_s_waitcnt(0);
        unsigned nloc = b.st[0], nx = b.st[1];
        if (nloc == 0u) { xcd_barrier_complete(bar, b.x, nloc, nx); b.st[0] = nloc; b.st[1] = nx; }
        const unsigned old = xb_add(&bar[XB_XSUB(b.x)], 1u);
        const unsigned gen = old / nloc;
        if (old + 1u == (gen + 1u) * nloc) {
            __builtin_amdgcn_fence(__ATOMIC_RELEASE, "agent");
            asm volatile("s_waitcnt vmcnt(0)" ::: "memory");
            const unsigned og = xb_add(&bar[XB_TOP], 1u);
            const unsigned tg = og / nx;
            if (og + 1u == (tg + 1u) * nx) xb_add(&bar[XB_TOPGEN], 1u);
            else XB_SPIN(xb_ld(&bar[XB_TOPGEN]) == tg, bar);
            __builtin_amdgcn_fence(__ATOMIC_ACQUIRE, "agent");
            xb_add(&bar[XB_XGEN(b.x)], 1u);
            asm volatile("s_waitcnt vmcnt(0)" ::: "memory");
        } else {
            XB_SPIN(xb_ld(&bar[XB_XGEN(b.x)]) == gen, bar);
            __builtin_amdgcn_fence(__ATOMIC_ACQUIRE, "agent");
            asm volatile("s_waitcnt vmcnt(0)" ::: "memory");
        }
    }
    __syncthreads();
}

namespace pg8 {
constexpr int BM = 256, BK = 64, HALF = 128, HTB = HALF * BK * 2, STAGE_BYTES = 8 * HTB, NXCD = 8, WGM = 8;
__host__ __device__ __forceinline__ int lds_byte(int r, int c) { const int st = (r >> 4) * 2 + (c >> 5), rr = r & 15, cc = c & 31, ob = rr * 64 + cc * 2; return st * 1024 + (ob ^ (((ob >> 9) & 1) << 5)); }
__host__ __device__ __forceinline__ void stage_rc(int b, int& R, int& C) { const int st = b / 1024, sb = b % 1024, swz = sb ^ (((sb >> 9) & 1) << 5); R = (st >> 1) * 16 + swz / 64; C = (st & 1) * 32 + (swz % 64) / 2; }
__host__ __device__ __forceinline__ int perm32(int rho) { const int n = rho >> 4, i = rho & 15; return 8 * (i >> 2) + 4 * n + (i & 3); }

struct Unit { unsigned aoff, boff; int pm, pn, kind, x0, x1, kh; };
struct Gemm { const bf16_t* A; const bf16_t* Bt; int K; int ld; };

__device__ __forceinline__ void swz_map(int L, int nM, int nN, int& pm, int& pn) {
    const int nwg = nM * nN; int wgid = L;
    { const int q = nwg / NXCD, r = nwg % NXCD, xcd = wgid % NXCD, off = wgid / NXCD; wgid = (xcd < r ? xcd * (q + 1) : r * (q + 1) + (xcd - r) * q) + off; }
    const int nig = WGM * nN, gid = wgid / nig, fm = gid * WGM, gsz = (nM - fm) < WGM ? (nM - fm) : WGM;
    pm = fm + ((wgid % nig) % gsz); pn = (wgid % nig) / gsz;
}

struct NoGather { static constexpr bool GA = false, GB = false;
    __device__ __forceinline__ unsigned arow(const Unit&, int) const { return 0u; }
    __device__ __forceinline__ unsigned brow(const Unit&, int) const { return 0u; } };

template <class Epi, class Sched, class Rows>
__device__ __forceinline__ void gemm_phase(LAS unsigned char* lds, const Gemm g, const Sched& S, const Epi& E, const Rows& RW) {
    int tid_ = threadIdx.x; asm volatile("" : "+v"(tid_));
    const int tid = tid_, wid = __builtin_amdgcn_readfirstlane(tid >> 6), lane = tid & 63, wr = wid >> 2, wc = wid & 3, fr = lane & 15, fq = lane >> 4;
    int K_ = g.K; asm volatile("" : "+s"(K_));
    const int K = K_, nt = K / BK;
    int sR[2], sRb[2], sC[2];
#pragma unroll
    for (int i = 0; i < 2; ++i) { int R, C; stage_rc(tid * 16 + i * 8192, R, C); sR[i] = R; sC[i] = C; sRb[i] = (R & ~31) + perm32(R & 31); }
    unsigned voffA[2], voffB[2];
    const int LD = g.ld;
#pragma unroll
    for (int i = 0; i < 2; ++i) { voffA[i] = (unsigned)(sR[i] * LD + sC[i]) * 2u; voffB[i] = (unsigned)(sRb[i] * LD + sC[i]) * 2u; }
    const size_t kstep = (size_t)(BK * 2);
    const size_t hstep = (size_t)HALF * LD * 2;
    const unsigned ldsw = (unsigned)wid * 1024u;
    const int aoff = lds_byte(wr * 64 + fr, fq * 8), boff = lds_byte(wc * 32 + fr, fq * 8);
    struct Side { const char* base[2]; unsigned off[2][2]; };
#define PG8_SA(b, h) (((b) * 2 + (h)) * HTB)
#define PG8_SB(b, h) ((4 + (b) * 2 + (h)) * HTB)
#define PG8_STAGE(bufoff, side, h, kt) do { _Pragma("unroll") for (int _i = 0; _i < 2; ++_i) \
        __builtin_amdgcn_global_load_lds((const unsigned*)((side).base[h] + (size_t)(kt) * kstep + (side).off[h][_i]), (LAS unsigned*)(lds + (bufoff) + ldsw + _i * 8192), 16, 0, 0); } while (0)
#define PG8_LDA(dst, b, h) do { _Pragma("unroll") for (int m = 0; m < 4; ++m) _Pragma("unroll") for (int k = 0; k < 2; ++k) dst[m][k] = *(const LAS bf16x8*)(lds + PG8_SA(b, h) + aoff + m * 2048 + k * 1024); } while (0)
#define PG8_LDB(dst, b, h) do { _Pragma("unroll") for (int n = 0; n < 2; ++n) _Pragma("unroll") for (int k = 0; k < 2; ++k) dst[n][k] = *(const LAS bf16x8*)(lds + PG8_SB(b, h) + boff + n * 2048 + k * 1024); } while (0)
#define PG8_MMA(ai, bj, At, Bt) do { __builtin_amdgcn_s_setprio(1); _Pragma("unroll") for (int m = 0; m < 4; ++m) _Pragma("unroll") for (int n = 0; n < 2; ++n) _Pragma("unroll") for (int k = 0; k < 2; ++k) \
        acc[ai][bj][m][n] = __builtin_amdgcn_mfma_f32_16x16x32_bf16(Bt[n][k], At[m][k], acc[ai][bj][m][n], 0, 0, 0); __builtin_amdgcn_s_setprio(0); } while (0)
#define PG8_WAIT_V(n) asm volatile("s_waitcnt vmcnt(" #n ")" ::: "memory")
#define PG8_WAIT_L(n) asm volatile("s_waitcnt lgkmcnt(" #n ")" ::: "memory")
#define PG8_BAR __builtin_amdgcn_s_barrier()
#define PG8_SCHED __builtin_amdgcn_sched_barrier(0)
#define PG8_MKSIDES(u, sa, sb) do { \
        if constexpr (Rows::GA) { sa.base[0] = sa.base[1] = (const char*)g.A; _Pragma("unroll") for (int h = 0; h < 2; ++h) _Pragma("unroll") for (int i = 0; i < 2; ++i) sa.off[h][i] = RW.arow(u, h * HALF + sR[i]) + (unsigned)sC[i] * 2u; } \
        else { sa.base[0] = (const char*)g.A + (u).aoff; sa.base[1] = sa.base[0] + hstep; _Pragma("unroll") for (int h = 0; h < 2; ++h) _Pragma("unroll") for (int i = 0; i < 2; ++i) sa.off[h][i] = voffA[i]; } \
        if constexpr (Rows::GB) { sb.base[0] = sb.base[1] = (const char*)g.Bt; _Pragma("unroll") for (int h = 0; h < 2; ++h) _Pragma("unroll") for (int i = 0; i < 2; ++i) sb.off[h][i] = RW.brow(u, h * HALF + sRb[i]) + (unsigned)sC[i] * 2u; } \
        else { sb.base[0] = (const char*)g.Bt + (u).boff; sb.base[1] = sb.base[0] + hstep; _Pragma("unroll") for (int h = 0; h < 2; ++h) _Pragma("unroll") for (int i = 0; i < 2; ++i) sb.off[h][i] = voffB[i]; } } while (0)
    Unit cur, nxt; int ui = 0;
    if (!S.next(0, cur)) return;
    f32x4 acc[2][2][4][2];
#pragma unroll
    for (int a = 0; a < 2; ++a)
#pragma unroll
        for (int b = 0; b < 2; ++b)
#pragma unroll
            for (int m = 0; m < 4; ++m)
#pragma unroll
                for (int n = 0; n < 2; ++n) acc[a][b][m][n] = (f32x4){0.f, 0.f, 0.f, 0.f};
    bf16x8 At[4][2], B0[2][2], B1[2][2];
    Side cA, cB, nA, nB;
    PG8_MKSIDES(cur, cA, cB);
    PG8_STAGE(PG8_SB(0, 0), cB, 0, 0); PG8_STAGE(PG8_SB(0, 1), cB, 1, 0); PG8_STAGE(PG8_SA(0, 0), cA, 0, 0); PG8_STAGE(PG8_SA(0, 1), cA, 1, 0);
    if (wr == 1) PG8_BAR;
    PG8_WAIT_V(2); PG8_BAR;
    PG8_STAGE(PG8_SB(1, 0), cB, 0, 1); PG8_STAGE(PG8_SA(1, 0), cA, 0, 1); PG8_STAGE(PG8_SB(1, 1), cB, 1, 1);
    PG8_WAIT_V(6); PG8_BAR;
    for (;;) {
        const bool has_next = S.next(ui + 1, nxt);
        if (has_next) { PG8_MKSIDES(nxt, nA, nB); } else { nA = cA; nB = cB; }
        for (int t = 0; t < nt; t += 2) {
            const bool last = (t == nt - 2);
            if constexpr (Epi::MIDK > 0) { if (t == Epi::MIDK) E.mid(acc, cur, wr, wc, fr, fq); }
            Side a2, b2;
            a2.base[0] = last ? nA.base[0] : cA.base[0]; a2.base[1] = last ? nA.base[1] : cA.base[1];
            b2.base[0] = last ? nB.base[0] : cB.base[0]; b2.base[1] = last ? nB.base[1] : cB.base[1];
#pragma unroll
            for (int h = 0; h < 2; ++h)
#pragma unroll
                for (int i = 0; i < 2; ++i) { a2.off[h][i] = (Rows::GA && last) ? nA.off[h][i] : cA.off[h][i]; b2.off[h][i] = (Rows::GB && last) ? nB.off[h][i] : cB.off[h][i]; }
            const int k2 = last ? 0 : t + 2, k3 = k2 + 1;
            PG8_LDB(B0, 0, 0); PG8_LDB(B1, 0, 1); PG8_SCHED; PG8_LDA(At, 0, 0); PG8_STAGE(PG8_SA(1, 1), cA, 1, t + 1);
            PG8_WAIT_V(8); PG8_WAIT_L(0); PG8_BAR; PG8_MMA(0, 0, At, B0); PG8_MMA(0, 1, At, B1); PG8_BAR; PG8_SCHED;
            PG8_LDA(At, 0, 1); PG8_STAGE(PG8_SB(0, 0), b2, 0, k2); PG8_STAGE(PG8_SB(0, 1), b2, 1, k2); PG8_STAGE(PG8_SA(0, 0), a2, 0, k2);
            PG8_WAIT_V(8); PG8_WAIT_L(0); PG8_BAR; PG8_MMA(1, 0, At, B0); PG8_MMA(1, 1, At, B1); PG8_BAR; PG8_SCHED;
            PG8_LDB(B0, 1, 0); PG8_LDB(B1, 1, 1); PG8_SCHED; PG8_LDA(At, 1, 0); PG8_STAGE(PG8_SA(0, 1), a2, 1, k2);
            PG8_WAIT_V(8); PG8_WAIT_L(0); PG8_BAR; PG8_MMA(0, 0, At, B0); PG8_MMA(0, 1, At, B1); PG8_BAR; PG8_SCHED;
            PG8_LDA(At, 1, 1); PG8_STAGE(PG8_SB(1, 0), b2, 0, k3); PG8_STAGE(PG8_SB(1, 1), b2, 1, k3); PG8_STAGE(PG8_SA(1, 0), a2, 0, k3);
            PG8_WAIT_V(8); PG8_WAIT_L(0); PG8_BAR; PG8_MMA(1, 0, At, B0); PG8_MMA(1, 1, At, B1); PG8_BAR; PG8_SCHED;
        }
        if (wr == 0) PG8_BAR;
        E(acc, cur, wr, wc, fr, fq);
        if (!has_next) break;
#pragma unroll
        for (int a = 0; a < 2; ++a)
#pragma unroll
            for (int b = 0; b < 2; ++b)
#pragma unroll
                for (int m = 0; m < 4; ++m)
#pragma unroll
                    for (int n = 0; n < 2; ++n) acc[a][b][m][n] = (f32x4){0.f, 0.f, 0.f, 0.f};
        cur = nxt; cA = nA; cB = nB; ++ui;
        if (wr == 1) PG8_BAR;
    }
    PG8_WAIT_V(0);
    PG8_BAR;
#undef PG8_SA
#undef PG8_SB
#undef PG8_STAGE
#undef PG8_LDA
#undef PG8_LDB
#undef PG8_MMA
#undef PG8_WAIT_V
#undef PG8_WAIT_L
#undef PG8_BAR
#undef PG8_SCHED
#undef PG8_MKSIDES
}

struct SUnit { unsigned aoff, boff; int K; int pm, pn, kind, x0, x1, grp, dep, sig; };
__device__ __forceinline__ void st16_wt(unsigned char* wsbase, unsigned off, u32x4 v) {
    const __amdgpu_buffer_rsrc_t rsrc = __builtin_amdgcn_make_buffer_rsrc((void*)wsbase, 0, 0x7fffffff, 0x00020000);
    __builtin_amdgcn_raw_buffer_store_b128(v, rsrc, off, 0, 16); }

template <class Epi, class Sched, class Rows>
__device__ __forceinline__ void gemm_stream(LAS unsigned char* lds, const char* base, const Sched& S, const Epi& E, const Rows& RW) {
    int tid_ = threadIdx.x; asm volatile("" : "+v"(tid_));
    const int tid = tid_, wid = __builtin_amdgcn_readfirstlane(tid >> 6), lane = tid & 63, wr = wid >> 2, wc = wid & 3, fr = lane & 15, fq = lane >> 4;
    int sR[2], sRb[2], sC[2];
#pragma unroll
    for (int i = 0; i < 2; ++i) { int R, C; stage_rc(tid * 16 + i * 8192, R, C); sR[i] = R; sC[i] = C; sRb[i] = (R & ~31) + perm32(R & 31); }
    const size_t kstep = (size_t)(BK * 2);
    const unsigned ldsw = (unsigned)wid * 1024u;
    const int aoff = lds_byte(wr * 64 + fr, fq * 8), boff = lds_byte(wc * 32 + fr, fq * 8);
    struct Side { const char* base[2]; unsigned off[2][2]; };
#define PG8_SA(b, h) (((b) * 2 + (h)) * HTB)
#define PG8_SB(b, h) ((4 + (b) * 2 + (h)) * HTB)
#define PG8_STAGE(bufoff, side, h, kt) do { _Pragma("unroll") for (int _i = 0; _i < 2; ++_i) \
        __builtin_amdgcn_global_load_lds((const unsigned*)((side).base[h] + (size_t)(kt) * kstep + (side).off[h][_i]), (LAS unsigned*)(lds + (bufoff) + ldsw + _i * 8192), 16, 0, 0); } while (0)
#define PG8_LDA(dst, b, h) do { _Pragma("unroll") for (int m = 0; m < 4; ++m) _Pragma("unroll") for (int k = 0; k < 2; ++k) dst[m][k] = *(const LAS bf16x8*)(lds + PG8_SA(b, h) + aoff + m * 2048 + k * 1024); } while (0)
#define PG8_LDB(dst, b, h) do { _Pragma("unroll") for (int n = 0; n < 2; ++n) _Pragma("unroll") for (int k = 0; k < 2; ++k) dst[n][k] = *(const LAS bf16x8*)(lds + PG8_SB(b, h) + boff + n * 2048 + k * 1024); } while (0)
#define PG8_MMA(ai, bj, At, Bt) do { __builtin_amdgcn_s_setprio(1); _Pragma("unroll") for (int m = 0; m < 4; ++m) _Pragma("unroll") for (int n = 0; n < 2; ++n) _Pragma("unroll") for (int k = 0; k < 2; ++k) \
        acc[ai][bj][m][n] = __builtin_amdgcn_mfma_f32_16x16x32_bf16(Bt[n][k], At[m][k], acc[ai][bj][m][n], 0, 0, 0); __builtin_amdgcn_s_setprio(0); } while (0)
#define PG8_WAIT_V(n) asm volatile("s_waitcnt vmcnt(" #n ")" ::: "memory")
#define PG8_WAIT_L(n) asm volatile("s_waitcnt lgkmcnt(" #n ")" ::: "memory")
#define PG8_BAR __builtin_amdgcn_s_barrier()
#define PG8_SCHED __builtin_amdgcn_sched_barrier(0)
#define PG8_MKSIDES(un, sa, sb) do { const int K_ = (un).K; \
        if (RW.a_gather(un)) { sa.base[0] = sa.base[1] = base; _Pragma("unroll") for (int h = 0; h < 2; ++h) _Pragma("unroll") for (int i = 0; i < 2; ++i) sa.off[h][i] = RW.arow(un, h * HALF + sR[i]) + (unsigned)sC[i] * 2u; } \
        else { sa.base[0] = base + (un).aoff; sa.base[1] = sa.base[0] + (size_t)HALF * K_ * 2; _Pragma("unroll") for (int h = 0; h < 2; ++h) _Pragma("unroll") for (int i = 0; i < 2; ++i) sa.off[h][i] = (unsigned)(sR[i] * K_ + sC[i]) * 2u; } \
        sb.base[0] = base + (un).boff; sb.base[1] = sb.base[0] + (size_t)HALF * K_ * 2; _Pragma("unroll") for (int h = 0; h < 2; ++h) _Pragma("unroll") for (int i = 0; i < 2; ++i) sb.off[h][i] = (unsigned)(sRb[i] * K_ + sC[i]) * 2u; } while (0)
#define PG8_SIGNAL(idx) do { if (lane == 0) __hip_atomic_fetch_add(S.rdy + 64 * (idx), 1u, __ATOMIC_RELAXED, __HIP_MEMORY_SCOPE_AGENT); } while (0)
    SUnit cur, nxt;
    unsigned pend = 0u;
    const unsigned lw_addr = (unsigned)(size_t)S.lw;
    if (tid == 0) { S.lw[0] = __hip_atomic_fetch_add(S.q, 1u, __ATOMIC_RELAXED, __HIP_MEMORY_SCOPE_AGENT); pend = __hip_atomic_fetch_add(S.q, 1u, __ATOMIC_RELAXED, __HIP_MEMORY_SCOPE_AGENT); }
    __syncthreads();
    { const int L0 = __builtin_amdgcn_readfirstlane((int)S.lw[0]); if (!S.decode(L0, cur)) return; }
    f32x4 acc[2][2][4][2];
#pragma unroll
    for (int a = 0; a < 2; ++a)
#pragma unroll
        for (int b = 0; b < 2; ++b)
#pragma unroll
            for (int m = 0; m < 4; ++m)
#pragma unroll
                for (int n = 0; n < 2; ++n) acc[a][b][m][n] = (f32x4){0.f, 0.f, 0.f, 0.f};
    bf16x8 At[4][2], B0[2][2], B1[2][2];
    Side cA, cB, nA, nB;
    bool need_pro = true; int sig_idx = -1;
    PG8_MKSIDES(cur, cA, cB);
    for (;;) {
        if (need_pro) {
            if (cur.dep >= 0) S.a_ready(cur);
            PG8_STAGE(PG8_SB(0, 0), cB, 0, 0); PG8_STAGE(PG8_SB(0, 1), cB, 1, 0); PG8_STAGE(PG8_SA(0, 0), cA, 0, 0); PG8_STAGE(PG8_SA(0, 1), cA, 1, 0);
            if (wr == 1) PG8_BAR;
            PG8_WAIT_V(2); PG8_BAR;
            PG8_STAGE(PG8_SB(1, 0), cB, 0, 1); PG8_STAGE(PG8_SA(1, 0), cA, 0, 1); PG8_STAGE(PG8_SB(1, 1), cB, 1, 1);
            PG8_WAIT_V(6); PG8_BAR;
        }
        if (tid == 0) { asm volatile("s_nop 7\n\tds_write_b32 %1, %0\n\tglobal_atomic_add %0, %2, %3, %4 sc0" : "+v"(pend) : "v"(lw_addr), "v"(0u), "v"(1u), "s"(S.q) : "memory"); }
        PG8_WAIT_L(0); PG8_BAR; asm volatile("" ::: "memory");
        const int Ln = __builtin_amdgcn_readfirstlane((int)S.lw[0]);
        const bool has_next = S.decode(Ln, nxt), pre = has_next && nxt.dep < 0;
        if (pre) { PG8_MKSIDES(nxt, nA, nB); } else { nA = cA; nB = cB; }
        const int nt = cur.K / BK;
        for (int t = 0; t < nt; t += 2) {
            const bool last = (t == nt - 2);
            Side a2, b2;
            a2.base[0] = last ? nA.base[0] : cA.base[0]; a2.base[1] = last ? nA.base[1] : cA.base[1];
            b2.base[0] = last ? nB.base[0] : cB.base[0]; b2.base[1] = last ? nB.base[1] : cB.base[1];
#pragma unroll
            for (int h = 0; h < 2; ++h)
#pragma unroll
                for (int i = 0; i < 2; ++i) { a2.off[h][i] = last ? nA.off[h][i] : cA.off[h][i]; b2.off[h][i] = last ? nB.off[h][i] : cB.off[h][i]; }
            const int k2 = last ? 0 : t + 2, k3 = k2 + 1;
            if (t == 2 && sig_idx >= 0) { PG8_SIGNAL(sig_idx); sig_idx = -1; }
            PG8_LDB(B0, 0, 0); PG8_LDB(B1, 0, 1); PG8_SCHED; PG8_LDA(At, 0, 0); PG8_STAGE(PG8_SA(1, 1), cA, 1, t + 1);
            PG8_WAIT_V(8); PG8_WAIT_L(0); PG8_BAR; PG8_MMA(0, 0, At, B0); PG8_MMA(0, 1, At, B1); PG8_BAR; PG8_SCHED;
            PG8_LDA(At, 0, 1); PG8_STAGE(PG8_SB(0, 0), b2, 0, k2); PG8_STAGE(PG8_SB(0, 1), b2, 1, k2); PG8_STAGE(PG8_SA(0, 0), a2, 0, k2);
            PG8_WAIT_V(8); PG8_WAIT_L(0); PG8_BAR; PG8_MMA(1, 0, At, B0); PG8_MMA(1, 1, At, B1); PG8_BAR; PG8_SCHED;
            PG8_LDB(B0, 1, 0); PG8_LDB(B1, 1, 1); PG8_SCHED; PG8_LDA(At, 1, 0); PG8_STAGE(PG8_SA(0, 1), a2, 1, k2);
            PG8_WAIT_V(8); PG8_WAIT_L(0); PG8_BAR; PG8_MMA(0, 0, At, B0); PG8_MMA(0, 1, At, B1); PG8_BAR; PG8_SCHED;
            PG8_LDA(At, 1, 1); PG8_STAGE(PG8_SB(1, 0), b2, 0, k3); PG8_STAGE(PG8_SB(1, 1), b2, 1, k3); PG8_STAGE(PG8_SA(1, 0), a2, 0, k3);
            PG8_WAIT_V(8); PG8_WAIT_L(0); PG8_BAR; PG8_MMA(1, 0, At, B0); PG8_MMA(1, 1, At, B1); PG8_BAR; PG8_SCHED;
        }
        if (wr == 0) PG8_BAR;
        E(acc, cur, wr, wc, fr, fq);
        if (!has_next) { PG8_WAIT_V(0); if (cur.sig >= 0) PG8_SIGNAL(cur.sig); break; }
#pragma unroll
        for (int a = 0; a < 2; ++a)
#pragma unroll
            for (int b = 0; b < 2; ++b)
#pragma unroll
                for (int m = 0; m < 4; ++m)
#pragma unroll
                    for (int n = 0; n < 2; ++n) acc[a][b][m][n] = (f32x4){0.f, 0.f, 0.f, 0.f};
        if (pre) {
            sig_idx = cur.sig; need_pro = false; cur = nxt; cA = nA; cB = nB;
            if (wr == 1) PG8_BAR;
        } else {
            PG8_WAIT_V(0); if (cur.sig >= 0) PG8_SIGNAL(cur.sig);
            PG8_BAR; need_pro = true; cur = nxt; PG8_MKSIDES(cur, cA, cB);
        }
    }
    PG8_BAR;
#undef PG8_SA
#undef PG8_SB
#undef PG8_STAGE
#undef PG8_LDA
#undef PG8_LDB
#undef PG8_MMA
#undef PG8_WAIT_V
#undef PG8_WAIT_L
#undef PG8_BAR
#undef PG8_SCHED
#undef PG8_MKSIDES
#undef PG8_SIGNAL
}
}
using pg8::Unit;
using pg8::SUnit;

struct Args { const float* in[21]; float* out; unsigned char* ws; int ph_lo, ph_hi; };

struct Frame {
    LAS unsigned char* lds;
    unsigned char* ws;
    const float* const* in;
    float* out;
    int tid, lane, wave, G, bx;
};
__device__ __forceinline__ float* modp(const Frame& F, int l, int v) { return (float*)(F.ws + WS_CTL) + CW_MOD + (l * 3 + v) * MODSZ; }

__device__ __forceinline__ void p0_transpose_item(const float* W, int ldw, int k0, int c0, bf16_t* WT, int ldt, int drow, int lane) {
    const float* src = W + (size_t)k0 * ldw + c0 + lane;
    float v[64];
#pragma unroll
    for (int i = 0; i < 64; ++i) v[i] = src[(size_t)i * ldw];
    bf16_t* dst = WT + (size_t)drow * ldt + k0;
#pragma unroll
    for (int j = 0; j < 8; ++j) { u32x4 o; o.x = pk2(v[8 * j], v[8 * j + 1]); o.y = pk2(v[8 * j + 2], v[8 * j + 3]); o.z = pk2(v[8 * j + 4], v[8 * j + 5]); o.w = pk2(v[8 * j + 6], v[8 * j + 7]);
        *(u32x4*)(dst + 8 * j) = o; }
}

constexpr int CW_CONVQ = 12288 + 128;
constexpr int MOE_I_GE = 16 * 56, MOE_I_DE = 56 * 16, MOE_ITEMS = NE * (2 * MOE_I_GE + MOE_I_DE), MOE_BATCHES = MOE_ITEMS / 8;
__device__ __forceinline__ void moe_convert_batch(Frame& F, int which, int idx) {
    const float* const* in = F.in; const int ln = F.lane;
    int r = idx * 8 + F.wave;
    if (which == 0) { const int e = r / (2 * MOE_I_GE); r %= (2 * MOE_I_GE); const int up = r / MOE_I_GE; r %= MOE_I_GE; const int kb = r / 56, nb = r % 56, c0 = 64 * nb;
        p0_transpose_item(in[up ? 18 : 17] + (size_t)e * D * DFFE, DFFE, 64 * kb, c0, (bf16_t*)(F.ws + WS_WGUE) + (size_t)e * 2 * DFFE * D, D, (c0 >> 7) * 256 + up * 128 + (c0 & 127) + ln, ln); }
    else { const int e = r / MOE_I_DE; r %= MOE_I_DE; const int kb = r / 16, nb = r % 16;
        p0_transpose_item(in[19] + (size_t)e * DFFE * D, D, 64 * kb, 64 * nb, (bf16_t*)(F.ws + WS_WDE) + (size_t)e * D * DFFE, DFFE, 64 * nb + ln, ln); }
}
__device__ __forceinline__ void moe_convert(Frame& F, int which) {
    volatile LAS unsigned* lw = (volatile LAS unsigned*)(F.lds + MISC_OFF) + 20;
    unsigned* q = (unsigned*)(F.ws + WS_CTL) + CW_CONVQ + 64 * which;
    const int nb = which == 0 ? NE * 2 * MOE_I_GE / 8 : NE * MOE_I_DE / 8;
    for (;;) {
        __syncthreads();
        if (F.tid == 0) lw[0] = __hip_atomic_fetch_add(q, 1u, __ATOMIC_RELAXED, __HIP_MEMORY_SCOPE_AGENT);
        __syncthreads();
        const int idx = (int)lw[0];
        if (idx >= nb) break;
        moe_convert_batch(F, which, idx);
    }
    __syncthreads();
}

__device__ __forceinline__ void p0_prologue(Frame& F) {
    const float* const* in = F.in;
    const int gw = F.bx * NWAVES + F.wave, NGW = F.G * NWAVES;
    {
        constexpr int I_IN = 16 * 44, I_O = 16 * 16, I_GD = 16 * 44, I_DD = 44 * 16;
        constexpr int N_A = 2 * I_IN + 2 * I_O + 2 * I_GD + I_DD;
        const int ln = F.lane;
        for (int it = gw; it < N_A; it += NGW) {
            int r = it;
            if (r < 2 * I_IN) { const int l = r / I_IN; r %= I_IN; const int kb = r / 44, nb = r % 44, c0 = 512 + 64 * nb;
                const int n32 = ln & 31; const int dn = c0 < OFFV ? (ln & 32) + ((n32 < 16) ? 2 * n32 : 2 * (n32 - 16) + 1) : ln;
                int drow = c0 + dn;
                if (c0 >= OFFG) { const int gcol = c0 - OFFG; drow = gcol < D ? OFFG + (gcol >> 7) * 256 + (gcol & 127) + ln : OFFG + ((gcol - D) >> 7) * 256 + 128 + ((gcol - D) & 127) + ln; }
                p0_transpose_item(in[8] + (size_t)l * D * INW, INW, 64 * kb, c0, (bf16_t*)(F.ws + (l ? WS_WIN1 : WS_WIN0)), D, drow, ln); continue; }
            r -= 2 * I_IN;
            if (r < 2 * I_O) { const int l = r / I_O; r %= I_O; const int kb = r / 16, nb = r % 16;
                p0_transpose_item(in[12] + (size_t)l * D * D, D, 64 * kb, 64 * nb, (bf16_t*)(F.ws + (l ? WS_WO1 : WS_WO0)), D, 64 * nb + ln, ln); continue; }
            r -= 2 * I_O;
            if (r < 2 * I_GD) { const int up = r / I_GD; r %= I_GD; const int kb = r / 44, nb = r % 44, c0 = 64 * nb;
                p0_transpose_item(in[up ? 14 : 13], DFF0, 64 * kb, c0, (bf16_t*)(F.ws + WS_WGUD), D, (c0 >> 7) * 256 + up * 128 + (c0 & 127) + ln, ln); continue; }
            r -= 2 * I_GD;
            { const int kb = r / 16, nb = r % 16;
              p0_transpose_item(in[15], D, 64 * kb, 64 * nb, (bf16_t*)(F.ws + WS_WDD), DFF0, 64 * nb + ln, ln); }
        }
    }
    __syncthreads();
    {
        LAS float* wrow = (LAS float*)F.lds;
        LAS float* ctab = wrow + 4096;
        if (F.tid < 128) ctab[F.tid] = cospif((float)F.tid / 64.0f);
        for (int it = F.bx; it < 2 * 128; it += F.G) {
            const int l = it >> 7, d0 = (it & 127) * 8;
            __syncthreads();
            for (int i = F.tid; i < 4096; i += NTHR) wrow[i] = in[8][(size_t)l * D * INW + (size_t)(d0 + (i >> 9)) * INW + (i & 511)];
            __syncthreads();
            const int r = F.tid, j = r >> 1, ri = r & 1, g = j >> 6, jj = j & 63;
            float a[8];
#pragma unroll
            for (int q = 0; q < 8; ++q) a[q] = 0.f;
            for (int cc = 0; cc < 128; ++cc) {
                float cf;
                if (jj == 0) cf = ri ? ((cc & 1) ? -1.f : 1.f) : 1.f;
                else { const int idx = (cc * jj) & 127; cf = ri ? -ctab[(idx - 32) & 127] : ctab[idx]; }
#pragma unroll
                for (int q = 0; q < 8; ++q) a[q] += cf * wrow[q * 512 + g * 128 + cc];
            }
            u32x4 o; o.x = pk2(a[0], a[1]); o.y = pk2(a[2], a[3]); o.z = pk2(a[4], a[5]); o.w = pk2(a[6], a[7]);
            *(u32x4*)((bf16_t*)(F.ws + (l ? WS_WIN1 : WS_WIN0)) + (size_t)r * D + d0) = o;
        }
        __syncthreads();
    }
    const int gt = F.bx * NTHR + F.tid, NGT = F.G * NTHR;
    for (int it = gt; it < 2 * 1024 * 144; it += NGT) {
        const int l = it / (1024 * 144), r = it % (1024 * 144), kc = r / 1024, o = r % 1024;
        const float* wf = in[10] + (size_t)l * 512 * D; const float* wa = in[11] + (size_t)l * 512 * D;
        float v[8];
#pragma unroll
        for (int q = 0; q < 8; ++q) { const int k = kc * 8 + q; float x = 0.f;
            if (k < 512) { const int mm = k & 127; x = wf[(size_t)k * D + o] * ((mm == 0 || mm == 64) ? 0.5f : 1.f); }
            else if (k < 520) { const int gg = (k - 512) >> 1, sgn = (k - 512) & 1; x = 0.5f * wf[(size_t)(gg * 128 + 64 * sgn) * D + o]; }
            else if (k >= 640) x = wa[(size_t)(k - 640) * D + o];
            v[q] = x; }
        u32x4 w; w.x = pk2(v[0], v[1]); w.y = pk2(v[2], v[3]); w.z = pk2(v[4], v[5]); w.w = pk2(v[6], v[7]);
        *(u32x4*)((bf16_t*)(F.ws + (l ? WS_WM1 : WS_WM0)) + (size_t)o * KM + kc * 8) = w;
    }
    for (int it = gt; it < 192 * 16; it += NGT) {
        const int i = it & 15, p = it >> 4, pos = p < 128 ? p : p - 128;
        const float inv = powf(10000.0f, -(float)i / 16.0f), a = (float)pos * inv;
        ((f32x2*)(F.ws + WS_ROPE))[it] = (f32x2){cosf(a), sinf(a)};
    }
    for (int it = gt; it < 128 * 64; it += NGT) {
        const int t2 = it >> 6, k1 = it & 63; float s, c; sincospif((float)(t2 * k1) / 4096.0f, &s, &c);
        ((f32x2*)(F.ws + WS_TW))[it] = (f32x2){c, s};
    }
    for (int it = gt; it < 256 * 128; it += NGT) {
        const int nu = it >> 7, ka = it & 127; float v = 0.f;
        if (nu < 128) { const int k1 = nu >> 1, ro = nu & 1, ri = ka >> 6, t1 = ka & 63; float s, c; sincospif((float)((t1 * k1) & 63) / 32.0f, &s, &c);
            v = ro == 0 ? (ri == 0 ? c : s) : (ri == 0 ? -s : c); }
        ((bf16_t*)(F.ws + WS_FA64))[it] = (bf16_t)f2bf(v);
    }
    for (int it = gt; it < 256 * 256; it += NGT) {
        const int mu = it >> 8, la = it & 255, k2 = mu >> 1, ro = mu & 1, ri = la >> 7, t2 = la & 127; float s, c; sincospif((float)((t2 * k2) & 127) / 64.0f, &s, &c);
        const float v = (ro == 0 ? (ri == 0 ? c : s) : (ri == 0 ? -s : c)) * 0.0009765625f;
        ((bf16_t*)(F.ws + WS_TC))[it] = (bf16_t)f2bf(v);
    }
    for (int it = gt; it < 512 * 512; it += NGT) {
        const int mu = it >> 9, la = it & 511, k = mu >> 1, ro = mu & 1, ri = la >> 8, t = la & 255; float s, c; sincospif((float)((t * k) & 255) / 128.0f, &s, &c);
        const float v = (ro == 0 ? (ri == 0 ? c : s) : (ri == 0 ? -s : c)) * 0.005524271728019903f;
        ((bf16_t*)(F.ws + WS_TX))[it] = (bf16_t)f2bf(v);
    }
    __syncthreads();
    {
        LAS float* sl = (LAS float*)F.lds;
        LAS float* part = sl + 3 * D;
        for (int i = F.tid; i < 3 * D; i += NTHR) { const float c = i < 2 * D ? in[1][i] : in[3][i - 2 * D]; sl[i] = c / (1.0f + __expf(-c)); }
        __syncthreads();
        for (int it = F.bx; it < 2 * 96; it += F.G) {
            const int l = it / 96, n = (it % 96) * 64 + F.lane;
            const float* wm = in[4] + (size_t)l * D * MODSZ + (size_t)(F.wave * 128) * MODSZ + n;
            float a0 = 0.f, a1 = 0.f, a2 = 0.f;
#pragma unroll
            for (int d0 = 0; d0 < 128; d0 += 32) { float w[32];
#pragma unroll
                for (int q = 0; q < 32; ++q) w[q] = wm[(size_t)(d0 + q) * MODSZ];
#pragma unroll
                for (int q = 0; q < 32; ++q) { const int d = F.wave * 128 + d0 + q; a0 += sl[d] * w[q]; a1 += sl[D + d] * w[q]; a2 += sl[2 * D + d] * w[q]; } }
            __syncthreads();
            part[(F.wave * 3 + 0) * 64 + F.lane] = a0; part[(F.wave * 3 + 1) * 64 + F.lane] = a1; part[(F.wave * 3 + 2) * 64 + F.lane] = a2;
            __syncthreads();
            if (F.tid < 192) { const int v = F.tid >> 6, ln = F.tid & 63; float sacc = in[5][l * MODSZ + (it % 96) * 64 + ln];
#pragma unroll
                for (int w = 0; w < 8; ++w) sacc += part[(w * 3 + v) * 64 + ln];
                modp(F, l, v)[(it % 96) * 64 + ln] = sacc; }
        }
    }
    for (int it = gt; it < NTOK * 15; it += NGT) { const int row = it / 15, c = it % 15;
        *(u32x4*)((bf16_t*)(F.ws + WS_FO) + (size_t)row * KM + 520 + c * 8) = (u32x4){0u, 0u, 0u, 0u}; }
}

__device__ __forceinline__ const float* xrow_ptr(const Frame& F, int row, const float* xl) { return row < NL ? xl + (size_t)row * D : (const float*)(F.ws + WS_XC) + (size_t)(row - NL) * D; }

template <bool ROUTE>
__device__ __forceinline__ void norm_phase(Frame& F, int l, int which  , const float* xl, const float* xc, int nrows, const float* xcadd = nullptr, float* xcwb = nullptr) {
    const float* gvec = F.in[which ? 7 : 6] + l * D;
    LAS float* wr_l = (LAS float*)F.lds;
    if (ROUTE) { for (int i = F.tid; i < D * NE; i += NTHR) wr_l[i] = F.in[16][i]; __syncthreads(); }
    const int gw = F.bx * NWAVES + F.wave, NGW = F.G * NWAVES;
    for (int row = gw; row < nrows; row += NGW) {
        const int v = row < T ? 0 : (row < NL ? 1 : 2);
        const bool fromb = row < NL && xl == nullptr;
        const float* xr = row < NL ? (fromb ? xc : xl + (size_t)row * D) : xc + (size_t)(row - NL) * D;
        const bf16_t* xbr = (const bf16_t*)(F.ws + WS_XB) + (size_t)row * D;
        const float* sh = modp(F, l, v) + (which ? 3 : 0) * D; const float* sc = sh + D;
        f32x4 x[4]; float s = 0.f;
#pragma unroll
        for (int j = 0; j < 4; ++j) {
            if (fromb) { const u32x2 xb = *(const u32x2*)(xbr + 256 * j + 4 * F.lane); x[j] = (f32x4){bflo(xb.x), bfhi(xb.x), bflo(xb.y), bfhi(xb.y)}; }
            else x[j] = *(const f32x4*)(xr + 256 * j + 4 * F.lane);
            if (row >= NL && xcadd) { x[j] = x[j] + *(const f32x4*)(xcadd + (size_t)(row - NL) * D + 256 * j + 4 * F.lane); if (xcwb) *(f32x4*)(xcwb + (size_t)(row - NL) * D + 256 * j + 4 * F.lane) = x[j]; }
            s += (x[j].x * x[j].x + x[j].y * x[j].y) + (x[j].z * x[j].z + x[j].w * x[j].w); }
        const float r = 1.0f / sqrtf(wave_sum(s) * (1.f / D) + EPS);
        float lg[NE];
        if (ROUTE) {
#pragma unroll
            for (int e = 0; e < NE; ++e) lg[e] = 0.f; }
        bf16_t* hr = (bf16_t*)(F.ws + WS_H) + (size_t)row * D;
#pragma unroll
        for (int j = 0; j < 4; ++j) { const int c = 256 * j + 4 * F.lane;
            const f32x4 gg = *(const f32x4*)(gvec + c), s4 = *(const f32x4*)(sh + c), c4 = *(const f32x4*)(sc + c);
            f32x4 h = (x[j] * r) * gg; h = h * (c4 + 1.0f) + s4;
            u32x2 o; o.x = pk2(h.x, h.y); o.y = pk2(h.z, h.w); *(u32x2*)(hr + c) = o;
            if (ROUTE) {
#pragma unroll
                for (int q = 0; q < 4; ++q) { const float hv = h[q]; const LAS f32x4* w = (const LAS f32x4*)(wr_l + (c + q) * NE); const f32x4 w0 = w[0], w1 = w[1];
                    lg[0] += hv * w0.x; lg[1] += hv * w0.y; lg[2] += hv * w0.z; lg[3] += hv * w0.w; lg[4] += hv * w1.x; lg[5] += hv * w1.y; lg[6] += hv * w1.z; lg[7] += hv * w1.w; } }
        }
        if (ROUTE) {
#pragma unroll
            for (int e = 0; e < NE; ++e) lg[e] = wave_sum(lg[e]);
            if (F.lane == 0) {
                int e1 = 0; float v1 = lg[0];
#pragma unroll
                for (int e = 1; e < NE; ++e) if (lg[e] > v1) { v1 = lg[e]; e1 = e; }
                int e2 = -1; float v2 = -3.0e38f;
#pragma unroll
                for (int e = 0; e < NE; ++e) if (e != e1 && lg[e] > v2) { v2 = lg[e]; e2 = e; }
                const float p2 = __expf(v2 - v1), w1 = 1.f / (1.f + p2), w2 = p2 * w1;
                unsigned* cnt = (unsigned*)(F.ws + WS_CTL) + CW_CNT;
                const unsigned r1 = atomicAdd(cnt + 64 * e1, 1u), r2 = atomicAdd(cnt + 64 * e2, 1u);
                int* toke = (int*)(F.ws + WS_TOKE); int* tokr = (int*)(F.ws + WS_TOKR); float* tokw = (float*)(F.ws + WS_TOKW); int* list = (int*)(F.ws + WS_LIST);
                toke[2 * row] = e1; toke[2 * row + 1] = e2; tokr[2 * row] = (int)r1; tokr[2 * row + 1] = (int)r2; tokw[2 * row] = w1; tokw[2 * row + 1] = w2;
                list[e1 * NL + r1] = row; list[e2 * NL + r2] = row;
            }
        }
    }
}

constexpr int TAILQ_ROWS = 8 * 256;
__device__ __forceinline__ int moe_tail_panels(const unsigned* cw, int G) { int ptot = 0, plast = 0;
#pragma unroll
    for (int e = 0; e < NE; ++e) { const int p_ = ((int)cw[64 * e] + 255) >> 8; ptot += p_; plast = p_; }
    const int left = (4 * ptot) % G; int t = (left + 3) >> 2; if (4 * ptot < G) t = 0; if (t > plast) t = plast; if (t > 8) t = 8; return t; }
__device__ __forceinline__ void final_phase(Frame& F) {
    const int gw = F.bx * NWAVES + F.wave, NGW = F.G * NWAVES;
    const unsigned* cnt = (const unsigned*)(F.ws + WS_CTL) + CW_CNT;
    int base[NE]; { int b = 0;
#pragma unroll
        for (int e = 0; e < NE; ++e) { base[e] = b; b += ((int)cnt[64 * e] + 255) & ~255; } }
    const int* toke = (const int*)(F.ws + WS_TOKE); const int* tokr = (const int*)(F.ws + WS_TOKR); const float* tokw = (const float*)(F.ws + WS_TOKW);
    const bf16_t* dout = (const bf16_t*)(F.ws + WS_DOUT); const bf16_t* tq = (const bf16_t*)(F.ws + WS_DOUT1);
    const int trim_ = moe_tail_panels(cnt, F.G), trow0 = trim_ > 0 ? base[NE - 1] + ((((int)cnt[64 * (NE - 1)] + 255) >> 8) - trim_) * 256 : 0x7fffffff;
    for (int row = gw; row < NL; row += NGW) {
        const int v = row < T ? 0 : 1;
        const float* ga2 = modp(F, 1, v) + 5 * D;
        const int e1 = toke[2 * row], e2 = toke[2 * row + 1];
        int b1 = 0, b2 = 0;
#pragma unroll
        for (int e = 0; e < NE; ++e) { if (e == e1) b1 = base[e]; if (e == e2) b2 = base[e]; }
        const bf16_t* d1 = dout + (size_t)(b1 + tokr[2 * row]) * D; const bf16_t* d2 = dout + (size_t)(b2 + tokr[2 * row + 1]) * D;
        const int r1_ = b1 + tokr[2 * row], r2_ = b2 + tokr[2 * row + 1];
        const bool t1 = r1_ >= trow0, t2 = r2_ >= trow0;
        const bf16_t* q1 = tq + (size_t)(t1 ? r1_ - trow0 : 0) * D; const bf16_t* q2 = tq + (size_t)(t2 ? r2_ - trow0 : 0) * D;
        const float w1 = tokw[2 * row], w2 = tokw[2 * row + 1];
        float* xr = F.out + (size_t)row * D;
        f32x4 x[4]; float s = 0.f;
#pragma unroll
        for (int j = 0; j < 4; ++j) { const int c = 256 * j + 4 * F.lane;
            const u32x2 a = *(const u32x2*)(d1 + c), b = *(const u32x2*)(d2 + c); const f32x4 g4 = *(const f32x4*)(ga2 + c);
            f32x4 ya = (f32x4){bflo(a.x), bfhi(a.x), bflo(a.y), bfhi(a.y)}, yb = (f32x4){bflo(b.x), bfhi(b.x), bflo(b.y), bfhi(b.y)};
            if (t1) {
#pragma unroll
                for (int k = 0; k < 3; ++k) { const u32x2 e_ = *(const u32x2*)(q1 + (size_t)k * TAILQ_ROWS * D + c); ya = ya + (f32x4){bflo(e_.x), bfhi(e_.x), bflo(e_.y), bfhi(e_.y)}; } }
            if (t2) {
#pragma unroll
                for (int k = 0; k < 3; ++k) { const u32x2 e_ = *(const u32x2*)(q2 + (size_t)k * TAILQ_ROWS * D + c); yb = yb + (f32x4){bflo(e_.x), bfhi(e_.x), bflo(e_.y), bfhi(e_.y)}; } }
            const f32x4 y = ya * w1 + yb * w2;
            { const u32x2 xb = *(const u32x2*)((const bf16_t*)(F.ws + WS_XB) + (size_t)row * D + c); x[j] = (f32x4){bflo(xb.x), bfhi(xb.x), bflo(xb.y), bfhi(xb.y)} + g4 * y; }
            s += (x[j].x * x[j].x + x[j].y * x[j].y) + (x[j].z * x[j].z + x[j].w * x[j].w); }
        const float r = 1.0f / sqrtf(wave_sum(s) * (1.f / D) + EPS);
#pragma unroll
        for (int j = 0; j < 4; ++j) { const int c = 256 * j + 4 * F.lane; *(f32x4*)(xr + c) = (x[j] * r) * *(const f32x4*)(F.in[20] + c); }
    }
}

struct GridSched { int nM, nN, G, c; unsigned abytes, bbytes;
    __device__ __forceinline__ bool next(int i, Unit& u) const { const int L = i * G + c; if (L >= nM * nN) return false; pg8::swz_map(L, nM, nN, u.pm, u.pn); u.aoff = (unsigned)u.pm * abytes; u.boff = (unsigned)u.pn * bbytes; u.kind = 0; u.x0 = 0; u.x1 = 0; u.kh = 0; return true; } };

struct CtxSched { int G, c, nN; unsigned abytes, bbytes; int ksplit; unsigned khbytes;
    __device__ __forceinline__ bool next(int i, Unit& u) const { int L = i * G + c; if (L >= 2 * nN * ksplit) return false; u.kh = L / (2 * nN); L -= u.kh * 2 * nN; u.pm = 64 + L / nN; u.pn = L % nN;
        u.aoff = (unsigned)u.pm * abytes + (unsigned)u.kh * khbytes; u.boff = (unsigned)u.pn * bbytes + (unsigned)u.kh * khbytes; u.kind = 0; u.x0 = u.pm * 256; u.x1 = 0; return true; } };

struct InprojSched { int G, c, l;
    __device__ __forceinline__ bool next(int i, Unit& u) const { const int L = i * G + c; const int nmain = 64 * 11;
        if (L < nmain) { pg8::swz_map(L, 64, 11, u.pm, u.pn); }
        else { const int r = L - nmain; if (l == 0) { if (r >= 22) return false; u.pm = 64 + r / 11; u.pn = r % 11; } else { if (r >= 2) return false; u.pm = 64 + r; u.pn = 2; } }
        u.aoff = (unsigned)u.pm * (256u * D * 2u); u.boff = (unsigned)u.pn * (256u * D * 2u); u.kind = 0; u.x0 = 0; u.x1 = 0; u.kh = 0; return true; } };

struct EpiInproj {
    static constexpr bool PERM = true; static constexpr int MIDK = 0;
    unsigned char* ws;
    __device__ __forceinline__ void operator()(const f32x4 (&acc)[2][2][4][2], const Unit& u, int wr, int wc, int fr, int fq) const {
        const int row0 = u.pm * 256 + wr * 64 + fr;
        const bool lat = u.pm < 64;
        const f32x2* rope = (const f32x2*)(ws + WS_ROPE);
#pragma unroll
        for (int ai = 0; ai < 2; ++ai)
#pragma unroll
            for (int m = 0; m < 4; ++m) {
                const int row = row0 + ai * 128 + m * 16;
                const int t = row & (T - 1), prow = t >> 6, pcol = t & 63;
#pragma unroll
                for (int bj = 0; bj < 2; ++bj) {
                    const int cl = u.pn * 256 + bj * 128 + wc * 32 + 8 * fq;
                    f32x4 v0 = acc[ai][bj][m][0], v1 = acc[ai][bj][m][1];
                    bf16_t* dst;
                    if (cl < 640) {
                        if (lat) { const int dh = cl & 63, i0 = (dh & 31) >> 1; const f32x2* rp = rope + ((dh < 32 ? prow : 128 + pcol) * 16 + i0);
                            const f32x2 c0 = rp[0], c1 = rp[1], c2 = rp[2], c3 = rp[3];
                            f32x4 w0, w1; w0.x = v0.x * c0.x - v0.y * c0.y; w0.y = v0.x * c0.y + v0.y * c0.x; w0.z = v0.z * c1.x - v0.w * c1.y; w0.w = v0.z * c1.y + v0.w * c1.x;
                            w1.x = v1.x * c2.x - v1.y * c2.y; w1.y = v1.x * c2.y + v1.y * c2.x; w1.z = v1.z * c3.x - v1.w * c3.y; w1.w = v1.z * c3.y + v1.w * c3.x; v0 = w0; v1 = w1; }
                        if (cl < 512) { v0 = v0 * QSCALE; v1 = v1 * QSCALE; dst = (bf16_t*)(ws + WS_Q) + (size_t)row * 512 + cl; }
                        else dst = (bf16_t*)(ws + WS_KB) + (size_t)row * 128 + (cl - 512);
                    } else if (cl < 768) { dst = (bf16_t*)(ws + WS_VB) + (size_t)row * 128 + (cl - 640); }
                    else {
                        const int oc = (u.pn - 3) * 128 + wc * 32 + 8 * fq;
                        if (bj == 0) { const f32x4 a0 = acc[ai][1][m][0], a1 = acc[ai][1][m][1];
#pragma unroll
                            for (int q = 0; q < 4; ++q) { v0[q] = sigmoidf_(v0[q]) * (1.0f + __builtin_amdgcn_exp2f(-a0[q] * LOG2E)); v1[q] = sigmoidf_(v1[q]) * (1.0f + __builtin_amdgcn_exp2f(-a1[q] * LOG2E)); }
                            dst = (bf16_t*)(ws + WS_GF) + (size_t)row * D + oc; }
                        else {
#pragma unroll
                            for (int q = 0; q < 4; ++q) { v0[q] = sigmoidf_(v0[q]); v1[q] = sigmoidf_(v1[q]); }
                            dst = (bf16_t*)(ws + WS_GA) + (size_t)row * D + oc; } }
                    u32x4 w; w.x = cvt_pk_bf16(v0[0], v0[1]); w.y = cvt_pk_bf16(v0[2], v0[3]); w.z = cvt_pk_bf16(v1[0], v1[1]); w.w = cvt_pk_bf16(v1[2], v1[3]);
                    *(u32x4*)dst = w;
                }
            }
    }
};

struct UpermSched { int G, c, l;
    __device__ __forceinline__ bool next(int i, Unit& u) const { const int L = i * G + c; const int nn = l == 0 ? 66 : 64; if (L >= 2 * nn) return false;
        u.pm = L & 1; u.pn = L >> 1; u.aoff = (unsigned)u.pm * (256u * D * 2u); u.boff = 0; u.kind = 0; u.x0 = 0; u.x1 = 0; u.kh = 0; return true; } };
struct UpermRows { static constexpr bool GA = false, GB = true;
    __device__ __forceinline__ unsigned arow(const Unit&, int) const { return 0u; }
    __device__ __forceinline__ unsigned brow(const Unit& u, int c) const { const int n = u.pn; int row;
        if (n < 64) { const int b = n >> 5, q = n & 31; row = b * T + 128 * (c & 63) + 4 * q + (c >> 6); } else row = NL + (n - 64) * 256 + c;
        return (unsigned)row * (D * 2u); } };
struct EpiUperm {
    static constexpr bool PERM = true; static constexpr int MIDK = 0;
    unsigned char* ws;
    __device__ __forceinline__ void operator()(const f32x4 (&acc)[2][2][4][2], const Unit& u, int wr, int wc, int fr, int fq) const {
        const int n = u.pn;
#pragma unroll
        for (int ai = 0; ai < 2; ++ai)
#pragma unroll
            for (int m = 0; m < 4; ++m) { const int r = u.pm * 256 + ai * 128 + wr * 64 + m * 16 + fr, j = r >> 1, ri = r & 1;
#pragma unroll
                for (int bj = 0; bj < 2; ++bj) { const int c = bj * 128 + wc * 32 + 8 * fq;
                    const f32x4 v0 = acc[ai][bj][m][0], v1 = acc[ai][bj][m][1];
                    u32x4 w; w.x = cvt_pk_bf16(v0[0], v0[1]); w.y = cvt_pk_bf16(v0[2], v0[3]); w.z = cvt_pk_bf16(v1[0], v1[1]); w.w = cvt_pk_bf16(v1[2], v1[3]);
                    bf16_t* dst;
                    if (n < 64) { const int b = n >> 5, q = n & 31, t2 = 4 * q + (c >> 6), t1 = c & 63; dst = (bf16_t*)(ws + WS_UP) + ((size_t)((j * 2 + b) * 128 + t2) * 128 + ri * 64 + t1); }
                    else { const int b = n - 64; dst = (bf16_t*)(ws + WS_VCT) + ((size_t)((b * 256 + j) * 2 + ri) * 256 + c); }
                    *(u32x4*)dst = w; } }
    }
};

struct StepASched { int G, c, l;
    __device__ __forceinline__ bool next(int i, Unit& u) const { int L = i * G + c;
        if (l == 0 && G == 256) { if (c >= 16 && c < 20) return false; if (c >= 20 && c < 24) { if (i > 1) return false; L = i == 0 ? c : c - 4; } else if (i > 0) return false; }
        if (L >= 256) return false; pg8::swz_map(L, 256, 1, u.pm, u.pn); u.aoff = (unsigned)u.pm * (256u * 128u * 2u); u.boff = 0u; u.kind = 0; u.x0 = 0; u.x1 = 0; u.kh = 0; return true; } };

struct EpiStepA {
    static constexpr bool PERM = true; static constexpr int MIDK = 0;
    unsigned char* ws;
    __device__ __forceinline__ void operator()(const f32x4 (&acc)[2][2][4][2], const Unit& u, int wr, int wc, int fr, int fq) const {
        const f32x2* tw = (const f32x2*)(ws + WS_TW); bf16_t* gp = (bf16_t*)(ws + WS_GP);
        const int j = u.pm;
#pragma unroll
        for (int ai = 0; ai < 2; ++ai)
#pragma unroll
            for (int m = 0; m < 4; ++m) { const int t2 = wr * 64 + m * 16 + fr, b = ai;
#pragma unroll
                for (int n = 0; n < 2; ++n) { const f32x4 v = acc[ai][0][m][n];
#pragma unroll
                    for (int p = 0; p < 2; ++p) { const int k1 = 16 * wc + 4 * fq + 2 * n + p; const f32x2 w = tw[t2 * 64 + k1];
                        const float gr = v[2 * p], gi = v[2 * p + 1];
                        const float orr = gr * w.x + gi * w.y, oi = gi * w.x - gr * w.y;
                        bf16_t* d = gp + ((size_t)((b * 64 + k1) * 256 + j) * 256 + t2);
                        d[0] = (bf16_t)f2bf(orr); d[128] = (bf16_t)f2bf(oi); } } }
    }
};
template <bool CTXV> struct EpiStepC {
    static constexpr bool PERM = true; static constexpr int MIDK = 0;
    unsigned char* ws;
    __device__ __forceinline__ void operator()(const f32x4 (&acc)[2][2][4][2], const Unit& u, int wr_, int wc_, int fr_, int fq_) const {
        int wr = wr_, wc = wc_, fr = fr_, fq = fq_, upm = u.pm, upn = u.pn;
        asm volatile("" : "+s"(wr), "+s"(wc), "+v"(fr), "+v"(fq), "+s"(upm), "+s"(upn));
        bf16_t* fo = (bf16_t*)(ws + WS_FO);
        const int NN = CTXV ? 256 : T;
        const int b = CTXV ? upm : (upm >> 6), k1 = CTXV ? 0 : (upm & 63), rowb = CTXV ? NL + b * 256 : b * T;
        const int own0 = wr * 128 + fr, mir0 = wr * 128 + 128 - fr;
        const int kk0 = (CTXV ? 128 * upn : 0) + 16 * wc + 4 * fq;
#pragma unroll
        for (int bj = 0; bj < 2; ++bj)
#pragma unroll
            for (int n = 0; n < 2; ++n)
#pragma unroll
                for (int p = 0; p < 2; ++p) {
                    const int kk = kk0 + 64 * bj + 2 * n + p;
                    const int k = CTXV ? kk : (k1 + 64 * kk), km = (NN - k) & (NN - 1);
                    const unsigned oo = (unsigned)(rowb + k) * KM, om = (unsigned)(rowb + km) * KM;
#pragma unroll
                    for (int ai = 0; ai < 2; ++ai)
#pragma unroll
                        for (int m = 0; m < 4; ++m) {
                            const f32x4 v = acc[ai][bj][m][n];
                            const bf16_t re = (bf16_t)f2bf(v[2 * p]);
                            if (m == 0 && fr == 0) { const int g = 2 * ai + wr; const bf16_t im = (bf16_t)f2bf(v[2 * p + 1]);
                                fo[oo + g * 128] = re; fo[om + 512 + 2 * g] = re; fo[oo + g * 128 + 64] = im; fo[om + 512 + 2 * g + 1] = im; }
                            else { fo[oo + own0 + ai * 256 + 16 * m] = re; fo[om + mir0 + ai * 256 - 16 * m] = re; }
                        }
                    asm volatile("" ::: "memory"); __builtin_amdgcn_sched_barrier(0);
                }
    }
};

struct EpiMerge {
    static constexpr bool PERM = true; static constexpr int MIDK = 10;
    unsigned char* ws;
    __device__ __forceinline__ void mid(f32x4 (&acc)[2][2][4][2], const Unit& u, int wr, int wc, int fr, int fq) const {
        asm volatile("" : "+v"(fr), "+v"(fq));
#pragma unroll
        for (int ai = 0; ai < 2; ++ai)
#pragma unroll
            for (int m = 0; m < 4; ++m) { const size_t row = (size_t)(u.pm * 256 + ai * 128 + wr * 64 + m * 16 + fr);
#pragma unroll
                for (int bj = 0; bj < 2; ++bj) { const int col = u.pn * 256 + bj * 128 + wc * 32 + 8 * fq;
                    const u32x4 gr = *(const u32x4*)((const bf16_t*)(ws + WS_GF) + row * D + col);
                    const f32x4 r0 = (f32x4){bflo(gr.x), bfhi(gr.x), bflo(gr.y), bfhi(gr.y)}, r1 = (f32x4){bflo(gr.z), bfhi(gr.z), bflo(gr.w), bfhi(gr.w)};
                    acc[ai][bj][m][0] = acc[ai][bj][m][0] * r0; acc[ai][bj][m][1] = acc[ai][bj][m][1] * r1; } }
    }
    __device__ __forceinline__ void operator()(const f32x4 (&acc)[2][2][4][2], const Unit& u, int wr, int wc, int fr, int fq) const {
#pragma unroll
        for (int ai = 0; ai < 2; ++ai)
#pragma unroll
            for (int m = 0; m < 4; ++m) { const size_t row = (size_t)(u.pm * 256 + ai * 128 + wr * 64 + m * 16 + fr);
#pragma unroll
                for (int bj = 0; bj < 2; ++bj) { const int col = u.pn * 256 + bj * 128 + wc * 32 + 8 * fq;
                    const u32x4 ga = *(const u32x4*)((const bf16_t*)(ws + WS_GA) + row * D + col);
                    const f32x4 a0 = acc[ai][bj][m][0], a1 = acc[ai][bj][m][1];
                    u32x4 w;
                    w.x = cvt_pk_bf16(bflo(ga.x) * a0[0], bfhi(ga.x) * a0[1]); w.y = cvt_pk_bf16(bflo(ga.y) * a0[2], bfhi(ga.y) * a0[3]);
                    w.z = cvt_pk_bf16(bflo(ga.z) * a1[0], bfhi(ga.z) * a1[1]); w.w = cvt_pk_bf16(bflo(ga.w) * a1[2], bfhi(ga.w) * a1[3]);
                    *(u32x4*)((bf16_t*)(ws + WS_Y) + row * D + col) = w; } }
    }
};

struct EpiResid {
    static constexpr bool PERM = true; static constexpr int MIDK = 0;
    const float* xl_in32; const bf16_t* xl_inb; bf16_t* xl_out; const float* xc_in; float* xc_out; const float* mod_l; int chunk; float* tmpc;
    __device__ __forceinline__ void operator()(const f32x4 (&acc)[2][2][4][2], const Unit& u, int wr, int wc, int fr, int fq) const {
        const int v = u.pm < 32 ? 0 : (u.pm < 64 ? 1 : 2);
        const float* gate = mod_l + v * MODSZ + chunk * D;
        const bool lat = u.pm < 64; const int rbase = lat ? u.pm * 256 : (u.pm - 64) * 256;
#pragma unroll
        for (int bj = 0; bj < 2; ++bj) { const int col = u.pn * 256 + bj * 128 + wc * 32 + 8 * fq;
            const f32x4 g0 = *(const f32x4*)(gate + col), g1 = *(const f32x4*)(gate + col + 4);
#pragma unroll
            for (int ai = 0; ai < 2; ++ai)
#pragma unroll
                for (int m = 0; m < 4; ++m) { const size_t o = (size_t)(rbase + ai * 128 + wr * 64 + m * 16 + fr) * D + col;
                    if (lat) {
                        f32x4 x0, x1;
                        if (xl_in32) { x0 = *(const f32x4*)(xl_in32 + o); x1 = *(const f32x4*)(xl_in32 + o + 4); }
                        else { const u32x4 xb = *(const u32x4*)(xl_inb + o); x0 = (f32x4){bflo(xb.x), bfhi(xb.x), bflo(xb.y), bfhi(xb.y)}; x1 = (f32x4){bflo(xb.z), bfhi(xb.z), bflo(xb.w), bfhi(xb.w)}; }
                        x0 = x0 + g0 * acc[ai][bj][m][0]; x1 = x1 + g1 * acc[ai][bj][m][1];
                        u32x4 w; w.x = cvt_pk_bf16(x0[0], x0[1]); w.y = cvt_pk_bf16(x0[2], x0[3]); w.z = cvt_pk_bf16(x1[0], x1[1]); w.w = cvt_pk_bf16(x1[2], x1[3]);
                        *(u32x4*)(xl_out + o) = w;
                    } else if (u.kh) { *(f32x4*)(tmpc + o) = g0 * acc[ai][bj][m][0]; *(f32x4*)(tmpc + o + 4) = g1 * acc[ai][bj][m][1]; }
                    else { *(f32x4*)(xc_out + o) = *(const f32x4*)(xc_in + o) + g0 * acc[ai][bj][m][0];
                           *(f32x4*)(xc_out + o + 4) = *(const f32x4*)(xc_in + o + 4) + g1 * acc[ai][bj][m][1]; } } }
    }
};

struct EpiSwiglu {
    static constexpr bool PERM = true; static constexpr int MIDK = 0;
    bf16_t* act; int ld;
    __device__ __forceinline__ void operator()(const f32x4 (&acc)[2][2][4][2], const Unit& u, int wr, int wc, int fr, int fq) const {
        const int col = u.pn * 128 + wc * 32 + 8 * fq;
#pragma unroll
        for (int ai = 0; ai < 2; ++ai)
#pragma unroll
            for (int m = 0; m < 4; ++m) { const size_t row = (size_t)(u.x0 + ai * 128 + wr * 64 + m * 16 + fr);
                float o[8];
#pragma unroll
                for (int n = 0; n < 2; ++n)
#pragma unroll
                    for (int q = 0; q < 4; ++q) { const float gv = acc[ai][0][m][n][q], uv = acc[ai][1][m][n][q]; o[4 * n + q] = gv * sigmoidf_(gv) * uv; }
                u32x4 w; w.x = cvt_pk_bf16(o[0], o[1]); w.y = cvt_pk_bf16(o[2], o[3]); w.z = cvt_pk_bf16(o[4], o[5]); w.w = cvt_pk_bf16(o[6], o[7]);
                *(u32x4*)(act + row * ld + col) = w; }
    }
};
struct EpiBf16 {
    static constexpr bool PERM = true; static constexpr int MIDK = 0;
    bf16_t* O0; bf16_t* O1; int ld;
    __device__ __forceinline__ void operator()(const f32x4 (&acc)[2][2][4][2], const Unit& u, int wr, int wc, int fr, int fq) const {
#pragma unroll
        for (int ai = 0; ai < 2; ++ai)
#pragma unroll
            for (int m = 0; m < 4; ++m) { const size_t row = (size_t)(u.x0 + ai * 128 + wr * 64 + m * 16 + fr);
#pragma unroll
                for (int bj = 0; bj < 2; ++bj) { const int col = u.pn * 256 + bj * 128 + wc * 32 + 8 * fq; const f32x4 v0 = acc[ai][bj][m][0], v1 = acc[ai][bj][m][1];
                    u32x4 w; w.x = cvt_pk_bf16(v0[0], v0[1]); w.y = cvt_pk_bf16(v0[2], v0[3]); w.z = cvt_pk_bf16(v1[0], v1[1]); w.w = cvt_pk_bf16(v1[2], v1[3]);
                    *(u32x4*)((u.kh ? O1 : O0) + row * ld + col) = w; } }
    }
};

struct RowSched { int nM, nN, G, c; unsigned abytes, bbytes;
    __device__ __forceinline__ bool next(int i, Unit& u) const { const int L = i * G + c; if (L >= nM * nN) return false; pg8::swz_map(L, nM, nN, u.pm, u.pn); u.aoff = (unsigned)u.pm * abytes; u.boff = (unsigned)u.pn * bbytes; u.kind = 0; u.x0 = u.pm * 256; u.x1 = 0; u.kh = 0; return true; } };

struct MoeSched { int G, c, nN, ksplit, trim; unsigned bexp, bbytes, arow_bytes, khbytes; bool a_slots; int cnt[NE], base[NE];
    __device__ __forceinline__ void init(const unsigned* cw) { int b = 0;
#pragma unroll
        for (int e = 0; e < NE; ++e) { cnt[e] = (int)cw[64 * e]; base[e] = b; b += (cnt[e] + 255) & ~255; } }
    __device__ __forceinline__ bool next(int i, Unit& u) const { int L = i * G + c; int e = 0;
        for (; e < NE; ++e) { const int nu = (((cnt[e] + 255) >> 8) - (e == NE - 1 ? trim : 0)) * nN * ksplit; if (L < nu) break; L -= nu; }
        if (e >= NE) return false;
        int cn = 0, bs = 0;
#pragma unroll
        for (int q = 0; q < NE; ++q) if (q == e) { cn = cnt[q]; bs = base[q]; }
        const int np_ = ((cn + 255) >> 8) - (e == NE - 1 ? trim : 0); const int nt_ = np_ * nN; u.kh = L / nt_; L -= u.kh * nt_;
        pg8::swz_map(L, np_, nN, u.pm, u.pn);
        u.kind = e; u.x1 = cn; u.x0 = bs + u.pm * 256;
        u.aoff = (a_slots ? (unsigned)u.x0 * arow_bytes : 0u) + (unsigned)u.kh * khbytes; u.boff = (unsigned)e * bexp + (unsigned)u.pn * bbytes + (unsigned)u.kh * khbytes; return true; } };
struct MoeTailSched { int G, c, trim, plast, rbase; unsigned bexp;
    __device__ __forceinline__ bool next(int i, Unit& u) const { int L = i * G + c; if (L >= 16 * trim) return false; u.kh = L / (4 * trim); L -= u.kh * 4 * trim;
        u.pm = plast - trim + (L >> 2); u.pn = L & 3; u.kind = NE - 1; u.x1 = 0; u.x0 = rbase + u.pm * 256;
        u.aoff = (unsigned)u.x0 * (DFFE * 2u) + (unsigned)u.kh * (DFFE / 4 * 2u); u.boff = (unsigned)(NE - 1) * bexp + (unsigned)u.pn * (256u * DFFE * 2u) + (unsigned)u.kh * (DFFE / 4 * 2u); return true; } };
struct EpiTail {
    static constexpr bool PERM = true; static constexpr int MIDK = 0;
    bf16_t* O0; bf16_t* Q; int row0;
    __device__ __forceinline__ void operator()(const f32x4 (&acc)[2][2][4][2], const Unit& u, int wr, int wc, int fr, int fq) const {
#pragma unroll
        for (int ai = 0; ai < 2; ++ai)
#pragma unroll
            for (int m = 0; m < 4; ++m) { const int row = u.x0 + ai * 128 + wr * 64 + m * 16 + fr;
                bf16_t* dst = u.kh == 0 ? O0 + (size_t)row * D : Q + ((size_t)(u.kh - 1) * TAILQ_ROWS + (size_t)(row - row0)) * D;
#pragma unroll
                for (int bj = 0; bj < 2; ++bj) { const int col = u.pn * 256 + bj * 128 + wc * 32 + 8 * fq; const f32x4 v0 = acc[ai][bj][m][0], v1 = acc[ai][bj][m][1];
                    u32x4 w; w.x = cvt_pk_bf16(v0[0], v0[1]); w.y = cvt_pk_bf16(v0[2], v0[3]); w.z = cvt_pk_bf16(v1[0], v1[1]); w.w = cvt_pk_bf16(v1[2], v1[3]);
                    *(u32x4*)(dst + col) = w; } }
    }
};
struct MoeRows { static constexpr bool GA = true, GB = false; const int* list;
    __device__ __forceinline__ unsigned arow(const Unit& u, int r) const { int idx = u.pm * 256 + r; idx = idx < u.x1 ? idx : u.x1 - 1; return (unsigned)list[u.kind * NL + idx] * (D * 2u); }
    __device__ __forceinline__ unsigned brow(const Unit&, int) const { return 0u; } };


constexpr int CW_QUEUE = 12288, CW_RDY = 65536;
template <int NG, bool MOE> struct FfnStream {
    int P[NG], rb[NG], cn[NG];
    int f, nNgu, Kdn; unsigned need;
    unsigned* q; volatile LAS unsigned* lw; unsigned* rdy; unsigned* tmo;
    __device__ __forceinline__ void finish_init(int G) { int sacc = 0; f = NG;
#pragma unroll
        for (int g = NG - 1; g >= 0; --g) { if (f == g + 1 && sacc + P[g] * 4 <= G) { sacc += P[g] * 4; f = g; } }
        if (f > NG - 1) f = NG - 1; }
    __device__ __forceinline__ bool decode(int L, SUnit& u) const {
        int pos = L, kind = -1, grp = 0, j = 0;
#pragma unroll
        for (int g = 0; g < NG; ++g) {
            { const int n = P[g] * nNgu; if (kind < 0) { if (pos < n) { kind = 0; grp = g; j = pos; } else pos -= n; } }
            if (g >= 1 && (g - 1) < f) { const int n = P[g - 1] * 4; if (kind < 0) { if (pos < n) { kind = 1; grp = g - 1; j = pos; } else pos -= n; } }
        }
#pragma unroll
        for (int g = 0; g < NG; ++g) if (g >= f) { const int n = P[g] * 4; if (kind < 0) { if (pos < n) { kind = 1; grp = g; j = pos; } else pos -= n; } }
        if (kind < 0) return false;
        int nM = 0, rbase = 0, cnt = 0;
#pragma unroll
        for (int g = 0; g < NG; ++g) if (g == grp) { nM = P[g]; rbase = rb[g]; cnt = cn[g]; }
        const int nN = kind == 0 ? nNgu : 4;
        const int nig = 8 * nN, gid = j / nig, fm = gid * 8, gsz = (nM - fm) < 8 ? (nM - fm) : 8;
        u.pm = fm + ((j % nig) % gsz); u.pn = (j % nig) / gsz; u.kind = kind; u.grp = grp; u.x0 = rbase + u.pm * 256; u.x1 = cnt;
        const int gp = u.x0 >> 8;
        if (kind == 0) { u.K = D; u.dep = -1; u.sig = gp;
            u.aoff = (unsigned)WS_H + (unsigned)u.x0 * (D * 2u);
            u.boff = (MOE ? (unsigned)WS_WGUE + (unsigned)grp * (2u * DFFE * D * 2u) : (unsigned)WS_WGUD) + (unsigned)u.pn * (256u * D * 2u); }
        else { u.K = Kdn; u.dep = gp; u.sig = -1;
            u.aoff = (unsigned)WS_ACT + (unsigned)u.x0 * ((unsigned)Kdn * 2u);
            u.boff = (MOE ? (unsigned)WS_WDE + (unsigned)grp * ((unsigned)D * DFFE * 2u) : (unsigned)WS_WDD) + (unsigned)u.pn * (256u * (unsigned)Kdn * 2u); }
        return true;
    }
    __device__ __forceinline__ void a_ready(const SUnit& u) const {
        if (threadIdx.x < 64) {
            const unsigned long long t0 = __builtin_amdgcn_s_memrealtime(); unsigned polls = 0;
            while ((unsigned)__builtin_amdgcn_readfirstlane(__hip_atomic_load(rdy + 64 * u.dep, __ATOMIC_RELAXED, __HIP_MEMORY_SCOPE_AGENT)) < need) {
                if ((++polls & 255u) == 0u && __builtin_amdgcn_readfirstlane(__hip_atomic_load(tmo, __ATOMIC_RELAXED, __HIP_MEMORY_SCOPE_AGENT)) != 0u) break;
                if (__builtin_amdgcn_s_memrealtime() - t0 > 2000000ull) { if (threadIdx.x == 0) __hip_atomic_store(tmo, 1u, __ATOMIC_RELAXED, __HIP_MEMORY_SCOPE_AGENT); break; }
                __builtin_amdgcn_s_sleep(2); }
            __builtin_amdgcn_fence(__ATOMIC_ACQUIRE, "agent");
            asm volatile("s_waitcnt vmcnt(0)" ::: "memory");
        }
        asm volatile("" ::: "memory"); __builtin_amdgcn_s_barrier(); asm volatile("" ::: "memory");
    }
};
template <bool MOE> struct FfnRows { const int* list;
    __device__ __forceinline__ bool a_gather(const SUnit& u) const { return MOE && u.kind == 0; }
    __device__ __forceinline__ unsigned arow(const SUnit& u, int r) const { int idx = u.pm * 256 + r; idx = idx < u.x1 ? idx : u.x1 - 1; return (unsigned)WS_H + (unsigned)list[u.grp * NL + idx] * (D * 2u); } };

template <bool MOE> struct EpiFfn {
    static constexpr bool PERM = true; static constexpr int MIDK = 0;
    unsigned char* ws; float* xl; const float* mod_l;
    __device__ __forceinline__ void operator()(const f32x4 (&acc)[2][2][4][2], const SUnit& u, int wr, int wc, int fr, int fq) const {
        if (u.kind == 0) {
            constexpr int ld = MOE ? DFFE : DFF0;
            bf16_t* act = (bf16_t*)(ws + WS_ACT);
            const int col = u.pn * 128 + wc * 32 + 8 * fq;
#pragma unroll
            for (int ai = 0; ai < 2; ++ai)
#pragma unroll
                for (int m = 0; m < 4; ++m) { const size_t row = (size_t)(u.x0 + ai * 128 + wr * 64 + m * 16 + fr);
                    float o[8];
#pragma unroll
                    for (int n = 0; n < 2; ++n)
#pragma unroll
                        for (int q = 0; q < 4; ++q) { const float gv = acc[ai][0][m][n][q], uv = acc[ai][1][m][n][q]; o[4 * n + q] = gv * sigmoidf_(gv) * uv; }
                    u32x4 w; w.x = cvt_pk_bf16(o[0], o[1]); w.y = cvt_pk_bf16(o[2], o[3]); w.z = cvt_pk_bf16(o[4], o[5]); w.w = cvt_pk_bf16(o[6], o[7]);
                    pg8::st16_wt(ws, (unsigned)WS_ACT + ((unsigned)row * (unsigned)ld + (unsigned)col) * 2u, w); }
        } else if (MOE) {
            bf16_t* O = (bf16_t*)(ws + WS_DOUT);
#pragma unroll
            for (int ai = 0; ai < 2; ++ai)
#pragma unroll
                for (int m = 0; m < 4; ++m) { const size_t row = (size_t)(u.x0 + ai * 128 + wr * 64 + m * 16 + fr);
#pragma unroll
                    for (int bj = 0; bj < 2; ++bj) { const int col = u.pn * 256 + bj * 128 + wc * 32 + 8 * fq; const f32x4 v0 = acc[ai][bj][m][0], v1 = acc[ai][bj][m][1];
                        u32x4 w; w.x = cvt_pk_bf16(v0[0], v0[1]); w.y = cvt_pk_bf16(v0[2], v0[3]); w.z = cvt_pk_bf16(v1[0], v1[1]); w.w = cvt_pk_bf16(v1[2], v1[3]);
                        *(u32x4*)(O + row * D + col) = w; } }
        } else {
            asm volatile("" : "+v"(fr), "+v"(fq));
            const int pmg = u.x0 >> 8;
            const int v = pmg < 32 ? 0 : (pmg < 64 ? 1 : 2);
            const float* gate = mod_l + v * MODSZ + 5 * D;
            float* xo = pmg < 64 ? xl + (size_t)u.x0 * D : (float*)(ws + WS_XC) + (size_t)(u.x0 - NL) * D;
#pragma unroll
            for (int bj = 0; bj < 2; ++bj) { const int col = u.pn * 256 + bj * 128 + wc * 32 + 8 * fq;
                const f32x4 g0 = *(const f32x4*)(gate + col), g1 = *(const f32x4*)(gate + col + 4);
#pragma unroll
                for (int ai = 0; ai < 2; ++ai)
#pragma unroll
                    for (int m = 0; m < 4; ++m) { const size_t o = (size_t)(ai * 128 + wr * 64 + m * 16 + fr) * D + col;
                        *(f32x4*)(xo + o) = *(const f32x4*)(xo + o) + g0 * acc[ai][bj][m][0];
                        *(f32x4*)(xo + o + 4) = *(const f32x4*)(xo + o + 4) + g1 * acc[ai][bj][m][1];
                        asm volatile("" ::: "memory"); __builtin_amdgcn_sched_barrier(0); } }
        }
    }
};

__device__ __forceinline__ int crow(int r, int hi) { return (r & 3) + 8 * (r >> 2) + 4 * hi; }
__device__ __forceinline__ s16x4 vtr(const LAS unsigned char* p) { typedef short v4i16_t __attribute__((ext_vector_type(4))); return __builtin_bit_cast(s16x4, __builtin_amdgcn_ds_read_tr16_b64_v4i16((LAS v4i16_t*)p)); }

__device__ __forceinline__ void attn_unit(Frame& F, int l, int b, int hkv, int qb, bool ctxq) {
    const int tid = F.tid, lane = F.lane, wid = F.wave, r32 = lane & 31, hi = lane >> 5;
    const int g = wid >> 1, qs = wid & 1, head = hkv * 4 + g;
    const bf16_t* Q = (const bf16_t*)(F.ws + WS_Q); const bf16_t* KB = (const bf16_t*)(F.ws + WS_KB); const bf16_t* VB = (const bf16_t*)(F.ws + WS_VB);
    const int q0 = qb * 64;
    const int qrow = (ctxq ? NL + b * CTXL : b * T) + q0 + qs * 32 + r32;
    bf16x8 qr[4];
#pragma unroll
    for (int d0 = 0; d0 < 4; ++d0) qr[d0] = *(const bf16x8*)(Q + (size_t)qrow * 512 + head * 64 + d0 * 16 + hi * 8);
    int jlo = 0, jhi = -1;
    if (!ctxq) { jlo = -2; jhi = 2; if (q0 + 64 * jlo < 0) jlo = -(q0 / 64); if (q0 + 64 * jhi >= T) jhi = (T - 64 - q0) / 64; }
    const int nloc = jhi - jlo + 1, ntile = nloc + 4;
    const float sinkv = F.in[9][l * 8 + head] * LOG2E;
    float mrun = sinkv, lrun = 1.0f;
    f32x16 o[2]; o[0] = f32x16{}; o[1] = f32x16{};
    const int kkey = lane, vkey = 16 * (wid & 3) + (lane >> 2);
    auto tile_row = [&](int ti) -> int { return ti < nloc ? b * T + q0 + 64 * (jlo + ti) : NL + b * CTXL + 64 * (ti - nloc); };
    u32x4 kreg, vreg;
    { const int r0 = tile_row(0); kreg = *(const u32x4*)(KB + (size_t)(r0 + kkey) * 128 + hkv * 64 + wid * 8); vreg = *(const u32x4*)(VB + (size_t)(r0 + vkey) * 128 + hkv * 64 + (wid >> 2) * 32 + (lane & 3) * 8); }
    for (int ti = 0; ti < ntile; ++ti) {
        LAS unsigned char* slot = F.lds + (ti & 1) * 16384;
        *(LAS u32x4*)(slot + wid * 1024 + lane * 16) = kreg;
        *(LAS u32x4*)(slot + 8192 + wid * 1024 + lane * 16) = vreg;
        __syncthreads();
        if (ti + 1 < ntile) { const int r0 = tile_row(ti + 1); kreg = *(const u32x4*)(KB + (size_t)(r0 + kkey) * 128 + hkv * 64 + wid * 8); vreg = *(const u32x4*)(VB + (size_t)(r0 + vkey) * 128 + hkv * 64 + (wid >> 2) * 32 + (lane & 3) * 8); }
        f32x16 p0 = f32x16{}, p1 = f32x16{};
        { const LAS unsigned char* kb = slot + hi * 1024 + r32 * 16;
#pragma unroll
          for (int d0 = 0; d0 < 4; ++d0) { const bf16x8 k0 = *(const LAS bf16x8*)(kb + d0 * 2048), k1 = *(const LAS bf16x8*)(kb + d0 * 2048 + 512);
              p0 = __builtin_amdgcn_mfma_f32_32x32x16_bf16(k0, qr[d0], p0, 0, 0, 0); p1 = __builtin_amdgcn_mfma_f32_32x32x16_bf16(k1, qr[d0], p1, 0, 0, 0); } }
        if (ti < nloc) { const int j = jlo + ti; const int qq = qs * 32 + r32;
            if (j == -2) {
#pragma unroll
                for (int r = 0; r < 16; ++r) { const int kk = crow(r, hi); if (kk < qq) p0[r] = -INFINITY; if (kk + 32 < qq) p1[r] = -INFINITY; } }
            else if (j == 2) {
#pragma unroll
                for (int r = 0; r < 16; ++r) { const int kk = crow(r, hi); if (kk > qq) p0[r] = -INFINITY; if (kk + 32 > qq) p1[r] = -INFINITY; } } }
        float mx = p0[0];
#pragma unroll
        for (int r = 1; r < 16; ++r) mx = fmaxf(mx, p0[r]);
#pragma unroll
        for (int r = 0; r < 16; ++r) mx = fmaxf(mx, p1[r]);
        mx = fmaxf(mx, __shfl_xor(mx, 32));
        const float mnew = fmaxf(mrun, mx), fsc = __builtin_amdgcn_exp2f(mrun - mnew);
        mrun = mnew;
        float rs = 0.f;
#pragma unroll
        for (int r = 0; r < 16; ++r) { p0[r] = __builtin_amdgcn_exp2f(p0[r] - mnew); p1[r] = __builtin_amdgcn_exp2f(p1[r] - mnew); rs += p0[r] + p1[r]; }
        rs += __shfl_xor(rs, 32);
        lrun = lrun * fsc + rs;
#pragma unroll
        for (int r = 0; r < 16; ++r) { o[0][r] *= fsc; o[1][r] *= fsc; }
        u32x4 pw[4];
        pw[0] = (u32x4){cvt_pk_bf16(p0[0], p0[1]), cvt_pk_bf16(p0[2], p0[3]), cvt_pk_bf16(p0[4], p0[5]), cvt_pk_bf16(p0[6], p0[7])};
        pw[1] = (u32x4){cvt_pk_bf16(p0[8], p0[9]), cvt_pk_bf16(p0[10], p0[11]), cvt_pk_bf16(p0[12], p0[13]), cvt_pk_bf16(p0[14], p0[15])};
        pw[2] = (u32x4){cvt_pk_bf16(p1[0], p1[1]), cvt_pk_bf16(p1[2], p1[3]), cvt_pk_bf16(p1[4], p1[5]), cvt_pk_bf16(p1[6], p1[7])};
        pw[3] = (u32x4){cvt_pk_bf16(p1[8], p1[9]), cvt_pk_bf16(p1[10], p1[11]), cvt_pk_bf16(p1[12], p1[13]), cvt_pk_bf16(p1[14], p1[15])};
        { const LAS unsigned char* vb = slot + 8192 + ((lane >> 4) & 1) * 32 + (lane & 3) * 8 + (4 * hi + ((lane & 15) >> 2)) * 64;
#pragma unroll
          for (int d0 = 0; d0 < 2; ++d0)
#pragma unroll
              for (int ks = 0; ks < 4; ++ks) { const s16x4 lo = vtr(vb + d0 * 4096 + ks * 1024), hh = vtr(vb + d0 * 4096 + ks * 1024 + 512);
                  const bf16x8 vf = (bf16x8){lo[0], lo[1], lo[2], lo[3], hh[0], hh[1], hh[2], hh[3]};
                  o[d0] = __builtin_amdgcn_mfma_f32_32x32x16_bf16(vf, __builtin_bit_cast(bf16x8, pw[ks]), o[d0], 0, 0, 0); } }
    }
    const float rl = 1.0f / lrun;
    bf16_t* orow = (bf16_t*)(F.ws + WS_FO) + (size_t)qrow * KM + 640 + head * 64;
#pragma unroll
    for (int d0 = 0; d0 < 2; ++d0)
#pragma unroll
        for (int rq = 0; rq < 4; ++rq) { u32x2 w; w.x = cvt_pk_bf16(o[d0][4 * rq] * rl, o[d0][4 * rq + 1] * rl); w.y = cvt_pk_bf16(o[d0][4 * rq + 2] * rl, o[d0][4 * rq + 3] * rl);
            *(u32x2*)(orow + 32 * d0 + 8 * rq + 4 * hi) = w; }
    __syncthreads();
}

__device__ __forceinline__ void attn_phase(Frame& F, int l, int part) {
    const int nlat = NB * 2 * 128;
    auto lat_unit = [&](int it) { const int qb = it & 127, hkv = (it >> 7) & 1, b = it >> 8; attn_unit(F, l, b, hkv, qb, false); };
    if (part == 0) {
        const bool extra = (l == 0) && F.G == 256 && ((F.bx >= 16 && F.bx < 24) || F.bx >= 240);
        if (!extra) for (int it = F.bx; it < 256; it += F.G) lat_unit(it);
        if (l == 0) for (int r = (F.bx + F.G - 240) % F.G; r < NB * 2 * 4; r += F.G) { const int qb = r & 3, hkv = (r >> 2) & 1, b = r >> 3; attn_unit(F, l, b, hkv, qb, true); }
    } else {
        const bool busy = (l == 0) && F.bx >= 128 && F.bx < 136;
        if (!busy) for (int it = 256 + F.bx; it < nlat; it += F.G) lat_unit(it);
        if (l == 0 && F.bx >= 136 && F.bx < 144) lat_unit(256 + F.bx - 8);
        if (l == 0 && F.G == 256 && F.bx >= 144 && F.bx < 168) { const int k = F.bx - 144; lat_unit(k < 8 ? 16 + k : 240 + (k - 8)); }
    }
}

#if !MK_MULTI
#define GRID_BAR() xcd_barrier(bar)
#else
#define GRID_BAR() do {} while (0)
#endif
#ifndef PH_MASK
#define PH_MASK 0xFFFFFu
#endif
#define IN(k) (((PH_MASK >> (k)) & 1u) && lo <= (k) && (k) < hi)
#define SEAM(k) do { if (IN((k) + 1)) GRID_BAR(); } while (0)
#ifndef REP_MASK
#define REP_MASK 0u
#endif
#define REPS(k) ((((REP_MASK) >> (k)) & 1u) ? 2 : 1)
template <int l, class BarT>
__device__ __forceinline__ void layer_phases(Frame& F, unsigned* ctl, const int lo, const int hi, const BarT& bar) {
        const int pb = 1 + 8 * l;
        bf16_t* H = (bf16_t*)(F.ws + WS_H);
        const float* xl_in = l == 0 ? F.in[0] : nullptr;
        bf16_t* XB = (bf16_t*)(F.ws + WS_XB);
        const float* xc_in = l == 0 ? F.in[2] : (const float*)(F.ws + WS_XC);
        float* xc = (float*)(F.ws + WS_XC);
        const float* mod_l = (const float*)ctl + CW_MOD + l * 3 * MODSZ;
        if (IN(pb + 0)) { for (int rep = 0; rep < REPS(pb + 0); ++rep) norm_phase<false>(F, l, 0, xl_in, xc_in, NTOK, l == 1 ? (const float*)(F.ws + WS_TMPC2) : nullptr, nullptr); SEAM(pb + 0); }
        if (IN(pb + 1)) {
            for (int rep = 0; rep < REPS(pb + 1); ++rep) {
            { pg8::Gemm g{H, (const bf16_t*)(F.ws + (l ? WS_WIN1 : WS_WIN0)) + (size_t)512 * D, D, D}; InprojSched S{F.G, F.bx, l}; EpiInproj E{F.ws}; pg8::NoGather R;
              pg8::gemm_phase(F.lds, g, S, E, R); }
            { pg8::Gemm g{(const bf16_t*)(F.ws + (l ? WS_WIN1 : WS_WIN0)), H, D, D}; UpermSched S{F.G, F.bx, l}; EpiUperm E{F.ws}; UpermRows R;
              pg8::gemm_phase(F.lds, g, S, E, R); }
            }
            SEAM(pb + 1);
        }
        if (IN(pb + 2)) {
            for (int rep = 0; rep < REPS(pb + 2); ++rep) {
            attn_phase(F, l, 0);
            { pg8::Gemm g{(const bf16_t*)(F.ws + WS_UP), (const bf16_t*)(F.ws + WS_FA64), 128, 128}; StepASched S{F.G, F.bx, l}; EpiStepA E{F.ws}; pg8::NoGather R;
              pg8::gemm_phase(F.lds, g, S, E, R); }
            if (l == 0) { pg8::Gemm g{(const bf16_t*)(F.ws + WS_VCT), (const bf16_t*)(F.ws + WS_TX), 512, 512}; GridSched S{2, 2, F.G, (F.bx + F.G - 16) % F.G, 256u * 512u * 2u, 256u * 512u * 2u}; EpiStepC<true> E{F.ws}; pg8::NoGather R;
              pg8::gemm_phase(F.lds, g, S, E, R); }
            }
            SEAM(pb + 2);
        }
        if (IN(pb + 3)) {
            for (int rep = 0; rep < REPS(pb + 3); ++rep) {
            { pg8::Gemm g{(const bf16_t*)(F.ws + WS_GP), (const bf16_t*)(F.ws + WS_TC), 256, 256}; GridSched S{128, 1, F.G, F.bx, 256u * 256u * 2u, 0u}; EpiStepC<false> E{F.ws}; pg8::NoGather R;
              pg8::gemm_phase(F.lds, g, S, E, R); }
            if (l == 0) { pg8::Gemm g{(const bf16_t*)(F.ws + WS_FO), (const bf16_t*)(F.ws + WS_WM0), KM, KM}; CtxSched S{F.G, (F.bx + F.G - 128) % F.G, 4, 256u * KM * 2u, 256u * KM * 2u, 1, 0u}; EpiMerge E{F.ws}; pg8::NoGather R;
              pg8::gemm_phase(F.lds, g, S, E, R); }
            attn_phase(F, l, 1);
            }
            SEAM(pb + 3);
        }
        if (IN(pb + 4)) {
            const int nM = 64;
            pg8::Gemm g{(const bf16_t*)(F.ws + WS_FO), (const bf16_t*)(F.ws + (l ? WS_WM1 : WS_WM0)), KM, KM}; GridSched S{nM, 4, F.G, F.bx, 256u * KM * 2u, 256u * KM * 2u}; EpiMerge E{F.ws}; pg8::NoGather R;
            for (int rep = 0; rep < REPS(pb + 4); ++rep) pg8::gemm_phase(F.lds, g, S, E, R);
            SEAM(pb + 4);
        }
        if (IN(pb + 5)) {
            EpiResid E{xl_in, XB, XB, xc_in, xc, mod_l, 2, (float*)(F.ws + WS_TMPC1)}; pg8::NoGather R;
            { pg8::Gemm g{(const bf16_t*)(F.ws + WS_Y), (const bf16_t*)(F.ws + (l ? WS_WO1 : WS_WO0)), D, D}; GridSched S{64, 4, F.G, F.bx, 256u * D * 2u, 256u * D * 2u};
              pg8::gemm_phase(F.lds, g, S, E, R); }
            if (l == 0) { pg8::Gemm g{(const bf16_t*)(F.ws + WS_Y), (const bf16_t*)(F.ws + WS_WO0), D / 2, D}; CtxSched S{F.G, F.bx, 4, 256u * D * 2u, 256u * D * 2u, 2, (unsigned)D};
              pg8::gemm_phase(F.lds, g, S, E, R); }
            SEAM(pb + 5);
        }
        if (IN(pb + 6)) {
            if (l == 0) norm_phase<false>(F, l, 1, nullptr, xc, NTOK, (const float*)(F.ws + WS_TMPC1), xc); else { norm_phase<true>(F, l, 1, nullptr, xc, NL); moe_convert(F, 0); }
            SEAM(pb + 6);
        }
#ifndef STREAM0
#define STREAM0 0
#endif
#ifndef STREAM1
#define STREAM1 0
#endif
        if (IN(pb + 7)) {
            volatile LAS unsigned* lw = (volatile LAS unsigned*)(F.lds + MISC_OFF) + 16;
            if (l == 0) {
#if STREAM0
                FfnStream<9, false> S;
#pragma unroll
                for (int g = 0; g < 9; ++g) { S.P[g] = g < 8 ? 8 : 2; S.rb[g] = 2048 * g; S.cn[g] = g < 8 ? 2048 : 512; }
                S.nNgu = 22; S.Kdn = DFF0; S.need = 22u * 8u; S.q = ctl + CW_QUEUE; S.lw = lw; S.rdy = ctl + CW_RDY; S.tmo = ctl + 2; S.finish_init(F.G);
                EpiFfn<false> E{F.ws, F.out, mod_l}; FfnRows<false> R{nullptr};
                pg8::gemm_stream(F.lds, (const char*)F.ws, S, E, R);
#else
                { pg8::Gemm g{H, (const bf16_t*)(F.ws + WS_WGUD), D, D}; RowSched S{66, 22, F.G, F.bx, 256u * D * 2u, 256u * D * 2u}; EpiSwiglu E{(bf16_t*)(F.ws + WS_ACT), DFF0}; pg8::NoGather R;
                  pg8::gemm_phase(F.lds, g, S, E, R); }
                GRID_BAR();
                { EpiResid E{nullptr, XB, XB, xc, xc, mod_l, 5, (float*)(F.ws + WS_TMPC2)}; pg8::NoGather R;
                  { pg8::Gemm g{(const bf16_t*)(F.ws + WS_ACT), (const bf16_t*)(F.ws + WS_WDD), DFF0, DFF0}; GridSched S{64, 4, F.G, F.bx, 256u * DFF0 * 2u, 256u * DFF0 * 2u};
                    pg8::gemm_phase(F.lds, g, S, E, R); }
                  { pg8::Gemm g{(const bf16_t*)(F.ws + WS_ACT), (const bf16_t*)(F.ws + WS_WDD), DFF0 / 2, DFF0}; CtxSched S{F.G, F.bx, 4, 256u * DFF0 * 2u, 256u * DFF0 * 2u, 2, (unsigned)DFF0};
                    pg8::gemm_phase(F.lds, g, S, E, R); } }

#endif
            } else {
#if STREAM1
                FfnStream<8, true> S; { int bacc = 0;
#pragma unroll
                for (int e = 0; e < NE; ++e) { const int c = (int)ctl[CW_CNT + 64 * e]; S.cn[e] = c; S.P[e] = (c + 255) >> 8; S.rb[e] = bacc; bacc += ((c + 255) >> 8) << 8; } }
                S.nNgu = 28; S.Kdn = DFFE; S.need = 28u * 8u; S.q = ctl + CW_QUEUE + 64; S.lw = lw; S.rdy = ctl + CW_RDY + 64 * 80; S.tmo = ctl + 2; S.finish_init(F.G);
                EpiFfn<true> E{F.ws, F.out, mod_l}; FfnRows<true> R{(const int*)(F.ws + WS_LIST)};
                pg8::gemm_stream(F.lds, (const char*)F.ws, S, E, R);
#else
                { pg8::Gemm g{H, (const bf16_t*)(F.ws + WS_WGUE), D, D}; MoeSched S; S.G = F.G; S.c = F.bx; S.nN = 28; S.ksplit = 1; S.trim = 0; S.khbytes = 0; S.bexp = 2u * DFFE * D * 2u; S.bbytes = 256u * D * 2u; S.arow_bytes = 0; S.a_slots = false; S.init(ctl + CW_CNT);
                  EpiSwiglu E{(bf16_t*)(F.ws + WS_ACT), DFFE}; MoeRows R{(const int*)(F.ws + WS_LIST)};
                  pg8::gemm_phase(F.lds, g, S, E, R); }
                moe_convert(F, 1);
                GRID_BAR();
                { const int trim = moe_tail_panels(ctl + CW_CNT, F.G);
                  MoeSched S; S.G = F.G; S.c = F.bx; S.nN = 4; S.ksplit = 1; S.trim = trim; S.khbytes = 0; S.bexp = (unsigned)D * DFFE * 2u; S.bbytes = 256u * DFFE * 2u; S.arow_bytes = DFFE * 2u; S.a_slots = true; S.init(ctl + CW_CNT);
                  { pg8::Gemm g{(const bf16_t*)(F.ws + WS_ACT), (const bf16_t*)(F.ws + WS_WDE), DFFE, DFFE};
                    EpiBf16 E{(bf16_t*)(F.ws + WS_DOUT), (bf16_t*)(F.ws + WS_DOUT), D}; pg8::NoGather R;
                    pg8::gemm_phase(F.lds, g, S, E, R); }
                  if (trim > 0) {
                    const int plast = (S.cnt[NE - 1] + 255) >> 8;
                    pg8::Gemm g{(const bf16_t*)(F.ws + WS_ACT), (const bf16_t*)(F.ws + WS_WDE), DFFE / 4, DFFE};
                    MoeTailSched T{F.G, F.bx, trim, plast, S.base[NE - 1], (unsigned)D * DFFE * 2u};
                    EpiTail E{(bf16_t*)(F.ws + WS_DOUT), (bf16_t*)(F.ws + WS_DOUT1), S.base[NE - 1] + (plast - trim) * 256}; pg8::NoGather R;
                    pg8::gemm_phase(F.lds, g, T, E, R); } }
#endif
            }
            SEAM(pb + 7);
        }
}

constexpr int NPHASE = 18;
__global__ void __launch_bounds__(NTHR, 2) fwd_kernel(Args args) {
    extern __shared__ __attribute__((aligned(16))) unsigned char lds_raw[];
    Frame F;
    F.lds = (LAS unsigned char*)lds_raw; F.ws = args.ws; F.in = args.in; F.out = args.out;
    F.tid = threadIdx.x; F.lane = F.tid & 63; F.wave = __builtin_amdgcn_readfirstlane(F.tid >> 6); F.G = gridDim.x; F.bx = blockIdx.x;
    volatile LAS unsigned* MISC = (volatile LAS unsigned*)(F.lds + MISC_OFF);
    if (F.tid < 32) MISC[F.tid] = 0u;
    __syncthreads();
    unsigned* ctl = (unsigned*)(F.ws + WS_CTL);
#if !MK_MULTI
    XcdBarrier bar = xcd_barrier_post(ctl + CW_BAR, MISC + 8);
#else
    XcdBarrier bar; bar.bar = ctl + CW_BAR; bar.x = 0; bar.st = MISC + 8;
#endif
    const int lo = args.ph_lo, hi = args.ph_hi;
    if (IN(0)) { for (int rep = 0; rep < REPS(0); ++rep) { p0_prologue(F); __syncthreads(); } SEAM(0); }
    layer_phases<0>(F, ctl, lo, hi, bar);
    layer_phases<1>(F, ctl, lo, hi, bar);
    if (IN(17)) final_phase(F);
}

extern "C" void kernel_launch(void* const* d_in, const int* in_sizes, int n_in, void* d_out, int out_size, void* d_ws, size_t ws_size, hipStream_t stream) {
    static int grid = 0;
    if (grid == 0) {
        if (n_in != 21 || out_size != NL * D || ws_size < WS_END) { fprintf(stderr, "kernel_launch: unexpected problem (n_in %d out %d ws %zu)\n", n_in, out_size, ws_size); grid = -1; return; }
        int dev = 0, cus = 0;
        hipGetDevice(&dev); hipDeviceGetAttribute(&cus, hipDeviceAttributeMultiprocessorCount, dev);
        if (hipFuncSetAttribute((const void*)fwd_kernel, hipFuncAttributeMaxDynamicSharedMemorySize, LDS_BYTES) != hipSuccess) { fprintf(stderr, "kernel_launch: hipFuncSetAttribute failed\n"); grid = -1; return; }
        int per_cu = 0; (void)hipOccupancyMaxActiveBlocksPerMultiprocessor(&per_cu, (const void*)fwd_kernel, NTHR, LDS_BYTES); (void)hipGetLastError();
        grid = cus;
    }
    if (grid < 0) return;
    hipMemsetAsync((char*)d_ws + WS_CTL, 0, CTL_BYTES, stream);
#ifdef DBG_SCRUB
    hipMemsetAsync((char*)d_ws + CTL_BYTES, 0, WS_END - CTL_BYTES, stream);
#endif
    Args a{};
    for (int i = 0; i < 21; ++i) a.in[i] = (const float*)d_in[i];
    a.out = (float*)d_out; a.ws = (unsigned char*)d_ws;
#if MK_MULTI
    for (int p = 0; p < NPHASE; ++p) { a.ph_lo = p; a.ph_hi = p + 1; hipLaunchKernelGGL(fwd_kernel, dim3(grid), dim3(NTHR), LDS_BYTES, stream, a); }
#else
    a.ph_lo = 0; a.ph_hi = NPHASE;
    hipLaunchKernelGGL(fwd_kernel, dim3(grid), dim3(NTHR), LDS_BYTES, stream, a);
#endif
}
```

```cpp
#include <hip/hip_runtime.h>
#include <cstdio>
#include <cstdint>

#define LAS __attribute__((address_space(3)))
#define GAS __attribute__((address_space(1)))
typedef unsigned short bf16_t;
typedef short bf16x8 __attribute__((ext_vector_type(8)));
typedef short s16x4 __attribute__((ext_vector_type(4)));
typedef float f32x4 __attribute__((ext_vector_type(4)));
typedef float f32x2 __attribute__((ext_vector_type(2)));
typedef float f32x16 __attribute__((ext_vector_type(16)));
typedef unsigned u32x4 __attribute__((ext_vector_type(4)));
typedef unsigned u32x2 __attribute__((ext_vector_type(2)));

#ifndef MK_MULTI
#define MK_MULTI 0
#endif

constexpr int D = 1024, T = 8192, NB = 2, NL = NB * T, CTXL = 256, NC = NB * CTXL, NTOK = NL + NC;
constexpr int INW = 3328, OFFQ = 512, OFFK = 1024, OFFV = 1152, OFFG = 1280;
constexpr int DFF0 = 2816, DFFE = 3584, NE = 8;
constexpr int KM = 1152;
constexpr int MOE_ROWS = 2 * NL + NE * 256;
constexpr float EPS = 1e-6f;
constexpr float LOG2E = 1.4426950408889634f;
constexpr float QSCALE = 0.125f * LOG2E;

constexpr size_t MiB = 1u << 20, KiB = 1u << 10;
constexpr size_t WS_CTL = 0, CTL_BYTES = 1 * MiB;
constexpr size_t WS_ROPE = 1 * MiB, WS_TW = WS_ROPE + 32 * KiB, WS_FA64 = WS_ROPE + 96 * KiB, WS_TC = WS_ROPE + 160 * KiB, WS_TX = WS_ROPE + 288 * KiB;
constexpr size_t WS_TOKE = 2 * MiB, WS_TOKR = WS_TOKE + 128 * KiB, WS_TOKW = WS_TOKE + 256 * KiB, WS_LIST = WS_TOKE + 384 * KiB;
constexpr size_t WS_XC = 3 * MiB, WS_VCT = 5 * MiB;
constexpr size_t WS_WIN0 = 6 * MiB, WS_WM0 = WS_WIN0 + 13 * MiB / 2, WS_WO0 = 17 * MiB, WS_WGUD = 19 * MiB, WS_WDD = 30 * MiB;
constexpr size_t WS_WIN1 = 36 * MiB, WS_WM1 = WS_WIN1 + 13 * MiB / 2, WS_WO1 = 47 * MiB;
constexpr size_t WS_H = 49 * MiB;
constexpr size_t WS_DOUT = 6 * MiB;
constexpr size_t WS_WGUE = 82 * MiB, WS_WDE = 194 * MiB;
constexpr size_t WS_DOUT1 = WS_WGUE;
constexpr size_t WS_R1 = 250 * MiB;
constexpr size_t WS_UP = WS_R1, WS_Q = 266 * MiB, WS_KB = 283 * MiB, WS_VB = 288 * MiB, WS_GF = 293 * MiB, WS_GA = 326 * MiB, WS_GP = 359 * MiB, WS_FO = 375 * MiB, WS_Y = 413 * MiB;
constexpr size_t WS_ACT = WS_R1;
constexpr size_t WS_TMPC1 = 446 * MiB, WS_TMPC2 = 448 * MiB;
constexpr size_t WS_XB = 490 * MiB;
constexpr size_t WS_END = 523 * MiB;
static_assert(WS_DOUT + (size_t)MOE_ROWS * D * 2 <= WS_WGUE, "DOUT overlay");
static_assert(WS_ACT + (size_t)MOE_ROWS * DFFE * 2 <= WS_END, "ACT");
static_assert(WS_FO + (size_t)NTOK * KM * 2 <= WS_Y, "FO");
constexpr int CW_BAR = 4096, CW_CNT = 8192, CW_MOD = 16384;
constexpr int MODSZ = 6 * D;

constexpr int RING_BYTES = 131072, MISC_OFF = RING_BYTES + 320, LDS_BYTES = 147456;
constexpr int NWAVES = 8, NTHR = 512;

__device__ __forceinline__ unsigned f2bf(float f) { unsigned u = __builtin_bit_cast(unsigned, f); return (u + 0x7fffu + ((u >> 16) & 1u)) >> 16; }
__device__ __forceinline__ unsigned pk2(float lo, float hi) { return f2bf(lo) | (f2bf(hi) << 16); }
__device__ __forceinline__ unsigned pk4f8(float a, float b, float c, float d) { int w = __builtin_amdgcn_cvt_pk_fp8_f32(a, b, 0, false); w = __builtin_amdgcn_cvt_pk_fp8_f32(c, d, w, true); return (unsigned)w; }
__device__ __forceinline__ unsigned cvt_pk_bf16(float lo, float hi) { unsigned r; asm volatile("v_cvt_pk_bf16_f32 %0, %1, %2" : "=v"(r) : "v"(lo), "v"(hi)); return r; }
__device__ __forceinline__ float bf2f(unsigned short h) { return __builtin_bit_cast(float, (unsigned)h << 16); }
__device__ __forceinline__ float bflo(unsigned w) { return __builtin_bit_cast(float, w << 16); }
__device__ __forceinline__ float bfhi(unsigned w) { return __builtin_bit_cast(float, w & 0xffff0000u); }
__device__ __forceinline__ float wave_sum(float v) {
#pragma unroll
    for (int o = 1; o < 64; o <<= 1) v += __shfl_xor(v, o);
    return v;
}
__device__ __forceinline__ float sigmoidf_(float x) { return __builtin_amdgcn_rcpf(1.0f + __builtin_amdgcn_exp2f(-x * LOG2E)); }
#define LDS_WAIT() asm volatile("s_waitcnt lgkmcnt(0)" ::: "memory")
#define VM_WAIT() asm volatile("s_waitcnt vmcnt(0)" ::: "memory")

#define XB_TMO      128
#define XB_XCNT(j)  (256  + 64 * (j))
#define XB_XSUB(j)  (1280 + 64 * (j))
#define XB_XGEN(j)  (2304 + 64 * (j))
#define XB_TOP      3328
#define XB_TOPGEN   3392
#define XCD_BAR_WORDS 3456
#define XB_SPIN_CAP (1u << 18)
__device__ __forceinline__ unsigned xb_ld(unsigned* p)              { return __hip_atomic_load(p, __ATOMIC_RELAXED, __HIP_MEMORY_SCOPE_AGENT); }
__device__ __forceinline__ unsigned xb_add(unsigned* p, unsigned v) { return __hip_atomic_fetch_add(p, v, __ATOMIC_RELAXED, __HIP_MEMORY_SCOPE_AGENT); }
__device__ __forceinline__ unsigned xb_xcc_id() { return (unsigned)__builtin_amdgcn_s_getreg((3 << 11) | 20) & 0xFu; }
#define XB_SPIN(cond, bar) do { unsigned _sp = 0; while (cond) { __builtin_amdgcn_s_sleep(1); \
    if ((++_sp & 255u) == 0u) { if (xb_ld(&(bar)[XB_TMO])) break; if (_sp > XB_SPIN_CAP) { atomicAdd(&(bar)[XB_TMO], 1u); break; } } } } while (0)
struct XcdBarrier { unsigned* bar; unsigned x; volatile LAS unsigned* st; };
__device__ __forceinline__ XcdBarrier xcd_barrier_post(unsigned* bar, volatile LAS unsigned* st) {
    XcdBarrier b; b.bar = bar; b.x = xb_xcc_id(); b.st = st;
    if (threadIdx.x == 0) (void)xb_add(&bar[XB_XCNT(b.x)], 1u);
    return b;
}
__device__ __forceinline__ void xcd_barrier_complete(unsigned* bar, unsigned x, unsigned& nloc, unsigned& nx) {
    const unsigned G = gridDim.x * gridDim.y * gridDim.z;
    unsigned sum, cnt, mine, sp = 0u;
    for (;;) {
        sum = 0u; cnt = 0u; mine = 0u;
#pragma unroll
        for (unsigned j = 0; j < 16; ++j) { const unsigned c = xb_ld(&bar[XB_XCNT(j)]); sum += c; cnt += (c > 0u) ? 1u : 0u; mine = (j == x) ? c : mine; }
        if (sum == G) break;
        __builtin_amdgcn_s_sleep(1);
        if ((++sp & 255u) == 0u) { if (xb_ld(&bar[XB_TMO])) break; if (sp > XB_SPIN_CAP) { atomicAdd(&bar[XB_TMO], 1u); break; } }
    }
    nloc = mine > 0u ? mine : 1u; nx = cnt > 0u ? cnt : 1u;
}
__device__ __forceinline__ void xcd_barrier(const XcdBarrier& b) {
    asm volatile("s_waitcnt vmcnt(0)" ::: "memory");
    __syncthreads();
    if (threadIdx.x == 0) {
        unsigned* bar = b.bar;
        __builtin_amdgcn_s_waitcnt(0);
        unsigned nloc = b.st[0], nx = b.st[1];
        if (nloc == 0u) { xcd_barrier_complete(bar, b.x, nloc, nx); b.st[0] = nloc; b.st[1] = nx; }
        const unsigned old = xb_add(&bar[XB_XSUB(b.x)], 1u);
        const unsigned gen = old / nloc;
        if (old + 1u == (gen + 1u) * nloc) {
            __builtin_amdgcn_fence(__ATOMIC_RELEASE, "agent");
            asm volatile("s_waitcnt vmcnt(0)" ::: "memory");
            const unsigned og = xb_add(&bar[XB_TOP], 1u);
            const unsigned tg = og / nx;
            if (og + 1u == (tg + 1u) * nx) xb_add(&bar[XB_TOPGEN], 1u);
            else XB_SPIN(xb_ld(&bar[XB_TOPGEN]) == tg, bar);
            __builtin_amdgcn_fence(__ATOMIC_ACQUIRE, "agent");
            xb_add(&bar[XB_XGEN(b.x)], 1u);
            asm volatile("s_waitcnt vmcnt(0)" ::: "memory");
        } else {
            XB_SPIN(xb_ld(&bar[XB_XGEN(b.x)]) == gen, bar);
            __builtin_amdgcn_fence(__ATOMIC_ACQUIRE, "agent");
            asm volatile("s_waitcnt vmcnt(0)" ::: "memory");
        }
    }
    __syncthreads();
}

#ifndef QGU
#define QGU 32
#endif
#ifndef QDN
#define QDN 64
#endif
#ifndef QACT
#define QACT 16
#endif
namespace pg8 {
constexpr int BM = 256, BK = 64, HALF = 128, HTB = HALF * BK * 2, STAGE_BYTES = 8 * HTB, NXCD = 8, WGM = 8;
__host__ __device__ __forceinline__ int lds_byte(int r, int c) { const int st = (r >> 4) * 2 + (c >> 5), rr = r & 15, cc = c & 31, ob = rr * 64 + cc * 2; return st * 1024 + (ob ^ (((ob >> 9) & 1) << 5)); }
__host__ __device__ __forceinline__ void stage_rc(int b, int& R, int& C) { const int st = b / 1024, sb = b % 1024, swz = sb ^ (((sb >> 9) & 1) << 5); R = (st >> 1) * 16 + swz / 64; C = (st & 1) * 32 + (swz % 64) / 2; }
__host__ __device__ __forceinline__ int perm32(int rho) { const int n = rho >> 4, i = rho & 15; return 8 * (i >> 2) + 4 * n + (i & 3); }

typedef int i32x8 __attribute__((ext_vector_type(8)));
typedef int i32x4 __attribute__((ext_vector_type(4)));
__device__ __forceinline__ i32x8 cat8(bf16x8 a, bf16x8 b) { return __builtin_shufflevector(__builtin_bit_cast(i32x4, a), __builtin_bit_cast(i32x4, b), 0, 1, 2, 3, 4, 5, 6, 7); }
struct Unit { unsigned aoff, boff; int pm, pn, kind, x0, x1, kh; };
struct Gemm { const bf16_t* A; const bf16_t* Bt; int K; int ld; };

__device__ __forceinline__ void swz_map(int L, int nM, int nN, int& pm, int& pn) {
    const int nwg = nM * nN; int wgid = L;
    { const int q = nwg / NXCD, r = nwg % NXCD, xcd = wgid % NXCD, off = wgid / NXCD; wgid = (xcd < r ? xcd * (q + 1) : r * (q + 1) + (xcd - r) * q) + off; }
    const int nig = WGM * nN, gid = wgid / nig, fm = gid * WGM, gsz = (nM - fm) < WGM ? (nM - fm) : WGM;
    pm = fm + ((wgid % nig) % gsz); pn = (wgid % nig) / gsz;
}

struct NoGather { static constexpr bool GA = false, GB = false;
    __device__ __forceinline__ unsigned arow(const Unit&, int) const { return 0u; }
    __device__ __forceinline__ unsigned brow(const Unit&, int) const { return 0u; } };

template <bool F8, class Epi, class Sched, class Rows>
__device__ __forceinline__ void gemm_phase_t(LAS unsigned char* lds, const Gemm g, const Sched& S, const Epi& E, const Rows& RW) {
    int tid_ = threadIdx.x; asm volatile("" : "+v"(tid_));
    const int tid = tid_, wid = __builtin_amdgcn_readfirstlane(tid >> 6), lane = tid & 63, wr = wid >> 2, wc = wid & 3, fr = lane & 15, fq = lane >> 4;
    int K_ = g.K; asm volatile("" : "+s"(K_));
    const int K = K_, nt = K / BK;
    int sR[2], sRb[2], sC[2];
#pragma unroll
    for (int i = 0; i < 2; ++i) { int R, C; stage_rc(tid * 16 + i * 8192, R, C); sR[i] = R; sC[i] = C; sRb[i] = (R & ~31) + perm32(R & 31); }
    unsigned voffA[2], voffB[2];
    const int LD = g.ld;
#pragma unroll
    for (int i = 0; i < 2; ++i) { voffA[i] = (unsigned)(sR[i] * LD + sC[i]) * 2u; voffB[i] = (unsigned)(sRb[i] * LD + sC[i]) * 2u; }
    const size_t kstep = (size_t)(BK * 2);
    const size_t hstep = (size_t)HALF * LD * 2;
    const unsigned ldsw = (unsigned)wid * 1024u;
    const int aoff = lds_byte(wr * 64 + fr, fq * 8), boff = lds_byte(wc * 32 + fr, fq * 8);
    constexpr int NTHR_ = 512;
    LAS unsigned* stash = (LAS unsigned*)(lds + 131072 + 320 + 1024) + tid;
    struct Side { const char* base[2]; unsigned off[2][2]; };
#define PG8_SA(b, h) (((b) * 2 + (h)) * HTB)
#define PG8_SB(b, h) ((4 + (b) * 2 + (h)) * HTB)
#define PG8_STAGE(bufoff, side, h, kt) do { _Pragma("unroll") for (int _i = 0; _i < 2; ++_i) { unsigned _o = (side).off[h][_i]; asm volatile("" : "+v"(_o)); \
        __builtin_amdgcn_global_load_lds((const unsigned*)((side).base[h] + (size_t)(kt) * kstep + _o), (LAS unsigned*)(lds + (bufoff) + ldsw + _i * 8192), 16, 0, 0); } } while (0)
#define PG8_LDA(dst, b, h) do { _Pragma("unroll") for (int m = 0; m < 4; ++m) _Pragma("unroll") for (int k = 0; k < 2; ++k) dst[m][k] = *(const LAS bf16x8*)(lds + PG8_SA(b, h) + aoff + m * 2048 + k * 1024); } while (0)
#define PG8_LDB(dst, b, h) do { _Pragma("unroll") for (int n = 0; n < 2; ++n) _Pragma("unroll") for (int k = 0; k < 2; ++k) dst[n][k] = *(const LAS bf16x8*)(lds + PG8_SB(b, h) + boff + n * 2048 + k * 1024); } while (0)
#define PG8_MMA(ai, bj, At, Bt) do { __builtin_amdgcn_s_setprio(1); _Pragma("unroll") for (int m = 0; m < 4; ++m) _Pragma("unroll") for (int n = 0; n < 2; ++n) { \
        if constexpr (F8) acc[ai][bj][m][n] = __builtin_amdgcn_mfma_scale_f32_16x16x128_f8f6f4(cat8(Bt[n][0], Bt[n][1]), cat8(At[m][0], At[m][1]), acc[ai][bj][m][n], 0, 0, 0, 0, 0, 0); \
        else { _Pragma("unroll") for (int k = 0; k < 2; ++k) acc[ai][bj][m][n] = __builtin_amdgcn_mfma_f32_16x16x32_bf16(Bt[n][k], At[m][k], acc[ai][bj][m][n], 0, 0, 0); } } __builtin_amdgcn_s_setprio(0); } while (0)
#define PG8_WAIT_V(n) asm volatile("s_waitcnt vmcnt(" #n ")" ::: "memory")
#define PG8_WAIT_L(n) asm volatile("s_waitcnt lgkmcnt(" #n ")" ::: "memory")
#define PG8_BAR __builtin_amdgcn_s_barrier()
#define PG8_SCHED __builtin_amdgcn_sched_barrier(0)
#define PG8_MKSIDES(u, sa, sb) do { \
        if constexpr (Rows::GA) { sa.base[0] = sa.base[1] = (const char*)g.A; int t2_ = tid; asm volatile("" : "+v"(t2_)); _Pragma("unroll") for (int i = 0; i < 2; ++i) { int R_, C_; stage_rc(t2_ * 16 + i * 8192, R_, C_); \
            _Pragma("unroll") for (int h = 0; h < 2; ++h) sa.off[h][i] = RW.arow(u, h * HALF + R_) + (unsigned)C_ * 2u; } } \
        else { sa.base[0] = (const char*)g.A + (u).aoff; sa.base[1] = sa.base[0] + hstep; _Pragma("unroll") for (int h = 0; h < 2; ++h) _Pragma("unroll") for (int i = 0; i < 2; ++i) sa.off[h][i] = voffA[i]; } \
        if constexpr (Rows::GB) { sb.base[0] = sb.base[1] = (const char*)g.Bt; _Pragma("unroll") for (int h = 0; h < 2; ++h) _Pragma("unroll") for (int i = 0; i < 2; ++i) sb.off[h][i] = RW.brow(u, h * HALF + sRb[i]) + (unsigned)sC[i] * 2u; } \
        else { sb.base[0] = (const char*)g.Bt + (u).boff; sb.base[1] = sb.base[0] + hstep; _Pragma("unroll") for (int h = 0; h < 2; ++h) _Pragma("unroll") for (int i = 0; i < 2; ++i) sb.off[h][i] = voffB[i]; } } while (0)
    Unit cur, nxt; int ui = 0;
    if (!S.next(0, cur)) return;
    f32x4 acc[2][2][4][2];
#pragma unroll
    for (int a = 0; a < 2; ++a)
#pragma unroll
        for (int b = 0; b < 2; ++b)
#pragma unroll
            for (int m = 0; m < 4; ++m)
#pragma unroll
                for (int n = 0; n < 2; ++n) acc[a][b][m][n] = (f32x4){0.f, 0.f, 0.f, 0.f};
    bf16x8 At[4][2], B0[2][2], B1[2][2];
    Side cA, cB, nA, nB;
    PG8_MKSIDES(cur, cA, cB);
    PG8_STAGE(PG8_SB(0, 0), cB, 0, 0); PG8_STAGE(PG8_SB(0, 1), cB, 1, 0); PG8_STAGE(PG8_SA(0, 0), cA, 0, 0); PG8_STAGE(PG8_SA(0, 1), cA, 1, 0);
    if (wr == 1) PG8_BAR;
    PG8_WAIT_V(2); PG8_BAR;
    PG8_STAGE(PG8_SB(1, 0), cB, 0, 1); PG8_STAGE(PG8_SA(1, 0), cA, 0, 1); PG8_STAGE(PG8_SB(1, 1), cB, 1, 1);
    PG8_WAIT_V(6); PG8_BAR;
    for (;;) {
        const bool has_next = S.next(ui + 1, nxt);
        if (has_next) { PG8_MKSIDES(nxt, nA, nB); } else { nA = cA; nB = cB; }
        if constexpr (Rows::GA) {
#pragma unroll
            for (int h = 0; h < 2; ++h)
#pragma unroll
                for (int i = 0; i < 2; ++i) stash[(h * 2 + i) * NTHR_] = nA.off[h][i]; }
        for (int t = 0; t < nt; t += 2) {
            const bool last = (t == nt - 2);
            if constexpr (Epi::MIDK > 0) { if (t == Epi::MIDK) E.mid(acc, cur, wr, wc, fr, fq); }
            Side a2, b2;
            a2.base[0] = last ? nA.base[0] : cA.base[0]; a2.base[1] = last ? nA.base[1] : cA.base[1];
            b2.base[0] = last ? nB.base[0] : cB.base[0]; b2.base[1] = last ? nB.base[1] : cB.base[1];
#pragma unroll
            for (int h = 0; h < 2; ++h)
#pragma unroll
                for (int i = 0; i < 2; ++i) { if constexpr (!Rows::GA) a2.off[h][i] = cA.off[h][i]; b2.off[h][i] = (Rows::GB && last) ? nB.off[h][i] : cB.off[h][i]; }
            const int k2 = last ? 0 : t + 2, k3 = k2 + 1;
            PG8_LDB(B0, 0, 0); PG8_LDB(B1, 0, 1); PG8_SCHED; PG8_LDA(At, 0, 0); PG8_STAGE(PG8_SA(1, 1), cA, 1, t + 1);
            if constexpr (Rows::GA) {
                if (last) {
#pragma unroll
                    for (int h = 0; h < 2; ++h)
#pragma unroll
                        for (int i = 0; i < 2; ++i) cA.off[h][i] = stash[(h * 2 + i) * NTHR_]; }
#pragma unroll
                for (int h = 0; h < 2; ++h)
#pragma unroll
                    for (int i = 0; i < 2; ++i) a2.off[h][i] = cA.off[h][i]; }
            PG8_WAIT_V(8); PG8_WAIT_L(0); PG8_BAR; PG8_MMA(0, 0, At, B0); PG8_MMA(0, 1, At, B1); PG8_BAR; PG8_SCHED;
            PG8_LDA(At, 0, 1); PG8_STAGE(PG8_SB(0, 0), b2, 0, k2); PG8_STAGE(PG8_SB(0, 1), b2, 1, k2); PG8_STAGE(PG8_SA(0, 0), a2, 0, k2);
            PG8_WAIT_V(8); PG8_WAIT_L(0); PG8_BAR; PG8_MMA(1, 0, At, B0); PG8_MMA(1, 1, At, B1); PG8_BAR; PG8_SCHED;
            PG8_LDB(B0, 1, 0); PG8_LDB(B1, 1, 1); PG8_SCHED; PG8_LDA(At, 1, 0); PG8_STAGE(PG8_SA(0, 1), a2, 1, k2);
            PG8_WAIT_V(8); PG8_WAIT_L(0); PG8_BAR; PG8_MMA(0, 0, At, B0); PG8_MMA(0, 1, At, B1); PG8_BAR; PG8_SCHED;
            PG8_LDA(At, 1, 1); PG8_STAGE(PG8_SB(1, 0), b2, 0, k3); PG8_STAGE(PG8_SB(1, 1), b2, 1, k3); PG8_STAGE(PG8_SA(1, 0), a2, 0, k3);
            PG8_WAIT_V(8); PG8_WAIT_L(0); PG8_BAR; PG8_MMA(1, 0, At, B0); PG8_MMA(1, 1, At, B1); PG8_BAR; PG8_SCHED;
        }
        if (wr == 0) PG8_BAR;
        E(acc, cur, wr, wc, fr, fq);
        if (!has_next) break;
#pragma unroll
        for (int a = 0; a < 2; ++a)
#pragma unroll
            for (int b = 0; b < 2; ++b)
#pragma unroll
                for (int m = 0; m < 4; ++m)
#pragma unroll
                    for (int n = 0; n < 2; ++n) acc[a][b][m][n] = (f32x4){0.f, 0.f, 0.f, 0.f};
        cur = nxt; if constexpr (Rows::GA) { cA.base[0] = nA.base[0]; cA.base[1] = nA.base[1]; } else cA = nA; cB = nB; ++ui;
        if (wr == 1) PG8_BAR;
    }
    PG8_WAIT_V(0);
    PG8_BAR;
#undef PG8_SA
#undef PG8_SB
#undef PG8_STAGE
#undef PG8_LDA
#undef PG8_LDB
#undef PG8_MMA
#undef PG8_WAIT_V
#undef PG8_WAIT_L
#undef PG8_BAR
#undef PG8_SCHED
#undef PG8_MKSIDES
}

template <class Epi, class Sched, class Rows>
__device__ __forceinline__ void gemm_phase(LAS unsigned char* lds, const Gemm g, const Sched& S, const Epi& E, const Rows& RW) { gemm_phase_t<false>(lds, g, S, E, RW); }
template <class Epi, class Sched, class Rows>
__device__ __forceinline__ void gemm_phase8(LAS unsigned char* lds, const Gemm g, const Sched& S, const Epi& E, const Rows& RW) { gemm_phase_t<true>(lds, g, S, E, RW); }

struct SUnit { unsigned aoff, boff; int K; int pm, pn, kind, x0, x1, grp, dep, sig; };
__device__ __forceinline__ void st16_wt(unsigned char* wsbase, unsigned off, u32x4 v) {
    const __amdgpu_buffer_rsrc_t rsrc = __builtin_amdgcn_make_buffer_rsrc((void*)wsbase, 0, 0x7fffffff, 0x00020000);
    __builtin_amdgcn_raw_buffer_store_b128(v, rsrc, off, 0, 16); }

template <class Epi, class Sched, class Rows>
__device__ __forceinline__ void gemm_stream(LAS unsigned char* lds, const char* base, const Sched& S, const Epi& E, const Rows& RW) {
    int tid_ = threadIdx.x; asm volatile("" : "+v"(tid_));
    const int tid = tid_, wid = __builtin_amdgcn_readfirstlane(tid >> 6), lane = tid & 63, wr = wid >> 2, wc = wid & 3, fr = lane & 15, fq = lane >> 4;
    int sR[2], sRb[2], sC[2];
#pragma unroll
    for (int i = 0; i < 2; ++i) { int R, C; stage_rc(tid * 16 + i * 8192, R, C); sR[i] = R; sC[i] = C; sRb[i] = (R & ~31) + perm32(R & 31); }
    const size_t kstep = (size_t)(BK * 2);
    const unsigned ldsw = (unsigned)wid * 1024u;
    const int aoff = lds_byte(wr * 64 + fr, fq * 8), boff = lds_byte(wc * 32 + fr, fq * 8);
    struct Side { const char* base[2]; unsigned off[2][2]; };
#define PG8_SA(b, h) (((b) * 2 + (h)) * HTB)
#define PG8_SB(b, h) ((4 + (b) * 2 + (h)) * HTB)
#define PG8_STAGE(bufoff, side, h, kt) do { _Pragma("unroll") for (int _i = 0; _i < 2; ++_i) \
        __builtin_amdgcn_global_load_lds((const unsigned*)((side).base[h] + (size_t)(kt) * kstep + (side).off[h][_i]), (LAS unsigned*)(lds + (bufoff) + ldsw + _i * 8192), 16, 0, 0); } while (0)
#define PG8_LDA(dst, b, h) do { _Pragma("unroll") for (int m = 0; m < 4; ++m) _Pragma("unroll") for (int k = 0; k < 2; ++k) dst[m][k] = *(const LAS bf16x8*)(lds + PG8_SA(b, h) + aoff + m * 2048 + k * 1024); } while (0)
#define PG8_LDB(dst, b, h) do { _Pragma("unroll") for (int n = 0; n < 2; ++n) _Pragma("unroll") for (int k = 0; k < 2; ++k) dst[n][k] = *(const LAS bf16x8*)(lds + PG8_SB(b, h) + boff + n * 2048 + k * 1024); } while (0)
#define PG8_MMA(ai, bj, At, Bt) do { __builtin_amdgcn_s_setprio(1); _Pragma("unroll") for (int m = 0; m < 4; ++m) _Pragma("unroll") for (int n = 0; n < 2; ++n) _Pragma("unroll") for (int k = 0; k < 2; ++k) \
        acc[ai][bj][m][n] = __builtin_amdgcn_mfma_f32_16x16x32_bf16(Bt[n][k], At[m][k], acc[ai][bj][m][n], 0, 0, 0); __builtin_amdgcn_s_setprio(0); } while (0)
#define PG8_WAIT_V(n) asm volatile("s_waitcnt vmcnt(" #n ")" ::: "memory")
#define PG8_WAIT_L(n) asm volatile("s_waitcnt lgkmcnt(" #n ")" ::: "memory")
#define PG8_BAR __builtin_amdgcn_s_barrier()
#define PG8_SCHED __builtin_amdgcn_sched_barrier(0)
#define PG8_MKSIDES(un, sa, sb) do { const int K_ = (un).K; \
        if (RW.a_gather(un)) { sa.base[0] = sa.base[1] = base; _Pragma("unroll") for (int h = 0; h < 2; ++h) _Pragma("unroll") for (int i = 0; i < 2; ++i) sa.off[h][i] = RW.arow(un, h * HALF + sR[i]) + (unsigned)sC[i] * 2u; } \
        else { sa.base[0] = base + (un).aoff; sa.base[1] = sa.base[0] + (size_t)HALF * K_ * 2; _Pragma("unroll") for (int h = 0; h < 2; ++h) _Pragma("unroll") for (int i = 0; i < 2; ++i) sa.off[h][i] = (unsigned)(sR[i] * K_ + sC[i]) * 2u; } \
        sb.base[0] = base + (un).boff; sb.base[1] = sb.base[0] + (size_t)HALF * K_ * 2; _Pragma("unroll") for (int h = 0; h < 2; ++h) _Pragma("unroll") for (int i = 0; i < 2; ++i) sb.off[h][i] = (unsigned)(sRb[i] * K_ + sC[i]) * 2u; } while (0)
#define PG8_SIGNAL(idx) do { if (lane == 0) __hip_atomic_fetch_add(S.rdy + 64 * (idx), 1u, __ATOMIC_RELAXED, __HIP_MEMORY_SCOPE_AGENT); } while (0)
    SUnit cur, nxt;
    unsigned pend = 0u;
    const unsigned lw_addr = (unsigned)(size_t)S.lw;
    if (tid == 0) { S.lw[0] = __hip_atomic_fetch_add(S.q, 1u, __ATOMIC_RELAXED, __HIP_MEMORY_SCOPE_AGENT); pend = __hip_atomic_fetch_add(S.q, 1u, __ATOMIC_RELAXED, __HIP_MEMORY_SCOPE_AGENT); }
    __syncthreads();
    { const int L0 = __builtin_amdgcn_readfirstlane((int)S.lw[0]); if (!S.decode(L0, cur)) return; }
    f32x4 acc[2][2][4][2];
#pragma unroll
    for (int a = 0; a < 2; ++a)
#pragma unroll
        for (int b = 0; b < 2; ++b)
#pragma unroll
            for (int m = 0; m < 4; ++m)
#pragma unroll
                for (int n = 0; n < 2; ++n) acc[a][b][m][n] = (f32x4){0.f, 0.f, 0.f, 0.f};
    bf16x8 At[4][2], B0[2][2], B1[2][2];
    Side cA, cB, nA, nB;
    bool need_pro = true; int sig_idx = -1;
    PG8_MKSIDES(cur, cA, cB);
    for (;;) {
        if (need_pro) {
            if (cur.dep >= 0) S.a_ready(cur);
            PG8_STAGE(PG8_SB(0, 0), cB, 0, 0); PG8_STAGE(PG8_SB(0, 1), cB, 1, 0); PG8_STAGE(PG8_SA(0, 0), cA, 0, 0); PG8_STAGE(PG8_SA(0, 1), cA, 1, 0);
            if (wr == 1) PG8_BAR;
            PG8_WAIT_V(2); PG8_BAR;
            PG8_STAGE(PG8_SB(1, 0), cB, 0, 1); PG8_STAGE(PG8_SA(1, 0), cA, 0, 1); PG8_STAGE(PG8_SB(1, 1), cB, 1, 1);
            PG8_WAIT_V(6); PG8_BAR;
        }
        if (tid == 0) { asm volatile("s_nop 7\n\tds_write_b32 %1, %0\n\tglobal_atomic_add %0, %2, %3, %4 sc0" : "+v"(pend) : "v"(lw_addr), "v"(0u), "v"(1u), "s"(S.q) : "memory"); }
        PG8_WAIT_L(0); PG8_BAR; asm volatile("" ::: "memory");
        const int Ln = __builtin_amdgcn_readfirstlane((int)S.lw[0]);
        const bool has_next = S.decode(Ln, nxt), pre = has_next && nxt.dep < 0;
        if (pre) { PG8_MKSIDES(nxt, nA, nB); } else { nA = cA; nB = cB; }
        const int nt = cur.K / BK;
        for (int t = 0; t < nt; t += 2) {
            const bool last = (t == nt - 2);
            Side a2, b2;
            a2.base[0] = last ? nA.base[0] : cA.base[0]; a2.base[1] = last ? nA.base[1] : cA.base[1];
            b2.base[0] = last ? nB.base[0] : cB.base[0]; b2.base[1] = last ? nB.base[1] : cB.base[1];
#pragma unroll
            for (int h = 0; h < 2; ++h)
#pragma unroll
                for (int i = 0; i < 2; ++i) { a2.off[h][i] = last ? nA.off[h][i] : cA.off[h][i]; b2.off[h][i] = last ? nB.off[h][i] : cB.off[h][i]; }
            const int k2 = last ? 0 : t + 2, k3 = k2 + 1;
            if (t == 2 && sig_idx >= 0) { PG8_SIGNAL(sig_idx); sig_idx = -1; }
            PG8_LDB(B0, 0, 0); PG8_LDB(B1, 0, 1); PG8_SCHED; PG8_LDA(At, 0, 0); PG8_STAGE(PG8_SA(1, 1), cA, 1, t + 1);
            PG8_WAIT_V(8); PG8_WAIT_L(0); PG8_BAR; PG8_MMA(0, 0, At, B0); PG8_MMA(0, 1, At, B1); PG8_BAR; PG8_SCHED;
            PG8_LDA(At, 0, 1); PG8_STAGE(PG8_SB(0, 0), b2, 0, k2); PG8_STAGE(PG8_SB(0, 1), b2, 1, k2); PG8_STAGE(PG8_SA(0, 0), a2, 0, k2);
            PG8_WAIT_V(8); PG8_WAIT_L(0); PG8_BAR; PG8_MMA(1, 0, At, B0); PG8_MMA(1, 1, At, B1); PG8_BAR; PG8_SCHED;
            PG8_LDB(B0, 1, 0); PG8_LDB(B1, 1, 1); PG8_SCHED; PG8_LDA(At, 1, 0); PG8_STAGE(PG8_SA(0, 1), a2, 1, k2);
            PG8_WAIT_V(8); PG8_WAIT_L(0); PG8_BAR; PG8_MMA(0, 0, At, B0); PG8_MMA(0, 1, At, B1); PG8_BAR; PG8_SCHED;
            PG8_LDA(At, 1, 1); PG8_STAGE(PG8_SB(1, 0), b2, 0, k3); PG8_STAGE(PG8_SB(1, 1), b2, 1, k3); PG8_STAGE(PG8_SA(1, 0), a2, 0, k3);
            PG8_WAIT_V(8); PG8_WAIT_L(0); PG8_BAR; PG8_MMA(1, 0, At, B0); PG8_MMA(1, 1, At, B1); PG8_BAR; PG8_SCHED;
        }
        if (wr == 0) PG8_BAR;
        E(acc, cur, wr, wc, fr, fq);
        if (!has_next) { PG8_WAIT_V(0); if (cur.sig >= 0) PG8_SIGNAL(cur.sig); break; }
#pragma unroll
        for (int a = 0; a < 2; ++a)
#pragma unroll
            for (int b = 0; b < 2; ++b)
#pragma unroll
                for (int m = 0; m < 4; ++m)
#pragma unroll
                    for (int n = 0; n < 2; ++n) acc[a][b][m][n] = (f32x4){0.f, 0.f, 0.f, 0.f};
        if (pre) {
            sig_idx = cur.sig; need_pro = false; cur = nxt; cA = nA; cB = nB;
            if (wr == 1) PG8_BAR;
        } else {
            PG8_WAIT_V(0); if (cur.sig >= 0) PG8_SIGNAL(cur.sig);
            PG8_BAR; need_pro = true; cur = nxt; PG8_MKSIDES(cur, cA, cB);
        }
    }
    PG8_BAR;
#undef PG8_SA
#undef PG8_SB
#undef PG8_STAGE
#undef PG8_LDA
#undef PG8_LDB
#undef PG8_MMA
#undef PG8_WAIT_V
#undef PG8_WAIT_L
#undef PG8_BAR
#undef PG8_SCHED
#undef PG8_MKSIDES
#undef PG8_SIGNAL
}
}
using pg8::Unit;
using pg8::SUnit;

struct Args { const float* in[21]; float* out; unsigned char* ws; int ph_lo, ph_hi; };

struct Frame {
    LAS unsigned char* lds;
    unsigned char* ws;
    const float* const* in;
    float* out;
    int tid, lane, wave, G, bx;
};
__device__ __forceinline__ float* modp(const Frame& F, int l, int v) { return (float*)(F.ws + WS_CTL) + CW_MOD + (l * 3 + v) * MODSZ; }

__device__ __forceinline__ void p0_transpose_item(const float* W, int ldw, int k0, int c0, bf16_t* WT, int ldt, int drow, int lane) {
    const float* src = W + (size_t)k0 * ldw + c0 + lane;
    float v[64];
#pragma unroll
    for (int i = 0; i < 64; ++i) { v[i] = src[(size_t)i * ldw]; }
    bf16_t* dst = WT + (size_t)drow * ldt + k0;
#pragma unroll
    for (int j = 0; j < 8; ++j) { u32x4 o; o.x = pk2(v[8 * j], v[8 * j + 1]); o.y = pk2(v[8 * j + 2], v[8 * j + 3]); o.z = pk2(v[8 * j + 4], v[8 * j + 5]); o.w = pk2(v[8 * j + 6], v[8 * j + 7]);
        *(u32x4*)(dst + 8 * j) = o; }
}
template <int QS>
__device__ __forceinline__ void p0_transpose_item8(const float* W, int ldw, int k0, int c0, unsigned char* WT, int ldt, int drow, int lane) {
    const float* src = W + (size_t)k0 * ldw + c0 + lane;
    float v[64];
#pragma unroll
    for (int i = 0; i < 64; ++i) v[i] = src[(size_t)i * ldw] * (float)QS;
    unsigned char* dst = WT + (size_t)drow * ldt + k0;
#pragma unroll
    for (int j = 0; j < 4; ++j) { u32x4 o; o.x = pk4f8(v[16 * j], v[16 * j + 1], v[16 * j + 2], v[16 * j + 3]); o.y = pk4f8(v[16 * j + 4], v[16 * j + 5], v[16 * j + 6], v[16 * j + 7]);
        o.z = pk4f8(v[16 * j + 8], v[16 * j + 9], v[16 * j + 10], v[16 * j + 11]); o.w = pk4f8(v[16 * j + 12], v[16 * j + 13], v[16 * j + 14], v[16 * j + 15]);
        *(u32x4*)(dst + 16 * j) = o; }
}

constexpr int CW_CONVQ = 12288 + 128;
constexpr int MOE_I_GE = 16 * 56, MOE_I_DE = 56 * 16, MOE_ITEMS = NE * (2 * MOE_I_GE + MOE_I_DE), MOE_BATCHES = MOE_ITEMS / 8;
__device__ __forceinline__ void moe_convert_batch(Frame& F, int which, int idx) {
    const float* const* in = F.in; const int ln = F.lane;
    int r = idx * 8 + F.wave;
    if (which == 0) { const int e = r / (2 * MOE_I_GE); r %= (2 * MOE_I_GE); const int up = r / MOE_I_GE; r %= MOE_I_GE; const int kb = r / 56, nb = r % 56, c0 = 64 * nb;
        p0_transpose_item8<QGU>(in[up ? 18 : 17] + (size_t)e * D * DFFE, DFFE, 64 * kb, c0, F.ws + WS_WGUE + (size_t)e * 2 * DFFE * D, D, (c0 >> 7) * 256 + up * 128 + (c0 & 127) + ln, ln); }
    else { const int e = r / MOE_I_DE; r %= MOE_I_DE; const int kb = r / 16, nb = r % 16;
        p0_transpose_item8<QDN>(in[19] + (size_t)e * DFFE * D, D, 64 * kb, 64 * nb, F.ws + WS_WDE + (size_t)e * D * DFFE, DFFE, 64 * nb + ln, ln); }
}
__device__ __forceinline__ void moe_convert(Frame& F, int which) {
    volatile LAS unsigned* lw = (volatile LAS unsigned*)(F.lds + MISC_OFF) + 20;
    unsigned* q = (unsigned*)(F.ws + WS_CTL) + CW_CONVQ + 64 * which;
    const int nb = which == 0 ? NE * 2 * MOE_I_GE / 8 : NE * MOE_I_DE / 8;
    for (;;) {
        __syncthreads();
        if (F.tid == 0) lw[0] = __hip_atomic_fetch_add(q, 1u, __ATOMIC_RELAXED, __HIP_MEMORY_SCOPE_AGENT);
        __syncthreads();
        const int idx = (int)lw[0];
        if (idx >= nb) break;
        moe_convert_batch(F, which, idx);
    }
    __syncthreads();
}

__device__ __forceinline__ void p0_prologue(Frame& F) {
    const float* const* in = F.in;
    const int gw = F.bx * NWAVES + F.wave, NGW = F.G * NWAVES;
    {
        constexpr int I_IN = 16 * 44, I_O = 16 * 16, I_GD = 16 * 44, I_DD = 44 * 16;
        constexpr int N_A = 2 * I_IN + 2 * I_O + 2 * I_GD + I_DD;
        const int ln = F.lane;
        for (int it = gw; it < N_A; it += NGW) {
            int r = it;
            if (r < 2 * I_IN) { const int l = r / I_IN; r %= I_IN; const int kb = r / 44, nb = r % 44, c0 = 512 + 64 * nb;
                const int n32 = ln & 31; const int dn = c0 < OFFV ? (ln & 32) + ((n32 < 16) ? 2 * n32 : 2 * (n32 - 16) + 1) : ln;
                int drow = c0 + dn;
                if (c0 >= OFFG) { const int gcol = c0 - OFFG; drow = gcol < D ? OFFG + (gcol >> 7) * 256 + (gcol & 127) + ln : OFFG + ((gcol - D) >> 7) * 256 + 128 + ((gcol - D) & 127) + ln; }
                p0_transpose_item(in[8] + (size_t)l * D * INW, INW, 64 * kb, c0, (bf16_t*)(F.ws + (l ? WS_WIN1 : WS_WIN0)), D, drow, ln); continue; }
            r -= 2 * I_IN;
            if (r < 2 * I_O) { const int l = r / I_O; r %= I_O; const int kb = r / 16, nb = r % 16;
                p0_transpose_item(in[12] + (size_t)l * D * D, D, 64 * kb, 64 * nb, (bf16_t*)(F.ws + (l ? WS_WO1 : WS_WO0)), D, 64 * nb + ln, ln); continue; }
            r -= 2 * I_O;
            if (r < 2 * I_GD) { const int up = r / I_GD; r %= I_GD; const int kb = r / 44, nb = r % 44, c0 = 64 * nb;
                p0_transpose_item(in[up ? 14 : 13], DFF0, 64 * kb, c0, (bf16_t*)(F.ws + WS_WGUD), D, (c0 >> 7) * 256 + up * 128 + (c0 & 127) + ln, ln); continue; }
            r -= 2 * I_GD;
            { const int kb = r / 16, nb = r % 16;
              p0_transpose_item(in[15], D, 64 * kb, 64 * nb, (bf16_t*)(F.ws + WS_WDD), DFF0, 64 * nb + ln, ln); }
        }
    }
    __syncthreads();
    {
        LAS float* wrow = (LAS float*)F.lds;
        LAS float* ctab = wrow + 4096;
        if (F.tid < 128) ctab[F.tid] = cospif((float)F.tid / 64.0f);
        for (int it = F.bx; it < 2 * 128; it += F.G) {
            const int l = it >> 7, d0 = (it & 127) * 8;
            __syncthreads();
            for (int i = F.tid; i < 4096; i += NTHR) wrow[i] = in[8][(size_t)l * D * INW + (size_t)(d0 + (i >> 9)) * INW + (i & 511)];
            __syncthreads();
            const int r = F.tid, j = r >> 1, ri = r & 1, g = j >> 6, jj = j & 63;
            float a[8];
#pragma unroll
            for (int q = 0; q < 8; ++q) a[q] = 0.f;
            for (int cc = 0; cc < 128; ++cc) {
                float cf;
                if (jj == 0) cf = ri ? ((cc & 1) ? -1.f : 1.f) : 1.f;
                else { const int idx = (cc * jj) & 127; cf = ri ? -ctab[(idx - 32) & 127] : ctab[idx]; }
#pragma unroll
                for (int q = 0; q < 8; ++q) a[q] += cf * wrow[q * 512 + g * 128 + cc];
            }
            u32x4 o; o.x = pk2(a[0], a[1]); o.y = pk2(a[2], a[3]); o.z = pk2(a[4], a[5]); o.w = pk2(a[6], a[7]);
            *(u32x4*)((bf16_t*)(F.ws + (l ? WS_WIN1 : WS_WIN0)) + (size_t)r * D + d0) = o;
        }
        __syncthreads();
    }
    const int gt = F.bx * NTHR + F.tid, NGT = F.G * NTHR;
    for (int it = gt; it < 2 * 1024 * 144; it += NGT) {
        const int l = it / (1024 * 144), r = it % (1024 * 144), kc = r / 1024, o = r % 1024;
        const float* wf = in[10] + (size_t)l * 512 * D; const float* wa = in[11] + (size_t)l * 512 * D;
        float v[8];
#pragma unroll
        for (int q = 0; q < 8; ++q) { const int k = kc * 8 + q; float x = 0.f;
            if (k < 512) { const int mm = k & 127; x = wf[(size_t)k * D + o] * ((mm == 0 || mm == 64) ? 0.5f : 1.f); }
            else if (k < 520) { const int gg = (k - 512) >> 1, sgn = (k - 512) & 1; x = 0.5f * wf[(size_t)(gg * 128 + 64 * sgn) * D + o]; }
            else if (k >= 640) x = wa[(size_t)(k - 640) * D + o];
            v[q] = x; }
        u32x4 w; w.x = pk2(v[0], v[1]); w.y = pk2(v[2], v[3]); w.z = pk2(v[4], v[5]); w.w = pk2(v[6], v[7]);
        *(u32x4*)((bf16_t*)(F.ws + (l ? WS_WM1 : WS_WM0)) + (size_t)o * KM + kc * 8) = w;
    }
    for (int it = gt; it < 192 * 16; it += NGT) {
        const int i = it & 15, p = it >> 4, pos = p < 128 ? p : p - 128;
        const float inv = powf(10000.0f, -(float)i / 16.0f), a = (float)pos * inv;
        ((f32x2*)(F.ws + WS_ROPE))[it] = (f32x2){cosf(a), sinf(a)};
    }
    for (int it = gt; it < 128 * 64; it += NGT) {
        const int t2 = it >> 6, k1 = it & 63; float s, c; sincospif((float)(t2 * k1) / 4096.0f, &s, &c);
        ((f32x2*)(F.ws + WS_TW))[it] = (f32x2){c, s};
    }
    for (int it = gt; it < 256 * 128; it += NGT) {
        const int nu = it >> 7, ka = it & 127; float v = 0.f;
        if (nu < 128) { const int k1 = nu >> 1, ro = nu & 1, ri = ka >> 6, t1 = ka & 63; float s, c; sincospif((float)((t1 * k1) & 63) / 32.0f, &s, &c);
            v = ro == 0 ? (ri == 0 ? c : s) : (ri == 0 ? -s : c); }
        ((bf16_t*)(F.ws + WS_FA64))[it] = (bf16_t)f2bf(v);
    }
    for (int it = gt; it < 256 * 256; it += NGT) {
        const int mu = it >> 8, la = it & 255, k2 = mu >> 1, ro = mu & 1, ri = la >> 7, t2 = la & 127; float s, c; sincospif((float)((t2 * k2) & 127) / 64.0f, &s, &c);
        const float v = (ro == 0 ? (ri == 0 ? c : s) : (ri == 0 ? -s : c)) * 0.0009765625f;
        ((bf16_t*)(F.ws + WS_TC))[it] = (bf16_t)f2bf(v);
    }
    for (int it = gt; it < 512 * 512; it += NGT) {
        const int mu = it >> 9, la = it & 511, k = mu >> 1, ro = mu & 1, ri = la >> 8, t = la & 255; float s, c; sincospif((float)((t * k) & 255) / 128.0f, &s, &c);
        const float v = (ro == 0 ? (ri == 0 ? c : s) : (ri == 0 ? -s : c)) * 0.005524271728019903f;
        ((bf16_t*)(F.ws + WS_TX))[it] = (bf16_t)f2bf(v);
    }
    __syncthreads();
    {
        LAS float* sl = (LAS float*)F.lds;
        LAS float* part = sl + 3 * D;
        for (int i = F.tid; i < 3 * D; i += NTHR) { const float c = i < 2 * D ? in[1][i] : in[3][i - 2 * D]; sl[i] = c / (1.0f + __expf(-c)); }
        __syncthreads();
        for (int it = F.bx; it < 2 * 96; it += F.G) {
            const int l = it / 96, n = (it % 96) * 64 + F.lane;
            const float* wm = in[4] + (size_t)l * D * MODSZ + (size_t)(F.wave * 128) * MODSZ + n;
            float a0 = 0.f, a1 = 0.f, a2 = 0.f;
#pragma unroll
            for (int d0 = 0; d0 < 128; d0 += 32) { float w[32];
#pragma unroll
                for (int q = 0; q < 32; ++q) w[q] = wm[(size_t)(d0 + q) * MODSZ];
#pragma unroll
                for (int q = 0; q < 32; ++q) { const int d = F.wave * 128 + d0 + q; a0 += sl[d] * w[q]; a1 += sl[D + d] * w[q]; a2 += sl[2 * D + d] * w[q]; } }
            __syncthreads();
            part[(F.wave * 3 + 0) * 64 + F.lane] = a0; part[(F.wave * 3 + 1) * 64 + F.lane] = a1; part[(F.wave * 3 + 2) * 64 + F.lane] = a2;
            __syncthreads();
            if (F.tid < 192) { const int v = F.tid >> 6, ln = F.tid & 63; float sacc = in[5][l * MODSZ + (it % 96) * 64 + ln];
#pragma unroll
                for (int w = 0; w < 8; ++w) sacc += part[(w * 3 + v) * 64 + ln];
                modp(F, l, v)[(it % 96) * 64 + ln] = sacc; }
        }
    }
    for (int it = gt; it < NTOK * 15; it += NGT) { const int row = it / 15, c = it % 15;
        *(u32x4*)((bf16_t*)(F.ws + WS_FO) + (size_t)row * KM + 520 + c * 8) = (u32x4){0u, 0u, 0u, 0u}; }
}

__device__ __forceinline__ const float* xrow_ptr(const Frame& F, int row, const float* xl) { return row < NL ? xl + (size_t)row * D : (const float*)(F.ws + WS_XC) + (size_t)(row - NL) * D; }

template <bool ROUTE>
__device__ __forceinline__ void norm_phase(Frame& F, int l, int which  , const float* xl, const float* xc, int nrows, const float* xcadd = nullptr, float* xcwb = nullptr) {
    const float* gvec = F.in[which ? 7 : 6] + l * D;
    LAS float* wr_l = (LAS float*)F.lds;
    if (ROUTE) { for (int i = F.tid; i < D * NE; i += NTHR) wr_l[i] = F.in[16][i]; __syncthreads(); }
    const int gw = F.bx * NWAVES + F.wave, NGW = F.G * NWAVES;
    for (int row = gw; row < nrows; row += NGW) {
        const int v = row < T ? 0 : (row < NL ? 1 : 2);
        const bool fromb = row < NL && xl == nullptr;
        const float* xr = row < NL ? (fromb ? xc : xl + (size_t)row * D) : xc + (size_t)(row - NL) * D;
        const bf16_t* xbr = (const bf16_t*)(F.ws + WS_XB) + (size_t)row * D;
        const float* sh = modp(F, l, v) + (which ? 3 : 0) * D; const float* sc = sh + D;
        f32x4 x[4]; float s = 0.f;
#pragma unroll
        for (int j = 0; j < 4; ++j) {
            if (fromb) { const u32x2 xb = *(const u32x2*)(xbr + 256 * j + 4 * F.lane); x[j] = (f32x4){bflo(xb.x), bfhi(xb.x), bflo(xb.y), bfhi(xb.y)}; }
            else x[j] = *(const f32x4*)(xr + 256 * j + 4 * F.lane);
            if (row >= NL && xcadd) { x[j] = x[j] + *(const f32x4*)(xcadd + (size_t)(row - NL) * D + 256 * j + 4 * F.lane); if (xcwb) *(f32x4*)(xcwb + (size_t)(row - NL) * D + 256 * j + 4 * F.lane) = x[j]; }
            s += (x[j].x * x[j].x + x[j].y * x[j].y) + (x[j].z * x[j].z + x[j].w * x[j].w); }
        const float r = 1.0f / sqrtf(wave_sum(s) * (1.f / D) + EPS);
        float lg[NE];
        if (ROUTE) {
#pragma unroll
            for (int e = 0; e < NE; ++e) lg[e] = 0.f; }
        bf16_t* hr = (bf16_t*)(F.ws + WS_H) + (size_t)row * D;
#pragma unroll
        for (int j = 0; j < 4; ++j) { const int c = 256 * j + 4 * F.lane;
            const f32x4 gg = *(const f32x4*)(gvec + c), s4 = *(const f32x4*)(sh + c), c4 = *(const f32x4*)(sc + c);
            f32x4 h = (x[j] * r) * gg; h = h * (c4 + 1.0f) + s4;
            if (ROUTE) *(unsigned*)((unsigned char*)(F.ws + WS_H) + (size_t)row * D + c) = pk4f8(h.x, h.y, h.z, h.w);
            else { u32x2 o; o.x = pk2(h.x, h.y); o.y = pk2(h.z, h.w); *(u32x2*)(hr + c) = o; }
            if (ROUTE) {
#pragma unroll
                for (int q = 0; q < 4; ++q) { const float hv = h[q]; const LAS f32x4* w = (const LAS f32x4*)(wr_l + (c + q) * NE); const f32x4 w0 = w[0], w1 = w[1];
                    lg[0] += hv * w0.x; lg[1] += hv * w0.y; lg[2] += hv * w0.z; lg[3] += hv * w0.w; lg[4] += hv * w1.x; lg[5] += hv * w1.y; lg[6] += hv * w1.z; lg[7] += hv * w1.w; } }
        }
        if (ROUTE) {
#pragma unroll
            for (int e = 0; e < NE; ++e) lg[e] = wave_sum(lg[e]);
            if (F.lane == 0) {
                int e1 = 0; float v1 = lg[0];
#pragma unroll
                for (int e = 1; e < NE; ++e) if (lg[e] > v1) { v1 = lg[e]; e1 = e; }
                int e2 = -1; float v2 = -3.0e38f;
#pragma unroll
                for (int e = 0; e < NE; ++e) if (e != e1 && lg[e] > v2) { v2 = lg[e]; e2 = e; }
                const float p2 = __expf(v2 - v1), w1 = 1.f / (1.f + p2), w2 = p2 * w1;
                unsigned* cnt = (unsigned*)(F.ws + WS_CTL) + CW_CNT;
                const unsigned r1 = atomicAdd(cnt + 64 * e1, 1u), r2 = atomicAdd(cnt + 64 * e2, 1u);
                int* toke = (int*)(F.ws + WS_TOKE); int* tokr = (int*)(F.ws + WS_TOKR); float* tokw = (float*)(F.ws + WS_TOKW); int* list = (int*)(F.ws + WS_LIST);
                toke[2 * row] = e1; toke[2 * row + 1] = e2; tokr[2 * row] = (int)r1; tokr[2 * row + 1] = (int)r2; tokw[2 * row] = w1; tokw[2 * row + 1] = w2;
                list[e1 * NL + r1] = row; list[e2 * NL + r2] = row;
            }
        }
    }
}

constexpr int TAILQ_ROWS = 8 * 256;
__device__ __forceinline__ int moe_tail_panels(const unsigned* cw, int G) { int ptot = 0, plast = 0;
#pragma unroll
    for (int e = 0; e < NE; ++e) { const int p_ = ((int)cw[64 * e] + 255) >> 8; ptot += p_; plast = p_; }
    const int left = (4 * ptot) % G; int t = (left + 3) >> 2; if (4 * ptot < G) t = 0; if (t > plast) t = plast; if (t > 8) t = 8; return t; }
__device__ __forceinline__ void final_phase(Frame& F) {
    int t_ = threadIdx.x; asm volatile("" : "+v"(t_)); const int lane_ = t_ & 63;
    const int gw = F.bx * NWAVES + F.wave, NGW = F.G * NWAVES;
    const unsigned* cnt = (const unsigned*)(F.ws + WS_CTL) + CW_CNT;
    int base[NE]; { int b = 0;
#pragma unroll
        for (int e = 0; e < NE; ++e) { base[e] = b; b += ((int)cnt[64 * e] + 255) & ~255; } }
    const int* toke = (const int*)(F.ws + WS_TOKE); const int* tokr = (const int*)(F.ws + WS_TOKR); const float* tokw = (const float*)(F.ws + WS_TOKW);
    const bf16_t* dout = (const bf16_t*)(F.ws + WS_DOUT); const bf16_t* tq = (const bf16_t*)(F.ws + WS_DOUT1);
    const int trim_ = moe_tail_panels(cnt, F.G), trow0 = trim_ > 0 ? base[NE - 1] + ((((int)cnt[64 * (NE - 1)] + 255) >> 8) - trim_) * 256 : 0x7fffffff;
    for (int row = gw; row < NL; row += NGW) {
        const int v = row < T ? 0 : 1;
        const float* ga2 = modp(F, 1, v) + 5 * D;
        const int e1 = toke[2 * row], e2 = toke[2 * row + 1];
        int b1 = 0, b2 = 0;
#pragma unroll
        for (int e = 0; e < NE; ++e) { if (e == e1) b1 = base[e]; if (e == e2) b2 = base[e]; }
        const bf16_t* d1 = dout + (size_t)(b1 + tokr[2 * row]) * D; const bf16_t* d2 = dout + (size_t)(b2 + tokr[2 * row + 1]) * D;
        const int r1_ = b1 + tokr[2 * row], r2_ = b2 + tokr[2 * row + 1];
        const bool t1 = r1_ >= trow0, t2 = r2_ >= trow0;
        const bf16_t* q1 = tq + (size_t)(t1 ? r1_ - trow0 : 0) * D; const bf16_t* q2 = tq + (size_t)(t2 ? r2_ - trow0 : 0) * D;
        const float w1 = tokw[2 * row], w2 = tokw[2 * row + 1];
        float* xr = F.out + (size_t)row * D;
        f32x4 x[4]; float s = 0.f;
#pragma unroll
        for (int j = 0; j < 4; ++j) { const int c = 256 * j + 4 * lane_;
            const u32x2 a = *(const u32x2*)(d1 + c), b = *(const u32x2*)(d2 + c); const f32x4 g4 = *(const f32x4*)(ga2 + c);
            f32x4 ya = (f32x4){bflo(a.x), bfhi(a.x), bflo(a.y), bfhi(a.y)}, yb = (f32x4){bflo(b.x), bfhi(b.x), bflo(b.y), bfhi(b.y)};
            if (t1) {
#pragma unroll
                for (int k = 0; k < 1; ++k) { const u32x2 e_ = *(const u32x2*)(q1 + (size_t)k * TAILQ_ROWS * D + c); ya = ya + (f32x4){bflo(e_.x), bfhi(e_.x), bflo(e_.y), bfhi(e_.y)}; } }
            if (t2) {
#pragma unroll
                for (int k = 0; k < 1; ++k) { const u32x2 e_ = *(const u32x2*)(q2 + (size_t)k * TAILQ_ROWS * D + c); yb = yb + (f32x4){bflo(e_.x), bfhi(e_.x), bflo(e_.y), bfhi(e_.y)}; } }
            const f32x4 y = (ya * w1 + yb * w2) * (1.0f / (float)(QDN * QACT));
            { const u32x2 xb = *(const u32x2*)((const bf16_t*)(F.ws + WS_XB) + (size_t)row * D + c); x[j] = (f32x4){bflo(xb.x), bfhi(xb.x), bflo(xb.y), bfhi(xb.y)} + g4 * y; }
            s += (x[j].x * x[j].x + x[j].y * x[j].y) + (x[j].z * x[j].z + x[j].w * x[j].w); }
        const float r = 1.0f / sqrtf(wave_sum(s) * (1.f / D) + EPS);
#pragma unroll
        for (int j = 0; j < 4; ++j) { const int c = 256 * j + 4 * lane_; *(f32x4*)(xr + c) = (x[j] * r) * *(const f32x4*)(F.in[20] + c); }
    }
}

struct GridSched { int nM, nN, G, c; unsigned abytes, bbytes;
    __device__ __forceinline__ bool next(int i, Unit& u) const { const int L = i * G + c; if (L >= nM * nN) return false; pg8::swz_map(L, nM, nN, u.pm, u.pn); u.aoff = (unsigned)u.pm * abytes; u.boff = (unsigned)u.pn * bbytes; u.kind = 0; u.x0 = 0; u.x1 = 0; u.kh = 0; return true; } };

struct CtxSched { int G, c, nN; unsigned abytes, bbytes; int ksplit; unsigned khbytes;
    __device__ __forceinline__ bool next(int i, Unit& u) const { int L = i * G + c; if (L >= 2 * nN * ksplit) return false; u.kh = L / (2 * nN); L -= u.kh * 2 * nN; u.pm = 64 + L / nN; u.pn = L % nN;
        u.aoff = (unsigned)u.pm * abytes + (unsigned)u.kh * khbytes; u.boff = (unsigned)u.pn * bbytes + (unsigned)u.kh * khbytes; u.kind = 0; u.x0 = u.pm * 256; u.x1 = 0; return true; } };

struct InprojSched { int G, c, l;
    __device__ __forceinline__ bool next(int i, Unit& u) const { const int L = i * G + c; const int nmain = 64 * 11;
        if (L < nmain) { pg8::swz_map(L, 64, 11, u.pm, u.pn); }
        else { const int r = L - nmain; if (l == 0) { if (r >= 22) return false; u.pm = 64 + r / 11; u.pn = r % 11; } else { if (r >= 2) return false; u.pm = 64 + r; u.pn = 2; } }
        u.aoff = (unsigned)u.pm * (256u * D * 2u); u.boff = (unsigned)u.pn * (256u * D * 2u); u.kind = 0; u.x0 = 0; u.x1 = 0; u.kh = 0; return true; } };

struct EpiInproj {
    static constexpr bool PERM = true; static constexpr int MIDK = 0;
    unsigned char* ws;
    __device__ __forceinline__ void operator()(const f32x4 (&acc)[2][2][4][2], const Unit& u, int wr, int wc, int fr, int fq) const {
        const int row0 = u.pm * 256 + wr * 64 + fr;
        const bool lat = u.pm < 64;
        const f32x2* rope = (const f32x2*)(ws + WS_ROPE);
#pragma unroll
        for (int ai = 0; ai < 2; ++ai)
#pragma unroll
            for (int m = 0; m < 4; ++m) {
                const int row = row0 + ai * 128 + m * 16;
                const int t = row & (T - 1), prow = t >> 6, pcol = t & 63;
#pragma unroll
                for (int bj = 0; bj < 2; ++bj) {
                    const int cl = u.pn * 256 + bj * 128 + wc * 32 + 8 * fq;
                    f32x4 v0 = acc[ai][bj][m][0], v1 = acc[ai][bj][m][1];
                    bf16_t* dst;
                    if (cl < 640) {
                        if (lat) { const int dh = cl & 63, i0 = (dh & 31) >> 1; const f32x2* rp = rope + ((dh < 32 ? prow : 128 + pcol) * 16 + i0);
                            const f32x2 c0 = rp[0], c1 = rp[1], c2 = rp[2], c3 = rp[3];
                            f32x4 w0, w1; w0.x = v0.x * c0.x - v0.y * c0.y; w0.y = v0.x * c0.y + v0.y * c0.x; w0.z = v0.z * c1.x - v0.w * c1.y; w0.w = v0.z * c1.y + v0.w * c1.x;
                            w1.x = v1.x * c2.x - v1.y * c2.y; w1.y = v1.x * c2.y + v1.y * c2.x; w1.z = v1.z * c3.x - v1.w * c3.y; w1.w = v1.z * c3.y + v1.w * c3.x; v0 = w0; v1 = w1; }
                        if (cl < 512) { v0 = v0 * QSCALE; v1 = v1 * QSCALE; dst = (bf16_t*)(ws + WS_Q) + (size_t)row * 512 + cl; }
                        else dst = (bf16_t*)(ws + WS_KB) + (size_t)row * 128 + (cl - 512);
                    } else if (cl < 768) { dst = (bf16_t*)(ws + WS_VB) + (size_t)row * 128 + (cl - 640); }
                    else {
                        const int oc = (u.pn - 3) * 128 + wc * 32 + 8 * fq;
                        if (bj == 0) { const f32x4 a0 = acc[ai][1][m][0], a1 = acc[ai][1][m][1];
#pragma unroll
                            for (int q = 0; q < 4; ++q) { v0[q] = sigmoidf_(v0[q]) * (1.0f + __builtin_amdgcn_exp2f(-a0[q] * LOG2E)); v1[q] = sigmoidf_(v1[q]) * (1.0f + __builtin_amdgcn_exp2f(-a1[q] * LOG2E)); }
                            dst = (bf16_t*)(ws + WS_GF) + (size_t)row * D + oc; }
                        else {
#pragma unroll
                            for (int q = 0; q < 4; ++q) { v0[q] = sigmoidf_(v0[q]); v1[q] = sigmoidf_(v1[q]); }
                            dst = (bf16_t*)(ws + WS_GA) + (size_t)row * D + oc; } }
                    u32x4 w; w.x = cvt_pk_bf16(v0[0], v0[1]); w.y = cvt_pk_bf16(v0[2], v0[3]); w.z = cvt_pk_bf16(v1[0], v1[1]); w.w = cvt_pk_bf16(v1[2], v1[3]);
                    *(u32x4*)dst = w;
                }
            }
    }
};

struct UpermSched { int G, c, l;
    __device__ __forceinline__ bool next(int i, Unit& u) const { const int L = i * G + c; const int nn = l == 0 ? 66 : 64; if (L >= 2 * nn) return false;
        u.pm = L & 1; u.pn = L >> 1; u.aoff = (unsigned)u.pm * (256u * D * 2u); u.boff = 0; u.kind = 0; u.x0 = 0; u.x1 = 0; u.kh = 0; return true; } };
struct UpermRows { static constexpr bool GA = false, GB = true;
    __device__ __forceinline__ unsigned arow(const Unit&, int) const { return 0u; }
    __device__ __forceinline__ unsigned brow(const Unit& u, int c) const { const int n = u.pn; int row;
        if (n < 64) { const int b = n >> 5, q = n & 31; row = b * T + 128 * (c & 63) + 4 * q + (c >> 6); } else row = NL + (n - 64) * 256 + c;
        return (unsigned)row * (D * 2u); } };
struct EpiUperm {
    static constexpr bool PERM = true; static constexpr int MIDK = 0;
    unsigned char* ws;
    __device__ __forceinline__ void operator()(const f32x4 (&acc)[2][2][4][2], const Unit& u, int wr, int wc, int fr, int fq) const {
        const int n = u.pn;
#pragma unroll
        for (int ai = 0; ai < 2; ++ai)
#pragma unroll
            for (int m = 0; m < 4; ++m) { const int r = u.pm * 256 + ai * 128 + wr * 64 + m * 16 + fr, j = r >> 1, ri = r & 1;
#pragma unroll
                for (int bj = 0; bj < 2; ++bj) { const int c = bj * 128 + wc * 32 + 8 * fq;
                    const f32x4 v0 = acc[ai][bj][m][0], v1 = acc[ai][bj][m][1];
                    u32x4 w; w.x = cvt_pk_bf16(v0[0], v0[1]); w.y = cvt_pk_bf16(v0[2], v0[3]); w.z = cvt_pk_bf16(v1[0], v1[1]); w.w = cvt_pk_bf16(v1[2], v1[3]);
                    bf16_t* dst;
                    if (n < 64) { const int b = n >> 5, q = n & 31, t2 = 4 * q + (c >> 6), t1 = c & 63; dst = (bf16_t*)(ws + WS_UP) + ((size_t)((j * 2 + b) * 128 + t2) * 128 + ri * 64 + t1); }
                    else { const int b = n - 64; dst = (bf16_t*)(ws + WS_VCT) + ((size_t)((b * 256 + j) * 2 + ri) * 256 + c); }
                    *(u32x4*)dst = w; } }
    }
};

struct StepASched { int G, c, l;
    __device__ __forceinline__ bool next(int i, Unit& u) const { int L = i * G + c;
        if (l == 0 && G == 256) { if (c >= 16 && c < 20) return false; if (c >= 20 && c < 24) { if (i > 1) return false; L = i == 0 ? c : c - 4; } else if (i > 0) return false; }
        if (L >= 256) return false; pg8::swz_map(L, 256, 1, u.pm, u.pn); u.aoff = (unsigned)u.pm * (256u * 128u * 2u); u.boff = 0u; u.kind = 0; u.x0 = 0; u.x1 = 0; u.kh = 0; return true; } };

struct EpiStepA {
    static constexpr bool PERM = true; static constexpr int MIDK = 0;
    unsigned char* ws;
    __device__ __forceinline__ void operator()(const f32x4 (&acc)[2][2][4][2], const Unit& u, int wr, int wc, int fr, int fq) const {
        const f32x2* tw = (const f32x2*)(ws + WS_TW); bf16_t* gp = (bf16_t*)(ws + WS_GP);
        const int j = u.pm;
#pragma unroll
        for (int ai = 0; ai < 2; ++ai)
#pragma unroll
            for (int m = 0; m < 4; ++m) { const int t2 = wr * 64 + m * 16 + fr, b = ai;
#pragma unroll
                for (int n = 0; n < 2; ++n) { const f32x4 v = acc[ai][0][m][n];
#pragma unroll
                    for (int p = 0; p < 2; ++p) { const int k1 = 16 * wc + 4 * fq + 2 * n + p; const f32x2 w = tw[t2 * 64 + k1];
                        const float gr = v[2 * p], gi = v[2 * p + 1];
                        const float orr = gr * w.x + gi * w.y, oi = gi * w.x - gr * w.y;
                        bf16_t* d = gp + ((size_t)((b * 64 + k1) * 256 + j) * 256 + t2);
                        d[0] = (bf16_t)f2bf(orr); d[128] = (bf16_t)f2bf(oi); } } }
    }
};
template <bool CTXV> struct EpiStepC {
    static constexpr bool PERM = true; static constexpr int MIDK = 0;
    unsigned char* ws;
    __device__ __forceinline__ void operator()(const f32x4 (&acc)[2][2][4][2], const Unit& u, int wr_, int wc_, int fr_, int fq_) const {
        int wr = wr_, wc = wc_, fr = fr_, fq = fq_, upm = u.pm, upn = u.pn;
        asm volatile("" : "+s"(wr), "+s"(wc), "+v"(fr), "+v"(fq), "+s"(upm), "+s"(upn));
        bf16_t* fo = (bf16_t*)(ws + WS_FO);
        const int NN = CTXV ? 256 : T;
        const int b = CTXV ? upm : (upm >> 6), k1 = CTXV ? 0 : (upm & 63), rowb = CTXV ? NL + b * 256 : b * T;
        const int own0 = wr * 128 + fr, mir0 = wr * 128 + 128 - fr;
        const int kk0 = (CTXV ? 128 * upn : 0) + 16 * wc + 4 * fq;
#pragma unroll
        for (int bj = 0; bj < 2; ++bj)
#pragma unroll
            for (int n = 0; n < 2; ++n)
#pragma unroll
                for (int p = 0; p < 2; ++p) {
                    const int kk = kk0 + 64 * bj + 2 * n + p;
                    const int k = CTXV ? kk : (k1 + 64 * kk), km = (NN - k) & (NN - 1);
                    const unsigned oo = (unsigned)(rowb + k) * KM, om = (unsigned)(rowb + km) * KM;
#pragma unroll
                    for (int ai = 0; ai < 2; ++ai)
#pragma unroll
                        for (int m = 0; m < 4; ++m) {
                            const f32x4 v = acc[ai][bj][m][n];
                            const bf16_t re = (bf16_t)f2bf(v[2 * p]);
                            if (m == 0 && fr == 0) { const int g = 2 * ai + wr; const bf16_t im = (bf16_t)f2bf(v[2 * p + 1]);
                                fo[oo + g * 128] = re; fo[om + 512 + 2 * g] = re; fo[oo + g * 128 + 64] = im; fo[om + 512 + 2 * g + 1] = im; }
                            else { fo[oo + own0 + ai * 256 + 16 * m] = re; fo[om + mir0 + ai * 256 - 16 * m] = re; }
                        }
                    asm volatile("" ::: "memory"); __builtin_amdgcn_sched_barrier(0);
                }
    }
};

struct EpiMerge {
    static constexpr bool PERM = true; static constexpr int MIDK = 10;
    unsigned char* ws;
    __device__ __forceinline__ void mid(f32x4 (&acc)[2][2][4][2], const Unit& u, int wr, int wc, int fr, int fq) const {
        asm volatile("" : "+v"(fr), "+v"(fq));
#pragma unroll
        for (int ai = 0; ai < 2; ++ai)
#pragma unroll
            for (int m = 0; m < 4; ++m) { const size_t row = (size_t)(u.pm * 256 + ai * 128 + wr * 64 + m * 16 + fr);
#pragma unroll
                for (int bj = 0; bj < 2; ++bj) { const int col = u.pn * 256 + bj * 128 + wc * 32 + 8 * fq;
                    const u32x4 gr = *(const u32x4*)((const bf16_t*)(ws + WS_GF) + row * D + col);
                    const f32x4 r0 = (f32x4){bflo(gr.x), bfhi(gr.x), bflo(gr.y), bfhi(gr.y)}, r1 = (f32x4){bflo(gr.z), bfhi(gr.z), bflo(gr.w), bfhi(gr.w)};
                    acc[ai][bj][m][0] = acc[ai][bj][m][0] * r0; acc[ai][bj][m][1] = acc[ai][bj][m][1] * r1; } }
    }
    __device__ __forceinline__ void operator()(const f32x4 (&acc)[2][2][4][2], const Unit& u, int wr, int wc, int fr, int fq) const {
#pragma unroll
        for (int ai = 0; ai < 2; ++ai)
#pragma unroll
            for (int m = 0; m < 4; ++m) { const size_t row = (size_t)(u.pm * 256 + ai * 128 + wr * 64 + m * 16 + fr);
#pragma unroll
                for (int bj = 0; bj < 2; ++bj) { const int col = u.pn * 256 + bj * 128 + wc * 32 + 8 * fq;
                    const u32x4 ga = *(const u32x4*)((const bf16_t*)(ws + WS_GA) + row * D + col);
                    const f32x4 a0 = acc[ai][bj][m][0], a1 = acc[ai][bj][m][1];
                    u32x4 w;
                    w.x = cvt_pk_bf16(bflo(ga.x) * a0[0], bfhi(ga.x) * a0[1]); w.y = cvt_pk_bf16(bflo(ga.y) * a0[2], bfhi(ga.y) * a0[3]);
                    w.z = cvt_pk_bf16(bflo(ga.z) * a1[0], bfhi(ga.z) * a1[1]); w.w = cvt_pk_bf16(bflo(ga.w) * a1[2], bfhi(ga.w) * a1[3]);
                    *(u32x4*)((bf16_t*)(ws + WS_Y) + row * D + col) = w; } }
    }
};

struct EpiResid {
    static constexpr bool PERM = true; static constexpr int MIDK = 0;
    const float* xl_in32; const bf16_t* xl_inb; bf16_t* xl_out; const float* xc_in; float* xc_out; const float* mod_l; int chunk; float* tmpc;
    __device__ __forceinline__ void operator()(const f32x4 (&acc)[2][2][4][2], const Unit& u, int wr, int wc, int fr, int fq) const {
        const int v = u.pm < 32 ? 0 : (u.pm < 64 ? 1 : 2);
        const float* gate = mod_l + v * MODSZ + chunk * D;
        const bool lat = u.pm < 64; const int rbase = lat ? u.pm * 256 : (u.pm - 64) * 256;
#pragma unroll
        for (int bj = 0; bj < 2; ++bj) { const int col = u.pn * 256 + bj * 128 + wc * 32 + 8 * fq;
            const f32x4 g0 = *(const f32x4*)(gate + col), g1 = *(const f32x4*)(gate + col + 4);
#pragma unroll
            for (int ai = 0; ai < 2; ++ai)
#pragma unroll
                for (int m = 0; m < 4; ++m) { const size_t o = (size_t)(rbase + ai * 128 + wr * 64 + m * 16 + fr) * D + col;
                    if (lat) {
                        f32x4 x0, x1;
                        if (xl_in32) { x0 = *(const f32x4*)(xl_in32 + o); x1 = *(const f32x4*)(xl_in32 + o + 4); }
                        else { const u32x4 xb = *(const u32x4*)(xl_inb + o); x0 = (f32x4){bflo(xb.x), bfhi(xb.x), bflo(xb.y), bfhi(xb.y)}; x1 = (f32x4){bflo(xb.z), bfhi(xb.z), bflo(xb.w), bfhi(xb.w)}; }
                        x0 = x0 + g0 * acc[ai][bj][m][0]; x1 = x1 + g1 * acc[ai][bj][m][1];
                        u32x4 w; w.x = cvt_pk_bf16(x0[0], x0[1]); w.y = cvt_pk_bf16(x0[2], x0[3]); w.z = cvt_pk_bf16(x1[0], x1[1]); w.w = cvt_pk_bf16(x1[2], x1[3]);
                        *(u32x4*)(xl_out + o) = w;
                    } else if (u.kh) { *(f32x4*)(tmpc + o) = g0 * acc[ai][bj][m][0]; *(f32x4*)(tmpc + o + 4) = g1 * acc[ai][bj][m][1]; }
                    else { *(f32x4*)(xc_out + o) = *(const f32x4*)(xc_in + o) + g0 * acc[ai][bj][m][0];
                           *(f32x4*)(xc_out + o + 4) = *(const f32x4*)(xc_in + o + 4) + g1 * acc[ai][bj][m][1]; } } }
    }
};

struct EpiSwiglu {
    static constexpr bool PERM = true; static constexpr int MIDK = 0;
    bf16_t* act; int ld;
    __device__ __forceinline__ void operator()(const f32x4 (&acc)[2][2][4][2], const Unit& u, int wr, int wc, int fr, int fq) const {
        const int col = u.pn * 128 + wc * 32 + 8 * fq;
#pragma unroll
        for (int ai = 0; ai < 2; ++ai)
#pragma unroll
            for (int m = 0; m < 4; ++m) { const size_t row = (size_t)(u.x0 + ai * 128 + wr * 64 + m * 16 + fr);
                float o[8];
#pragma unroll
                for (int n = 0; n < 2; ++n)
#pragma unroll
                    for (int q = 0; q < 4; ++q) { const float gv = acc[ai][0][m][n][q], uv = acc[ai][1][m][n][q]; o[4 * n + q] = gv * sigmoidf_(gv) * uv; }
                u32x4 w; w.x = cvt_pk_bf16(o[0], o[1]); w.y = cvt_pk_bf16(o[2], o[3]); w.z = cvt_pk_bf16(o[4], o[5]); w.w = cvt_pk_bf16(o[6], o[7]);
                *(u32x4*)(act + row * ld + col) = w; }
    }
};
struct EpiSwiglu8 {
    static constexpr bool PERM = true; static constexpr int MIDK = 0;
    unsigned char* act; int ld;
    __device__ __forceinline__ void operator()(const f32x4 (&acc)[2][2][4][2], const Unit& u, int wr, int wc, int fr, int fq) const {
        asm volatile("" : "+v"(fr), "+v"(fq));
        const int col = u.pn * 128 + wc * 32 + 8 * fq;
#pragma unroll
        for (int ai = 0; ai < 2; ++ai)
#pragma unroll
            for (int m = 0; m < 4; ++m) { const size_t row = (size_t)(u.x0 + ai * 128 + wr * 64 + m * 16 + fr);
                float o[8];
#pragma unroll
                for (int n = 0; n < 2; ++n)
#pragma unroll
                    for (int q = 0; q < 4; ++q) { const float gv = acc[ai][0][m][n][q] * (1.0f / (float)QGU), uv = acc[ai][1][m][n][q] * ((float)QACT / (float)QGU);
                        o[4 * n + q] = __builtin_amdgcn_fmed3f(gv * sigmoidf_(gv) * uv, -448.0f, 448.0f); }
                u32x2 w; w.x = pk4f8(o[0], o[1], o[2], o[3]); w.y = pk4f8(o[4], o[5], o[6], o[7]);
                *(u32x2*)(act + row * ld + col) = w; }
    }
};
struct EpiBf16 {
    static constexpr bool PERM = true; static constexpr int MIDK = 0;
    bf16_t* O0; bf16_t* O1; int ld;
    __device__ __forceinline__ void operator()(const f32x4 (&acc)[2][2][4][2], const Unit& u, int wr, int wc, int fr, int fq) const {
        asm volatile("" : "+v"(fr), "+v"(fq));
#pragma unroll
        for (int ai = 0; ai < 2; ++ai)
#pragma unroll
            for (int m = 0; m < 4; ++m) { const size_t row = (size_t)(u.x0 + ai * 128 + wr * 64 + m * 16 + fr);
#pragma unroll
                for (int bj = 0; bj < 2; ++bj) { const int col = u.pn * 256 + bj * 128 + wc * 32 + 8 * fq; const f32x4 v0 = acc[ai][bj][m][0], v1 = acc[ai][bj][m][1];
                    u32x4 w; w.x = cvt_pk_bf16(v0[0], v0[1]); w.y = cvt_pk_bf16(v0[2], v0[3]); w.z = cvt_pk_bf16(v1[0], v1[1]); w.w = cvt_pk_bf16(v1[2], v1[3]);
                    *(u32x4*)((u.kh ? O1 : O0) + row * ld + col) = w; } }
    }
};

struct RowSched { int nM, nN, G, c; unsigned abytes, bbytes;
    __device__ __forceinline__ bool next(int i, Unit& u) const { const int L = i * G + c; if (L >= nM * nN) return false; pg8::swz_map(L, nM, nN, u.pm, u.pn); u.aoff = (unsigned)u.pm * abytes; u.boff = (unsigned)u.pn * bbytes; u.kind = 0; u.x0 = u.pm * 256; u.x1 = 0; u.kh = 0; return true; } };

struct MoeSched { int G, c, nN, ksplit, trim; unsigned bexp, bbytes, arow_bytes, khbytes; bool a_slots; int cnt[NE], base[NE];
    __device__ __forceinline__ void init(const unsigned* cw) { int b = 0;
#pragma unroll
        for (int e = 0; e < NE; ++e) { cnt[e] = (int)cw[64 * e]; base[e] = b; b += (cnt[e] + 255) & ~255; } }
    __device__ __forceinline__ bool next(int i, Unit& u) const { int L = i * G + c; int e = 0;
        for (; e < NE; ++e) { const int nu = (((cnt[e] + 255) >> 8) - (e == NE - 1 ? trim : 0)) * nN * ksplit; if (L < nu) break; L -= nu; }
        if (e >= NE) return false;
        int cn = 0, bs = 0;
#pragma unroll
        for (int q = 0; q < NE; ++q) if (q == e) { cn = cnt[q]; bs = base[q]; }
        const int np_ = ((cn + 255) >> 8) - (e == NE - 1 ? trim : 0); const int nt_ = np_ * nN; u.kh = L / nt_; L -= u.kh * nt_;
        pg8::swz_map(L, np_, nN, u.pm, u.pn);
        u.kind = e; u.x1 = cn; u.x0 = bs + u.pm * 256;
        u.aoff = (a_slots ? (unsigned)u.x0 * arow_bytes : 0u) + (unsigned)u.kh * khbytes; u.boff = (unsigned)e * bexp + (unsigned)u.pn * bbytes + (unsigned)u.kh * khbytes; return true; } };
struct MoeTailSched { int G, c, trim, plast, rbase; unsigned bexp;
    __device__ __forceinline__ bool next(int i, Unit& u) const { int L = i * G + c; if (L >= 8 * trim) return false; u.kh = L / (4 * trim); L -= u.kh * 4 * trim;
        u.pm = plast - trim + (L >> 2); u.pn = L & 3; u.kind = NE - 1; u.x1 = 0; u.x0 = rbase + u.pm * 256;
        u.aoff = (unsigned)u.x0 * (unsigned)DFFE + (unsigned)u.kh * (DFFE / 2u); u.boff = (unsigned)(NE - 1) * bexp + (unsigned)u.pn * (256u * DFFE) + (unsigned)u.kh * (DFFE / 2u); return true; } };
struct EpiTail {
    static constexpr bool PERM = true; static constexpr int MIDK = 0;
    bf16_t* O0; bf16_t* Q; int row0;
    __device__ __forceinline__ void operator()(const f32x4 (&acc)[2][2][4][2], const Unit& u, int wr, int wc, int fr, int fq) const {
        asm volatile("" : "+v"(fr), "+v"(fq));
#pragma unroll
        for (int ai = 0; ai < 2; ++ai)
#pragma unroll
            for (int m = 0; m < 4; ++m) { const int row = u.x0 + ai * 128 + wr * 64 + m * 16 + fr;
                bf16_t* dst = u.kh == 0 ? O0 + (size_t)row * D : Q + ((size_t)(u.kh - 1) * TAILQ_ROWS + (size_t)(row - row0)) * D;
#pragma unroll
                for (int bj = 0; bj < 2; ++bj) { const int col = u.pn * 256 + bj * 128 + wc * 32 + 8 * fq; const f32x4 v0 = acc[ai][bj][m][0], v1 = acc[ai][bj][m][1];
                    u32x4 w; w.x = cvt_pk_bf16(v0[0], v0[1]); w.y = cvt_pk_bf16(v0[2], v0[3]); w.z = cvt_pk_bf16(v1[0], v1[1]); w.w = cvt_pk_bf16(v1[2], v1[3]);
                    *(u32x4*)(dst + col) = w; } }
    }
};
struct MoeRows { static constexpr bool GA = true, GB = false; const int* list;
    __device__ __forceinline__ unsigned arow(const Unit& u, int r) const { int idx = u.pm * 256 + r; idx = idx < u.x1 ? idx : u.x1 - 1; return (unsigned)list[u.kind * NL + idx] * (unsigned)D; }
    __device__ __forceinline__ unsigned brow(const Unit&, int) const { return 0u; } };


constexpr int CW_QUEUE = 12288, CW_RDY = 65536;
template <int NG, bool MOE> struct FfnStream {
    int P[NG], rb[NG], cn[NG];
    int f, nNgu, Kdn; unsigned need;
    unsigned* q; volatile LAS unsigned* lw; unsigned* rdy; unsigned* tmo;
    __device__ __forceinline__ void finish_init(int G) { int sacc = 0; f = NG;
#pragma unroll
        for (int g = NG - 1; g >= 0; --g) { if (f == g + 1 && sacc + P[g] * 4 <= G) { sacc += P[g] * 4; f = g; } }
        if (f > NG - 1) f = NG - 1; }
    __device__ __forceinline__ bool decode(int L, SUnit& u) const {
        int pos = L, kind = -1, grp = 0, j = 0;
#pragma unroll
        for (int g = 0; g < NG; ++g) {
            { const int n = P[g] * nNgu; if (kind < 0) { if (pos < n) { kind = 0; grp = g; j = pos; } else pos -= n; } }
            if (g >= 1 && (g - 1) < f) { const int n = P[g - 1] * 4; if (kind < 0) { if (pos < n) { kind = 1; grp = g - 1; j = pos; } else pos -= n; } }
        }
#pragma unroll
        for (int g = 0; g < NG; ++g) if (g >= f) { const int n = P[g] * 4; if (kind < 0) { if (pos < n) { kind = 1; grp = g; j = pos; } else pos -= n; } }
        if (kind < 0) return false;
        int nM = 0, rbase = 0, cnt = 0;
#pragma unroll
        for (int g = 0; g < NG; ++g) if (g == grp) { nM = P[g]; rbase = rb[g]; cnt = cn[g]; }
        const int nN = kind == 0 ? nNgu : 4;
        const int nig = 8 * nN, gid = j / nig, fm = gid * 8, gsz = (nM - fm) < 8 ? (nM - fm) : 8;
        u.pm = fm + ((j % nig) % gsz); u.pn = (j % nig) / gsz; u.kind = kind; u.grp = grp; u.x0 = rbase + u.pm * 256; u.x1 = cnt;
        const int gp = u.x0 >> 8;
        if (kind == 0) { u.K = D; u.dep = -1; u.sig = gp;
            u.aoff = (unsigned)WS_H + (unsigned)u.x0 * (D * 2u);
            u.boff = (MOE ? (unsigned)WS_WGUE + (unsigned)grp * (2u * DFFE * D * 2u) : (unsigned)WS_WGUD) + (unsigned)u.pn * (256u * D * 2u); }
        else { u.K = Kdn; u.dep = gp; u.sig = -1;
            u.aoff = (unsigned)WS_ACT + (unsigned)u.x0 * ((unsigned)Kdn * 2u);
            u.boff = (MOE ? (unsigned)WS_WDE + (unsigned)grp * ((unsigned)D * DFFE * 2u) : (unsigned)WS_WDD) + (unsigned)u.pn * (256u * (unsigned)Kdn * 2u); }
        return true;
    }
    __device__ __forceinline__ void a_ready(const SUnit& u) const {
        if (threadIdx.x < 64) {
            const unsigned long long t0 = __builtin_amdgcn_s_memrealtime(); unsigned polls = 0;
            while ((unsigned)__builtin_amdgcn_readfirstlane(__hip_atomic_load(rdy + 64 * u.dep, __ATOMIC_RELAXED, __HIP_MEMORY_SCOPE_AGENT)) < need) {
                if ((++polls & 255u) == 0u && __builtin_amdgcn_readfirstlane(__hip_atomic_load(tmo, __ATOMIC_RELAXED, __HIP_MEMORY_SCOPE_AGENT)) != 0u) break;
                if (__builtin_amdgcn_s_memrealtime() - t0 > 2000000ull) { if (threadIdx.x == 0) __hip_atomic_store(tmo, 1u, __ATOMIC_RELAXED, __HIP_MEMORY_SCOPE_AGENT); break; }
                __builtin_amdgcn_s_sleep(2); }
            __builtin_amdgcn_fence(__ATOMIC_ACQUIRE, "agent");
            asm volatile("s_waitcnt vmcnt(0)" ::: "memory");
        }
        asm volatile("" ::: "memory"); __builtin_amdgcn_s_barrier(); asm volatile("" ::: "memory");
    }
};
template <bool MOE> struct FfnRows { const int* list;
    __device__ __forceinline__ bool a_gather(const SUnit& u) const { return MOE && u.kind == 0; }
    __device__ __forceinline__ unsigned arow(const SUnit& u, int r) const { int idx = u.pm * 256 + r; idx = idx < u.x1 ? idx : u.x1 - 1; return (unsigned)WS_H + (unsigned)list[u.grp * NL + idx] * (D * 2u); } };

template <bool MOE> struct EpiFfn {
    static constexpr bool PERM = true; static constexpr int MIDK = 0;
    unsigned char* ws; float* xl; const float* mod_l;
    __device__ __forceinline__ void operator()(const f32x4 (&acc)[2][2][4][2], const SUnit& u, int wr, int wc, int fr, int fq) const {
        if (u.kind == 0) {
            constexpr int ld = MOE ? DFFE : DFF0;
            bf16_t* act = (bf16_t*)(ws + WS_ACT);
            const int col = u.pn * 128 + wc * 32 + 8 * fq;
#pragma unroll
            for (int ai = 0; ai < 2; ++ai)
#pragma unroll
                for (int m = 0; m < 4; ++m) { const size_t row = (size_t)(u.x0 + ai * 128 + wr * 64 + m * 16 + fr);
                    float o[8];
#pragma unroll
                    for (int n = 0; n < 2; ++n)
#pragma unroll
                        for (int q = 0; q < 4; ++q) { const float gv = acc[ai][0][m][n][q], uv = acc[ai][1][m][n][q]; o[4 * n + q] = gv * sigmoidf_(gv) * uv; }
                    u32x4 w; w.x = cvt_pk_bf16(o[0], o[1]); w.y = cvt_pk_bf16(o[2], o[3]); w.z = cvt_pk_bf16(o[4], o[5]); w.w = cvt_pk_bf16(o[6], o[7]);
                    pg8::st16_wt(ws, (unsigned)WS_ACT + ((unsigned)row * (unsigned)ld + (unsigned)col) * 2u, w); }
        } else if (MOE) {
            bf16_t* O = (bf16_t*)(ws + WS_DOUT);
#pragma unroll
            for (int ai = 0; ai < 2; ++ai)
#pragma unroll
                for (int m = 0; m < 4; ++m) { const size_t row = (size_t)(u.x0 + ai * 128 + wr * 64 + m * 16 + fr);
#pragma unroll
                    for (int bj = 0; bj < 2; ++bj) { const int col = u.pn * 256 + bj * 128 + wc * 32 + 8 * fq; const f32x4 v0 = acc[ai][bj][m][0], v1 = acc[ai][bj][m][1];
                        u32x4 w; w.x = cvt_pk_bf16(v0[0], v0[1]); w.y = cvt_pk_bf16(v0[2], v0[3]); w.z = cvt_pk_bf16(v1[0], v1[1]); w.w = cvt_pk_bf16(v1[2], v1[3]);
                        *(u32x4*)(O + row * D + col) = w; } }
        } else {
            asm volatile("" : "+v"(fr), "+v"(fq));
            const int pmg = u.x0 >> 8;
            const int v = pmg < 32 ? 0 : (pmg < 64 ? 1 : 2);
            const float* gate = mod_l + v * MODSZ + 5 * D;
            float* xo = pmg < 64 ? xl + (size_t)u.x0 * D : (float*)(ws + WS_XC) + (size_t)(u.x0 - NL) * D;
#pragma unroll
            for (int bj = 0; bj < 2; ++bj) { const int col = u.pn * 256 + bj * 128 + wc * 32 + 8 * fq;
                const f32x4 g0 = *(const f32x4*)(gate + col), g1 = *(const f32x4*)(gate + col + 4);
#pragma unroll
                for (int ai = 0; ai < 2; ++ai)
#pragma unroll
                    for (int m = 0; m < 4; ++m) { const size_t o = (size_t)(ai * 128 + wr * 64 + m * 16 + fr) * D + col;
                        *(f32x4*)(xo + o) = *(const f32x4*)(xo + o) + g0 * acc[ai][bj][m][0];
                        *(f32x4*)(xo + o + 4) = *(const f32x4*)(xo + o + 4) + g1 * acc[ai][bj][m][1];
                        asm volatile("" ::: "memory"); __builtin_amdgcn_sched_barrier(0); } }
        }
    }
};

__device__ __forceinline__ int crow(int r, int hi) { return (r & 3) + 8 * (r >> 2) + 4 * hi; }
__device__ __forceinline__ s16x4 vtr(const LAS unsigned char* p) { typedef short v4i16_t __attribute__((ext_vector_type(4))); return __builtin_bit_cast(s16x4, __builtin_amdgcn_ds_read_tr16_b64_v4i16((LAS v4i16_t*)p)); }

__device__ __forceinline__ void attn_unit(Frame& F, int l, int b, int hkv, int qb, bool ctxq) {
    const int tid = F.tid, lane = F.lane, wid = F.wave, r32 = lane & 31, hi = lane >> 5;
    const int g = wid >> 1, qs = wid & 1, head = hkv * 4 + g;
    const bf16_t* Q = (const bf16_t*)(F.ws + WS_Q); const bf16_t* KB = (const bf16_t*)(F.ws + WS_KB); const bf16_t* VB = (const bf16_t*)(F.ws + WS_VB);
    const int q0 = qb * 64;
    const int qrow = (ctxq ? NL + b * CTXL : b * T) + q0 + qs * 32 + r32;
    bf16x8 qr[4];
#pragma unroll
    for (int d0 = 0; d0 < 4; ++d0) qr[d0] = *(const bf16x8*)(Q + (size_t)qrow * 512 + head * 64 + d0 * 16 + hi * 8);
    int jlo = 0, jhi = -1;
    if (!ctxq) { jlo = -2; jhi = 2; if (q0 + 64 * jlo < 0) jlo = -(q0 / 64); if (q0 + 64 * jhi >= T) jhi = (T - 64 - q0) / 64; }
    const int nloc = jhi - jlo + 1, ntile = nloc + 4;
    const float sinkv = F.in[9][l * 8 + head] * LOG2E;
    float mrun = sinkv, lrun = 1.0f;
    f32x16 o[2]; o[0] = f32x16{}; o[1] = f32x16{};
    const int kkey = lane, vkey = 16 * (wid & 3) + (lane >> 2);
    auto tile_row = [&](int ti) -> int { return ti < nloc ? b * T + q0 + 64 * (jlo + ti) : NL + b * CTXL + 64 * (ti - nloc); };
    u32x4 kreg, vreg;
    { const int r0 = tile_row(0); kreg = *(const u32x4*)(KB + (size_t)(r0 + kkey) * 128 + hkv * 64 + wid * 8); vreg = *(const u32x4*)(VB + (size_t)(r0 + vkey) * 128 + hkv * 64 + (wid >> 2) * 32 + (lane & 3) * 8); }
    for (int ti = 0; ti < ntile; ++ti) {
        LAS unsigned char* slot = F.lds + (ti & 1) * 16384;
        *(LAS u32x4*)(slot + wid * 1024 + lane * 16) = kreg;
        *(LAS u32x4*)(slot + 8192 + wid * 1024 + lane * 16) = vreg;
        __syncthreads();
        if (ti + 1 < ntile) { const int r0 = tile_row(ti + 1); kreg = *(const u32x4*)(KB + (size_t)(r0 + kkey) * 128 + hkv * 64 + wid * 8); vreg = *(const u32x4*)(VB + (size_t)(r0 + vkey) * 128 + hkv * 64 + (wid >> 2) * 32 + (lane & 3) * 8); }
        f32x16 p0 = f32x16{}, p1 = f32x16{};
        { const LAS unsigned char* kb = slot + hi * 1024 + r32 * 16;
#pragma unroll
          for (int d0 = 0; d0 < 4; ++d0) { const bf16x8 k0 = *(const LAS bf16x8*)(kb + d0 * 2048), k1 = *(const LAS bf16x8*)(kb + d0 * 2048 + 512);
              p0 = __builtin_amdgcn_mfma_f32_32x32x16_bf16(k0, qr[d0], p0, 0, 0, 0); p1 = __builtin_amdgcn_mfma_f32_32x32x16_bf16(k1, qr[d0], p1, 0, 0, 0); } }
        if (ti < nloc) { const int j = jlo + ti; const int qq = qs * 32 + r32;
            if (j == -2) {
#pragma unroll
                for (int r = 0; r < 16; ++r) { const int kk = crow(r, hi); if (kk < qq) p0[r] = -INFINITY; if (kk + 32 < qq) p1[r] = -INFINITY; } }
            else if (j == 2) {
#pragma unroll
                for (int r = 0; r < 16; ++r) { const int kk = crow(r, hi); if (kk > qq) p0[r] = -INFINITY; if (kk + 32 > qq) p1[r] = -INFINITY; } } }
        float mx = p0[0];
#pragma unroll
        for (int r = 1; r < 16; ++r) mx = fmaxf(mx, p0[r]);
#pragma unroll
        for (int r = 0; r < 16; ++r) mx = fmaxf(mx, p1[r]);
        mx = fmaxf(mx, __shfl_xor(mx, 32));
        const float mnew = fmaxf(mrun, mx), fsc = __builtin_amdgcn_exp2f(mrun - mnew);
        mrun = mnew;
        float rs = 0.f;
#pragma unroll
        for (int r = 0; r < 16; ++r) { p0[r] = __builtin_amdgcn_exp2f(p0[r] - mnew); p1[r] = __builtin_amdgcn_exp2f(p1[r] - mnew); rs += p0[r] + p1[r]; }
        rs += __shfl_xor(rs, 32);
        lrun = lrun * fsc + rs;
#pragma unroll
        for (int r = 0; r < 16; ++r) { o[0][r] *= fsc; o[1][r] *= fsc; }
        u32x4 pw[4];
        pw[0] = (u32x4){cvt_pk_bf16(p0[0], p0[1]), cvt_pk_bf16(p0[2], p0[3]), cvt_pk_bf16(p0[4], p0[5]), cvt_pk_bf16(p0[6], p0[7])};
        pw[1] = (u32x4){cvt_pk_bf16(p0[8], p0[9]), cvt_pk_bf16(p0[10], p0[11]), cvt_pk_bf16(p0[12], p0[13]), cvt_pk_bf16(p0[14], p0[15])};
        pw[2] = (u32x4){cvt_pk_bf16(p1[0], p1[1]), cvt_pk_bf16(p1[2], p1[3]), cvt_pk_bf16(p1[4], p1[5]), cvt_pk_bf16(p1[6], p1[7])};
        pw[3] = (u32x4){cvt_pk_bf16(p1[8], p1[9]), cvt_pk_bf16(p1[10], p1[11]), cvt_pk_bf16(p1[12], p1[13]), cvt_pk_bf16(p1[14], p1[15])};
        { const LAS unsigned char* vb = slot + 8192 + ((lane >> 4) & 1) * 32 + (lane & 3) * 8 + (4 * hi + ((lane & 15) >> 2)) * 64;
#pragma unroll
          for (int d0 = 0; d0 < 2; ++d0)
#pragma unroll
              for (int ks = 0; ks < 4; ++ks) { const s16x4 lo = vtr(vb + d0 * 4096 + ks * 1024), hh = vtr(vb + d0 * 4096 + ks * 1024 + 512);
                  const bf16x8 vf = (bf16x8){lo[0], lo[1], lo[2], lo[3], hh[0], hh[1], hh[2], hh[3]};
                  o[d0] = __builtin_amdgcn_mfma_f32_32x32x16_bf16(vf, __builtin_bit_cast(bf16x8, pw[ks]), o[d0], 0, 0, 0); } }
    }
    const float rl = 1.0f / lrun;
    bf16_t* orow = (bf16_t*)(F.ws + WS_FO) + (size_t)qrow * KM + 640 + head * 64;
#pragma unroll
    for (int d0 = 0; d0 < 2; ++d0)
#pragma unroll
        for (int rq = 0; rq < 4; ++rq) { u32x2 w; w.x = cvt_pk_bf16(o[d0][4 * rq] * rl, o[d0][4 * rq + 1] * rl); w.y = cvt_pk_bf16(o[d0][4 * rq + 2] * rl, o[d0][4 * rq + 3] * rl);
            *(u32x2*)(orow + 32 * d0 + 8 * rq + 4 * hi) = w; }
    __syncthreads();
}

__device__ __forceinline__ void attn_phase(Frame& F, int l, int part) {
    const int nlat = NB * 2 * 128;
    auto lat_unit = [&](int it) { const int qb = it & 127, hkv = (it >> 7) & 1, b = it >> 8; attn_unit(F, l, b, hkv, qb, false); };
    if (part == 0) {
        const bool extra = (l == 0) && F.G == 256 && ((F.bx >= 16 && F.bx < 24) || F.bx >= 240);
        if (!extra) for (int it = F.bx; it < 256; it += F.G) lat_unit(it);
        if (l == 0) for (int r = (F.bx + F.G - 240) % F.G; r < NB * 2 * 4; r += F.G) { const int qb = r & 3, hkv = (r >> 2) & 1, b = r >> 3; attn_unit(F, l, b, hkv, qb, true); }
    } else {
        const bool busy = (l == 0) && F.bx >= 128 && F.bx < 136;
        if (!busy) for (int it = 256 + F.bx; it < nlat; it += F.G) lat_unit(it);
        if (l == 0 && F.bx >= 136 && F.bx < 144) lat_unit(256 + F.bx - 8);
        if (l == 0 && F.G == 256 && F.bx >= 144 && F.bx < 168) { const int k = F.bx - 144; lat_unit(k < 8 ? 16 + k : 240 + (k - 8)); }
    }
}

#if !MK_MULTI
#define GRID_BAR() xcd_barrier(bar)
#else
#define GRID_BAR() do {} while (0)
#endif
#ifndef PH_MASK
#define PH_MASK 0xFFFFFu
#endif
#define IN(k) (((PH_MASK >> (k)) & 1u) && lo <= (k) && (k) < hi)
#define SEAM(k) do { if (IN((k) + 1)) GRID_BAR(); } while (0)
#ifndef REP_MASK
#define REP_MASK 0u
#endif
#define REPS(k) ((((REP_MASK) >> (k)) & 1u) ? 2 : 1)
template <int l, class BarT>
__device__ __forceinline__ void layer_phases(Frame& F, unsigned* ctl, const int lo, const int hi, const BarT& bar) {
        const int pb = 1 + 8 * l;
        bf16_t* H = (bf16_t*)(F.ws + WS_H);
        const float* xl_in = l == 0 ? F.in[0] : nullptr;
        bf16_t* XB = (bf16_t*)(F.ws + WS_XB);
        const float* xc_in = l == 0 ? F.in[2] : (const float*)(F.ws + WS_XC);
        float* xc = (float*)(F.ws + WS_XC);
        const float* mod_l = (const float*)ctl + CW_MOD + l * 3 * MODSZ;
        if (IN(pb + 0)) { for (int rep = 0; rep < REPS(pb + 0); ++rep) norm_phase<false>(F, l, 0, xl_in, xc_in, NTOK, l == 1 ? (const float*)(F.ws + WS_TMPC2) : nullptr, nullptr); SEAM(pb + 0); }
        if (IN(pb + 1)) {
            for (int rep = 0; rep < REPS(pb + 1); ++rep) {
            { pg8::Gemm g{H, (const bf16_t*)(F.ws + (l ? WS_WIN1 : WS_WIN0)) + (size_t)512 * D, D, D}; InprojSched S{F.G, F.bx, l}; EpiInproj E{F.ws}; pg8::NoGather R;
              pg8::gemm_phase(F.lds, g, S, E, R); }
            { pg8::Gemm g{(const bf16_t*)(F.ws + (l ? WS_WIN1 : WS_WIN0)), H, D, D}; UpermSched S{F.G, F.bx, l}; EpiUperm E{F.ws}; UpermRows R;
              pg8::gemm_phase(F.lds, g, S, E, R); }
            }
            SEAM(pb + 1);
        }
        if (IN(pb + 2)) {
            for (int rep = 0; rep < REPS(pb + 2); ++rep) {
            attn_phase(F, l, 0);
            { pg8::Gemm g{(const bf16_t*)(F.ws + WS_UP), (const bf16_t*)(F.ws + WS_FA64), 128, 128}; StepASched S{F.G, F.bx, l}; EpiStepA E{F.ws}; pg8::NoGather R;
              pg8::gemm_phase(F.lds, g, S, E, R); }
            if (l == 0) { pg8::Gemm g{(const bf16_t*)(F.ws + WS_VCT), (const bf16_t*)(F.ws + WS_TX), 512, 512}; GridSched S{2, 2, F.G, (F.bx + F.G - 16) % F.G, 256u * 512u * 2u, 256u * 512u * 2u}; EpiStepC<true> E{F.ws}; pg8::NoGather R;
              pg8::gemm_phase(F.lds, g, S, E, R); }
            }
            SEAM(pb + 2);
        }
        if (IN(pb + 3)) {
            for (int rep = 0; rep < REPS(pb + 3); ++rep) {
            { pg8::Gemm g{(const bf16_t*)(F.ws + WS_GP), (const bf16_t*)(F.ws + WS_TC), 256, 256}; GridSched S{128, 1, F.G, F.bx, 256u * 256u * 2u, 0u}; EpiStepC<false> E{F.ws}; pg8::NoGather R;
              pg8::gemm_phase(F.lds, g, S, E, R); }
            if (l == 0) { pg8::Gemm g{(const bf16_t*)(F.ws + WS_FO), (const bf16_t*)(F.ws + WS_WM0), KM, KM}; CtxSched S{F.G, (F.bx + F.G - 128) % F.G, 4, 256u * KM * 2u, 256u * KM * 2u, 1, 0u}; EpiMerge E{F.ws}; pg8::NoGather R;
              pg8::gemm_phase(F.lds, g, S, E, R); }
            attn_phase(F, l, 1);
            }
            SEAM(pb + 3);
        }
        if (IN(pb + 4)) {
            const int nM = 64;
            pg8::Gemm g{(const bf16_t*)(F.ws + WS_FO), (const bf16_t*)(F.ws + (l ? WS_WM1 : WS_WM0)), KM, KM}; GridSched S{nM, 4, F.G, F.bx, 256u * KM * 2u, 256u * KM * 2u}; EpiMerge E{F.ws}; pg8::NoGather R;
            for (int rep = 0; rep < REPS(pb + 4); ++rep) pg8::gemm_phase(F.lds, g, S, E, R);
            SEAM(pb + 4);
        }
        if (IN(pb + 5)) {
            EpiResid E{xl_in, XB, XB, xc_in, xc, mod_l, 2, (float*)(F.ws + WS_TMPC1)}; pg8::NoGather R;
            { pg8::Gemm g{(const bf16_t*)(F.ws + WS_Y), (const bf16_t*)(F.ws + (l ? WS_WO1 : WS_WO0)), D, D}; GridSched S{64, 4, F.G, F.bx, 256u * D * 2u, 256u * D * 2u};
              pg8::gemm_phase(F.lds, g, S, E, R); }
            if (l == 0) { pg8::Gemm g{(const bf16_t*)(F.ws + WS_Y), (const bf16_t*)(F.ws + WS_WO0), D / 2, D}; CtxSched S{F.G, F.bx, 4, 256u * D * 2u, 256u * D * 2u, 2, (unsigned)D};
              pg8::gemm_phase(F.lds, g, S, E, R); }
            SEAM(pb + 5);
        }
        if (IN(pb + 6)) {
            if (l == 0) norm_phase<false>(F, l, 1, nullptr, xc, NTOK, (const float*)(F.ws + WS_TMPC1), xc); else { norm_phase<true>(F, l, 1, nullptr, xc, NL); moe_convert(F, 0); }
            SEAM(pb + 6);
        }
#ifndef STREAM0
#define STREAM0 0
#endif
#ifndef STREAM1
#define STREAM1 0
#endif
        if (IN(pb + 7)) {
            volatile LAS unsigned* lw = (volatile LAS unsigned*)(F.lds + MISC_OFF) + 16;
            if (l == 0) {
#if STREAM0
                FfnStream<9, false> S;
#pragma unroll
                for (int g = 0; g < 9; ++g) { S.P[g] = g < 8 ? 8 : 2; S.rb[g] = 2048 * g; S.cn[g] = g < 8 ? 2048 : 512; }
                S.nNgu = 22; S.Kdn = DFF0; S.need = 22u * 8u; S.q = ctl + CW_QUEUE; S.lw = lw; S.rdy = ctl + CW_RDY; S.tmo = ctl + 2; S.finish_init(F.G);
                EpiFfn<false> E{F.ws, F.out, mod_l}; FfnRows<false> R{nullptr};
                pg8::gemm_stream(F.lds, (const char*)F.ws, S, E, R);
#else
                { pg8::Gemm g{H, (const bf16_t*)(F.ws + WS_WGUD), D, D}; RowSched S{66, 22, F.G, F.bx, 256u * D * 2u, 256u * D * 2u}; EpiSwiglu E{(bf16_t*)(F.ws + WS_ACT), DFF0}; pg8::NoGather R;
                  pg8::gemm_phase(F.lds, g, S, E, R); }
                GRID_BAR();
                { EpiResid E{nullptr, XB, XB, xc, xc, mod_l, 5, (float*)(F.ws + WS_TMPC2)}; pg8::NoGather R;
                  { pg8::Gemm g{(const bf16_t*)(F.ws + WS_ACT), (const bf16_t*)(F.ws + WS_WDD), DFF0, DFF0}; GridSched S{64, 4, F.G, F.bx, 256u * DFF0 * 2u, 256u * DFF0 * 2u};
                    pg8::gemm_phase(F.lds, g, S, E, R); }
                  { pg8::Gemm g{(const bf16_t*)(F.ws + WS_ACT), (const bf16_t*)(F.ws + WS_WDD), DFF0 / 2, DFF0}; CtxSched S{F.G, F.bx, 4, 256u * DFF0 * 2u, 256u * DFF0 * 2u, 2, (unsigned)DFF0};
                    pg8::gemm_phase(F.lds, g, S, E, R); } }

#endif
            } else {
#if STREAM1
                FfnStream<8, true> S; { int bacc = 0;
#pragma unroll
                for (int e = 0; e < NE; ++e) { const int c = (int)ctl[CW_CNT + 64 * e]; S.cn[e] = c; S.P[e] = (c + 255) >> 8; S.rb[e] = bacc; bacc += ((c + 255) >> 8) << 8; } }
                S.nNgu = 28; S.Kdn = DFFE; S.need = 28u * 8u; S.q = ctl + CW_QUEUE + 64; S.lw = lw; S.rdy = ctl + CW_RDY + 64 * 80; S.tmo = ctl + 2; S.finish_init(F.G);
                EpiFfn<true> E{F.ws, F.out, mod_l}; FfnRows<true> R{(const int*)(F.ws + WS_LIST)};
                pg8::gemm_stream(F.lds, (const char*)F.ws, S, E, R);
#else
                { pg8::Gemm g{H, (const bf16_t*)(F.ws + WS_WGUE), D / 2, D / 2}; MoeSched S; S.G = F.G; S.c = F.bx; S.nN = 28; S.ksplit = 1; S.trim = 0; S.khbytes = 0; S.bexp = 2u * DFFE * D; S.bbytes = 256u * D; S.arow_bytes = 0; S.a_slots = false; S.init(ctl + CW_CNT);
                  EpiSwiglu8 E{F.ws + WS_ACT, DFFE}; MoeRows R{(const int*)(F.ws + WS_LIST)};
                  pg8::gemm_phase8(F.lds, g, S, E, R); }
                moe_convert(F, 1);
                GRID_BAR();
                { const int trim = moe_tail_panels(ctl + CW_CNT, F.G);
                  MoeSched S; S.G = F.G; S.c = F.bx; S.nN = 4; S.ksplit = 1; S.trim = trim; S.khbytes = 0; S.bexp = (unsigned)D * DFFE; S.bbytes = 256u * DFFE; S.arow_bytes = (unsigned)DFFE; S.a_slots = true; S.init(ctl + CW_CNT);
                  { pg8::Gemm g{(const bf16_t*)(F.ws + WS_ACT), (const bf16_t*)(F.ws + WS_WDE), DFFE / 2, DFFE / 2};
                    EpiBf16 E{(bf16_t*)(F.ws + WS_DOUT), (bf16_t*)(F.ws + WS_DOUT), D}; pg8::NoGather R;
                    pg8::gemm_phase8(F.lds, g, S, E, R); }
                  if (trim > 0) {
                    const int plast = (S.cnt[NE - 1] + 255) >> 8;
                    pg8::Gemm g{(const bf16_t*)(F.ws + WS_ACT), (const bf16_t*)(F.ws + WS_WDE), DFFE / 4, DFFE / 2};
                    MoeTailSched T{F.G, F.bx, trim, plast, S.base[NE - 1], (unsigned)D * DFFE};
                    EpiTail E{(bf16_t*)(F.ws + WS_DOUT), (bf16_t*)(F.ws + WS_DOUT1), S.base[NE - 1] + (plast - trim) * 256}; pg8::NoGather R;
                    pg8::gemm_phase8(F.lds, g, T, E, R); } }
#endif
            }
            SEAM(pb + 7);
        }
}

constexpr int NPHASE = 18;
__global__ void __launch_bounds__(NTHR, 2) fwd_kernel(Args args) {
    extern __shared__ __attribute__((aligned(16))) unsigned char lds_raw[];
    Frame F;
    F.lds = (LAS unsigned char*)lds_raw; F.ws = args.ws; F.in = args.in; F.out = args.out;
    F.tid = threadIdx.x; F.lane = F.tid & 63; F.wave = __builtin_amdgcn_readfirstlane(F.tid >> 6); F.G = gridDim.x; F.bx = blockIdx.x;
    volatile LAS unsigned* MISC = (volatile LAS unsigned*)(F.lds + MISC_OFF);
    if (F.tid < 32) MISC[F.tid] = 0u;
    __syncthreads();
    unsigned* ctl = (unsigned*)(F.ws + WS_CTL);
#if !MK_MULTI
    XcdBarrier bar = xcd_barrier_post(ctl + CW_BAR, MISC + 8);
#else
    XcdBarrier bar; bar.bar = ctl + CW_BAR; bar.x = 0; bar.st = MISC + 8;
#endif
    const int lo = args.ph_lo, hi = args.ph_hi;
    if (IN(0)) { for (int rep = 0; rep < REPS(0); ++rep) { p0_prologue(F); __syncthreads(); } SEAM(0); }
    layer_phases<0>(F, ctl, lo, hi, bar);
    layer_phases<1>(F, ctl, lo, hi, bar);
    if (IN(17)) final_phase(F);
}

extern "C" void kernel_launch(void* const* d_in, const int* in_sizes, int n_in, void* d_out, int out_size, void* d_ws, size_t ws_size, hipStream_t stream) {
    static int grid = 0;
    if (grid == 0) {
        if (n_in != 21 || out_size != NL * D || ws_size < WS_END) { fprintf(stderr, "kernel_launch: unexpected problem (n_in %d out %d ws %zu)\n", n_in, out_size, ws_size); grid = -1; return; }
        int dev = 0, cus = 0;
        hipGetDevice(&dev); hipDeviceGetAttribute(&cus, hipDeviceAttributeMultiprocessorCount, dev);
        if (hipFuncSetAttribute((const void*)fwd_kernel, hipFuncAttributeMaxDynamicSharedMemorySize, LDS_BYTES) != hipSuccess) { fprintf(stderr, "kernel_launch: hipFuncSetAttribute failed\n"); grid = -1; return; }
        int per_cu = 0; (void)hipOccupancyMaxActiveBlocksPerMultiprocessor(&per_cu, (const void*)fwd_kernel, NTHR, LDS_BYTES); (void)hipGetLastError();
        grid = cus;
    }
    if (grid < 0) return;
    hipMemsetAsync((char*)d_ws + WS_CTL, 0, CTL_BYTES, stream);
#ifdef DBG_SCRUB
    hipMemsetAsync((char*)d_ws + CTL_BYTES, 0, WS_END - CTL_BYTES, stream);
#endif
    Args a{};
    for (int i = 0; i < 21; ++i) a.in[i] = (const float*)d_in[i];
    a.out = (float*)d_out; a.ws = (unsigned char*)d_ws;
#if MK_MULTI
    for (int p = 0; p < NPHASE; ++p) { a.ph_lo = p; a.ph_hi = p + 1; hipLaunchKernelGGL(fwd_kernel, dim3(grid), dim3(NTHR), LDS_BYTES, stream, a); }
#else
    a.ph_lo = 0; a.ph_hi = NPHASE;
    hipLaunchKernelGGL(fwd_kernel, dim3(grid), dim3(NTHR), LDS_BYTES, stream, a);
#endif
}
```

```cpp
#include <hip/hip_runtime.h>
#include <cstdio>
#include <cstdint>

#define LAS __attribute__((address_space(3)))
#define GAS __attribute__((address_space(1)))
typedef unsigned short bf16_t;
typedef short bf16x8 __attribute__((ext_vector_type(8)));
typedef short s16x4 __attribute__((ext_vector_type(4)));
typedef float f32x4 __attribute__((ext_vector_type(4)));
typedef float f32x2 __attribute__((ext_vector_type(2)));
typedef float f32x16 __attribute__((ext_vector_type(16)));
typedef unsigned u32x4 __attribute__((ext_vector_type(4)));
typedef unsigned u32x2 __attribute__((ext_vector_type(2)));

#ifndef MK_MULTI
#define MK_MULTI 0
#endif

constexpr int D = 1024, T = 8192, NB = 2, NL = NB * T, CTXL = 256, NC = NB * CTXL, NTOK = NL + NC;
constexpr int INW = 3328, OFFQ = 512, OFFK = 1024, OFFV = 1152, OFFG = 1280;
constexpr int DFF0 = 2816, DFFE = 3584, NE = 8;
constexpr int KM = 1152;
constexpr int MOE_ROWS = 2 * NL + NE * 256;
constexpr float EPS = 1e-6f;
constexpr float LOG2E = 1.4426950408889634f;
constexpr float QSCALE = 0.125f * LOG2E;

constexpr size_t MiB = 1u << 20, KiB = 1u << 10;
constexpr size_t WS_CTL = 0, CTL_BYTES = 1 * MiB;
constexpr size_t WS_ROPE = 1 * MiB, WS_TW = WS_ROPE + 32 * KiB, WS_FA64 = WS_ROPE + 96 * KiB, WS_TC = WS_ROPE + 160 * KiB, WS_TX = WS_ROPE + 288 * KiB;
constexpr size_t WS_TOKE = 2 * MiB, WS_TOKR = WS_TOKE + 128 * KiB, WS_TOKW = WS_TOKE + 256 * KiB, WS_LIST = WS_TOKE + 384 * KiB;
constexpr size_t WS_XC = 3 * MiB, WS_VCT = 5 * MiB;
constexpr size_t WS_WIN0 = 6 * MiB, WS_WM0 = WS_WIN0 + 13 * MiB / 2, WS_WO0 = 17 * MiB, WS_WGUD = 19 * MiB, WS_WDD = 30 * MiB;
constexpr size_t WS_WIN1 = 36 * MiB, WS_WM1 = WS_WIN1 + 13 * MiB / 2, WS_WO1 = 47 * MiB;
constexpr size_t WS_H = 49 * MiB;
constexpr size_t WS_DOUT = 6 * MiB;
constexpr size_t WS_WGUE = 82 * MiB, WS_WDE = 194 * MiB;
constexpr size_t WS_DOUT1 = WS_WGUE;
constexpr size_t WS_R1 = 250 * MiB;
constexpr size_t WS_UP = WS_R1, WS_Q = 266 * MiB, WS_KB = 283 * MiB, WS_VB = 288 * MiB, WS_GF = 293 * MiB, WS_GA = 326 * MiB, WS_GP = 359 * MiB, WS_FO = 375 * MiB, WS_Y = 413 * MiB;
constexpr size_t WS_ACT = WS_R1;
constexpr size_t WS_TMPC1 = 446 * MiB, WS_TMPC2 = 448 * MiB;
constexpr size_t WS_XB = 490 * MiB;
constexpr size_t WS_END = 523 * MiB;
static_assert(WS_DOUT + (size_t)MOE_ROWS * D * 2 <= WS_WGUE, "DOUT overlay");
static_assert(WS_ACT + (size_t)MOE_ROWS * DFFE * 2 <= WS_END, "ACT");
static_assert(WS_FO + (size_t)NTOK * KM * 2 <= WS_Y, "FO");
constexpr int CW_BAR = 4096, CW_CNT = 8192, CW_MOD = 16384;
constexpr int MODSZ = 6 * D;

constexpr int RING_BYTES = 131072, MISC_OFF = RING_BYTES + 320, LDS_BYTES = 147456;
constexpr int NWAVES = 8, NTHR = 512;

__device__ __forceinline__ unsigned f2bf(float f) { unsigned u = __builtin_bit_cast(unsigned, f); return (u + 0x7fffu + ((u >> 16) & 1u)) >> 16; }
__device__ __forceinline__ unsigned pk2(float lo, float hi) { return f2bf(lo) | (f2bf(hi) << 16); }
__device__ __forceinline__ unsigned pk4f8(float a, float b, float c, float d) { int w = __builtin_amdgcn_cvt_pk_fp8_f32(a, b, 0, false); w = __builtin_amdgcn_cvt_pk_fp8_f32(c, d, w, true); return (unsigned)w; }
__device__ __forceinline__ unsigned cvt_pk_bf16(float lo, float hi) { unsigned r; asm volatile("v_cvt_pk_bf16_f32 %0, %1, %2" : "=v"(r) : "v"(lo), "v"(hi)); return r; }
__device__ __forceinline__ float bf2f(unsigned short h) { return __builtin_bit_cast(float, (unsigned)h << 16); }
__device__ __forceinline__ float bflo(unsigned w) { return __builtin_bit_cast(float, w << 16); }
__device__ __forceinline__ float bfhi(unsigned w) { return __builtin_bit_cast(float, w & 0xffff0000u); }
__device__ __forceinline__ float wave_sum(float v) {
#pragma unroll
    for (int o = 1; o < 64; o <<= 1) v += __shfl_xor(v, o);
    return v;
}
__device__ __forceinline__ float sigmoidf_(float x) { return __builtin_amdgcn_rcpf(1.0f + __builtin_amdgcn_exp2f(-x * LOG2E)); }
#define LDS_WAIT() asm volatile("s_waitcnt lgkmcnt(0)" ::: "memory")
#define VM_WAIT() asm volatile("s_waitcnt vmcnt(0)" ::: "memory")

#define XB_TMO      128
#define XB_XCNT(j)  (256  + 64 * (j))
#define XB_XSUB(j)  (1280 + 64 * (j))
#define XB_XGEN(j)  (2304 + 64 * (j))
#define XB_TOP      3328
#define XB_TOPGEN   3392
#define XCD_BAR_WORDS 3456
#define XB_SPIN_CAP (1u << 18)
__device__ __forceinline__ unsigned xb_ld(unsigned* p)              { return __hip_atomic_load(p, __ATOMIC_RELAXED, __HIP_MEMORY_SCOPE_AGENT); }
__device__ __forceinline__ unsigned xb_add(unsigned* p, unsigned v) { return __hip_atomic_fetch_add(p, v, __ATOMIC_RELAXED, __HIP_MEMORY_SCOPE_AGENT); }
__device__ __forceinline__ unsigned xb_xcc_id() { return (unsigned)__builtin_amdgcn_s_getreg((3 << 11) | 20) & 0xFu; }
#define XB_SPIN(cond, bar) do { unsigned _sp = 0; while (cond) { __builtin_amdgcn_s_sleep(1); \
    if ((++_sp & 255u) == 0u) { if (xb_ld(&(bar)[XB_TMO])) break; if (_sp > XB_SPIN_CAP) { atomicAdd(&(bar)[XB_TMO], 1u); break; } } } } while (0)
struct XcdBarrier { unsigned* bar; unsigned x; volatile LAS unsigned* st; };
__device__ __forceinline__ XcdBarrier xcd_barrier_post(unsigned* bar, volatile LAS unsigned* st) {
    XcdBarrier b; b.bar = bar; b.x = xb_xcc_id(); b.st = st;
    if (threadIdx.x == 0) (void)xb_add(&bar[XB_XCNT(b.x)], 1u);
    return b;
}
__device__ __forceinline__ void xcd_barrier_complete(unsigned* bar, unsigned x, unsigned& nloc, unsigned& nx) {
    const unsigned G = gridDim.x * gridDim.y * gridDim.z;
    unsigned sum, cnt, mine, sp = 0u;
    for (;;) {
        sum = 0u; cnt = 0u; mine = 0u;
#pragma unroll
        for (unsigned j = 0; j < 16; ++j) { const unsigned c = xb_ld(&bar[XB_XCNT(j)]); sum += c; cnt += (c > 0u) ? 1u : 0u; mine = (j == x) ? c : mine; }
        if (sum == G) break;
        __builtin_amdgcn_s_sleep(1);
        if ((++sp & 255u) == 0u) { if (xb_ld(&bar[XB_TMO])) break; if (sp > XB_SPIN_CAP) { atomicAdd(&bar[XB_TMO], 1u); break; } }
    }
    nloc = mine > 0u ? mine : 1u; nx = cnt > 0u ? cnt : 1u;
}
__device__ __forceinline__ void xcd_barrier(const XcdBarrier& b) {
    asm volatile("s_waitcnt vmcnt(0)" ::: "memory");
    __syncthreads();
    if (threadIdx.x == 0) {
        unsigned* bar = b.bar;
        __builtin_amdgcn_s_waitcnt(0);
        unsigned nloc = b.st[0], nx = b.st[1];
        if (nloc == 0u) { xcd_barrier_complete(bar, b.x, nloc, nx); b.st[0] = nloc; b.st[1] = nx; }
        const unsigned old = xb_add(&bar[XB_XSUB(b.x)], 1u);
        const unsigned gen = old / nloc;
        if (old + 1u == (gen + 1u) * nloc) {
            __builtin_amdgcn_fence(__ATOMIC_RELEASE, "agent");
            asm volatile("s_waitcnt vmcnt(0)" ::: "memory");
            const unsigned og = xb_add(&bar[XB_TOP], 1u);
            const unsigned tg = og / nx;
            if (og + 1u == (tg + 1u) * nx) xb_add(&bar[XB_TOPGEN], 1u);
            else XB_SPIN(xb_ld(&bar[XB_TOPGEN]) == tg, bar);
            __builtin_amdgcn_fence(__ATOMIC_ACQUIRE, "agent");
            xb_add(&bar[XB_XGEN(b.x)], 1u);
            asm volatile("s_waitcnt vmcnt(0)" ::: "memory");
        } else {
            XB_SPIN(xb_ld(&bar[XB_XGEN(b.x)]) == gen, bar);
            __builtin_amdgcn_fence(__ATOMIC_ACQUIRE, "agent");
            asm volatile("s_waitcnt vmcnt(0)" ::: "memory");
        }
    }
    __syncthreads();
}

#ifndef QGU
#define QGU 32
#endif
#ifndef QDN
#define QDN 64
#endif
#ifndef QACT
#define QACT 16
#endif
namespace pg8 {
constexpr int BM = 256, BK = 64, HALF = 128, HTB = HALF * BK * 2, STAGE_BYTES = 8 * HTB, NXCD = 8, WGM = 8;
__host__ __device__ __forceinline__ int lds_byte(int r, int c) { const int st = (r >> 4) * 2 + (c >> 5), rr = r & 15, cc = c & 31, ob = rr * 64 + cc * 2; return st * 1024 + (ob ^ (((ob >> 9) & 1) << 5)); }
__host__ __device__ __forceinline__ void stage_rc(int b, int& R, int& C) { const int st = b / 1024, sb = b % 1024, swz = sb ^ (((sb >> 9) & 1) << 5); R = (st >> 1) * 16 + swz / 64; C = (st & 1) * 32 + (swz % 64) / 2; }
__host__ __device__ __forceinline__ int perm32(int rho) { const int n = rho >> 4, i = rho & 15; return 8 * (i >> 2) + 4 * n + (i & 3); }

typedef int i32x8 __attribute__((ext_vector_type(8)));
typedef int i32x4 __attribute__((ext_vector_type(4)));
__device__ __forceinline__ i32x8 cat8(bf16x8 a, bf16x8 b) { return __builtin_shufflevector(__builtin_bit_cast(i32x4, a), __builtin_bit_cast(i32x4, b), 0, 1, 2, 3, 4, 5, 6, 7); }
struct Unit { unsigned aoff, boff; int pm, pn, kind, x0, x1, kh; };
struct Gemm { const bf16_t* A; const bf16_t* Bt; int K; int ld; };

__device__ __forceinline__ void swz_map(int L, int nM, int nN, int& pm, int& pn) {
    const int nwg = nM * nN; int wgid = L;
    { const int q = nwg / NXCD, r = nwg % NXCD, xcd = wgid % NXCD, off = wgid / NXCD; wgid = (xcd < r ? xcd * (q + 1) : r * (q + 1) + (xcd - r) * q) + off; }
    const int nig = WGM * nN, gid = wgid / nig, fm = gid * WGM, gsz = (nM - fm) < WGM ? (nM - fm) : WGM;
    pm = fm + ((wgid % nig) % gsz); pn = (wgid % nig) / gsz;
}

struct NoGather { static constexpr bool GA = false, GB = false;
    __device__ __forceinline__ unsigned arow(const Unit&, int) const { return 0u; }
    __device__ __forceinline__ unsigned brow(const Unit&, int) const { return 0u; } };

template <bool F8, class Epi, class Sched, class Rows>
__device__ __forceinline__ void gemm_phase_t(LAS unsigned char* lds, const Gemm g, const Sched& S, const Epi& E, const Rows& RW) {
    int tid_ = threadIdx.x; asm volatile("" : "+v"(tid_));
    const int tid = tid_, wid = __builtin_amdgcn_readfirstlane(tid >> 6), lane = tid & 63, wr = wid >> 2, wc = wid & 3, fr = lane & 15, fq = lane >> 4;
    int K_ = g.K; asm volatile("" : "+s"(K_));
    const int K = K_, nt = K / BK;
    int sR[2], sRb[2], sC[2];
#pragma unroll
    for (int i = 0; i < 2; ++i) { int R, C; stage_rc(tid * 16 + i * 8192, R, C); sR[i] = R; sC[i] = C; sRb[i] = (R & ~31) + perm32(R & 31); }
    unsigned voffA[2], voffB[2];
    const int LD = g.ld;
#pragma unroll
    for (int i = 0; i < 2; ++i) { voffA[i] = (unsigned)(sR[i] * LD + sC[i]) * 2u; voffB[i] = (unsigned)(sRb[i] * LD + sC[i]) * 2u; }
    const size_t kstep = (size_t)(BK * 2);
    const size_t hstep = (size_t)HALF * LD * 2;
    const unsigned ldsw = (unsigned)wid * 1024u;
    const int aoff = lds_byte(wr * 64 + fr, fq * 8), boff = lds_byte(wc * 32 + fr, fq * 8);
    constexpr int NTHR_ = 512;
    LAS unsigned* stash = (LAS unsigned*)(lds + 131072 + 320 + 1024) + tid;
    struct Side { const char* base[2]; unsigned off[2][2]; };
#define PG8_SA(b, h) (((b) * 2 + (h)) * HTB)
#define PG8_SB(b, h) ((4 + (b) * 2 + (h)) * HTB)
#define PG8_STAGE(bufoff, side, h, kt) do { _Pragma("unroll") for (int _i = 0; _i < 2; ++_i) { unsigned _o = (side).off[h][_i]; asm volatile("" : "+v"(_o)); \
        __builtin_amdgcn_global_load_lds((const unsigned*)((side).base[h] + (size_t)(kt) * kstep + _o), (LAS unsigned*)(lds + (bufoff) + ldsw + _i * 8192), 16, 0, 0); } } while (0)
#define PG8_LDA(dst, b, h) do { _Pragma("unroll") for (int m = 0; m < 4; ++m) _Pragma("unroll") for (int k = 0; k < 2; ++k) dst[m][k] = *(const LAS bf16x8*)(lds + PG8_SA(b, h) + aoff + m * 2048 + k * 1024); } while (0)
#define PG8_LDB(dst, b, h) do { _Pragma("unroll") for (int n = 0; n < 2; ++n) _Pragma("unroll") for (int k = 0; k < 2; ++k) dst[n][k] = *(const LAS bf16x8*)(lds + PG8_SB(b, h) + boff + n * 2048 + k * 1024); } while (0)
#define PG8_MMA(ai, bj, At, Bt) do { __builtin_amdgcn_s_setprio(1); _Pragma("unroll") for (int m = 0; m < 4; ++m) _Pragma("unroll") for (int n = 0; n < 2; ++n) { \
        if constexpr (F8) acc[ai][bj][m][n] = __builtin_amdgcn_mfma_scale_f32_16x16x128_f8f6f4(cat8(Bt[n][0], Bt[n][1]), cat8(At[m][0], At[m][1]), acc[ai][bj][m][n], 0, 0, 0, 0, 0, 0); \
        else { _Pragma("unroll") for (int k = 0; k < 2; ++k) acc[ai][bj][m][n] = __builtin_amdgcn_mfma_f32_16x16x32_bf16(Bt[n][k], At[m][k], acc[ai][bj][m][n], 0, 0, 0); } } __builtin_amdgcn_s_setprio(0); } while (0)
#define PG8_WAIT_V(n) asm volatile("s_waitcnt vmcnt(" #n ")" ::: "memory")
#define PG8_WAIT_L(n) asm volatile("s_waitcnt lgkmcnt(" #n ")" ::: "memory")
#define PG8_BAR __builtin_amdgcn_s_barrier()
#define PG8_SCHED __builtin_amdgcn_sched_barrier(0)
#define PG8_MKSIDES(u, sa, sb) do { \
        if constexpr (Rows::GA) { sa.base[0] = sa.base[1] = (const char*)g.A; int t2_ = tid; asm volatile("" : "+v"(t2_)); _Pragma("unroll") for (int i = 0; i < 2; ++i) { int R_, C_; stage_rc(t2_ * 16 + i * 8192, R_, C_); \
            _Pragma("unroll") for (int h = 0; h < 2; ++h) sa.off[h][i] = RW.arow(u, h * HALF + R_) + (unsigned)C_ * 2u; } } \
        else { sa.base[0] = (const char*)g.A + (u).aoff; sa.base[1] = sa.base[0] + hstep; _Pragma("unroll") for (int h = 0; h < 2; ++h) _Pragma("unroll") for (int i = 0; i < 2; ++i) sa.off[h][i] = voffA[i]; } \
        if constexpr (Rows::GB) { sb.base[0] = sb.base[1] = (const char*)g.Bt; _Pragma("unroll") for (int h = 0; h < 2; ++h) _Pragma("unroll") for (int i = 0; i < 2; ++i) sb.off[h][i] = RW.brow(u, h * HALF + sRb[i]) + (unsigned)sC[i] * 2u; } \
        else { sb.base[0] = (const char*)g.Bt + (u).boff; sb.base[1] = sb.base[0] + hstep; _Pragma("unroll") for (int h = 0; h < 2; ++h) _Pragma("unroll") for (int i = 0; i < 2; ++i) sb.off[h][i] = voffB[i]; } } while (0)
    Unit cur, nxt; int ui = 0;
    if (!S.next(0, cur)) return;
    f32x4 acc[2][2][4][2];
#pragma unroll
    for (int a = 0; a < 2; ++a)
#pragma unroll
        for (int b = 0; b < 2; ++b)
#pragma unroll
            for (int m = 0; m < 4; ++m)
#pragma unroll
                for (int n = 0; n < 2; ++n) acc[a][b][m][n] = (f32x4){0.f, 0.f, 0.f, 0.f};
    bf16x8 At[4][2], B0[2][2], B1[2][2];
    Side cA, cB, nA, nB;
    PG8_MKSIDES(cur, cA, cB);
    PG8_STAGE(PG8_SB(0, 0), cB, 0, 0); PG8_STAGE(PG8_SB(0, 1), cB, 1, 0); PG8_STAGE(PG8_SA(0, 0), cA, 0, 0); PG8_STAGE(PG8_SA(0, 1), cA, 1, 0);
    if (wr == 1) PG8_BAR;
    PG8_WAIT_V(2); PG8_BAR;
    PG8_STAGE(PG8_SB(1, 0), cB, 0, 1); PG8_STAGE(PG8_SA(1, 0), cA, 0, 1); PG8_STAGE(PG8_SB(1, 1), cB, 1, 1);
    PG8_WAIT_V(6); PG8_BAR;
    for (;;) {
        const bool has_next = S.next(ui + 1, nxt);
        if (has_next) { PG8_MKSIDES(nxt, nA, nB); } else { nA = cA; nB = cB; }
        if constexpr (Rows::GA) {
#pragma unroll
            for (int h = 0; h < 2; ++h)
#pragma unroll
                for (int i = 0; i < 2; ++i) stash[(h * 2 + i) * NTHR_] = nA.off[h][i]; }
        for (int t = 0; t < nt; t += 2) {
            const bool last = (t == nt - 2);
            if constexpr (Epi::MIDK > 0) { if (t == Epi::MIDK) E.mid(acc, cur, wr, wc, fr, fq); }
            Side a2, b2;
            a2.base[0] = last ? nA.base[0] : cA.base[0]; a2.base[1] = last ? nA.base[1] : cA.base[1];
            b2.base[0] = last ? nB.base[0] : cB.base[0]; b2.base[1] = last ? nB.base[1] : cB.base[1];
#pragma unroll
            for (int h = 0; h < 2; ++h)
#pragma unroll
                for (int i = 0; i < 2; ++i) { if constexpr (!Rows::GA) a2.off[h][i] = cA.off[h][i]; b2.off[h][i] = (Rows::GB && last) ? nB.off[h][i] : cB.off[h][i]; }
            const int k2 = last ? 0 : t + 2, k3 = k2 + 1;
            PG8_LDB(B0, 0, 0); PG8_LDB(B1, 0, 1); PG8_SCHED; PG8_LDA(At, 0, 0); PG8_STAGE(PG8_SA(1, 1), cA, 1, t + 1);
            if constexpr (Rows::GA) {
                if (last) {
#pragma unroll
                    for (int h = 0; h < 2; ++h)
#pragma unroll
                        for (int i = 0; i < 2; ++i) cA.off[h][i] = stash[(h * 2 + i) * NTHR_]; }
#pragma unroll
                for (int h = 0; h < 2; ++h)
#pragma unroll
                    for (int i = 0; i < 2; ++i) a2.off[h][i] = cA.off[h][i]; }
            PG8_WAIT_V(8); PG8_WAIT_L(0); PG8_BAR; PG8_MMA(0, 0, At, B0); PG8_MMA(0, 1, At, B1); PG8_BAR; PG8_SCHED;
            PG8_LDA(At, 0, 1); PG8_STAGE(PG8_SB(0, 0), b2, 0, k2); PG8_STAGE(PG8_SB(0, 1), b2, 1, k2); PG8_STAGE(PG8_SA(0, 0), a2, 0, k2);
            PG8_WAIT_V(8); PG8_WAIT_L(0); PG8_BAR; PG8_MMA(1, 0, At, B0); PG8_MMA(1, 1, At, B1); PG8_BAR; PG8_SCHED;
            PG8_LDB(B0, 1, 0); PG8_LDB(B1, 1, 1); PG8_SCHED; PG8_LDA(At, 1, 0); PG8_STAGE(PG8_SA(0, 1), a2, 1, k2);
            PG8_WAIT_V(8); PG8_WAIT_L(0); PG8_BAR; PG8_MMA(0, 0, At, B0); PG8_MMA(0, 1, At, B1); PG8_BAR; PG8_SCHED;
            PG8_LDA(At, 1, 1); PG8_STAGE(PG8_SB(1, 0), b2, 0, k3); PG8_STAGE(PG8_SB(1, 1), b2, 1, k3); PG8_STAGE(PG8_SA(1, 0), a2, 0, k3);
            PG8_WAIT_V(8); PG8_WAIT_L(0); PG8_BAR; PG8_MMA(1, 0, At, B0); PG8_MMA(1, 1, At, B1); PG8_BAR; PG8_SCHED;
        }
        if (wr == 0) PG8_BAR;
        E(acc, cur, wr, wc, fr, fq);
        if (!has_next) break;
#pragma unroll
        for (int a = 0; a < 2; ++a)
#pragma unroll
            for (int b = 0; b < 2; ++b)
#pragma unroll
                for (int m = 0; m < 4; ++m)
#pragma unroll
                    for (int n = 0; n < 2; ++n) acc[a][b][m][n] = (f32x4){0.f, 0.f, 0.f, 0.f};
        cur = nxt; if constexpr (Rows::GA) { cA.base[0] = nA.base[0]; cA.base[1] = nA.base[1]; } else cA = nA; cB = nB; ++ui;
        if (wr == 1) PG8_BAR;
    }
    PG8_WAIT_V(0);
    PG8_BAR;
#undef PG8_SA
#undef PG8_SB
#undef PG8_STAGE
#undef PG8_LDA
#undef PG8_LDB
#undef PG8_MMA
#undef PG8_WAIT_V
#undef PG8_WAIT_L
#undef PG8_BAR
#undef PG8_SCHED
#undef PG8_MKSIDES
}

template <class Epi, class Sched, class Rows>
__device__ __forceinline__ void gemm_phase(LAS unsigned char* lds, const Gemm g, const Sched& S, const Epi& E, const Rows& RW) { gemm_phase_t<false>(lds, g, S, E, RW); }
template <class Epi, class Sched, class Rows>
__device__ __forceinline__ void gemm_phase8(LAS unsigned char* lds, const Gemm g, const Sched& S, const Epi& E, const Rows& RW) { gemm_phase_t<true>(lds, g, S, E, RW); }

struct SUnit { unsigned aoff, boff; int K; int pm, pn, kind, x0, x1, grp, dep, sig; };
__device__ __forceinline__ void st16_wt(unsigned char* wsbase, unsigned off, u32x4 v) {
    const __amdgpu_buffer_rsrc_t rsrc = __builtin_amdgcn_make_buffer_rsrc((void*)wsbase, 0, 0x7fffffff, 0x00020000);
    __builtin_amdgcn_raw_buffer_store_b128(v, rsrc, off, 0, 16); }

template <class Epi, class Sched, class Rows>
__device__ __forceinline__ void gemm_stream(LAS unsigned char* lds, const char* base, const Sched& S, const Epi& E, const Rows& RW) {
    int tid_ = threadIdx.x; asm volatile("" : "+v"(tid_));
    const int tid = tid_, wid = __builtin_amdgcn_readfirstlane(tid >> 6), lane = tid & 63, wr = wid >> 2, wc = wid & 3, fr = lane & 15, fq = lane >> 4;
    int sR[2], sRb[2], sC[2];
#pragma unroll
    for (int i = 0; i < 2; ++i) { int R, C; stage_rc(tid * 16 + i * 8192, R, C); sR[i] = R; sC[i] = C; sRb[i] = (R & ~31) + perm32(R & 31); }
    const size_t kstep = (size_t)(BK * 2);
    const unsigned ldsw = (unsigned)wid * 1024u;
    const int aoff = lds_byte(wr * 64 + fr, fq * 8), boff = lds_byte(wc * 32 + fr, fq * 8);
    struct Side { const char* base[2]; unsigned off[2][2]; };
#define PG8_SA(b, h) (((b) * 2 + (h)) * HTB)
#define PG8_SB(b, h) ((4 + (b) * 2 + (h)) * HTB)
#define PG8_STAGE(bufoff, side, h, kt) do { _Pragma("unroll") for (int _i = 0; _i < 2; ++_i) \
        __builtin_amdgcn_global_load_lds((const unsigned*)((side).base[h] + (size_t)(kt) * kstep + (side).off[h][_i]), (LAS unsigned*)(lds + (bufoff) + ldsw + _i * 8192), 16, 0, 0); } while (0)
#define PG8_LDA(dst, b, h) do { _Pragma("unroll") for (int m = 0; m < 4; ++m) _Pragma("unroll") for (int k = 0; k < 2; ++k) dst[m][k] = *(const LAS bf16x8*)(lds + PG8_SA(b, h) + aoff + m * 2048 + k * 1024); } while (0)
#define PG8_LDB(dst, b, h) do { _Pragma("unroll") for (int n = 0; n < 2; ++n) _Pragma("unroll") for (int k = 0; k < 2; ++k) dst[n][k] = *(const LAS bf16x8*)(lds + PG8_SB(b, h) + boff + n * 2048 + k * 1024); } while (0)
#define PG8_MMA(ai, bj, At, Bt) do { __builtin_amdgcn_s_setprio(1); _Pragma("unroll") for (int m = 0; m < 4; ++m) _Pragma("unroll") for (int n = 0; n < 2; ++n) _Pragma("unroll") for (int k = 0; k < 2; ++k) \
        acc[ai][bj][m][n] = __builtin_amdgcn_mfma_f32_16x16x32_bf16(Bt[n][k], At[m][k], acc[ai][bj][m][n], 0, 0, 0); __builtin_amdgcn_s_setprio(0); } while (0)
#define PG8_WAIT_V(n) asm volatile("s_waitcnt vmcnt(" #n ")" ::: "memory")
#define PG8_WAIT_L(n) asm volatile("s_waitcnt lgkmcnt(" #n ")" ::: "memory")
#define PG8_BAR __builtin_amdgcn_s_barrier()
#define PG8_SCHED __builtin_amdgcn_sched_barrier(0)
#define PG8_MKSIDES(un, sa, sb) do { const int K_ = (un).K; \
        if (RW.a_gather(un)) { sa.base[0] = sa.base[1] = base; _Pragma("unroll") for (int h = 0; h < 2; ++h) _Pragma("unroll") for (int i = 0; i < 2; ++i) sa.off[h][i] = RW.arow(un, h * HALF + sR[i]) + (unsigned)sC[i] * 2u; } \
        else { sa.base[0] = base + (un).aoff; sa.base[1] = sa.base[0] + (size_t)HALF * K_ * 2; _Pragma("unroll") for (int h = 0; h < 2; ++h) _Pragma("unroll") for (int i = 0; i < 2; ++i) sa.off[h][i] = (unsigned)(sR[i] * K_ + sC[i]) * 2u; } \
        sb.base[0] = base + (un).boff; sb.base[1] = sb.base[0] + (size_t)HALF * K_ * 2; _Pragma("unroll") for (int h = 0; h < 2; ++h) _Pragma("unroll") for (int i = 0; i < 2; ++i) sb.off[h][i] = (unsigned)(sRb[i] * K_ + sC[i]) * 2u; } while (0)
#define PG8_SIGNAL(idx) do { if (lane == 0) __hip_atomic_fetch_add(S.rdy + 64 * (idx), 1u, __ATOMIC_RELAXED, __HIP_MEMORY_SCOPE_AGENT); } while (0)
    SUnit cur, nxt;
    unsigned pend = 0u;
    const unsigned lw_addr = (unsigned)(size_t)S.lw;
    if (tid == 0) { S.lw[0] = __hip_atomic_fetch_add(S.q, 1u, __ATOMIC_RELAXED, __HIP_MEMORY_SCOPE_AGENT); pend = __hip_atomic_fetch_add(S.q, 1u, __ATOMIC_RELAXED, __HIP_MEMORY_SCOPE_AGENT); }
    __syncthreads();
    { const int L0 = __builtin_amdgcn_readfirstlane((int)S.lw[0]); if (!S.decode(L0, cur)) return; }
    f32x4 acc[2][2][4][2];
#pragma unroll
    for (int a = 0; a < 2; ++a)
#pragma unroll
        for (int b = 0; b < 2; ++b)
#pragma unroll
            for (int m = 0; m < 4; ++m)
#pragma unroll
                for (int n = 0; n < 2; ++n) acc[a][b][m][n] = (f32x4){0.f, 0.f, 0.f, 0.f};
    bf16x8 At[4][2], B0[2][2], B1[2][2];
    Side cA, cB, nA, nB;
    bool need_pro = true; int sig_idx = -1;
    PG8_MKSIDES(cur, cA, cB);
    for (;;) {
        if (need_pro) {
            if (cur.dep >= 0) S.a_ready(cur);
            PG8_STAGE(PG8_SB(0, 0), cB, 0, 0); PG8_STAGE(PG8_SB(0, 1), cB, 1, 0); PG8_STAGE(PG8_SA(0, 0), cA, 0, 0); PG8_STAGE(PG8_SA(0, 1), cA, 1, 0);
            if (wr == 1) PG8_BAR;
            PG8_WAIT_V(2); PG8_BAR;
            PG8_STAGE(PG8_SB(1, 0), cB, 0, 1); PG8_STAGE(PG8_SA(1, 0), cA, 0, 1); PG8_STAGE(PG8_SB(1, 1), cB, 1, 1);
            PG8_WAIT_V(6); PG8_BAR;
        }
        if (tid == 0) { asm volatile("s_nop 7\n\tds_write_b32 %1, %0\n\tglobal_atomic_add %0, %2, %3, %4 sc0" : "+v"(pend) : "v"(lw_addr), "v"(0u), "v"(1u), "s"(S.q) : "memory"); }
        PG8_WAIT_L(0); PG8_BAR; asm volatile("" ::: "memory");
        const int Ln = __builtin_amdgcn_readfirstlane((int)S.lw[0]);
        const bool has_next = S.decode(Ln, nxt), pre = has_next && nxt.dep < 0;
        if (pre) { PG8_MKSIDES(nxt, nA, nB); } else { nA = cA; nB = cB; }
        const int nt = cur.K / BK;
        for (int t = 0; t < nt; t += 2) {
            const bool last = (t == nt - 2);
            Side a2, b2;
            a2.base[0] = last ? nA.base[0] : cA.base[0]; a2.base[1] = last ? nA.base[1] : cA.base[1];
            b2.base[0] = last ? nB.base[0] : cB.base[0]; b2.base[1] = last ? nB.base[1] : cB.base[1];
#pragma unroll
            for (int h = 0; h < 2; ++h)
#pragma unroll
                for (int i = 0; i < 2; ++i) { a2.off[h][i] = last ? nA.off[h][i] : cA.off[h][i]; b2.off[h][i] = last ? nB.off[h][i] : cB.off[h][i]; }
            const int k2 = last ? 0 : t + 2, k3 = k2 + 1;
            if (t == 2 && sig_idx >= 0) { PG8_SIGNAL(sig_idx); sig_idx = -1; }
            PG8_LDB(B0, 0, 0); PG8_LDB(B1, 0, 1); PG8_SCHED; PG8_LDA(At, 0, 0); PG8_STAGE(PG8_SA(1, 1), cA, 1, t + 1);
            PG8_WAIT_V(8); PG8_WAIT_L(0); PG8_BAR; PG8_MMA(0, 0, At, B0); PG8_MMA(0, 1, At, B1); PG8_BAR; PG8_SCHED;
            PG8_LDA(At, 0, 1); PG8_STAGE(PG8_SB(0, 0), b2, 0, k2); PG8_STAGE(PG8_SB(0, 1), b2, 1, k2); PG8_STAGE(PG8_SA(0, 0), a2, 0, k2);
            PG8_WAIT_V(8); PG8_WAIT_L(0); PG8_BAR; PG8_MMA(1, 0, At, B0); PG8_MMA(1, 1, At, B1); PG8_BAR; PG8_SCHED;
            PG8_LDB(B0, 1, 0); PG8_LDB(B1, 1, 1); PG8_SCHED; PG8_LDA(At, 1, 0); PG8_STAGE(PG8_SA(0, 1), a2, 1, k2);
            PG8_WAIT_V(8); PG8_WAIT_L(0); PG8_BAR; PG8_MMA(0, 0, At, B0); PG8_MMA(0, 1, At, B1); PG8_BAR; PG8_SCHED;
            PG8_LDA(At, 1, 1); PG8_STAGE(PG8_SB(1, 0), b2, 0, k3); PG8_STAGE(PG8_SB(1, 1), b2, 1, k3); PG8_STAGE(PG8_SA(1, 0), a2, 0, k3);
            PG8_WAIT_V(8); PG8_WAIT_L(0); PG8_BAR; PG8_MMA(1, 0, At, B0); PG8_MMA(1, 1, At, B1); PG8_BAR; PG8_SCHED;
        }
        if (wr == 0) PG8_BAR;
        E(acc, cur, wr, wc, fr, fq);
        if (!has_next) { PG8_WAIT_V(0); if (cur.sig >= 0) PG8_SIGNAL(cur.sig); break; }
#pragma unroll
        for (int a = 0; a < 2; ++a)
#pragma unroll
            for (int b = 0; b < 2; ++b)
#pragma unroll
                for (int m = 0; m < 4; ++m)
#pragma unroll
                    for (int n = 0; n < 2; ++n) acc[a][b][m][n] = (f32x4){0.f, 0.f, 0.f, 0.f};
        if (pre) {
            sig_idx = cur.sig; need_pro = false; cur = nxt; cA = nA; cB = nB;
            if (wr == 1) PG8_BAR;
        } else {
            PG8_WAIT_V(0); if (cur.sig >= 0) PG8_SIGNAL(cur.sig);
            PG8_BAR; need_pro = true; cur = nxt; PG8_MKSIDES(cur, cA, cB);
        }
    }
    PG8_BAR;
#undef PG8_SA
#undef PG8_SB
#undef PG8_STAGE
#undef PG8_LDA
#undef PG8_LDB
#undef PG8_MMA
#undef PG8_WAIT_V
#undef PG8_WAIT_L
#undef PG8_BAR
#undef PG8_SCHED
#undef PG8_MKSIDES
#undef PG8_SIGNAL
}
}
using pg8::Unit;
using pg8::SUnit;

struct Args { const float* in[21]; float* out; unsigned char* ws; int ph_lo, ph_hi; };

struct Frame {
    LAS unsigned char* lds;
    unsigned char* ws;
    const float* const* in;
    float* out;
    int tid, lane, wave, G, bx;
};
__device__ __forceinline__ float* modp(const Frame& F, int l, int v) { return (float*)(F.ws + WS_CTL) + CW_MOD + (l * 3 + v) * MODSZ; }

__device__ __forceinline__ void p0_transpose_item(const float* W, int ldw, int k0, int c0, bf16_t* WT, int ldt, int drow, int lane) {
    const float* src = W + (size_t)k0 * ldw + c0 + lane;
    float v[64];
#pragma unroll
    for (int i = 0; i < 64; ++i) { v[i] = src[(size_t)i * ldw]; }
    bf16_t* dst = WT + (size_t)drow * ldt + k0;
#pragma unroll
    for (int j = 0; j < 8; ++j) { u32x4 o; o.x = pk2(v[8 * j], v[8 * j + 1]); o.y = pk2(v[8 * j + 2], v[8 * j + 3]); o.z = pk2(v[8 * j + 4], v[8 * j + 5]); o.w = pk2(v[8 * j + 6], v[8 * j + 7]);
        *(u32x4*)(dst + 8 * j) = o; }
}
template <int QS>
__device__ __forceinline__ void p0_transpose_item8(const float* W, int ldw, int k0, int c0, unsigned char* WT, int ldt, int drow, int lane) {
    const float* src = W + (size_t)k0 * ldw + c0 + lane;
    float v[64];
#pragma unroll
    for (int i = 0; i < 64; ++i) v[i] = src[(size_t)i * ldw] * (float)QS;
    unsigned char* dst = WT + (size_t)drow * ldt + k0;
#pragma unroll
    for (int j = 0; j < 4; ++j) { u32x4 o; o.x = pk4f8(v[16 * j], v[16 * j + 1], v[16 * j + 2], v[16 * j + 3]); o.y = pk4f8(v[16 * j + 4], v[16 * j + 5], v[16 * j + 6], v[16 * j + 7]);
        o.z = pk4f8(v[16 * j + 8], v[16 * j + 9], v[16 * j + 10], v[16 * j + 11]); o.w = pk4f8(v[16 * j + 12], v[16 * j + 13], v[16 * j + 14], v[16 * j + 15]);
        *(u32x4*)(dst + 16 * j) = o; }
}

constexpr int CW_CONVQ = 12288 + 128;
constexpr int MOE_I_GE = 16 * 56, MOE_I_DE = 56 * 16, MOE_ITEMS = NE * (2 * MOE_I_GE + MOE_I_DE), MOE_BATCHES = MOE_ITEMS / 8;
__device__ __forceinline__ void moe_convert_batch(Frame& F, int which, int idx) {
    const float* const* in = F.in; const int ln = F.lane;
    int r = idx * 8 + F.wave;
    if (which == 0) { const int e = r / (2 * MOE_I_GE); r %= (2 * MOE_I_GE); const int up = r / MOE_I_GE; r %= MOE_I_GE; const int kb = r / 56, nb = r % 56, c0 = 64 * nb;
        p0_transpose_item8<QGU>(in[up ? 18 : 17] + (size_t)e * D * DFFE, DFFE, 64 * kb, c0, F.ws + WS_WGUE + (size_t)e * 2 * DFFE * D, D, (c0 >> 7) * 256 + up * 128 + (c0 & 127) + ln, ln); }
    else { const int e = r / MOE_I_DE; r %= MOE_I_DE; const int kb = r / 16, nb = r % 16;
        p0_transpose_item8<QDN>(in[19] + (size_t)e * DFFE * D, D, 64 * kb, 64 * nb, F.ws + WS_WDE + (size_t)e * D * DFFE, DFFE, 64 * nb + ln, ln); }
}
__device__ __forceinline__ void moe_convert(Frame& F, int which, int rep = 0) {
    volatile LAS unsigned* lw = (volatile LAS unsigned*)(F.lds + MISC_OFF) + 20;
    unsigned* q = (unsigned*)(F.ws + WS_CTL) + CW_CONVQ + 64 * which + 128 * rep;
    const int nb = which == 0 ? NE * 2 * MOE_I_GE / 8 : NE * MOE_I_DE / 8;
    for (;;) {
        __syncthreads();
        if (F.tid == 0) lw[0] = __hip_atomic_fetch_add(q, 1u, __ATOMIC_RELAXED, __HIP_MEMORY_SCOPE_AGENT);
        __syncthreads();
        const int idx = (int)lw[0];
        if (idx >= nb) break;
        moe_convert_batch(F, which, idx);
    }
    __syncthreads();
}

constexpr int MOE_P_GU = NE * 2 * 8 * 56, MOE_P_DN = NE * 28 * 16, MOE_PAIRS = MOE_P_GU + MOE_P_DN;
struct CvtItem { const float* src; unsigned char* dst; int ldw; float qs; };
__device__ __forceinline__ CvtItem moe_item(const Frame& F, int P, int half, int ln) {
    const float* const* in = F.in; CvtItem it;
    if (P < MOE_P_GU) { int r = P; const int e = r / (2 * 8 * 56); r %= (2 * 8 * 56); const int up = r / (8 * 56); r %= (8 * 56); const int kb = 2 * (r / 56) + half, nb = r % 56, c0 = 64 * nb;
        it.src = in[up ? 18 : 17] + (size_t)e * D * DFFE + (size_t)(64 * kb) * DFFE + c0 + ln; it.ldw = DFFE; it.qs = (float)QGU;
        it.dst = F.ws + WS_WGUE + (size_t)e * 2 * DFFE * D + (size_t)((c0 >> 7) * 256 + up * 128 + (c0 & 127) + ln) * D + 64 * kb; }
    else { int r = P - MOE_P_GU; const int e = r / (28 * 16); r %= (28 * 16); const int kb = 2 * (r / 16) + half, nb = r % 16;
        it.src = in[19] + (size_t)e * DFFE * D + (size_t)(64 * kb) * D + 64 * nb + ln; it.ldw = D; it.qs = (float)QDN;
        it.dst = F.ws + WS_WDE + (size_t)e * D * DFFE + (size_t)(64 * nb + ln) * DFFE + 64 * kb; }
    return it;
}
#define CVT_LOAD(v, it) do { _Pragma("unroll") for (int i_ = 0; i_ < 64; ++i_) v[i_] = (it).src[(size_t)i_ * (it).ldw]; } while (0)
#define CVT_STORE(v, it) do { _Pragma("unroll") for (int j_ = 0; j_ < 4; ++j_) { u32x4 o_; const float q_ = (it).qs; \
        o_.x = pk4f8(v[16 * j_] * q_, v[16 * j_ + 1] * q_, v[16 * j_ + 2] * q_, v[16 * j_ + 3] * q_); o_.y = pk4f8(v[16 * j_ + 4] * q_, v[16 * j_ + 5] * q_, v[16 * j_ + 6] * q_, v[16 * j_ + 7] * q_); \
        o_.z = pk4f8(v[16 * j_ + 8] * q_, v[16 * j_ + 9] * q_, v[16 * j_ + 10] * q_, v[16 * j_ + 11] * q_); o_.w = pk4f8(v[16 * j_ + 12] * q_, v[16 * j_ + 13] * q_, v[16 * j_ + 14] * q_, v[16 * j_ + 15] * q_); \
        *(u32x4*)((it).dst + 16 * j_) = o_; } } while (0)
__device__ __forceinline__ void moe_convert_all(Frame& F) {
    int t_ = threadIdx.x; asm volatile("" : "+v"(t_)); const int ln = t_ & 63;
    const int gw = F.bx * NWAVES + F.wave, NGW = F.G * NWAVES;
    float va[64], vb[64];
    int P = gw;
    CvtItem ia, ib;
    if (P < MOE_PAIRS) { ia = moe_item(F, P, 0, ln); CVT_LOAD(va, ia); }
    while (P < MOE_PAIRS) {
        ib = moe_item(F, P, 1, ln); CVT_LOAD(vb, ib);
        CVT_STORE(va, ia);
        const int Pn = P + NGW;
        if (Pn < MOE_PAIRS) { ia = moe_item(F, Pn, 0, ln); CVT_LOAD(va, ia); }
        CVT_STORE(vb, ib);
        P = Pn;
    }
}

__device__ __forceinline__ void p0_prologue(Frame& F) {
    const float* const* in = F.in;
    const int gw = F.bx * NWAVES + F.wave, NGW = F.G * NWAVES;
    {
        constexpr int I_IN = 16 * 44, I_O = 16 * 16, I_GD = 16 * 44, I_DD = 44 * 16;
        constexpr int N_A = 2 * I_IN + 2 * I_O + 2 * I_GD + I_DD;
        const int ln = F.lane;
        for (int it = gw; it < N_A; it += NGW) {
            int r = it;
            if (r < 2 * I_IN) { const int l = r / I_IN; r %= I_IN; const int kb = r / 44, nb = r % 44, c0 = 512 + 64 * nb;
                const int n32 = ln & 31; const int dn = c0 < OFFV ? (ln & 32) + ((n32 < 16) ? 2 * n32 : 2 * (n32 - 16) + 1) : ln;
                int drow = c0 + dn;
                if (c0 >= OFFG) { const int gcol = c0 - OFFG; drow = gcol < D ? OFFG + (gcol >> 7) * 256 + (gcol & 127) + ln : OFFG + ((gcol - D) >> 7) * 256 + 128 + ((gcol - D) & 127) + ln; }
                p0_transpose_item(in[8] + (size_t)l * D * INW, INW, 64 * kb, c0, (bf16_t*)(F.ws + (l ? WS_WIN1 : WS_WIN0)), D, drow, ln); continue; }
            r -= 2 * I_IN;
            if (r < 2 * I_O) { const int l = r / I_O; r %= I_O; const int kb = r / 16, nb = r % 16;
                p0_transpose_item(in[12] + (size_t)l * D * D, D, 64 * kb, 64 * nb, (bf16_t*)(F.ws + (l ? WS_WO1 : WS_WO0)), D, 64 * nb + ln, ln); continue; }
            r -= 2 * I_O;
            if (r < 2 * I_GD) { const int up = r / I_GD; r %= I_GD; const int kb = r / 44, nb = r % 44, c0 = 64 * nb;
                p0_transpose_item(in[up ? 14 : 13], DFF0, 64 * kb, c0, (bf16_t*)(F.ws + WS_WGUD), D, (c0 >> 7) * 256 + up * 128 + (c0 & 127) + ln, ln); continue; }
            r -= 2 * I_GD;
            { const int kb = r / 16, nb = r % 16;
              p0_transpose_item(in[15], D, 64 * kb, 64 * nb, (bf16_t*)(F.ws + WS_WDD), DFF0, 64 * nb + ln, ln); }
        }
    }
    __syncthreads();
    {
        LAS float* wrow = (LAS float*)F.lds;
        LAS float* ctab = wrow + 4096;
        if (F.tid < 128) ctab[F.tid] = cospif((float)F.tid / 64.0f);
        for (int it = F.bx; it < 2 * 128; it += F.G) {
            const int l = it >> 7, d0 = (it & 127) * 8;
            __syncthreads();
            for (int i = F.tid; i < 4096; i += NTHR) wrow[i] = in[8][(size_t)l * D * INW + (size_t)(d0 + (i >> 9)) * INW + (i & 511)];
            __syncthreads();
            const int r = F.tid, j = r >> 1, ri = r & 1, g = j >> 6, jj = j & 63;
            float a[8];
#pragma unroll
            for (int q = 0; q < 8; ++q) a[q] = 0.f;
            for (int cc = 0; cc < 128; ++cc) {
                float cf;
                if (jj == 0) cf = ri ? ((cc & 1) ? -1.f : 1.f) : 1.f;
                else { const int idx = (cc * jj) & 127; cf = ri ? -ctab[(idx - 32) & 127] : ctab[idx]; }
#pragma unroll
                for (int q = 0; q < 8; ++q) a[q] += cf * wrow[q * 512 + g * 128 + cc];
            }
            u32x4 o; o.x = pk2(a[0], a[1]); o.y = pk2(a[2], a[3]); o.z = pk2(a[4], a[5]); o.w = pk2(a[6], a[7]);
            *(u32x4*)((bf16_t*)(F.ws + (l ? WS_WIN1 : WS_WIN0)) + (size_t)r * D + d0) = o;
        }
        __syncthreads();
    }
    const int gt = F.bx * NTHR + F.tid, NGT = F.G * NTHR;
    for (int it = gt; it < 2 * 1024 * 144; it += NGT) {
        const int l = it / (1024 * 144), r = it % (1024 * 144), kc = r / 1024, o = r % 1024;
        const float* wf = in[10] + (size_t)l * 512 * D; const float* wa = in[11] + (size_t)l * 512 * D;
        float v[8];
#pragma unroll
        for (int q = 0; q < 8; ++q) { const int k = kc * 8 + q; float x = 0.f;
            if (k < 512) { const int mm = k & 127; x = wf[(size_t)k * D + o] * ((mm == 0 || mm == 64) ? 0.5f : 1.f); }
            else if (k < 520) { const int gg = (k - 512) >> 1, sgn = (k - 512) & 1; x = 0.5f * wf[(size_t)(gg * 128 + 64 * sgn) * D + o]; }
            else if (k >= 640) x = wa[(size_t)(k - 640) * D + o];
            v[q] = x; }
        u32x4 w; w.x = pk2(v[0], v[1]); w.y = pk2(v[2], v[3]); w.z = pk2(v[4], v[5]); w.w = pk2(v[6], v[7]);
        *(u32x4*)((bf16_t*)(F.ws + (l ? WS_WM1 : WS_WM0)) + (size_t)o * KM + kc * 8) = w;
    }
    for (int it = gt; it < 192 * 16; it += NGT) {
        const int i = it & 15, p = it >> 4, pos = p < 128 ? p : p - 128;
        const float inv = powf(10000.0f, -(float)i / 16.0f), a = (float)pos * inv;
        ((f32x2*)(F.ws + WS_ROPE))[it] = (f32x2){cosf(a), sinf(a)};
    }
    for (int it = gt; it < 128 * 64; it += NGT) {
        const int t2 = it >> 6, k1 = it & 63; float s, c; sincospif((float)(t2 * k1) / 4096.0f, &s, &c);
        ((f32x2*)(F.ws + WS_TW))[it] = (f32x2){c, s};
    }
    for (int it = gt; it < 256 * 128; it += NGT) {
        const int nu = it >> 7, ka = it & 127; float v = 0.f;
        if (nu < 128) { const int k1 = nu >> 1, ro = nu & 1, ri = ka >> 6, t1 = ka & 63; float s, c; sincospif((float)((t1 * k1) & 63) / 32.0f, &s, &c);
            v = ro == 0 ? (ri == 0 ? c : s) : (ri == 0 ? -s : c); }
        ((bf16_t*)(F.ws + WS_FA64))[it] = (bf16_t)f2bf(v);
    }
    for (int it = gt; it < 256 * 256; it += NGT) {
        const int mu = it >> 8, la = it & 255, k2 = mu >> 1, ro = mu & 1, ri = la >> 7, t2 = la & 127; float s, c; sincospif((float)((t2 * k2) & 127) / 64.0f, &s, &c);
        const float v = (ro == 0 ? (ri == 0 ? c : s) : (ri == 0 ? -s : c)) * 0.0009765625f;
        ((bf16_t*)(F.ws + WS_TC))[it] = (bf16_t)f2bf(v);
    }
    for (int it = gt; it < 512 * 512; it += NGT) {
        const int mu = it >> 9, la = it & 511, k = mu >> 1, ro = mu & 1, ri = la >> 8, t = la & 255; float s, c; sincospif((float)((t * k) & 255) / 128.0f, &s, &c);
        const float v = (ro == 0 ? (ri == 0 ? c : s) : (ri == 0 ? -s : c)) * 0.005524271728019903f;
        ((bf16_t*)(F.ws + WS_TX))[it] = (bf16_t)f2bf(v);
    }
    __syncthreads();
    {
        LAS float* sl = (LAS float*)F.lds;
        LAS float* part = sl + 3 * D;
        for (int i = F.tid; i < 3 * D; i += NTHR) { const float c = i < 2 * D ? in[1][i] : in[3][i - 2 * D]; sl[i] = c / (1.0f + __expf(-c)); }
        __syncthreads();
        for (int it = F.bx; it < 2 * 96; it += F.G) {
            const int l = it / 96, n = (it % 96) * 64 + F.lane;
            const float* wm = in[4] + (size_t)l * D * MODSZ + (size_t)(F.wave * 128) * MODSZ + n;
            float a0 = 0.f, a1 = 0.f, a2 = 0.f;
#pragma unroll
            for (int d0 = 0; d0 < 128; d0 += 32) { float w[32];
#pragma unroll
                for (int q = 0; q < 32; ++q) w[q] = wm[(size_t)(d0 + q) * MODSZ];
#pragma unroll
                for (int q = 0; q < 32; ++q) { const int d = F.wave * 128 + d0 + q; a0 += sl[d] * w[q]; a1 += sl[D + d] * w[q]; a2 += sl[2 * D + d] * w[q]; } }
            __syncthreads();
            part[(F.wave * 3 + 0) * 64 + F.lane] = a0; part[(F.wave * 3 + 1) * 64 + F.lane] = a1; part[(F.wave * 3 + 2) * 64 + F.lane] = a2;
            __syncthreads();
            if (F.tid < 192) { const int v = F.tid >> 6, ln = F.tid & 63; float sacc = in[5][l * MODSZ + (it % 96) * 64 + ln];
#pragma unroll
                for (int w = 0; w < 8; ++w) sacc += part[(w * 3 + v) * 64 + ln];
                modp(F, l, v)[(it % 96) * 64 + ln] = sacc; }
        }
    }
    for (int it = gt; it < NTOK * 15; it += NGT) { const int row = it / 15, c = it % 15;
        *(u32x4*)((bf16_t*)(F.ws + WS_FO) + (size_t)row * KM + 520 + c * 8) = (u32x4){0u, 0u, 0u, 0u}; }
}

__device__ __forceinline__ const float* xrow_ptr(const Frame& F, int row, const float* xl) { return row < NL ? xl + (size_t)row * D : (const float*)(F.ws + WS_XC) + (size_t)(row - NL) * D; }

template <bool ROUTE>
__device__ __forceinline__ void norm_phase(Frame& F, int l, int which  , const float* xl, const float* xc, int nrows, const float* xcadd = nullptr, float* xcwb = nullptr) {
    const float* gvec = F.in[which ? 7 : 6] + l * D;
    LAS float* wr_l = (LAS float*)F.lds;
    constexpr int RMAX = 32;
    LAS int* pe = (LAS int*)(F.lds + 32768); LAS float* pw = (LAS float*)(F.lds + 32768 + 2048); LAS unsigned* lcnt = (LAS unsigned*)(F.lds + 32768 + 4096); LAS unsigned* gb = lcnt + 8;
    if (ROUTE) { for (int i = F.tid; i < D * NE; i += NTHR) wr_l[i] = F.in[16][i]; pe[F.tid] = -1; if (F.tid < 8) lcnt[F.tid] = 0u; __syncthreads(); }
    const int gw = F.bx * NWAVES + F.wave, NGW = F.G * NWAVES;
    int iter = 0;
    for (int row = gw; row < nrows; row += NGW, ++iter) {
        const int v = row < T ? 0 : (row < NL ? 1 : 2);
        const bool fromb = row < NL && xl == nullptr;
        const float* xr = row < NL ? (fromb ? xc : xl + (size_t)row * D) : xc + (size_t)(row - NL) * D;
        const bf16_t* xbr = (const bf16_t*)(F.ws + WS_XB) + (size_t)row * D;
        const float* sh = modp(F, l, v) + (which ? 3 : 0) * D; const float* sc = sh + D;
        f32x4 x[4]; float s = 0.f;
#pragma unroll
        for (int j = 0; j < 4; ++j) {
            if (fromb) { const u32x2 xb = *(const u32x2*)(xbr + 256 * j + 4 * F.lane); x[j] = (f32x4){bflo(xb.x), bfhi(xb.x), bflo(xb.y), bfhi(xb.y)}; }
            else x[j] = *(const f32x4*)(xr + 256 * j + 4 * F.lane);
            if (row >= NL && xcadd) { x[j] = x[j] + *(const f32x4*)(xcadd + (size_t)(row - NL) * D + 256 * j + 4 * F.lane); if (xcwb) *(f32x4*)(xcwb + (size_t)(row - NL) * D + 256 * j + 4 * F.lane) = x[j]; }
            s += (x[j].x * x[j].x + x[j].y * x[j].y) + (x[j].z * x[j].z + x[j].w * x[j].w); }
        const float r = 1.0f / sqrtf(wave_sum(s) * (1.f / D) + EPS);
        float lg[NE];
        if (ROUTE) {
#pragma unroll
            for (int e = 0; e < NE; ++e) lg[e] = 0.f; }
        bf16_t* hr = (bf16_t*)(F.ws + WS_H) + (size_t)row * D;
#pragma unroll
        for (int j = 0; j < 4; ++j) { const int c = 256 * j + 4 * F.lane;
            const f32x4 gg = *(const f32x4*)(gvec + c), s4 = *(const f32x4*)(sh + c), c4 = *(const f32x4*)(sc + c);
            f32x4 h = (x[j] * r) * gg; h = h * (c4 + 1.0f) + s4;
            if (ROUTE) *(unsigned*)((unsigned char*)(F.ws + WS_H) + (size_t)row * D + c) = pk4f8(h.x, h.y, h.z, h.w);
            else { u32x2 o; o.x = pk2(h.x, h.y); o.y = pk2(h.z, h.w); *(u32x2*)(hr + c) = o; }
            if (ROUTE) {
#pragma unroll
                for (int q = 0; q < 4; ++q) { const float hv = h[q]; const LAS f32x4* w = (const LAS f32x4*)(wr_l + (c + q) * NE); const f32x4 w0 = w[0], w1 = w[1];
                    lg[0] += hv * w0.x; lg[1] += hv * w0.y; lg[2] += hv * w0.z; lg[3] += hv * w0.w; lg[4] += hv * w1.x; lg[5] += hv * w1.y; lg[6] += hv * w1.z; lg[7] += hv * w1.w; } }
        }
        if (ROUTE) {
#pragma unroll
            for (int e = 0; e < NE; ++e) lg[e] = wave_sum(lg[e]);
            if (F.lane == 0) {
                int e1 = 0; float v1 = lg[0];
#pragma unroll
                for (int e = 1; e < NE; ++e) if (lg[e] > v1) { v1 = lg[e]; e1 = e; }
                int e2 = -1; float v2 = -3.0e38f;
#pragma unroll
                for (int e = 0; e < NE; ++e) if (e != e1 && lg[e] > v2) { v2 = lg[e]; e2 = e; }
                const float p2 = __expf(v2 - v1), w1 = 1.f / (1.f + p2), w2 = p2 * w1;
                const int p = 2 * (F.wave * RMAX + iter);
                pe[p] = e1; pe[p + 1] = e2; pw[p] = w1; pw[p + 1] = w2;
            }
        }
    }
    if (ROUTE) {
        __syncthreads();
        const int p = F.tid, e = pe[p]; unsigned lr = 0u;
        if (e >= 0) lr = __hip_atomic_fetch_add(lcnt + e, 1u, __ATOMIC_RELAXED, __HIP_MEMORY_SCOPE_WORKGROUP);
        __syncthreads();
        if (F.tid < NE && lcnt[F.tid] > 0u) gb[F.tid] = atomicAdd((unsigned*)(F.ws + WS_CTL) + CW_CNT + 64 * F.tid, lcnt[F.tid]);
        __syncthreads();
        if (e >= 0) {
            const int slot = p >> 1, row = F.bx * NWAVES + slot / RMAX + (slot % RMAX) * NGW, r = (int)(gb[e] + lr);
            int* toke = (int*)(F.ws + WS_TOKE); int* tokr = (int*)(F.ws + WS_TOKR); float* tokw = (float*)(F.ws + WS_TOKW); int* list = (int*)(F.ws + WS_LIST);
            toke[2 * row + (p & 1)] = e; tokr[2 * row + (p & 1)] = r; tokw[2 * row + (p & 1)] = pw[p]; list[e * NL + r] = row;
        }
        __syncthreads();
    }
}

constexpr int TAILQ_ROWS = 8 * 256;
__device__ __forceinline__ int moe_tail_panels(const unsigned* cw, int G) { int ptot = 0, plast = 0;
#pragma unroll
    for (int e = 0; e < NE; ++e) { const int p_ = ((int)cw[64 * e] + 255) >> 8; ptot += p_; plast = p_; }
    const int left = (4 * ptot) % G; int t = (left + 3) >> 2; if (4 * ptot < G) t = 0; if (t > plast) t = plast; if (t > 8) t = 8; return t; }
__device__ __forceinline__ void final_phase(Frame& F) {
    int t_ = threadIdx.x; asm volatile("" : "+v"(t_)); const int lane_ = t_ & 63;
    const int gw = F.bx * NWAVES + F.wave, NGW = F.G * NWAVES;
    const unsigned* cnt = (const unsigned*)(F.ws + WS_CTL) + CW_CNT;
    int base[NE]; { int b = 0;
#pragma unroll
        for (int e = 0; e < NE; ++e) { base[e] = b; b += ((int)cnt[64 * e] + 255) & ~255; } }
    const int* toke = (const int*)(F.ws + WS_TOKE); const int* tokr = (const int*)(F.ws + WS_TOKR); const float* tokw = (const float*)(F.ws + WS_TOKW);
    const bf16_t* dout = (const bf16_t*)(F.ws + WS_DOUT); const bf16_t* tq = (const bf16_t*)(F.ws + WS_DOUT1);
    const int trim_ = moe_tail_panels(cnt, F.G), trow0 = trim_ > 0 ? base[NE - 1] + ((((int)cnt[64 * (NE - 1)] + 255) >> 8) - trim_) * 256 : 0x7fffffff;
    for (int row = gw; row < NL; row += NGW) {
        const int v = row < T ? 0 : 1;
        const float* ga2 = modp(F, 1, v) + 5 * D;
        const int e1 = toke[2 * row], e2 = toke[2 * row + 1];
        int b1 = 0, b2 = 0;
#pragma unroll
        for (int e = 0; e < NE; ++e) { if (e == e1) b1 = base[e]; if (e == e2) b2 = base[e]; }
        const bf16_t* d1 = dout + (size_t)(b1 + tokr[2 * row]) * D; const bf16_t* d2 = dout + (size_t)(b2 + tokr[2 * row + 1]) * D;
        const int r1_ = b1 + tokr[2 * row], r2_ = b2 + tokr[2 * row + 1];
        const bool t1 = r1_ >= trow0, t2 = r2_ >= trow0;
        const bf16_t* q1 = tq + (size_t)(t1 ? r1_ - trow0 : 0) * D; const bf16_t* q2 = tq + (size_t)(t2 ? r2_ - trow0 : 0) * D;
        const float w1 = tokw[2 * row], w2 = tokw[2 * row + 1];
        float* xr = F.out + (size_t)row * D;
        f32x4 x[4]; float s = 0.f;
#pragma unroll
        for (int j = 0; j < 4; ++j) { const int c = 256 * j + 4 * lane_;
            const u32x2 a = *(const u32x2*)(d1 + c), b = *(const u32x2*)(d2 + c); const f32x4 g4 = *(const f32x4*)(ga2 + c);
            f32x4 ya = (f32x4){bflo(a.x), bfhi(a.x), bflo(a.y), bfhi(a.y)}, yb = (f32x4){bflo(b.x), bfhi(b.x), bflo(b.y), bfhi(b.y)};
            if (t1) {
#pragma unroll
                for (int k = 0; k < 1; ++k) { const u32x2 e_ = *(const u32x2*)(q1 + (size_t)k * TAILQ_ROWS * D + c); ya = ya + (f32x4){bflo(e_.x), bfhi(e_.x), bflo(e_.y), bfhi(e_.y)}; } }
            if (t2) {
#pragma unroll
                for (int k = 0; k < 1; ++k) { const u32x2 e_ = *(const u32x2*)(q2 + (size_t)k * TAILQ_ROWS * D + c); yb = yb + (f32x4){bflo(e_.x), bfhi(e_.x), bflo(e_.y), bfhi(e_.y)}; } }
            const f32x4 y = (ya * w1 + yb * w2) * (1.0f / (float)(QDN * QACT));
            { const u32x2 xb = *(const u32x2*)((const bf16_t*)(F.ws + WS_XB) + (size_t)row * D + c); x[j] = (f32x4){bflo(xb.x), bfhi(xb.x), bflo(xb.y), bfhi(xb.y)} + g4 * y; }
            s += (x[j].x * x[j].x + x[j].y * x[j].y) + (x[j].z * x[j].z + x[j].w * x[j].w); }
        const float r = 1.0f / sqrtf(wave_sum(s) * (1.f / D) + EPS);
#pragma unroll
        for (int j = 0; j < 4; ++j) { const int c = 256 * j + 4 * lane_; *(f32x4*)(xr + c) = (x[j] * r) * *(const f32x4*)(F.in[20] + c); }
    }
}

struct GridSched { int nM, nN, G, c; unsigned abytes, bbytes;
    __device__ __forceinline__ bool next(int i, Unit& u) const { const int L = i * G + c; if (L >= nM * nN) return false; pg8::swz_map(L, nM, nN, u.pm, u.pn); u.aoff = (unsigned)u.pm * abytes; u.boff = (unsigned)u.pn * bbytes; u.kind = 0; u.x0 = 0; u.x1 = 0; u.kh = 0; return true; } };

struct CtxSched { int G, c, nN; unsigned abytes, bbytes; int ksplit; unsigned khbytes;
    __device__ __forceinline__ bool next(int i, Unit& u) const { int L = i * G + c; if (L >= 2 * nN * ksplit) return false; u.kh = L / (2 * nN); L -= u.kh * 2 * nN; u.pm = 64 + L / nN; u.pn = L % nN;
        u.aoff = (unsigned)u.pm * abytes + (unsigned)u.kh * khbytes; u.boff = (unsigned)u.pn * bbytes + (unsigned)u.kh * khbytes; u.kind = 0; u.x0 = u.pm * 256; u.x1 = 0; return true; } };

struct InprojSched { int G, c, l;
    __device__ __forceinline__ bool next(int i, Unit& u) const { const int L = i * G + c; const int nmain = 64 * 11;
        if (L < nmain) { pg8::swz_map(L, 64, 11, u.pm, u.pn); }
        else { const int r = L - nmain; if (l == 0) { if (r >= 22) return false; u.pm = 64 + r / 11; u.pn = r % 11; } else { if (r >= 2) return false; u.pm = 64 + r; u.pn = 2; } }
        u.aoff = (unsigned)u.pm * (256u * D * 2u); u.boff = (unsigned)u.pn * (256u * D * 2u); u.kind = 0; u.x0 = 0; u.x1 = 0; u.kh = 0; return true; } };

struct EpiInproj {
    static constexpr bool PERM = true; static constexpr int MIDK = 0;
    unsigned char* ws;
    __device__ __forceinline__ void operator()(const f32x4 (&acc)[2][2][4][2], const Unit& u, int wr, int wc, int fr, int fq) const {
        const int row0 = u.pm * 256 + wr * 64 + fr;
        const bool lat = u.pm < 64;
        const f32x2* rope = (const f32x2*)(ws + WS_ROPE);
#pragma unroll
        for (int ai = 0; ai < 2; ++ai)
#pragma unroll
            for (int m = 0; m < 4; ++m) {
                const int row = row0 + ai * 128 + m * 16;
                const int t = row & (T - 1), prow = t >> 6, pcol = t & 63;
#pragma unroll
                for (int bj = 0; bj < 2; ++bj) {
                    const int cl = u.pn * 256 + bj * 128 + wc * 32 + 8 * fq;
                    f32x4 v0 = acc[ai][bj][m][0], v1 = acc[ai][bj][m][1];
                    bf16_t* dst;
                    if (cl < 640) {
                        if (lat) { const int dh = cl & 63, i0 = (dh & 31) >> 1; const f32x2* rp = rope + ((dh < 32 ? prow : 128 + pcol) * 16 + i0);
                            const f32x2 c0 = rp[0], c1 = rp[1], c2 = rp[2], c3 = rp[3];
                            f32x4 w0, w1; w0.x = v0.x * c0.x - v0.y * c0.y; w0.y = v0.x * c0.y + v0.y * c0.x; w0.z = v0.z * c1.x - v0.w * c1.y; w0.w = v0.z * c1.y + v0.w * c1.x;
                            w1.x = v1.x * c2.x - v1.y * c2.y; w1.y = v1.x * c2.y + v1.y * c2.x; w1.z = v1.z * c3.x - v1.w * c3.y; w1.w = v1.z * c3.y + v1.w * c3.x; v0 = w0; v1 = w1; }
                        if (cl < 512) { v0 = v0 * QSCALE; v1 = v1 * QSCALE; dst = (bf16_t*)(ws + WS_Q) + (size_t)row * 512 + cl; }
                        else dst = (bf16_t*)(ws + WS_KB) + (size_t)row * 128 + (cl - 512);
                    } else if (cl < 768) { dst = (bf16_t*)(ws + WS_VB) + (size_t)row * 128 + (cl - 640); }
                    else {
                        const int oc = (u.pn - 3) * 128 + wc * 32 + 8 * fq;
                        if (bj == 0) { const f32x4 a0 = acc[ai][1][m][0], a1 = acc[ai][1][m][1];
#pragma unroll
                            for (int q = 0; q < 4; ++q) { v0[q] = sigmoidf_(v0[q]) * (1.0f + __builtin_amdgcn_exp2f(-a0[q] * LOG2E)); v1[q] = sigmoidf_(v1[q]) * (1.0f + __builtin_amdgcn_exp2f(-a1[q] * LOG2E)); }
                            dst = (bf16_t*)(ws + WS_GF) + (size_t)row * D + oc; }
                        else {
#pragma unroll
                            for (int q = 0; q < 4; ++q) { v0[q] = sigmoidf_(v0[q]); v1[q] = sigmoidf_(v1[q]); }
                            dst = (bf16_t*)(ws + WS_GA) + (size_t)row * D + oc; } }
                    u32x4 w; w.x = cvt_pk_bf16(v0[0], v0[1]); w.y = cvt_pk_bf16(v0[2], v0[3]); w.z = cvt_pk_bf16(v1[0], v1[1]); w.w = cvt_pk_bf16(v1[2], v1[3]);
                    *(u32x4*)dst = w;
                }
            }
    }
};

struct UpermSched { int G, c, l;
    __device__ __forceinline__ bool next(int i, Unit& u) const { const int L = i * G + c; const int nn = l == 0 ? 66 : 64; if (L >= 2 * nn) return false;
        u.pm = L & 1; u.pn = L >> 1; u.aoff = (unsigned)u.pm * (256u * D * 2u); u.boff = 0; u.kind = 0; u.x0 = 0; u.x1 = 0; u.kh = 0; return true; } };
struct UpermRows { static constexpr bool GA = false, GB = true;
    __device__ __forceinline__ unsigned arow(const Unit&, int) const { return 0u; }
    __device__ __forceinline__ unsigned brow(const Unit& u, int c) const { const int n = u.pn; int row;
        if (n < 64) { const int b = n >> 5, q = n & 31; row = b * T + 128 * (c & 63) + 4 * q + (c >> 6); } else row = NL + (n - 64) * 256 + c;
        return (unsigned)row * (D * 2u); } };
struct EpiUperm {
    static constexpr bool PERM = true; static constexpr int MIDK = 0;
    unsigned char* ws;
    __device__ __forceinline__ void operator()(const f32x4 (&acc)[2][2][4][2], const Unit& u, int wr, int wc, int fr, int fq) const {
        const int n = u.pn;
#pragma unroll
        for (int ai = 0; ai < 2; ++ai)
#pragma unroll
            for (int m = 0; m < 4; ++m) { const int r = u.pm * 256 + ai * 128 + wr * 64 + m * 16 + fr, j = r >> 1, ri = r & 1;
#pragma unroll
                for (int bj = 0; bj < 2; ++bj) { const int c = bj * 128 + wc * 32 + 8 * fq;
                    const f32x4 v0 = acc[ai][bj][m][0], v1 = acc[ai][bj][m][1];
                    u32x4 w; w.x = cvt_pk_bf16(v0[0], v0[1]); w.y = cvt_pk_bf16(v0[2], v0[3]); w.z = cvt_pk_bf16(v1[0], v1[1]); w.w = cvt_pk_bf16(v1[2], v1[3]);
                    bf16_t* dst;
                    if (n < 64) { const int b = n >> 5, q = n & 31, t2 = 4 * q + (c >> 6), t1 = c & 63; dst = (bf16_t*)(ws + WS_UP) + ((size_t)((j * 2 + b) * 128 + t2) * 128 + ri * 64 + t1); }
                    else { const int b = n - 64; dst = (bf16_t*)(ws + WS_VCT) + ((size_t)((b * 256 + j) * 2 + ri) * 256 + c); }
                    *(u32x4*)dst = w; } }
    }
};

struct StepASched { int G, c, l;
    __device__ __forceinline__ bool next(int i, Unit& u) const { int L = i * G + c;
        if (l == 0 && G == 256) { if (c >= 16 && c < 20) return false; if (c >= 20 && c < 24) { if (i > 1) return false; L = i == 0 ? c : c - 4; } else if (i > 0) return false; }
        if (L >= 256) return false; pg8::swz_map(L, 256, 1, u.pm, u.pn); u.aoff = (unsigned)u.pm * (256u * 128u * 2u); u.boff = 0u; u.kind = 0; u.x0 = 0; u.x1 = 0; u.kh = 0; return true; } };

struct EpiStepA {
    static constexpr bool PERM = true; static constexpr int MIDK = 0;
    unsigned char* ws;
    __device__ __forceinline__ void operator()(const f32x4 (&acc)[2][2][4][2], const Unit& u, int wr, int wc, int fr, int fq) const {
        const f32x2* tw = (const f32x2*)(ws + WS_TW); bf16_t* gp = (bf16_t*)(ws + WS_GP);
        const int j = u.pm;
#pragma unroll
        for (int ai = 0; ai < 2; ++ai)
#pragma unroll
            for (int m = 0; m < 4; ++m) { const int t2 = wr * 64 + m * 16 + fr, b = ai;
#pragma unroll
                for (int n = 0; n < 2; ++n) { const f32x4 v = acc[ai][0][m][n];
#pragma unroll
                    for (int p = 0; p < 2; ++p) { const int k1 = 16 * wc + 4 * fq + 2 * n + p; const f32x2 w = tw[t2 * 64 + k1];
                        const float gr = v[2 * p], gi = v[2 * p + 1];
                        const float orr = gr * w.x + gi * w.y, oi = gi * w.x - gr * w.y;
                        bf16_t* d = gp + ((size_t)((b * 64 + k1) * 256 + j) * 256 + t2);
                        d[0] = (bf16_t)f2bf(orr); d[128] = (bf16_t)f2bf(oi); } } }
    }
};
template <bool CTXV> struct EpiStepC {
    static constexpr bool PERM = true; static constexpr int MIDK = 0;
    unsigned char* ws;
    __device__ __forceinline__ void operator()(const f32x4 (&acc)[2][2][4][2], const Unit& u, int wr_, int wc_, int fr_, int fq_) const {
        int wr = wr_, wc = wc_, fr = fr_, fq = fq_, upm = u.pm, upn = u.pn;
        asm volatile("" : "+s"(wr), "+s"(wc), "+v"(fr), "+v"(fq), "+s"(upm), "+s"(upn));
        bf16_t* fo = (bf16_t*)(ws + WS_FO);
        const int NN = CTXV ? 256 : T;
        const int b = CTXV ? upm : (upm >> 6), k1 = CTXV ? 0 : (upm & 63), rowb = CTXV ? NL + b * 256 : b * T;
        const int own0 = wr * 128 + fr, mir0 = wr * 128 + 128 - fr;
        const int kk0 = (CTXV ? 128 * upn : 0) + 16 * wc + 4 * fq;
#pragma unroll
        for (int bj = 0; bj < 2; ++bj)
#pragma unroll
            for (int n = 0; n < 2; ++n)
#pragma unroll
                for (int p = 0; p < 2; ++p) {
                    const int kk = kk0 + 64 * bj + 2 * n + p;
                    const int k = CTXV ? kk : (k1 + 64 * kk), km = (NN - k) & (NN - 1);
                    const unsigned oo = (unsigned)(rowb + k) * KM, om = (unsigned)(rowb + km) * KM;
#pragma unroll
                    for (int ai = 0; ai < 2; ++ai)
#pragma unroll
                        for (int m = 0; m < 4; ++m) {
                            const f32x4 v = acc[ai][bj][m][n];
                            const bf16_t re = (bf16_t)f2bf(v[2 * p]);
                            if (m == 0 && fr == 0) { const int g = 2 * ai + wr; const bf16_t im = (bf16_t)f2bf(v[2 * p + 1]);
                                fo[oo + g * 128] = re; fo[om + 512 + 2 * g] = re; fo[oo + g * 128 + 64] = im; fo[om + 512 + 2 * g + 1] = im; }
                            else { fo[oo + own0 + ai * 256 + 16 * m] = re; fo[om + mir0 + ai * 256 - 16 * m] = re; }
                        }
                    asm volatile("" ::: "memory"); __builtin_amdgcn_sched_barrier(0);
                }
    }
};

struct EpiMerge {
    static constexpr bool PERM = true; static constexpr int MIDK = 10;
    unsigned char* ws;
    __device__ __forceinline__ void mid(f32x4 (&acc)[2][2][4][2], const Unit& u, int wr, int wc, int fr, int fq) const {
        asm volatile("" : "+v"(fr), "+v"(fq));
#pragma unroll
        for (int ai = 0; ai < 2; ++ai)
#pragma unroll
            for (int m = 0; m < 4; ++m) { const size_t row = (size_t)(u.pm * 256 + ai * 128 + wr * 64 + m * 16 + fr);
#pragma unroll
                for (int bj = 0; bj < 2; ++bj) { const int col = u.pn * 256 + bj * 128 + wc * 32 + 8 * fq;
                    const u32x4 gr = *(const u32x4*)((const bf16_t*)(ws + WS_GF) + row * D + col);
                    const f32x4 r0 = (f32x4){bflo(gr.x), bfhi(gr.x), bflo(gr.y), bfhi(gr.y)}, r1 = (f32x4){bflo(gr.z), bfhi(gr.z), bflo(gr.w), bfhi(gr.w)};
                    acc[ai][bj][m][0] = acc[ai][bj][m][0] * r0; acc[ai][bj][m][1] = acc[ai][bj][m][1] * r1; } }
    }
    __device__ __forceinline__ void operator()(const f32x4 (&acc)[2][2][4][2], const Unit& u, int wr, int wc, int fr, int fq) const {
#pragma unroll
        for (int ai = 0; ai < 2; ++ai)
#pragma unroll
            for (int m = 0; m < 4; ++m) { const size_t row = (size_t)(u.pm * 256 + ai * 128 + wr * 64 + m * 16 + fr);
#pragma unroll
                for (int bj = 0; bj < 2; ++bj) { const int col = u.pn * 256 + bj * 128 + wc * 32 + 8 * fq;
                    const u32x4 ga = *(const u32x4*)((const bf16_t*)(ws + WS_GA) + row * D + col);
                    const f32x4 a0 = acc[ai][bj][m][0], a1 = acc[ai][bj][m][1];
                    u32x4 w;
                    w.x = cvt_pk_bf16(bflo(ga.x) * a0[0], bfhi(ga.x) * a0[1]); w.y = cvt_pk_bf16(bflo(ga.y) * a0[2], bfhi(ga.y) * a0[3]);
                    w.z = cvt_pk_bf16(bflo(ga.z) * a1[0], bfhi(ga.z) * a1[1]); w.w = cvt_pk_bf16(bflo(ga.w) * a1[2], bfhi(ga.w) * a1[3]);
                    *(u32x4*)((bf16_t*)(ws + WS_Y) + row * D + col) = w; } }
    }
};

struct EpiResid {
    static constexpr bool PERM = true; static constexpr int MIDK = 0;
    const float* xl_in32; const bf16_t* xl_inb; bf16_t* xl_out; const float* xc_in; float* xc_out; const float* mod_l; int chunk; float* tmpc;
    __device__ __forceinline__ void operator()(const f32x4 (&acc)[2][2][4][2], const Unit& u, int wr, int wc, int fr, int fq) const {
        const int v = u.pm < 32 ? 0 : (u.pm < 64 ? 1 : 2);
        const float* gate = mod_l + v * MODSZ + chunk * D;
        const bool lat = u.pm < 64; const int rbase = lat ? u.pm * 256 : (u.pm - 64) * 256;
#pragma unroll
        for (int bj = 0; bj < 2; ++bj) { const int col = u.pn * 256 + bj * 128 + wc * 32 + 8 * fq;
            const f32x4 g0 = *(const f32x4*)(gate + col), g1 = *(const f32x4*)(gate + col + 4);
#pragma unroll
            for (int ai = 0; ai < 2; ++ai)
#pragma unroll
                for (int m = 0; m < 4; ++m) { const size_t o = (size_t)(rbase + ai * 128 + wr * 64 + m * 16 + fr) * D + col;
                    if (lat) {
                        f32x4 x0, x1;
                        if (xl_in32) { x0 = *(const f32x4*)(xl_in32 + o); x1 = *(const f32x4*)(xl_in32 + o + 4); }
                        else { const u32x4 xb = *(const u32x4*)(xl_inb + o); x0 = (f32x4){bflo(xb.x), bfhi(xb.x), bflo(xb.y), bfhi(xb.y)}; x1 = (f32x4){bflo(xb.z), bfhi(xb.z), bflo(xb.w), bfhi(xb.w)}; }
                        x0 = x0 + g0 * acc[ai][bj][m][0]; x1 = x1 + g1 * acc[ai][bj][m][1];
                        u32x4 w; w.x = cvt_pk_bf16(x0[0], x0[1]); w.y = cvt_pk_bf16(x0[2], x0[3]); w.z = cvt_pk_bf16(x1[0], x1[1]); w.w = cvt_pk_bf16(x1[2], x1[3]);
                        *(u32x4*)(xl_out + o) = w;
                    } else if (u.kh) { *(f32x4*)(tmpc + o) = g0 * acc[ai][bj][m][0]; *(f32x4*)(tmpc + o + 4) = g1 * acc[ai][bj][m][1]; }
                    else { *(f32x4*)(xc_out + o) = *(const f32x4*)(xc_in + o) + g0 * acc[ai][bj][m][0];
                           *(f32x4*)(xc_out + o + 4) = *(const f32x4*)(xc_in + o + 4) + g1 * acc[ai][bj][m][1]; } } }
    }
};

struct EpiSwiglu {
    static constexpr bool PERM = true; static constexpr int MIDK = 0;
    bf16_t* act; int ld;
    __device__ __forceinline__ void operator()(const f32x4 (&acc)[2][2][4][2], const Unit& u, int wr, int wc, int fr, int fq) const {
        const int col = u.pn * 128 + wc * 32 + 8 * fq;
#pragma unroll
        for (int ai = 0; ai < 2; ++ai)
#pragma unroll
            for (int m = 0; m < 4; ++m) { const size_t row = (size_t)(u.x0 + ai * 128 + wr * 64 + m * 16 + fr);
                float o[8];
#pragma unroll
                for (int n = 0; n < 2; ++n)
#pragma unroll
                    for (int q = 0; q < 4; ++q) { const float gv = acc[ai][0][m][n][q], uv = acc[ai][1][m][n][q]; o[4 * n + q] = gv * sigmoidf_(gv) * uv; }
                u32x4 w; w.x = cvt_pk_bf16(o[0], o[1]); w.y = cvt_pk_bf16(o[2], o[3]); w.z = cvt_pk_bf16(o[4], o[5]); w.w = cvt_pk_bf16(o[6], o[7]);
                *(u32x4*)(act + row * ld + col) = w; }
    }
};
struct EpiSwiglu8 {
    static constexpr bool PERM = true; static constexpr int MIDK = 0;
    unsigned char* act; int ld;
    __device__ __forceinline__ void operator()(const f32x4 (&acc)[2][2][4][2], const Unit& u, int wr, int wc, int fr, int fq) const {
        asm volatile("" : "+v"(fr), "+v"(fq));
        const int col = u.pn * 128 + wc * 32 + 8 * fq;
#pragma unroll
        for (int ai = 0; ai < 2; ++ai)
#pragma unroll
            for (int m = 0; m < 4; ++m) { const size_t row = (size_t)(u.x0 + ai * 128 + wr * 64 + m * 16 + fr);
                float o[8];
#pragma unroll
                for (int n = 0; n < 2; ++n)
#pragma unroll
                    for (int q = 0; q < 4; ++q) { const float gv = acc[ai][0][m][n][q] * (1.0f / (float)QGU), uv = acc[ai][1][m][n][q] * ((float)QACT / (float)QGU);
                        o[4 * n + q] = __builtin_amdgcn_fmed3f(gv * sigmoidf_(gv) * uv, -448.0f, 448.0f); }
                u32x2 w; w.x = pk4f8(o[0], o[1], o[2], o[3]); w.y = pk4f8(o[4], o[5], o[6], o[7]);
                *(u32x2*)(act + row * ld + col) = w; }
    }
};
struct EpiBf16 {
    static constexpr bool PERM = true; static constexpr int MIDK = 0;
    bf16_t* O0; bf16_t* O1; int ld;
    __device__ __forceinline__ void operator()(const f32x4 (&acc)[2][2][4][2], const Unit& u, int wr, int wc, int fr, int fq) const {
        asm volatile("" : "+v"(fr), "+v"(fq));
#pragma unroll
        for (int ai = 0; ai < 2; ++ai)
#pragma unroll
            for (int m = 0; m < 4; ++m) { const size_t row = (size_t)(u.x0 + ai * 128 + wr * 64 + m * 16 + fr);
#pragma unroll
                for (int bj = 0; bj < 2; ++bj) { const int col = u.pn * 256 + bj * 128 + wc * 32 + 8 * fq; const f32x4 v0 = acc[ai][bj][m][0], v1 = acc[ai][bj][m][1];
                    u32x4 w; w.x = cvt_pk_bf16(v0[0], v0[1]); w.y = cvt_pk_bf16(v0[2], v0[3]); w.z = cvt_pk_bf16(v1[0], v1[1]); w.w = cvt_pk_bf16(v1[2], v1[3]);
                    *(u32x4*)((u.kh ? O1 : O0) + row * ld + col) = w; } }
    }
};

struct RowSched { int nM, nN, G, c; unsigned abytes, bbytes;
    __device__ __forceinline__ bool next(int i, Unit& u) const { const int L = i * G + c; if (L >= nM * nN) return false; pg8::swz_map(L, nM, nN, u.pm, u.pn); u.aoff = (unsigned)u.pm * abytes; u.boff = (unsigned)u.pn * bbytes; u.kind = 0; u.x0 = u.pm * 256; u.x1 = 0; u.kh = 0; return true; } };

struct MoeSched { int G, c, nN, ksplit, trim; unsigned bexp, bbytes, arow_bytes, khbytes; bool a_slots; int cnt[NE], base[NE];
    __device__ __forceinline__ void init(const unsigned* cw) { int b = 0;
#pragma unroll
        for (int e = 0; e < NE; ++e) { cnt[e] = (int)cw[64 * e]; base[e] = b; b += (cnt[e] + 255) & ~255; } }
    __device__ __forceinline__ bool next(int i, Unit& u) const { int L = i * G + c; int e = 0;
        for (; e < NE; ++e) { const int nu = (((cnt[e] + 255) >> 8) - (e == NE - 1 ? trim : 0)) * nN * ksplit; if (L < nu) break; L -= nu; }
        if (e >= NE) return false;
        int cn = 0, bs = 0;
#pragma unroll
        for (int q = 0; q < NE; ++q) if (q == e) { cn = cnt[q]; bs = base[q]; }
        const int np_ = ((cn + 255) >> 8) - (e == NE - 1 ? trim : 0); const int nt_ = np_ * nN; u.kh = L / nt_; L -= u.kh * nt_;
        pg8::swz_map(L, np_, nN, u.pm, u.pn);
        u.kind = e; u.x1 = cn; u.x0 = bs + u.pm * 256;
        u.aoff = (a_slots ? (unsigned)u.x0 * arow_bytes : 0u) + (unsigned)u.kh * khbytes; u.boff = (unsigned)e * bexp + (unsigned)u.pn * bbytes + (unsigned)u.kh * khbytes; return true; } };
struct MoeTailSched { int G, c, trim, plast, rbase; unsigned bexp;
    __device__ __forceinline__ bool next(int i, Unit& u) const { int L = i * G + c; if (L >= 8 * trim) return false; u.kh = L / (4 * trim); L -= u.kh * 4 * trim;
        u.pm = plast - trim + (L >> 2); u.pn = L & 3; u.kind = NE - 1; u.x1 = 0; u.x0 = rbase + u.pm * 256;
        u.aoff = (unsigned)u.x0 * (unsigned)DFFE + (unsigned)u.kh * (DFFE / 2u); u.boff = (unsigned)(NE - 1) * bexp + (unsigned)u.pn * (256u * DFFE) + (unsigned)u.kh * (DFFE / 2u); return true; } };
struct EpiTail {
    static constexpr bool PERM = true; static constexpr int MIDK = 0;
    bf16_t* O0; bf16_t* Q; int row0;
    __device__ __forceinline__ void operator()(const f32x4 (&acc)[2][2][4][2], const Unit& u, int wr, int wc, int fr, int fq) const {
        asm volatile("" : "+v"(fr), "+v"(fq));
#pragma unroll
        for (int ai = 0; ai < 2; ++ai)
#pragma unroll
            for (int m = 0; m < 4; ++m) { const int row = u.x0 + ai * 128 + wr * 64 + m * 16 + fr;
                bf16_t* dst = u.kh == 0 ? O0 + (size_t)row * D : Q + ((size_t)(u.kh - 1) * TAILQ_ROWS + (size_t)(row - row0)) * D;
#pragma unroll
                for (int bj = 0; bj < 2; ++bj) { const int col = u.pn * 256 + bj * 128 + wc * 32 + 8 * fq; const f32x4 v0 = acc[ai][bj][m][0], v1 = acc[ai][bj][m][1];
                    u32x4 w; w.x = cvt_pk_bf16(v0[0], v0[1]); w.y = cvt_pk_bf16(v0[2], v0[3]); w.z = cvt_pk_bf16(v1[0], v1[1]); w.w = cvt_pk_bf16(v1[2], v1[3]);
                    *(u32x4*)(dst + col) = w; } }
    }
};
struct MoeRows { static constexpr bool GA = true, GB = false; const int* list;
    __device__ __forceinline__ unsigned arow(const Unit& u, int r) const { int idx = u.pm * 256 + r; idx = idx < u.x1 ? idx : u.x1 - 1; return (unsigned)list[u.kind * NL + idx] * (unsigned)D; }
    __device__ __forceinline__ unsigned brow(const Unit&, int) const { return 0u; } };


constexpr int CW_QUEUE = 12288, CW_RDY = 65536;
template <int NG, bool MOE> struct FfnStream {
    int P[NG], rb[NG], cn[NG];
    int f, nNgu, Kdn; unsigned need;
    unsigned* q; volatile LAS unsigned* lw; unsigned* rdy; unsigned* tmo;
    __device__ __forceinline__ void finish_init(int G) { int sacc = 0; f = NG;
#pragma unroll
        for (int g = NG - 1; g >= 0; --g) { if (f == g + 1 && sacc + P[g] * 4 <= G) { sacc += P[g] * 4; f = g; } }
        if (f > NG - 1) f = NG - 1; }
    __device__ __forceinline__ bool decode(int L, SUnit& u) const {
        int pos = L, kind = -1, grp = 0, j = 0;
#pragma unroll
        for (int g = 0; g < NG; ++g) {
            { const int n = P[g] * nNgu; if (kind < 0) { if (pos < n) { kind = 0; grp = g; j = pos; } else pos -= n; } }
            if (g >= 1 && (g - 1) < f) { const int n = P[g - 1] * 4; if (kind < 0) { if (pos < n) { kind = 1; grp = g - 1; j = pos; } else pos -= n; } }
        }
#pragma unroll
        for (int g = 0; g < NG; ++g) if (g >= f) { const int n = P[g] * 4; if (kind < 0) { if (pos < n) { kind = 1; grp = g; j = pos; } else pos -= n; } }
        if (kind < 0) return false;
        int nM = 0, rbase = 0, cnt = 0;
#pragma unroll
        for (int g = 0; g < NG; ++g) if (g == grp) { nM = P[g]; rbase = rb[g]; cnt = cn[g]; }
        const int nN = kind == 0 ? nNgu : 4;
        const int nig = 8 * nN, gid = j / nig, fm = gid * 8, gsz = (nM - fm) < 8 ? (nM - fm) : 8;
        u.pm = fm + ((j % nig) % gsz); u.pn = (j % nig) / gsz; u.kind = kind; u.grp = grp; u.x0 = rbase + u.pm * 256; u.x1 = cnt;
        const int gp = u.x0 >> 8;
        if (kind == 0) { u.K = D; u.dep = -1; u.sig = gp;
            u.aoff = (unsigned)WS_H + (unsigned)u.x0 * (D * 2u);
            u.boff = (MOE ? (unsigned)WS_WGUE + (unsigned)grp * (2u * DFFE * D * 2u) : (unsigned)WS_WGUD) + (unsigned)u.pn * (256u * D * 2u); }
        else { u.K = Kdn; u.dep = gp; u.sig = -1;
            u.aoff = (unsigned)WS_ACT + (unsigned)u.x0 * ((unsigned)Kdn * 2u);
            u.boff = (MOE ? (unsigned)WS_WDE + (unsigned)grp * ((unsigned)D * DFFE * 2u) : (unsigned)WS_WDD) + (unsigned)u.pn * (256u * (unsigned)Kdn * 2u); }
        return true;
    }
    __device__ __forceinline__ void a_ready(const SUnit& u) const {
        if (threadIdx.x < 64) {
            const unsigned long long t0 = __builtin_amdgcn_s_memrealtime(); unsigned polls = 0;
            while ((unsigned)__builtin_amdgcn_readfirstlane(__hip_atomic_load(rdy + 64 * u.dep, __ATOMIC_RELAXED, __HIP_MEMORY_SCOPE_AGENT)) < need) {
                if ((++polls & 255u) == 0u && __builtin_amdgcn_readfirstlane(__hip_atomic_load(tmo, __ATOMIC_RELAXED, __HIP_MEMORY_SCOPE_AGENT)) != 0u) break;
                if (__builtin_amdgcn_s_memrealtime() - t0 > 2000000ull) { if (threadIdx.x == 0) __hip_atomic_store(tmo, 1u, __ATOMIC_RELAXED, __HIP_MEMORY_SCOPE_AGENT); break; }
                __builtin_amdgcn_s_sleep(2); }
            __builtin_amdgcn_fence(__ATOMIC_ACQUIRE, "agent");
            asm volatile("s_waitcnt vmcnt(0)" ::: "memory");
        }
        asm volatile("" ::: "memory"); __builtin_amdgcn_s_barrier(); asm volatile("" ::: "memory");
    }
};
template <bool MOE> struct FfnRows { const int* list;
    __device__ __forceinline__ bool a_gather(const SUnit& u) const { return MOE && u.kind == 0; }
    __device__ __forceinline__ unsigned arow(const SUnit& u, int r) const { int idx = u.pm * 256 + r; idx = idx < u.x1 ? idx : u.x1 - 1; return (unsigned)WS_H + (unsigned)list[u.grp * NL + idx] * (D * 2u); } };

template <bool MOE> struct EpiFfn {
    static constexpr bool PERM = true; static constexpr int MIDK = 0;
    unsigned char* ws; float* xl; const float* mod_l;
    __device__ __forceinline__ void operator()(const f32x4 (&acc)[2][2][4][2], const SUnit& u, int wr, int wc, int fr, int fq) const {
        if (u.kind == 0) {
            constexpr int ld = MOE ? DFFE : DFF0;
            bf16_t* act = (bf16_t*)(ws + WS_ACT);
            const int col = u.pn * 128 + wc * 32 + 8 * fq;
#pragma unroll
            for (int ai = 0; ai < 2; ++ai)
#pragma unroll
                for (int m = 0; m < 4; ++m) { const size_t row = (size_t)(u.x0 + ai * 128 + wr * 64 + m * 16 + fr);
                    float o[8];
#pragma unroll
                    for (int n = 0; n < 2; ++n)
#pragma unroll
                        for (int q = 0; q < 4; ++q) { const float gv = acc[ai][0][m][n][q], uv = acc[ai][1][m][n][q]; o[4 * n + q] = gv * sigmoidf_(gv) * uv; }
                    u32x4 w; w.x = cvt_pk_bf16(o[0], o[1]); w.y = cvt_pk_bf16(o[2], o[3]); w.z = cvt_pk_bf16(o[4], o[5]); w.w = cvt_pk_bf16(o[6], o[7]);
                    pg8::st16_wt(ws, (unsigned)WS_ACT + ((unsigned)row * (unsigned)ld + (unsigned)col) * 2u, w); }
        } else if (MOE) {
            bf16_t* O = (bf16_t*)(ws + WS_DOUT);
#pragma unroll
            for (int ai = 0; ai < 2; ++ai)
#pragma unroll
                for (int m = 0; m < 4; ++m) { const size_t row = (size_t)(u.x0 + ai * 128 + wr * 64 + m * 16 + fr);
#pragma unroll
                    for (int bj = 0; bj < 2; ++bj) { const int col = u.pn * 256 + bj * 128 + wc * 32 + 8 * fq; const f32x4 v0 = acc[ai][bj][m][0], v1 = acc[ai][bj][m][1];
                        u32x4 w; w.x = cvt_pk_bf16(v0[0], v0[1]); w.y = cvt_pk_bf16(v0[2], v0[3]); w.z = cvt_pk_bf16(v1[0], v1[1]); w.w = cvt_pk_bf16(v1[2], v1[3]);
                        *(u32x4*)(O + row * D + col) = w; } }
        } else {
            asm volatile("" : "+v"(fr), "+v"(fq));
            const int pmg = u.x0 >> 8;
            const int v = pmg < 32 ? 0 : (pmg < 64 ? 1 : 2);
            const float* gate = mod_l + v * MODSZ + 5 * D;
            float* xo = pmg < 64 ? xl + (size_t)u.x0 * D : (float*)(ws + WS_XC) + (size_t)(u.x0 - NL) * D;
#pragma unroll
            for (int bj = 0; bj < 2; ++bj) { const int col = u.pn * 256 + bj * 128 + wc * 32 + 8 * fq;
                const f32x4 g0 = *(const f32x4*)(gate + col), g1 = *(const f32x4*)(gate + col + 4);
#pragma unroll
                for (int ai = 0; ai < 2; ++ai)
#pragma unroll
                    for (int m = 0; m < 4; ++m) { const size_t o = (size_t)(ai * 128 + wr * 64 + m * 16 + fr) * D + col;
                        *(f32x4*)(xo + o) = *(const f32x4*)(xo + o) + g0 * acc[ai][bj][m][0];
                        *(f32x4*)(xo + o + 4) = *(const f32x4*)(xo + o + 4) + g1 * acc[ai][bj][m][1];
                        asm volatile("" ::: "memory"); __builtin_amdgcn_sched_barrier(0); } }
        }
    }
};

__device__ __forceinline__ int crow(int r, int hi) { return (r & 3) + 8 * (r >> 2) + 4 * hi; }
__device__ __forceinline__ s16x4 vtr(const LAS unsigned char* p) { typedef short v4i16_t __attribute__((ext_vector_type(4))); return __builtin_bit_cast(s16x4, __builtin_amdgcn_ds_read_tr16_b64_v4i16((LAS v4i16_t*)p)); }

__device__ __forceinline__ void attn_unit(Frame& F, int l, int b, int hkv, int qb, bool ctxq) {
    const int tid = F.tid, lane = F.lane, wid = F.wave, r32 = lane & 31, hi = lane >> 5;
    const int g = wid >> 1, qs = wid & 1, head = hkv * 4 + g;
    const bf16_t* Q = (const bf16_t*)(F.ws + WS_Q); const bf16_t* KB = (const bf16_t*)(F.ws + WS_KB); const bf16_t* VB = (const bf16_t*)(F.ws + WS_VB);
    const int q0 = qb * 64;
    const int qrow = (ctxq ? NL + b * CTXL : b * T) + q0 + qs * 32 + r32;
    bf16x8 qr[4];
#pragma unroll
    for (int d0 = 0; d0 < 4; ++d0) qr[d0] = *(const bf16x8*)(Q + (size_t)qrow * 512 + head * 64 + d0 * 16 + hi * 8);
    int jlo = 0, jhi = -1;
    if (!ctxq) { jlo = -2; jhi = 2; if (q0 + 64 * jlo < 0) jlo = -(q0 / 64); if (q0 + 64 * jhi >= T) jhi = (T - 64 - q0) / 64; }
    const int nloc = jhi - jlo + 1, ntile = nloc + 4;
    const float sinkv = F.in[9][l * 8 + head] * LOG2E;
    float mrun = sinkv, lrun = 1.0f;
    f32x16 o[2]; o[0] = f32x16{}; o[1] = f32x16{};
    const int kkey = lane, vkey = 16 * (wid & 3) + (lane >> 2);
    auto tile_row = [&](int ti) -> int { return ti < nloc ? b * T + q0 + 64 * (jlo + ti) : NL + b * CTXL + 64 * (ti - nloc); };
    u32x4 kreg, vreg;
    { const int r0 = tile_row(0); kreg = *(const u32x4*)(KB + (size_t)(r0 + kkey) * 128 + hkv * 64 + wid * 8); vreg = *(const u32x4*)(VB + (size_t)(r0 + vkey) * 128 + hkv * 64 + (wid >> 2) * 32 + (lane & 3) * 8); }
    for (int ti = 0; ti < ntile; ++ti) {
        LAS unsigned char* slot = F.lds + (ti & 1) * 16384;
        *(LAS u32x4*)(slot + wid * 1024 + lane * 16) = kreg;
        *(LAS u32x4*)(slot + 8192 + wid * 1024 + lane * 16) = vreg;
        __syncthreads();
        if (ti + 1 < ntile) { const int r0 = tile_row(ti + 1); kreg = *(const u32x4*)(KB + (size_t)(r0 + kkey) * 128 + hkv * 64 + wid * 8); vreg = *(const u32x4*)(VB + (size_t)(r0 + vkey) * 128 + hkv * 64 + (wid >> 2) * 32 + (lane & 3) * 8); }
        f32x16 p0 = f32x16{}, p1 = f32x16{};
        { const LAS unsigned char* kb = slot + hi * 1024 + r32 * 16;
#pragma unroll
          for (int d0 = 0; d0 < 4; ++d0) { const bf16x8 k0 = *(const LAS bf16x8*)(kb + d0 * 2048), k1 = *(const LAS bf16x8*)(kb + d0 * 2048 + 512);
              p0 = __builtin_amdgcn_mfma_f32_32x32x16_bf16(k0, qr[d0], p0, 0, 0, 0); p1 = __builtin_amdgcn_mfma_f32_32x32x16_bf16(k1, qr[d0], p1, 0, 0, 0); } }
        if (ti < nloc) { const int j = jlo + ti; const int qq = qs * 32 + r32;
            if (j == -2) {
#pragma unroll
                for (int r = 0; r < 16; ++r) { const int kk = crow(r, hi); if (kk < qq) p0[r] = -INFINITY; if (kk + 32 < qq) p1[r] = -INFINITY; } }
            else if (j == 2) {
#pragma unroll
                for (int r = 0; r < 16; ++r) { const int kk = crow(r, hi); if (kk > qq) p0[r] = -INFINITY; if (kk + 32 > qq) p1[r] = -INFINITY; } } }
        float mx = p0[0];
#pragma unroll
        for (int r = 1; r < 16; ++r) mx = fmaxf(mx, p0[r]);
#pragma unroll
        for (int r = 0; r < 16; ++r) mx = fmaxf(mx, p1[r]);
        mx = fmaxf(mx, __shfl_xor(mx, 32));
        const float mnew = fmaxf(mrun, mx), fsc = __builtin_amdgcn_exp2f(mrun - mnew);
        mrun = mnew;
        float rs = 0.f;
#pragma unroll
        for (int r = 0; r < 16; ++r) { p0[r] = __builtin_amdgcn_exp2f(p0[r] - mnew); p1[r] = __builtin_amdgcn_exp2f(p1[r] - mnew); rs += p0[r] + p1[r]; }
        rs += __shfl_xor(rs, 32);
        lrun = lrun * fsc + rs;
#pragma unroll
        for (int r = 0; r < 16; ++r) { o[0][r] *= fsc; o[1][r] *= fsc; }
        u32x4 pw[4];
        pw[0] = (u32x4){cvt_pk_bf16(p0[0], p0[1]), cvt_pk_bf16(p0[2], p0[3]), cvt_pk_bf16(p0[4], p0[5]), cvt_pk_bf16(p0[6], p0[7])};
        pw[1] = (u32x4){cvt_pk_bf16(p0[8], p0[9]), cvt_pk_bf16(p0[10], p0[11]), cvt_pk_bf16(p0[12], p0[13]), cvt_pk_bf16(p0[14], p0[15])};
        pw[2] = (u32x4){cvt_pk_bf16(p1[0], p1[1]), cvt_pk_bf16(p1[2], p1[3]), cvt_pk_bf16(p1[4], p1[5]), cvt_pk_bf16(p1[6], p1[7])};
        pw[3] = (u32x4){cvt_pk_bf16(p1[8], p1[9]), cvt_pk_bf16(p1[10], p1[11]), cvt_pk_bf16(p1[12], p1[13]), cvt_pk_bf16(p1[14], p1[15])};
        { const LAS unsigned char* vb = slot + 8192 + ((lane >> 4) & 1) * 32 + (lane & 3) * 8 + (4 * hi + ((lane & 15) >> 2)) * 64;
#pragma unroll
          for (int d0 = 0; d0 < 2; ++d0)
#pragma unroll
              for (int ks = 0; ks < 4; ++ks) { const s16x4 lo = vtr(vb + d0 * 4096 + ks * 1024), hh = vtr(vb + d0 * 4096 + ks * 1024 + 512);
                  const bf16x8 vf = (bf16x8){lo[0], lo[1], lo[2], lo[3], hh[0], hh[1], hh[2], hh[3]};
                  o[d0] = __builtin_amdgcn_mfma_f32_32x32x16_bf16(vf, __builtin_bit_cast(bf16x8, pw[ks]), o[d0], 0, 0, 0); } }
    }
    const float rl = 1.0f / lrun;
    bf16_t* orow = (bf16_t*)(F.ws + WS_FO) + (size_t)qrow * KM + 640 + head * 64;
#pragma unroll
    for (int d0 = 0; d0 < 2; ++d0)
#pragma unroll
        for (int rq = 0; rq < 4; ++rq) { u32x2 w; w.x = cvt_pk_bf16(o[d0][4 * rq] * rl, o[d0][4 * rq + 1] * rl); w.y = cvt_pk_bf16(o[d0][4 * rq + 2] * rl, o[d0][4 * rq + 3] * rl);
            *(u32x2*)(orow + 32 * d0 + 8 * rq + 4 * hi) = w; }
    __syncthreads();
}

__device__ __forceinline__ void attn_phase(Frame& F, int l, int part) {
    const int nlat = NB * 2 * 128;
    auto lat_unit = [&](int it) { const int qb = it & 127, hkv = (it >> 7) & 1, b = it >> 8; attn_unit(F, l, b, hkv, qb, false); };
    if (part == 0) {
        const bool extra = (l == 0) && F.G == 256 && ((F.bx >= 16 && F.bx < 24) || F.bx >= 240);
        if (!extra) for (int it = F.bx; it < 256; it += F.G) lat_unit(it);
        if (l == 0) for (int r = (F.bx + F.G - 240) % F.G; r < NB * 2 * 4; r += F.G) { const int qb = r & 3, hkv = (r >> 2) & 1, b = r >> 3; attn_unit(F, l, b, hkv, qb, true); }
    } else {
        const bool busy = (l == 0) && F.bx >= 128 && F.bx < 136;
        if (!busy) for (int it = 256 + F.bx; it < nlat; it += F.G) lat_unit(it);
        if (l == 0 && F.bx >= 136 && F.bx < 144) lat_unit(256 + F.bx - 8);
        if (l == 0 && F.G == 256 && F.bx >= 144 && F.bx < 168) { const int k = F.bx - 144; lat_unit(k < 8 ? 16 + k : 240 + (k - 8)); }
    }
}

#if !MK_MULTI
#define GRID_BAR() xcd_barrier(bar)
#else
#define GRID_BAR() do {} while (0)
#endif
#ifndef PH_MASK
#define PH_MASK 0xFFFFFu
#endif
#define IN(k) (((PH_MASK >> (k)) & 1u) && lo <= (k) && (k) < hi)
#define SEAM(k) do { if (IN((k) + 1)) GRID_BAR(); } while (0)
#ifndef REP_MASK
#define REP_MASK 0u
#endif
#define REPS(k) ((((REP_MASK) >> (k)) & 1u) ? 2 : 1)
template <int l, class BarT>
__device__ __forceinline__ void layer_phases(Frame& F, unsigned* ctl, const int lo, const int hi, const BarT& bar) {
        const int pb = 1 + 8 * l;
        bf16_t* H = (bf16_t*)(F.ws + WS_H);
        const float* xl_in = l == 0 ? F.in[0] : nullptr;
        bf16_t* XB = (bf16_t*)(F.ws + WS_XB);
        const float* xc_in = l == 0 ? F.in[2] : (const float*)(F.ws + WS_XC);
        float* xc = (float*)(F.ws + WS_XC);
        const float* mod_l = (const float*)ctl + CW_MOD + l * 3 * MODSZ;
        if (IN(pb + 0)) { for (int rep = 0; rep < REPS(pb + 0); ++rep) norm_phase<false>(F, l, 0, xl_in, xc_in, NTOK, l == 1 ? (const float*)(F.ws + WS_TMPC2) : nullptr, nullptr); SEAM(pb + 0); }
        if (IN(pb + 1)) {
            for (int rep = 0; rep < REPS(pb + 1); ++rep) {
            { pg8::Gemm g{H, (const bf16_t*)(F.ws + (l ? WS_WIN1 : WS_WIN0)) + (size_t)512 * D, D, D}; InprojSched S{F.G, F.bx, l}; EpiInproj E{F.ws}; pg8::NoGather R;
              pg8::gemm_phase(F.lds, g, S, E, R); }
            { pg8::Gemm g{(const bf16_t*)(F.ws + (l ? WS_WIN1 : WS_WIN0)), H, D, D}; UpermSched S{F.G, F.bx, l}; EpiUperm E{F.ws}; UpermRows R;
              pg8::gemm_phase(F.lds, g, S, E, R); }
            }
            SEAM(pb + 1);
        }
        if (IN(pb + 2)) {
            for (int rep = 0; rep < REPS(pb + 2); ++rep) {
            attn_phase(F, l, 0);
            { pg8::Gemm g{(const bf16_t*)(F.ws + WS_UP), (const bf16_t*)(F.ws + WS_FA64), 128, 128}; StepASched S{F.G, F.bx, l}; EpiStepA E{F.ws}; pg8::NoGather R;
              pg8::gemm_phase(F.lds, g, S, E, R); }
            if (l == 0) { pg8::Gemm g{(const bf16_t*)(F.ws + WS_VCT), (const bf16_t*)(F.ws + WS_TX), 512, 512}; GridSched S{2, 2, F.G, (F.bx + F.G - 16) % F.G, 256u * 512u * 2u, 256u * 512u * 2u}; EpiStepC<true> E{F.ws}; pg8::NoGather R;
              pg8::gemm_phase(F.lds, g, S, E, R); }
            }
            SEAM(pb + 2);
        }
        if (IN(pb + 3)) {
            for (int rep = 0; rep < REPS(pb + 3); ++rep) {
            { pg8::Gemm g{(const bf16_t*)(F.ws + WS_GP), (const bf16_t*)(F.ws + WS_TC), 256, 256}; GridSched S{128, 1, F.G, F.bx, 256u * 256u * 2u, 0u}; EpiStepC<false> E{F.ws}; pg8::NoGather R;
              pg8::gemm_phase(F.lds, g, S, E, R); }
            if (l == 0) { pg8::Gemm g{(const bf16_t*)(F.ws + WS_FO), (const bf16_t*)(F.ws + WS_WM0), KM, KM}; CtxSched S{F.G, (F.bx + F.G - 128) % F.G, 4, 256u * KM * 2u, 256u * KM * 2u, 1, 0u}; EpiMerge E{F.ws}; pg8::NoGather R;
              pg8::gemm_phase(F.lds, g, S, E, R); }
            attn_phase(F, l, 1);
            }
            SEAM(pb + 3);
        }
        if (IN(pb + 4)) {
            const int nM = 64;
            pg8::Gemm g{(const bf16_t*)(F.ws + WS_FO), (const bf16_t*)(F.ws + (l ? WS_WM1 : WS_WM0)), KM, KM}; GridSched S{nM, 4, F.G, F.bx, 256u * KM * 2u, 256u * KM * 2u}; EpiMerge E{F.ws}; pg8::NoGather R;
            for (int rep = 0; rep < REPS(pb + 4); ++rep) pg8::gemm_phase(F.lds, g, S, E, R);
            SEAM(pb + 4);
        }
        if (IN(pb + 5)) {
            EpiResid E{xl_in, XB, XB, xc_in, xc, mod_l, 2, (float*)(F.ws + WS_TMPC1)}; pg8::NoGather R;
            { pg8::Gemm g{(const bf16_t*)(F.ws + WS_Y), (const bf16_t*)(F.ws + (l ? WS_WO1 : WS_WO0)), D, D}; GridSched S{64, 4, F.G, F.bx, 256u * D * 2u, 256u * D * 2u};
              pg8::gemm_phase(F.lds, g, S, E, R); }
            if (l == 0) { pg8::Gemm g{(const bf16_t*)(F.ws + WS_Y), (const bf16_t*)(F.ws + WS_WO0), D / 2, D}; CtxSched S{F.G, F.bx, 4, 256u * D * 2u, 256u * D * 2u, 2, (unsigned)D};
              pg8::gemm_phase(F.lds, g, S, E, R); }
            SEAM(pb + 5);
        }
        if (IN(pb + 6)) {
            if (l == 0) norm_phase<false>(F, l, 1, nullptr, xc, NTOK, (const float*)(F.ws + WS_TMPC1), xc); else { norm_phase<true>(F, l, 1, nullptr, xc, NL); for (int rep = 0; rep < REPS(21); ++rep) moe_convert_all(F); }
            SEAM(pb + 6);
        }
#ifndef STREAM0
#define STREAM0 0
#endif
#ifndef STREAM1
#define STREAM1 0
#endif
        if (IN(pb + 7)) {
            volatile LAS unsigned* lw = (volatile LAS unsigned*)(F.lds + MISC_OFF) + 16;
            if (l == 0) {
#if STREAM0
                FfnStream<9, false> S;
#pragma unroll
                for (int g = 0; g < 9; ++g) { S.P[g] = g < 8 ? 8 : 2; S.rb[g] = 2048 * g; S.cn[g] = g < 8 ? 2048 : 512; }
                S.nNgu = 22; S.Kdn = DFF0; S.need = 22u * 8u; S.q = ctl + CW_QUEUE; S.lw = lw; S.rdy = ctl + CW_RDY; S.tmo = ctl + 2; S.finish_init(F.G);
                EpiFfn<false> E{F.ws, F.out, mod_l}; FfnRows<false> R{nullptr};
                pg8::gemm_stream(F.lds, (const char*)F.ws, S, E, R);
#else
                for (int rep = 0; rep < REPS(18); ++rep)
                { pg8::Gemm g{H, (const bf16_t*)(F.ws + WS_WGUD), D, D}; RowSched S{66, 22, F.G, F.bx, 256u * D * 2u, 256u * D * 2u}; EpiSwiglu E{(bf16_t*)(F.ws + WS_ACT), DFF0}; pg8::NoGather R;
                  pg8::gemm_phase(F.lds, g, S, E, R); }
                GRID_BAR();
                { EpiResid E{nullptr, XB, XB, xc, xc, mod_l, 5, (float*)(F.ws + WS_TMPC2)}; pg8::NoGather R;
                  { pg8::Gemm g{(const bf16_t*)(F.ws + WS_ACT), (const bf16_t*)(F.ws + WS_WDD), DFF0, DFF0}; GridSched S{64, 4, F.G, F.bx, 256u * DFF0 * 2u, 256u * DFF0 * 2u};
                    pg8::gemm_phase(F.lds, g, S, E, R); }
                  { pg8::Gemm g{(const bf16_t*)(F.ws + WS_ACT), (const bf16_t*)(F.ws + WS_WDD), DFF0 / 2, DFF0}; CtxSched S{F.G, F.bx, 4, 256u * DFF0 * 2u, 256u * DFF0 * 2u, 2, (unsigned)DFF0};
                    pg8::gemm_phase(F.lds, g, S, E, R); } }

#endif
            } else {
#if STREAM1
                FfnStream<8, true> S; { int bacc = 0;
#pragma unroll
                for (int e = 0; e < NE; ++e) { const int c = (int)ctl[CW_CNT + 64 * e]; S.cn[e] = c; S.P[e] = (c + 255) >> 8; S.rb[e] = bacc; bacc += ((c + 255) >> 8) << 8; } }
                S.nNgu = 28; S.Kdn = DFFE; S.need = 28u * 8u; S.q = ctl + CW_QUEUE + 64; S.lw = lw; S.rdy = ctl + CW_RDY + 64 * 80; S.tmo = ctl + 2; S.finish_init(F.G);
                EpiFfn<true> E{F.ws, F.out, mod_l}; FfnRows<true> R{(const int*)(F.ws + WS_LIST)};
                pg8::gemm_stream(F.lds, (const char*)F.ws, S, E, R);
#else
                for (int rep = 0; rep < REPS(19); ++rep)
                { pg8::Gemm g{H, (const bf16_t*)(F.ws + WS_WGUE), D / 2, D / 2}; MoeSched S; S.G = F.G; S.c = F.bx; S.nN = 28; S.ksplit = 1; S.trim = 0; S.khbytes = 0; S.bexp = 2u * DFFE * D; S.bbytes = 256u * D; S.arow_bytes = 0; S.a_slots = false; S.init(ctl + CW_CNT);
                  EpiSwiglu8 E{F.ws + WS_ACT, DFFE}; MoeRows R{(const int*)(F.ws + WS_LIST)};
                  pg8::gemm_phase8(F.lds, g, S, E, R); }
                GRID_BAR();
                { const int trim = moe_tail_panels(ctl + CW_CNT, F.G);
                  MoeSched S; S.G = F.G; S.c = F.bx; S.nN = 4; S.ksplit = 1; S.trim = trim; S.khbytes = 0; S.bexp = (unsigned)D * DFFE; S.bbytes = 256u * DFFE; S.arow_bytes = (unsigned)DFFE; S.a_slots = true; S.init(ctl + CW_CNT);
                  for (int rep = 0; rep < REPS(20); ++rep)
                  { pg8::Gemm g{(const bf16_t*)(F.ws + WS_ACT), (const bf16_t*)(F.ws + WS_WDE), DFFE / 2, DFFE / 2};
                    EpiBf16 E{(bf16_t*)(F.ws + WS_DOUT), (bf16_t*)(F.ws + WS_DOUT), D}; pg8::NoGather R;
                    pg8::gemm_phase8(F.lds, g, S, E, R); }
                  if (trim > 0) {
                    const int plast = (S.cnt[NE - 1] + 255) >> 8;
                    pg8::Gemm g{(const bf16_t*)(F.ws + WS_ACT), (const bf16_t*)(F.ws + WS_WDE), DFFE / 4, DFFE / 2};
                    MoeTailSched T{F.G, F.bx, trim, plast, S.base[NE - 1], (unsigned)D * DFFE};
                    EpiTail E{(bf16_t*)(F.ws + WS_DOUT), (bf16_t*)(F.ws + WS_DOUT1), S.base[NE - 1] + (plast - trim) * 256}; pg8::NoGather R;
                    pg8::gemm_phase8(F.lds, g, T, E, R); } }
#endif
            }
            SEAM(pb + 7);
        }
}

constexpr int NPHASE = 18;
__global__ void __launch_bounds__(NTHR, 2) fwd_kernel(Args args) {
    extern __shared__ __attribute__((aligned(16))) unsigned char lds_raw[];
    Frame F;
    F.lds = (LAS unsigned char*)lds_raw; F.ws = args.ws; F.in = args.in; F.out = args.out;
    F.tid = threadIdx.x; F.lane = F.tid & 63; F.wave = __builtin_amdgcn_readfirstlane(F.tid >> 6); F.G = gridDim.x; F.bx = blockIdx.x;
    volatile LAS unsigned* MISC = (volatile LAS unsigned*)(F.lds + MISC_OFF);
    if (F.tid < 32) MISC[F.tid] = 0u;
    __syncthreads();
    unsigned* ctl = (unsigned*)(F.ws + WS_CTL);
#if !MK_MULTI
    XcdBarrier bar = xcd_barrier_post(ctl + CW_BAR, MISC + 8);
#else
    XcdBarrier bar; bar.bar = ctl + CW_BAR; bar.x = 0; bar.st = MISC + 8;
#endif
    const int lo = args.ph_lo, hi = args.ph_hi;
    if (IN(0)) { for (int rep = 0; rep < REPS(0); ++rep) { p0_prologue(F); __syncthreads(); } SEAM(0); }
    layer_phases<0>(F, ctl, lo, hi, bar);
    layer_phases<1>(F, ctl, lo, hi, bar);
    if (IN(17)) final_phase(F);
}

extern "C" void kernel_launch(void* const* d_in, const int* in_sizes, int n_in, void* d_out, int out_size, void* d_ws, size_t ws_size, hipStream_t stream) {
    static int grid = 0;
    if (grid == 0) {
        if (n_in != 21 || out_size != NL * D || ws_size < WS_END) { fprintf(stderr, "kernel_launch: unexpected problem (n_in %d out %d ws %zu)\n", n_in, out_size, ws_size); grid = -1; return; }
        int dev = 0, cus = 0;
        hipGetDevice(&dev); hipDeviceGetAttribute(&cus, hipDeviceAttributeMultiprocessorCount, dev);
        if (hipFuncSetAttribute((const void*)fwd_kernel, hipFuncAttributeMaxDynamicSharedMemorySize, LDS_BYTES) != hipSuccess) { fprintf(stderr, "kernel_launch: hipFuncSetAttribute failed\n"); grid = -1; return; }
        int per_cu = 0; (void)hipOccupancyMaxActiveBlocksPerMultiprocessor(&per_cu, (const void*)fwd_kernel, NTHR, LDS_BYTES); (void)hipGetLastError();
        grid = cus;
    }
    if (grid < 0) return;
    hipMemsetAsync((char*)d_ws + WS_CTL, 0, CTL_BYTES, stream);
#ifdef DBG_SCRUB
    hipMemsetAsync((char*)d_ws + CTL_BYTES, 0, WS_END - CTL_BYTES, stream);
#endif
    Args a{};
    for (int i = 0; i < 21; ++i) a.in[i] = (const float*)d_in[i];
    a.out = (float*)d_out; a.ws = (unsigned char*)d_ws;
#if MK_MULTI
    for (int p = 0; p < NPHASE; ++p) { a.ph_lo = p; a.ph_hi = p + 1; hipLaunchKernelGGL(fwd_kernel, dim3(grid), dim3(NTHR), LDS_BYTES, stream, a); }
#else
    a.ph_lo = 0; a.ph_hi = NPHASE;
    hipLaunchKernelGGL(fwd_kernel, dim3(grid), dim3(NTHR), LDS_BYTES, stream, a);
#endif
}
```

```cpp
#include <hip/hip_runtime.h>
#include <cstdio>
#include <cstdint>

#define LAS __attribute__((address_space(3)))
#define GAS __attribute__((address_space(1)))
typedef unsigned short bf16_t;
typedef short bf16x8 __attribute__((ext_vector_type(8)));
typedef short s16x4 __attribute__((ext_vector_type(4)));
typedef float f32x4 __attribute__((ext_vector_type(4)));
typedef float f32x2 __attribute__((ext_vector_type(2)));
typedef float f32x16 __attribute__((ext_vector_type(16)));
typedef unsigned u32x4 __attribute__((ext_vector_type(4)));
typedef unsigned u32x2 __attribute__((ext_vector_type(2)));

#ifndef MK_MULTI
#define MK_MULTI 0
#endif

constexpr int D = 1024, T = 8192, NB = 2, NL = NB * T, CTXL = 256, NC = NB * CTXL, NTOK = NL + NC;
constexpr int INW = 3328, OFFQ = 512, OFFK = 1024, OFFV = 1152, OFFG = 1280;
constexpr int DFF0 = 2816, DFFE = 3584, NE = 8;
constexpr int KM = 1152;
constexpr int MOE_ROWS = 2 * NL + NE * 256;
constexpr float EPS = 1e-6f;
constexpr float LOG2E = 1.4426950408889634f;
constexpr float QSCALE = 0.125f * LOG2E;

constexpr size_t MiB = 1u << 20, KiB = 1u << 10;
constexpr size_t WS_CTL = 0, CTL_BYTES = 1 * MiB;
constexpr size_t WS_ROPE = 1 * MiB, WS_TW = WS_ROPE + 32 * KiB, WS_FA64 = WS_ROPE + 96 * KiB, WS_TC = WS_ROPE + 160 * KiB, WS_TX = WS_ROPE + 288 * KiB;
constexpr size_t WS_RS = WS_ROPE + 832 * KiB, WS_CSD = WS_ROPE + 912 * KiB;
constexpr size_t WS_TOKE = 2 * MiB, WS_TOKR = WS_TOKE + 128 * KiB, WS_TOKW = WS_TOKE + 256 * KiB, WS_LIST = WS_TOKE + 384 * KiB;
constexpr size_t WS_XC = 3 * MiB, WS_VCT = 5 * MiB;
constexpr size_t WS_WIN0 = 6 * MiB, WS_WM0 = WS_WIN0 + 13 * MiB / 2, WS_WO0 = 17 * MiB, WS_WGUD = 19 * MiB, WS_WDD = 30 * MiB;
constexpr size_t WS_WIN1 = 36 * MiB, WS_WM1 = WS_WIN1 + 13 * MiB / 2, WS_WO1 = 47 * MiB;
constexpr size_t WS_H = 49 * MiB;
constexpr size_t WS_DOUT = 6 * MiB;
constexpr size_t WS_WGUE = 82 * MiB, WS_WDE = 194 * MiB;
constexpr size_t WS_DOUT1 = WS_WGUE;
constexpr size_t WS_R1 = 250 * MiB;
constexpr size_t WS_UP = WS_R1, WS_Q = 266 * MiB, WS_KB = 283 * MiB, WS_VB = 288 * MiB, WS_GF = 293 * MiB, WS_GA = 326 * MiB, WS_GP = 359 * MiB, WS_FO = 375 * MiB, WS_Y = 413 * MiB;
constexpr size_t WS_ACT = WS_R1;
constexpr size_t WS_TMPC1 = 446 * MiB, WS_TMPC2 = 448 * MiB;
constexpr size_t WS_XB = 490 * MiB;
constexpr size_t WS_END = 523 * MiB;
static_assert(WS_DOUT + (size_t)MOE_ROWS * D * 2 <= WS_WGUE, "DOUT overlay");
static_assert(WS_ACT + (size_t)MOE_ROWS * DFFE * 2 <= WS_END, "ACT");
static_assert(WS_FO + (size_t)NTOK * KM * 2 <= WS_Y, "FO");
constexpr int CW_BAR = 4096, CW_CNT = 8192, CW_MOD = 16384;
constexpr int MODSZ = 6 * D;

constexpr int RING_BYTES = 131072, MISC_OFF = RING_BYTES + 320, LDS_BYTES = 147456;
constexpr int NWAVES = 8, NTHR = 512;

__device__ __forceinline__ unsigned f2bf(float f) { unsigned u = __builtin_bit_cast(unsigned, f); return (u + 0x7fffu + ((u >> 16) & 1u)) >> 16; }
__device__ __forceinline__ unsigned pk2(float lo, float hi) { return f2bf(lo) | (f2bf(hi) << 16); }
__device__ __forceinline__ unsigned pk4f8(float a, float b, float c, float d) { int w = __builtin_amdgcn_cvt_pk_fp8_f32(a, b, 0, false); w = __builtin_amdgcn_cvt_pk_fp8_f32(c, d, w, true); return (unsigned)w; }
__device__ __forceinline__ unsigned cvt_pk_bf16(float lo, float hi) { unsigned r; asm volatile("v_cvt_pk_bf16_f32 %0, %1, %2" : "=v"(r) : "v"(lo), "v"(hi)); return r; }
__device__ __forceinline__ unsigned pk4i8(float a, float b, float c, float d, float sc) {
    const unsigned ua = __builtin_bit_cast(unsigned, fmaf(a, sc, 12582912.0f)), ub = __builtin_bit_cast(unsigned, fmaf(b, sc, 12582912.0f)), uc = __builtin_bit_cast(unsigned, fmaf(c, sc, 12582912.0f)), ud = __builtin_bit_cast(unsigned, fmaf(d, sc, 12582912.0f));
    return (ua & 0xffu) | ((ub & 0xffu) << 8) | ((uc & 0xffu) << 16) | (ud << 24); }
__device__ __forceinline__ float wave_max(float v) {
#pragma unroll
    for (int o = 1; o < 64; o <<= 1) v = fmaxf(v, __shfl_xor(v, o));
    return v;
}
__device__ __forceinline__ float bf2f(unsigned short h) { return __builtin_bit_cast(float, (unsigned)h << 16); }
__device__ __forceinline__ float bflo(unsigned w) { return __builtin_bit_cast(float, w << 16); }
__device__ __forceinline__ float bfhi(unsigned w) { return __builtin_bit_cast(float, w & 0xffff0000u); }
__device__ __forceinline__ float wave_sum(float v) {
#pragma unroll
    for (int o = 1; o < 64; o <<= 1) v += __shfl_xor(v, o);
    return v;
}
__device__ __forceinline__ float sigmoidf_(float x) { return __builtin_amdgcn_rcpf(1.0f + __builtin_amdgcn_exp2f(-x * LOG2E)); }
#define LDS_WAIT() asm volatile("s_waitcnt lgkmcnt(0)" ::: "memory")
#define VM_WAIT() asm volatile("s_waitcnt vmcnt(0)" ::: "memory")

#define XB_TMO      128
#define XB_XCNT(j)  (256  + 64 * (j))
#define XB_XSUB(j)  (1280 + 64 * (j))
#define XB_XGEN(j)  (2304 + 64 * (j))
#define XB_TOP      3328
#define XB_TOPGEN   3392
#define XCD_BAR_WORDS 3456
#define XB_SPIN_CAP (1u << 18)
__device__ __forceinline__ unsigned xb_ld(unsigned* p)              { return __hip_atomic_load(p, __ATOMIC_RELAXED, __HIP_MEMORY_SCOPE_AGENT); }
__device__ __forceinline__ unsigned xb_add(unsigned* p, unsigned v) { return __hip_atomic_fetch_add(p, v, __ATOMIC_RELAXED, __HIP_MEMORY_SCOPE_AGENT); }
__device__ __forceinline__ unsigned xb_xcc_id() { return (unsigned)__builtin_amdgcn_s_getreg((3 << 11) | 20) & 0xFu; }
#define XB_SPIN(cond, bar) do { unsigned _sp = 0; while (cond) { __builtin_amdgcn_s_sleep(1); \
    if ((++_sp & 255u) == 0u) { if (xb_ld(&(bar)[XB_TMO])) break; if (_sp > XB_SPIN_CAP) { atomicAdd(&(bar)[XB_TMO], 1u); break; } } } } while (0)
struct XcdBarrier { unsigned* bar; unsigned x; volatile LAS unsigned* st; };
__device__ __forceinline__ XcdBarrier xcd_barrier_post(unsigned* bar, volatile LAS unsigned* st) {
    XcdBarrier b; b.bar = bar; b.x = xb_xcc_id(); b.st = st;
    if (threadIdx.x == 0) (void)xb_add(&bar[XB_XCNT(b.x)], 1u);
    return b;
}
__device__ __forceinline__ void xcd_barrier_complete(unsigned* bar, unsigned x, unsigned& nloc, unsigned& nx) {
    const unsigned G = gridDim.x * gridDim.y * gridDim.z;
    unsigned sum, cnt, mine, sp = 0u;
    for (;;) {
        sum = 0u; cnt = 0u; mine = 0u;
#pragma unroll
        for (unsigned j = 0; j < 16; ++j) { const unsigned c = xb_ld(&bar[XB_XCNT(j)]); sum += c; cnt += (c > 0u) ? 1u : 0u; mine = (j == x) ? c : mine; }
        if (sum == G) break;
        __builtin_amdgcn_s_sleep(1);
        if ((++sp & 255u) == 0u) { if (xb_ld(&bar[XB_TMO])) break; if (sp > XB_SPIN_CAP) { atomicAdd(&bar[XB_TMO], 1u); break; } }
    }
    nloc = mine > 0u ? mine : 1u; nx = cnt > 0u ? cnt : 1u;
}
__device__ __forceinline__ void xcd_barrier(const XcdBarrier& b) {
    asm volatile("s_waitcnt vmcnt(0)" ::: "memory");
    __syncthreads();
    if (threadIdx.x == 0) {
        unsigned* bar = b.bar;
        __builtin_amdgcn_s_waitcnt(0);
        unsigned nloc = b.st[0], nx = b.st[1];
        if (nloc == 0u) { xcd_barrier_complete(bar, b.x, nloc, nx); b.st[0] = nloc; b.st[1] = nx; }
        const unsigned old = xb_add(&bar[XB_XSUB(b.x)], 1u);
        const unsigned gen = old / nloc;
        if (old + 1u == (gen + 1u) * nloc) {
            __builtin_amdgcn_fence(__ATOMIC_RELEASE, "agent");
            asm volatile("s_waitcnt vmcnt(0)" ::: "memory");
            const unsigned og = xb_add(&bar[XB_TOP], 1u);
            const unsigned tg = og / nx;
            if (og + 1u == (tg + 1u) * nx) xb_add(&bar[XB_TOPGEN], 1u);
            else XB_SPIN(xb_ld(&bar[XB_TOPGEN]) == tg, bar);
            __builtin_amdgcn_fence(__ATOMIC_ACQUIRE, "agent");
            xb_add(&bar[XB_XGEN(b.x)], 1u);
            asm volatile("s_waitcnt vmcnt(0)" ::: "memory");
        } else {
            XB_SPIN(xb_ld(&bar[XB_XGEN(b.x)]) == gen, bar);
            __builtin_amdgcn_fence(__ATOMIC_ACQUIRE, "agent");
            asm volatile("s_waitcnt vmcnt(0)" ::: "memory");
        }
    }
    __syncthreads();
}

#ifndef QGU
#define QGU 32
#endif
#ifndef QDN
#define QDN 64
#endif
#ifndef QACT
#define QACT 16
#endif
namespace pg8 {
constexpr int BM = 256, BK = 64, HALF = 128, HTB = HALF * BK * 2, STAGE_BYTES = 8 * HTB, NXCD = 8, WGM = 8;
__host__ __device__ __forceinline__ int lds_byte(int r, int c) { const int st = (r >> 4) * 2 + (c >> 5), rr = r & 15, cc = c & 31, ob = rr * 64 + cc * 2; return st * 1024 + (ob ^ (((ob >> 9) & 1) << 5)); }
__host__ __device__ __forceinline__ void stage_rc(int b, int& R, int& C) { const int st = b / 1024, sb = b % 1024, swz = sb ^ (((sb >> 9) & 1) << 5); R = (st >> 1) * 16 + swz / 64; C = (st & 1) * 32 + (swz % 64) / 2; }
__host__ __device__ __forceinline__ int perm32(int rho) { const int n = rho >> 4, i = rho & 15; return 8 * (i >> 2) + 4 * n + (i & 3); }

typedef int i32x8 __attribute__((ext_vector_type(8)));
typedef int i32x4 __attribute__((ext_vector_type(4)));
__device__ __forceinline__ i32x8 cat8(bf16x8 a, bf16x8 b) { return __builtin_shufflevector(__builtin_bit_cast(i32x4, a), __builtin_bit_cast(i32x4, b), 0, 1, 2, 3, 4, 5, 6, 7); }
struct Unit { unsigned aoff, boff; int pm, pn, kind, x0, x1, kh; };
struct Gemm { const bf16_t* A; const bf16_t* Bt; int K; int ld; };

__device__ __forceinline__ void swz_map(int L, int nM, int nN, int& pm, int& pn) {
    const int nwg = nM * nN; int wgid = L;
    { const int q = nwg / NXCD, r = nwg % NXCD, xcd = wgid % NXCD, off = wgid / NXCD; wgid = (xcd < r ? xcd * (q + 1) : r * (q + 1) + (xcd - r) * q) + off; }
    const int nig = WGM * nN, gid = wgid / nig, fm = gid * WGM, gsz = (nM - fm) < WGM ? (nM - fm) : WGM;
    pm = fm + ((wgid % nig) % gsz); pn = (wgid % nig) / gsz;
}

struct NoGather { static constexpr bool GA = false, GB = false;
    __device__ __forceinline__ unsigned arow(const Unit&, int) const { return 0u; }
    __device__ __forceinline__ unsigned brow(const Unit&, int) const { return 0u; } };

template <int F8, class Epi, class Sched, class Rows>
__device__ __forceinline__ void gemm_phase_t(LAS unsigned char* lds, const Gemm g, const Sched& S, const Epi& E, const Rows& RW) {
    int tid_ = threadIdx.x; asm volatile("" : "+v"(tid_));
    const int tid = tid_, wid = __builtin_amdgcn_readfirstlane(tid >> 6), lane = tid & 63, wr = wid >> 2, wc = wid & 3, fr = lane & 15, fq = lane >> 4;
    int K_ = g.K; asm volatile("" : "+s"(K_));
    const int K = K_, nt = K / BK;
    int sR[2], sRb[2], sC[2];
#pragma unroll
    for (int i = 0; i < 2; ++i) { int R, C; stage_rc(tid * 16 + i * 8192, R, C); sR[i] = R; sC[i] = C; sRb[i] = (R & ~31) + perm32(R & 31); }
    unsigned voffA[2], voffB[2];
    const int LD = g.ld;
#pragma unroll
    for (int i = 0; i < 2; ++i) { voffA[i] = (unsigned)(sR[i] * LD + sC[i]) * 2u; voffB[i] = (unsigned)(sRb[i] * LD + sC[i]) * 2u; }
    const size_t kstep = (size_t)(BK * 2);
    const size_t hstep = (size_t)HALF * LD * 2;
    const unsigned ldsw = (unsigned)wid * 1024u;
    const int aoff = lds_byte(wr * 64 + fr, fq * 8), boff = lds_byte(wc * 32 + fr, fq * 8);
    constexpr int NTHR_ = 512;
    LAS unsigned* stash = (LAS unsigned*)(lds + 131072 + 320 + 1024) + tid;
    struct Side { const char* base[2]; unsigned off[2][2]; };
#define PG8_SA(b, h) (((b) * 2 + (h)) * HTB)
#define PG8_SB(b, h) ((4 + (b) * 2 + (h)) * HTB)
#define PG8_STAGE(bufoff, side, h, kt) do { _Pragma("unroll") for (int _i = 0; _i < 2; ++_i) { unsigned _o = (side).off[h][_i]; asm volatile("" : "+v"(_o)); \
        __builtin_amdgcn_global_load_lds((const unsigned*)((side).base[h] + (size_t)(kt) * kstep + _o), (LAS unsigned*)(lds + (bufoff) + ldsw + _i * 8192), 16, 0, 0); } } while (0)
#define PG8_LDA(dst, b, h) do { _Pragma("unroll") for (int m = 0; m < 4; ++m) _Pragma("unroll") for (int k = 0; k < 2; ++k) dst[m][k] = *(const LAS bf16x8*)(lds + PG8_SA(b, h) + aoff + m * 2048 + k * 1024); } while (0)
#define PG8_LDB(dst, b, h) do { _Pragma("unroll") for (int n = 0; n < 2; ++n) _Pragma("unroll") for (int k = 0; k < 2; ++k) dst[n][k] = *(const LAS bf16x8*)(lds + PG8_SB(b, h) + boff + n * 2048 + k * 1024); } while (0)
#define PG8_MMA(ai, bj, At, Bt) do { __builtin_amdgcn_s_setprio(1); _Pragma("unroll") for (int m = 0; m < 4; ++m) _Pragma("unroll") for (int n = 0; n < 2; ++n) { \
        if constexpr (F8 == 1) acc[ai][bj][m][n] = __builtin_amdgcn_mfma_scale_f32_16x16x128_f8f6f4(cat8(Bt[n][0], Bt[n][1]), cat8(At[m][0], At[m][1]), acc[ai][bj][m][n], 0, 0, 0, 0, 0, 0); \
        else if constexpr (F8 == 2) { _Pragma("unroll") for (int k = 0; k < 2; ++k) acc[ai][bj][m][n] = __builtin_bit_cast(f32x4, __builtin_amdgcn_mfma_i32_16x16x64_i8(__builtin_bit_cast(i32x4, Bt[n][k]), __builtin_bit_cast(i32x4, At[m][k]), __builtin_bit_cast(i32x4, acc[ai][bj][m][n]), 0, 0, 0)); } \
        else { _Pragma("unroll") for (int k = 0; k < 2; ++k) acc[ai][bj][m][n] = __builtin_amdgcn_mfma_f32_16x16x32_bf16(Bt[n][k], At[m][k], acc[ai][bj][m][n], 0, 0, 0); } } __builtin_amdgcn_s_setprio(0); } while (0)
#define PG8_WAIT_V(n) asm volatile("s_waitcnt vmcnt(" #n ")" ::: "memory")
#define PG8_WAIT_L(n) asm volatile("s_waitcnt lgkmcnt(" #n ")" ::: "memory")
#define PG8_BAR __builtin_amdgcn_s_barrier()
#define PG8_SCHED __builtin_amdgcn_sched_barrier(0)
#define PG8_MKSIDES(u, sa, sb) do { \
        if constexpr (Rows::GA) { sa.base[0] = sa.base[1] = (const char*)g.A; int t2_ = tid; asm volatile("" : "+v"(t2_)); _Pragma("unroll") for (int i = 0; i < 2; ++i) { int R_, C_; stage_rc(t2_ * 16 + i * 8192, R_, C_); \
            _Pragma("unroll") for (int h = 0; h < 2; ++h) sa.off[h][i] = RW.arow(u, h * HALF + R_) + (unsigned)C_ * 2u; } } \
        else { sa.base[0] = (const char*)g.A + (u).aoff; sa.base[1] = sa.base[0] + hstep; _Pragma("unroll") for (int h = 0; h < 2; ++h) _Pragma("unroll") for (int i = 0; i < 2; ++i) sa.off[h][i] = voffA[i]; } \
        if constexpr (Rows::GB) { sb.base[0] = sb.base[1] = (const char*)g.Bt; _Pragma("unroll") for (int h = 0; h < 2; ++h) _Pragma("unroll") for (int i = 0; i < 2; ++i) sb.off[h][i] = RW.brow(u, h * HALF + sRb[i]) + (unsigned)sC[i] * 2u; } \
        else { sb.base[0] = (const char*)g.Bt + (u).boff; sb.base[1] = sb.base[0] + hstep; _Pragma("unroll") for (int h = 0; h < 2; ++h) _Pragma("unroll") for (int i = 0; i < 2; ++i) sb.off[h][i] = voffB[i]; } } while (0)
    Unit cur, nxt; int ui = 0;
    if (!S.next(0, cur)) return;
    f32x4 acc[2][2][4][2];
#pragma unroll
    for (int a = 0; a < 2; ++a)
#pragma unroll
        for (int b = 0; b < 2; ++b)
#pragma unroll
            for (int m = 0; m < 4; ++m)
#pragma unroll
                for (int n = 0; n < 2; ++n) acc[a][b][m][n] = (f32x4){0.f, 0.f, 0.f, 0.f};
    bf16x8 At[4][2], B0[2][2], B1[2][2];
    Side cA, cB, nA, nB;
    PG8_MKSIDES(cur, cA, cB);
    PG8_STAGE(PG8_SB(0, 0), cB, 0, 0); PG8_STAGE(PG8_SB(0, 1), cB, 1, 0); PG8_STAGE(PG8_SA(0, 0), cA, 0, 0); PG8_STAGE(PG8_SA(0, 1), cA, 1, 0);
    if (wr == 1) PG8_BAR;
    PG8_WAIT_V(2); PG8_BAR;
    PG8_STAGE(PG8_SB(1, 0), cB, 0, 1); PG8_STAGE(PG8_SA(1, 0), cA, 0, 1); PG8_STAGE(PG8_SB(1, 1), cB, 1, 1);
    PG8_WAIT_V(6); PG8_BAR;
    for (;;) {
        const bool has_next = S.next(ui + 1, nxt);
        if (has_next) { PG8_MKSIDES(nxt, nA, nB); } else { nA = cA; nB = cB; }
        if constexpr (Rows::GA) {
#pragma unroll
            for (int h = 0; h < 2; ++h)
#pragma unroll
                for (int i = 0; i < 2; ++i) stash[(h * 2 + i) * NTHR_] = nA.off[h][i]; }
        for (int t = 0; t < nt; t += 2) {
            const bool last = (t == nt - 2);
            if constexpr (Epi::MIDK > 0) { if (t == Epi::MIDK) E.mid(acc, cur, wr, wc, fr, fq); }
            Side a2, b2;
            a2.base[0] = last ? nA.base[0] : cA.base[0]; a2.base[1] = last ? nA.base[1] : cA.base[1];
            b2.base[0] = last ? nB.base[0] : cB.base[0]; b2.base[1] = last ? nB.base[1] : cB.base[1];
#pragma unroll
            for (int h = 0; h < 2; ++h)
#pragma unroll
                for (int i = 0; i < 2; ++i) { if constexpr (!Rows::GA) a2.off[h][i] = cA.off[h][i]; b2.off[h][i] = (Rows::GB && last) ? nB.off[h][i] : cB.off[h][i]; }
            const int k2 = last ? 0 : t + 2, k3 = k2 + 1;
            PG8_LDB(B0, 0, 0); PG8_LDB(B1, 0, 1); PG8_SCHED; PG8_LDA(At, 0, 0); PG8_STAGE(PG8_SA(1, 1), cA, 1, t + 1);
            if constexpr (Rows::GA) {
                if (last) {
#pragma unroll
                    for (int h = 0; h < 2; ++h)
#pragma unroll
                        for (int i = 0; i < 2; ++i) cA.off[h][i] = stash[(h * 2 + i) * NTHR_]; }
#pragma unroll
                for (int h = 0; h < 2; ++h)
#pragma unroll
                    for (int i = 0; i < 2; ++i) a2.off[h][i] = cA.off[h][i]; }
            PG8_WAIT_V(8); PG8_WAIT_L(0); PG8_BAR; PG8_MMA(0, 0, At, B0); PG8_MMA(0, 1, At, B1); PG8_BAR; PG8_SCHED;
            PG8_LDA(At, 0, 1); PG8_STAGE(PG8_SB(0, 0), b2, 0, k2); PG8_STAGE(PG8_SB(0, 1), b2, 1, k2); PG8_STAGE(PG8_SA(0, 0), a2, 0, k2);
            PG8_WAIT_V(8); PG8_WAIT_L(0); PG8_BAR; PG8_MMA(1, 0, At, B0); PG8_MMA(1, 1, At, B1); PG8_BAR; PG8_SCHED;
            PG8_LDB(B0, 1, 0); PG8_LDB(B1, 1, 1); PG8_SCHED; PG8_LDA(At, 1, 0); PG8_STAGE(PG8_SA(0, 1), a2, 1, k2);
            PG8_WAIT_V(8); PG8_WAIT_L(0); PG8_BAR; PG8_MMA(0, 0, At, B0); PG8_MMA(0, 1, At, B1); PG8_BAR; PG8_SCHED;
            PG8_LDA(At, 1, 1); PG8_STAGE(PG8_SB(1, 0), b2, 0, k3); PG8_STAGE(PG8_SB(1, 1), b2, 1, k3); PG8_STAGE(PG8_SA(1, 0), a2, 0, k3);
            PG8_WAIT_V(8); PG8_WAIT_L(0); PG8_BAR; PG8_MMA(1, 0, At, B0); PG8_MMA(1, 1, At, B1); PG8_BAR; PG8_SCHED;
        }
        if (wr == 0) PG8_BAR;
        E(acc, cur, wr, wc, fr, fq);
        if (!has_next) break;
#pragma unroll
        for (int a = 0; a < 2; ++a)
#pragma unroll
            for (int b = 0; b < 2; ++b)
#pragma unroll
                for (int m = 0; m < 4; ++m)
#pragma unroll
                    for (int n = 0; n < 2; ++n) acc[a][b][m][n] = (f32x4){0.f, 0.f, 0.f, 0.f};
        cur = nxt; if constexpr (Rows::GA) { cA.base[0] = nA.base[0]; cA.base[1] = nA.base[1]; } else cA = nA; cB = nB; ++ui;
        if (wr == 1) PG8_BAR;
    }
    PG8_WAIT_V(0);
    PG8_BAR;
#undef PG8_SA
#undef PG8_SB
#undef PG8_STAGE
#undef PG8_LDA
#undef PG8_LDB
#undef PG8_MMA
#undef PG8_WAIT_V
#undef PG8_WAIT_L
#undef PG8_BAR
#undef PG8_SCHED
#undef PG8_MKSIDES
}

template <class Epi, class Sched, class Rows>
__device__ __forceinline__ void gemm_phase(LAS unsigned char* lds, const Gemm g, const Sched& S, const Epi& E, const Rows& RW) { gemm_phase_t<0>(lds, g, S, E, RW); }
template <class Epi, class Sched, class Rows>
__device__ __forceinline__ void gemm_phase8(LAS unsigned char* lds, const Gemm g, const Sched& S, const Epi& E, const Rows& RW) { gemm_phase_t<1>(lds, g, S, E, RW); }
template <class Epi, class Sched, class Rows>
__device__ __forceinline__ void gemm_phasei8(LAS unsigned char* lds, const Gemm g, const Sched& S, const Epi& E, const Rows& RW) { gemm_phase_t<2>(lds, g, S, E, RW); }

struct SUnit { unsigned aoff, boff; int K; int pm, pn, kind, x0, x1, grp, dep, sig; };
__device__ __forceinline__ void st16_wt(unsigned char* wsbase, unsigned off, u32x4 v) {
    const __amdgpu_buffer_rsrc_t rsrc = __builtin_amdgcn_make_buffer_rsrc((void*)wsbase, 0, 0x7fffffff, 0x00020000);
    __builtin_amdgcn_raw_buffer_store_b128(v, rsrc, off, 0, 16); }

template <class Epi, class Sched, class Rows>
__device__ __forceinline__ void gemm_stream(LAS unsigned char* lds, const char* base, const Sched& S, const Epi& E, const Rows& RW) {
    int tid_ = threadIdx.x; asm volatile("" : "+v"(tid_));
    const int tid = tid_, wid = __builtin_amdgcn_readfirstlane(tid >> 6), lane = tid & 63, wr = wid >> 2, wc = wid & 3, fr = lane & 15, fq = lane >> 4;
    int sR[2], sRb[2], sC[2];
#pragma unroll
    for (int i = 0; i < 2; ++i) { int R, C; stage_rc(tid * 16 + i * 8192, R, C); sR[i] = R; sC[i] = C; sRb[i] = (R & ~31) + perm32(R & 31); }
    const size_t kstep = (size_t)(BK * 2);
    const unsigned ldsw = (unsigned)wid * 1024u;
    const int aoff = lds_byte(wr * 64 + fr, fq * 8), boff = lds_byte(wc * 32 + fr, fq * 8);
    struct Side { const char* base[2]; unsigned off[2][2]; };
#define PG8_SA(b, h) (((b) * 2 + (h)) * HTB)
#define PG8_SB(b, h) ((4 + (b) * 2 + (h)) * HTB)
#define PG8_STAGE(bufoff, side, h, kt) do { _Pragma("unroll") for (int _i = 0; _i < 2; ++_i) \
        __builtin_amdgcn_global_load_lds((const unsigned*)((side).base[h] + (size_t)(kt) * kstep + (side).off[h][_i]), (LAS unsigned*)(lds + (bufoff) + ldsw + _i * 8192), 16, 0, 0); } while (0)
#define PG8_LDA(dst, b, h) do { _Pragma("unroll") for (int m = 0; m < 4; ++m) _Pragma("unroll") for (int k = 0; k < 2; ++k) dst[m][k] = *(const LAS bf16x8*)(lds + PG8_SA(b, h) + aoff + m * 2048 + k * 1024); } while (0)
#define PG8_LDB(dst, b, h) do { _Pragma("unroll") for (int n = 0; n < 2; ++n) _Pragma("unroll") for (int k = 0; k < 2; ++k) dst[n][k] = *(const LAS bf16x8*)(lds + PG8_SB(b, h) + boff + n * 2048 + k * 1024); } while (0)
#define PG8_MMA(ai, bj, At, Bt) do { __builtin_amdgcn_s_setprio(1); _Pragma("unroll") for (int m = 0; m < 4; ++m) _Pragma("unroll") for (int n = 0; n < 2; ++n) _Pragma("unroll") for (int k = 0; k < 2; ++k) \
        acc[ai][bj][m][n] = __builtin_amdgcn_mfma_f32_16x16x32_bf16(Bt[n][k], At[m][k], acc[ai][bj][m][n], 0, 0, 0); __builtin_amdgcn_s_setprio(0); } while (0)
#define PG8_WAIT_V(n) asm volatile("s_waitcnt vmcnt(" #n ")" ::: "memory")
#define PG8_WAIT_L(n) asm volatile("s_waitcnt lgkmcnt(" #n ")" ::: "memory")
#define PG8_BAR __builtin_amdgcn_s_barrier()
#define PG8_SCHED __builtin_amdgcn_sched_barrier(0)
#define PG8_MKSIDES(un, sa, sb) do { const int K_ = (un).K; \
        if (RW.a_gather(un)) { sa.base[0] = sa.base[1] = base; _Pragma("unroll") for (int h = 0; h < 2; ++h) _Pragma("unroll") for (int i = 0; i < 2; ++i) sa.off[h][i] = RW.arow(un, h * HALF + sR[i]) + (unsigned)sC[i] * 2u; } \
        else { sa.base[0] = base + (un).aoff; sa.base[1] = sa.base[0] + (size_t)HALF * K_ * 2; _Pragma("unroll") for (int h = 0; h < 2; ++h) _Pragma("unroll") for (int i = 0; i < 2; ++i) sa.off[h][i] = (unsigned)(sR[i] * K_ + sC[i]) * 2u; } \
        sb.base[0] = base + (un).boff; sb.base[1] = sb.base[0] + (size_t)HALF * K_ * 2; _Pragma("unroll") for (int h = 0; h < 2; ++h) _Pragma("unroll") for (int i = 0; i < 2; ++i) sb.off[h][i] = (unsigned)(sRb[i] * K_ + sC[i]) * 2u; } while (0)
#define PG8_SIGNAL(idx) do { if (lane == 0) __hip_atomic_fetch_add(S.rdy + 64 * (idx), 1u, __ATOMIC_RELAXED, __HIP_MEMORY_SCOPE_AGENT); } while (0)
    SUnit cur, nxt;
    unsigned pend = 0u;
    const unsigned lw_addr = (unsigned)(size_t)S.lw;
    if (tid == 0) { S.lw[0] = __hip_atomic_fetch_add(S.q, 1u, __ATOMIC_RELAXED, __HIP_MEMORY_SCOPE_AGENT); pend = __hip_atomic_fetch_add(S.q, 1u, __ATOMIC_RELAXED, __HIP_MEMORY_SCOPE_AGENT); }
    __syncthreads();
    { const int L0 = __builtin_amdgcn_readfirstlane((int)S.lw[0]); if (!S.decode(L0, cur)) return; }
    f32x4 acc[2][2][4][2];
#pragma unroll
    for (int a = 0; a < 2; ++a)
#pragma unroll
        for (int b = 0; b < 2; ++b)
#pragma unroll
            for (int m = 0; m < 4; ++m)
#pragma unroll
                for (int n = 0; n < 2; ++n) acc[a][b][m][n] = (f32x4){0.f, 0.f, 0.f, 0.f};
    bf16x8 At[4][2], B0[2][2], B1[2][2];
    Side cA, cB, nA, nB;
    bool need_pro = true; int sig_idx = -1;
    PG8_MKSIDES(cur, cA, cB);
    for (;;) {
        if (need_pro) {
            if (cur.dep >= 0) S.a_ready(cur);
            PG8_STAGE(PG8_SB(0, 0), cB, 0, 0); PG8_STAGE(PG8_SB(0, 1), cB, 1, 0); PG8_STAGE(PG8_SA(0, 0), cA, 0, 0); PG8_STAGE(PG8_SA(0, 1), cA, 1, 0);
            if (wr == 1) PG8_BAR;
            PG8_WAIT_V(2); PG8_BAR;
            PG8_STAGE(PG8_SB(1, 0), cB, 0, 1); PG8_STAGE(PG8_SA(1, 0), cA, 0, 1); PG8_STAGE(PG8_SB(1, 1), cB, 1, 1);
            PG8_WAIT_V(6); PG8_BAR;
        }
        if (tid == 0) { asm volatile("s_nop 7\n\tds_write_b32 %1, %0\n\tglobal_atomic_add %0, %2, %3, %4 sc0" : "+v"(pend) : "v"(lw_addr), "v"(0u), "v"(1u), "s"(S.q) : "memory"); }
        PG8_WAIT_L(0); PG8_BAR; asm volatile("" ::: "memory");
        const int Ln = __builtin_amdgcn_readfirstlane((int)S.lw[0]);
        const bool has_next = S.decode(Ln, nxt), pre = has_next && nxt.dep < 0;
        if (pre) { PG8_MKSIDES(nxt, nA, nB); } else { nA = cA; nB = cB; }
        const int nt = cur.K / BK;
        for (int t = 0; t < nt; t += 2) {
            const bool last = (t == nt - 2);
            Side a2, b2;
            a2.base[0] = last ? nA.base[0] : cA.base[0]; a2.base[1] = last ? nA.base[1] : cA.base[1];
            b2.base[0] = last ? nB.base[0] : cB.base[0]; b2.base[1] = last ? nB.base[1] : cB.base[1];
#pragma unroll
            for (int h = 0; h < 2; ++h)
#pragma unroll
                for (int i = 0; i < 2; ++i) { a2.off[h][i] = last ? nA.off[h][i] : cA.off[h][i]; b2.off[h][i] = last ? nB.off[h][i] : cB.off[h][i]; }
            const int k2 = last ? 0 : t + 2, k3 = k2 + 1;
            if (t == 2 && sig_idx >= 0) { PG8_SIGNAL(sig_idx); sig_idx = -1; }
            PG8_LDB(B0, 0, 0); PG8_LDB(B1, 0, 1); PG8_SCHED; PG8_LDA(At, 0, 0); PG8_STAGE(PG8_SA(1, 1), cA, 1, t + 1);
            PG8_WAIT_V(8); PG8_WAIT_L(0); PG8_BAR; PG8_MMA(0, 0, At, B0); PG8_MMA(0, 1, At, B1); PG8_BAR; PG8_SCHED;
            PG8_LDA(At, 0, 1); PG8_STAGE(PG8_SB(0, 0), b2, 0, k2); PG8_STAGE(PG8_SB(0, 1), b2, 1, k2); PG8_STAGE(PG8_SA(0, 0), a2, 0, k2);
            PG8_WAIT_V(8); PG8_WAIT_L(0); PG8_BAR; PG8_MMA(1, 0, At, B0); PG8_MMA(1, 1, At, B1); PG8_BAR; PG8_SCHED;
            PG8_LDB(B0, 1, 0); PG8_LDB(B1, 1, 1); PG8_SCHED; PG8_LDA(At, 1, 0); PG8_STAGE(PG8_SA(0, 1), a2, 1, k2);
            PG8_WAIT_V(8); PG8_WAIT_L(0); PG8_BAR; PG8_MMA(0, 0, At, B0); PG8_MMA(0, 1, At, B1); PG8_BAR; PG8_SCHED;
            PG8_LDA(At, 1, 1); PG8_STAGE(PG8_SB(1, 0), b2, 0, k3); PG8_STAGE(PG8_SB(1, 1), b2, 1, k3); PG8_STAGE(PG8_SA(1, 0), a2, 0, k3);
            PG8_WAIT_V(8); PG8_WAIT_L(0); PG8_BAR; PG8_MMA(1, 0, At, B0); PG8_MMA(1, 1, At, B1); PG8_BAR; PG8_SCHED;
        }
        if (wr == 0) PG8_BAR;
        E(acc, cur, wr, wc, fr, fq);
        if (!has_next) { PG8_WAIT_V(0); if (cur.sig >= 0) PG8_SIGNAL(cur.sig); break; }
#pragma unroll
        for (int a = 0; a < 2; ++a)
#pragma unroll
            for (int b = 0; b < 2; ++b)
#pragma unroll
                for (int m = 0; m < 4; ++m)
#pragma unroll
                    for (int n = 0; n < 2; ++n) acc[a][b][m][n] = (f32x4){0.f, 0.f, 0.f, 0.f};
        if (pre) {
            sig_idx = cur.sig; need_pro = false; cur = nxt; cA = nA; cB = nB;
            if (wr == 1) PG8_BAR;
        } else {
            PG8_WAIT_V(0); if (cur.sig >= 0) PG8_SIGNAL(cur.sig);
            PG8_BAR; need_pro = true; cur = nxt; PG8_MKSIDES(cur, cA, cB);
        }
    }
    PG8_BAR;
#undef PG8_SA
#undef PG8_SB
#undef PG8_STAGE
#undef PG8_LDA
#undef PG8_LDB
#undef PG8_MMA
#undef PG8_WAIT_V
#undef PG8_WAIT_L
#undef PG8_BAR
#undef PG8_SCHED
#undef PG8_MKSIDES
#undef PG8_SIGNAL
}
}
using pg8::Unit;
using pg8::SUnit;

struct Args { const float* in[21]; float* out; unsigned char* ws; int ph_lo, ph_hi; };

struct Frame {
    LAS unsigned char* lds;
    unsigned char* ws;
    const float* const* in;
    float* out;
    int tid, lane, wave, G, bx;
};
__device__ __forceinline__ float* modp(const Frame& F, int l, int v) { return (float*)(F.ws + WS_CTL) + CW_MOD + (l * 3 + v) * MODSZ; }

__device__ __forceinline__ void p0_transpose_item(const float* W, int ldw, int k0, int c0, bf16_t* WT, int ldt, int drow, int lane) {
    const float* src = W + (size_t)k0 * ldw + c0 + lane;
    float v[64];
#pragma unroll
    for (int i = 0; i < 64; ++i) { v[i] = src[(size_t)i * ldw]; }
    bf16_t* dst = WT + (size_t)drow * ldt + k0;
#pragma unroll
    for (int j = 0; j < 8; ++j) { u32x4 o; o.x = pk2(v[8 * j], v[8 * j + 1]); o.y = pk2(v[8 * j + 2], v[8 * j + 3]); o.z = pk2(v[8 * j + 4], v[8 * j + 5]); o.w = pk2(v[8 * j + 6], v[8 * j + 7]);
        *(u32x4*)(dst + 8 * j) = o; }
}
template <int QS>
__device__ __forceinline__ void p0_transpose_item8(const float* W, int ldw, int k0, int c0, unsigned char* WT, int ldt, int drow, int lane) {
    const float* src = W + (size_t)k0 * ldw + c0 + lane;
    float v[64];
#pragma unroll
    for (int i = 0; i < 64; ++i) v[i] = src[(size_t)i * ldw] * (float)QS;
    unsigned char* dst = WT + (size_t)drow * ldt + k0;
#pragma unroll
    for (int j = 0; j < 4; ++j) { u32x4 o; o.x = pk4f8(v[16 * j], v[16 * j + 1], v[16 * j + 2], v[16 * j + 3]); o.y = pk4f8(v[16 * j + 4], v[16 * j + 5], v[16 * j + 6], v[16 * j + 7]);
        o.z = pk4f8(v[16 * j + 8], v[16 * j + 9], v[16 * j + 10], v[16 * j + 11]); o.w = pk4f8(v[16 * j + 12], v[16 * j + 13], v[16 * j + 14], v[16 * j + 15]);
        *(u32x4*)(dst + 16 * j) = o; }
}

constexpr int CW_CONVQ = 12288 + 128;
constexpr int MOE_I_GE = 16 * 56, MOE_I_DE = 56 * 16, MOE_ITEMS = NE * (2 * MOE_I_GE + MOE_I_DE), MOE_BATCHES = MOE_ITEMS / 8;
__device__ __forceinline__ void moe_convert_batch(Frame& F, int which, int idx) {
    const float* const* in = F.in; const int ln = F.lane;
    int r = idx * 8 + F.wave;
    if (which == 0) { const int e = r / (2 * MOE_I_GE); r %= (2 * MOE_I_GE); const int up = r / MOE_I_GE; r %= MOE_I_GE; const int kb = r / 56, nb = r % 56, c0 = 64 * nb;
        p0_transpose_item8<QGU>(in[up ? 18 : 17] + (size_t)e * D * DFFE, DFFE, 64 * kb, c0, F.ws + WS_WGUE + (size_t)e * 2 * DFFE * D, D, (c0 >> 7) * 256 + up * 128 + (c0 & 127) + ln, ln); }
    else { const int e = r / MOE_I_DE; r %= MOE_I_DE; const int kb = r / 16, nb = r % 16;
        p0_transpose_item8<QDN>(in[19] + (size_t)e * DFFE * D, D, 64 * kb, 64 * nb, F.ws + WS_WDE + (size_t)e * D * DFFE, DFFE, 64 * nb + ln, ln); }
}
__device__ __forceinline__ void moe_convert(Frame& F, int which, int rep = 0) {
    volatile LAS unsigned* lw = (volatile LAS unsigned*)(F.lds + MISC_OFF) + 20;
    unsigned* q = (unsigned*)(F.ws + WS_CTL) + CW_CONVQ + 64 * which + 128 * rep;
    const int nb = which == 0 ? NE * 2 * MOE_I_GE / 8 : NE * MOE_I_DE / 8;
    for (;;) {
        __syncthreads();
        if (F.tid == 0) lw[0] = __hip_atomic_fetch_add(q, 1u, __ATOMIC_RELAXED, __HIP_MEMORY_SCOPE_AGENT);
        __syncthreads();
        const int idx = (int)lw[0];
        if (idx >= nb) break;
        moe_convert_batch(F, which, idx);
    }
    __syncthreads();
}

constexpr int MOE_P_GU = NE * 2 * 8 * 56, MOE_P_DN = NE * 28 * 16, MOE_PAIRS = MOE_P_GU + MOE_P_DN;
struct CvtItem { const float* src; unsigned char* dst; int ldw; float qs; };
__device__ __forceinline__ CvtItem moe_item(const Frame& F, int P, int half, int ln) {
    const float* const* in = F.in; CvtItem it;
    if (P < MOE_P_GU) { int r = P; const int e = r / (2 * 8 * 56); r %= (2 * 8 * 56); const int up = r / (8 * 56); r %= (8 * 56); const int kb = 2 * (r / 56) + half, nb = r % 56, c0 = 64 * nb;
        it.src = in[up ? 18 : 17] + (size_t)e * D * DFFE + (size_t)(64 * kb) * DFFE + c0 + ln; it.ldw = DFFE; it.qs = (float)QGU;
        it.dst = F.ws + WS_WGUE + (size_t)e * 2 * DFFE * D + (size_t)((c0 >> 7) * 256 + up * 128 + (c0 & 127) + ln) * D + 64 * kb; }
    else { int r = P - MOE_P_GU; const int e = r / (28 * 16); r %= (28 * 16); const int kb = 2 * (r / 16) + half, nb = r % 16;
        it.src = in[19] + (size_t)e * DFFE * D + (size_t)(64 * kb) * D + 64 * nb + ln; it.ldw = D; it.qs = (float)QDN;
        it.dst = F.ws + WS_WDE + (size_t)e * D * DFFE + (size_t)(64 * nb + ln) * DFFE + 64 * kb; }
    return it;
}
#define CVT_LOAD(v, it) do { _Pragma("unroll") for (int i_ = 0; i_ < 64; ++i_) v[i_] = (it).src[(size_t)i_ * (it).ldw]; } while (0)
#define CVT_STORE(v, it) do { _Pragma("unroll") for (int j_ = 0; j_ < 4; ++j_) { u32x4 o_; const float q_ = (it).qs; \
        o_.x = pk4f8(v[16 * j_] * q_, v[16 * j_ + 1] * q_, v[16 * j_ + 2] * q_, v[16 * j_ + 3] * q_); o_.y = pk4f8(v[16 * j_ + 4] * q_, v[16 * j_ + 5] * q_, v[16 * j_ + 6] * q_, v[16 * j_ + 7] * q_); \
        o_.z = pk4f8(v[16 * j_ + 8] * q_, v[16 * j_ + 9] * q_, v[16 * j_ + 10] * q_, v[16 * j_ + 11] * q_); o_.w = pk4f8(v[16 * j_ + 12] * q_, v[16 * j_ + 13] * q_, v[16 * j_ + 14] * q_, v[16 * j_ + 15] * q_); \
        *(u32x4*)((it).dst + 16 * j_) = o_; } } while (0)
__device__ __forceinline__ void moe_convert_all(Frame& F) {
    int t_ = threadIdx.x; asm volatile("" : "+v"(t_)); const int ln = t_ & 63;
    const int gw = F.bx * NWAVES + F.wave, NGW = F.G * NWAVES;
    float va[64], vb[64];
    int P = gw;
    CvtItem ia, ib;
    if (P < MOE_PAIRS) { ia = moe_item(F, P, 0, ln); CVT_LOAD(va, ia); }
    while (P < MOE_PAIRS) {
        ib = moe_item(F, P, 1, ln); CVT_LOAD(vb, ib);
        CVT_STORE(va, ia);
        const int Pn = P + NGW;
        if (Pn < MOE_PAIRS) { ia = moe_item(F, Pn, 0, ln); CVT_LOAD(va, ia); }
        CVT_STORE(vb, ib);
        P = Pn;
    }
}

__device__ __forceinline__ void p0_prologue(Frame& F) {
    const float* const* in = F.in;
    const int gw = F.bx * NWAVES + F.wave, NGW = F.G * NWAVES;
    {
        constexpr int I_IN = 16 * 44, I_O = 16 * 16, I_GD = 16 * 44, I_DD = 44 * 16;
        constexpr int N_A = 2 * I_IN + 2 * I_O + I_DD;
        const int ln = F.lane;
        for (int it = gw; it < N_A; it += NGW) {
            int r = it;
            if (r < 2 * I_IN) { const int l = r / I_IN; r %= I_IN; const int kb = r / 44, nb = r % 44, c0 = 512 + 64 * nb;
                const int n32 = ln & 31; const int dn = c0 < OFFV ? (ln & 32) + ((n32 < 16) ? 2 * n32 : 2 * (n32 - 16) + 1) : ln;
                int drow = c0 + dn;
                if (c0 >= OFFG) { const int gcol = c0 - OFFG; drow = gcol < D ? OFFG + (gcol >> 7) * 256 + (gcol & 127) + ln : OFFG + ((gcol - D) >> 7) * 256 + 128 + ((gcol - D) & 127) + ln; }
                p0_transpose_item(in[8] + (size_t)l * D * INW, INW, 64 * kb, c0, (bf16_t*)(F.ws + (l ? WS_WIN1 : WS_WIN0)), D, drow, ln); continue; }
            r -= 2 * I_IN;
            if (r < 2 * I_O) { const int l = r / I_O; r %= I_O; const int kb = r / 16, nb = r % 16;
                p0_transpose_item(in[12] + (size_t)l * D * D, D, 64 * kb, 64 * nb, (bf16_t*)(F.ws + (l ? WS_WO1 : WS_WO0)), D, 64 * nb + ln, ln); continue; }
            r -= 2 * I_O;
            { const int kb = r / 16, nb = r % 16;
              p0_transpose_item(in[15], D, 64 * kb, 64 * nb, (bf16_t*)(F.ws + WS_WDD), DFF0, 64 * nb + ln, ln); }
        }
    }
    {
        LAS float* pm_ = (LAS float*)(F.lds + 65536);
        const int ln = F.lane;
        for (int it = F.G - 1 - F.bx; it < 2 * 44; it += F.G) {
            const int up = it / 44, c0 = 64 * (it % 44);
            const float* src = in[up ? 14 : 13] + (size_t)(F.wave * 128) * DFF0 + c0 + ln;
            float v[128]; float am = 0.f;
#pragma unroll
            for (int i = 0; i < 128; ++i) v[i] = src[(size_t)i * DFF0];
#pragma unroll
            for (int i = 0; i < 128; ++i) am = fmaxf(am, fabsf(v[i]));
            __syncthreads();
            pm_[F.wave * 64 + ln] = am;
            __syncthreads();
#pragma unroll
            for (int w = 0; w < 8; ++w) am = fmaxf(am, pm_[w * 64 + ln]);
            const float sc = am > 0.f ? 127.0f / am : 0.f;
            const int drow = (c0 >> 7) * 256 + up * 128 + (c0 & 127) + ln;
            if (F.wave == 0) ((float*)(F.ws + WS_CSD))[drow] = am * (1.0f / 127.0f);
            unsigned char* dst = F.ws + WS_WGUD + (size_t)drow * D + F.wave * 128;
#pragma unroll
            for (int j = 0; j < 8; ++j) { u32x4 o; o.x = pk4i8(v[16 * j], v[16 * j + 1], v[16 * j + 2], v[16 * j + 3], sc); o.y = pk4i8(v[16 * j + 4], v[16 * j + 5], v[16 * j + 6], v[16 * j + 7], sc);
                o.z = pk4i8(v[16 * j + 8], v[16 * j + 9], v[16 * j + 10], v[16 * j + 11], sc); o.w = pk4i8(v[16 * j + 12], v[16 * j + 13], v[16 * j + 14], v[16 * j + 15], sc);
                *(u32x4*)(dst + 16 * j) = o; }
        }
    }
    __syncthreads();
    {
        LAS float* wrow = (LAS float*)F.lds;
        LAS float* ctab = wrow + 4096;
        if (F.tid < 128) ctab[F.tid] = cospif((float)F.tid / 64.0f);
        for (int it = F.bx; it < 2 * 128; it += F.G) {
            const int l = it >> 7, d0 = (it & 127) * 8;
            __syncthreads();
            for (int i = F.tid; i < 4096; i += NTHR) wrow[i] = in[8][(size_t)l * D * INW + (size_t)(d0 + (i >> 9)) * INW + (i & 511)];
            __syncthreads();
            const int r = F.tid, j = r >> 1, ri = r & 1, g = j >> 6, jj = j & 63;
            float a[8];
#pragma unroll
            for (int q = 0; q < 8; ++q) a[q] = 0.f;
            for (int cc = 0; cc < 128; ++cc) {
                float cf;
                if (jj == 0) cf = ri ? ((cc & 1) ? -1.f : 1.f) : 1.f;
                else { const int idx = (cc * jj) & 127; cf = ri ? -ctab[(idx - 32) & 127] : ctab[idx]; }
#pragma unroll
                for (int q = 0; q < 8; ++q) a[q] += cf * wrow[q * 512 + g * 128 + cc];
            }
            u32x4 o; o.x = pk2(a[0], a[1]); o.y = pk2(a[2], a[3]); o.z = pk2(a[4], a[5]); o.w = pk2(a[6], a[7]);
            *(u32x4*)((bf16_t*)(F.ws + (l ? WS_WIN1 : WS_WIN0)) + (size_t)r * D + d0) = o;
        }
        __syncthreads();
    }
    const int gt = F.bx * NTHR + F.tid, NGT = F.G * NTHR;
    for (int it = gt; it < 2 * 1024 * 144; it += NGT) {
        const int l = it / (1024 * 144), r = it % (1024 * 144), kc = r / 1024, o = r % 1024;
        const float* wf = in[10] + (size_t)l * 512 * D; const float* wa = in[11] + (size_t)l * 512 * D;
        float v[8];
#pragma unroll
        for (int q = 0; q < 8; ++q) { const int k = kc * 8 + q; float x = 0.f;
            if (k < 512) { const int mm = k & 127; x = wf[(size_t)k * D + o] * ((mm == 0 || mm == 64) ? 0.5f : 1.f); }
            else if (k < 520) { const int gg = (k - 512) >> 1, sgn = (k - 512) & 1; x = 0.5f * wf[(size_t)(gg * 128 + 64 * sgn) * D + o]; }
            else if (k >= 640) x = wa[(size_t)(k - 640) * D + o];
            v[q] = x; }
        u32x4 w; w.x = pk2(v[0], v[1]); w.y = pk2(v[2], v[3]); w.z = pk2(v[4], v[5]); w.w = pk2(v[6], v[7]);
        *(u32x4*)((bf16_t*)(F.ws + (l ? WS_WM1 : WS_WM0)) + (size_t)o * KM + kc * 8) = w;
    }
    for (int it = gt; it < 192 * 16; it += NGT) {
        const int i = it & 15, p = it >> 4, pos = p < 128 ? p : p - 128;
        const float inv = powf(10000.0f, -(float)i / 16.0f), a = (float)pos * inv;
        ((f32x2*)(F.ws + WS_ROPE))[it] = (f32x2){cosf(a), sinf(a)};
    }
    for (int it = gt; it < 128 * 64; it += NGT) {
        const int t2 = it >> 6, k1 = it & 63; float s, c; sincospif((float)(t2 * k1) / 4096.0f, &s, &c);
        ((f32x2*)(F.ws + WS_TW))[it] = (f32x2){c, s};
    }
    for (int it = gt; it < 256 * 128; it += NGT) {
        const int nu = it >> 7, ka = it & 127; float v = 0.f;
        if (nu < 128) { const int k1 = nu >> 1, ro = nu & 1, ri = ka >> 6, t1 = ka & 63; float s, c; sincospif((float)((t1 * k1) & 63) / 32.0f, &s, &c);
            v = ro == 0 ? (ri == 0 ? c : s) : (ri == 0 ? -s : c); }
        ((bf16_t*)(F.ws + WS_FA64))[it] = (bf16_t)f2bf(v);
    }
    for (int it = gt; it < 256 * 256; it += NGT) {
        const int mu = it >> 8, la = it & 255, k2 = mu >> 1, ro = mu & 1, ri = la >> 7, t2 = la & 127; float s, c; sincospif((float)((t2 * k2) & 127) / 64.0f, &s, &c);
        const float v = (ro == 0 ? (ri == 0 ? c : s) : (ri == 0 ? -s : c)) * 0.0009765625f;
        ((bf16_t*)(F.ws + WS_TC))[it] = (bf16_t)f2bf(v);
    }
    for (int it = gt; it < 512 * 512; it += NGT) {
        const int mu = it >> 9, la = it & 511, k = mu >> 1, ro = mu & 1, ri = la >> 8, t = la & 255; float s, c; sincospif((float)((t * k) & 255) / 128.0f, &s, &c);
        const float v = (ro == 0 ? (ri == 0 ? c : s) : (ri == 0 ? -s : c)) * 0.005524271728019903f;
        ((bf16_t*)(F.ws + WS_TX))[it] = (bf16_t)f2bf(v);
    }
    __syncthreads();
    {
        LAS float* sl = (LAS float*)F.lds;
        LAS float* part = sl + 3 * D;
        for (int i = F.tid; i < 3 * D; i += NTHR) { const float c = i < 2 * D ? in[1][i] : in[3][i - 2 * D]; sl[i] = c / (1.0f + __expf(-c)); }
        __syncthreads();
        for (int it = F.bx; it < 2 * 96; it += F.G) {
            const int l = it / 96, n = (it % 96) * 64 + F.lane;
            const float* wm = in[4] + (size_t)l * D * MODSZ + (size_t)(F.wave * 128) * MODSZ + n;
            float a0 = 0.f, a1 = 0.f, a2 = 0.f;
#pragma unroll
            for (int d0 = 0; d0 < 128; d0 += 32) { float w[32];
#pragma unroll
                for (int q = 0; q < 32; ++q) w[q] = wm[(size_t)(d0 + q) * MODSZ];
#pragma unroll
                for (int q = 0; q < 32; ++q) { const int d = F.wave * 128 + d0 + q; a0 += sl[d] * w[q]; a1 += sl[D + d] * w[q]; a2 += sl[2 * D + d] * w[q]; } }
            __syncthreads();
            part[(F.wave * 3 + 0) * 64 + F.lane] = a0; part[(F.wave * 3 + 1) * 64 + F.lane] = a1; part[(F.wave * 3 + 2) * 64 + F.lane] = a2;
            __syncthreads();
            if (F.tid < 192) { const int v = F.tid >> 6, ln = F.tid & 63; float sacc = in[5][l * MODSZ + (it % 96) * 64 + ln];
#pragma unroll
                for (int w = 0; w < 8; ++w) sacc += part[(w * 3 + v) * 64 + ln];
                modp(F, l, v)[(it % 96) * 64 + ln] = sacc; }
        }
    }
    for (int it = gt; it < NTOK * 15; it += NGT) { const int row = it / 15, c = it % 15;
        *(u32x4*)((bf16_t*)(F.ws + WS_FO) + (size_t)row * KM + 520 + c * 8) = (u32x4){0u, 0u, 0u, 0u}; }
}

__device__ __forceinline__ const float* xrow_ptr(const Frame& F, int row, const float* xl) { return row < NL ? xl + (size_t)row * D : (const float*)(F.ws + WS_XC) + (size_t)(row - NL) * D; }

template <bool ROUTE, int OUTM = ROUTE ? 1 : 0>
__device__ __forceinline__ void norm_phase(Frame& F, int l, int which  , const float* xl, const float* xc, int nrows, const float* xcadd = nullptr, float* xcwb = nullptr) {
    const float* gvec = F.in[which ? 7 : 6] + l * D;
    LAS float* wr_l = (LAS float*)F.lds;
    constexpr int RMAX = 32;
    LAS int* pe = (LAS int*)(F.lds + 32768); LAS float* pw = (LAS float*)(F.lds + 32768 + 2048); LAS unsigned* lcnt = (LAS unsigned*)(F.lds + 32768 + 4096); LAS unsigned* gb = lcnt + 8;
    if (ROUTE) { for (int i = F.tid; i < D * NE; i += NTHR) wr_l[i] = F.in[16][i]; pe[F.tid] = -1; if (F.tid < 8) lcnt[F.tid] = 0u; __syncthreads(); }
    const int gw = F.bx * NWAVES + F.wave, NGW = F.G * NWAVES;
    int iter = 0;
    for (int row = gw; row < nrows; row += NGW, ++iter) {
        const int v = row < T ? 0 : (row < NL ? 1 : 2);
        const bool fromb = row < NL && xl == nullptr;
        const float* xr = row < NL ? (fromb ? xc : xl + (size_t)row * D) : xc + (size_t)(row - NL) * D;
        const bf16_t* xbr = (const bf16_t*)(F.ws + WS_XB) + (size_t)row * D;
        const float* sh = modp(F, l, v) + (which ? 3 : 0) * D; const float* sc = sh + D;
        f32x4 x[4]; float s = 0.f;
#pragma unroll
        for (int j = 0; j < 4; ++j) {
            if (fromb) { const u32x2 xb = *(const u32x2*)(xbr + 256 * j + 4 * F.lane); x[j] = (f32x4){bflo(xb.x), bfhi(xb.x), bflo(xb.y), bfhi(xb.y)}; }
            else x[j] = *(const f32x4*)(xr + 256 * j + 4 * F.lane);
            if (row >= NL && xcadd) { x[j] = x[j] + *(const f32x4*)(xcadd + (size_t)(row - NL) * D + 256 * j + 4 * F.lane); if (xcwb) *(f32x4*)(xcwb + (size_t)(row - NL) * D + 256 * j + 4 * F.lane) = x[j]; }
            s += (x[j].x * x[j].x + x[j].y * x[j].y) + (x[j].z * x[j].z + x[j].w * x[j].w); }
        const float r = 1.0f / sqrtf(wave_sum(s) * (1.f / D) + EPS);
        float lg[NE];
        if (ROUTE) {
#pragma unroll
            for (int e = 0; e < NE; ++e) lg[e] = 0.f; }
        bf16_t* hr = (bf16_t*)(F.ws + WS_H) + (size_t)row * D;
        f32x4 hh[4]; float amax = 0.f;
#pragma unroll
        for (int j = 0; j < 4; ++j) { const int c = 256 * j + 4 * F.lane;
            const f32x4 gg = *(const f32x4*)(gvec + c), s4 = *(const f32x4*)(sh + c), c4 = *(const f32x4*)(sc + c);
            f32x4 h = (x[j] * r) * gg; h = h * (c4 + 1.0f) + s4;
            if (OUTM == 1) *(unsigned*)((unsigned char*)(F.ws + WS_H) + (size_t)row * D + c) = pk4f8(h.x, h.y, h.z, h.w);
            else if (OUTM == 0) { u32x2 o; o.x = pk2(h.x, h.y); o.y = pk2(h.z, h.w); *(u32x2*)(hr + c) = o; }
            else { hh[j] = h; amax = fmaxf(fmaxf(amax, fmaxf(fabsf(h.x), fabsf(h.y))), fmaxf(fabsf(h.z), fabsf(h.w))); }
            if (ROUTE) {
#pragma unroll
                for (int q = 0; q < 4; ++q) { const float hv = h[q]; const LAS f32x4* w = (const LAS f32x4*)(wr_l + (c + q) * NE); const f32x4 w0 = w[0], w1 = w[1];
                    lg[0] += hv * w0.x; lg[1] += hv * w0.y; lg[2] += hv * w0.z; lg[3] += hv * w0.w; lg[4] += hv * w1.x; lg[5] += hv * w1.y; lg[6] += hv * w1.z; lg[7] += hv * w1.w; } }
        }
        if (OUTM == 2) {
            amax = wave_max(amax);
            const float qs = amax > 0.f ? 127.0f / amax : 0.f;
            if (F.lane == 0) ((float*)(F.ws + WS_RS))[row] = amax * (1.0f / 127.0f);
#pragma unroll
            for (int j = 0; j < 4; ++j) *(unsigned*)((unsigned char*)(F.ws + WS_H) + (size_t)row * D + 256 * j + 4 * F.lane) = pk4i8(hh[j].x, hh[j].y, hh[j].z, hh[j].w, qs);
        }
        if (ROUTE) {
#pragma unroll
            for (int e = 0; e < NE; ++e) lg[e] = wave_sum(lg[e]);
            if (F.lane == 0) {
                int e1 = 0; float v1 = lg[0];
#pragma unroll
                for (int e = 1; e < NE; ++e) if (lg[e] > v1) { v1 = lg[e]; e1 = e; }
                int e2 = -1; float v2 = -3.0e38f;
#pragma unroll
                for (int e = 0; e < NE; ++e) if (e != e1 && lg[e] > v2) { v2 = lg[e]; e2 = e; }
                const float p2 = __expf(v2 - v1), w1 = 1.f / (1.f + p2), w2 = p2 * w1;
                const int p = 2 * (F.wave * RMAX + iter);
                pe[p] = e1; pe[p + 1] = e2; pw[p] = w1; pw[p + 1] = w2;
            }
        }
    }
    if (ROUTE) {
        __syncthreads();
        const int p = F.tid, e = pe[p]; unsigned lr = 0u;
        if (e >= 0) lr = __hip_atomic_fetch_add(lcnt + e, 1u, __ATOMIC_RELAXED, __HIP_MEMORY_SCOPE_WORKGROUP);
        __syncthreads();
        if (F.tid < NE && lcnt[F.tid] > 0u) gb[F.tid] = atomicAdd((unsigned*)(F.ws + WS_CTL) + CW_CNT + 64 * F.tid, lcnt[F.tid]);
        __syncthreads();
        if (e >= 0) {
            const int slot = p >> 1, row = F.bx * NWAVES + slot / RMAX + (slot % RMAX) * NGW, r = (int)(gb[e] + lr);
            int* toke = (int*)(F.ws + WS_TOKE); int* tokr = (int*)(F.ws + WS_TOKR); float* tokw = (float*)(F.ws + WS_TOKW); int* list = (int*)(F.ws + WS_LIST);
            toke[2 * row + (p & 1)] = e; tokr[2 * row + (p & 1)] = r; tokw[2 * row + (p & 1)] = pw[p]; list[e * NL + r] = row;
        }
        __syncthreads();
    }
}

constexpr int TAILQ_ROWS = 8 * 256;
__device__ __forceinline__ int moe_tail_panels(const unsigned* cw, int G) { int ptot = 0, plast = 0;
#pragma unroll
    for (int e = 0; e < NE; ++e) { const int p_ = ((int)cw[64 * e] + 255) >> 8; ptot += p_; plast = p_; }
    const int left = (4 * ptot) % G; int t = (left + 3) >> 2; if (4 * ptot < G) t = 0; if (t > plast) t = plast; if (t > 8) t = 8; return t; }
__device__ __forceinline__ void final_phase(Frame& F) {
    int t_ = threadIdx.x; asm volatile("" : "+v"(t_)); const int lane_ = t_ & 63;
    const int gw = F.bx * NWAVES + F.wave, NGW = F.G * NWAVES;
    const unsigned* cnt = (const unsigned*)(F.ws + WS_CTL) + CW_CNT;
    int base[NE]; { int b = 0;
#pragma unroll
        for (int e = 0; e < NE; ++e) { base[e] = b; b += ((int)cnt[64 * e] + 255) & ~255; } }
    const int* toke = (const int*)(F.ws + WS_TOKE); const int* tokr = (const int*)(F.ws + WS_TOKR); const float* tokw = (const float*)(F.ws + WS_TOKW);
    const bf16_t* dout = (const bf16_t*)(F.ws + WS_DOUT); const bf16_t* tq = (const bf16_t*)(F.ws + WS_DOUT1);
    const int trim_ = moe_tail_panels(cnt, F.G), trow0 = trim_ > 0 ? base[NE - 1] + ((((int)cnt[64 * (NE - 1)] + 255) >> 8) - trim_) * 256 : 0x7fffffff;
    for (int row = gw; row < NL; row += NGW) {
        const int v = row < T ? 0 : 1;
        const float* ga2 = modp(F, 1, v) + 5 * D;
        const int e1 = toke[2 * row], e2 = toke[2 * row + 1];
        int b1 = 0, b2 = 0;
#pragma unroll
        for (int e = 0; e < NE; ++e) { if (e == e1) b1 = base[e]; if (e == e2) b2 = base[e]; }
        const bf16_t* d1 = dout + (size_t)(b1 + tokr[2 * row]) * D; const bf16_t* d2 = dout + (size_t)(b2 + tokr[2 * row + 1]) * D;
        const int r1_ = b1 + tokr[2 * row], r2_ = b2 + tokr[2 * row + 1];
        const bool t1 = r1_ >= trow0, t2 = r2_ >= trow0;
        const bf16_t* q1 = tq + (size_t)(t1 ? r1_ - trow0 : 0) * D; const bf16_t* q2 = tq + (size_t)(t2 ? r2_ - trow0 : 0) * D;
        const float w1 = tokw[2 * row], w2 = tokw[2 * row + 1];
        float* xr = F.out + (size_t)row * D;
        f32x4 x[4]; float s = 0.f;
#pragma unroll
        for (int j = 0; j < 4; ++j) { const int c = 256 * j + 4 * lane_;
            const u32x2 a = *(const u32x2*)(d1 + c), b = *(const u32x2*)(d2 + c); const f32x4 g4 = *(const f32x4*)(ga2 + c);
            f32x4 ya = (f32x4){bflo(a.x), bfhi(a.x), bflo(a.y), bfhi(a.y)}, yb = (f32x4){bflo(b.x), bfhi(b.x), bflo(b.y), bfhi(b.y)};
            if (t1) {
#pragma unroll
                for (int k = 0; k < 1; ++k) { const u32x2 e_ = *(const u32x2*)(q1 + (size_t)k * TAILQ_ROWS * D + c); ya = ya + (f32x4){bflo(e_.x), bfhi(e_.x), bflo(e_.y), bfhi(e_.y)}; } }
            if (t2) {
#pragma unroll
                for (int k = 0; k < 1; ++k) { const u32x2 e_ = *(const u32x2*)(q2 + (size_t)k * TAILQ_ROWS * D + c); yb = yb + (f32x4){bflo(e_.x), bfhi(e_.x), bflo(e_.y), bfhi(e_.y)}; } }
            const f32x4 y = (ya * w1 + yb * w2) * (1.0f / (float)(QDN * QACT));
            { const u32x2 xb = *(const u32x2*)((const bf16_t*)(F.ws + WS_XB) + (size_t)row * D + c); x[j] = (f32x4){bflo(xb.x), bfhi(xb.x), bflo(xb.y), bfhi(xb.y)} + g4 * y; }
            s += (x[j].x * x[j].x + x[j].y * x[j].y) + (x[j].z * x[j].z + x[j].w * x[j].w); }
        const float r = 1.0f / sqrtf(wave_sum(s) * (1.f / D) + EPS);
#pragma unroll
        for (int j = 0; j < 4; ++j) { const int c = 256 * j + 4 * lane_; *(f32x4*)(xr + c) = (x[j] * r) * *(const f32x4*)(F.in[20] + c); }
    }
}

struct GridSched { int nM, nN, G, c; unsigned abytes, bbytes;
    __device__ __forceinline__ bool next(int i, Unit& u) const { const int L = i * G + c; if (L >= nM * nN) return false; pg8::swz_map(L, nM, nN, u.pm, u.pn); u.aoff = (unsigned)u.pm * abytes; u.boff = (unsigned)u.pn * bbytes; u.kind = 0; u.x0 = 0; u.x1 = 0; u.kh = 0; return true; } };

struct CtxSched { int G, c, nN; unsigned abytes, bbytes; int ksplit; unsigned khbytes;
    __device__ __forceinline__ bool next(int i, Unit& u) const { int L = i * G + c; if (L >= 2 * nN * ksplit) return false; u.kh = L / (2 * nN); L -= u.kh * 2 * nN; u.pm = 64 + L / nN; u.pn = L % nN;
        u.aoff = (unsigned)u.pm * abytes + (unsigned)u.kh * khbytes; u.boff = (unsigned)u.pn * bbytes + (unsigned)u.kh * khbytes; u.kind = 0; u.x0 = u.pm * 256; u.x1 = 0; return true; } };

struct InprojSched { int G, c, l;
    __device__ __forceinline__ bool next(int i, Unit& u) const { const int L = i * G + c; const int nmain = 64 * 11;
        if (L < nmain) { pg8::swz_map(L, 64, 11, u.pm, u.pn); }
        else { const int r = L - nmain; if (l == 0) { if (r >= 22) return false; u.pm = 64 + r / 11; u.pn = r % 11; } else { if (r >= 2) return false; u.pm = 64 + r; u.pn = 2; } }
        u.aoff = (unsigned)u.pm * (256u * D * 2u); u.boff = (unsigned)u.pn * (256u * D * 2u); u.kind = 0; u.x0 = 0; u.x1 = 0; u.kh = 0; return true; } };

struct EpiInproj {
    static constexpr bool PERM = true; static constexpr int MIDK = 0;
    unsigned char* ws;
    __device__ __forceinline__ void operator()(const f32x4 (&acc)[2][2][4][2], const Unit& u, int wr, int wc, int fr, int fq) const {
        const int row0 = u.pm * 256 + wr * 64 + fr;
        const bool lat = u.pm < 64;
        const f32x2* rope = (const f32x2*)(ws + WS_ROPE);
#pragma unroll
        for (int ai = 0; ai < 2; ++ai)
#pragma unroll
            for (int m = 0; m < 4; ++m) {
                const int row = row0 + ai * 128 + m * 16;
                const int t = row & (T - 1), prow = t >> 6, pcol = t & 63;
#pragma unroll
                for (int bj = 0; bj < 2; ++bj) {
                    const int cl = u.pn * 256 + bj * 128 + wc * 32 + 8 * fq;
                    f32x4 v0 = acc[ai][bj][m][0], v1 = acc[ai][bj][m][1];
                    bf16_t* dst;
                    if (cl < 640) {
                        if (lat) { const int dh = cl & 63, i0 = (dh & 31) >> 1; const f32x2* rp = rope + ((dh < 32 ? prow : 128 + pcol) * 16 + i0);
                            const f32x2 c0 = rp[0], c1 = rp[1], c2 = rp[2], c3 = rp[3];
                            f32x4 w0, w1; w0.x = v0.x * c0.x - v0.y * c0.y; w0.y = v0.x * c0.y + v0.y * c0.x; w0.z = v0.z * c1.x - v0.w * c1.y; w0.w = v0.z * c1.y + v0.w * c1.x;
                            w1.x = v1.x * c2.x - v1.y * c2.y; w1.y = v1.x * c2.y + v1.y * c2.x; w1.z = v1.z * c3.x - v1.w * c3.y; w1.w = v1.z * c3.y + v1.w * c3.x; v0 = w0; v1 = w1; }
                        if (cl < 512) { v0 = v0 * QSCALE; v1 = v1 * QSCALE; dst = (bf16_t*)(ws + WS_Q) + (size_t)row * 512 + cl; }
                        else dst = (bf16_t*)(ws + WS_KB) + (size_t)row * 128 + (cl - 512);
                    } else if (cl < 768) { dst = (bf16_t*)(ws + WS_VB) + (size_t)row * 128 + (cl - 640); }
                    else {
                        const int oc = (u.pn - 3) * 128 + wc * 32 + 8 * fq;
                        if (bj == 0) { const f32x4 a0 = acc[ai][1][m][0], a1 = acc[ai][1][m][1];
#pragma unroll
                            for (int q = 0; q < 4; ++q) { v0[q] = sigmoidf_(v0[q]) * (1.0f + __builtin_amdgcn_exp2f(-a0[q] * LOG2E)); v1[q] = sigmoidf_(v1[q]) * (1.0f + __builtin_amdgcn_exp2f(-a1[q] * LOG2E)); }
                            dst = (bf16_t*)(ws + WS_GF) + (size_t)row * D + oc; }
                        else {
#pragma unroll
                            for (int q = 0; q < 4; ++q) { v0[q] = sigmoidf_(v0[q]); v1[q] = sigmoidf_(v1[q]); }
                            dst = (bf16_t*)(ws + WS_GA) + (size_t)row * D + oc; } }
                    u32x4 w; w.x = cvt_pk_bf16(v0[0], v0[1]); w.y = cvt_pk_bf16(v0[2], v0[3]); w.z = cvt_pk_bf16(v1[0], v1[1]); w.w = cvt_pk_bf16(v1[2], v1[3]);
                    *(u32x4*)dst = w;
                }
            }
    }
};

struct UpermSched { int G, c, l;
    __device__ __forceinline__ bool next(int i, Unit& u) const { const int L = i * G + c; const int nn = l == 0 ? 66 : 64; if (L >= 2 * nn) return false;
        u.pm = L & 1; u.pn = L >> 1; u.aoff = (unsigned)u.pm * (256u * D * 2u); u.boff = 0; u.kind = 0; u.x0 = 0; u.x1 = 0; u.kh = 0; return true; } };
struct UpermRows { static constexpr bool GA = false, GB = true;
    __device__ __forceinline__ unsigned arow(const Unit&, int) const { return 0u; }
    __device__ __forceinline__ unsigned brow(const Unit& u, int c) const { const int n = u.pn; int row;
        if (n < 64) { const int b = n >> 5, q = n & 31; row = b * T + 128 * (c & 63) + 4 * q + (c >> 6); } else row = NL + (n - 64) * 256 + c;
        return (unsigned)row * (D * 2u); } };
struct EpiUperm {
    static constexpr bool PERM = true; static constexpr int MIDK = 0;
    unsigned char* ws;
    __device__ __forceinline__ void operator()(const f32x4 (&acc)[2][2][4][2], const Unit& u, int wr, int wc, int fr, int fq) const {
        const int n = u.pn;
#pragma unroll
        for (int ai = 0; ai < 2; ++ai)
#pragma unroll
            for (int m = 0; m < 4; ++m) { const int r = u.pm * 256 + ai * 128 + wr * 64 + m * 16 + fr, j = r >> 1, ri = r & 1;
#pragma unroll
                for (int bj = 0; bj < 2; ++bj) { const int c = bj * 128 + wc * 32 + 8 * fq;
                    const f32x4 v0 = acc[ai][bj][m][0], v1 = acc[ai][bj][m][1];
                    u32x4 w; w.x = cvt_pk_bf16(v0[0], v0[1]); w.y = cvt_pk_bf16(v0[2], v0[3]); w.z = cvt_pk_bf16(v1[0], v1[1]); w.w = cvt_pk_bf16(v1[2], v1[3]);
                    bf16_t* dst;
                    if (n < 64) { const int b = n >> 5, q = n & 31, t2 = 4 * q + (c >> 6), t1 = c & 63; dst = (bf16_t*)(ws + WS_UP) + ((size_t)((j * 2 + b) * 128 + t2) * 128 + ri * 64 + t1); }
                    else { const int b = n - 64; dst = (bf16_t*)(ws + WS_VCT) + ((size_t)((b * 256 + j) * 2 + ri) * 256 + c); }
                    *(u32x4*)dst = w; } }
    }
};

struct StepASched { int G, c, l;
    __device__ __forceinline__ bool next(int i, Unit& u) const { int L = i * G + c;
        if (l == 0 && G == 256) { if (c >= 16 && c < 20) return false; if (c >= 20 && c < 24) { if (i > 1) return false; L = i == 0 ? c : c - 4; } else if (i > 0) return false; }
        if (L >= 256) return false; pg8::swz_map(L, 256, 1, u.pm, u.pn); u.aoff = (unsigned)u.pm * (256u * 128u * 2u); u.boff = 0u; u.kind = 0; u.x0 = 0; u.x1 = 0; u.kh = 0; return true; } };

struct EpiStepA {
    static constexpr bool PERM = true; static constexpr int MIDK = 0;
    unsigned char* ws;
    __device__ __forceinline__ void operator()(const f32x4 (&acc)[2][2][4][2], const Unit& u, int wr, int wc, int fr, int fq) const {
        const f32x2* tw = (const f32x2*)(ws + WS_TW); bf16_t* gp = (bf16_t*)(ws + WS_GP);
        const int j = u.pm;
#pragma unroll
        for (int ai = 0; ai < 2; ++ai)
#pragma unroll
            for (int m = 0; m < 4; ++m) { const int t2 = wr * 64 + m * 16 + fr, b = ai;
#pragma unroll
                for (int n = 0; n < 2; ++n) { const f32x4 v = acc[ai][0][m][n];
#pragma unroll
                    for (int p = 0; p < 2; ++p) { const int k1 = 16 * wc + 4 * fq + 2 * n + p; const f32x2 w = tw[t2 * 64 + k1];
                        const float gr = v[2 * p], gi = v[2 * p + 1];
                        const float orr = gr * w.x + gi * w.y, oi = gi * w.x - gr * w.y;
                        bf16_t* d = gp + ((size_t)((b * 64 + k1) * 256 + j) * 256 + t2);
                        d[0] = (bf16_t)f2bf(orr); d[128] = (bf16_t)f2bf(oi); } } }
    }
};
template <bool CTXV> struct EpiStepC {
    static constexpr bool PERM = true; static constexpr int MIDK = 0;
    unsigned char* ws;
    __device__ __forceinline__ void operator()(const f32x4 (&acc)[2][2][4][2], const Unit& u, int wr_, int wc_, int fr_, int fq_) const {
        int wr = wr_, wc = wc_, fr = fr_, fq = fq_, upm = u.pm, upn = u.pn;
        asm volatile("" : "+s"(wr), "+s"(wc), "+v"(fr), "+v"(fq), "+s"(upm), "+s"(upn));
        bf16_t* fo = (bf16_t*)(ws + WS_FO);
        const int NN = CTXV ? 256 : T;
        const int b = CTXV ? upm : (upm >> 6), k1 = CTXV ? 0 : (upm & 63), rowb = CTXV ? NL + b * 256 : b * T;
        const int own0 = wr * 128 + fr, mir0 = wr * 128 + 128 - fr;
        const int kk0 = (CTXV ? 128 * upn : 0) + 16 * wc + 4 * fq;
#pragma unroll
        for (int bj = 0; bj < 2; ++bj)
#pragma unroll
            for (int n = 0; n < 2; ++n)
#pragma unroll
                for (int p = 0; p < 2; ++p) {
                    const int kk = kk0 + 64 * bj + 2 * n + p;
                    const int k = CTXV ? kk : (k1 + 64 * kk), km = (NN - k) & (NN - 1);
                    const unsigned oo = (unsigned)(rowb + k) * KM, om = (unsigned)(rowb + km) * KM;
#pragma unroll
                    for (int ai = 0; ai < 2; ++ai)
#pragma unroll
                        for (int m = 0; m < 4; ++m) {
                            const f32x4 v = acc[ai][bj][m][n];
                            const bf16_t re = (bf16_t)f2bf(v[2 * p]);
                            if (m == 0 && fr == 0) { const int g = 2 * ai + wr; const bf16_t im = (bf16_t)f2bf(v[2 * p + 1]);
                                fo[oo + g * 128] = re; fo[om + 512 + 2 * g] = re; fo[oo + g * 128 + 64] = im; fo[om + 512 + 2 * g + 1] = im; }
                            else { fo[oo + own0 + ai * 256 + 16 * m] = re; fo[om + mir0 + ai * 256 - 16 * m] = re; }
                        }
                    asm volatile("" ::: "memory"); __builtin_amdgcn_sched_barrier(0);
                }
    }
};

struct EpiMerge {
    static constexpr bool PERM = true; static constexpr int MIDK = 10;
    unsigned char* ws;
    __device__ __forceinline__ void mid(f32x4 (&acc)[2][2][4][2], const Unit& u, int wr, int wc, int fr, int fq) const {
        asm volatile("" : "+v"(fr), "+v"(fq));
#pragma unroll
        for (int ai = 0; ai < 2; ++ai)
#pragma unroll
            for (int m = 0; m < 4; ++m) { const size_t row = (size_t)(u.pm * 256 + ai * 128 + wr * 64 + m * 16 + fr);
#pragma unroll
                for (int bj = 0; bj < 2; ++bj) { const int col = u.pn * 256 + bj * 128 + wc * 32 + 8 * fq;
                    const u32x4 gr = *(const u32x4*)((const bf16_t*)(ws + WS_GF) + row * D + col);
                    const f32x4 r0 = (f32x4){bflo(gr.x), bfhi(gr.x), bflo(gr.y), bfhi(gr.y)}, r1 = (f32x4){bflo(gr.z), bfhi(gr.z), bflo(gr.w), bfhi(gr.w)};
                    acc[ai][bj][m][0] = acc[ai][bj][m][0] * r0; acc[ai][bj][m][1] = acc[ai][bj][m][1] * r1; } }
    }
    __device__ __forceinline__ void operator()(const f32x4 (&acc)[2][2][4][2], const Unit& u, int wr, int wc, int fr, int fq) const {
#pragma unroll
        for (int ai = 0; ai < 2; ++ai)
#pragma unroll
            for (int m = 0; m < 4; ++m) { const size_t row = (size_t)(u.pm * 256 + ai * 128 + wr * 64 + m * 16 + fr);
#pragma unroll
                for (int bj = 0; bj < 2; ++bj) { const int col = u.pn * 256 + bj * 128 + wc * 32 + 8 * fq;
                    const u32x4 ga = *(const u32x4*)((const bf16_t*)(ws + WS_GA) + row * D + col);
                    const f32x4 a0 = acc[ai][bj][m][0], a1 = acc[ai][bj][m][1];
                    u32x4 w;
                    w.x = cvt_pk_bf16(bflo(ga.x) * a0[0], bfhi(ga.x) * a0[1]); w.y = cvt_pk_bf16(bflo(ga.y) * a0[2], bfhi(ga.y) * a0[3]);
                    w.z = cvt_pk_bf16(bflo(ga.z) * a1[0], bfhi(ga.z) * a1[1]); w.w = cvt_pk_bf16(bflo(ga.w) * a1[2], bfhi(ga.w) * a1[3]);
                    *(u32x4*)((bf16_t*)(ws + WS_Y) + row * D + col) = w; } }
    }
};

struct EpiResid {
    static constexpr bool PERM = true; static constexpr int MIDK = 0;
    const float* xl_in32; const bf16_t* xl_inb; bf16_t* xl_out; const float* xc_in; float* xc_out; const float* mod_l; int chunk; float* tmpc;
    __device__ __forceinline__ void operator()(const f32x4 (&acc)[2][2][4][2], const Unit& u, int wr, int wc, int fr, int fq) const {
        const int v = u.pm < 32 ? 0 : (u.pm < 64 ? 1 : 2);
        const float* gate = mod_l + v * MODSZ + chunk * D;
        const bool lat = u.pm < 64; const int rbase = lat ? u.pm * 256 : (u.pm - 64) * 256;
#pragma unroll
        for (int bj = 0; bj < 2; ++bj) { const int col = u.pn * 256 + bj * 128 + wc * 32 + 8 * fq;
            const f32x4 g0 = *(const f32x4*)(gate + col), g1 = *(const f32x4*)(gate + col + 4);
#pragma unroll
            for (int ai = 0; ai < 2; ++ai)
#pragma unroll
                for (int m = 0; m < 4; ++m) { const size_t o = (size_t)(rbase + ai * 128 + wr * 64 + m * 16 + fr) * D + col;
                    if (lat) {
                        f32x4 x0, x1;
                        if (xl_in32) { x0 = *(const f32x4*)(xl_in32 + o); x1 = *(const f32x4*)(xl_in32 + o + 4); }
                        else { const u32x4 xb = *(const u32x4*)(xl_inb + o); x0 = (f32x4){bflo(xb.x), bfhi(xb.x), bflo(xb.y), bfhi(xb.y)}; x1 = (f32x4){bflo(xb.z), bfhi(xb.z), bflo(xb.w), bfhi(xb.w)}; }
                        x0 = x0 + g0 * acc[ai][bj][m][0]; x1 = x1 + g1 * acc[ai][bj][m][1];
                        u32x4 w; w.x = cvt_pk_bf16(x0[0], x0[1]); w.y = cvt_pk_bf16(x0[2], x0[3]); w.z = cvt_pk_bf16(x1[0], x1[1]); w.w = cvt_pk_bf16(x1[2], x1[3]);
                        *(u32x4*)(xl_out + o) = w;
                    } else if (u.kh) { *(f32x4*)(tmpc + o) = g0 * acc[ai][bj][m][0]; *(f32x4*)(tmpc + o + 4) = g1 * acc[ai][bj][m][1]; }
                    else { *(f32x4*)(xc_out + o) = *(const f32x4*)(xc_in + o) + g0 * acc[ai][bj][m][0];
                           *(f32x4*)(xc_out + o + 4) = *(const f32x4*)(xc_in + o + 4) + g1 * acc[ai][bj][m][1]; } } }
    }
};

struct EpiSwiglu {
    static constexpr bool PERM = true; static constexpr int MIDK = 0;
    bf16_t* act; int ld;
    __device__ __forceinline__ void operator()(const f32x4 (&acc)[2][2][4][2], const Unit& u, int wr, int wc, int fr, int fq) const {
        const int col = u.pn * 128 + wc * 32 + 8 * fq;
#pragma unroll
        for (int ai = 0; ai < 2; ++ai)
#pragma unroll
            for (int m = 0; m < 4; ++m) { const size_t row = (size_t)(u.x0 + ai * 128 + wr * 64 + m * 16 + fr);
                float o[8];
#pragma unroll
                for (int n = 0; n < 2; ++n)
#pragma unroll
                    for (int q = 0; q < 4; ++q) { const float gv = acc[ai][0][m][n][q], uv = acc[ai][1][m][n][q]; o[4 * n + q] = gv * sigmoidf_(gv) * uv; }
                u32x4 w; w.x = cvt_pk_bf16(o[0], o[1]); w.y = cvt_pk_bf16(o[2], o[3]); w.z = cvt_pk_bf16(o[4], o[5]); w.w = cvt_pk_bf16(o[6], o[7]);
                *(u32x4*)(act + row * ld + col) = w; }
    }
};
struct EpiSwigluI8 {
    static constexpr bool PERM = true; static constexpr int MIDK = 0;
    bf16_t* act; int ld; const float* rs; const float* cs;
    __device__ __forceinline__ void operator()(const f32x4 (&acc)[2][2][4][2], const Unit& u, int wr, int wc, int fr, int fq) const {
        asm volatile("" : "+v"(fr), "+v"(fq));
        const int col = u.pn * 128 + wc * 32 + 8 * fq;
        const float* cg = cs + u.pn * 256 + wc * 32 + 8 * fq;
        const f32x4 g0 = *(const f32x4*)cg, g1 = *(const f32x4*)(cg + 4), u0 = *(const f32x4*)(cg + 128), u1 = *(const f32x4*)(cg + 132);
        const float csg[8] = {g0.x, g0.y, g0.z, g0.w, g1.x, g1.y, g1.z, g1.w}, csu[8] = {u0.x, u0.y, u0.z, u0.w, u1.x, u1.y, u1.z, u1.w};
#pragma unroll
        for (int ai = 0; ai < 2; ++ai)
#pragma unroll
            for (int m = 0; m < 4; ++m) { const size_t row = (size_t)(u.x0 + ai * 128 + wr * 64 + m * 16 + fr);
                const float rsc = rs[row];
                float o[8];
#pragma unroll
                for (int n = 0; n < 2; ++n) { const pg8::i32x4 gi = __builtin_bit_cast(pg8::i32x4, acc[ai][0][m][n]), ui = __builtin_bit_cast(pg8::i32x4, acc[ai][1][m][n]);
#pragma unroll
                    for (int q = 0; q < 4; ++q) { const float gv = (float)gi[q] * (rsc * csg[4 * n + q]), uv = (float)ui[q] * (rsc * csu[4 * n + q]);
                        o[4 * n + q] = gv * sigmoidf_(gv) * uv; } }
                u32x4 w; w.x = cvt_pk_bf16(o[0], o[1]); w.y = cvt_pk_bf16(o[2], o[3]); w.z = cvt_pk_bf16(o[4], o[5]); w.w = cvt_pk_bf16(o[6], o[7]);
                *(u32x4*)(act + row * ld + col) = w; }
    }
};
struct EpiSwiglu8 {
    static constexpr bool PERM = true; static constexpr int MIDK = 0;
    unsigned char* act; int ld;
    __device__ __forceinline__ void operator()(const f32x4 (&acc)[2][2][4][2], const Unit& u, int wr, int wc, int fr, int fq) const {
        asm volatile("" : "+v"(fr), "+v"(fq));
        const int col = u.pn * 128 + wc * 32 + 8 * fq;
#pragma unroll
        for (int ai = 0; ai < 2; ++ai)
#pragma unroll
            for (int m = 0; m < 4; ++m) { const size_t row = (size_t)(u.x0 + ai * 128 + wr * 64 + m * 16 + fr);
                float o[8];
#pragma unroll
                for (int n = 0; n < 2; ++n)
#pragma unroll
                    for (int q = 0; q < 4; ++q) { const float gv = acc[ai][0][m][n][q] * (1.0f / (float)QGU), uv = acc[ai][1][m][n][q] * ((float)QACT / (float)QGU);
                        o[4 * n + q] = __builtin_amdgcn_fmed3f(gv * sigmoidf_(gv) * uv, -448.0f, 448.0f); }
                u32x2 w; w.x = pk4f8(o[0], o[1], o[2], o[3]); w.y = pk4f8(o[4], o[5], o[6], o[7]);
                *(u32x2*)(act + row * ld + col) = w; }
    }
};
struct EpiBf16 {
    static constexpr bool PERM = true; static constexpr int MIDK = 0;
    bf16_t* O0; bf16_t* O1; int ld;
    __device__ __forceinline__ void operator()(const f32x4 (&acc)[2][2][4][2], const Unit& u, int wr, int wc, int fr, int fq) const {
        asm volatile("" : "+v"(fr), "+v"(fq));
#pragma unroll
        for (int ai = 0; ai < 2; ++ai)
#pragma unroll
            for (int m = 0; m < 4; ++m) { const size_t row = (size_t)(u.x0 + ai * 128 + wr * 64 + m * 16 + fr);
#pragma unroll
                for (int bj = 0; bj < 2; ++bj) { const int col = u.pn * 256 + bj * 128 + wc * 32 + 8 * fq; const f32x4 v0 = acc[ai][bj][m][0], v1 = acc[ai][bj][m][1];
                    u32x4 w; w.x = cvt_pk_bf16(v0[0], v0[1]); w.y = cvt_pk_bf16(v0[2], v0[3]); w.z = cvt_pk_bf16(v1[0], v1[1]); w.w = cvt_pk_bf16(v1[2], v1[3]);
                    *(u32x4*)((u.kh ? O1 : O0) + row * ld + col) = w; } }
    }
};

struct RowSched { int nM, nN, G, c; unsigned abytes, bbytes;
    __device__ __forceinline__ bool next(int i, Unit& u) const { const int L = i * G + c; if (L >= nM * nN) return false; pg8::swz_map(L, nM, nN, u.pm, u.pn); u.aoff = (unsigned)u.pm * abytes; u.boff = (unsigned)u.pn * bbytes; u.kind = 0; u.x0 = u.pm * 256; u.x1 = 0; u.kh = 0; return true; } };

struct MoeSched { int G, c, nN, ksplit, trim; unsigned bexp, bbytes, arow_bytes, khbytes; bool a_slots; int cnt[NE], base[NE];
    __device__ __forceinline__ void init(const unsigned* cw) { int b = 0;
#pragma unroll
        for (int e = 0; e < NE; ++e) { cnt[e] = (int)cw[64 * e]; base[e] = b; b += (cnt[e] + 255) & ~255; } }
    __device__ __forceinline__ bool next(int i, Unit& u) const { int L = i * G + c; int e = 0;
        for (; e < NE; ++e) { const int nu = (((cnt[e] + 255) >> 8) - (e == NE - 1 ? trim : 0)) * nN * ksplit; if (L < nu) break; L -= nu; }
        if (e >= NE) return false;
        int cn = 0, bs = 0;
#pragma unroll
        for (int q = 0; q < NE; ++q) if (q == e) { cn = cnt[q]; bs = base[q]; }
        const int np_ = ((cn + 255) >> 8) - (e == NE - 1 ? trim : 0); const int nt_ = np_ * nN; u.kh = L / nt_; L -= u.kh * nt_;
        pg8::swz_map(L, np_, nN, u.pm, u.pn);
        u.kind = e; u.x1 = cn; u.x0 = bs + u.pm * 256;
        u.aoff = (a_slots ? (unsigned)u.x0 * arow_bytes : 0u) + (unsigned)u.kh * khbytes; u.boff = (unsigned)e * bexp + (unsigned)u.pn * bbytes + (unsigned)u.kh * khbytes; return true; } };
struct MoeTailSched { int G, c, trim, plast, rbase; unsigned bexp;
    __device__ __forceinline__ bool next(int i, Unit& u) const { int L = i * G + c; if (L >= 8 * trim) return false; u.kh = L / (4 * trim); L -= u.kh * 4 * trim;
        u.pm = plast - trim + (L >> 2); u.pn = L & 3; u.kind = NE - 1; u.x1 = 0; u.x0 = rbase + u.pm * 256;
        u.aoff = (unsigned)u.x0 * (unsigned)DFFE + (unsigned)u.kh * (DFFE / 2u); u.boff = (unsigned)(NE - 1) * bexp + (unsigned)u.pn * (256u * DFFE) + (unsigned)u.kh * (DFFE / 2u); return true; } };
struct EpiTail {
    static constexpr bool PERM = true; static constexpr int MIDK = 0;
    bf16_t* O0; bf16_t* Q; int row0;
    __device__ __forceinline__ void operator()(const f32x4 (&acc)[2][2][4][2], const Unit& u, int wr, int wc, int fr, int fq) const {
        asm volatile("" : "+v"(fr), "+v"(fq));
#pragma unroll
        for (int ai = 0; ai < 2; ++ai)
#pragma unroll
            for (int m = 0; m < 4; ++m) { const int row = u.x0 + ai * 128 + wr * 64 + m * 16 + fr;
                bf16_t* dst = u.kh == 0 ? O0 + (size_t)row * D : Q + ((size_t)(u.kh - 1) * TAILQ_ROWS + (size_t)(row - row0)) * D;
#pragma unroll
                for (int bj = 0; bj < 2; ++bj) { const int col = u.pn * 256 + bj * 128 + wc * 32 + 8 * fq; const f32x4 v0 = acc[ai][bj][m][0], v1 = acc[ai][bj][m][1];
                    u32x4 w; w.x = cvt_pk_bf16(v0[0], v0[1]); w.y = cvt_pk_bf16(v0[2], v0[3]); w.z = cvt_pk_bf16(v1[0], v1[1]); w.w = cvt_pk_bf16(v1[2], v1[3]);
                    *(u32x4*)(dst + col) = w; } }
    }
};
struct MoeRows { static constexpr bool GA = true, GB = false; const int* list;
    __device__ __forceinline__ unsigned arow(const Unit& u, int r) const { int idx = u.pm * 256 + r; idx = idx < u.x1 ? idx : u.x1 - 1; return (unsigned)list[u.kind * NL + idx] * (unsigned)D; }
    __device__ __forceinline__ unsigned brow(const Unit&, int) const { return 0u; } };


constexpr int CW_QUEUE = 12288, CW_RDY = 65536;
template <int NG, bool MOE> struct FfnStream {
    int P[NG], rb[NG], cn[NG];
    int f, nNgu, Kdn; unsigned need;
    unsigned* q; volatile LAS unsigned* lw; unsigned* rdy; unsigned* tmo;
    __device__ __forceinline__ void finish_init(int G) { int sacc = 0; f = NG;
#pragma unroll
        for (int g = NG - 1; g >= 0; --g) { if (f == g + 1 && sacc + P[g] * 4 <= G) { sacc += P[g] * 4; f = g; } }
        if (f > NG - 1) f = NG - 1; }
    __device__ __forceinline__ bool decode(int L, SUnit& u) const {
        int pos = L, kind = -1, grp = 0, j = 0;
#pragma unroll
        for (int g = 0; g < NG; ++g) {
            { const int n = P[g] * nNgu; if (kind < 0) { if (pos < n) { kind = 0; grp = g; j = pos; } else pos -= n; } }
            if (g >= 1 && (g - 1) < f) { const int n = P[g - 1] * 4; if (kind < 0) { if (pos < n) { kind = 1; grp = g - 1; j = pos; } else pos -= n; } }
        }
#pragma unroll
        for (int g = 0; g < NG; ++g) if (g >= f) { const int n = P[g] * 4; if (kind < 0) { if (pos < n) { kind = 1; grp = g; j = pos; } else pos -= n; } }
        if (kind < 0) return false;
        int nM = 0, rbase = 0, cnt = 0;
#pragma unroll
        for (int g = 0; g < NG; ++g) if (g == grp) { nM = P[g]; rbase = rb[g]; cnt = cn[g]; }
        const int nN = kind == 0 ? nNgu : 4;
        const int nig = 8 * nN, gid = j / nig, fm = gid * 8, gsz = (nM - fm) < 8 ? (nM - fm) : 8;
        u.pm = fm + ((j % nig) % gsz); u.pn = (j % nig) / gsz; u.kind = kind; u.grp = grp; u.x0 = rbase + u.pm * 256; u.x1 = cnt;
        const int gp = u.x0 >> 8;
        if (kind == 0) { u.K = D; u.dep = -1; u.sig = gp;
            u.aoff = (unsigned)WS_H + (unsigned)u.x0 * (D * 2u);
            u.boff = (MOE ? (unsigned)WS_WGUE + (unsigned)grp * (2u * DFFE * D * 2u) : (unsigned)WS_WGUD) + (unsigned)u.pn * (256u * D * 2u); }
        else { u.K = Kdn; u.dep = gp; u.sig = -1;
            u.aoff = (unsigned)WS_ACT + (unsigned)u.x0 * ((unsigned)Kdn * 2u);
            u.boff = (MOE ? (unsigned)WS_WDE + (unsigned)grp * ((unsigned)D * DFFE * 2u) : (unsigned)WS_WDD) + (unsigned)u.pn * (256u * (unsigned)Kdn * 2u); }
        return true;
    }
    __device__ __forceinline__ void a_ready(const SUnit& u) const {
        if (threadIdx.x < 64) {
            const unsigned long long t0 = __builtin_amdgcn_s_memrealtime(); unsigned polls = 0;
            while ((unsigned)__builtin_amdgcn_readfirstlane(__hip_atomic_load(rdy + 64 * u.dep, __ATOMIC_RELAXED, __HIP_MEMORY_SCOPE_AGENT)) < need) {
                if ((++polls & 255u) == 0u && __builtin_amdgcn_readfirstlane(__hip_atomic_load(tmo, __ATOMIC_RELAXED, __HIP_MEMORY_SCOPE_AGENT)) != 0u) break;
                if (__builtin_amdgcn_s_memrealtime() - t0 > 2000000ull) { if (threadIdx.x == 0) __hip_atomic_store(tmo, 1u, __ATOMIC_RELAXED, __HIP_MEMORY_SCOPE_AGENT); break; }
                __builtin_amdgcn_s_sleep(2); }
            __builtin_amdgcn_fence(__ATOMIC_ACQUIRE, "agent");
            asm volatile("s_waitcnt vmcnt(0)" ::: "memory");
        }
        asm volatile("" ::: "memory"); __builtin_amdgcn_s_barrier(); asm volatile("" ::: "memory");
    }
};
template <bool MOE> struct FfnRows { const int* list;
    __device__ __forceinline__ bool a_gather(const SUnit& u) const { return MOE && u.kind == 0; }
    __device__ __forceinline__ unsigned arow(const SUnit& u, int r) const { int idx = u.pm * 256 + r; idx = idx < u.x1 ? idx : u.x1 - 1; return (unsigned)WS_H + (unsigned)list[u.grp * NL + idx] * (D * 2u); } };

template <bool MOE> struct EpiFfn {
    static constexpr bool PERM = true; static constexpr int MIDK = 0;
    unsigned char* ws; float* xl; const float* mod_l;
    __device__ __forceinline__ void operator()(const f32x4 (&acc)[2][2][4][2], const SUnit& u, int wr, int wc, int fr, int fq) const {
        if (u.kind == 0) {
            constexpr int ld = MOE ? DFFE : DFF0;
            bf16_t* act = (bf16_t*)(ws + WS_ACT);
            const int col = u.pn * 128 + wc * 32 + 8 * fq;
#pragma unroll
            for (int ai = 0; ai < 2; ++ai)
#pragma unroll
                for (int m = 0; m < 4; ++m) { const size_t row = (size_t)(u.x0 + ai * 128 + wr * 64 + m * 16 + fr);
                    float o[8];
#pragma unroll
                    for (int n = 0; n < 2; ++n)
#pragma unroll
                        for (int q = 0; q < 4; ++q) { const float gv = acc[ai][0][m][n][q], uv = acc[ai][1][m][n][q]; o[4 * n + q] = gv * sigmoidf_(gv) * uv; }
                    u32x4 w; w.x = cvt_pk_bf16(o[0], o[1]); w.y = cvt_pk_bf16(o[2], o[3]); w.z = cvt_pk_bf16(o[4], o[5]); w.w = cvt_pk_bf16(o[6], o[7]);
                    pg8::st16_wt(ws, (unsigned)WS_ACT + ((unsigned)row * (unsigned)ld + (unsigned)col) * 2u, w); }
        } else if (MOE) {
            bf16_t* O = (bf16_t*)(ws + WS_DOUT);
#pragma unroll
            for (int ai = 0; ai < 2; ++ai)
#pragma unroll
                for (int m = 0; m < 4; ++m) { const size_t row = (size_t)(u.x0 + ai * 128 + wr * 64 + m * 16 + fr);
#pragma unroll
                    for (int bj = 0; bj < 2; ++bj) { const int col = u.pn * 256 + bj * 128 + wc * 32 + 8 * fq; const f32x4 v0 = acc[ai][bj][m][0], v1 = acc[ai][bj][m][1];
                        u32x4 w; w.x = cvt_pk_bf16(v0[0], v0[1]); w.y = cvt_pk_bf16(v0[2], v0[3]); w.z = cvt_pk_bf16(v1[0], v1[1]); w.w = cvt_pk_bf16(v1[2], v1[3]);
                        *(u32x4*)(O + row * D + col) = w; } }
        } else {
            asm volatile("" : "+v"(fr), "+v"(fq));
            const int pmg = u.x0 >> 8;
            const int v = pmg < 32 ? 0 : (pmg < 64 ? 1 : 2);
            const float* gate = mod_l + v * MODSZ + 5 * D;
            float* xo = pmg < 64 ? xl + (size_t)u.x0 * D : (float*)(ws + WS_XC) + (size_t)(u.x0 - NL) * D;
#pragma unroll
            for (int bj = 0; bj < 2; ++bj) { const int col = u.pn * 256 + bj * 128 + wc * 32 + 8 * fq;
                const f32x4 g0 = *(const f32x4*)(gate + col), g1 = *(const f32x4*)(gate + col + 4);
#pragma unroll
                for (int ai = 0; ai < 2; ++ai)
#pragma unroll
                    for (int m = 0; m < 4; ++m) { const size_t o = (size_t)(ai * 128 + wr * 64 + m * 16 + fr) * D + col;
                        *(f32x4*)(xo + o) = *(const f32x4*)(xo + o) + g0 * acc[ai][bj][m][0];
                        *(f32x4*)(xo + o + 4) = *(const f32x4*)(xo + o + 4) + g1 * acc[ai][bj][m][1];
                        asm volatile("" ::: "memory"); __builtin_amdgcn_sched_barrier(0); } }
        }
    }
};

__device__ __forceinline__ int crow(int r, int hi) { return (r & 3) + 8 * (r >> 2) + 4 * hi; }
__device__ __forceinline__ s16x4 vtr(const LAS unsigned char* p) { typedef short v4i16_t __attribute__((ext_vector_type(4))); return __builtin_bit_cast(s16x4, __builtin_amdgcn_ds_read_tr16_b64_v4i16((LAS v4i16_t*)p)); }

__device__ __forceinline__ void attn_unit(Frame& F, int l, int b, int hkv, int qb, bool ctxq) {
    const int tid = F.tid, lane = F.lane, wid = F.wave, r32 = lane & 31, hi = lane >> 5;
    const int g = wid >> 1, qs = wid & 1, head = hkv * 4 + g;
    const bf16_t* Q = (const bf16_t*)(F.ws + WS_Q); const bf16_t* KB = (const bf16_t*)(F.ws + WS_KB); const bf16_t* VB = (const bf16_t*)(F.ws + WS_VB);
    const int q0 = qb * 64;
    const int qrow = (ctxq ? NL + b * CTXL : b * T) + q0 + qs * 32 + r32;
    bf16x8 qr[4];
#pragma unroll
    for (int d0 = 0; d0 < 4; ++d0) qr[d0] = *(const bf16x8*)(Q + (size_t)qrow * 512 + head * 64 + d0 * 16 + hi * 8);
    int jlo = 0, jhi = -1;
    if (!ctxq) { jlo = -2; jhi = 2; if (q0 + 64 * jlo < 0) jlo = -(q0 / 64); if (q0 + 64 * jhi >= T) jhi = (T - 64 - q0) / 64; }
    const int nloc = jhi - jlo + 1, ntile = nloc + 4;
    const float sinkv = F.in[9][l * 8 + head] * LOG2E;
    float mrun = sinkv, lrun = 1.0f;
    f32x16 o[2]; o[0] = f32x16{}; o[1] = f32x16{};
    const int kkey = lane, vkey = 16 * (wid & 3) + (lane >> 2);
    auto tile_row = [&](int ti) -> int { return ti < nloc ? b * T + q0 + 64 * (jlo + ti) : NL + b * CTXL + 64 * (ti - nloc); };
    u32x4 kreg, vreg;
    { const int r0 = tile_row(0); kreg = *(const u32x4*)(KB + (size_t)(r0 + kkey) * 128 + hkv * 64 + wid * 8); vreg = *(const u32x4*)(VB + (size_t)(r0 + vkey) * 128 + hkv * 64 + (wid >> 2) * 32 + (lane & 3) * 8); }
    for (int ti = 0; ti < ntile; ++ti) {
        LAS unsigned char* slot = F.lds + (ti & 1) * 16384;
        *(LAS u32x4*)(slot + wid * 1024 + lane * 16) = kreg;
        *(LAS u32x4*)(slot + 8192 + wid * 1024 + lane * 16) = vreg;
        __syncthreads();
        if (ti + 1 < ntile) { const int r0 = tile_row(ti + 1); kreg = *(const u32x4*)(KB + (size_t)(r0 + kkey) * 128 + hkv * 64 + wid * 8); vreg = *(const u32x4*)(VB + (size_t)(r0 + vkey) * 128 + hkv * 64 + (wid >> 2) * 32 + (lane & 3) * 8); }
        f32x16 p0 = f32x16{}, p1 = f32x16{};
        { const LAS unsigned char* kb = slot + hi * 1024 + r32 * 16;
#pragma unroll
          for (int d0 = 0; d0 < 4; ++d0) { const bf16x8 k0 = *(const LAS bf16x8*)(kb + d0 * 2048), k1 = *(const LAS bf16x8*)(kb + d0 * 2048 + 512);
              p0 = __builtin_amdgcn_mfma_f32_32x32x16_bf16(k0, qr[d0], p0, 0, 0, 0); p1 = __builtin_amdgcn_mfma_f32_32x32x16_bf16(k1, qr[d0], p1, 0, 0, 0); } }
        if (ti < nloc) { const int j = jlo + ti; const int qq = qs * 32 + r32;
            if (j == -2) {
#pragma unroll
                for (int r = 0; r < 16; ++r) { const int kk = crow(r, hi); if (kk < qq) p0[r] = -INFINITY; if (kk + 32 < qq) p1[r] = -INFINITY; } }
            else if (j == 2) {
#pragma unroll
                for (int r = 0; r < 16; ++r) { const int kk = crow(r, hi); if (kk > qq) p0[r] = -INFINITY; if (kk + 32 > qq) p1[r] = -INFINITY; } } }
        float mx = p0[0];
#pragma unroll
        for (int r = 1; r < 16; ++r) mx = fmaxf(mx, p0[r]);
#pragma unroll
        for (int r = 0; r < 16; ++r) mx = fmaxf(mx, p1[r]);
        mx = fmaxf(mx, __shfl_xor(mx, 32));
        const float mnew = fmaxf(mrun, mx), fsc = __builtin_amdgcn_exp2f(mrun - mnew);
        mrun = mnew;
        float rs = 0.f;
#pragma unroll
        for (int r = 0; r < 16; ++r) { p0[r] = __builtin_amdgcn_exp2f(p0[r] - mnew); p1[r] = __builtin_amdgcn_exp2f(p1[r] - mnew); rs += p0[r] + p1[r]; }
        rs += __shfl_xor(rs, 32);
        lrun = lrun * fsc + rs;
#pragma unroll
        for (int r = 0; r < 16; ++r) { o[0][r] *= fsc; o[1][r] *= fsc; }
        u32x4 pw[4];
        pw[0] = (u32x4){cvt_pk_bf16(p0[0], p0[1]), cvt_pk_bf16(p0[2], p0[3]), cvt_pk_bf16(p0[4], p0[5]), cvt_pk_bf16(p0[6], p0[7])};
        pw[1] = (u32x4){cvt_pk_bf16(p0[8], p0[9]), cvt_pk_bf16(p0[10], p0[11]), cvt_pk_bf16(p0[12], p0[13]), cvt_pk_bf16(p0[14], p0[15])};
        pw[2] = (u32x4){cvt_pk_bf16(p1[0], p1[1]), cvt_pk_bf16(p1[2], p1[3]), cvt_pk_bf16(p1[4], p1[5]), cvt_pk_bf16(p1[6], p1[7])};
        pw[3] = (u32x4){cvt_pk_bf16(p1[8], p1[9]), cvt_pk_bf16(p1[10], p1[11]), cvt_pk_bf16(p1[12], p1[13]), cvt_pk_bf16(p1[14], p1[15])};
        { const LAS unsigned char* vb = slot + 8192 + ((lane >> 4) & 1) * 32 + (lane & 3) * 8 + (4 * hi + ((lane & 15) >> 2)) * 64;
#pragma unroll
          for (int d0 = 0; d0 < 2; ++d0)
#pragma unroll
              for (int ks = 0; ks < 4; ++ks) { const s16x4 lo = vtr(vb + d0 * 4096 + ks * 1024), hh = vtr(vb + d0 * 4096 + ks * 1024 + 512);
                  const bf16x8 vf = (bf16x8){lo[0], lo[1], lo[2], lo[3], hh[0], hh[1], hh[2], hh[3]};
                  o[d0] = __builtin_amdgcn_mfma_f32_32x32x16_bf16(vf, __builtin_bit_cast(bf16x8, pw[ks]), o[d0], 0, 0, 0); } }
    }
    const float rl = 1.0f / lrun;
    bf16_t* orow = (bf16_t*)(F.ws + WS_FO) + (size_t)qrow * KM + 640 + head * 64;
#pragma unroll
    for (int d0 = 0; d0 < 2; ++d0)
#pragma unroll
        for (int rq = 0; rq < 4; ++rq) { u32x2 w; w.x = cvt_pk_bf16(o[d0][4 * rq] * rl, o[d0][4 * rq + 1] * rl); w.y = cvt_pk_bf16(o[d0][4 * rq + 2] * rl, o[d0][4 * rq + 3] * rl);
            *(u32x2*)(orow + 32 * d0 + 8 * rq + 4 * hi) = w; }
    __syncthreads();
}

__device__ __forceinline__ void attn_phase(Frame& F, int l, int part) {
    const int nlat = NB * 2 * 128;
    auto lat_unit = [&](int it) { const int qb = it & 127, hkv = (it >> 7) & 1, b = it >> 8; attn_unit(F, l, b, hkv, qb, false); };
    if (part == 0) {
        const bool extra = (l == 0) && F.G == 256 && ((F.bx >= 16 && F.bx < 24) || F.bx >= 240);
        if (!extra) for (int it = F.bx; it < 256; it += F.G) lat_unit(it);
        if (l == 0) for (int r = (F.bx + F.G - 240) % F.G; r < NB * 2 * 4; r += F.G) { const int qb = r & 3, hkv = (r >> 2) & 1, b = r >> 3; attn_unit(F, l, b, hkv, qb, true); }
    } else {
        const bool busy = (l == 0) && F.bx >= 128 && F.bx < 136;
        if (!busy) for (int it = 256 + F.bx; it < nlat; it += F.G) lat_unit(it);
        if (l == 0 && F.bx >= 136 && F.bx < 144) lat_unit(256 + F.bx - 8);
        if (l == 0 && F.G == 256 && F.bx >= 144 && F.bx < 168) { const int k = F.bx - 144; lat_unit(k < 8 ? 16 + k : 240 + (k - 8)); }
    }
}

#if !MK_MULTI
#define GRID_BAR() xcd_barrier(bar)
#else
#define GRID_BAR() do {} while (0)
#endif
#ifndef PH_MASK
#define PH_MASK 0xFFFFFu
#endif
#define IN(k) (((PH_MASK >> (k)) & 1u) && lo <= (k) && (k) < hi)
#define SEAM(k) do { if (IN((k) + 1)) GRID_BAR(); } while (0)
#ifndef REP_MASK
#define REP_MASK 0u
#endif
#define REPS(k) ((((REP_MASK) >> (k)) & 1u) ? 2 : 1)
template <int l, class BarT>
__device__ __forceinline__ void layer_phases(Frame& F, unsigned* ctl, const int lo, const int hi, const BarT& bar) {
        const int pb = 1 + 8 * l;
        bf16_t* H = (bf16_t*)(F.ws + WS_H);
        const float* xl_in = l == 0 ? F.in[0] : nullptr;
        bf16_t* XB = (bf16_t*)(F.ws + WS_XB);
        const float* xc_in = l == 0 ? F.in[2] : (const float*)(F.ws + WS_XC);
        float* xc = (float*)(F.ws + WS_XC);
        const float* mod_l = (const float*)ctl + CW_MOD + l * 3 * MODSZ;
        if (IN(pb + 0)) { for (int rep = 0; rep < REPS(pb + 0); ++rep) norm_phase<false>(F, l, 0, xl_in, xc_in, NTOK, l == 1 ? (const float*)(F.ws + WS_TMPC2) : nullptr, nullptr); SEAM(pb + 0); }
        if (IN(pb + 1)) {
            for (int rep = 0; rep < REPS(pb + 1); ++rep) {
            { pg8::Gemm g{H, (const bf16_t*)(F.ws + (l ? WS_WIN1 : WS_WIN0)) + (size_t)512 * D, D, D}; InprojSched S{F.G, F.bx, l}; EpiInproj E{F.ws}; pg8::NoGather R;
              pg8::gemm_phase(F.lds, g, S, E, R); }
            { pg8::Gemm g{(const bf16_t*)(F.ws + (l ? WS_WIN1 : WS_WIN0)), H, D, D}; UpermSched S{F.G, F.bx, l}; EpiUperm E{F.ws}; UpermRows R;
              pg8::gemm_phase(F.lds, g, S, E, R); }
            }
            SEAM(pb + 1);
        }
        if (IN(pb + 2)) {
            for (int rep = 0; rep < REPS(pb + 2); ++rep) {
            attn_phase(F, l, 0);
            { pg8::Gemm g{(const bf16_t*)(F.ws + WS_UP), (const bf16_t*)(F.ws + WS_FA64), 128, 128}; StepASched S{F.G, F.bx, l}; EpiStepA E{F.ws}; pg8::NoGather R;
              pg8::gemm_phase(F.lds, g, S, E, R); }
            if (l == 0) { pg8::Gemm g{(const bf16_t*)(F.ws + WS_VCT), (const bf16_t*)(F.ws + WS_TX), 512, 512}; GridSched S{2, 2, F.G, (F.bx + F.G - 16) % F.G, 256u * 512u * 2u, 256u * 512u * 2u}; EpiStepC<true> E{F.ws}; pg8::NoGather R;
              pg8::gemm_phase(F.lds, g, S, E, R); }
            }
            SEAM(pb + 2);
        }
        if (IN(pb + 3)) {
            for (int rep = 0; rep < REPS(pb + 3); ++rep) {
            { pg8::Gemm g{(const bf16_t*)(F.ws + WS_GP), (const bf16_t*)(F.ws + WS_TC), 256, 256}; GridSched S{128, 1, F.G, F.bx, 256u * 256u * 2u, 0u}; EpiStepC<false> E{F.ws}; pg8::NoGather R;
              pg8::gemm_phase(F.lds, g, S, E, R); }
            if (l == 0) { pg8::Gemm g{(const bf16_t*)(F.ws + WS_FO), (const bf16_t*)(F.ws + WS_WM0), KM, KM}; CtxSched S{F.G, (F.bx + F.G - 128) % F.G, 4, 256u * KM * 2u, 256u * KM * 2u, 1, 0u}; EpiMerge E{F.ws}; pg8::NoGather R;
              pg8::gemm_phase(F.lds, g, S, E, R); }
            attn_phase(F, l, 1);
            }
            SEAM(pb + 3);
        }
        if (IN(pb + 4)) {
            const int nM = 64;
            pg8::Gemm g{(const bf16_t*)(F.ws + WS_FO), (const bf16_t*)(F.ws + (l ? WS_WM1 : WS_WM0)), KM, KM}; GridSched S{nM, 4, F.G, F.bx, 256u * KM * 2u, 256u * KM * 2u}; EpiMerge E{F.ws}; pg8::NoGather R;
            for (int rep = 0; rep < REPS(pb + 4); ++rep) pg8::gemm_phase(F.lds, g, S, E, R);
            SEAM(pb + 4);
        }
        if (IN(pb + 5)) {
            EpiResid E{xl_in, XB, XB, xc_in, xc, mod_l, 2, (float*)(F.ws + WS_TMPC1)}; pg8::NoGather R;
            for (int rep = 0; rep < (l == 0 ? REPS(6) : 1); ++rep)
            { pg8::Gemm g{(const bf16_t*)(F.ws + WS_Y), (const bf16_t*)(F.ws + (l ? WS_WO1 : WS_WO0)), D, D}; GridSched S{64, 4, F.G, F.bx, 256u * D * 2u, 256u * D * 2u};
              pg8::gemm_phase(F.lds, g, S, E, R); }
            if (l == 0) { pg8::Gemm g{(const bf16_t*)(F.ws + WS_Y), (const bf16_t*)(F.ws + WS_WO0), D / 2, D}; CtxSched S{F.G, F.bx, 4, 256u * D * 2u, 256u * D * 2u, 2, (unsigned)D};
              pg8::gemm_phase(F.lds, g, S, E, R); }
            SEAM(pb + 5);
        }
        if (IN(pb + 6)) {
            if (l == 0) norm_phase<false, 2>(F, l, 1, nullptr, xc, NTOK, (const float*)(F.ws + WS_TMPC1), xc); else { norm_phase<true>(F, l, 1, nullptr, xc, NL); for (int rep = 0; rep < REPS(21); ++rep) moe_convert_all(F); }
            SEAM(pb + 6);
        }
#ifndef STREAM0
#define STREAM0 0
#endif
#ifndef STREAM1
#define STREAM1 0
#endif
        if (IN(pb + 7)) {
            volatile LAS unsigned* lw = (volatile LAS unsigned*)(F.lds + MISC_OFF) + 16;
            if (l == 0) {
#if STREAM0
                FfnStream<9, false> S;
#pragma unroll
                for (int g = 0; g < 9; ++g) { S.P[g] = g < 8 ? 8 : 2; S.rb[g] = 2048 * g; S.cn[g] = g < 8 ? 2048 : 512; }
                S.nNgu = 22; S.Kdn = DFF0; S.need = 22u * 8u; S.q = ctl + CW_QUEUE; S.lw = lw; S.rdy = ctl + CW_RDY; S.tmo = ctl + 2; S.finish_init(F.G);
                EpiFfn<false> E{F.ws, F.out, mod_l}; FfnRows<false> R{nullptr};
                pg8::gemm_stream(F.lds, (const char*)F.ws, S, E, R);
#else
                for (int rep = 0; rep < REPS(18); ++rep)
                { pg8::Gemm g{H, (const bf16_t*)(F.ws + WS_WGUD), D / 2, D / 2}; RowSched S{66, 22, F.G, F.bx, 256u * D, 256u * D}; EpiSwigluI8 E{(bf16_t*)(F.ws + WS_ACT), DFF0, (const float*)(F.ws + WS_RS), (const float*)(F.ws + WS_CSD)}; pg8::NoGather R;
                  pg8::gemm_phasei8(F.lds, g, S, E, R); }
                GRID_BAR();
                { EpiResid E{nullptr, XB, XB, xc, xc, mod_l, 5, (float*)(F.ws + WS_TMPC2)}; pg8::NoGather R;
                  { pg8::Gemm g{(const bf16_t*)(F.ws + WS_ACT), (const bf16_t*)(F.ws + WS_WDD), DFF0, DFF0}; GridSched S{64, 4, F.G, F.bx, 256u * DFF0 * 2u, 256u * DFF0 * 2u};
                    pg8::gemm_phase(F.lds, g, S, E, R); }
                  { pg8::Gemm g{(const bf16_t*)(F.ws + WS_ACT), (const bf16_t*)(F.ws + WS_WDD), DFF0 / 2, DFF0}; CtxSched S{F.G, F.bx, 4, 256u * DFF0 * 2u, 256u * DFF0 * 2u, 2, (unsigned)DFF0};
                    pg8::gemm_phase(F.lds, g, S, E, R); } }

#endif
            } else {
#if STREAM1
                FfnStream<8, true> S; { int bacc = 0;
#pragma unroll
                for (int e = 0; e < NE; ++e) { const int c = (int)ctl[CW_CNT + 64 * e]; S.cn[e] = c; S.P[e] = (c + 255) >> 8; S.rb[e] = bacc; bacc += ((c + 255) >> 8) << 8; } }
                S.nNgu = 28; S.Kdn = DFFE; S.need = 28u * 8u; S.q = ctl + CW_QUEUE + 64; S.lw = lw; S.rdy = ctl + CW_RDY + 64 * 80; S.tmo = ctl + 2; S.finish_init(F.G);
                EpiFfn<true> E{F.ws, F.out, mod_l}; FfnRows<true> R{(const int*)(F.ws + WS_LIST)};
                pg8::gemm_stream(F.lds, (const char*)F.ws, S, E, R);
#else
                for (int rep = 0; rep < REPS(19); ++rep)
                { pg8::Gemm g{H, (const bf16_t*)(F.ws + WS_WGUE), D / 2, D / 2}; MoeSched S; S.G = F.G; S.c = F.bx; S.nN = 28; S.ksplit = 1; S.trim = 0; S.khbytes = 0; S.bexp = 2u * DFFE * D; S.bbytes = 256u * D; S.arow_bytes = 0; S.a_slots = false; S.init(ctl + CW_CNT);
                  EpiSwiglu8 E{F.ws + WS_ACT, DFFE}; MoeRows R{(const int*)(F.ws + WS_LIST)};
                  pg8::gemm_phase8(F.lds, g, S, E, R); }
                GRID_BAR();
                { const int trim = moe_tail_panels(ctl + CW_CNT, F.G);
                  MoeSched S; S.G = F.G; S.c = F.bx; S.nN = 4; S.ksplit = 1; S.trim = trim; S.khbytes = 0; S.bexp = (unsigned)D * DFFE; S.bbytes = 256u * DFFE; S.arow_bytes = (unsigned)DFFE; S.a_slots = true; S.init(ctl + CW_CNT);
                  for (int rep = 0; rep < REPS(20); ++rep)
                  { pg8::Gemm g{(const bf16_t*)(F.ws + WS_ACT), (const bf16_t*)(F.ws + WS_WDE), DFFE / 2, DFFE / 2};
                    EpiBf16 E{(bf16_t*)(F.ws + WS_DOUT), (bf16_t*)(F.ws + WS_DOUT), D}; pg8::NoGather R;
                    pg8::gemm_phase8(F.lds, g, S, E, R); }
                  for (int rep = 0; rep < REPS(23); ++rep)
                  if (trim > 0) {
                    const int plast = (S.cnt[NE - 1] + 255) >> 8;
                    pg8::Gemm g{(const bf16_t*)(F.ws + WS_ACT), (const bf16_t*)(F.ws + WS_WDE), DFFE / 4, DFFE / 2};
                    MoeTailSched T{F.G, F.bx, trim, plast, S.base[NE - 1], (unsigned)D * DFFE};
                    EpiTail E{(bf16_t*)(F.ws + WS_DOUT), (bf16_t*)(F.ws + WS_DOUT1), S.base[NE - 1] + (plast - trim) * 256}; pg8::NoGather R;
                    pg8::gemm_phase8(F.lds, g, T, E, R); } }
#endif
            }
            SEAM(pb + 7);
        }
}

constexpr int NPHASE = 18;
__global__ void __launch_bounds__(NTHR, 2) fwd_kernel(Args args) {
    extern __shared__ __attribute__((aligned(16))) unsigned char lds_raw[];
    Frame F;
    F.lds = (LAS unsigned char*)lds_raw; F.ws = args.ws; F.in = args.in; F.out = args.out;
    F.tid = threadIdx.x; F.lane = F.tid & 63; F.wave = __builtin_amdgcn_readfirstlane(F.tid >> 6); F.G = gridDim.x; F.bx = blockIdx.x;
    volatile LAS unsigned* MISC = (volatile LAS unsigned*)(F.lds + MISC_OFF);
    if (F.tid < 32) MISC[F.tid] = 0u;
    __syncthreads();
    unsigned* ctl = (unsigned*)(F.ws + WS_CTL);
#if !MK_MULTI
    XcdBarrier bar = xcd_barrier_post(ctl + CW_BAR, MISC + 8);
#else
    XcdBarrier bar; bar.bar = ctl + CW_BAR; bar.x = 0; bar.st = MISC + 8;
#endif
    const int lo = args.ph_lo, hi = args.ph_hi;
    if (IN(0)) { for (int rep = 0; rep < REPS(0); ++rep) { p0_prologue(F); __syncthreads(); } SEAM(0); }
    layer_phases<0>(F, ctl, lo, hi, bar);
    layer_phases<1>(F, ctl, lo, hi, bar);
    if (IN(17)) for (int rep = 0; rep < REPS(17); ++rep) final_phase(F);
}

extern "C" void kernel_launch(void* const* d_in, const int* in_sizes, int n_in, void* d_out, int out_size, void* d_ws, size_t ws_size, hipStream_t stream) {
    static int grid = 0;
    if (grid == 0) {
        if (n_in != 21 || out_size != NL * D || ws_size < WS_END) { fprintf(stderr, "kernel_launch: unexpected problem (n_in %d out %d ws %zu)\n", n_in, out_size, ws_size); grid = -1; return; }
        int dev = 0, cus = 0;
        hipGetDevice(&dev); hipDeviceGetAttribute(&cus, hipDeviceAttributeMultiprocessorCount, dev);
        if (hipFuncSetAttribute((const void*)fwd_kernel, hipFuncAttributeMaxDynamicSharedMemorySize, LDS_BYTES) != hipSuccess) { fprintf(stderr, "kernel_launch: hipFuncSetAttribute failed\n"); grid = -1; return; }
        int per_cu = 0; (void)hipOccupancyMaxActiveBlocksPerMultiprocessor(&per_cu, (const void*)fwd_kernel, NTHR, LDS_BYTES); (void)hipGetLastError();
        grid = cus;
    }
    if (grid < 0) return;
    hipMemsetAsync((char*)d_ws + WS_CTL, 0, CTL_BYTES, stream);
#ifdef DBG_SCRUB
    hipMemsetAsync((char*)d_ws + CTL_BYTES, 0, WS_END - CTL_BYTES, stream);
#endif
    Args a{};
    for (int i = 0; i < 21; ++i) a.in[i] = (const float*)d_in[i];
    a.out = (float*)d_out; a.ws = (unsigned char*)d_ws;
#if MK_MULTI
    for (int p = 0; p < NPHASE; ++p) { a.ph_lo = p; a.ph_hi = p + 1; hipLaunchKernelGGL(fwd_kernel, dim3(grid), dim3(NTHR), LDS_BYTES, stream, a); }
#else
    a.ph_lo = 0; a.ph_hi = NPHASE;
    hipLaunchKernelGGL(fwd_kernel, dim3(grid), dim3(NTHR), LDS_BYTES, stream, a);
#endif
}
```

```cpp
#include <hip/hip_runtime.h>
#include <cstdio>
#include <cstdint>

#define LAS __attribute__((address_space(3)))
#define GAS __attribute__((address_space(1)))
typedef unsigned short bf16_t;
typedef short bf16x8 __attribute__((ext_vector_type(8)));
typedef short s16x4 __attribute__((ext_vector_type(4)));
typedef float f32x4 __attribute__((ext_vector_type(4)));
typedef float f32x2 __attribute__((ext_vector_type(2)));
typedef float f32x16 __attribute__((ext_vector_type(16)));
typedef unsigned u32x4 __attribute__((ext_vector_type(4)));
typedef unsigned u32x2 __attribute__((ext_vector_type(2)));

#ifndef MK_MULTI
#define MK_MULTI 0
#endif

constexpr int D = 1024, T = 8192, NB = 2, NL = NB * T, CTXL = 256, NC = NB * CTXL, NTOK = NL + NC;
constexpr int INW = 3328, OFFQ = 512, OFFK = 1024, OFFV = 1152, OFFG = 1280;
constexpr int DFF0 = 2816, DFFE = 3584, NE = 8;
constexpr int KM = 1152;
constexpr int MOE_ROWS = 2 * NL + NE * 256;
constexpr float EPS = 1e-6f;
constexpr float LOG2E = 1.4426950408889634f;
constexpr float QSCALE = 0.125f * LOG2E;

constexpr size_t MiB = 1u << 20, KiB = 1u << 10;
constexpr size_t WS_CTL = 0, CTL_BYTES = 1 * MiB;
constexpr size_t WS_ROPE = 1 * MiB, WS_TW = WS_ROPE + 32 * KiB, WS_FA64 = WS_ROPE + 96 * KiB, WS_TC = WS_ROPE + 160 * KiB, WS_TX = WS_ROPE + 288 * KiB;
constexpr size_t WS_H8 = 452 * MiB;
constexpr size_t WS_CSI = WS_ROPE + 936 * KiB;
constexpr size_t WS_RS = WS_ROPE + 832 * KiB, WS_CSD = WS_ROPE + 912 * KiB;
constexpr size_t WS_TOKE = 2 * MiB, WS_TOKR = WS_TOKE + 128 * KiB, WS_TOKW = WS_TOKE + 256 * KiB, WS_LIST = WS_TOKE + 384 * KiB;
constexpr size_t WS_XC = 3 * MiB, WS_VCT = 5 * MiB;
constexpr size_t WS_WIN0 = 6 * MiB, WS_WM0 = WS_WIN0 + 13 * MiB / 2, WS_WO0 = 17 * MiB, WS_WGUD = 19 * MiB, WS_WDD = 30 * MiB;
constexpr size_t WS_WIN1 = 36 * MiB, WS_WM1 = WS_WIN1 + 13 * MiB / 2, WS_WO1 = 47 * MiB;
constexpr size_t WS_H = 49 * MiB;
constexpr size_t WS_DOUT = 6 * MiB;
constexpr size_t WS_WGUE = 82 * MiB, WS_WDE = 194 * MiB;
constexpr size_t WS_DOUT1 = WS_WGUE;
constexpr size_t WS_R1 = 250 * MiB;
constexpr size_t WS_UP = WS_R1, WS_Q = 266 * MiB, WS_KB = 283 * MiB, WS_VB = 288 * MiB, WS_GF = 293 * MiB, WS_GA = 326 * MiB, WS_GP = 359 * MiB, WS_FO = 375 * MiB, WS_Y = 413 * MiB;
constexpr size_t WS_ACT = WS_R1;
constexpr size_t WS_TMPC1 = 446 * MiB, WS_TMPC2 = 448 * MiB;
constexpr size_t WS_XB = 490 * MiB;
constexpr size_t WS_END = 523 * MiB;
static_assert(WS_DOUT + (size_t)MOE_ROWS * D * 2 <= WS_WGUE, "DOUT overlay");
static_assert(WS_ACT + (size_t)MOE_ROWS * DFFE * 2 <= WS_END, "ACT");
static_assert(WS_FO + (size_t)NTOK * KM * 2 <= WS_Y, "FO");
constexpr int CW_BAR = 4096, CW_CNT = 8192, CW_MOD = 16384;
constexpr int MODSZ = 6 * D;

constexpr int RING_BYTES = 131072, MISC_OFF = RING_BYTES + 320, LDS_BYTES = 147456;
constexpr int NWAVES = 8, NTHR = 512;

__device__ __forceinline__ unsigned f2bf(float f) { unsigned u = __builtin_bit_cast(unsigned, f); return (u + 0x7fffu + ((u >> 16) & 1u)) >> 16; }
__device__ __forceinline__ unsigned pk2(float lo, float hi) { return f2bf(lo) | (f2bf(hi) << 16); }
__device__ __forceinline__ unsigned pk4f8(float a, float b, float c, float d) { int w = __builtin_amdgcn_cvt_pk_fp8_f32(a, b, 0, false); w = __builtin_amdgcn_cvt_pk_fp8_f32(c, d, w, true); return (unsigned)w; }
__device__ __forceinline__ unsigned cvt_pk_bf16(float lo, float hi) { unsigned r; asm volatile("v_cvt_pk_bf16_f32 %0, %1, %2" : "=v"(r) : "v"(lo), "v"(hi)); return r; }
__device__ __forceinline__ unsigned pk4i8(float a, float b, float c, float d, float sc) {
    const unsigned ua = __builtin_bit_cast(unsigned, fmaf(a, sc, 12582912.0f)), ub = __builtin_bit_cast(unsigned, fmaf(b, sc, 12582912.0f)), uc = __builtin_bit_cast(unsigned, fmaf(c, sc, 12582912.0f)), ud = __builtin_bit_cast(unsigned, fmaf(d, sc, 12582912.0f));
    return (ua & 0xffu) | ((ub & 0xffu) << 8) | ((uc & 0xffu) << 16) | (ud << 24); }
__device__ __forceinline__ float wave_max(float v) {
#pragma unroll
    for (int o = 1; o < 64; o <<= 1) v = fmaxf(v, __shfl_xor(v, o));
    return v;
}
__device__ __forceinline__ float bf2f(unsigned short h) { return __builtin_bit_cast(float, (unsigned)h << 16); }
__device__ __forceinline__ float bflo(unsigned w) { return __builtin_bit_cast(float, w << 16); }
__device__ __forceinline__ float bfhi(unsigned w) { return __builtin_bit_cast(float, w & 0xffff0000u); }
__device__ __forceinline__ float wave_sum(float v) {
#pragma unroll
    for (int o = 1; o < 64; o <<= 1) v += __shfl_xor(v, o);
    return v;
}
__device__ __forceinline__ float sigmoidf_(float x) { return __builtin_amdgcn_rcpf(1.0f + __builtin_amdgcn_exp2f(-x * LOG2E)); }
#define LDS_WAIT() asm volatile("s_waitcnt lgkmcnt(0)" ::: "memory")
#define VM_WAIT() asm volatile("s_waitcnt vmcnt(0)" ::: "memory")

#define XB_TMO      128
#define XB_XCNT(j)  (256  + 64 * (j))
#define XB_XSUB(j)  (1280 + 64 * (j))
#define XB_XGEN(j)  (2304 + 64 * (j))
#define XB_TOP      3328
#define XB_TOPGEN   3392
#define XCD_BAR_WORDS 3456
#define XB_SPIN_CAP (1u << 18)
__device__ __forceinline__ unsigned xb_ld(unsigned* p)              { return __hip_atomic_load(p, __ATOMIC_RELAXED, __HIP_MEMORY_SCOPE_AGENT); }
__device__ __forceinline__ unsigned xb_add(unsigned* p, unsigned v) { return __hip_atomic_fetch_add(p, v, __ATOMIC_RELAXED, __HIP_MEMORY_SCOPE_AGENT); }
__device__ __forceinline__ unsigned xb_xcc_id() { return (unsigned)__builtin_amdgcn_s_getreg((3 << 11) | 20) & 0xFu; }
#define XB_SPIN(cond, bar) do { unsigned _sp = 0; while (cond) { __builtin_amdgcn_s_sleep(1); \
    if ((++_sp & 255u) == 0u) { if (xb_ld(&(bar)[XB_TMO])) break; if (_sp > XB_SPIN_CAP) { atomicAdd(&(bar)[XB_TMO], 1u); break; } } } } while (0)
struct XcdBarrier { unsigned* bar; unsigned x; volatile LAS unsigned* st; };
__device__ __forceinline__ XcdBarrier xcd_barrier_post(unsigned* bar, volatile LAS unsigned* st) {
    XcdBarrier b; b.bar = bar; b.x = xb_xcc_id(); b.st = st;
    if (threadIdx.x == 0) (void)xb_add(&bar[XB_XCNT(b.x)], 1u);
    return b;
}
__device__ __forceinline__ void xcd_barrier_complete(unsigned* bar, unsigned x, unsigned& nloc, unsigned& nx) {
    const unsigned G = gridDim.x * gridDim.y * gridDim.z;
    unsigned sum, cnt, mine, sp = 0u;
    for (;;) {
        sum = 0u; cnt = 0u; mine = 0u;
#pragma unroll
        for (unsigned j = 0; j < 16; ++j) { const unsigned c = xb_ld(&bar[XB_XCNT(j)]); sum += c; cnt += (c > 0u) ? 1u : 0u; mine = (j == x) ? c : mine; }
        if (sum == G) break;
        __builtin_amdgcn_s_sleep(1);
        if ((++sp & 255u) == 0u) { if (xb_ld(&bar[XB_TMO])) break; if (sp > XB_SPIN_CAP) { atomicAdd(&bar[XB_TMO], 1u); break; } }
    }
    nloc = mine > 0u ? mine : 1u; nx = cnt > 0u ? cnt : 1u;
}
__device__ __forceinline__ void xcd_barrier(const XcdBarrier& b) {
    asm volatile("s_waitcnt vmcnt(0)" ::: "memory");
    __syncthreads();
    if (threadIdx.x == 0) {
        unsigned* bar = b.bar;
        __builtin_amdgcn_s_waitcnt(0);
        unsigned nloc = b.st[0], nx = b.st[1];
        if (nloc == 0u) { xcd_barrier_complete(bar, b.x, nloc, nx); b.st[0] = nloc; b.st[1] = nx; }
        const unsigned old = xb_add(&bar[XB_XSUB(b.x)], 1u);
        const unsigned gen = old / nloc;
        if (old + 1u == (gen + 1u) * nloc) {
            __builtin_amdgcn_fence(__ATOMIC_RELEASE, "agent");
            asm volatile("s_waitcnt vmcnt(0)" ::: "memory");
            const unsigned og = xb_add(&bar[XB_TOP], 1u);
            const unsigned tg = og / nx;
            if (og + 1u == (tg + 1u) * nx) xb_add(&bar[XB_TOPGEN], 1u);
            else XB_SPIN(xb_ld(&bar[XB_TOPGEN]) == tg, bar);
            __builtin_amdgcn_fence(__ATOMIC_ACQUIRE, "agent");
            xb_add(&bar[XB_XGEN(b.x)], 1u);
            asm volatile("s_waitcnt vmcnt(0)" ::: "memory");
        } else {
            XB_SPIN(xb_ld(&bar[XB_XGEN(b.x)]) == gen, bar);
            __builtin_amdgcn_fence(__ATOMIC_ACQUIRE, "agent");
            asm volatile("s_waitcnt vmcnt(0)" ::: "memory");
        }
    }
    __syncthreads();
}

#ifndef QGU
#define QGU 32
#endif
#ifndef QDN
#define QDN 64
#endif
#ifndef QACT
#define QACT 16
#endif
namespace pg8 {
constexpr int BM = 256, BK = 64, HALF = 128, HTB = HALF * BK * 2, STAGE_BYTES = 8 * HTB, NXCD = 8, WGM = 8;
__host__ __device__ __forceinline__ int lds_byte(int r, int c) { const int st = (r >> 4) * 2 + (c >> 5), rr = r & 15, cc = c & 31, ob = rr * 64 + cc * 2; return st * 1024 + (ob ^ (((ob >> 9) & 1) << 5)); }
__host__ __device__ __forceinline__ void stage_rc(int b, int& R, int& C) { const int st = b / 1024, sb = b % 1024, swz = sb ^ (((sb >> 9) & 1) << 5); R = (st >> 1) * 16 + swz / 64; C = (st & 1) * 32 + (swz % 64) / 2; }
__host__ __device__ __forceinline__ int perm32(int rho) { const int n = rho >> 4, i = rho & 15; return 8 * (i >> 2) + 4 * n + (i & 3); }

typedef int i32x8 __attribute__((ext_vector_type(8)));
typedef int i32x4 __attribute__((ext_vector_type(4)));
__device__ __forceinline__ i32x8 cat8(bf16x8 a, bf16x8 b) { return __builtin_shufflevector(__builtin_bit_cast(i32x4, a), __builtin_bit_cast(i32x4, b), 0, 1, 2, 3, 4, 5, 6, 7); }
struct Unit { unsigned aoff, boff; int pm, pn, kind, x0, x1, kh; };
struct Gemm { const bf16_t* A; const bf16_t* Bt; int K; int ld; };

__device__ __forceinline__ void swz_map(int L, int nM, int nN, int& pm, int& pn) {
    const int nwg = nM * nN; int wgid = L;
    { const int q = nwg / NXCD, r = nwg % NXCD, xcd = wgid % NXCD, off = wgid / NXCD; wgid = (xcd < r ? xcd * (q + 1) : r * (q + 1) + (xcd - r) * q) + off; }
    const int nig = WGM * nN, gid = wgid / nig, fm = gid * WGM, gsz = (nM - fm) < WGM ? (nM - fm) : WGM;
    pm = fm + ((wgid % nig) % gsz); pn = (wgid % nig) / gsz;
}

struct NoGather { static constexpr bool GA = false, GB = false;
    __device__ __forceinline__ unsigned arow(const Unit&, int) const { return 0u; }
    __device__ __forceinline__ unsigned brow(const Unit&, int) const { return 0u; } };

template <int F8, class Epi, class Sched, class Rows>
__device__ __forceinline__ void gemm_phase_t(LAS unsigned char* lds, const Gemm g, const Sched& S, const Epi& E, const Rows& RW) {
    int tid_ = threadIdx.x; asm volatile("" : "+v"(tid_));
    const int tid = tid_, wid = __builtin_amdgcn_readfirstlane(tid >> 6), lane = tid & 63, wr = wid >> 2, wc = wid & 3, fr = lane & 15, fq = lane >> 4;
    int K_ = g.K; asm volatile("" : "+s"(K_));
    const int K = K_, nt = K / BK;
    int sR[2], sRb[2], sC[2];
#pragma unroll
    for (int i = 0; i < 2; ++i) { int R, C; stage_rc(tid * 16 + i * 8192, R, C); sR[i] = R; sC[i] = C; sRb[i] = (R & ~31) + perm32(R & 31); }
    unsigned voffA[2], voffB[2];
    const int LD = g.ld;
#pragma unroll
    for (int i = 0; i < 2; ++i) { voffA[i] = (unsigned)(sR[i] * LD + sC[i]) * 2u; voffB[i] = (unsigned)(sRb[i] * LD + sC[i]) * 2u; }
    const size_t kstep = (size_t)(BK * 2);
    const size_t hstep = (size_t)HALF * LD * 2;
    const unsigned ldsw = (unsigned)wid * 1024u;
    const int aoff = lds_byte(wr * 64 + fr, fq * 8), boff = lds_byte(wc * 32 + fr, fq * 8);
    constexpr int NTHR_ = 512;
    LAS unsigned* stash = (LAS unsigned*)(lds + 131072 + 320 + 1024) + tid;
    struct Side { const char* base[2]; unsigned off[2][2]; };
#define PG8_SA(b, h) (((b) * 2 + (h)) * HTB)
#define PG8_SB(b, h) ((4 + (b) * 2 + (h)) * HTB)
#define PG8_STAGE(bufoff, side, h, kt) do { _Pragma("unroll") for (int _i = 0; _i < 2; ++_i) { unsigned _o = (side).off[h][_i]; asm volatile("" : "+v"(_o)); \
        __builtin_amdgcn_global_load_lds((const unsigned*)((side).base[h] + (size_t)(kt) * kstep + _o), (LAS unsigned*)(lds + (bufoff) + ldsw + _i * 8192), 16, 0, 0); } } while (0)
#define PG8_LDA(dst, b, h) do { _Pragma("unroll") for (int m = 0; m < 4; ++m) _Pragma("unroll") for (int k = 0; k < 2; ++k) dst[m][k] = *(const LAS bf16x8*)(lds + PG8_SA(b, h) + aoff + m * 2048 + k * 1024); } while (0)
#define PG8_LDB(dst, b, h) do { _Pragma("unroll") for (int n = 0; n < 2; ++n) _Pragma("unroll") for (int k = 0; k < 2; ++k) dst[n][k] = *(const LAS bf16x8*)(lds + PG8_SB(b, h) + boff + n * 2048 + k * 1024); } while (0)
#define PG8_MMA(ai, bj, At, Bt) do { __builtin_amdgcn_s_setprio(1); _Pragma("unroll") for (int m = 0; m < 4; ++m) _Pragma("unroll") for (int n = 0; n < 2; ++n) { \
        if constexpr (F8 == 1) acc[ai][bj][m][n] = __builtin_amdgcn_mfma_scale_f32_16x16x128_f8f6f4(cat8(Bt[n][0], Bt[n][1]), cat8(At[m][0], At[m][1]), acc[ai][bj][m][n], 0, 0, 0, 0, 0, 0); \
        else if constexpr (F8 == 2) { _Pragma("unroll") for (int k = 0; k < 2; ++k) acc[ai][bj][m][n] = __builtin_bit_cast(f32x4, __builtin_amdgcn_mfma_i32_16x16x64_i8(__builtin_bit_cast(i32x4, Bt[n][k]), __builtin_bit_cast(i32x4, At[m][k]), __builtin_bit_cast(i32x4, acc[ai][bj][m][n]), 0, 0, 0)); } \
        else { _Pragma("unroll") for (int k = 0; k < 2; ++k) acc[ai][bj][m][n] = __builtin_amdgcn_mfma_f32_16x16x32_bf16(Bt[n][k], At[m][k], acc[ai][bj][m][n], 0, 0, 0); } } __builtin_amdgcn_s_setprio(0); } while (0)
#define PG8_WAIT_V(n) asm volatile("s_waitcnt vmcnt(" #n ")" ::: "memory")
#define PG8_WAIT_L(n) asm volatile("s_waitcnt lgkmcnt(" #n ")" ::: "memory")
#define PG8_BAR __builtin_amdgcn_s_barrier()
#define PG8_SCHED __builtin_amdgcn_sched_barrier(0)
#define PG8_MKSIDES(u, sa, sb) do { \
        if constexpr (Rows::GA) { sa.base[0] = sa.base[1] = (const char*)g.A; int t2_ = tid; asm volatile("" : "+v"(t2_)); _Pragma("unroll") for (int i = 0; i < 2; ++i) { int R_, C_; stage_rc(t2_ * 16 + i * 8192, R_, C_); \
            _Pragma("unroll") for (int h = 0; h < 2; ++h) sa.off[h][i] = RW.arow(u, h * HALF + R_) + (unsigned)C_ * 2u; } } \
        else { sa.base[0] = (const char*)g.A + (u).aoff; sa.base[1] = sa.base[0] + hstep; _Pragma("unroll") for (int h = 0; h < 2; ++h) _Pragma("unroll") for (int i = 0; i < 2; ++i) sa.off[h][i] = voffA[i]; } \
        if constexpr (Rows::GB) { sb.base[0] = sb.base[1] = (const char*)g.Bt; _Pragma("unroll") for (int h = 0; h < 2; ++h) _Pragma("unroll") for (int i = 0; i < 2; ++i) sb.off[h][i] = RW.brow(u, h * HALF + sRb[i]) + (unsigned)sC[i] * 2u; } \
        else { sb.base[0] = (const char*)g.Bt + (u).boff; sb.base[1] = sb.base[0] + hstep; _Pragma("unroll") for (int h = 0; h < 2; ++h) _Pragma("unroll") for (int i = 0; i < 2; ++i) sb.off[h][i] = voffB[i]; } } while (0)
    Unit cur, nxt; int ui = 0;
    if (!S.next(0, cur)) return;
    f32x4 acc[2][2][4][2];
#pragma unroll
    for (int a = 0; a < 2; ++a)
#pragma unroll
        for (int b = 0; b < 2; ++b)
#pragma unroll
            for (int m = 0; m < 4; ++m)
#pragma unroll
                for (int n = 0; n < 2; ++n) acc[a][b][m][n] = (f32x4){0.f, 0.f, 0.f, 0.f};
    bf16x8 At[4][2], B0[2][2], B1[2][2];
    Side cA, cB, nA, nB;
    PG8_MKSIDES(cur, cA, cB);
    PG8_STAGE(PG8_SB(0, 0), cB, 0, 0); PG8_STAGE(PG8_SB(0, 1), cB, 1, 0); PG8_STAGE(PG8_SA(0, 0), cA, 0, 0); PG8_STAGE(PG8_SA(0, 1), cA, 1, 0);
    if (wr == 1) PG8_BAR;
    PG8_WAIT_V(2); PG8_BAR;
    PG8_STAGE(PG8_SB(1, 0), cB, 0, 1); PG8_STAGE(PG8_SA(1, 0), cA, 0, 1); PG8_STAGE(PG8_SB(1, 1), cB, 1, 1);
    PG8_WAIT_V(6); PG8_BAR;
    for (;;) {
        const bool has_next = S.next(ui + 1, nxt);
        if (has_next) { PG8_MKSIDES(nxt, nA, nB); } else { nA = cA; nB = cB; }
        if constexpr (Rows::GA) {
#pragma unroll
            for (int h = 0; h < 2; ++h)
#pragma unroll
                for (int i = 0; i < 2; ++i) stash[(h * 2 + i) * NTHR_] = nA.off[h][i]; }
        for (int t = 0; t < nt; t += 2) {
            const bool last = (t == nt - 2);
            if constexpr (Epi::MIDK > 0) { if (t == Epi::MIDK) E.mid(acc, cur, wr, wc, fr, fq); }
            Side a2, b2;
            a2.base[0] = last ? nA.base[0] : cA.base[0]; a2.base[1] = last ? nA.base[1] : cA.base[1];
            b2.base[0] = last ? nB.base[0] : cB.base[0]; b2.base[1] = last ? nB.base[1] : cB.base[1];
#pragma unroll
            for (int h = 0; h < 2; ++h)
#pragma unroll
                for (int i = 0; i < 2; ++i) { if constexpr (!Rows::GA) a2.off[h][i] = cA.off[h][i]; b2.off[h][i] = (Rows::GB && last) ? nB.off[h][i] : cB.off[h][i]; }
            const int k2 = last ? 0 : t + 2, k3 = k2 + 1;
            PG8_LDB(B0, 0, 0); PG8_LDB(B1, 0, 1); PG8_SCHED; PG8_LDA(At, 0, 0); PG8_STAGE(PG8_SA(1, 1), cA, 1, t + 1);
            if constexpr (Rows::GA) {
                if (last) {
#pragma unroll
                    for (int h = 0; h < 2; ++h)
#pragma unroll
                        for (int i = 0; i < 2; ++i) cA.off[h][i] = stash[(h * 2 + i) * NTHR_]; }
#pragma unroll
                for (int h = 0; h < 2; ++h)
#pragma unroll
                    for (int i = 0; i < 2; ++i) a2.off[h][i] = cA.off[h][i]; }
            PG8_WAIT_V(8); PG8_WAIT_L(0); PG8_BAR; PG8_MMA(0, 0, At, B0); PG8_MMA(0, 1, At, B1); PG8_BAR; PG8_SCHED;
            PG8_LDA(At, 0, 1); PG8_STAGE(PG8_SB(0, 0), b2, 0, k2); PG8_STAGE(PG8_SB(0, 1), b2, 1, k2); PG8_STAGE(PG8_SA(0, 0), a2, 0, k2);
            PG8_WAIT_V(8); PG8_WAIT_L(0); PG8_BAR; PG8_MMA(1, 0, At, B0); PG8_MMA(1, 1, At, B1); PG8_BAR; PG8_SCHED;
            PG8_LDB(B0, 1, 0); PG8_LDB(B1, 1, 1); PG8_SCHED; PG8_LDA(At, 1, 0); PG8_STAGE(PG8_SA(0, 1), a2, 1, k2);
            PG8_WAIT_V(8); PG8_WAIT_L(0); PG8_BAR; PG8_MMA(0, 0, At, B0); PG8_MMA(0, 1, At, B1); PG8_BAR; PG8_SCHED;
            PG8_LDA(At, 1, 1); PG8_STAGE(PG8_SB(1, 0), b2, 0, k3); PG8_STAGE(PG8_SB(1, 1), b2, 1, k3); PG8_STAGE(PG8_SA(1, 0), a2, 0, k3);
            PG8_WAIT_V(8); PG8_WAIT_L(0); PG8_BAR; PG8_MMA(1, 0, At, B0); PG8_MMA(1, 1, At, B1); PG8_BAR; PG8_SCHED;
        }
        if (wr == 0) PG8_BAR;
        E(acc, cur, wr, wc, fr, fq);
        if (!has_next) break;
#pragma unroll
        for (int a = 0; a < 2; ++a)
#pragma unroll
            for (int b = 0; b < 2; ++b)
#pragma unroll
                for (int m = 0; m < 4; ++m)
#pragma unroll
                    for (int n = 0; n < 2; ++n) acc[a][b][m][n] = (f32x4){0.f, 0.f, 0.f, 0.f};
        cur = nxt; if constexpr (Rows::GA) { cA.base[0] = nA.base[0]; cA.base[1] = nA.base[1]; } else cA = nA; cB = nB; ++ui;
        if (wr == 1) PG8_BAR;
    }
    PG8_WAIT_V(0);
    PG8_BAR;
#undef PG8_SA
#undef PG8_SB
#undef PG8_STAGE
#undef PG8_LDA
#undef PG8_LDB
#undef PG8_MMA
#undef PG8_WAIT_V
#undef PG8_WAIT_L
#undef PG8_BAR
#undef PG8_SCHED
#undef PG8_MKSIDES
}

template <class Epi, class Sched, class Rows>
__device__ __forceinline__ void gemm_phase(LAS unsigned char* lds, const Gemm g, const Sched& S, const Epi& E, const Rows& RW) { gemm_phase_t<0>(lds, g, S, E, RW); }
template <class Epi, class Sched, class Rows>
__device__ __forceinline__ void gemm_phase8(LAS unsigned char* lds, const Gemm g, const Sched& S, const Epi& E, const Rows& RW) { gemm_phase_t<1>(lds, g, S, E, RW); }
template <class Epi, class Sched, class Rows>
__device__ __forceinline__ void gemm_phasei8(LAS unsigned char* lds, const Gemm g, const Sched& S, const Epi& E, const Rows& RW) { gemm_phase_t<2>(lds, g, S, E, RW); }

struct SUnit { unsigned aoff, boff; int K; int pm, pn, kind, x0, x1, grp, dep, sig; };
__device__ __forceinline__ void st16_wt(unsigned char* wsbase, unsigned off, u32x4 v) {
    const __amdgpu_buffer_rsrc_t rsrc = __builtin_amdgcn_make_buffer_rsrc((void*)wsbase, 0, 0x7fffffff, 0x00020000);
    __builtin_amdgcn_raw_buffer_store_b128(v, rsrc, off, 0, 16); }

template <class Epi, class Sched, class Rows>
__device__ __forceinline__ void gemm_stream(LAS unsigned char* lds, const char* base, const Sched& S, const Epi& E, const Rows& RW) {
    int tid_ = threadIdx.x; asm volatile("" : "+v"(tid_));
    const int tid = tid_, wid = __builtin_amdgcn_readfirstlane(tid >> 6), lane = tid & 63, wr = wid >> 2, wc = wid & 3, fr = lane & 15, fq = lane >> 4;
    int sR[2], sRb[2], sC[2];
#pragma unroll
    for (int i = 0; i < 2; ++i) { int R, C; stage_rc(tid * 16 + i * 8192, R, C); sR[i] = R; sC[i] = C; sRb[i] = (R & ~31) + perm32(R & 31); }
    const size_t kstep = (size_t)(BK * 2);
    const unsigned ldsw = (unsigned)wid * 1024u;
    const int aoff = lds_byte(wr * 64 + fr, fq * 8), boff = lds_byte(wc * 32 + fr, fq * 8);
    struct Side { const char* base[2]; unsigned off[2][2]; };
#define PG8_SA(b, h) (((b) * 2 + (h)) * HTB)
#define PG8_SB(b, h) ((4 + (b) * 2 + (h)) * HTB)
#define PG8_STAGE(bufoff, side, h, kt) do { _Pragma("unroll") for (int _i = 0; _i < 2; ++_i) \
        __builtin_amdgcn_global_load_lds((const unsigned*)((side).base[h] + (size_t)(kt) * kstep + (side).off[h][_i]), (LAS unsigned*)(lds + (bufoff) + ldsw + _i * 8192), 16, 0, 0); } while (0)
#define PG8_LDA(dst, b, h) do { _Pragma("unroll") for (int m = 0; m < 4; ++m) _Pragma("unroll") for (int k = 0; k < 2; ++k) dst[m][k] = *(const LAS bf16x8*)(lds + PG8_SA(b, h) + aoff + m * 2048 + k * 1024); } while (0)
#define PG8_LDB(dst, b, h) do { _Pragma("unroll") for (int n = 0; n < 2; ++n) _Pragma("unroll") for (int k = 0; k < 2; ++k) dst[n][k] = *(const LAS bf16x8*)(lds + PG8_SB(b, h) + boff + n * 2048 + k * 1024); } while (0)
#define PG8_MMA(ai, bj, At, Bt) do { __builtin_amdgcn_s_setprio(1); _Pragma("unroll") for (int m = 0; m < 4; ++m) _Pragma("unroll") for (int n = 0; n < 2; ++n) _Pragma("unroll") for (int k = 0; k < 2; ++k) \
        acc[ai][bj][m][n] = __builtin_amdgcn_mfma_f32_16x16x32_bf16(Bt[n][k], At[m][k], acc[ai][bj][m][n], 0, 0, 0); __builtin_amdgcn_s_setprio(0); } while (0)
#define PG8_WAIT_V(n) asm volatile("s_waitcnt vmcnt(" #n ")" ::: "memory")
#define PG8_WAIT_L(n) asm volatile("s_waitcnt lgkmcnt(" #n ")" ::: "memory")
#define PG8_BAR __builtin_amdgcn_s_barrier()
#define PG8_SCHED __builtin_amdgcn_sched_barrier(0)
#define PG8_MKSIDES(un, sa, sb) do { const int K_ = (un).K; \
        if (RW.a_gather(un)) { sa.base[0] = sa.base[1] = base; _Pragma("unroll") for (int h = 0; h < 2; ++h) _Pragma("unroll") for (int i = 0; i < 2; ++i) sa.off[h][i] = RW.arow(un, h * HALF + sR[i]) + (unsigned)sC[i] * 2u; } \
        else { sa.base[0] = base + (un).aoff; sa.base[1] = sa.base[0] + (size_t)HALF * K_ * 2; _Pragma("unroll") for (int h = 0; h < 2; ++h) _Pragma("unroll") for (int i = 0; i < 2; ++i) sa.off[h][i] = (unsigned)(sR[i] * K_ + sC[i]) * 2u; } \
        sb.base[0] = base + (un).boff; sb.base[1] = sb.base[0] + (size_t)HALF * K_ * 2; _Pragma("unroll") for (int h = 0; h < 2; ++h) _Pragma("unroll") for (int i = 0; i < 2; ++i) sb.off[h][i] = (unsigned)(sRb[i] * K_ + sC[i]) * 2u; } while (0)
#define PG8_SIGNAL(idx) do { if (lane == 0) __hip_atomic_fetch_add(S.rdy + 64 * (idx), 1u, __ATOMIC_RELAXED, __HIP_MEMORY_SCOPE_AGENT); } while (0)
    SUnit cur, nxt;
    unsigned pend = 0u;
    const unsigned lw_addr = (unsigned)(size_t)S.lw;
    if (tid == 0) { S.lw[0] = __hip_atomic_fetch_add(S.q, 1u, __ATOMIC_RELAXED, __HIP_MEMORY_SCOPE_AGENT); pend = __hip_atomic_fetch_add(S.q, 1u, __ATOMIC_RELAXED, __HIP_MEMORY_SCOPE_AGENT); }
    __syncthreads();
    { const int L0 = __builtin_amdgcn_readfirstlane((int)S.lw[0]); if (!S.decode(L0, cur)) return; }
    f32x4 acc[2][2][4][2];
#pragma unroll
    for (int a = 0; a < 2; ++a)
#pragma unroll
        for (int b = 0; b < 2; ++b)
#pragma unroll
            for (int m = 0; m < 4; ++m)
#pragma unroll
                for (int n = 0; n < 2; ++n) acc[a][b][m][n] = (f32x4){0.f, 0.f, 0.f, 0.f};
    bf16x8 At[4][2], B0[2][2], B1[2][2];
    Side cA, cB, nA, nB;
    bool need_pro = true; int sig_idx = -1;
    PG8_MKSIDES(cur, cA, cB);
    for (;;) {
        if (need_pro) {
            if (cur.dep >= 0) S.a_ready(cur);
            PG8_STAGE(PG8_SB(0, 0), cB, 0, 0); PG8_STAGE(PG8_SB(0, 1), cB, 1, 0); PG8_STAGE(PG8_SA(0, 0), cA, 0, 0); PG8_STAGE(PG8_SA(0, 1), cA, 1, 0);
            if (wr == 1) PG8_BAR;
            PG8_WAIT_V(2); PG8_BAR;
            PG8_STAGE(PG8_SB(1, 0), cB, 0, 1); PG8_STAGE(PG8_SA(1, 0), cA, 0, 1); PG8_STAGE(PG8_SB(1, 1), cB, 1, 1);
            PG8_WAIT_V(6); PG8_BAR;
        }
        if (tid == 0) { asm volatile("s_nop 7\n\tds_write_b32 %1, %0\n\tglobal_atomic_add %0, %2, %3, %4 sc0" : "+v"(pend) : "v"(lw_addr), "v"(0u), "v"(1u), "s"(S.q) : "memory"); }
        PG8_WAIT_L(0); PG8_BAR; asm volatile("" ::: "memory");
        const int Ln = __builtin_amdgcn_readfirstlane((int)S.lw[0]);
        const bool has_next = S.decode(Ln, nxt), pre = has_next && nxt.dep < 0;
        if (pre) { PG8_MKSIDES(nxt, nA, nB); } else { nA = cA; nB = cB; }
        const int nt = cur.K / BK;
        for (int t = 0; t < nt; t += 2) {
            const bool last = (t == nt - 2);
            Side a2, b2;
            a2.base[0] = last ? nA.base[0] : cA.base[0]; a2.base[1] = last ? nA.base[1] : cA.base[1];
            b2.base[0] = last ? nB.base[0] : cB.base[0]; b2.base[1] = last ? nB.base[1] : cB.base[1];
#pragma unroll
            for (int h = 0; h < 2; ++h)
#pragma unroll
                for (int i = 0; i < 2; ++i) { a2.off[h][i] = last ? nA.off[h][i] : cA.off[h][i]; b2.off[h][i] = last ? nB.off[h][i] : cB.off[h][i]; }
            const int k2 = last ? 0 : t + 2, k3 = k2 + 1;
            if (t == 2 && sig_idx >= 0) { PG8_SIGNAL(sig_idx); sig_idx = -1; }
            PG8_LDB(B0, 0, 0); PG8_LDB(B1, 0, 1); PG8_SCHED; PG8_LDA(At, 0, 0); PG8_STAGE(PG8_SA(1, 1), cA, 1, t + 1);
            PG8_WAIT_V(8); PG8_WAIT_L(0); PG8_BAR; PG8_MMA(0, 0, At, B0); PG8_MMA(0, 1, At, B1); PG8_BAR; PG8_SCHED;
            PG8_LDA(At, 0, 1); PG8_STAGE(PG8_SB(0, 0), b2, 0, k2); PG8_STAGE(PG8_SB(0, 1), b2, 1, k2); PG8_STAGE(PG8_SA(0, 0), a2, 0, k2);
            PG8_WAIT_V(8); PG8_WAIT_L(0); PG8_BAR; PG8_MMA(1, 0, At, B0); PG8_MMA(1, 1, At, B1); PG8_BAR; PG8_SCHED;
            PG8_LDB(B0, 1, 0); PG8_LDB(B1, 1, 1); PG8_SCHED; PG8_LDA(At, 1, 0); PG8_STAGE(PG8_SA(0, 1), a2, 1, k2);
            PG8_WAIT_V(8); PG8_WAIT_L(0); PG8_BAR; PG8_MMA(0, 0, At, B0); PG8_MMA(0, 1, At, B1); PG8_BAR; PG8_SCHED;
            PG8_LDA(At, 1, 1); PG8_STAGE(PG8_SB(1, 0), b2, 0, k3); PG8_STAGE(PG8_SB(1, 1), b2, 1, k3); PG8_STAGE(PG8_SA(1, 0), a2, 0, k3);
            PG8_WAIT_V(8); PG8_WAIT_L(0); PG8_BAR; PG8_MMA(1, 0, At, B0); PG8_MMA(1, 1, At, B1); PG8_BAR; PG8_SCHED;
        }
        if (wr == 0) PG8_BAR;
        E(acc, cur, wr, wc, fr, fq);
        if (!has_next) { PG8_WAIT_V(0); if (cur.sig >= 0) PG8_SIGNAL(cur.sig); break; }
#pragma unroll
        for (int a = 0; a < 2; ++a)
#pragma unroll
            for (int b = 0; b < 2; ++b)
#pragma unroll
                for (int m = 0; m < 4; ++m)
#pragma unroll
                    for (int n = 0; n < 2; ++n) acc[a][b][m][n] = (f32x4){0.f, 0.f, 0.f, 0.f};
        if (pre) {
            sig_idx = cur.sig; need_pro = false; cur = nxt; cA = nA; cB = nB;
            if (wr == 1) PG8_BAR;
        } else {
            PG8_WAIT_V(0); if (cur.sig >= 0) PG8_SIGNAL(cur.sig);
            PG8_BAR; need_pro = true; cur = nxt; PG8_MKSIDES(cur, cA, cB);
        }
    }
    PG8_BAR;
#undef PG8_SA
#undef PG8_SB
#undef PG8_STAGE
#undef PG8_LDA
#undef PG8_LDB
#undef PG8_MMA
#undef PG8_WAIT_V
#undef PG8_WAIT_L
#undef PG8_BAR
#undef PG8_SCHED
#undef PG8_MKSIDES
#undef PG8_SIGNAL
}
}
using pg8::Unit;
using pg8::SUnit;

struct Args { const float* in[21]; float* out; unsigned char* ws; int ph_lo, ph_hi; };

struct Frame {
    LAS unsigned char* lds;
    unsigned char* ws;
    const float* const* in;
    float* out;
    int tid, lane, wave, G, bx;
};
__device__ __forceinline__ float* modp(const Frame& F, int l, int v) { return (float*)(F.ws + WS_CTL) + CW_MOD + (l * 3 + v) * MODSZ; }

__device__ __forceinline__ void p0_transpose_item(const float* W, int ldw, int k0, int c0, bf16_t* WT, int ldt, int drow, int lane) {
    const float* src = W + (size_t)k0 * ldw + c0 + lane;
    float v[64];
#pragma unroll
    for (int i = 0; i < 64; ++i) { v[i] = src[(size_t)i * ldw]; }
    bf16_t* dst = WT + (size_t)drow * ldt + k0;
#pragma unroll
    for (int j = 0; j < 8; ++j) { u32x4 o; o.x = pk2(v[8 * j], v[8 * j + 1]); o.y = pk2(v[8 * j + 2], v[8 * j + 3]); o.z = pk2(v[8 * j + 4], v[8 * j + 5]); o.w = pk2(v[8 * j + 6], v[8 * j + 7]);
        *(u32x4*)(dst + 8 * j) = o; }
}
template <int QS>
__device__ __forceinline__ void p0_transpose_item8(const float* W, int ldw, int k0, int c0, unsigned char* WT, int ldt, int drow, int lane) {
    const float* src = W + (size_t)k0 * ldw + c0 + lane;
    float v[64];
#pragma unroll
    for (int i = 0; i < 64; ++i) v[i] = src[(size_t)i * ldw] * (float)QS;
    unsigned char* dst = WT + (size_t)drow * ldt + k0;
#pragma unroll
    for (int j = 0; j < 4; ++j) { u32x4 o; o.x = pk4f8(v[16 * j], v[16 * j + 1], v[16 * j + 2], v[16 * j + 3]); o.y = pk4f8(v[16 * j + 4], v[16 * j + 5], v[16 * j + 6], v[16 * j + 7]);
        o.z = pk4f8(v[16 * j + 8], v[16 * j + 9], v[16 * j + 10], v[16 * j + 11]); o.w = pk4f8(v[16 * j + 12], v[16 * j + 13], v[16 * j + 14], v[16 * j + 15]);
        *(u32x4*)(dst + 16 * j) = o; }
}

constexpr int CW_CONVQ = 12288 + 128;
constexpr int MOE_I_GE = 16 * 56, MOE_I_DE = 56 * 16, MOE_ITEMS = NE * (2 * MOE_I_GE + MOE_I_DE), MOE_BATCHES = MOE_ITEMS / 8;
__device__ __forceinline__ void moe_convert_batch(Frame& F, int which, int idx) {
    const float* const* in = F.in; const int ln = F.lane;
    int r = idx * 8 + F.wave;
    if (which == 0) { const int e = r / (2 * MOE_I_GE); r %= (2 * MOE_I_GE); const int up = r / MOE_I_GE; r %= MOE_I_GE; const int kb = r / 56, nb = r % 56, c0 = 64 * nb;
        p0_transpose_item8<QGU>(in[up ? 18 : 17] + (size_t)e * D * DFFE, DFFE, 64 * kb, c0, F.ws + WS_WGUE + (size_t)e * 2 * DFFE * D, D, (c0 >> 7) * 256 + up * 128 + (c0 & 127) + ln, ln); }
    else { const int e = r / MOE_I_DE; r %= MOE_I_DE; const int kb = r / 16, nb = r % 16;
        p0_transpose_item8<QDN>(in[19] + (size_t)e * DFFE * D, D, 64 * kb, 64 * nb, F.ws + WS_WDE + (size_t)e * D * DFFE, DFFE, 64 * nb + ln, ln); }
}
__device__ __forceinline__ void moe_convert(Frame& F, int which, int rep = 0) {
    volatile LAS unsigned* lw = (volatile LAS unsigned*)(F.lds + MISC_OFF) + 20;
    unsigned* q = (unsigned*)(F.ws + WS_CTL) + CW_CONVQ + 64 * which + 128 * rep;
    const int nb = which == 0 ? NE * 2 * MOE_I_GE / 8 : NE * MOE_I_DE / 8;
    for (;;) {
        __syncthreads();
        if (F.tid == 0) lw[0] = __hip_atomic_fetch_add(q, 1u, __ATOMIC_RELAXED, __HIP_MEMORY_SCOPE_AGENT);
        __syncthreads();
        const int idx = (int)lw[0];
        if (idx >= nb) break;
        moe_convert_batch(F, which, idx);
    }
    __syncthreads();
}

constexpr int MOE_P_GU = NE * 2 * 8 * 56, MOE_P_DN = NE * 28 * 16, MOE_PAIRS = MOE_P_GU + MOE_P_DN;
struct CvtItem { const float* src; unsigned char* dst; int ldw; float qs; };
__device__ __forceinline__ CvtItem moe_item(const Frame& F, int P, int half, int ln) {
    const float* const* in = F.in; CvtItem it;
    if (P < MOE_P_GU) { int r = P; const int e = r / (2 * 8 * 56); r %= (2 * 8 * 56); const int up = r / (8 * 56); r %= (8 * 56); const int kb = 2 * (r / 56) + half, nb = r % 56, c0 = 64 * nb;
        it.src = in[up ? 18 : 17] + (size_t)e * D * DFFE + (size_t)(64 * kb) * DFFE + c0 + ln; it.ldw = DFFE; it.qs = (float)QGU;
        it.dst = F.ws + WS_WGUE + (size_t)e * 2 * DFFE * D + (size_t)((c0 >> 7) * 256 + up * 128 + (c0 & 127) + ln) * D + 64 * kb; }
    else { int r = P - MOE_P_GU; const int e = r / (28 * 16); r %= (28 * 16); const int kb = 2 * (r / 16) + half, nb = r % 16;
        it.src = in[19] + (size_t)e * DFFE * D + (size_t)(64 * kb) * D + 64 * nb + ln; it.ldw = D; it.qs = (float)QDN;
        it.dst = F.ws + WS_WDE + (size_t)e * D * DFFE + (size_t)(64 * nb + ln) * DFFE + 64 * kb; }
    return it;
}
#define CVT_LOAD(v, it) do { _Pragma("unroll") for (int i_ = 0; i_ < 64; ++i_) v[i_] = (it).src[(size_t)i_ * (it).ldw]; } while (0)
#define CVT_STORE(v, it) do { _Pragma("unroll") for (int j_ = 0; j_ < 4; ++j_) { u32x4 o_; const float q_ = (it).qs; \
        o_.x = pk4f8(v[16 * j_] * q_, v[16 * j_ + 1] * q_, v[16 * j_ + 2] * q_, v[16 * j_ + 3] * q_); o_.y = pk4f8(v[16 * j_ + 4] * q_, v[16 * j_ + 5] * q_, v[16 * j_ + 6] * q_, v[16 * j_ + 7] * q_); \
        o_.z = pk4f8(v[16 * j_ + 8] * q_, v[16 * j_ + 9] * q_, v[16 * j_ + 10] * q_, v[16 * j_ + 11] * q_); o_.w = pk4f8(v[16 * j_ + 12] * q_, v[16 * j_ + 13] * q_, v[16 * j_ + 14] * q_, v[16 * j_ + 15] * q_); \
        *(u32x4*)((it).dst + 16 * j_) = o_; } } while (0)
__device__ __forceinline__ void moe_convert_all(Frame& F) {
    int t_ = threadIdx.x; asm volatile("" : "+v"(t_)); const int ln = t_ & 63;
    const int gw = F.bx * NWAVES + F.wave, NGW = F.G * NWAVES;
    float va[64], vb[64];
    int P = gw;
    CvtItem ia, ib;
    if (P < MOE_PAIRS) { ia = moe_item(F, P, 0, ln); CVT_LOAD(va, ia); }
    while (P < MOE_PAIRS) {
        ib = moe_item(F, P, 1, ln); CVT_LOAD(vb, ib);
        CVT_STORE(va, ia);
        const int Pn = P + NGW;
        if (Pn < MOE_PAIRS) { ia = moe_item(F, Pn, 0, ln); CVT_LOAD(va, ia); }
        CVT_STORE(vb, ib);
        P = Pn;
    }
}

__device__ __forceinline__ void p0_prologue(Frame& F) {
    const float* const* in = F.in;
    const int gw = F.bx * NWAVES + F.wave, NGW = F.G * NWAVES;
    {
        constexpr int I_IN = 16 * 44, I_O = 16 * 16, I_GD = 16 * 44, I_DD = 44 * 16;
        constexpr int N_A = 2 * I_O + I_DD;
        const int ln = F.lane;
        for (int it = gw; it < N_A; it += NGW) {
            int r = it;
            if (r < 2 * I_O) { const int l = r / I_O; r %= I_O; const int kb = r / 16, nb = r % 16;
                p0_transpose_item(in[12] + (size_t)l * D * D, D, 64 * kb, 64 * nb, (bf16_t*)(F.ws + (l ? WS_WO1 : WS_WO0)), D, 64 * nb + ln, ln); continue; }
            r -= 2 * I_O;
            { const int kb = r / 16, nb = r % 16;
              p0_transpose_item(in[15], D, 64 * kb, 64 * nb, (bf16_t*)(F.ws + WS_WDD), DFF0, 64 * nb + ln, ln); }
        }
    }
    {
        LAS float* pm_ = (LAS float*)(F.lds + 65536);
        const int ln = F.lane;
        for (int it = F.G - 1 - F.bx; it < 4 * 44; it += F.G) {
            const float* src; int ldw, drow; unsigned char* dbase; float* csp;
            if (it < 2 * 44) { const int up = it / 44, c0 = 64 * (it % 44);
                src = in[up ? 14 : 13] + c0 + ln; ldw = DFF0; drow = (c0 >> 7) * 256 + up * 128 + (c0 & 127) + ln; dbase = F.ws + WS_WGUD; csp = (float*)(F.ws + WS_CSD); }
            else { const int l = (it - 2 * 44) / 44, c0 = 512 + 64 * (it % 44);
                const int n32 = ln & 31; const int dn = c0 < OFFV ? (ln & 32) + ((n32 < 16) ? 2 * n32 : 2 * (n32 - 16) + 1) : ln;
                drow = c0 + dn;
                if (c0 >= OFFG) { const int gcol = c0 - OFFG; drow = gcol < D ? OFFG + (gcol >> 7) * 256 + (gcol & 127) + ln : OFFG + ((gcol - D) >> 7) * 256 + 128 + ((gcol - D) & 127) + ln; }
                drow -= 512;
                src = in[8] + (size_t)l * D * INW + c0 + ln; ldw = INW; dbase = F.ws + (l ? WS_WIN1 : WS_WIN0) + (size_t)512 * D * 2; csp = (float*)(F.ws + WS_CSI) + l * 2816; }
            src += (size_t)(F.wave * 128) * ldw;
            float v[128]; float am = 0.f;
#pragma unroll
            for (int i = 0; i < 128; ++i) v[i] = src[(size_t)i * ldw];
#pragma unroll
            for (int i = 0; i < 128; ++i) am = fmaxf(am, fabsf(v[i]));
            __syncthreads();
            pm_[F.wave * 64 + ln] = am;
            __syncthreads();
#pragma unroll
            for (int w = 0; w < 8; ++w) am = fmaxf(am, pm_[w * 64 + ln]);
            const float sc = am > 0.f ? 127.0f / am : 0.f;
            if (F.wave == 0) csp[drow] = am * (1.0f / 127.0f);
            unsigned char* dst = dbase + (size_t)drow * D + F.wave * 128;
#pragma unroll
            for (int j = 0; j < 8; ++j) { u32x4 o; o.x = pk4i8(v[16 * j], v[16 * j + 1], v[16 * j + 2], v[16 * j + 3], sc); o.y = pk4i8(v[16 * j + 4], v[16 * j + 5], v[16 * j + 6], v[16 * j + 7], sc);
                o.z = pk4i8(v[16 * j + 8], v[16 * j + 9], v[16 * j + 10], v[16 * j + 11], sc); o.w = pk4i8(v[16 * j + 12], v[16 * j + 13], v[16 * j + 14], v[16 * j + 15], sc);
                *(u32x4*)(dst + 16 * j) = o; }
        }
    }
    __syncthreads();
    {
        LAS float* wrow = (LAS float*)F.lds;
        LAS float* ctab = wrow + 4096;
        if (F.tid < 128) ctab[F.tid] = cospif((float)F.tid / 64.0f);
        for (int it = F.bx; it < 2 * 128; it += F.G) {
            const int l = it >> 7, d0 = (it & 127) * 8;
            __syncthreads();
            for (int i = F.tid; i < 4096; i += NTHR) wrow[i] = in[8][(size_t)l * D * INW + (size_t)(d0 + (i >> 9)) * INW + (i & 511)];
            __syncthreads();
            const int r = F.tid, j = r >> 1, ri = r & 1, g = j >> 6, jj = j & 63;
            float a[8];
#pragma unroll
            for (int q = 0; q < 8; ++q) a[q] = 0.f;
            for (int cc = 0; cc < 128; ++cc) {
                float cf;
                if (jj == 0) cf = ri ? ((cc & 1) ? -1.f : 1.f) : 1.f;
                else { const int idx = (cc * jj) & 127; cf = ri ? -ctab[(idx - 32) & 127] : ctab[idx]; }
#pragma unroll
                for (int q = 0; q < 8; ++q) a[q] += cf * wrow[q * 512 + g * 128 + cc];
            }
            u32x4 o; o.x = pk2(a[0], a[1]); o.y = pk2(a[2], a[3]); o.z = pk2(a[4], a[5]); o.w = pk2(a[6], a[7]);
            *(u32x4*)((bf16_t*)(F.ws + (l ? WS_WIN1 : WS_WIN0)) + (size_t)r * D + d0) = o;
        }
        __syncthreads();
    }
    const int gt = F.bx * NTHR + F.tid, NGT = F.G * NTHR;
    for (int it = gt; it < 2 * 1024 * 144; it += NGT) {
        const int l = it / (1024 * 144), r = it % (1024 * 144), kc = r / 1024, o = r % 1024;
        const float* wf = in[10] + (size_t)l * 512 * D; const float* wa = in[11] + (size_t)l * 512 * D;
        float v[8];
#pragma unroll
        for (int q = 0; q < 8; ++q) { const int k = kc * 8 + q; float x = 0.f;
            if (k < 512) { const int mm = k & 127; x = wf[(size_t)k * D + o] * ((mm == 0 || mm == 64) ? 0.5f : 1.f); }
            else if (k < 520) { const int gg = (k - 512) >> 1, sgn = (k - 512) & 1; x = 0.5f * wf[(size_t)(gg * 128 + 64 * sgn) * D + o]; }
            else if (k >= 640) x = wa[(size_t)(k - 640) * D + o];
            v[q] = x; }
        u32x4 w; w.x = pk2(v[0], v[1]); w.y = pk2(v[2], v[3]); w.z = pk2(v[4], v[5]); w.w = pk2(v[6], v[7]);
        *(u32x4*)((bf16_t*)(F.ws + (l ? WS_WM1 : WS_WM0)) + (size_t)o * KM + kc * 8) = w;
    }
    for (int it = gt; it < 192 * 16; it += NGT) {
        const int i = it & 15, p = it >> 4, pos = p < 128 ? p : p - 128;
        const float inv = powf(10000.0f, -(float)i / 16.0f), a = (float)pos * inv;
        ((f32x2*)(F.ws + WS_ROPE))[it] = (f32x2){cosf(a), sinf(a)};
    }
    for (int it = gt; it < 128 * 64; it += NGT) {
        const int t2 = it >> 6, k1 = it & 63; float s, c; sincospif((float)(t2 * k1) / 4096.0f, &s, &c);
        ((f32x2*)(F.ws + WS_TW))[it] = (f32x2){c, s};
    }
    for (int it = gt; it < 256 * 128; it += NGT) {
        const int nu = it >> 7, ka = it & 127; float v = 0.f;
        if (nu < 128) { const int k1 = nu >> 1, ro = nu & 1, ri = ka >> 6, t1 = ka & 63; float s, c; sincospif((float)((t1 * k1) & 63) / 32.0f, &s, &c);
            v = ro == 0 ? (ri == 0 ? c : s) : (ri == 0 ? -s : c); }
        ((bf16_t*)(F.ws + WS_FA64))[it] = (bf16_t)f2bf(v);
    }
    for (int it = gt; it < 256 * 256; it += NGT) {
        const int mu = it >> 8, la = it & 255, k2 = mu >> 1, ro = mu & 1, ri = la >> 7, t2 = la & 127; float s, c; sincospif((float)((t2 * k2) & 127) / 64.0f, &s, &c);
        const float v = (ro == 0 ? (ri == 0 ? c : s) : (ri == 0 ? -s : c)) * 0.0009765625f;
        ((bf16_t*)(F.ws + WS_TC))[it] = (bf16_t)f2bf(v);
    }
    for (int it = gt; it < 512 * 512; it += NGT) {
        const int mu = it >> 9, la = it & 511, k = mu >> 1, ro = mu & 1, ri = la >> 8, t = la & 255; float s, c; sincospif((float)((t * k) & 255) / 128.0f, &s, &c);
        const float v = (ro == 0 ? (ri == 0 ? c : s) : (ri == 0 ? -s : c)) * 0.005524271728019903f;
        ((bf16_t*)(F.ws + WS_TX))[it] = (bf16_t)f2bf(v);
    }
    __syncthreads();
    {
        LAS float* sl = (LAS float*)F.lds;
        LAS float* part = sl + 3 * D;
        for (int i = F.tid; i < 3 * D; i += NTHR) { const float c = i < 2 * D ? in[1][i] : in[3][i - 2 * D]; sl[i] = c / (1.0f + __expf(-c)); }
        __syncthreads();
        for (int it = F.bx; it < 2 * 96; it += F.G) {
            const int l = it / 96, n = (it % 96) * 64 + F.lane;
            const float* wm = in[4] + (size_t)l * D * MODSZ + (size_t)(F.wave * 128) * MODSZ + n;
            float a0 = 0.f, a1 = 0.f, a2 = 0.f;
#pragma unroll
            for (int d0 = 0; d0 < 128; d0 += 32) { float w[32];
#pragma unroll
                for (int q = 0; q < 32; ++q) w[q] = wm[(size_t)(d0 + q) * MODSZ];
#pragma unroll
                for (int q = 0; q < 32; ++q) { const int d = F.wave * 128 + d0 + q; a0 += sl[d] * w[q]; a1 += sl[D + d] * w[q]; a2 += sl[2 * D + d] * w[q]; } }
            __syncthreads();
            part[(F.wave * 3 + 0) * 64 + F.lane] = a0; part[(F.wave * 3 + 1) * 64 + F.lane] = a1; part[(F.wave * 3 + 2) * 64 + F.lane] = a2;
            __syncthreads();
            if (F.tid < 192) { const int v = F.tid >> 6, ln = F.tid & 63; float sacc = in[5][l * MODSZ + (it % 96) * 64 + ln];
#pragma unroll
                for (int w = 0; w < 8; ++w) sacc += part[(w * 3 + v) * 64 + ln];
                modp(F, l, v)[(it % 96) * 64 + ln] = sacc; }
        }
    }
    for (int it = gt; it < NTOK * 15; it += NGT) { const int row = it / 15, c = it % 15;
        *(u32x4*)((bf16_t*)(F.ws + WS_FO) + (size_t)row * KM + 520 + c * 8) = (u32x4){0u, 0u, 0u, 0u}; }
}

__device__ __forceinline__ const float* xrow_ptr(const Frame& F, int row, const float* xl) { return row < NL ? xl + (size_t)row * D : (const float*)(F.ws + WS_XC) + (size_t)(row - NL) * D; }

template <bool ROUTE, int OUTM = ROUTE ? 1 : 0>
__device__ __forceinline__ void norm_phase(Frame& F, int l, int which  , const float* xl, const float* xc, int nrows, const float* xcadd = nullptr, float* xcwb = nullptr) {
    const float* gvec = F.in[which ? 7 : 6] + l * D;
    LAS float* wr_l = (LAS float*)F.lds;
    constexpr int RMAX = 32;
    LAS int* pe = (LAS int*)(F.lds + 32768); LAS float* pw = (LAS float*)(F.lds + 32768 + 2048); LAS unsigned* lcnt = (LAS unsigned*)(F.lds + 32768 + 4096); LAS unsigned* gb = lcnt + 8;
    if (ROUTE) { for (int i = F.tid; i < D * NE; i += NTHR) wr_l[i] = F.in[16][i]; pe[F.tid] = -1; if (F.tid < 8) lcnt[F.tid] = 0u; __syncthreads(); }
    const int gw = F.bx * NWAVES + F.wave, NGW = F.G * NWAVES;
    int iter = 0;
    for (int row = gw; row < nrows; row += NGW, ++iter) {
        const int v = row < T ? 0 : (row < NL ? 1 : 2);
        const bool fromb = row < NL && xl == nullptr;
        const float* xr = row < NL ? (fromb ? xc : xl + (size_t)row * D) : xc + (size_t)(row - NL) * D;
        const bf16_t* xbr = (const bf16_t*)(F.ws + WS_XB) + (size_t)row * D;
        const float* sh = modp(F, l, v) + (which ? 3 : 0) * D; const float* sc = sh + D;
        f32x4 x[4]; float s = 0.f;
#pragma unroll
        for (int j = 0; j < 4; ++j) {
            if (fromb) { const u32x2 xb = *(const u32x2*)(xbr + 256 * j + 4 * F.lane); x[j] = (f32x4){bflo(xb.x), bfhi(xb.x), bflo(xb.y), bfhi(xb.y)}; }
            else x[j] = *(const f32x4*)(xr + 256 * j + 4 * F.lane);
            if (row >= NL && xcadd) { x[j] = x[j] + *(const f32x4*)(xcadd + (size_t)(row - NL) * D + 256 * j + 4 * F.lane); if (xcwb) *(f32x4*)(xcwb + (size_t)(row - NL) * D + 256 * j + 4 * F.lane) = x[j]; }
            s += (x[j].x * x[j].x + x[j].y * x[j].y) + (x[j].z * x[j].z + x[j].w * x[j].w); }
        const float r = 1.0f / sqrtf(wave_sum(s) * (1.f / D) + EPS);
        float lg[NE];
        if (ROUTE) {
#pragma unroll
            for (int e = 0; e < NE; ++e) lg[e] = 0.f; }
        bf16_t* hr = (bf16_t*)(F.ws + WS_H) + (size_t)row * D;
        f32x4 hh[4]; float amax = 0.f;
#pragma unroll
        for (int j = 0; j < 4; ++j) { const int c = 256 * j + 4 * F.lane;
            const f32x4 gg = *(const f32x4*)(gvec + c), s4 = *(const f32x4*)(sh + c), c4 = *(const f32x4*)(sc + c);
            f32x4 h = (x[j] * r) * gg; h = h * (c4 + 1.0f) + s4;
            if (OUTM == 1) *(unsigned*)((unsigned char*)(F.ws + WS_H) + (size_t)row * D + c) = pk4f8(h.x, h.y, h.z, h.w);
            else if (OUTM == 0) { u32x2 o; o.x = pk2(h.x, h.y); o.y = pk2(h.z, h.w); *(u32x2*)(hr + c) = o; }
            else { if (OUTM == 3) { u32x2 o; o.x = pk2(h.x, h.y); o.y = pk2(h.z, h.w); *(u32x2*)(hr + c) = o; }
                hh[j] = h; amax = fmaxf(fmaxf(amax, fmaxf(fabsf(h.x), fabsf(h.y))), fmaxf(fabsf(h.z), fabsf(h.w))); }
            if (ROUTE) {
#pragma unroll
                for (int q = 0; q < 4; ++q) { const float hv = h[q]; const LAS f32x4* w = (const LAS f32x4*)(wr_l + (c + q) * NE); const f32x4 w0 = w[0], w1 = w[1];
                    lg[0] += hv * w0.x; lg[1] += hv * w0.y; lg[2] += hv * w0.z; lg[3] += hv * w0.w; lg[4] += hv * w1.x; lg[5] += hv * w1.y; lg[6] += hv * w1.z; lg[7] += hv * w1.w; } }
        }
        if (OUTM >= 2) {
            amax = wave_max(amax);
            const float qs = amax > 0.f ? 127.0f / amax : 0.f;
            if (F.lane == 0) ((float*)(F.ws + WS_RS))[row] = amax * (1.0f / 127.0f);
#pragma unroll
            for (int j = 0; j < 4; ++j) *(unsigned*)((unsigned char*)(F.ws + (OUTM == 3 ? WS_H8 : WS_H)) + (size_t)row * D + 256 * j + 4 * F.lane) = pk4i8(hh[j].x, hh[j].y, hh[j].z, hh[j].w, qs);
        }
        if (ROUTE) {
#pragma unroll
            for (int e = 0; e < NE; ++e) lg[e] = wave_sum(lg[e]);
            if (F.lane == 0) {
                int e1 = 0; float v1 = lg[0];
#pragma unroll
                for (int e = 1; e < NE; ++e) if (lg[e] > v1) { v1 = lg[e]; e1 = e; }
                int e2 = -1; float v2 = -3.0e38f;
#pragma unroll
                for (int e = 0; e < NE; ++e) if (e != e1 && lg[e] > v2) { v2 = lg[e]; e2 = e; }
                const float p2 = __expf(v2 - v1), w1 = 1.f / (1.f + p2), w2 = p2 * w1;
                const int p = 2 * (F.wave * RMAX + iter);
                pe[p] = e1; pe[p + 1] = e2; pw[p] = w1; pw[p + 1] = w2;
            }
        }
    }
    if (ROUTE) {
        __syncthreads();
        const int p = F.tid, e = pe[p]; unsigned lr = 0u;
        if (e >= 0) lr = __hip_atomic_fetch_add(lcnt + e, 1u, __ATOMIC_RELAXED, __HIP_MEMORY_SCOPE_WORKGROUP);
        __syncthreads();
        if (F.tid < NE && lcnt[F.tid] > 0u) gb[F.tid] = atomicAdd((unsigned*)(F.ws + WS_CTL) + CW_CNT + 64 * F.tid, lcnt[F.tid]);
        __syncthreads();
        if (e >= 0) {
            const int slot = p >> 1, row = F.bx * NWAVES + slot / RMAX + (slot % RMAX) * NGW, r = (int)(gb[e] + lr);
            int* toke = (int*)(F.ws + WS_TOKE); int* tokr = (int*)(F.ws + WS_TOKR); float* tokw = (float*)(F.ws + WS_TOKW); int* list = (int*)(F.ws + WS_LIST);
            toke[2 * row + (p & 1)] = e; tokr[2 * row + (p & 1)] = r; tokw[2 * row + (p & 1)] = pw[p]; list[e * NL + r] = row;
        }
        __syncthreads();
    }
}

constexpr int TAILQ_ROWS = 8 * 256;
__device__ __forceinline__ int moe_tail_panels(const unsigned* cw, int G) { int ptot = 0, plast = 0;
#pragma unroll
    for (int e = 0; e < NE; ++e) { const int p_ = ((int)cw[64 * e] + 255) >> 8; ptot += p_; plast = p_; }
    const int left = (4 * ptot) % G; int t = (left + 3) >> 2; if (4 * ptot < G) t = 0; if (t > plast) t = plast; if (t > 8) t = 8; return t; }
__device__ __forceinline__ void final_phase(Frame& F) {
    int t_ = threadIdx.x; asm volatile("" : "+v"(t_)); const int lane_ = t_ & 63;
    const int gw = F.bx * NWAVES + F.wave, NGW = F.G * NWAVES;
    const unsigned* cnt = (const unsigned*)(F.ws + WS_CTL) + CW_CNT;
    int base[NE]; { int b = 0;
#pragma unroll
        for (int e = 0; e < NE; ++e) { base[e] = b; b += ((int)cnt[64 * e] + 255) & ~255; } }
    const int* toke = (const int*)(F.ws + WS_TOKE); const int* tokr = (const int*)(F.ws + WS_TOKR); const float* tokw = (const float*)(F.ws + WS_TOKW);
    const bf16_t* dout = (const bf16_t*)(F.ws + WS_DOUT); const bf16_t* tq = (const bf16_t*)(F.ws + WS_DOUT1);
    const int trim_ = moe_tail_panels(cnt, F.G), trow0 = trim_ > 0 ? base[NE - 1] + ((((int)cnt[64 * (NE - 1)] + 255) >> 8) - trim_) * 256 : 0x7fffffff;
    for (int row = gw; row < NL; row += NGW) {
        const int v = row < T ? 0 : 1;
        const float* ga2 = modp(F, 1, v) + 5 * D;
        const int e1 = toke[2 * row], e2 = toke[2 * row + 1];
        int b1 = 0, b2 = 0;
#pragma unroll
        for (int e = 0; e < NE; ++e) { if (e == e1) b1 = base[e]; if (e == e2) b2 = base[e]; }
        const bf16_t* d1 = dout + (size_t)(b1 + tokr[2 * row]) * D; const bf16_t* d2 = dout + (size_t)(b2 + tokr[2 * row + 1]) * D;
        const int r1_ = b1 + tokr[2 * row], r2_ = b2 + tokr[2 * row + 1];
        const bool t1 = r1_ >= trow0, t2 = r2_ >= trow0;
        const bf16_t* q1 = tq + (size_t)(t1 ? r1_ - trow0 : 0) * D; const bf16_t* q2 = tq + (size_t)(t2 ? r2_ - trow0 : 0) * D;
        const float w1 = tokw[2 * row], w2 = tokw[2 * row + 1];
        float* xr = F.out + (size_t)row * D;
        f32x4 x[4]; float s = 0.f;
#pragma unroll
        for (int j = 0; j < 4; ++j) { const int c = 256 * j + 4 * lane_;
            const u32x2 a = *(const u32x2*)(d1 + c), b = *(const u32x2*)(d2 + c); const f32x4 g4 = *(const f32x4*)(ga2 + c);
            f32x4 ya = (f32x4){bflo(a.x), bfhi(a.x), bflo(a.y), bfhi(a.y)}, yb = (f32x4){bflo(b.x), bfhi(b.x), bflo(b.y), bfhi(b.y)};
            if (t1) {
#pragma unroll
                for (int k = 0; k < 1; ++k) { const u32x2 e_ = *(const u32x2*)(q1 + (size_t)k * TAILQ_ROWS * D + c); ya = ya + (f32x4){bflo(e_.x), bfhi(e_.x), bflo(e_.y), bfhi(e_.y)}; } }
            if (t2) {
#pragma unroll
                for (int k = 0; k < 1; ++k) { const u32x2 e_ = *(const u32x2*)(q2 + (size_t)k * TAILQ_ROWS * D + c); yb = yb + (f32x4){bflo(e_.x), bfhi(e_.x), bflo(e_.y), bfhi(e_.y)}; } }
            const f32x4 y = (ya * w1 + yb * w2) * (1.0f / (float)(QDN * QACT));
            { const u32x2 xb = *(const u32x2*)((const bf16_t*)(F.ws + WS_XB) + (size_t)row * D + c); x[j] = (f32x4){bflo(xb.x), bfhi(xb.x), bflo(xb.y), bfhi(xb.y)} + g4 * y; }
            s += (x[j].x * x[j].x + x[j].y * x[j].y) + (x[j].z * x[j].z + x[j].w * x[j].w); }
        const float r = 1.0f / sqrtf(wave_sum(s) * (1.f / D) + EPS);
#pragma unroll
        for (int j = 0; j < 4; ++j) { const int c = 256 * j + 4 * lane_; *(f32x4*)(xr + c) = (x[j] * r) * *(const f32x4*)(F.in[20] + c); }
    }
}

struct GridSched { int nM, nN, G, c; unsigned abytes, bbytes;
    __device__ __forceinline__ bool next(int i, Unit& u) const { const int L = i * G + c; if (L >= nM * nN) return false; pg8::swz_map(L, nM, nN, u.pm, u.pn); u.aoff = (unsigned)u.pm * abytes; u.boff = (unsigned)u.pn * bbytes; u.kind = 0; u.x0 = 0; u.x1 = 0; u.kh = 0; return true; } };

struct CtxSched { int G, c, nN; unsigned abytes, bbytes; int ksplit; unsigned khbytes;
    __device__ __forceinline__ bool next(int i, Unit& u) const { int L = i * G + c; if (L >= 2 * nN * ksplit) return false; u.kh = L / (2 * nN); L -= u.kh * 2 * nN; u.pm = 64 + L / nN; u.pn = L % nN;
        u.aoff = (unsigned)u.pm * abytes + (unsigned)u.kh * khbytes; u.boff = (unsigned)u.pn * bbytes + (unsigned)u.kh * khbytes; u.kind = 0; u.x0 = u.pm * 256; u.x1 = 0; return true; } };

struct InprojSched { int G, c, l;
    __device__ __forceinline__ bool next(int i, Unit& u) const { const int L = i * G + c; const int nmain = 64 * 11;
        if (L < nmain) { pg8::swz_map(L, 64, 11, u.pm, u.pn); }
        else { const int r = L - nmain; if (l == 0) { if (r >= 22) return false; u.pm = 64 + r / 11; u.pn = r % 11; } else { if (r >= 2) return false; u.pm = 64 + r; u.pn = 2; } }
        u.aoff = (unsigned)u.pm * (256u * D); u.boff = (unsigned)u.pn * (256u * D); u.kind = 0; u.x0 = 0; u.x1 = 0; u.kh = 0; return true; } };

struct EpiInproj {
    static constexpr bool PERM = true; static constexpr int MIDK = 0;
    unsigned char* ws; const float* rs; const float* cs;
    __device__ __forceinline__ void operator()(const f32x4 (&acci)[2][2][4][2], const Unit& u, int wr, int wc, int fr, int fq) const {
        asm volatile("" : "+v"(fr), "+v"(fq));
        const int row0 = u.pm * 256 + wr * 64 + fr;
        const bool lat = u.pm < 64;
        const f32x2* rope = (const f32x2*)(ws + WS_ROPE);
        f32x4 csc[2][2];
#pragma unroll
        for (int bj = 0; bj < 2; ++bj) { const float* cp = cs + u.pn * 256 + bj * 128 + wc * 32 + 8 * fq; csc[bj][0] = *(const f32x4*)cp; csc[bj][1] = *(const f32x4*)(cp + 4); }
#pragma unroll
        for (int ai = 0; ai < 2; ++ai)
#pragma unroll
            for (int m = 0; m < 4; ++m) {
                const int row = row0 + ai * 128 + m * 16;
                const int t = row & (T - 1), prow = t >> 6, pcol = t & 63;
                const float rsc = rs[row];
                f32x4 acc[2][2][4][2];
#pragma unroll
                for (int bj = 0; bj < 2; ++bj)
#pragma unroll
                    for (int n = 0; n < 2; ++n) acc[ai][bj][m][n] = __builtin_convertvector(__builtin_bit_cast(pg8::i32x4, acci[ai][bj][m][n]), f32x4) * (csc[bj][n] * rsc);
#pragma unroll
                for (int bj = 0; bj < 2; ++bj) {
                    const int cl = u.pn * 256 + bj * 128 + wc * 32 + 8 * fq;
                    f32x4 v0 = acc[ai][bj][m][0], v1 = acc[ai][bj][m][1];
                    bf16_t* dst;
                    if (cl < 640) {
                        if (lat) { const int dh = cl & 63, i0 = (dh & 31) >> 1; const f32x2* rp = rope + ((dh < 32 ? prow : 128 + pcol) * 16 + i0);
                            const f32x2 c0 = rp[0], c1 = rp[1], c2 = rp[2], c3 = rp[3];
                            f32x4 w0, w1; w0.x = v0.x * c0.x - v0.y * c0.y; w0.y = v0.x * c0.y + v0.y * c0.x; w0.z = v0.z * c1.x - v0.w * c1.y; w0.w = v0.z * c1.y + v0.w * c1.x;
                            w1.x = v1.x * c2.x - v1.y * c2.y; w1.y = v1.x * c2.y + v1.y * c2.x; w1.z = v1.z * c3.x - v1.w * c3.y; w1.w = v1.z * c3.y + v1.w * c3.x; v0 = w0; v1 = w1; }
                        if (cl < 512) { v0 = v0 * QSCALE; v1 = v1 * QSCALE; dst = (bf16_t*)(ws + WS_Q) + (size_t)row * 512 + cl; }
                        else dst = (bf16_t*)(ws + WS_KB) + (size_t)row * 128 + (cl - 512);
                    } else if (cl < 768) { dst = (bf16_t*)(ws + WS_VB) + (size_t)row * 128 + (cl - 640); }
                    else {
                        const int oc = (u.pn - 3) * 128 + wc * 32 + 8 * fq;
                        if (bj == 0) { const f32x4 a0 = acc[ai][1][m][0], a1 = acc[ai][1][m][1];
#pragma unroll
                            for (int q = 0; q < 4; ++q) { v0[q] = sigmoidf_(v0[q]) * (1.0f + __builtin_amdgcn_exp2f(-a0[q] * LOG2E)); v1[q] = sigmoidf_(v1[q]) * (1.0f + __builtin_amdgcn_exp2f(-a1[q] * LOG2E)); }
                            dst = (bf16_t*)(ws + WS_GF) + (size_t)row * D + oc; }
                        else {
#pragma unroll
                            for (int q = 0; q < 4; ++q) { v0[q] = sigmoidf_(v0[q]); v1[q] = sigmoidf_(v1[q]); }
                            dst = (bf16_t*)(ws + WS_GA) + (size_t)row * D + oc; } }
                    u32x4 w; w.x = cvt_pk_bf16(v0[0], v0[1]); w.y = cvt_pk_bf16(v0[2], v0[3]); w.z = cvt_pk_bf16(v1[0], v1[1]); w.w = cvt_pk_bf16(v1[2], v1[3]);
                    *(u32x4*)dst = w;
                }
            }
    }
};

struct UpermSched { int G, c, l;
    __device__ __forceinline__ bool next(int i, Unit& u) const { const int L = i * G + c; const int nn = l == 0 ? 66 : 64; if (L >= 2 * nn) return false;
        u.pm = L & 1; u.pn = L >> 1; u.aoff = (unsigned)u.pm * (256u * D * 2u); u.boff = 0; u.kind = 0; u.x0 = 0; u.x1 = 0; u.kh = 0; return true; } };
struct UpermRows { static constexpr bool GA = false, GB = true;
    __device__ __forceinline__ unsigned arow(const Unit&, int) const { return 0u; }
    __device__ __forceinline__ unsigned brow(const Unit& u, int c) const { const int n = u.pn; int row;
        if (n < 64) { const int b = n >> 5, q = n & 31; row = b * T + 128 * (c & 63) + 4 * q + (c >> 6); } else row = NL + (n - 64) * 256 + c;
        return (unsigned)row * (D * 2u); } };
struct EpiUperm {
    static constexpr bool PERM = true; static constexpr int MIDK = 0;
    unsigned char* ws;
    __device__ __forceinline__ void operator()(const f32x4 (&acc)[2][2][4][2], const Unit& u, int wr, int wc, int fr, int fq) const {
        const int n = u.pn;
#pragma unroll
        for (int ai = 0; ai < 2; ++ai)
#pragma unroll
            for (int m = 0; m < 4; ++m) { const int r = u.pm * 256 + ai * 128 + wr * 64 + m * 16 + fr, j = r >> 1, ri = r & 1;
#pragma unroll
                for (int bj = 0; bj < 2; ++bj) { const int c = bj * 128 + wc * 32 + 8 * fq;
                    const f32x4 v0 = acc[ai][bj][m][0], v1 = acc[ai][bj][m][1];
                    u32x4 w; w.x = cvt_pk_bf16(v0[0], v0[1]); w.y = cvt_pk_bf16(v0[2], v0[3]); w.z = cvt_pk_bf16(v1[0], v1[1]); w.w = cvt_pk_bf16(v1[2], v1[3]);
                    bf16_t* dst;
                    if (n < 64) { const int b = n >> 5, q = n & 31, t2 = 4 * q + (c >> 6), t1 = c & 63; dst = (bf16_t*)(ws + WS_UP) + ((size_t)((j * 2 + b) * 128 + t2) * 128 + ri * 64 + t1); }
                    else { const int b = n - 64; dst = (bf16_t*)(ws + WS_VCT) + ((size_t)((b * 256 + j) * 2 + ri) * 256 + c); }
                    *(u32x4*)dst = w; } }
    }
};

struct StepASched { int G, c, l;
    __device__ __forceinline__ bool next(int i, Unit& u) const { int L = i * G + c;
        if (l == 0 && G == 256) { if (c >= 16 && c < 20) return false; if (c >= 20 && c < 24) { if (i > 1) return false; L = i == 0 ? c : c - 4; } else if (i > 0) return false; }
        if (L >= 256) return false; pg8::swz_map(L, 256, 1, u.pm, u.pn); u.aoff = (unsigned)u.pm * (256u * 128u * 2u); u.boff = 0u; u.kind = 0; u.x0 = 0; u.x1 = 0; u.kh = 0; return true; } };

struct EpiStepA {
    static constexpr bool PERM = true; static constexpr int MIDK = 0;
    unsigned char* ws;
    __device__ __forceinline__ void operator()(const f32x4 (&acc)[2][2][4][2], const Unit& u, int wr, int wc, int fr, int fq) const {
        const f32x2* tw = (const f32x2*)(ws + WS_TW); bf16_t* gp = (bf16_t*)(ws + WS_GP);
        const int j = u.pm;
#pragma unroll
        for (int ai = 0; ai < 2; ++ai)
#pragma unroll
            for (int m = 0; m < 4; ++m) { const int t2 = wr * 64 + m * 16 + fr, b = ai;
#pragma unroll
                for (int n = 0; n < 2; ++n) { const f32x4 v = acc[ai][0][m][n];
#pragma unroll
                    for (int p = 0; p < 2; ++p) { const int k1 = 16 * wc + 4 * fq + 2 * n + p; const f32x2 w = tw[t2 * 64 + k1];
                        const float gr = v[2 * p], gi = v[2 * p + 1];
                        const float orr = gr * w.x + gi * w.y, oi = gi * w.x - gr * w.y;
                        bf16_t* d = gp + ((size_t)((b * 64 + k1) * 256 + j) * 256 + t2);
                        d[0] = (bf16_t)f2bf(orr); d[128] = (bf16_t)f2bf(oi); } } }
    }
};
template <bool CTXV> struct EpiStepC {
    static constexpr bool PERM = true; static constexpr int MIDK = 0;
    unsigned char* ws;
    __device__ __forceinline__ void operator()(const f32x4 (&acc)[2][2][4][2], const Unit& u, int wr_, int wc_, int fr_, int fq_) const {
        int wr = wr_, wc = wc_, fr = fr_, fq = fq_, upm = u.pm, upn = u.pn;
        asm volatile("" : "+s"(wr), "+s"(wc), "+v"(fr), "+v"(fq), "+s"(upm), "+s"(upn));
        bf16_t* fo = (bf16_t*)(ws + WS_FO);
        const int NN = CTXV ? 256 : T;
        const int b = CTXV ? upm : (upm >> 6), k1 = CTXV ? 0 : (upm & 63), rowb = CTXV ? NL + b * 256 : b * T;
        const int own0 = wr * 128 + fr, mir0 = wr * 128 + 128 - fr;
        const int kk0 = (CTXV ? 128 * upn : 0) + 16 * wc + 4 * fq;
#pragma unroll
        for (int bj = 0; bj < 2; ++bj)
#pragma unroll
            for (int n = 0; n < 2; ++n)
#pragma unroll
                for (int p = 0; p < 2; ++p) {
                    const int kk = kk0 + 64 * bj + 2 * n + p;
                    const int k = CTXV ? kk : (k1 + 64 * kk), km = (NN - k) & (NN - 1);
                    const unsigned oo = (unsigned)(rowb + k) * KM, om = (unsigned)(rowb + km) * KM;
#pragma unroll
                    for (int ai = 0; ai < 2; ++ai)
#pragma unroll
                        for (int m = 0; m < 4; ++m) {
                            const f32x4 v = acc[ai][bj][m][n];
                            const bf16_t re = (bf16_t)f2bf(v[2 * p]);
                            if (m == 0 && fr == 0) { const int g = 2 * ai + wr; const bf16_t im = (bf16_t)f2bf(v[2 * p + 1]);
                                fo[oo + g * 128] = re; fo[om + 512 + 2 * g] = re; fo[oo + g * 128 + 64] = im; fo[om + 512 + 2 * g + 1] = im; }
                            else { fo[oo + own0 + ai * 256 + 16 * m] = re; fo[om + mir0 + ai * 256 - 16 * m] = re; }
                        }
                    asm volatile("" ::: "memory"); __builtin_amdgcn_sched_barrier(0);
                }
    }
};

struct EpiMerge {
    static constexpr bool PERM = true; static constexpr int MIDK = 10;
    unsigned char* ws;
    __device__ __forceinline__ void mid(f32x4 (&acc)[2][2][4][2], const Unit& u, int wr, int wc, int fr, int fq) const {
        asm volatile("" : "+v"(fr), "+v"(fq));
#pragma unroll
        for (int ai = 0; ai < 2; ++ai)
#pragma unroll
            for (int m = 0; m < 4; ++m) { const size_t row = (size_t)(u.pm * 256 + ai * 128 + wr * 64 + m * 16 + fr);
#pragma unroll
                for (int bj = 0; bj < 2; ++bj) { const int col = u.pn * 256 + bj * 128 + wc * 32 + 8 * fq;
                    const u32x4 gr = *(const u32x4*)((const bf16_t*)(ws + WS_GF) + row * D + col);
                    const f32x4 r0 = (f32x4){bflo(gr.x), bfhi(gr.x), bflo(gr.y), bfhi(gr.y)}, r1 = (f32x4){bflo(gr.z), bfhi(gr.z), bflo(gr.w), bfhi(gr.w)};
                    acc[ai][bj][m][0] = acc[ai][bj][m][0] * r0; acc[ai][bj][m][1] = acc[ai][bj][m][1] * r1; } }
    }
    __device__ __forceinline__ void operator()(const f32x4 (&acc)[2][2][4][2], const Unit& u, int wr, int wc, int fr, int fq) const {
#pragma unroll
        for (int ai = 0; ai < 2; ++ai)
#pragma unroll
            for (int m = 0; m < 4; ++m) { const size_t row = (size_t)(u.pm * 256 + ai * 128 + wr * 64 + m * 16 + fr);
#pragma unroll
                for (int bj = 0; bj < 2; ++bj) { const int col = u.pn * 256 + bj * 128 + wc * 32 + 8 * fq;
                    const u32x4 ga = *(const u32x4*)((const bf16_t*)(ws + WS_GA) + row * D + col);
                    const f32x4 a0 = acc[ai][bj][m][0], a1 = acc[ai][bj][m][1];
                    u32x4 w;
                    w.x = cvt_pk_bf16(bflo(ga.x) * a0[0], bfhi(ga.x) * a0[1]); w.y = cvt_pk_bf16(bflo(ga.y) * a0[2], bfhi(ga.y) * a0[3]);
                    w.z = cvt_pk_bf16(bflo(ga.z) * a1[0], bfhi(ga.z) * a1[1]); w.w = cvt_pk_bf16(bflo(ga.w) * a1[2], bfhi(ga.w) * a1[3]);
                    *(u32x4*)((bf16_t*)(ws + WS_Y) + row * D + col) = w; } }
    }
};

struct EpiResid {
    static constexpr bool PERM = true; static constexpr int MIDK = 0;
    const float* xl_in32; const bf16_t* xl_inb; bf16_t* xl_out; const float* xc_in; float* xc_out; const float* mod_l; int chunk; float* tmpc;
    __device__ __forceinline__ void operator()(const f32x4 (&acc)[2][2][4][2], const Unit& u, int wr, int wc, int fr, int fq) const {
        const int v = u.pm < 32 ? 0 : (u.pm < 64 ? 1 : 2);
        const float* gate = mod_l + v * MODSZ + chunk * D;
        const bool lat = u.pm < 64; const int rbase = lat ? u.pm * 256 : (u.pm - 64) * 256;
#pragma unroll
        for (int bj = 0; bj < 2; ++bj) { const int col = u.pn * 256 + bj * 128 + wc * 32 + 8 * fq;
            const f32x4 g0 = *(const f32x4*)(gate + col), g1 = *(const f32x4*)(gate + col + 4);
#pragma unroll
            for (int ai = 0; ai < 2; ++ai)
#pragma unroll
                for (int m = 0; m < 4; ++m) { const size_t o = (size_t)(rbase + ai * 128 + wr * 64 + m * 16 + fr) * D + col;
                    if (lat) {
                        f32x4 x0, x1;
                        if (xl_in32) { x0 = *(const f32x4*)(xl_in32 + o); x1 = *(const f32x4*)(xl_in32 + o + 4); }
                        else { const u32x4 xb = *(const u32x4*)(xl_inb + o); x0 = (f32x4){bflo(xb.x), bfhi(xb.x), bflo(xb.y), bfhi(xb.y)}; x1 = (f32x4){bflo(xb.z), bfhi(xb.z), bflo(xb.w), bfhi(xb.w)}; }
                        x0 = x0 + g0 * acc[ai][bj][m][0]; x1 = x1 + g1 * acc[ai][bj][m][1];
                        u32x4 w; w.x = cvt_pk_bf16(x0[0], x0[1]); w.y = cvt_pk_bf16(x0[2], x0[3]); w.z = cvt_pk_bf16(x1[0], x1[1]); w.w = cvt_pk_bf16(x1[2], x1[3]);
                        *(u32x4*)(xl_out + o) = w;
                    } else if (u.kh) { *(f32x4*)(tmpc + o) = g0 * acc[ai][bj][m][0]; *(f32x4*)(tmpc + o + 4) = g1 * acc[ai][bj][m][1]; }
                    else { *(f32x4*)(xc_out + o) = *(const f32x4*)(xc_in + o) + g0 * acc[ai][bj][m][0];
                           *(f32x4*)(xc_out + o + 4) = *(const f32x4*)(xc_in + o + 4) + g1 * acc[ai][bj][m][1]; } } }
    }
};

struct EpiSwiglu {
    static constexpr bool PERM = true; static constexpr int MIDK = 0;
    bf16_t* act; int ld;
    __device__ __forceinline__ void operator()(const f32x4 (&acc)[2][2][4][2], const Unit& u, int wr, int wc, int fr, int fq) const {
        const int col = u.pn * 128 + wc * 32 + 8 * fq;
#pragma unroll
        for (int ai = 0; ai < 2; ++ai)
#pragma unroll
            for (int m = 0; m < 4; ++m) { const size_t row = (size_t)(u.x0 + ai * 128 + wr * 64 + m * 16 + fr);
                float o[8];
#pragma unroll
                for (int n = 0; n < 2; ++n)
#pragma unroll
                    for (int q = 0; q < 4; ++q) { const float gv = acc[ai][0][m][n][q], uv = acc[ai][1][m][n][q]; o[4 * n + q] = gv * sigmoidf_(gv) * uv; }
                u32x4 w; w.x = cvt_pk_bf16(o[0], o[1]); w.y = cvt_pk_bf16(o[2], o[3]); w.z = cvt_pk_bf16(o[4], o[5]); w.w = cvt_pk_bf16(o[6], o[7]);
                *(u32x4*)(act + row * ld + col) = w; }
    }
};
struct EpiSwigluI8 {
    static constexpr bool PERM = true; static constexpr int MIDK = 0;
    bf16_t* act; int ld; const float* rs; const float* cs;
    __device__ __forceinline__ void operator()(const f32x4 (&acc)[2][2][4][2], const Unit& u, int wr, int wc, int fr, int fq) const {
        asm volatile("" : "+v"(fr), "+v"(fq));
        const int col = u.pn * 128 + wc * 32 + 8 * fq;
        const float* cg = cs + u.pn * 256 + wc * 32 + 8 * fq;
        const f32x4 g0 = *(const f32x4*)cg, g1 = *(const f32x4*)(cg + 4), u0 = *(const f32x4*)(cg + 128), u1 = *(const f32x4*)(cg + 132);
        const float csg[8] = {g0.x, g0.y, g0.z, g0.w, g1.x, g1.y, g1.z, g1.w}, csu[8] = {u0.x, u0.y, u0.z, u0.w, u1.x, u1.y, u1.z, u1.w};
#pragma unroll
        for (int ai = 0; ai < 2; ++ai)
#pragma unroll
            for (int m = 0; m < 4; ++m) { const size_t row = (size_t)(u.x0 + ai * 128 + wr * 64 + m * 16 + fr);
                const float rsc = rs[row];
                float o[8];
#pragma unroll
                for (int n = 0; n < 2; ++n) { const pg8::i32x4 gi = __builtin_bit_cast(pg8::i32x4, acc[ai][0][m][n]), ui = __builtin_bit_cast(pg8::i32x4, acc[ai][1][m][n]);
#pragma unroll
                    for (int q = 0; q < 4; ++q) { const float gv = (float)gi[q] * (rsc * csg[4 * n + q]), uv = (float)ui[q] * (rsc * csu[4 * n + q]);
                        o[4 * n + q] = gv * sigmoidf_(gv) * uv; } }
                u32x4 w; w.x = cvt_pk_bf16(o[0], o[1]); w.y = cvt_pk_bf16(o[2], o[3]); w.z = cvt_pk_bf16(o[4], o[5]); w.w = cvt_pk_bf16(o[6], o[7]);
                *(u32x4*)(act + row * ld + col) = w; }
    }
};
struct EpiSwiglu8 {
    static constexpr bool PERM = true; static constexpr int MIDK = 0;
    unsigned char* act; int ld;
    __device__ __forceinline__ void operator()(const f32x4 (&acc)[2][2][4][2], const Unit& u, int wr, int wc, int fr, int fq) const {
        asm volatile("" : "+v"(fr), "+v"(fq));
        const int col = u.pn * 128 + wc * 32 + 8 * fq;
#pragma unroll
        for (int ai = 0; ai < 2; ++ai)
#pragma unroll
            for (int m = 0; m < 4; ++m) { const size_t row = (size_t)(u.x0 + ai * 128 + wr * 64 + m * 16 + fr);
                float o[8];
#pragma unroll
                for (int n = 0; n < 2; ++n)
#pragma unroll
                    for (int q = 0; q < 4; ++q) { const float gv = acc[ai][0][m][n][q] * (1.0f / (float)QGU), uv = acc[ai][1][m][n][q] * ((float)QACT / (float)QGU);
                        o[4 * n + q] = __builtin_amdgcn_fmed3f(gv * sigmoidf_(gv) * uv, -448.0f, 448.0f); }
                u32x2 w; w.x = pk4f8(o[0], o[1], o[2], o[3]); w.y = pk4f8(o[4], o[5], o[6], o[7]);
                *(u32x2*)(act + row * ld + col) = w; }
    }
};
struct EpiBf16 {
    static constexpr bool PERM = true; static constexpr int MIDK = 0;
    bf16_t* O0; bf16_t* O1; int ld;
    __device__ __forceinline__ void operator()(const f32x4 (&acc)[2][2][4][2], const Unit& u, int wr, int wc, int fr, int fq) const {
        asm volatile("" : "+v"(fr), "+v"(fq));
#pragma unroll
        for (int ai = 0; ai < 2; ++ai)
#pragma unroll
            for (int m = 0; m < 4; ++m) { const size_t row = (size_t)(u.x0 + ai * 128 + wr * 64 + m * 16 + fr);
#pragma unroll
                for (int bj = 0; bj < 2; ++bj) { const int col = u.pn * 256 + bj * 128 + wc * 32 + 8 * fq; const f32x4 v0 = acc[ai][bj][m][0], v1 = acc[ai][bj][m][1];
                    u32x4 w; w.x = cvt_pk_bf16(v0[0], v0[1]); w.y = cvt_pk_bf16(v0[2], v0[3]); w.z = cvt_pk_bf16(v1[0], v1[1]); w.w = cvt_pk_bf16(v1[2], v1[3]);
                    *(u32x4*)((u.kh ? O1 : O0) + row * ld + col) = w; } }
    }
};

struct RowSched { int nM, nN, G, c; unsigned abytes, bbytes;
    __device__ __forceinline__ bool next(int i, Unit& u) const { const int L = i * G + c; if (L >= nM * nN) return false; pg8::swz_map(L, nM, nN, u.pm, u.pn); u.aoff = (unsigned)u.pm * abytes; u.boff = (unsigned)u.pn * bbytes; u.kind = 0; u.x0 = u.pm * 256; u.x1 = 0; u.kh = 0; return true; } };

struct MoeSched { int G, c, nN, ksplit, trim; unsigned bexp, bbytes, arow_bytes, khbytes; bool a_slots; int cnt[NE], base[NE];
    __device__ __forceinline__ void init(const unsigned* cw) { int b = 0;
#pragma unroll
        for (int e = 0; e < NE; ++e) { cnt[e] = (int)cw[64 * e]; base[e] = b; b += (cnt[e] + 255) & ~255; } }
    __device__ __forceinline__ bool next(int i, Unit& u) const { int L = i * G + c; int e = 0;
        for (; e < NE; ++e) { const int nu = (((cnt[e] + 255) >> 8) - (e == NE - 1 ? trim : 0)) * nN * ksplit; if (L < nu) break; L -= nu; }
        if (e >= NE) return false;
        int cn = 0, bs = 0;
#pragma unroll
        for (int q = 0; q < NE; ++q) if (q == e) { cn = cnt[q]; bs = base[q]; }
        const int np_ = ((cn + 255) >> 8) - (e == NE - 1 ? trim : 0); const int nt_ = np_ * nN; u.kh = L / nt_; L -= u.kh * nt_;
        pg8::swz_map(L, np_, nN, u.pm, u.pn);
        u.kind = e; u.x1 = cn; u.x0 = bs + u.pm * 256;
        u.aoff = (a_slots ? (unsigned)u.x0 * arow_bytes : 0u) + (unsigned)u.kh * khbytes; u.boff = (unsigned)e * bexp + (unsigned)u.pn * bbytes + (unsigned)u.kh * khbytes; return true; } };
struct MoeTailSched { int G, c, trim, plast, rbase; unsigned bexp;
    __device__ __forceinline__ bool next(int i, Unit& u) const { int L = i * G + c; if (L >= 8 * trim) return false; u.kh = L / (4 * trim); L -= u.kh * 4 * trim;
        u.pm = plast - trim + (L >> 2); u.pn = L & 3; u.kind = NE - 1; u.x1 = 0; u.x0 = rbase + u.pm * 256;
        u.aoff = (unsigned)u.x0 * (unsigned)DFFE + (unsigned)u.kh * (DFFE / 2u); u.boff = (unsigned)(NE - 1) * bexp + (unsigned)u.pn * (256u * DFFE) + (unsigned)u.kh * (DFFE / 2u); return true; } };
struct EpiTail {
    static constexpr bool PERM = true; static constexpr int MIDK = 0;
    bf16_t* O0; bf16_t* Q; int row0;
    __device__ __forceinline__ void operator()(const f32x4 (&acc)[2][2][4][2], const Unit& u, int wr, int wc, int fr, int fq) const {
        asm volatile("" : "+v"(fr), "+v"(fq));
#pragma unroll
        for (int ai = 0; ai < 2; ++ai)
#pragma unroll
            for (int m = 0; m < 4; ++m) { const int row = u.x0 + ai * 128 + wr * 64 + m * 16 + fr;
                bf16_t* dst = u.kh == 0 ? O0 + (size_t)row * D : Q + ((size_t)(u.kh - 1) * TAILQ_ROWS + (size_t)(row - row0)) * D;
#pragma unroll
                for (int bj = 0; bj < 2; ++bj) { const int col = u.pn * 256 + bj * 128 + wc * 32 + 8 * fq; const f32x4 v0 = acc[ai][bj][m][0], v1 = acc[ai][bj][m][1];
                    u32x4 w; w.x = cvt_pk_bf16(v0[0], v0[1]); w.y = cvt_pk_bf16(v0[2], v0[3]); w.z = cvt_pk_bf16(v1[0], v1[1]); w.w = cvt_pk_bf16(v1[2], v1[3]);
                    *(u32x4*)(dst + col) = w; } }
    }
};
struct MoeRows { static constexpr bool GA = true, GB = false; const int* list;
    __device__ __forceinline__ unsigned arow(const Unit& u, int r) const { int idx = u.pm * 256 + r; idx = idx < u.x1 ? idx : u.x1 - 1; return (unsigned)list[u.kind * NL + idx] * (unsigned)D; }
    __device__ __forceinline__ unsigned brow(const Unit&, int) const { return 0u; } };


constexpr int CW_QUEUE = 12288, CW_RDY = 65536;
template <int NG, bool MOE> struct FfnStream {
    int P[NG], rb[NG], cn[NG];
    int f, nNgu, Kdn; unsigned need;
    unsigned* q; volatile LAS unsigned* lw; unsigned* rdy; unsigned* tmo;
    __device__ __forceinline__ void finish_init(int G) { int sacc = 0; f = NG;
#pragma unroll
        for (int g = NG - 1; g >= 0; --g) { if (f == g + 1 && sacc + P[g] * 4 <= G) { sacc += P[g] * 4; f = g; } }
        if (f > NG - 1) f = NG - 1; }
    __device__ __forceinline__ bool decode(int L, SUnit& u) const {
        int pos = L, kind = -1, grp = 0, j = 0;
#pragma unroll
        for (int g = 0; g < NG; ++g) {
            { const int n = P[g] * nNgu; if (kind < 0) { if (pos < n) { kind = 0; grp = g; j = pos; } else pos -= n; } }
            if (g >= 1 && (g - 1) < f) { const int n = P[g - 1] * 4; if (kind < 0) { if (pos < n) { kind = 1; grp = g - 1; j = pos; } else pos -= n; } }
        }
#pragma unroll
        for (int g = 0; g < NG; ++g) if (g >= f) { const int n = P[g] * 4; if (kind < 0) { if (pos < n) { kind = 1; grp = g; j = pos; } else pos -= n; } }
        if (kind < 0) return false;
        int nM = 0, rbase = 0, cnt = 0;
#pragma unroll
        for (int g = 0; g < NG; ++g) if (g == grp) { nM = P[g]; rbase = rb[g]; cnt = cn[g]; }
        const int nN = kind == 0 ? nNgu : 4;
        const int nig = 8 * nN, gid = j / nig, fm = gid * 8, gsz = (nM - fm) < 8 ? (nM - fm) : 8;
        u.pm = fm + ((j % nig) % gsz); u.pn = (j % nig) / gsz; u.kind = kind; u.grp = grp; u.x0 = rbase + u.pm * 256; u.x1 = cnt;
        const int gp = u.x0 >> 8;
        if (kind == 0) { u.K = D; u.dep = -1; u.sig = gp;
            u.aoff = (unsigned)WS_H + (unsigned)u.x0 * (D * 2u);
            u.boff = (MOE ? (unsigned)WS_WGUE + (unsigned)grp * (2u * DFFE * D * 2u) : (unsigned)WS_WGUD) + (unsigned)u.pn * (256u * D * 2u); }
        else { u.K = Kdn; u.dep = gp; u.sig = -1;
            u.aoff = (unsigned)WS_ACT + (unsigned)u.x0 * ((unsigned)Kdn * 2u);
            u.boff = (MOE ? (unsigned)WS_WDE + (unsigned)grp * ((unsigned)D * DFFE * 2u) : (unsigned)WS_WDD) + (unsigned)u.pn * (256u * (unsigned)Kdn * 2u); }
        return true;
    }
    __device__ __forceinline__ void a_ready(const SUnit& u) const {
        if (threadIdx.x < 64) {
            const unsigned long long t0 = __builtin_amdgcn_s_memrealtime(); unsigned polls = 0;
            while ((unsigned)__builtin_amdgcn_readfirstlane(__hip_atomic_load(rdy + 64 * u.dep, __ATOMIC_RELAXED, __HIP_MEMORY_SCOPE_AGENT)) < need) {
                if ((++polls & 255u) == 0u && __builtin_amdgcn_readfirstlane(__hip_atomic_load(tmo, __ATOMIC_RELAXED, __HIP_MEMORY_SCOPE_AGENT)) != 0u) break;
                if (__builtin_amdgcn_s_memrealtime() - t0 > 2000000ull) { if (threadIdx.x == 0) __hip_atomic_store(tmo, 1u, __ATOMIC_RELAXED, __HIP_MEMORY_SCOPE_AGENT); break; }
                __builtin_amdgcn_s_sleep(2); }
            __builtin_amdgcn_fence(__ATOMIC_ACQUIRE, "agent");
            asm volatile("s_waitcnt vmcnt(0)" ::: "memory");
        }
        asm volatile("" ::: "memory"); __builtin_amdgcn_s_barrier(); asm volatile("" ::: "memory");
    }
};
template <bool MOE> struct FfnRows { const int* list;
    __device__ __forceinline__ bool a_gather(const SUnit& u) const { return MOE && u.kind == 0; }
    __device__ __forceinline__ unsigned arow(const SUnit& u, int r) const { int idx = u.pm * 256 + r; idx = idx < u.x1 ? idx : u.x1 - 1; return (unsigned)WS_H + (unsigned)list[u.grp * NL + idx] * (D * 2u); } };

template <bool MOE> struct EpiFfn {
    static constexpr bool PERM = true; static constexpr int MIDK = 0;
    unsigned char* ws; float* xl; const float* mod_l;
    __device__ __forceinline__ void operator()(const f32x4 (&acc)[2][2][4][2], const SUnit& u, int wr, int wc, int fr, int fq) const {
        if (u.kind == 0) {
            constexpr int ld = MOE ? DFFE : DFF0;
            bf16_t* act = (bf16_t*)(ws + WS_ACT);
            const int col = u.pn * 128 + wc * 32 + 8 * fq;
#pragma unroll
            for (int ai = 0; ai < 2; ++ai)
#pragma unroll
                for (int m = 0; m < 4; ++m) { const size_t row = (size_t)(u.x0 + ai * 128 + wr * 64 + m * 16 + fr);
                    float o[8];
#pragma unroll
                    for (int n = 0; n < 2; ++n)
#pragma unroll
                        for (int q = 0; q < 4; ++q) { const float gv = acc[ai][0][m][n][q], uv = acc[ai][1][m][n][q]; o[4 * n + q] = gv * sigmoidf_(gv) * uv; }
                    u32x4 w; w.x = cvt_pk_bf16(o[0], o[1]); w.y = cvt_pk_bf16(o[2], o[3]); w.z = cvt_pk_bf16(o[4], o[5]); w.w = cvt_pk_bf16(o[6], o[7]);
                    pg8::st16_wt(ws, (unsigned)WS_ACT + ((unsigned)row * (unsigned)ld + (unsigned)col) * 2u, w); }
        } else if (MOE) {
            bf16_t* O = (bf16_t*)(ws + WS_DOUT);
#pragma unroll
            for (int ai = 0; ai < 2; ++ai)
#pragma unroll
                for (int m = 0; m < 4; ++m) { const size_t row = (size_t)(u.x0 + ai * 128 + wr * 64 + m * 16 + fr);
#pragma unroll
                    for (int bj = 0; bj < 2; ++bj) { const int col = u.pn * 256 + bj * 128 + wc * 32 + 8 * fq; const f32x4 v0 = acc[ai][bj][m][0], v1 = acc[ai][bj][m][1];
                        u32x4 w; w.x = cvt_pk_bf16(v0[0], v0[1]); w.y = cvt_pk_bf16(v0[2], v0[3]); w.z = cvt_pk_bf16(v1[0], v1[1]); w.w = cvt_pk_bf16(v1[2], v1[3]);
                        *(u32x4*)(O + row * D + col) = w; } }
        } else {
            asm volatile("" : "+v"(fr), "+v"(fq));
            const int pmg = u.x0 >> 8;
            const int v = pmg < 32 ? 0 : (pmg < 64 ? 1 : 2);
            const float* gate = mod_l + v * MODSZ + 5 * D;
            float* xo = pmg < 64 ? xl + (size_t)u.x0 * D : (float*)(ws + WS_XC) + (size_t)(u.x0 - NL) * D;
#pragma unroll
            for (int bj = 0; bj < 2; ++bj) { const int col = u.pn * 256 + bj * 128 + wc * 32 + 8 * fq;
                const f32x4 g0 = *(const f32x4*)(gate + col), g1 = *(const f32x4*)(gate + col + 4);
#pragma unroll
                for (int ai = 0; ai < 2; ++ai)
#pragma unroll
                    for (int m = 0; m < 4; ++m) { const size_t o = (size_t)(ai * 128 + wr * 64 + m * 16 + fr) * D + col;
                        *(f32x4*)(xo + o) = *(const f32x4*)(xo + o) + g0 * acc[ai][bj][m][0];
                        *(f32x4*)(xo + o + 4) = *(const f32x4*)(xo + o + 4) + g1 * acc[ai][bj][m][1];
                        asm volatile("" ::: "memory"); __builtin_amdgcn_sched_barrier(0); } }
        }
    }
};

__device__ __forceinline__ int crow(int r, int hi) { return (r & 3) + 8 * (r >> 2) + 4 * hi; }
__device__ __forceinline__ s16x4 vtr(const LAS unsigned char* p) { typedef short v4i16_t __attribute__((ext_vector_type(4))); return __builtin_bit_cast(s16x4, __builtin_amdgcn_ds_read_tr16_b64_v4i16((LAS v4i16_t*)p)); }

__device__ __forceinline__ void attn_unit(Frame& F, int l, int b, int hkv, int qb, bool ctxq) {
    const int tid = F.tid, lane = F.lane, wid = F.wave, r32 = lane & 31, hi = lane >> 5;
    const int g = wid >> 1, qs = wid & 1, head = hkv * 4 + g;
    const bf16_t* Q = (const bf16_t*)(F.ws + WS_Q); const bf16_t* KB = (const bf16_t*)(F.ws + WS_KB); const bf16_t* VB = (const bf16_t*)(F.ws + WS_VB);
    const int q0 = qb * 64;
    const int qrow = (ctxq ? NL + b * CTXL : b * T) + q0 + qs * 32 + r32;
    bf16x8 qr[4];
#pragma unroll
    for (int d0 = 0; d0 < 4; ++d0) qr[d0] = *(const bf16x8*)(Q + (size_t)qrow * 512 + head * 64 + d0 * 16 + hi * 8);
    int jlo = 0, jhi = -1;
    if (!ctxq) { jlo = -2; jhi = 2; if (q0 + 64 * jlo < 0) jlo = -(q0 / 64); if (q0 + 64 * jhi >= T) jhi = (T - 64 - q0) / 64; }
    const int nloc = jhi - jlo + 1, ntile = nloc + 4;
    const float sinkv = F.in[9][l * 8 + head] * LOG2E;
    float mrun = sinkv, lrun = 1.0f;
    f32x16 o[2]; o[0] = f32x16{}; o[1] = f32x16{};
    const int kkey = lane, vkey = 16 * (wid & 3) + (lane >> 2);
    auto tile_row = [&](int ti) -> int { return ti < nloc ? b * T + q0 + 64 * (jlo + ti) : NL + b * CTXL + 64 * (ti - nloc); };
    u32x4 kreg, vreg;
    { const int r0 = tile_row(0); kreg = *(const u32x4*)(KB + (size_t)(r0 + kkey) * 128 + hkv * 64 + wid * 8); vreg = *(const u32x4*)(VB + (size_t)(r0 + vkey) * 128 + hkv * 64 + (wid >> 2) * 32 + (lane & 3) * 8); }
    for (int ti = 0; ti < ntile; ++ti) {
        LAS unsigned char* slot = F.lds + (ti & 1) * 16384;
        *(LAS u32x4*)(slot + wid * 1024 + lane * 16) = kreg;
        *(LAS u32x4*)(slot + 8192 + wid * 1024 + lane * 16) = vreg;
        __syncthreads();
        if (ti + 1 < ntile) { const int r0 = tile_row(ti + 1); kreg = *(const u32x4*)(KB + (size_t)(r0 + kkey) * 128 + hkv * 64 + wid * 8); vreg = *(const u32x4*)(VB + (size_t)(r0 + vkey) * 128 + hkv * 64 + (wid >> 2) * 32 + (lane & 3) * 8); }
        f32x16 p0 = f32x16{}, p1 = f32x16{};
        { const LAS unsigned char* kb = slot + hi * 1024 + r32 * 16;
#pragma unroll
          for (int d0 = 0; d0 < 4; ++d0) { const bf16x8 k0 = *(const LAS bf16x8*)(kb + d0 * 2048), k1 = *(const LAS bf16x8*)(kb + d0 * 2048 + 512);
              p0 = __builtin_amdgcn_mfma_f32_32x32x16_bf16(k0, qr[d0], p0, 0, 0, 0); p1 = __builtin_amdgcn_mfma_f32_32x32x16_bf16(k1, qr[d0], p1, 0, 0, 0); } }
        if (ti < nloc) { const int j = jlo + ti; const int qq = qs * 32 + r32;
            if (j == -2) {
#pragma unroll
                for (int r = 0; r < 16; ++r) { const int kk = crow(r, hi); if (kk < qq) p0[r] = -INFINITY; if (kk + 32 < qq) p1[r] = -INFINITY; } }
            else if (j == 2) {
#pragma unroll
                for (int r = 0; r < 16; ++r) { const int kk = crow(r, hi); if (kk > qq) p0[r] = -INFINITY; if (kk + 32 > qq) p1[r] = -INFINITY; } } }
        float mx = p0[0];
#pragma unroll
        for (int r = 1; r < 16; ++r) mx = fmaxf(mx, p0[r]);
#pragma unroll
        for (int r = 0; r < 16; ++r) mx = fmaxf(mx, p1[r]);
        mx = fmaxf(mx, __shfl_xor(mx, 32));
        const float mnew = fmaxf(mrun, mx), fsc = __builtin_amdgcn_exp2f(mrun - mnew);
        mrun = mnew;
        float rs = 0.f;
#pragma unroll
        for (int r = 0; r < 16; ++r) { p0[r] = __builtin_amdgcn_exp2f(p0[r] - mnew); p1[r] = __builtin_amdgcn_exp2f(p1[r] - mnew); rs += p0[r] + p1[r]; }
        rs += __shfl_xor(rs, 32);
        lrun = lrun * fsc + rs;
#pragma unroll
        for (int r = 0; r < 16; ++r) { o[0][r] *= fsc; o[1][r] *= fsc; }
        u32x4 pw[4];
        pw[0] = (u32x4){cvt_pk_bf16(p0[0], p0[1]), cvt_pk_bf16(p0[2], p0[3]), cvt_pk_bf16(p0[4], p0[5]), cvt_pk_bf16(p0[6], p0[7])};
        pw[1] = (u32x4){cvt_pk_bf16(p0[8], p0[9]), cvt_pk_bf16(p0[10], p0[11]), cvt_pk_bf16(p0[12], p0[13]), cvt_pk_bf16(p0[14], p0[15])};
        pw[2] = (u32x4){cvt_pk_bf16(p1[0], p1[1]), cvt_pk_bf16(p1[2], p1[3]), cvt_pk_bf16(p1[4], p1[5]), cvt_pk_bf16(p1[6], p1[7])};
        pw[3] = (u32x4){cvt_pk_bf16(p1[8], p1[9]), cvt_pk_bf16(p1[10], p1[11]), cvt_pk_bf16(p1[12], p1[13]), cvt_pk_bf16(p1[14], p1[15])};
        { const LAS unsigned char* vb = slot + 8192 + ((lane >> 4) & 1) * 32 + (lane & 3) * 8 + (4 * hi + ((lane & 15) >> 2)) * 64;
#pragma unroll
          for (int d0 = 0; d0 < 2; ++d0)
#pragma unroll
              for (int ks = 0; ks < 4; ++ks) { const s16x4 lo = vtr(vb + d0 * 4096 + ks * 1024), hh = vtr(vb + d0 * 4096 + ks * 1024 + 512);
                  const bf16x8 vf = (bf16x8){lo[0], lo[1], lo[2], lo[3], hh[0], hh[1], hh[2], hh[3]};
                  o[d0] = __builtin_amdgcn_mfma_f32_32x32x16_bf16(vf, __builtin_bit_cast(bf16x8, pw[ks]), o[d0], 0, 0, 0); } }
    }
    const float rl = 1.0f / lrun;
    bf16_t* orow = (bf16_t*)(F.ws + WS_FO) + (size_t)qrow * KM + 640 + head * 64;
#pragma unroll
    for (int d0 = 0; d0 < 2; ++d0)
#pragma unroll
        for (int rq = 0; rq < 4; ++rq) { u32x2 w; w.x = cvt_pk_bf16(o[d0][4 * rq] * rl, o[d0][4 * rq + 1] * rl); w.y = cvt_pk_bf16(o[d0][4 * rq + 2] * rl, o[d0][4 * rq + 3] * rl);
            *(u32x2*)(orow + 32 * d0 + 8 * rq + 4 * hi) = w; }
    __syncthreads();
}

__device__ __forceinline__ void attn_phase(Frame& F, int l, int part) {
    const int nlat = NB * 2 * 128;
    auto lat_unit = [&](int it) { const int qb = it & 127, hkv = (it >> 7) & 1, b = it >> 8; attn_unit(F, l, b, hkv, qb, false); };
    if (part == 0) {
        const bool extra = (l == 0) && F.G == 256 && ((F.bx >= 16 && F.bx < 24) || F.bx >= 240);
        if (!extra) for (int it = F.bx; it < 256; it += F.G) lat_unit(it);
        if (l == 0) for (int r = (F.bx + F.G - 240) % F.G; r < NB * 2 * 4; r += F.G) { const int qb = r & 3, hkv = (r >> 2) & 1, b = r >> 3; attn_unit(F, l, b, hkv, qb, true); }
    } else {
        const bool busy = (l == 0) && F.bx >= 128 && F.bx < 136;
        if (!busy) for (int it = 256 + F.bx; it < nlat; it += F.G) lat_unit(it);
        if (l == 0 && F.bx >= 136 && F.bx < 144) lat_unit(256 + F.bx - 8);
        if (l == 0 && F.G == 256 && F.bx >= 144 && F.bx < 168) { const int k = F.bx - 144; lat_unit(k < 8 ? 16 + k : 240 + (k - 8)); }
    }
}

#if !MK_MULTI
#define GRID_BAR() xcd_barrier(bar)
#else
#define GRID_BAR() do {} while (0)
#endif
#ifndef PH_MASK
#define PH_MASK 0xFFFFFu
#endif
#define IN(k) (((PH_MASK >> (k)) & 1u) && lo <= (k) && (k) < hi)
#define SEAM(k) do { if (IN((k) + 1)) GRID_BAR(); } while (0)
#ifndef REP_MASK
#define REP_MASK 0u
#endif
#define REPS(k) ((((REP_MASK) >> (k)) & 1u) ? 2 : 1)
template <int l, class BarT>
__device__ __forceinline__ void layer_phases(Frame& F, unsigned* ctl, const int lo, const int hi, const BarT& bar) {
        const int pb = 1 + 8 * l;
        bf16_t* H = (bf16_t*)(F.ws + WS_H);
        const float* xl_in = l == 0 ? F.in[0] : nullptr;
        bf16_t* XB = (bf16_t*)(F.ws + WS_XB);
        const float* xc_in = l == 0 ? F.in[2] : (const float*)(F.ws + WS_XC);
        float* xc = (float*)(F.ws + WS_XC);
        const float* mod_l = (const float*)ctl + CW_MOD + l * 3 * MODSZ;
        if (IN(pb + 0)) { for (int rep = 0; rep < REPS(pb + 0); ++rep) norm_phase<false, 3>(F, l, 0, xl_in, xc_in, NTOK, l == 1 ? (const float*)(F.ws + WS_TMPC2) : nullptr, nullptr); SEAM(pb + 0); }
        if (IN(pb + 1)) {
            for (int rep = 0; rep < REPS(pb + 1); ++rep) {
            { pg8::Gemm g{(const bf16_t*)(F.ws + WS_H8), (const bf16_t*)(F.ws + (l ? WS_WIN1 : WS_WIN0)) + (size_t)512 * D, D / 2, D / 2}; InprojSched S{F.G, F.bx, l}; EpiInproj E{F.ws, (const float*)(F.ws + WS_RS), (const float*)(F.ws + WS_CSI) + l * 2816}; pg8::NoGather R;
              pg8::gemm_phasei8(F.lds, g, S, E, R); }
            { pg8::Gemm g{(const bf16_t*)(F.ws + (l ? WS_WIN1 : WS_WIN0)), H, D, D}; UpermSched S{F.G, F.bx, l}; EpiUperm E{F.ws}; UpermRows R;
              pg8::gemm_phase(F.lds, g, S, E, R); }
            }
            SEAM(pb + 1);
        }
        if (IN(pb + 2)) {
            for (int rep = 0; rep < REPS(pb + 2); ++rep) {
            attn_phase(F, l, 0);
            { pg8::Gemm g{(const bf16_t*)(F.ws + WS_UP), (const bf16_t*)(F.ws + WS_FA64), 128, 128}; StepASched S{F.G, F.bx, l}; EpiStepA E{F.ws}; pg8::NoGather R;
              pg8::gemm_phase(F.lds, g, S, E, R); }
            if (l == 0) { pg8::Gemm g{(const bf16_t*)(F.ws + WS_VCT), (const bf16_t*)(F.ws + WS_TX), 512, 512}; GridSched S{2, 2, F.G, (F.bx + F.G - 16) % F.G, 256u * 512u * 2u, 256u * 512u * 2u}; EpiStepC<true> E{F.ws}; pg8::NoGather R;
              pg8::gemm_phase(F.lds, g, S, E, R); }
            }
            SEAM(pb + 2);
        }
        if (IN(pb + 3)) {
            for (int rep = 0; rep < REPS(pb + 3); ++rep) {
            { pg8::Gemm g{(const bf16_t*)(F.ws + WS_GP), (const bf16_t*)(F.ws + WS_TC), 256, 256}; GridSched S{128, 1, F.G, F.bx, 256u * 256u * 2u, 0u}; EpiStepC<false> E{F.ws}; pg8::NoGather R;
              pg8::gemm_phase(F.lds, g, S, E, R); }
            if (l == 0) { pg8::Gemm g{(const bf16_t*)(F.ws + WS_FO), (const bf16_t*)(F.ws + WS_WM0), KM, KM}; CtxSched S{F.G, (F.bx + F.G - 128) % F.G, 4, 256u * KM * 2u, 256u * KM * 2u, 1, 0u}; EpiMerge E{F.ws}; pg8::NoGather R;
              pg8::gemm_phase(F.lds, g, S, E, R); }
            attn_phase(F, l, 1);
            }
            SEAM(pb + 3);
        }
        if (IN(pb + 4)) {
            const int nM = 64;
            pg8::Gemm g{(const bf16_t*)(F.ws + WS_FO), (const bf16_t*)(F.ws + (l ? WS_WM1 : WS_WM0)), KM, KM}; GridSched S{nM, 4, F.G, F.bx, 256u * KM * 2u, 256u * KM * 2u}; EpiMerge E{F.ws}; pg8::NoGather R;
            for (int rep = 0; rep < REPS(pb + 4); ++rep) pg8::gemm_phase(F.lds, g, S, E, R);
            SEAM(pb + 4);
        }
        if (IN(pb + 5)) {
            EpiResid E{xl_in, XB, XB, xc_in, xc, mod_l, 2, (float*)(F.ws + WS_TMPC1)}; pg8::NoGather R;
            for (int rep = 0; rep < (l == 0 ? REPS(6) : 1); ++rep)
            { pg8::Gemm g{(const bf16_t*)(F.ws + WS_Y), (const bf16_t*)(F.ws + (l ? WS_WO1 : WS_WO0)), D, D}; GridSched S{64, 4, F.G, F.bx, 256u * D * 2u, 256u * D * 2u};
              pg8::gemm_phase(F.lds, g, S, E, R); }
            if (l == 0) { pg8::Gemm g{(const bf16_t*)(F.ws + WS_Y), (const bf16_t*)(F.ws + WS_WO0), D / 2, D}; CtxSched S{F.G, F.bx, 4, 256u * D * 2u, 256u * D * 2u, 2, (unsigned)D};
              pg8::gemm_phase(F.lds, g, S, E, R); }
            SEAM(pb + 5);
        }
        if (IN(pb + 6)) {
            if (l == 0) norm_phase<false, 2>(F, l, 1, nullptr, xc, NTOK, (const float*)(F.ws + WS_TMPC1), xc); else { norm_phase<true>(F, l, 1, nullptr, xc, NL); for (int rep = 0; rep < REPS(21); ++rep) moe_convert_all(F); }
            SEAM(pb + 6);
        }
#ifndef STREAM0
#define STREAM0 0
#endif
#ifndef STREAM1
#define STREAM1 0
#endif
        if (IN(pb + 7)) {
            volatile LAS unsigned* lw = (volatile LAS unsigned*)(F.lds + MISC_OFF) + 16;
            if (l == 0) {
#if STREAM0
                FfnStream<9, false> S;
#pragma unroll
                for (int g = 0; g < 9; ++g) { S.P[g] = g < 8 ? 8 : 2; S.rb[g] = 2048 * g; S.cn[g] = g < 8 ? 2048 : 512; }
                S.nNgu = 22; S.Kdn = DFF0; S.need = 22u * 8u; S.q = ctl + CW_QUEUE; S.lw = lw; S.rdy = ctl + CW_RDY; S.tmo = ctl + 2; S.finish_init(F.G);
                EpiFfn<false> E{F.ws, F.out, mod_l}; FfnRows<false> R{nullptr};
                pg8::gemm_stream(F.lds, (const char*)F.ws, S, E, R);
#else
                for (int rep = 0; rep < REPS(18); ++rep)
                { pg8::Gemm g{H, (const bf16_t*)(F.ws + WS_WGUD), D / 2, D / 2}; RowSched S{66, 22, F.G, F.bx, 256u * D, 256u * D}; EpiSwigluI8 E{(bf16_t*)(F.ws + WS_ACT), DFF0, (const float*)(F.ws + WS_RS), (const float*)(F.ws + WS_CSD)}; pg8::NoGather R;
                  pg8::gemm_phasei8(F.lds, g, S, E, R); }
                GRID_BAR();
                { EpiResid E{nullptr, XB, XB, xc, xc, mod_l, 5, (float*)(F.ws + WS_TMPC2)}; pg8::NoGather R;
                  { pg8::Gemm g{(const bf16_t*)(F.ws + WS_ACT), (const bf16_t*)(F.ws + WS_WDD), DFF0, DFF0}; GridSched S{64, 4, F.G, F.bx, 256u * DFF0 * 2u, 256u * DFF0 * 2u};
                    pg8::gemm_phase(F.lds, g, S, E, R); }
                  { pg8::Gemm g{(const bf16_t*)(F.ws + WS_ACT), (const bf16_t*)(F.ws + WS_WDD), DFF0 / 2, DFF0}; CtxSched S{F.G, F.bx, 4, 256u * DFF0 * 2u, 256u * DFF0 * 2u, 2, (unsigned)DFF0};
                    pg8::gemm_phase(F.lds, g, S, E, R); } }

#endif
            } else {
#if STREAM1
                FfnStream<8, true> S; { int bacc = 0;
#pragma unroll
                for (int e = 0; e < NE; ++e) { const int c = (int)ctl[CW_CNT + 64 * e]; S.cn[e] = c; S.P[e] = (c + 255) >> 8; S.rb[e] = bacc; bacc += ((c + 255) >> 8) << 8; } }
                S.nNgu = 28; S.Kdn = DFFE; S.need = 28u * 8u; S.q = ctl + CW_QUEUE + 64; S.lw = lw; S.rdy = ctl + CW_RDY + 64 * 80; S.tmo = ctl + 2; S.finish_init(F.G);
                EpiFfn<true> E{F.ws, F.out, mod_l}; FfnRows<true> R{(const int*)(F.ws + WS_LIST)};
                pg8::gemm_stream(F.lds, (const char*)F.ws, S, E, R);
#else
                for (int rep = 0; rep < REPS(19); ++rep)
                { pg8::Gemm g{H, (const bf16_t*)(F.ws + WS_WGUE), D / 2, D / 2}; MoeSched S; S.G = F.G; S.c = F.bx; S.nN = 28; S.ksplit = 1; S.trim = 0; S.khbytes = 0; S.bexp = 2u * DFFE * D; S.bbytes = 256u * D; S.arow_bytes = 0; S.a_slots = false; S.init(ctl + CW_CNT);
                  EpiSwiglu8 E{F.ws + WS_ACT, DFFE}; MoeRows R{(const int*)(F.ws + WS_LIST)};
                  pg8::gemm_phase8(F.lds, g, S, E, R); }
                GRID_BAR();
                { const int trim = moe_tail_panels(ctl + CW_CNT, F.G);
                  MoeSched S; S.G = F.G; S.c = F.bx; S.nN = 4; S.ksplit = 1; S.trim = trim; S.khbytes = 0; S.bexp = (unsigned)D * DFFE; S.bbytes = 256u * DFFE; S.arow_bytes = (unsigned)DFFE; S.a_slots = true; S.init(ctl + CW_CNT);
                  for (int rep = 0; rep < REPS(20); ++rep)
                  { pg8::Gemm g{(const bf16_t*)(F.ws + WS_ACT), (const bf16_t*)(F.ws + WS_WDE), DFFE / 2, DFFE / 2};
                    EpiBf16 E{(bf16_t*)(F.ws + WS_DOUT), (bf16_t*)(F.ws + WS_DOUT), D}; pg8::NoGather R;
                    pg8::gemm_phase8(F.lds, g, S, E, R); }
                  for (int rep = 0; rep < REPS(23); ++rep)
                  if (trim > 0) {
                    const int plast = (S.cnt[NE - 1] + 255) >> 8;
                    pg8::Gemm g{(const bf16_t*)(F.ws + WS_ACT), (const bf16_t*)(F.ws + WS_WDE), DFFE / 4, DFFE / 2};
                    MoeTailSched T{F.G, F.bx, trim, plast, S.base[NE - 1], (unsigned)D * DFFE};
                    EpiTail E{(bf16_t*)(F.ws + WS_DOUT), (bf16_t*)(F.ws + WS_DOUT1), S.base[NE - 1] + (plast - trim) * 256}; pg8::NoGather R;
                    pg8::gemm_phase8(F.lds, g, T, E, R); } }
#endif
            }
            SEAM(pb + 7);
        }
}

constexpr int NPHASE = 18;
__global__ void __launch_bounds__(NTHR, 2) fwd_kernel(Args args) {
    extern __shared__ __attribute__((aligned(16))) unsigned char lds_raw[];
    Frame F;
    F.lds = (LAS unsigned char*)lds_raw; F.ws = args.ws; F.in = args.in; F.out = args.out;
    F.tid = threadIdx.x; F.lane = F.tid & 63; F.wave = __builtin_amdgcn_readfirstlane(F.tid >> 6); F.G = gridDim.x; F.bx = blockIdx.x;
    volatile LAS unsigned* MISC = (volatile LAS unsigned*)(F.lds + MISC_OFF);
    if (F.tid < 32) MISC[F.tid] = 0u;
    __syncthreads();
    unsigned* ctl = (unsigned*)(F.ws + WS_CTL);
#if !MK_MULTI
    XcdBarrier bar = xcd_barrier_post(ctl + CW_BAR, MISC + 8);
#else
    XcdBarrier bar; bar.bar = ctl + CW_BAR; bar.x = 0; bar.st = MISC + 8;
#endif
    const int lo = args.ph_lo, hi = args.ph_hi;
    if (IN(0)) { for (int rep = 0; rep < REPS(0); ++rep) { p0_prologue(F); __syncthreads(); } SEAM(0); }
    layer_phases<0>(F, ctl, lo, hi, bar);
    layer_phases<1>(F, ctl, lo, hi, bar);
    if (IN(17)) for (int rep = 0; rep < REPS(17); ++rep) final_phase(F);
}

extern "C" void kernel_launch(void* const* d_in, const int* in_sizes, int n_in, void* d_out, int out_size, void* d_ws, size_t ws_size, hipStream_t stream) {
    static int grid = 0;
    if (grid == 0) {
        if (n_in != 21 || out_size != NL * D || ws_size < WS_END) { fprintf(stderr, "kernel_launch: unexpected problem (n_in %d out %d ws %zu)\n", n_in, out_size, ws_size); grid = -1; return; }
        int dev = 0, cus = 0;
        hipGetDevice(&dev); hipDeviceGetAttribute(&cus, hipDeviceAttributeMultiprocessorCount, dev);
        if (hipFuncSetAttribute((const void*)fwd_kernel, hipFuncAttributeMaxDynamicSharedMemorySize, LDS_BYTES) != hipSuccess) { fprintf(stderr, "kernel_launch: hipFuncSetAttribute failed\n"); grid = -1; return; }
        int per_cu = 0; (void)hipOccupancyMaxActiveBlocksPerMultiprocessor(&per_cu, (const void*)fwd_kernel, NTHR, LDS_BYTES); (void)hipGetLastError();
        grid = cus;
    }
    if (grid < 0) return;
    hipMemsetAsync((char*)d_ws + WS_CTL, 0, CTL_BYTES, stream);
#ifdef DBG_SCRUB
    hipMemsetAsync((char*)d_ws + CTL_BYTES, 0, WS_END - CTL_BYTES, stream);
#endif
    Args a{};
    for (int i = 0; i < 21; ++i) a.in[i] = (const float*)d_in[i];
    a.out = (float*)d_out; a.ws = (unsigned char*)d_ws;
#if MK_MULTI
    for (int p = 0; p < NPHASE; ++p) { a.ph_lo = p; a.ph_hi = p + 1; hipLaunchKernelGGL(fwd_kernel, dim3(grid), dim3(NTHR), LDS_BYTES, stream, a); }
#else
    a.ph_lo = 0; a.ph_hi = NPHASE;
    hipLaunchKernelGGL(fwd_kernel, dim3(grid), dim3(NTHR), LDS_BYTES, stream, a);
#endif
}
```

```cpp
#include <hip/hip_runtime.h>
#include <cstdio>
#include <cstdint>

#define LAS __attribute__((address_space(3)))
#define GAS __attribute__((address_space(1)))
typedef unsigned short bf16_t;
typedef short bf16x8 __attribute__((ext_vector_type(8)));
typedef short s16x4 __attribute__((ext_vector_type(4)));
typedef float f32x4 __attribute__((ext_vector_type(4)));
typedef float f32x2 __attribute__((ext_vector_type(2)));
typedef float f32x16 __attribute__((ext_vector_type(16)));
typedef unsigned u32x4 __attribute__((ext_vector_type(4)));
typedef unsigned u32x2 __attribute__((ext_vector_type(2)));

#ifndef MK_MULTI
#define MK_MULTI 0
#endif

constexpr int D = 1024, T = 8192, NB = 2, NL = NB * T, CTXL = 256, NC = NB * CTXL, NTOK = NL + NC;
constexpr int INW = 3328, OFFQ = 512, OFFK = 1024, OFFV = 1152, OFFG = 1280;
constexpr int DFF0 = 2816, DFFE = 3584, NE = 8;
constexpr int KM = 1152;
constexpr int MOE_ROWS = 2 * NL + NE * 256;
constexpr float EPS = 1e-6f;
constexpr float LOG2E = 1.4426950408889634f;
constexpr float QSCALE = 0.125f * LOG2E;

constexpr size_t MiB = 1u << 20, KiB = 1u << 10;
constexpr size_t WS_CTL = 0, CTL_BYTES = 1 * MiB;
constexpr size_t WS_ROPE = 1 * MiB, WS_TW = WS_ROPE + 32 * KiB, WS_FA64 = WS_ROPE + 96 * KiB, WS_TC = WS_ROPE + 160 * KiB, WS_TX = WS_ROPE + 288 * KiB;
constexpr size_t WS_H8 = 452 * MiB;
constexpr size_t WS_CSI = WS_ROPE + 936 * KiB;
constexpr size_t WS_RS = WS_ROPE + 832 * KiB, WS_CSD = WS_ROPE + 912 * KiB;
constexpr size_t WS_TOKE = 2 * MiB, WS_TOKR = WS_TOKE + 128 * KiB, WS_TOKW = WS_TOKE + 256 * KiB, WS_LIST = WS_TOKE + 384 * KiB;
constexpr size_t WS_XC = 3 * MiB, WS_VCT = 5 * MiB;
constexpr size_t WS_WIN0 = 6 * MiB, WS_WM0 = WS_WIN0 + 13 * MiB / 2, WS_WO0 = 17 * MiB, WS_WGUD = 19 * MiB, WS_WDD = 30 * MiB;
constexpr size_t WS_WIN1 = 36 * MiB, WS_WM1 = WS_WIN1 + 13 * MiB / 2, WS_WO1 = 47 * MiB;
constexpr size_t WS_H = 49 * MiB;
constexpr size_t WS_DOUT = 6 * MiB;
constexpr size_t WS_WGUE = 82 * MiB, WS_WDE = 194 * MiB;
constexpr size_t WS_DOUT1 = WS_WGUE;
constexpr size_t WS_R1 = 250 * MiB;
constexpr size_t WS_UP = WS_R1, WS_Q = 266 * MiB, WS_KB = 283 * MiB, WS_VB = 288 * MiB, WS_GF = 293 * MiB, WS_GA = 326 * MiB, WS_GP = 359 * MiB, WS_FO = 375 * MiB, WS_Y = 413 * MiB;
constexpr size_t WS_ACT = WS_R1;
constexpr size_t WS_TMPC1 = 446 * MiB, WS_TMPC2 = 448 * MiB;
constexpr size_t WS_XB = 490 * MiB;
constexpr size_t WS_END = 523 * MiB;
static_assert(WS_DOUT + (size_t)MOE_ROWS * D * 2 <= WS_WGUE, "DOUT overlay");
static_assert(WS_ACT + (size_t)MOE_ROWS * DFFE * 2 <= WS_END, "ACT");
static_assert(WS_FO + (size_t)NTOK * KM * 2 <= WS_Y, "FO");
constexpr int CW_BAR = 4096, CW_CNT = 8192, CW_MOD = 16384;
constexpr int MODSZ = 6 * D;

constexpr int RING_BYTES = 131072, MISC_OFF = RING_BYTES + 320, LDS_BYTES = 147456;
constexpr int NWAVES = 8, NTHR = 512;

__device__ __forceinline__ unsigned f2bf(float f) { unsigned u = __builtin_bit_cast(unsigned, f); return (u + 0x7fffu + ((u >> 16) & 1u)) >> 16; }
__device__ __forceinline__ unsigned pk2(float lo, float hi) { return f2bf(lo) | (f2bf(hi) << 16); }
__device__ __forceinline__ unsigned pk4f8(float a, float b, float c, float d) { int w = __builtin_amdgcn_cvt_pk_fp8_f32(a, b, 0, false); w = __builtin_amdgcn_cvt_pk_fp8_f32(c, d, w, true); return (unsigned)w; }
__device__ __forceinline__ unsigned cvt_pk_bf16(float lo, float hi) { unsigned r; asm volatile("v_cvt_pk_bf16_f32 %0, %1, %2" : "=v"(r) : "v"(lo), "v"(hi)); return r; }
__device__ __forceinline__ unsigned pk4i8(float a, float b, float c, float d, float sc) {
    const unsigned ua = __builtin_bit_cast(unsigned, fmaf(a, sc, 12582912.0f)), ub = __builtin_bit_cast(unsigned, fmaf(b, sc, 12582912.0f)), uc = __builtin_bit_cast(unsigned, fmaf(c, sc, 12582912.0f)), ud = __builtin_bit_cast(unsigned, fmaf(d, sc, 12582912.0f));
    return (ua & 0xffu) | ((ub & 0xffu) << 8) | ((uc & 0xffu) << 16) | (ud << 24); }
__device__ __forceinline__ float wave_max(float v) {
#pragma unroll
    for (int o = 1; o < 64; o <<= 1) v = fmaxf(v, __shfl_xor(v, o));
    return v;
}
__device__ __forceinline__ float bf2f(unsigned short h) { return __builtin_bit_cast(float, (unsigned)h << 16); }
__device__ __forceinline__ float bflo(unsigned w) { return __builtin_bit_cast(float, w << 16); }
__device__ __forceinline__ float bfhi(unsigned w) { return __builtin_bit_cast(float, w & 0xffff0000u); }
__device__ __forceinline__ float wave_sum(float v) {
#pragma unroll
    for (int o = 1; o < 64; o <<= 1) v += __shfl_xor(v, o);
    return v;
}
__device__ __forceinline__ float sigmoidf_(float x) { return __builtin_amdgcn_rcpf(1.0f + __builtin_amdgcn_exp2f(-x * LOG2E)); }
#define LDS_WAIT() asm volatile("s_waitcnt lgkmcnt(0)" ::: "memory")
#define VM_WAIT() asm volatile("s_waitcnt vmcnt(0)" ::: "memory")

#define XB_TMO      128
#define XB_XCNT(j)  (256  + 64 * (j))
#define XB_XSUB(j)  (1280 + 64 * (j))
#define XB_XGEN(j)  (2304 + 64 * (j))
#define XB_TOP      3328
#define XB_TOPGEN   3392
#define XCD_BAR_WORDS 3456
#define XB_SPIN_CAP (1u << 18)
__device__ __forceinline__ unsigned xb_ld(unsigned* p)              { return __hip_atomic_load(p, __ATOMIC_RELAXED, __HIP_MEMORY_SCOPE_AGENT); }
__device__ __forceinline__ unsigned xb_add(unsigned* p, unsigned v) { return __hip_atomic_fetch_add(p, v, __ATOMIC_RELAXED, __HIP_MEMORY_SCOPE_AGENT); }
__device__ __forceinline__ unsigned xb_xcc_id() { return (unsigned)__builtin_amdgcn_s_getreg((3 << 11) | 20) & 0xFu; }
#define XB_SPIN(cond, bar) do { unsigned _sp = 0; while (cond) { __builtin_amdgcn_s_sleep(1); \
    if ((++_sp & 255u) == 0u) { if (xb_ld(&(bar)[XB_TMO])) break; if (_sp > XB_SPIN_CAP) { atomicAdd(&(bar)[XB_TMO], 1u); break; } } } } while (0)
struct XcdBarrier { unsigned* bar; unsigned x; volatile LAS unsigned* st; };
__device__ __forceinline__ XcdBarrier xcd_barrier_post(unsigned* bar, volatile LAS unsigned* st) {
    XcdBarrier b; b.bar = bar; b.x = xb_xcc_id(); b.st = st;
    if (threadIdx.x == 0) (void)xb_add(&bar[XB_XCNT(b.x)], 1u);
    return b;
}
__device__ __forceinline__ void xcd_barrier_complete(unsigned* bar, unsigned x, unsigned& nloc, unsigned& nx) {
    const unsigned G = gridDim.x * gridDim.y * gridDim.z;
    unsigned sum, cnt, mine, sp = 0u;
    for (;;) {
        sum = 0u; cnt = 0u; mine = 0u;
#pragma unroll
        for (unsigned j = 0; j < 16; ++j) { const unsigned c = xb_ld(&bar[XB_XCNT(j)]); sum += c; cnt += (c > 0u) ? 1u : 0u; mine = (j == x) ? c : mine; }
        if (sum == G) break;
        __builtin_amdgcn_s_sleep(1);
        if ((++sp & 255u) == 0u) { if (xb_ld(&bar[XB_TMO])) break; if (sp > XB_SPIN_CAP) { atomicAdd(&bar[XB_TMO], 1u); break; } }
    }
    nloc = mine > 0u ? mine : 1u; nx = cnt > 0u ? cnt : 1u;
}
__device__ __forceinline__ void xcd_barrier(const XcdBarrier& b) {
    asm volatile("s_waitcnt vmcnt(0)" ::: "memory");
    __syncthreads();
    if (threadIdx.x == 0) {
        unsigned* bar = b.bar;
        __builtin_amdgcn_s_waitcnt(0);
        unsigned nloc = b.st[0], nx = b.st[1];
        if (nloc == 0u) { xcd_barrier_complete(bar, b.x, nloc, nx); b.st[0] = nloc; b.st[1] = nx; }
        const unsigned old = xb_add(&bar[XB_XSUB(b.x)], 1u);
        const unsigned gen = old / nloc;
        if (old + 1u == (gen + 1u) * nloc) {
            __builtin_amdgcn_fence(__ATOMIC_RELEASE, "agent");
            asm volatile("s_waitcnt vmcnt(0)" ::: "memory");
            const unsigned og = xb_add(&bar[XB_TOP], 1u);
            const unsigned tg = og / nx;
            if (og + 1u == (tg + 1u) * nx) xb_add(&bar[XB_TOPGEN], 1u);
            else XB_SPIN(xb_ld(&bar[XB_TOPGEN]) == tg, bar);
            __builtin_amdgcn_fence(__ATOMIC_ACQUIRE, "agent");
            xb_add(&bar[XB_XGEN(b.x)], 1u);
            asm volatile("s_waitcnt vmcnt(0)" ::: "memory");
        } else {
            XB_SPIN(xb_ld(&bar[XB_XGEN(b.x)]) == gen, bar);
            __builtin_amdgcn_fence(__ATOMIC_ACQUIRE, "agent");
            asm volatile("s_waitcnt vmcnt(0)" ::: "memory");
        }
    }
    __syncthreads();
}

#ifndef QGU
#define QGU 32
#endif
#ifndef QDN
#define QDN 64
#endif
#ifndef QACT
#define QACT 16
#endif
namespace pg8 {
constexpr int BM = 256, BK = 64, HALF = 128, HTB = HALF * BK * 2, STAGE_BYTES = 8 * HTB, NXCD = 8, WGM = 8;
__host__ __device__ __forceinline__ int lds_byte(int r, int c) { const int st = (r >> 4) * 2 + (c >> 5), rr = r & 15, cc = c & 31, ob = rr * 64 + cc * 2; return st * 1024 + (ob ^ (((ob >> 9) & 1) << 5)); }
__host__ __device__ __forceinline__ void stage_rc(int b, int& R, int& C) { const int st = b / 1024, sb = b % 1024, swz = sb ^ (((sb >> 9) & 1) << 5); R = (st >> 1) * 16 + swz / 64; C = (st & 1) * 32 + (swz % 64) / 2; }
__host__ __device__ __forceinline__ int perm32(int rho) { const int n = rho >> 4, i = rho & 15; return 8 * (i >> 2) + 4 * n + (i & 3); }

typedef int i32x8 __attribute__((ext_vector_type(8)));
typedef int i32x4 __attribute__((ext_vector_type(4)));
__device__ __forceinline__ i32x8 cat8(bf16x8 a, bf16x8 b) { return __builtin_shufflevector(__builtin_bit_cast(i32x4, a), __builtin_bit_cast(i32x4, b), 0, 1, 2, 3, 4, 5, 6, 7); }
struct Unit { unsigned aoff, boff; int pm, pn, kind, x0, x1, kh; };
struct Gemm { const bf16_t* A; const bf16_t* Bt; int K; int ld; };

__device__ __forceinline__ void swz_map(int L, int nM, int nN, int& pm, int& pn) {
    const int nwg = nM * nN; int wgid = L;
    { const int q = nwg / NXCD, r = nwg % NXCD, xcd = wgid % NXCD, off = wgid / NXCD; wgid = (xcd < r ? xcd * (q + 1) : r * (q + 1) + (xcd - r) * q) + off; }
    const int nig = WGM * nN, gid = wgid / nig, fm = gid * WGM, gsz = (nM - fm) < WGM ? (nM - fm) : WGM;
    pm = fm + ((wgid % nig) % gsz); pn = (wgid % nig) / gsz;
}

struct NoGather { static constexpr bool GA = false, GB = false;
    __device__ __forceinline__ unsigned arow(const Unit&, int) const { return 0u; }
    __device__ __forceinline__ unsigned brow(const Unit&, int) const { return 0u; } };

template <int F8, class Epi, class Sched, class Rows>
__device__ __forceinline__ void gemm_phase_t(LAS unsigned char* lds, const Gemm g, const Sched& S, const Epi& E, const Rows& RW) {
    int tid_ = threadIdx.x; asm volatile("" : "+v"(tid_));
    const int tid = tid_, wid = __builtin_amdgcn_readfirstlane(tid >> 6), lane = tid & 63, wr = wid >> 2, wc = wid & 3, fr = lane & 15, fq = lane >> 4;
    int K_ = g.K; asm volatile("" : "+s"(K_));
    const int K = K_, nt = K / BK;
    int sR[2], sRb[2], sC[2];
#pragma unroll
    for (int i = 0; i < 2; ++i) { int R, C; stage_rc(tid * 16 + i * 8192, R, C); sR[i] = R; sC[i] = C; sRb[i] = (R & ~31) + perm32(R & 31); }
    unsigned voffA[2], voffB[2];
    const int LD = g.ld;
#pragma unroll
    for (int i = 0; i < 2; ++i) { voffA[i] = (unsigned)(sR[i] * LD + sC[i]) * 2u; voffB[i] = (unsigned)(sRb[i] * LD + sC[i]) * 2u; }
    const size_t kstep = (size_t)(BK * 2);
    const size_t hstep = (size_t)HALF * LD * 2;
    const unsigned ldsw = (unsigned)wid * 1024u;
    const int aoff = lds_byte(wr * 64 + fr, fq * 8), boff = lds_byte(wc * 32 + fr, fq * 8);
    constexpr int NTHR_ = 512;
    LAS unsigned* stash = (LAS unsigned*)(lds + 131072 + 320 + 1024) + tid;
    struct Side { const char* base[2]; unsigned off[2][2]; };
#define PG8_SA(b, h) (((b) * 2 + (h)) * HTB)
#define PG8_SB(b, h) ((4 + (b) * 2 + (h)) * HTB)
#define PG8_STAGE(bufoff, side, h, kt) do { _Pragma("unroll") for (int _i = 0; _i < 2; ++_i) { unsigned _o = (side).off[h][_i]; asm volatile("" : "+v"(_o)); \
        __builtin_amdgcn_global_load_lds((const unsigned*)((side).base[h] + (size_t)(kt) * kstep + _o), (LAS unsigned*)(lds + (bufoff) + ldsw + _i * 8192), 16, 0, 0); } } while (0)
#define PG8_LDA(dst, b, h) do { _Pragma("unroll") for (int m = 0; m < 4; ++m) _Pragma("unroll") for (int k = 0; k < 2; ++k) dst[m][k] = *(const LAS bf16x8*)(lds + PG8_SA(b, h) + aoff + m * 2048 + k * 1024); } while (0)
#define PG8_LDB(dst, b, h) do { _Pragma("unroll") for (int n = 0; n < 2; ++n) _Pragma("unroll") for (int k = 0; k < 2; ++k) dst[n][k] = *(const LAS bf16x8*)(lds + PG8_SB(b, h) + boff + n * 2048 + k * 1024); } while (0)
#define PG8_MMA(ai, bj, At, Bt) do { __builtin_amdgcn_s_setprio(1); _Pragma("unroll") for (int m = 0; m < 4; ++m) _Pragma("unroll") for (int n = 0; n < 2; ++n) { \
        if constexpr (F8 == 1) acc[ai][bj][m][n] = __builtin_amdgcn_mfma_scale_f32_16x16x128_f8f6f4(cat8(Bt[n][0], Bt[n][1]), cat8(At[m][0], At[m][1]), acc[ai][bj][m][n], 0, 0, 0, 0, 0, 0); \
        else if constexpr (F8 == 2) { _Pragma("unroll") for (int k = 0; k < 2; ++k) acc[ai][bj][m][n] = __builtin_bit_cast(f32x4, __builtin_amdgcn_mfma_i32_16x16x64_i8(__builtin_bit_cast(i32x4, Bt[n][k]), __builtin_bit_cast(i32x4, At[m][k]), __builtin_bit_cast(i32x4, acc[ai][bj][m][n]), 0, 0, 0)); } \
        else { _Pragma("unroll") for (int k = 0; k < 2; ++k) acc[ai][bj][m][n] = __builtin_amdgcn_mfma_f32_16x16x32_bf16(Bt[n][k], At[m][k], acc[ai][bj][m][n], 0, 0, 0); } } __builtin_amdgcn_s_setprio(0); } while (0)
#define PG8_WAIT_V(n) asm volatile("s_waitcnt vmcnt(" #n ")" ::: "memory")
#define PG8_WAIT_L(n) asm volatile("s_waitcnt lgkmcnt(" #n ")" ::: "memory")
#define PG8_BAR __builtin_amdgcn_s_barrier()
#define PG8_SCHED __builtin_amdgcn_sched_barrier(0)
#define PG8_MKSIDES(u, sa, sb) do { \
        if constexpr (Rows::GA) { sa.base[0] = sa.base[1] = (const char*)g.A; int t2_ = tid; asm volatile("" : "+v"(t2_)); _Pragma("unroll") for (int i = 0; i < 2; ++i) { int R_, C_; stage_rc(t2_ * 16 + i * 8192, R_, C_); \
            _Pragma("unroll") for (int h = 0; h < 2; ++h) sa.off[h][i] = RW.arow(u, h * HALF + R_) + (unsigned)C_ * 2u; } } \
        else { sa.base[0] = (const char*)g.A + (u).aoff; sa.base[1] = sa.base[0] + hstep; _Pragma("unroll") for (int h = 0; h < 2; ++h) _Pragma("unroll") for (int i = 0; i < 2; ++i) sa.off[h][i] = voffA[i]; } \
        if constexpr (Rows::GB) { sb.base[0] = sb.base[1] = (const char*)g.Bt; _Pragma("unroll") for (int h = 0; h < 2; ++h) _Pragma("unroll") for (int i = 0; i < 2; ++i) sb.off[h][i] = RW.brow(u, h * HALF + sRb[i]) + (unsigned)sC[i] * 2u; } \
        else { sb.base[0] = (const char*)g.Bt + (u).boff; sb.base[1] = sb.base[0] + hstep; _Pragma("unroll") for (int h = 0; h < 2; ++h) _Pragma("unroll") for (int i = 0; i < 2; ++i) sb.off[h][i] = voffB[i]; } } while (0)
    Unit cur, nxt; int ui = 0;
    if (!S.next(0, cur)) return;
    f32x4 acc[2][2][4][2];
#pragma unroll
    for (int a = 0; a < 2; ++a)
#pragma unroll
        for (int b = 0; b < 2; ++b)
#pragma unroll
            for (int m = 0; m < 4; ++m)
#pragma unroll
                for (int n = 0; n < 2; ++n) acc[a][b][m][n] = (f32x4){0.f, 0.f, 0.f, 0.f};
    bf16x8 At[4][2], B0[2][2], B1[2][2];
    Side cA, cB, nA, nB;
    PG8_MKSIDES(cur, cA, cB);
    PG8_STAGE(PG8_SB(0, 0), cB, 0, 0); PG8_STAGE(PG8_SB(0, 1), cB, 1, 0); PG8_STAGE(PG8_SA(0, 0), cA, 0, 0); PG8_STAGE(PG8_SA(0, 1), cA, 1, 0);
    if (wr == 1) PG8_BAR;
    PG8_WAIT_V(2); PG8_BAR;
    PG8_STAGE(PG8_SB(1, 0), cB, 0, 1); PG8_STAGE(PG8_SA(1, 0), cA, 0, 1); PG8_STAGE(PG8_SB(1, 1), cB, 1, 1);
    PG8_WAIT_V(6); PG8_BAR;
    for (;;) {
        const bool has_next = S.next(ui + 1, nxt);
        if (has_next) { PG8_MKSIDES(nxt, nA, nB); } else { nA = cA; nB = cB; }
        if constexpr (Rows::GA) {
#pragma unroll
            for (int h = 0; h < 2; ++h)
#pragma unroll
                for (int i = 0; i < 2; ++i) stash[(h * 2 + i) * NTHR_] = nA.off[h][i]; }
        for (int t = 0; t < nt; t += 2) {
            const bool last = (t == nt - 2);
            if constexpr (Epi::MIDK > 0) { if (t == Epi::MIDK) E.mid(acc, cur, wr, wc, fr, fq); }
            Side a2, b2;
            a2.base[0] = last ? nA.base[0] : cA.base[0]; a2.base[1] = last ? nA.base[1] : cA.base[1];
            b2.base[0] = last ? nB.base[0] : cB.base[0]; b2.base[1] = last ? nB.base[1] : cB.base[1];
#pragma unroll
            for (int h = 0; h < 2; ++h)
#pragma unroll
                for (int i = 0; i < 2; ++i) { if constexpr (!Rows::GA) a2.off[h][i] = cA.off[h][i]; b2.off[h][i] = (Rows::GB && last) ? nB.off[h][i] : cB.off[h][i]; }
            const int k2 = last ? 0 : t + 2, k3 = k2 + 1;
            PG8_LDB(B0, 0, 0); PG8_LDB(B1, 0, 1); PG8_SCHED; PG8_LDA(At, 0, 0); PG8_STAGE(PG8_SA(1, 1), cA, 1, t + 1);
            if constexpr (Rows::GA) {
                if (last) {
#pragma unroll
                    for (int h = 0; h < 2; ++h)
#pragma unroll
                        for (int i = 0; i < 2; ++i) cA.off[h][i] = stash[(h * 2 + i) * NTHR_]; }
#pragma unroll
                for (int h = 0; h < 2; ++h)
#pragma unroll
                    for (int i = 0; i < 2; ++i) a2.off[h][i] = cA.off[h][i]; }
            PG8_WAIT_V(8); PG8_WAIT_L(0); PG8_BAR; PG8_MMA(0, 0, At, B0); PG8_MMA(0, 1, At, B1); PG8_BAR; PG8_SCHED;
            PG8_LDA(At, 0, 1); PG8_STAGE(PG8_SB(0, 0), b2, 0, k2); PG8_STAGE(PG8_SB(0, 1), b2, 1, k2); PG8_STAGE(PG8_SA(0, 0), a2, 0, k2);
            PG8_WAIT_V(8); PG8_WAIT_L(0); PG8_BAR; PG8_MMA(1, 0, At, B0); PG8_MMA(1, 1, At, B1); PG8_BAR; PG8_SCHED;
            PG8_LDB(B0, 1, 0); PG8_LDB(B1, 1, 1); PG8_SCHED; PG8_LDA(At, 1, 0); PG8_STAGE(PG8_SA(0, 1), a2, 1, k2);
            PG8_WAIT_V(8); PG8_WAIT_L(0); PG8_BAR; PG8_MMA(0, 0, At, B0); PG8_MMA(0, 1, At, B1); PG8_BAR; PG8_SCHED;
            PG8_LDA(At, 1, 1); PG8_STAGE(PG8_SB(1, 0), b2, 0, k3); PG8_STAGE(PG8_SB(1, 1), b2, 1, k3); PG8_STAGE(PG8_SA(1, 0), a2, 0, k3);
            PG8_WAIT_V(8); PG8_WAIT_L(0); PG8_BAR; PG8_MMA(1, 0, At, B0); PG8_MMA(1, 1, At, B1); PG8_BAR; PG8_SCHED;
        }
        if (wr == 0) PG8_BAR;
        E(acc, cur, wr, wc, fr, fq);
        if (!has_next) break;
#pragma unroll
        for (int a = 0; a < 2; ++a)
#pragma unroll
            for (int b = 0; b < 2; ++b)
#pragma unroll
                for (int m = 0; m < 4; ++m)
#pragma unroll
                    for (int n = 0; n < 2; ++n) acc[a][b][m][n] = (f32x4){0.f, 0.f, 0.f, 0.f};
        cur = nxt; if constexpr (Rows::GA) { cA.base[0] = nA.base[0]; cA.base[1] = nA.base[1]; } else cA = nA; cB = nB; ++ui;
        if (wr == 1) PG8_BAR;
    }
    PG8_WAIT_V(0);
    PG8_BAR;
#undef PG8_SA
#undef PG8_SB
#undef PG8_STAGE
#undef PG8_LDA
#undef PG8_LDB
#undef PG8_MMA
#undef PG8_WAIT_V
#undef PG8_WAIT_L
#undef PG8_BAR
#undef PG8_SCHED
#undef PG8_MKSIDES
}

template <class Epi, class Sched, class Rows>
__device__ __forceinline__ void gemm_phase(LAS unsigned char* lds, const Gemm g, const Sched& S, const Epi& E, const Rows& RW) { gemm_phase_t<0>(lds, g, S, E, RW); }
template <class Epi, class Sched, class Rows>
__device__ __forceinline__ void gemm_phase8(LAS unsigned char* lds, const Gemm g, const Sched& S, const Epi& E, const Rows& RW) { gemm_phase_t<1>(lds, g, S, E, RW); }
template <class Epi, class Sched, class Rows>
__device__ __forceinline__ void gemm_phasei8(LAS unsigned char* lds, const Gemm g, const Sched& S, const Epi& E, const Rows& RW) { gemm_phase_t<2>(lds, g, S, E, RW); }

struct SUnit { unsigned aoff, boff; int K; int pm, pn, kind, x0, x1, grp, dep, sig; };
__device__ __forceinline__ void st16_wt(unsigned char* wsbase, unsigned off, u32x4 v) {
    const __amdgpu_buffer_rsrc_t rsrc = __builtin_amdgcn_make_buffer_rsrc((void*)wsbase, 0, 0x7fffffff, 0x00020000);
    __builtin_amdgcn_raw_buffer_store_b128(v, rsrc, off, 0, 16); }

template <class Epi, class Sched, class Rows>
__device__ __forceinline__ void gemm_stream(LAS unsigned char* lds, const char* base, const Sched& S, const Epi& E, const Rows& RW) {
    int tid_ = threadIdx.x; asm volatile("" : "+v"(tid_));
    const int tid = tid_, wid = __builtin_amdgcn_readfirstlane(tid >> 6), lane = tid & 63, wr = wid >> 2, wc = wid & 3, fr = lane & 15, fq = lane >> 4;
    int sR[2], sRb[2], sC[2];
#pragma unroll
    for (int i = 0; i < 2; ++i) { int R, C; stage_rc(tid * 16 + i * 8192, R, C); sR[i] = R; sC[i] = C; sRb[i] = (R & ~31) + perm32(R & 31); }
    const size_t kstep = (size_t)(BK * 2);
    const unsigned ldsw = (unsigned)wid * 1024u;
    const int aoff = lds_byte(wr * 64 + fr, fq * 8), boff = lds_byte(wc * 32 + fr, fq * 8);
    struct Side { const char* base[2]; unsigned off[2][2]; };
#define PG8_SA(b, h) (((b) * 2 + (h)) * HTB)
#define PG8_SB(b, h) ((4 + (b) * 2 + (h)) * HTB)
#define PG8_STAGE(bufoff, side, h, kt) do { _Pragma("unroll") for (int _i = 0; _i < 2; ++_i) \
        __builtin_amdgcn_global_load_lds((const unsigned*)((side).base[h] + (size_t)(kt) * kstep + (side).off[h][_i]), (LAS unsigned*)(lds + (bufoff) + ldsw + _i * 8192), 16, 0, 0); } while (0)
#define PG8_LDA(dst, b, h) do { _Pragma("unroll") for (int m = 0; m < 4; ++m) _Pragma("unroll") for (int k = 0; k < 2; ++k) dst[m][k] = *(const LAS bf16x8*)(lds + PG8_SA(b, h) + aoff + m * 2048 + k * 1024); } while (0)
#define PG8_LDB(dst, b, h) do { _Pragma("unroll") for (int n = 0; n < 2; ++n) _Pragma("unroll") for (int k = 0; k < 2; ++k) dst[n][k] = *(const LAS bf16x8*)(lds + PG8_SB(b, h) + boff + n * 2048 + k * 1024); } while (0)
#define PG8_MMA(ai, bj, At, Bt) do { __builtin_amdgcn_s_setprio(1); _Pragma("unroll") for (int m = 0; m < 4; ++m) _Pragma("unroll") for (int n = 0; n < 2; ++n) _Pragma("unroll") for (int k = 0; k < 2; ++k) \
        acc[ai][bj][m][n] = __builtin_amdgcn_mfma_f32_16x16x32_bf16(Bt[n][k], At[m][k], acc[ai][bj][m][n], 0, 0, 0); __builtin_amdgcn_s_setprio(0); } while (0)
#define PG8_WAIT_V(n) asm volatile("s_waitcnt vmcnt(" #n ")" ::: "memory")
#define PG8_WAIT_L(n) asm volatile("s_waitcnt lgkmcnt(" #n ")" ::: "memory")
#define PG8_BAR __builtin_amdgcn_s_barrier()
#define PG8_SCHED __builtin_amdgcn_sched_barrier(0)
#define PG8_MKSIDES(un, sa, sb) do { const int K_ = (un).K; \
        if (RW.a_gather(un)) { sa.base[0] = sa.base[1] = base; _Pragma("unroll") for (int h = 0; h < 2; ++h) _Pragma("unroll") for (int i = 0; i < 2; ++i) sa.off[h][i] = RW.arow(un, h * HALF + sR[i]) + (unsigned)sC[i] * 2u; } \
        else { sa.base[0] = base + (un).aoff; sa.base[1] = sa.base[0] + (size_t)HALF * K_ * 2; _Pragma("unroll") for (int h = 0; h < 2; ++h) _Pragma("unroll") for (int i = 0; i < 2; ++i) sa.off[h][i] = (unsigned)(sR[i] * K_ + sC[i]) * 2u; } \
        sb.base[0] = base + (un).boff; sb.base[1] = sb.base[0] + (size_t)HALF * K_ * 2; _Pragma("unroll") for (int h = 0; h < 2; ++h) _Pragma("unroll") for (int i = 0; i < 2; ++i) sb.off[h][i] = (unsigned)(sRb[i] * K_ + sC[i]) * 2u; } while (0)
#define PG8_SIGNAL(idx) do { if (lane == 0) __hip_atomic_fetch_add(S.rdy + 64 * (idx), 1u, __ATOMIC_RELAXED, __HIP_MEMORY_SCOPE_AGENT); } while (0)
    SUnit cur, nxt;
    unsigned pend = 0u;
    const unsigned lw_addr = (unsigned)(size_t)S.lw;
    if (tid == 0) { S.lw[0] = __hip_atomic_fetch_add(S.q, 1u, __ATOMIC_RELAXED, __HIP_MEMORY_SCOPE_AGENT); pend = __hip_atomic_fetch_add(S.q, 1u, __ATOMIC_RELAXED, __HIP_MEMORY_SCOPE_AGENT); }
    __syncthreads();
    { const int L0 = __builtin_amdgcn_readfirstlane((int)S.lw[0]); if (!S.decode(L0, cur)) return; }
    f32x4 acc[2][2][4][2];
#pragma unroll
    for (int a = 0; a < 2; ++a)
#pragma unroll
        for (int b = 0; b < 2; ++b)
#pragma unroll
            for (int m = 0; m < 4; ++m)
#pragma unroll
                for (int n = 0; n < 2; ++n) acc[a][b][m][n] = (f32x4){0.f, 0.f, 0.f, 0.f};
    bf16x8 At[4][2], B0[2][2], B1[2][2];
    Side cA, cB, nA, nB;
    bool need_pro = true; int sig_idx = -1;
    PG8_MKSIDES(cur, cA, cB);
    for (;;) {
        if (need_pro) {
            if (cur.dep >= 0) S.a_ready(cur);
            PG8_STAGE(PG8_SB(0, 0), cB, 0, 0); PG8_STAGE(PG8_SB(0, 1), cB, 1, 0); PG8_STAGE(PG8_SA(0, 0), cA, 0, 0); PG8_STAGE(PG8_SA(0, 1), cA, 1, 0);
            if (wr == 1) PG8_BAR;
            PG8_WAIT_V(2); PG8_BAR;
            PG8_STAGE(PG8_SB(1, 0), cB, 0, 1); PG8_STAGE(PG8_SA(1, 0), cA, 0, 1); PG8_STAGE(PG8_SB(1, 1), cB, 1, 1);
            PG8_WAIT_V(6); PG8_BAR;
        }
        if (tid == 0) { asm volatile("s_nop 7\n\tds_write_b32 %1, %0\n\tglobal_atomic_add %0, %2, %3, %4 sc0" : "+v"(pend) : "v"(lw_addr), "v"(0u), "v"(1u), "s"(S.q) : "memory"); }
        PG8_WAIT_L(0); PG8_BAR; asm volatile("" ::: "memory");
        const int Ln = __builtin_amdgcn_readfirstlane((int)S.lw[0]);
        const bool has_next = S.decode(Ln, nxt), pre = has_next && nxt.dep < 0;
        if (pre) { PG8_MKSIDES(nxt, nA, nB); } else { nA = cA; nB = cB; }
        const int nt = cur.K / BK;
        for (int t = 0; t < nt; t += 2) {
            const bool last = (t == nt - 2);
            Side a2, b2;
            a2.base[0] = last ? nA.base[0] : cA.base[0]; a2.base[1] = last ? nA.base[1] : cA.base[1];
            b2.base[0] = last ? nB.base[0] : cB.base[0]; b2.base[1] = last ? nB.base[1] : cB.base[1];
#pragma unroll
            for (int h = 0; h < 2; ++h)
#pragma unroll
                for (int i = 0; i < 2; ++i) { a2.off[h][i] = last ? nA.off[h][i] : cA.off[h][i]; b2.off[h][i] = last ? nB.off[h][i] : cB.off[h][i]; }
            const int k2 = last ? 0 : t + 2, k3 = k2 + 1;
            if (t == 2 && sig_idx >= 0) { PG8_SIGNAL(sig_idx); sig_idx = -1; }
            PG8_LDB(B0, 0, 0); PG8_LDB(B1, 0, 1); PG8_SCHED; PG8_LDA(At, 0, 0); PG8_STAGE(PG8_SA(1, 1), cA, 1, t + 1);
            PG8_WAIT_V(8); PG8_WAIT_L(0); PG8_BAR; PG8_MMA(0, 0, At, B0); PG8_MMA(0, 1, At, B1); PG8_BAR; PG8_SCHED;
            PG8_LDA(At, 0, 1); PG8_STAGE(PG8_SB(0, 0), b2, 0, k2); PG8_STAGE(PG8_SB(0, 1), b2, 1, k2); PG8_STAGE(PG8_SA(0, 0), a2, 0, k2);
            PG8_WAIT_V(8); PG8_WAIT_L(0); PG8_BAR; PG8_MMA(1, 0, At, B0); PG8_MMA(1, 1, At, B1); PG8_BAR; PG8_SCHED;
            PG8_LDB(B0, 1, 0); PG8_LDB(B1, 1, 1); PG8_SCHED; PG8_LDA(At, 1, 0); PG8_STAGE(PG8_SA(0, 1), a2, 1, k2);
            PG8_WAIT_V(8); PG8_WAIT_L(0); PG8_BAR; PG8_MMA(0, 0, At, B0); PG8_MMA(0, 1, At, B1); PG8_BAR; PG8_SCHED;
            PG8_LDA(At, 1, 1); PG8_STAGE(PG8_SB(1, 0), b2, 0, k3); PG8_STAGE(PG8_SB(1, 1), b2, 1, k3); PG8_STAGE(PG8_SA(1, 0), a2, 0, k3);
            PG8_WAIT_V(8); PG8_WAIT_L(0); PG8_BAR; PG8_MMA(1, 0, At, B0); PG8_MMA(1, 1, At, B1); PG8_BAR; PG8_SCHED;
        }
        if (wr == 0) PG8_BAR;
        E(acc, cur, wr, wc, fr, fq);
        if (!has_next) { PG8_WAIT_V(0); if (cur.sig >= 0) PG8_SIGNAL(cur.sig); break; }
#pragma unroll
        for (int a = 0; a < 2; ++a)
#pragma unroll
            for (int b = 0; b < 2; ++b)
#pragma unroll
                for (int m = 0; m < 4; ++m)
#pragma unroll
                    for (int n = 0; n < 2; ++n) acc[a][b][m][n] = (f32x4){0.f, 0.f, 0.f, 0.f};
        if (pre) {
            sig_idx = cur.sig; need_pro = false; cur = nxt; cA = nA; cB = nB;
            if (wr == 1) PG8_BAR;
        } else {
            PG8_WAIT_V(0); if (cur.sig >= 0) PG8_SIGNAL(cur.sig);
            PG8_BAR; need_pro = true; cur = nxt; PG8_MKSIDES(cur, cA, cB);
        }
    }
    PG8_BAR;
#undef PG8_SA
#undef PG8_SB
#undef PG8_STAGE
#undef PG8_LDA
#undef PG8_LDB
#undef PG8_MMA
#undef PG8_WAIT_V
#undef PG8_WAIT_L
#undef PG8_BAR
#undef PG8_SCHED
#undef PG8_MKSIDES
#undef PG8_SIGNAL
}
}
using pg8::Unit;
using pg8::SUnit;

struct Args { const float* in[21]; float* out; unsigned char* ws; int ph_lo, ph_hi; };

struct Frame {
    LAS unsigned char* lds;
    unsigned char* ws;
    const float* const* in;
    float* out;
    int tid, lane, wave, G, bx;
};
__device__ __forceinline__ float* modp(const Frame& F, int l, int v) { return (float*)(F.ws + WS_CTL) + CW_MOD + (l * 3 + v) * MODSZ; }

__device__ __forceinline__ void p0_transpose_item(const float* W, int ldw, int k0, int c0, bf16_t* WT, int ldt, int drow, int lane) {
    const float* src = W + (size_t)k0 * ldw + c0 + lane;
    float v[64];
#pragma unroll
    for (int i = 0; i < 64; ++i) { v[i] = src[(size_t)i * ldw]; }
    bf16_t* dst = WT + (size_t)drow * ldt + k0;
#pragma unroll
    for (int j = 0; j < 8; ++j) { u32x4 o; o.x = pk2(v[8 * j], v[8 * j + 1]); o.y = pk2(v[8 * j + 2], v[8 * j + 3]); o.z = pk2(v[8 * j + 4], v[8 * j + 5]); o.w = pk2(v[8 * j + 6], v[8 * j + 7]);
        *(u32x4*)(dst + 8 * j) = o; }
}
template <int QS>
__device__ __forceinline__ void p0_transpose_item8(const float* W, int ldw, int k0, int c0, unsigned char* WT, int ldt, int drow, int lane) {
    const float* src = W + (size_t)k0 * ldw + c0 + lane;
    float v[64];
#pragma unroll
    for (int i = 0; i < 64; ++i) v[i] = src[(size_t)i * ldw] * (float)QS;
    unsigned char* dst = WT + (size_t)drow * ldt + k0;
#pragma unroll
    for (int j = 0; j < 4; ++j) { u32x4 o; o.x = pk4f8(v[16 * j], v[16 * j + 1], v[16 * j + 2], v[16 * j + 3]); o.y = pk4f8(v[16 * j + 4], v[16 * j + 5], v[16 * j + 6], v[16 * j + 7]);
        o.z = pk4f8(v[16 * j + 8], v[16 * j + 9], v[16 * j + 10], v[16 * j + 11]); o.w = pk4f8(v[16 * j + 12], v[16 * j + 13], v[16 * j + 14], v[16 * j + 15]);
        *(u32x4*)(dst + 16 * j) = o; }
}

constexpr int CW_CONVQ = 12288 + 128;
constexpr int MOE_I_GE = 16 * 56, MOE_I_DE = 56 * 16, MOE_ITEMS = NE * (2 * MOE_I_GE + MOE_I_DE), MOE_BATCHES = MOE_ITEMS / 8;
__device__ __forceinline__ void moe_convert_batch(Frame& F, int which, int idx) {
    const float* const* in = F.in; const int ln = F.lane;
    int r = idx * 8 + F.wave;
    if (which == 0) { const int e = r / (2 * MOE_I_GE); r %= (2 * MOE_I_GE); const int up = r / MOE_I_GE; r %= MOE_I_GE; const int kb = r / 56, nb = r % 56, c0 = 64 * nb;
        p0_transpose_item8<QGU>(in[up ? 18 : 17] + (size_t)e * D * DFFE, DFFE, 64 * kb, c0, F.ws + WS_WGUE + (size_t)e * 2 * DFFE * D, D, (c0 >> 7) * 256 + up * 128 + (c0 & 127) + ln, ln); }
    else { const int e = r / MOE_I_DE; r %= MOE_I_DE; const int kb = r / 16, nb = r % 16;
        p0_transpose_item8<QDN>(in[19] + (size_t)e * DFFE * D, D, 64 * kb, 64 * nb, F.ws + WS_WDE + (size_t)e * D * DFFE, DFFE, 64 * nb + ln, ln); }
}
__device__ __forceinline__ void moe_convert(Frame& F, int which, int rep = 0) {
    volatile LAS unsigned* lw = (volatile LAS unsigned*)(F.lds + MISC_OFF) + 20;
    unsigned* q = (unsigned*)(F.ws + WS_CTL) + CW_CONVQ + 64 * which + 128 * rep;
    const int nb = which == 0 ? NE * 2 * MOE_I_GE / 8 : NE * MOE_I_DE / 8;
    for (;;) {
        __syncthreads();
        if (F.tid == 0) lw[0] = __hip_atomic_fetch_add(q, 1u, __ATOMIC_RELAXED, __HIP_MEMORY_SCOPE_AGENT);
        __syncthreads();
        const int idx = (int)lw[0];
        if (idx >= nb) break;
        moe_convert_batch(F, which, idx);
    }
    __syncthreads();
}

constexpr int MOE_P_GU = NE * 2 * 8 * 56, MOE_P_DN = NE * 28 * 16, MOE_PAIRS = MOE_P_GU + MOE_P_DN;
struct CvtItem { const float* src; unsigned char* dst; int ldw; float qs; };
__device__ __forceinline__ CvtItem moe_item(const Frame& F, int P, int half, int ln) {
    const float* const* in = F.in; CvtItem it;
    if (P < MOE_P_GU) { int r = P; const int e = r / (2 * 8 * 56); r %= (2 * 8 * 56); const int up = r / (8 * 56); r %= (8 * 56); const int kb = 2 * (r / 56) + half, nb = r % 56, c0 = 64 * nb;
        it.src = in[up ? 18 : 17] + (size_t)e * D * DFFE + (size_t)(64 * kb) * DFFE + c0 + ln; it.ldw = DFFE; it.qs = (float)QGU;
        it.dst = F.ws + WS_WGUE + (size_t)e * 2 * DFFE * D + (size_t)((c0 >> 7) * 256 + up * 128 + (c0 & 127) + ln) * D + 64 * kb; }
    else { int r = P - MOE_P_GU; const int e = r / (28 * 16); r %= (28 * 16); const int kb = 2 * (r / 16) + half, nb = r % 16;
        it.src = in[19] + (size_t)e * DFFE * D + (size_t)(64 * kb) * D + 64 * nb + ln; it.ldw = D; it.qs = (float)QDN;
        it.dst = F.ws + WS_WDE + (size_t)e * D * DFFE + (size_t)(64 * nb + ln) * DFFE + 64 * kb; }
    return it;
}
#define CVT_LOAD(v, it) do { _Pragma("unroll") for (int i_ = 0; i_ < 64; ++i_) v[i_] = (it).src[(size_t)i_ * (it).ldw]; } while (0)
#define CVT_STORE(v, it) do { _Pragma("unroll") for (int j_ = 0; j_ < 4; ++j_) { u32x4 o_; const float q_ = (it).qs; \
        o_.x = pk4f8(v[16 * j_] * q_, v[16 * j_ + 1] * q_, v[16 * j_ + 2] * q_, v[16 * j_ + 3] * q_); o_.y = pk4f8(v[16 * j_ + 4] * q_, v[16 * j_ + 5] * q_, v[16 * j_ + 6] * q_, v[16 * j_ + 7] * q_); \
        o_.z = pk4f8(v[16 * j_ + 8] * q_, v[16 * j_ + 9] * q_, v[16 * j_ + 10] * q_, v[16 * j_ + 11] * q_); o_.w = pk4f8(v[16 * j_ + 12] * q_, v[16 * j_ + 13] * q_, v[16 * j_ + 14] * q_, v[16 * j_ + 15] * q_); \
        *(u32x4*)((it).dst + 16 * j_) = o_; } } while (0)
__device__ __forceinline__ void moe_convert_all(Frame& F) {
    int t_ = threadIdx.x; asm volatile("" : "+v"(t_)); const int ln = t_ & 63;
    const int gw = F.bx * NWAVES + F.wave, NGW = F.G * NWAVES;
    float va[64], vb[64];
    int P = gw;
    CvtItem ia, ib;
    if (P < MOE_PAIRS) { ia = moe_item(F, P, 0, ln); CVT_LOAD(va, ia); }
    while (P < MOE_PAIRS) {
        ib = moe_item(F, P, 1, ln); CVT_LOAD(vb, ib);
        CVT_STORE(va, ia);
        const int Pn = P + NGW;
        if (Pn < MOE_PAIRS) { ia = moe_item(F, Pn, 0, ln); CVT_LOAD(va, ia); }
        CVT_STORE(vb, ib);
        P = Pn;
    }
}

__device__ __forceinline__ void p0_prologue(Frame& F) {
    const float* const* in = F.in;
    const int gw = F.bx * NWAVES + F.wave, NGW = F.G * NWAVES;
    {
        constexpr int I_IN = 16 * 44, I_O = 16 * 16, I_GD = 16 * 44, I_DD = 44 * 16;
        constexpr int N_A = 2 * I_O + I_DD;
        const int ln = F.lane;
        for (int it = gw; it < N_A; it += NGW) {
            int r = it;
            if (r < 2 * I_O) { const int l = r / I_O; r %= I_O; const int kb = r / 16, nb = r % 16;
                p0_transpose_item(in[12] + (size_t)l * D * D, D, 64 * kb, 64 * nb, (bf16_t*)(F.ws + (l ? WS_WO1 : WS_WO0)), D, 64 * nb + ln, ln); continue; }
            r -= 2 * I_O;
            { const int kb = r / 16, nb = r % 16;
              p0_transpose_item(in[15], D, 64 * kb, 64 * nb, (bf16_t*)(F.ws + WS_WDD), DFF0, 64 * nb + ln, ln); }
        }
    }
    {
        LAS float* pm_ = (LAS float*)(F.lds + 65536);
        const int ln = F.lane;
        for (int it = F.G - 1 - F.bx; it < 4 * 44; it += F.G) {
            const float* src; int ldw, drow; unsigned char* dbase; float* csp;
            if (it < 2 * 44) { const int up = it / 44, c0 = 64 * (it % 44);
                src = in[up ? 14 : 13] + c0 + ln; ldw = DFF0; drow = (c0 >> 7) * 256 + up * 128 + (c0 & 127) + ln; dbase = F.ws + WS_WGUD; csp = (float*)(F.ws + WS_CSD); }
            else { const int l = (it - 2 * 44) / 44, c0 = 512 + 64 * (it % 44);
                const int n32 = ln & 31; const int dn = c0 < OFFV ? (ln & 32) + ((n32 < 16) ? 2 * n32 : 2 * (n32 - 16) + 1) : ln;
                drow = c0 + dn;
                if (c0 >= OFFG) { const int gcol = c0 - OFFG; drow = gcol < D ? OFFG + (gcol >> 7) * 256 + (gcol & 127) + ln : OFFG + ((gcol - D) >> 7) * 256 + 128 + ((gcol - D) & 127) + ln; }
                drow -= 512;
                src = in[8] + (size_t)l * D * INW + c0 + ln; ldw = INW; dbase = F.ws + (l ? WS_WIN1 : WS_WIN0) + (size_t)512 * D * 2; csp = (float*)(F.ws + WS_CSI) + l * 2816; }
            src += (size_t)(F.wave * 128) * ldw;
            float v[128]; float am = 0.f;
#pragma unroll
            for (int i = 0; i < 128; ++i) v[i] = src[(size_t)i * ldw];
#pragma unroll
            for (int i = 0; i < 128; ++i) am = fmaxf(am, fabsf(v[i]));
            __syncthreads();
            pm_[F.wave * 64 + ln] = am;
            __syncthreads();
#pragma unroll
            for (int w = 0; w < 8; ++w) am = fmaxf(am, pm_[w * 64 + ln]);
            const float sc = am > 0.f ? 127.0f / am : 0.f;
            if (F.wave == 0) csp[drow] = am * (1.0f / 127.0f);
            unsigned char* dst = dbase + (size_t)drow * D + F.wave * 128;
#pragma unroll
            for (int j = 0; j < 8; ++j) { u32x4 o; o.x = pk4i8(v[16 * j], v[16 * j + 1], v[16 * j + 2], v[16 * j + 3], sc); o.y = pk4i8(v[16 * j + 4], v[16 * j + 5], v[16 * j + 6], v[16 * j + 7], sc);
                o.z = pk4i8(v[16 * j + 8], v[16 * j + 9], v[16 * j + 10], v[16 * j + 11], sc); o.w = pk4i8(v[16 * j + 12], v[16 * j + 13], v[16 * j + 14], v[16 * j + 15], sc);
                *(u32x4*)(dst + 16 * j) = o; }
        }
    }
    __syncthreads();
    {
        LAS float* wrow = (LAS float*)F.lds;
        LAS float* ctab = wrow + 4096;
        if (F.tid < 128) ctab[F.tid] = cospif((float)F.tid / 64.0f);
        for (int it = F.bx; it < 2 * 128; it += F.G) {
            const int l = it >> 7, d0 = (it & 127) * 8;
            __syncthreads();
            for (int i = F.tid; i < 4096; i += NTHR) wrow[i] = in[8][(size_t)l * D * INW + (size_t)(d0 + (i >> 9)) * INW + (i & 511)];
            __syncthreads();
            const int r = F.tid, j = r >> 1, ri = r & 1, g = j >> 6, jj = j & 63;
            float a[8];
#pragma unroll
            for (int q = 0; q < 8; ++q) a[q] = 0.f;
            for (int cc = 0; cc < 128; ++cc) {
                float cf;
                if (jj == 0) cf = ri ? ((cc & 1) ? -1.f : 1.f) : 1.f;
                else { const int idx = (cc * jj) & 127; cf = ri ? -ctab[(idx - 32) & 127] : ctab[idx]; }
#pragma unroll
                for (int q = 0; q < 8; ++q) a[q] += cf * wrow[q * 512 + g * 128 + cc];
            }
            u32x4 o; o.x = pk2(a[0], a[1]); o.y = pk2(a[2], a[3]); o.z = pk2(a[4], a[5]); o.w = pk2(a[6], a[7]);
            *(u32x4*)((bf16_t*)(F.ws + (l ? WS_WIN1 : WS_WIN0)) + (size_t)r * D + d0) = o;
        }
        __syncthreads();
    }
    const int gt = F.bx * NTHR + F.tid, NGT = F.G * NTHR;
    for (int it = gt; it < 2 * 1024 * 144; it += NGT) {
        const int l = it / (1024 * 144), r = it % (1024 * 144), kc = r / 1024, o = r % 1024;
        const float* wf = in[10] + (size_t)l * 512 * D; const float* wa = in[11] + (size_t)l * 512 * D;
        float v[8];
#pragma unroll
        for (int q = 0; q < 8; ++q) { const int k = kc * 8 + q; float x = 0.f;
            if (k < 512) { const int mm = k & 127; x = wf[(size_t)k * D + o] * ((mm == 0 || mm == 64) ? 0.5f : 1.f); }
            else if (k < 520) { const int gg = (k - 512) >> 1, sgn = (k - 512) & 1; x = 0.5f * wf[(size_t)(gg * 128 + 64 * sgn) * D + o]; }
            else if (k >= 640) x = wa[(size_t)(k - 640) * D + o];
            v[q] = x; }
        u32x4 w; w.x = pk2(v[0], v[1]); w.y = pk2(v[2], v[3]); w.z = pk2(v[4], v[5]); w.w = pk2(v[6], v[7]);
        *(u32x4*)((bf16_t*)(F.ws + (l ? WS_WM1 : WS_WM0)) + (size_t)o * KM + kc * 8) = w;
    }
    for (int it = gt; it < 192 * 16; it += NGT) {
        const int i = it & 15, p = it >> 4, pos = p < 128 ? p : p - 128;
        const float inv = powf(10000.0f, -(float)i / 16.0f), a = (float)pos * inv;
        ((f32x2*)(F.ws + WS_ROPE))[it] = (f32x2){cosf(a), sinf(a)};
    }
    for (int it = gt; it < 128 * 64; it += NGT) {
        const int t2 = it >> 6, k1 = it & 63; float s, c; sincospif((float)(t2 * k1) / 4096.0f, &s, &c);
        ((f32x2*)(F.ws + WS_TW))[it] = (f32x2){c, s};
    }
    for (int it = gt; it < 256 * 128; it += NGT) {
        const int nu = it >> 7, ka = it & 127; float v = 0.f;
        if (nu < 128) { const int k1 = nu >> 1, ro = nu & 1, ri = ka >> 6, t1 = ka & 63; float s, c; sincospif((float)((t1 * k1) & 63) / 32.0f, &s, &c);
            v = ro == 0 ? (ri == 0 ? c : s) : (ri == 0 ? -s : c); }
        ((bf16_t*)(F.ws + WS_FA64))[it] = (bf16_t)f2bf(v);
    }
    for (int it = gt; it < 256 * 256; it += NGT) {
        const int mu = it >> 8, la = it & 255, k2 = mu >> 1, ro = mu & 1, ri = la >> 7, t2 = la & 127; float s, c; sincospif((float)((t2 * k2) & 127) / 64.0f, &s, &c);
        const float v = (ro == 0 ? (ri == 0 ? c : s) : (ri == 0 ? -s : c)) * 0.0009765625f;
        ((bf16_t*)(F.ws + WS_TC))[it] = (bf16_t)f2bf(v);
    }
    for (int it = gt; it < 512 * 512; it += NGT) {
        const int mu = it >> 9, la = it & 511, k = mu >> 1, ro = mu & 1, ri = la >> 8, t = la & 255; float s, c; sincospif((float)((t * k) & 255) / 128.0f, &s, &c);
        const float v = (ro == 0 ? (ri == 0 ? c : s) : (ri == 0 ? -s : c)) * 0.005524271728019903f;
        ((bf16_t*)(F.ws + WS_TX))[it] = (bf16_t)f2bf(v);
    }
    __syncthreads();
    {
        LAS float* sl = (LAS float*)F.lds;
        LAS float* part = sl + 3 * D;
        for (int i = F.tid; i < 3 * D; i += NTHR) { const float c = i < 2 * D ? in[1][i] : in[3][i - 2 * D]; sl[i] = c / (1.0f + __expf(-c)); }
        __syncthreads();
        for (int it = F.bx; it < 2 * 96; it += F.G) {
            const int l = it / 96, n = (it % 96) * 64 + F.lane;
            const float* wm = in[4] + (size_t)l * D * MODSZ + (size_t)(F.wave * 128) * MODSZ + n;
            float a0 = 0.f, a1 = 0.f, a2 = 0.f;
#pragma unroll
            for (int d0 = 0; d0 < 128; d0 += 32) { float w[32];
#pragma unroll
                for (int q = 0; q < 32; ++q) w[q] = wm[(size_t)(d0 + q) * MODSZ];
#pragma unroll
                for (int q = 0; q < 32; ++q) { const int d = F.wave * 128 + d0 + q; a0 += sl[d] * w[q]; a1 += sl[D + d] * w[q]; a2 += sl[2 * D + d] * w[q]; } }
            __syncthreads();
            part[(F.wave * 3 + 0) * 64 + F.lane] = a0; part[(F.wave * 3 + 1) * 64 + F.lane] = a1; part[(F.wave * 3 + 2) * 64 + F.lane] = a2;
            __syncthreads();
            if (F.tid < 192) { const int v = F.tid >> 6, ln = F.tid & 63; float sacc = in[5][l * MODSZ + (it % 96) * 64 + ln];
#pragma unroll
                for (int w = 0; w < 8; ++w) sacc += part[(w * 3 + v) * 64 + ln];
                modp(F, l, v)[(it % 96) * 64 + ln] = sacc; }
        }
    }
    for (int it = gt; it < NTOK * 15; it += NGT) { const int row = it / 15, c = it % 15;
        *(u32x4*)((bf16_t*)(F.ws + WS_FO) + (size_t)row * KM + 520 + c * 8) = (u32x4){0u, 0u, 0u, 0u}; }
}

__device__ __forceinline__ const float* xrow_ptr(const Frame& F, int row, const float* xl) { return row < NL ? xl + (size_t)row * D : (const float*)(F.ws + WS_XC) + (size_t)(row - NL) * D; }

template <bool ROUTE, int OUTM = ROUTE ? 1 : 0>
__device__ __forceinline__ void norm_phase(Frame& F, int l, int which  , const float* xl, const float* xc, int nrows, const float* xcadd = nullptr, float* xcwb = nullptr) {
    const float* gvec = F.in[which ? 7 : 6] + l * D;
    LAS float* wr_l = (LAS float*)F.lds;
    constexpr int RMAX = 32;
    LAS int* pe = (LAS int*)(F.lds + 32768); LAS float* pw = (LAS float*)(F.lds + 32768 + 2048); LAS unsigned* lcnt = (LAS unsigned*)(F.lds + 32768 + 4096); LAS unsigned* gb = lcnt + 8;
    if (ROUTE) { for (int i = F.tid; i < D * NE; i += NTHR) wr_l[i] = F.in[16][i]; pe[F.tid] = -1; if (F.tid < 8) lcnt[F.tid] = 0u; __syncthreads(); }
    const int gw = F.bx * NWAVES + F.wave, NGW = F.G * NWAVES;
    int iter = 0;
    auto ldx = [&](int row, f32x4 (&x)[4]) {
        const bool fromb = row < NL && xl == nullptr;
        const float* xr = row < NL ? (fromb ? xc : xl + (size_t)row * D) : xc + (size_t)(row - NL) * D;
        const bf16_t* xbr = (const bf16_t*)(F.ws + WS_XB) + (size_t)row * D;
#pragma unroll
        for (int j = 0; j < 4; ++j) {
            if (fromb) { const u32x2 xb = *(const u32x2*)(xbr + 256 * j + 4 * F.lane); x[j] = (f32x4){bflo(xb.x), bfhi(xb.x), bflo(xb.y), bfhi(xb.y)}; }
            else x[j] = *(const f32x4*)(xr + 256 * j + 4 * F.lane);
            if (row >= NL && xcadd) { x[j] = x[j] + *(const f32x4*)(xcadd + (size_t)(row - NL) * D + 256 * j + 4 * F.lane); if (xcwb) *(f32x4*)(xcwb + (size_t)(row - NL) * D + 256 * j + 4 * F.lane) = x[j]; } }
    };
    f32x4 x[4], xn[4];
    if (gw < nrows) ldx(gw, x);
    for (int row = gw; row < nrows; row += NGW, ++iter) {
        const int v = row < T ? 0 : (row < NL ? 1 : 2);
        const float* sh = modp(F, l, v) + (which ? 3 : 0) * D; const float* sc = sh + D;
        if (row + NGW < nrows) ldx(row + NGW, xn);
        float s = 0.f;
#pragma unroll
        for (int j = 0; j < 4; ++j) s += (x[j].x * x[j].x + x[j].y * x[j].y) + (x[j].z * x[j].z + x[j].w * x[j].w);
        const float r = 1.0f / sqrtf(wave_sum(s) * (1.f / D) + EPS);
        float lg[NE];
        if (ROUTE) {
#pragma unroll
            for (int e = 0; e < NE; ++e) lg[e] = 0.f; }
        bf16_t* hr = (bf16_t*)(F.ws + WS_H) + (size_t)row * D;
        f32x4 hh[4]; float amax = 0.f;
#pragma unroll
        for (int j = 0; j < 4; ++j) { const int c = 256 * j + 4 * F.lane;
            const f32x4 gg = *(const f32x4*)(gvec + c), s4 = *(const f32x4*)(sh + c), c4 = *(const f32x4*)(sc + c);
            f32x4 h = (x[j] * r) * gg; h = h * (c4 + 1.0f) + s4;
            if (OUTM == 1) *(unsigned*)((unsigned char*)(F.ws + WS_H) + (size_t)row * D + c) = pk4f8(h.x, h.y, h.z, h.w);
            else if (OUTM == 0) { u32x2 o; o.x = pk2(h.x, h.y); o.y = pk2(h.z, h.w); *(u32x2*)(hr + c) = o; }
            else { if (OUTM == 3) { u32x2 o; o.x = pk2(h.x, h.y); o.y = pk2(h.z, h.w); *(u32x2*)(hr + c) = o; }
                hh[j] = h; amax = fmaxf(fmaxf(amax, fmaxf(fabsf(h.x), fabsf(h.y))), fmaxf(fabsf(h.z), fabsf(h.w))); }
            if (ROUTE) {
#pragma unroll
                for (int q = 0; q < 4; ++q) { const float hv = h[q]; const LAS f32x4* w = (const LAS f32x4*)(wr_l + (c + q) * NE); const f32x4 w0 = w[0], w1 = w[1];
                    lg[0] += hv * w0.x; lg[1] += hv * w0.y; lg[2] += hv * w0.z; lg[3] += hv * w0.w; lg[4] += hv * w1.x; lg[5] += hv * w1.y; lg[6] += hv * w1.z; lg[7] += hv * w1.w; } }
        }
        if (OUTM >= 2) {
            amax = wave_max(amax);
            const float qs = amax > 0.f ? 127.0f / amax : 0.f;
            if (F.lane == 0) ((float*)(F.ws + WS_RS))[row] = amax * (1.0f / 127.0f);
#pragma unroll
            for (int j = 0; j < 4; ++j) *(unsigned*)((unsigned char*)(F.ws + (OUTM == 3 ? WS_H8 : WS_H)) + (size_t)row * D + 256 * j + 4 * F.lane) = pk4i8(hh[j].x, hh[j].y, hh[j].z, hh[j].w, qs);
        }
        if (ROUTE) {
#pragma unroll
            for (int e = 0; e < NE; ++e) lg[e] = wave_sum(lg[e]);
            if (F.lane == 0) {
                int e1 = 0; float v1 = lg[0];
#pragma unroll
                for (int e = 1; e < NE; ++e) if (lg[e] > v1) { v1 = lg[e]; e1 = e; }
                int e2 = -1; float v2 = -3.0e38f;
#pragma unroll
                for (int e = 0; e < NE; ++e) if (e != e1 && lg[e] > v2) { v2 = lg[e]; e2 = e; }
                const float p2 = __expf(v2 - v1), w1 = 1.f / (1.f + p2), w2 = p2 * w1;
                const int p = 2 * (F.wave * RMAX + iter);
                pe[p] = e1; pe[p + 1] = e2; pw[p] = w1; pw[p + 1] = w2;
            }
        }
#pragma unroll
        for (int j = 0; j < 4; ++j) x[j] = xn[j];
    }
    if (ROUTE) {
        __syncthreads();
        const int p = F.tid, e = pe[p]; unsigned lr = 0u;
        if (e >= 0) lr = __hip_atomic_fetch_add(lcnt + e, 1u, __ATOMIC_RELAXED, __HIP_MEMORY_SCOPE_WORKGROUP);
        __syncthreads();
        if (F.tid < NE && lcnt[F.tid] > 0u) gb[F.tid] = atomicAdd((unsigned*)(F.ws + WS_CTL) + CW_CNT + 64 * F.tid, lcnt[F.tid]);
        __syncthreads();
        if (e >= 0) {
            const int slot = p >> 1, row = F.bx * NWAVES + slot / RMAX + (slot % RMAX) * NGW, r = (int)(gb[e] + lr);
            int* toke = (int*)(F.ws + WS_TOKE); int* tokr = (int*)(F.ws + WS_TOKR); float* tokw = (float*)(F.ws + WS_TOKW); int* list = (int*)(F.ws + WS_LIST);
            toke[2 * row + (p & 1)] = e; tokr[2 * row + (p & 1)] = r; tokw[2 * row + (p & 1)] = pw[p]; list[e * NL + r] = row;
        }
        __syncthreads();
    }
}

constexpr int TAILQ_ROWS = 8 * 256;
__device__ __forceinline__ int moe_tail_panels(const unsigned* cw, int G) { int ptot = 0, plast = 0;
#pragma unroll
    for (int e = 0; e < NE; ++e) { const int p_ = ((int)cw[64 * e] + 255) >> 8; ptot += p_; plast = p_; }
    const int left = (4 * ptot) % G; int t = (left + 3) >> 2; if (4 * ptot < G) t = 0; if (t > plast) t = plast; if (t > 8) t = 8; return t; }
__device__ __forceinline__ void final_phase(Frame& F) {
    int t_ = threadIdx.x; asm volatile("" : "+v"(t_)); const int lane_ = t_ & 63;
    const int gw = F.bx * NWAVES + F.wave, NGW = F.G * NWAVES;
    const unsigned* cnt = (const unsigned*)(F.ws + WS_CTL) + CW_CNT;
    int base[NE]; { int b = 0;
#pragma unroll
        for (int e = 0; e < NE; ++e) { base[e] = b; b += ((int)cnt[64 * e] + 255) & ~255; } }
    const int* toke = (const int*)(F.ws + WS_TOKE); const int* tokr = (const int*)(F.ws + WS_TOKR); const float* tokw = (const float*)(F.ws + WS_TOKW);
    const bf16_t* dout = (const bf16_t*)(F.ws + WS_DOUT); const bf16_t* tq = (const bf16_t*)(F.ws + WS_DOUT1);
    const int trim_ = moe_tail_panels(cnt, F.G), trow0 = trim_ > 0 ? base[NE - 1] + ((((int)cnt[64 * (NE - 1)] + 255) >> 8) - trim_) * 256 : 0x7fffffff;
    struct RowIn { u32x2 a[4], b[4], xb[4]; const bf16_t* q1; const bf16_t* q2; float w1, w2; bool t1, t2; };
    auto ldrow = [&](int row, RowIn& R) {
        const int e1 = toke[2 * row], e2 = toke[2 * row + 1];
        int b1 = 0, b2 = 0;
#pragma unroll
        for (int e = 0; e < NE; ++e) { if (e == e1) b1 = base[e]; if (e == e2) b2 = base[e]; }
        const int r1_ = b1 + tokr[2 * row], r2_ = b2 + tokr[2 * row + 1];
        const bf16_t* d1 = dout + (size_t)r1_ * D; const bf16_t* d2 = dout + (size_t)r2_ * D;
        R.t1 = r1_ >= trow0; R.t2 = r2_ >= trow0;
        R.q1 = tq + (size_t)(R.t1 ? r1_ - trow0 : 0) * D; R.q2 = tq + (size_t)(R.t2 ? r2_ - trow0 : 0) * D;
        R.w1 = tokw[2 * row]; R.w2 = tokw[2 * row + 1];
#pragma unroll
        for (int j = 0; j < 4; ++j) { const int c = 256 * j + 4 * lane_;
            R.a[j] = *(const u32x2*)(d1 + c); R.b[j] = *(const u32x2*)(d2 + c); R.xb[j] = *(const u32x2*)((const bf16_t*)(F.ws + WS_XB) + (size_t)row * D + c); }
    };
    RowIn cur, nxt;
    if (gw < NL) ldrow(gw, cur);
    for (int row = gw; row < NL; row += NGW) {
        const int v = row < T ? 0 : 1;
        const float* ga2 = modp(F, 1, v) + 5 * D;
        if (row + NGW < NL) ldrow(row + NGW, nxt);
        float* xr = F.out + (size_t)row * D;
        f32x4 x[4]; float s = 0.f;
#pragma unroll
        for (int j = 0; j < 4; ++j) { const int c = 256 * j + 4 * lane_;
            const u32x2 a = cur.a[j], b = cur.b[j]; const f32x4 g4 = *(const f32x4*)(ga2 + c);
            f32x4 ya = (f32x4){bflo(a.x), bfhi(a.x), bflo(a.y), bfhi(a.y)}, yb = (f32x4){bflo(b.x), bfhi(b.x), bflo(b.y), bfhi(b.y)};
            if (cur.t1) { const u32x2 e_ = *(const u32x2*)(cur.q1 + c); ya = ya + (f32x4){bflo(e_.x), bfhi(e_.x), bflo(e_.y), bfhi(e_.y)}; }
            if (cur.t2) { const u32x2 e_ = *(const u32x2*)(cur.q2 + c); yb = yb + (f32x4){bflo(e_.x), bfhi(e_.x), bflo(e_.y), bfhi(e_.y)}; }
            const f32x4 y = (ya * cur.w1 + yb * cur.w2) * (1.0f / (float)(QDN * QACT));
            { const u32x2 xb = cur.xb[j]; x[j] = (f32x4){bflo(xb.x), bfhi(xb.x), bflo(xb.y), bfhi(xb.y)} + g4 * y; }
            s += (x[j].x * x[j].x + x[j].y * x[j].y) + (x[j].z * x[j].z + x[j].w * x[j].w); }
        const float r = 1.0f / sqrtf(wave_sum(s) * (1.f / D) + EPS);
#pragma unroll
        for (int j = 0; j < 4; ++j) { const int c = 256 * j + 4 * lane_; *(f32x4*)(xr + c) = (x[j] * r) * *(const f32x4*)(F.in[20] + c); }
        cur = nxt;
    }
}

struct GridSched { int nM, nN, G, c; unsigned abytes, bbytes;
    __device__ __forceinline__ bool next(int i, Unit& u) const { const int L = i * G + c; if (L >= nM * nN) return false; pg8::swz_map(L, nM, nN, u.pm, u.pn); u.aoff = (unsigned)u.pm * abytes; u.boff = (unsigned)u.pn * bbytes; u.kind = 0; u.x0 = 0; u.x1 = 0; u.kh = 0; return true; } };

struct CtxSched { int G, c, nN; unsigned abytes, bbytes; int ksplit; unsigned khbytes;
    __device__ __forceinline__ bool next(int i, Unit& u) const { int L = i * G + c; if (L >= 2 * nN * ksplit) return false; u.kh = L / (2 * nN); L -= u.kh * 2 * nN; u.pm = 64 + L / nN; u.pn = L % nN;
        u.aoff = (unsigned)u.pm * abytes + (unsigned)u.kh * khbytes; u.boff = (unsigned)u.pn * bbytes + (unsigned)u.kh * khbytes; u.kind = 0; u.x0 = u.pm * 256; u.x1 = 0; return true; } };

struct InprojSched { int G, c, l;
    __device__ __forceinline__ bool next(int i, Unit& u) const { const int L = i * G + c; const int nmain = 64 * 11;
        if (L < nmain) { pg8::swz_map(L, 64, 11, u.pm, u.pn); }
        else { const int r = L - nmain; if (l == 0) { if (r >= 22) return false; u.pm = 64 + r / 11; u.pn = r % 11; } else { if (r >= 2) return false; u.pm = 64 + r; u.pn = 2; } }
        u.aoff = (unsigned)u.pm * (256u * D); u.boff = (unsigned)u.pn * (256u * D); u.kind = 0; u.x0 = 0; u.x1 = 0; u.kh = 0; return true; } };

struct EpiInproj {
    static constexpr bool PERM = true; static constexpr int MIDK = 0;
    unsigned char* ws; const float* rs; const float* cs;
    __device__ __forceinline__ void operator()(const f32x4 (&acci)[2][2][4][2], const Unit& u, int wr, int wc, int fr, int fq) const {
        asm volatile("" : "+v"(fr), "+v"(fq));
        const int row0 = u.pm * 256 + wr * 64 + fr;
        const bool lat = u.pm < 64;
        const f32x2* rope = (const f32x2*)(ws + WS_ROPE);
        f32x4 csc[2][2]; float rsv[2][4];
#pragma unroll
        for (int bj = 0; bj < 2; ++bj) { const float* cp = cs + u.pn * 256 + bj * 128 + wc * 32 + 8 * fq; csc[bj][0] = *(const f32x4*)cp; csc[bj][1] = *(const f32x4*)(cp + 4); }
#pragma unroll
        for (int ai = 0; ai < 2; ++ai)
#pragma unroll
            for (int m = 0; m < 4; ++m) rsv[ai][m] = rs[row0 + ai * 128 + m * 16];
        asm volatile("" ::: "memory");
#pragma unroll
        for (int bj = 0; bj < 2; ++bj) {
            const int cl = u.pn * 256 + bj * 128 + wc * 32 + 8 * fq;
#pragma unroll
            for (int ai = 0; ai < 2; ++ai) {
                f32x4 rp0[4], rp1[4];
                if (cl < 640 && lat) {
#pragma unroll
                    for (int m = 0; m < 4; ++m) { const int row = row0 + ai * 128 + m * 16, t = row & (T - 1), prow = t >> 6, pcol = t & 63;
                        const int dh = cl & 63, i0 = (dh & 31) >> 1; const f32x2* rp = rope + ((dh < 32 ? prow : 128 + pcol) * 16 + i0);
                        rp0[m] = *(const f32x4*)rp; rp1[m] = *(const f32x4*)(rp + 2); }
                }
                asm volatile("" ::: "memory");
#pragma unroll
                for (int m = 0; m < 4; ++m) {
                    const int row = row0 + ai * 128 + m * 16;
                    const float rsc = rsv[ai][m];
                    f32x4 v0 = __builtin_convertvector(__builtin_bit_cast(pg8::i32x4, acci[ai][bj][m][0]), f32x4) * (csc[bj][0] * rsc);
                    f32x4 v1 = __builtin_convertvector(__builtin_bit_cast(pg8::i32x4, acci[ai][bj][m][1]), f32x4) * (csc[bj][1] * rsc);
                    bf16_t* dst;
                    if (cl < 640) {
                        if (lat) { const f32x2 c0 = (f32x2){rp0[m].x, rp0[m].y}, c1 = (f32x2){rp0[m].z, rp0[m].w}, c2 = (f32x2){rp1[m].x, rp1[m].y}, c3 = (f32x2){rp1[m].z, rp1[m].w};
                            f32x4 w0, w1; w0.x = v0.x * c0.x - v0.y * c0.y; w0.y = v0.x * c0.y + v0.y * c0.x; w0.z = v0.z * c1.x - v0.w * c1.y; w0.w = v0.z * c1.y + v0.w * c1.x;
                            w1.x = v1.x * c2.x - v1.y * c2.y; w1.y = v1.x * c2.y + v1.y * c2.x; w1.z = v1.z * c3.x - v1.w * c3.y; w1.w = v1.z * c3.y + v1.w * c3.x; v0 = w0; v1 = w1; }
                        if (cl < 512) { v0 = v0 * QSCALE; v1 = v1 * QSCALE; dst = (bf16_t*)(ws + WS_Q) + (size_t)row * 512 + cl; }
                        else dst = (bf16_t*)(ws + WS_KB) + (size_t)row * 128 + (cl - 512);
                    } else if (cl < 768) { dst = (bf16_t*)(ws + WS_VB) + (size_t)row * 128 + (cl - 640); }
                    else {
                        const int oc = (u.pn - 3) * 128 + wc * 32 + 8 * fq;
                        if (bj == 0) {
                            const f32x4 a0 = __builtin_convertvector(__builtin_bit_cast(pg8::i32x4, acci[ai][1][m][0]), f32x4) * (csc[1][0] * rsc), a1 = __builtin_convertvector(__builtin_bit_cast(pg8::i32x4, acci[ai][1][m][1]), f32x4) * (csc[1][1] * rsc);
#pragma unroll
                            for (int q = 0; q < 4; ++q) { v0[q] = sigmoidf_(v0[q]) * (1.0f + __builtin_amdgcn_exp2f(-a0[q] * LOG2E)); v1[q] = sigmoidf_(v1[q]) * (1.0f + __builtin_amdgcn_exp2f(-a1[q] * LOG2E)); }
                            dst = (bf16_t*)(ws + WS_GF) + (size_t)row * D + oc; }
                        else {
#pragma unroll
                            for (int q = 0; q < 4; ++q) { v0[q] = sigmoidf_(v0[q]); v1[q] = sigmoidf_(v1[q]); }
                            dst = (bf16_t*)(ws + WS_GA) + (size_t)row * D + oc; } }
                    u32x4 w; w.x = cvt_pk_bf16(v0[0], v0[1]); w.y = cvt_pk_bf16(v0[2], v0[3]); w.z = cvt_pk_bf16(v1[0], v1[1]); w.w = cvt_pk_bf16(v1[2], v1[3]);
                    *(u32x4*)dst = w;
                }
                asm volatile("" ::: "memory");
            }
        }
    }
};

struct UpermSched { int G, c, l;
    __device__ __forceinline__ bool next(int i, Unit& u) const { const int L = i * G + c; const int nn = l == 0 ? 66 : 64; if (L >= 2 * nn) return false;
        u.pm = L & 1; u.pn = L >> 1; u.aoff = (unsigned)u.pm * (256u * D * 2u); u.boff = 0; u.kind = 0; u.x0 = 0; u.x1 = 0; u.kh = 0; return true; } };
struct UpermRows { static constexpr bool GA = false, GB = true;
    __device__ __forceinline__ unsigned arow(const Unit&, int) const { return 0u; }
    __device__ __forceinline__ unsigned brow(const Unit& u, int c) const { const int n = u.pn; int row;
        if (n < 64) { const int b = n >> 5, q = n & 31; row = b * T + 128 * (c & 63) + 4 * q + (c >> 6); } else row = NL + (n - 64) * 256 + c;
        return (unsigned)row * (D * 2u); } };
struct EpiUperm {
    static constexpr bool PERM = true; static constexpr int MIDK = 0;
    unsigned char* ws;
    __device__ __forceinline__ void operator()(const f32x4 (&acc)[2][2][4][2], const Unit& u, int wr, int wc, int fr, int fq) const {
        const int n = u.pn;
#pragma unroll
        for (int ai = 0; ai < 2; ++ai)
#pragma unroll
            for (int m = 0; m < 4; ++m) { const int r = u.pm * 256 + ai * 128 + wr * 64 + m * 16 + fr, j = r >> 1, ri = r & 1;
#pragma unroll
                for (int bj = 0; bj < 2; ++bj) { const int c = bj * 128 + wc * 32 + 8 * fq;
                    const f32x4 v0 = acc[ai][bj][m][0], v1 = acc[ai][bj][m][1];
                    u32x4 w; w.x = cvt_pk_bf16(v0[0], v0[1]); w.y = cvt_pk_bf16(v0[2], v0[3]); w.z = cvt_pk_bf16(v1[0], v1[1]); w.w = cvt_pk_bf16(v1[2], v1[3]);
                    bf16_t* dst;
                    if (n < 64) { const int b = n >> 5, q = n & 31, t2 = 4 * q + (c >> 6), t1 = c & 63; dst = (bf16_t*)(ws + WS_UP) + ((size_t)((j * 2 + b) * 128 + t2) * 128 + ri * 64 + t1); }
                    else { const int b = n - 64; dst = (bf16_t*)(ws + WS_VCT) + ((size_t)((b * 256 + j) * 2 + ri) * 256 + c); }
                    *(u32x4*)dst = w; } }
    }
};

struct StepASched { int G, c, l;
    __device__ __forceinline__ bool next(int i, Unit& u) const { int L = i * G + c;
        if (l == 0 && G == 256) { if (c >= 16 && c < 20) return false; if (c >= 20 && c < 24) { if (i > 1) return false; L = i == 0 ? c : c - 4; } else if (i > 0) return false; }
        if (L >= 256) return false; pg8::swz_map(L, 256, 1, u.pm, u.pn); u.aoff = (unsigned)u.pm * (256u * 128u * 2u); u.boff = 0u; u.kind = 0; u.x0 = 0; u.x1 = 0; u.kh = 0; return true; } };

struct EpiStepA {
    static constexpr bool PERM = true; static constexpr int MIDK = 0;
    unsigned char* ws;
    __device__ __forceinline__ void operator()(const f32x4 (&acc)[2][2][4][2], const Unit& u, int wr, int wc, int fr, int fq) const {
        const f32x2* tw = (const f32x2*)(ws + WS_TW); bf16_t* gp = (bf16_t*)(ws + WS_GP);
        const int j = u.pm;
        f32x4 twv[4][2];
#pragma unroll
        for (int m = 0; m < 4; ++m)
#pragma unroll
            for (int n = 0; n < 2; ++n) twv[m][n] = *(const f32x4*)(tw + (wr * 64 + m * 16 + fr) * 64 + 16 * wc + 4 * fq + 2 * n);
        asm volatile("" ::: "memory");
#pragma unroll
        for (int ai = 0; ai < 2; ++ai)
#pragma unroll
            for (int m = 0; m < 4; ++m) { const int t2 = wr * 64 + m * 16 + fr, b = ai;
#pragma unroll
                for (int n = 0; n < 2; ++n) { const f32x4 v = acc[ai][0][m][n];
#pragma unroll
                    for (int p = 0; p < 2; ++p) { const int k1 = 16 * wc + 4 * fq + 2 * n + p; const f32x2 w = p ? (f32x2){twv[m][n].z, twv[m][n].w} : (f32x2){twv[m][n].x, twv[m][n].y};
                        const float gr = v[2 * p], gi = v[2 * p + 1];
                        const float orr = gr * w.x + gi * w.y, oi = gi * w.x - gr * w.y;
                        bf16_t* d = gp + ((size_t)((b * 64 + k1) * 256 + j) * 256 + t2);
                        d[0] = (bf16_t)f2bf(orr); d[128] = (bf16_t)f2bf(oi); } } }
    }
};
template <bool CTXV> struct EpiStepC {
    static constexpr bool PERM = true; static constexpr int MIDK = 0;
    unsigned char* ws;
    __device__ __forceinline__ void operator()(const f32x4 (&acc)[2][2][4][2], const Unit& u, int wr_, int wc_, int fr_, int fq_) const {
        int wr = wr_, wc = wc_, fr = fr_, fq = fq_, upm = u.pm, upn = u.pn;
        asm volatile("" : "+s"(wr), "+s"(wc), "+v"(fr), "+v"(fq), "+s"(upm), "+s"(upn));
        bf16_t* fo = (bf16_t*)(ws + WS_FO);
        const int NN = CTXV ? 256 : T;
        const int b = CTXV ? upm : (upm >> 6), k1 = CTXV ? 0 : (upm & 63), rowb = CTXV ? NL + b * 256 : b * T;
        const int own0 = wr * 128 + fr, mir0 = wr * 128 + 128 - fr;
        const int kk0 = (CTXV ? 128 * upn : 0) + 16 * wc + 4 * fq;
#pragma unroll
        for (int bj = 0; bj < 2; ++bj)
#pragma unroll
            for (int n = 0; n < 2; ++n)
#pragma unroll
                for (int p = 0; p < 2; ++p) {
                    const int kk = kk0 + 64 * bj + 2 * n + p;
                    const int k = CTXV ? kk : (k1 + 64 * kk), km = (NN - k) & (NN - 1);
                    const unsigned oo = (unsigned)(rowb + k) * KM, om = (unsigned)(rowb + km) * KM;
#pragma unroll
                    for (int ai = 0; ai < 2; ++ai)
#pragma unroll
                        for (int m = 0; m < 4; ++m) {
                            const f32x4 v = acc[ai][bj][m][n];
                            const bf16_t re = (bf16_t)f2bf(v[2 * p]);
                            if (m == 0 && fr == 0) { const int g = 2 * ai + wr; const bf16_t im = (bf16_t)f2bf(v[2 * p + 1]);
                                fo[oo + g * 128] = re; fo[om + 512 + 2 * g] = re; fo[oo + g * 128 + 64] = im; fo[om + 512 + 2 * g + 1] = im; }
                            else { fo[oo + own0 + ai * 256 + 16 * m] = re; fo[om + mir0 + ai * 256 - 16 * m] = re; }
                        }
                    asm volatile("" ::: "memory"); __builtin_amdgcn_sched_barrier(0);
                }
    }
};

struct EpiMerge {
    static constexpr bool PERM = true; static constexpr int MIDK = 10;
    unsigned char* ws;
    __device__ __forceinline__ void mid(f32x4 (&acc)[2][2][4][2], const Unit& u, int wr, int wc, int fr, int fq) const {
        asm volatile("" : "+v"(fr), "+v"(fq));
#pragma unroll
        for (int ai = 0; ai < 2; ++ai) {
            u32x4 gr[4][2];
#pragma unroll
            for (int m = 0; m < 4; ++m) { const size_t row = (size_t)(u.pm * 256 + ai * 128 + wr * 64 + m * 16 + fr);
#pragma unroll
                for (int bj = 0; bj < 2; ++bj) { const int col = u.pn * 256 + bj * 128 + wc * 32 + 8 * fq;
                    gr[m][bj] = *(const u32x4*)((const bf16_t*)(ws + WS_GF) + row * D + col); } }
            asm volatile("" ::: "memory");
#pragma unroll
            for (int m = 0; m < 4; ++m)
#pragma unroll
                for (int bj = 0; bj < 2; ++bj) { const u32x4 g_ = gr[m][bj];
                    const f32x4 r0 = (f32x4){bflo(g_.x), bfhi(g_.x), bflo(g_.y), bfhi(g_.y)}, r1 = (f32x4){bflo(g_.z), bfhi(g_.z), bflo(g_.w), bfhi(g_.w)};
                    acc[ai][bj][m][0] = acc[ai][bj][m][0] * r0; acc[ai][bj][m][1] = acc[ai][bj][m][1] * r1; }
            asm volatile("" ::: "memory");
        }
    }
    __device__ __forceinline__ void operator()(const f32x4 (&acc)[2][2][4][2], const Unit& u, int wr, int wc, int fr, int fq) const {
#pragma unroll
        for (int ai = 0; ai < 2; ++ai)
#pragma unroll
            for (int m = 0; m < 4; ++m) { const size_t row = (size_t)(u.pm * 256 + ai * 128 + wr * 64 + m * 16 + fr);
#pragma unroll
                for (int bj = 0; bj < 2; ++bj) { const int col = u.pn * 256 + bj * 128 + wc * 32 + 8 * fq;
                    const u32x4 ga = *(const u32x4*)((const bf16_t*)(ws + WS_GA) + row * D + col);
                    const f32x4 a0 = acc[ai][bj][m][0], a1 = acc[ai][bj][m][1];
                    u32x4 w;
                    w.x = cvt_pk_bf16(bflo(ga.x) * a0[0], bfhi(ga.x) * a0[1]); w.y = cvt_pk_bf16(bflo(ga.y) * a0[2], bfhi(ga.y) * a0[3]);
                    w.z = cvt_pk_bf16(bflo(ga.z) * a1[0], bfhi(ga.z) * a1[1]); w.w = cvt_pk_bf16(bflo(ga.w) * a1[2], bfhi(ga.w) * a1[3]);
                    *(u32x4*)((bf16_t*)(ws + WS_Y) + row * D + col) = w; } }
    }
};

struct EpiResid {
    static constexpr bool PERM = true; static constexpr int MIDK = 0;
    const float* xl_in32; const bf16_t* xl_inb; bf16_t* xl_out; const float* xc_in; float* xc_out; const float* mod_l; int chunk; float* tmpc;
    __device__ __forceinline__ void operator()(const f32x4 (&acc)[2][2][4][2], const Unit& u, int wr, int wc, int fr, int fq) const {
        asm volatile("" : "+v"(fr), "+v"(fq));
        const int v = u.pm < 32 ? 0 : (u.pm < 64 ? 1 : 2);
        const float* gate = mod_l + v * MODSZ + chunk * D;
        const bool lat = u.pm < 64; const int rbase = lat ? u.pm * 256 : (u.pm - 64) * 256;
        const bool f32src = lat ? (xl_in32 != nullptr) : true;
#pragma unroll
        for (int bj = 0; bj < 2; ++bj) { const int col = u.pn * 256 + bj * 128 + wc * 32 + 8 * fq;
            const f32x4 g0 = *(const f32x4*)(gate + col), g1 = *(const f32x4*)(gate + col + 4);
#pragma unroll
            for (int ai = 0; ai < 2; ++ai) {
                f32x4 x0[4], x1[4];
                if (!(!lat && u.kh)) {
                    if (f32src) { const float* src = lat ? xl_in32 : xc_in;
#pragma unroll
                        for (int m = 0; m < 4; ++m) { const size_t o = (size_t)(rbase + ai * 128 + wr * 64 + m * 16 + fr) * D + col; x0[m] = *(const f32x4*)(src + o); x1[m] = *(const f32x4*)(src + o + 4); } }
                    else {
                        u32x4 xb[4];
#pragma unroll
                        for (int m = 0; m < 4; ++m) { const size_t o = (size_t)(rbase + ai * 128 + wr * 64 + m * 16 + fr) * D + col; xb[m] = *(const u32x4*)(xl_inb + o); }
                        asm volatile("" ::: "memory");
#pragma unroll
                        for (int m = 0; m < 4; ++m) { x0[m] = (f32x4){bflo(xb[m].x), bfhi(xb[m].x), bflo(xb[m].y), bfhi(xb[m].y)}; x1[m] = (f32x4){bflo(xb[m].z), bfhi(xb[m].z), bflo(xb[m].w), bfhi(xb[m].w)}; } }
                }
                asm volatile("" ::: "memory");
#pragma unroll
                for (int m = 0; m < 4; ++m) { const size_t o = (size_t)(rbase + ai * 128 + wr * 64 + m * 16 + fr) * D + col;
                    if (lat) {
                        const f32x4 y0 = x0[m] + g0 * acc[ai][bj][m][0], y1 = x1[m] + g1 * acc[ai][bj][m][1];
                        u32x4 w; w.x = cvt_pk_bf16(y0[0], y0[1]); w.y = cvt_pk_bf16(y0[2], y0[3]); w.z = cvt_pk_bf16(y1[0], y1[1]); w.w = cvt_pk_bf16(y1[2], y1[3]);
                        *(u32x4*)(xl_out + o) = w;
                    } else if (u.kh) { *(f32x4*)(tmpc + o) = g0 * acc[ai][bj][m][0]; *(f32x4*)(tmpc + o + 4) = g1 * acc[ai][bj][m][1]; }
                    else { *(f32x4*)(xc_out + o) = x0[m] + g0 * acc[ai][bj][m][0];
                           *(f32x4*)(xc_out + o + 4) = x1[m] + g1 * acc[ai][bj][m][1]; } }
                asm volatile("" ::: "memory");
            } }
    }
};

struct EpiSwiglu {
    static constexpr bool PERM = true; static constexpr int MIDK = 0;
    bf16_t* act; int ld;
    __device__ __forceinline__ void operator()(const f32x4 (&acc)[2][2][4][2], const Unit& u, int wr, int wc, int fr, int fq) const {
        const int col = u.pn * 128 + wc * 32 + 8 * fq;
#pragma unroll
        for (int ai = 0; ai < 2; ++ai)
#pragma unroll
            for (int m = 0; m < 4; ++m) { const size_t row = (size_t)(u.x0 + ai * 128 + wr * 64 + m * 16 + fr);
                float o[8];
#pragma unroll
                for (int n = 0; n < 2; ++n)
#pragma unroll
                    for (int q = 0; q < 4; ++q) { const float gv = acc[ai][0][m][n][q], uv = acc[ai][1][m][n][q]; o[4 * n + q] = gv * sigmoidf_(gv) * uv; }
                u32x4 w; w.x = cvt_pk_bf16(o[0], o[1]); w.y = cvt_pk_bf16(o[2], o[3]); w.z = cvt_pk_bf16(o[4], o[5]); w.w = cvt_pk_bf16(o[6], o[7]);
                *(u32x4*)(act + row * ld + col) = w; }
    }
};
struct EpiSwigluI8 {
    static constexpr bool PERM = true; static constexpr int MIDK = 0;
    bf16_t* act; int ld; const float* rs; const float* cs;
    __device__ __forceinline__ void operator()(const f32x4 (&acc)[2][2][4][2], const Unit& u, int wr, int wc, int fr, int fq) const {
        asm volatile("" : "+v"(fr), "+v"(fq));
        const int col = u.pn * 128 + wc * 32 + 8 * fq;
        const float* cg = cs + u.pn * 256 + wc * 32 + 8 * fq;
        const f32x4 g0 = *(const f32x4*)cg, g1 = *(const f32x4*)(cg + 4), u0 = *(const f32x4*)(cg + 128), u1 = *(const f32x4*)(cg + 132);
        const float csg[8] = {g0.x, g0.y, g0.z, g0.w, g1.x, g1.y, g1.z, g1.w}, csu[8] = {u0.x, u0.y, u0.z, u0.w, u1.x, u1.y, u1.z, u1.w};
        float rsv[2][4];
#pragma unroll
        for (int ai = 0; ai < 2; ++ai)
#pragma unroll
            for (int m = 0; m < 4; ++m) rsv[ai][m] = rs[(size_t)(u.x0 + ai * 128 + wr * 64 + m * 16 + fr)];
        asm volatile("" ::: "memory");
#pragma unroll
        for (int ai = 0; ai < 2; ++ai)
#pragma unroll
            for (int m = 0; m < 4; ++m) { const size_t row = (size_t)(u.x0 + ai * 128 + wr * 64 + m * 16 + fr);
                const float rsc = rsv[ai][m];
                float o[8];
#pragma unroll
                for (int n = 0; n < 2; ++n) { const pg8::i32x4 gi = __builtin_bit_cast(pg8::i32x4, acc[ai][0][m][n]), ui = __builtin_bit_cast(pg8::i32x4, acc[ai][1][m][n]);
#pragma unroll
                    for (int q = 0; q < 4; ++q) { const float gv = (float)gi[q] * (rsc * csg[4 * n + q]), uv = (float)ui[q] * (rsc * csu[4 * n + q]);
                        o[4 * n + q] = gv * sigmoidf_(gv) * uv; } }
                u32x4 w; w.x = cvt_pk_bf16(o[0], o[1]); w.y = cvt_pk_bf16(o[2], o[3]); w.z = cvt_pk_bf16(o[4], o[5]); w.w = cvt_pk_bf16(o[6], o[7]);
                *(u32x4*)(act + row * ld + col) = w; }
    }
};
struct EpiSwiglu8 {
    static constexpr bool PERM = true; static constexpr int MIDK = 0;
    unsigned char* act; int ld;
    __device__ __forceinline__ void operator()(const f32x4 (&acc)[2][2][4][2], const Unit& u, int wr, int wc, int fr, int fq) const {
        asm volatile("" : "+v"(fr), "+v"(fq));
        const int col = u.pn * 128 + wc * 32 + 8 * fq;
#pragma unroll
        for (int ai = 0; ai < 2; ++ai)
#pragma unroll
            for (int m = 0; m < 4; ++m) { const size_t row = (size_t)(u.x0 + ai * 128 + wr * 64 + m * 16 + fr);
                float o[8];
#pragma unroll
                for (int n = 0; n < 2; ++n)
#pragma unroll
                    for (int q = 0; q < 4; ++q) { const float gv = acc[ai][0][m][n][q] * (1.0f / (float)QGU), uv = acc[ai][1][m][n][q] * ((float)QACT / (float)QGU);
                        o[4 * n + q] = __builtin_amdgcn_fmed3f(gv * sigmoidf_(gv) * uv, -448.0f, 448.0f); }
                u32x2 w; w.x = pk4f8(o[0], o[1], o[2], o[3]); w.y = pk4f8(o[4], o[5], o[6], o[7]);
                *(u32x2*)(act + row * ld + col) = w; }
    }
};
struct EpiBf16 {
    static constexpr bool PERM = true; static constexpr int MIDK = 0;
    bf16_t* O0; bf16_t* O1; int ld;
    __device__ __forceinline__ void operator()(const f32x4 (&acc)[2][2][4][2], const Unit& u, int wr, int wc, int fr, int fq) const {
        asm volatile("" : "+v"(fr), "+v"(fq));
#pragma unroll
        for (int ai = 0; ai < 2; ++ai)
#pragma unroll
            for (int m = 0; m < 4; ++m) { const size_t row = (size_t)(u.x0 + ai * 128 + wr * 64 + m * 16 + fr);
#pragma unroll
                for (int bj = 0; bj < 2; ++bj) { const int col = u.pn * 256 + bj * 128 + wc * 32 + 8 * fq; const f32x4 v0 = acc[ai][bj][m][0], v1 = acc[ai][bj][m][1];
                    u32x4 w; w.x = cvt_pk_bf16(v0[0], v0[1]); w.y = cvt_pk_bf16(v0[2], v0[3]); w.z = cvt_pk_bf16(v1[0], v1[1]); w.w = cvt_pk_bf16(v1[2], v1[3]);
                    *(u32x4*)((u.kh ? O1 : O0) + row * ld + col) = w; } }
    }
};

struct RowSched { int nM, nN, G, c; unsigned abytes, bbytes;
    __device__ __forceinline__ bool next(int i, Unit& u) const { const int L = i * G + c; if (L >= nM * nN) return false; pg8::swz_map(L, nM, nN, u.pm, u.pn); u.aoff = (unsigned)u.pm * abytes; u.boff = (unsigned)u.pn * bbytes; u.kind = 0; u.x0 = u.pm * 256; u.x1 = 0; u.kh = 0; return true; } };

struct MoeSched { int G, c, nN, ksplit, trim; unsigned bexp, bbytes, arow_bytes, khbytes; bool a_slots; int cnt[NE], base[NE];
    __device__ __forceinline__ void init(const unsigned* cw) { int b = 0;
#pragma unroll
        for (int e = 0; e < NE; ++e) { cnt[e] = (int)cw[64 * e]; base[e] = b; b += (cnt[e] + 255) & ~255; } }
    __device__ __forceinline__ bool next(int i, Unit& u) const { int L = i * G + c; int e = 0;
        for (; e < NE; ++e) { const int nu = (((cnt[e] + 255) >> 8) - (e == NE - 1 ? trim : 0)) * nN * ksplit; if (L < nu) break; L -= nu; }
        if (e >= NE) return false;
        int cn = 0, bs = 0;
#pragma unroll
        for (int q = 0; q < NE; ++q) if (q == e) { cn = cnt[q]; bs = base[q]; }
        const int np_ = ((cn + 255) >> 8) - (e == NE - 1 ? trim : 0); const int nt_ = np_ * nN; u.kh = L / nt_; L -= u.kh * nt_;
        pg8::swz_map(L, np_, nN, u.pm, u.pn);
        u.kind = e; u.x1 = cn; u.x0 = bs + u.pm * 256;
        u.aoff = (a_slots ? (unsigned)u.x0 * arow_bytes : 0u) + (unsigned)u.kh * khbytes; u.boff = (unsigned)e * bexp + (unsigned)u.pn * bbytes + (unsigned)u.kh * khbytes; return true; } };
struct MoeTailSched { int G, c, trim, plast, rbase; unsigned bexp;
    __device__ __forceinline__ bool next(int i, Unit& u) const { int L = i * G + c; if (L >= 8 * trim) return false; u.kh = L / (4 * trim); L -= u.kh * 4 * trim;
        u.pm = plast - trim + (L >> 2); u.pn = L & 3; u.kind = NE - 1; u.x1 = 0; u.x0 = rbase + u.pm * 256;
        u.aoff = (unsigned)u.x0 * (unsigned)DFFE + (unsigned)u.kh * (DFFE / 2u); u.boff = (unsigned)(NE - 1) * bexp + (unsigned)u.pn * (256u * DFFE) + (unsigned)u.kh * (DFFE / 2u); return true; } };
struct EpiTail {
    static constexpr bool PERM = true; static constexpr int MIDK = 0;
    bf16_t* O0; bf16_t* Q; int row0;
    __device__ __forceinline__ void operator()(const f32x4 (&acc)[2][2][4][2], const Unit& u, int wr, int wc, int fr, int fq) const {
        asm volatile("" : "+v"(fr), "+v"(fq));
#pragma unroll
        for (int ai = 0; ai < 2; ++ai)
#pragma unroll
            for (int m = 0; m < 4; ++m) { const int row = u.x0 + ai * 128 + wr * 64 + m * 16 + fr;
                bf16_t* dst = u.kh == 0 ? O0 + (size_t)row * D : Q + ((size_t)(u.kh - 1) * TAILQ_ROWS + (size_t)(row - row0)) * D;
#pragma unroll
                for (int bj = 0; bj < 2; ++bj) { const int col = u.pn * 256 + bj * 128 + wc * 32 + 8 * fq; const f32x4 v0 = acc[ai][bj][m][0], v1 = acc[ai][bj][m][1];
                    u32x4 w; w.x = cvt_pk_bf16(v0[0], v0[1]); w.y = cvt_pk_bf16(v0[2], v0[3]); w.z = cvt_pk_bf16(v1[0], v1[1]); w.w = cvt_pk_bf16(v1[2], v1[3]);
                    *(u32x4*)(dst + col) = w; } }
    }
};
struct MoeRows { static constexpr bool GA = true, GB = false; const int* list;
    __device__ __forceinline__ unsigned arow(const Unit& u, int r) const { int idx = u.pm * 256 + r; idx = idx < u.x1 ? idx : u.x1 - 1; return (unsigned)list[u.kind * NL + idx] * (unsigned)D; }
    __device__ __forceinline__ unsigned brow(const Unit&, int) const { return 0u; } };


constexpr int CW_QUEUE = 12288, CW_RDY = 65536;
template <int NG, bool MOE> struct FfnStream {
    int P[NG], rb[NG], cn[NG];
    int f, nNgu, Kdn; unsigned need;
    unsigned* q; volatile LAS unsigned* lw; unsigned* rdy; unsigned* tmo;
    __device__ __forceinline__ void finish_init(int G) { int sacc = 0; f = NG;
#pragma unroll
        for (int g = NG - 1; g >= 0; --g) { if (f == g + 1 && sacc + P[g] * 4 <= G) { sacc += P[g] * 4; f = g; } }
        if (f > NG - 1) f = NG - 1; }
    __device__ __forceinline__ bool decode(int L, SUnit& u) const {
        int pos = L, kind = -1, grp = 0, j = 0;
#pragma unroll
        for (int g = 0; g < NG; ++g) {
            { const int n = P[g] * nNgu; if (kind < 0) { if (pos < n) { kind = 0; grp = g; j = pos; } else pos -= n; } }
            if (g >= 1 && (g - 1) < f) { const int n = P[g - 1] * 4; if (kind < 0) { if (pos < n) { kind = 1; grp = g - 1; j = pos; } else pos -= n; } }
        }
#pragma unroll
        for (int g = 0; g < NG; ++g) if (g >= f) { const int n = P[g] * 4; if (kind < 0) { if (pos < n) { kind = 1; grp = g; j = pos; } else pos -= n; } }
        if (kind < 0) return false;
        int nM = 0, rbase = 0, cnt = 0;
#pragma unroll
        for (int g = 0; g < NG; ++g) if (g == grp) { nM = P[g]; rbase = rb[g]; cnt = cn[g]; }
        const int nN = kind == 0 ? nNgu : 4;
        const int nig = 8 * nN, gid = j / nig, fm = gid * 8, gsz = (nM - fm) < 8 ? (nM - fm) : 8;
        u.pm = fm + ((j % nig) % gsz); u.pn = (j % nig) / gsz; u.kind = kind; u.grp = grp; u.x0 = rbase + u.pm * 256; u.x1 = cnt;
        const int gp = u.x0 >> 8;
        if (kind == 0) { u.K = D; u.dep = -1; u.sig = gp;
            u.aoff = (unsigned)WS_H + (unsigned)u.x0 * (D * 2u);
            u.boff = (MOE ? (unsigned)WS_WGUE + (unsigned)grp * (2u * DFFE * D * 2u) : (unsigned)WS_WGUD) + (unsigned)u.pn * (256u * D * 2u); }
        else { u.K = Kdn; u.dep = gp; u.sig = -1;
            u.aoff = (unsigned)WS_ACT + (unsigned)u.x0 * ((unsigned)Kdn * 2u);
            u.boff = (MOE ? (unsigned)WS_WDE + (unsigned)grp * ((unsigned)D * DFFE * 2u) : (unsigned)WS_WDD) + (unsigned)u.pn * (256u * (unsigned)Kdn * 2u); }
        return true;
    }
    __device__ __forceinline__ void a_ready(const SUnit& u) const {
        if (threadIdx.x < 64) {
            const unsigned long long t0 = __builtin_amdgcn_s_memrealtime(); unsigned polls = 0;
            while ((unsigned)__builtin_amdgcn_readfirstlane(__hip_atomic_load(rdy + 64 * u.dep, __ATOMIC_RELAXED, __HIP_MEMORY_SCOPE_AGENT)) < need) {
                if ((++polls & 255u) == 0u && __builtin_amdgcn_readfirstlane(__hip_atomic_load(tmo, __ATOMIC_RELAXED, __HIP_MEMORY_SCOPE_AGENT)) != 0u) break;
                if (__builtin_amdgcn_s_memrealtime() - t0 > 2000000ull) { if (threadIdx.x == 0) __hip_atomic_store(tmo, 1u, __ATOMIC_RELAXED, __HIP_MEMORY_SCOPE_AGENT); break; }
                __builtin_amdgcn_s_sleep(2); }
            __builtin_amdgcn_fence(__ATOMIC_ACQUIRE, "agent");
            asm volatile("s_waitcnt vmcnt(0)" ::: "memory");
        }
        asm volatile("" ::: "memory"); __builtin_amdgcn_s_barrier(); asm volatile("" ::: "memory");
    }
};
template <bool MOE> struct FfnRows { const int* list;
    __device__ __forceinline__ bool a_gather(const SUnit& u) const { return MOE && u.kind == 0; }
    __device__ __forceinline__ unsigned arow(const SUnit& u, int r) const { int idx = u.pm * 256 + r; idx = idx < u.x1 ? idx : u.x1 - 1; return (unsigned)WS_H + (unsigned)list[u.grp * NL + idx] * (D * 2u); } };

template <bool MOE> struct EpiFfn {
    static constexpr bool PERM = true; static constexpr int MIDK = 0;
    unsigned char* ws; float* xl; const float* mod_l;
    __device__ __forceinline__ void operator()(const f32x4 (&acc)[2][2][4][2], const SUnit& u, int wr, int wc, int fr, int fq) const {
        if (u.kind == 0) {
            constexpr int ld = MOE ? DFFE : DFF0;
            bf16_t* act = (bf16_t*)(ws + WS_ACT);
            const int col = u.pn * 128 + wc * 32 + 8 * fq;
#pragma unroll
            for (int ai = 0; ai < 2; ++ai)
#pragma unroll
                for (int m = 0; m < 4; ++m) { const size_t row = (size_t)(u.x0 + ai * 128 + wr * 64 + m * 16 + fr);
                    float o[8];
#pragma unroll
                    for (int n = 0; n < 2; ++n)
#pragma unroll
                        for (int q = 0; q < 4; ++q) { const float gv = acc[ai][0][m][n][q], uv = acc[ai][1][m][n][q]; o[4 * n + q] = gv * sigmoidf_(gv) * uv; }
                    u32x4 w; w.x = cvt_pk_bf16(o[0], o[1]); w.y = cvt_pk_bf16(o[2], o[3]); w.z = cvt_pk_bf16(o[4], o[5]); w.w = cvt_pk_bf16(o[6], o[7]);
                    pg8::st16_wt(ws, (unsigned)WS_ACT + ((unsigned)row * (unsigned)ld + (unsigned)col) * 2u, w); }
        } else if (MOE) {
            bf16_t* O = (bf16_t*)(ws + WS_DOUT);
#pragma unroll
            for (int ai = 0; ai < 2; ++ai)
#pragma unroll
                for (int m = 0; m < 4; ++m) { const size_t row = (size_t)(u.x0 + ai * 128 + wr * 64 + m * 16 + fr);
#pragma unroll
                    for (int bj = 0; bj < 2; ++bj) { const int col = u.pn * 256 + bj * 128 + wc * 32 + 8 * fq; const f32x4 v0 = acc[ai][bj][m][0], v1 = acc[ai][bj][m][1];
                        u32x4 w; w.x = cvt_pk_bf16(v0[0], v0[1]); w.y = cvt_pk_bf16(v0[2], v0[3]); w.z = cvt_pk_bf16(v1[0], v1[1]); w.w = cvt_pk_bf16(v1[2], v1[3]);
                        *(u32x4*)(O + row * D + col) = w; } }
        } else {
            asm volatile("" : "+v"(fr), "+v"(fq));
            const int pmg = u.x0 >> 8;
            const int v = pmg < 32 ? 0 : (pmg < 64 ? 1 : 2);
            const float* gate = mod_l + v * MODSZ + 5 * D;
            float* xo = pmg < 64 ? xl + (size_t)u.x0 * D : (float*)(ws + WS_XC) + (size_t)(u.x0 - NL) * D;
#pragma unroll
            for (int bj = 0; bj < 2; ++bj) { const int col = u.pn * 256 + bj * 128 + wc * 32 + 8 * fq;
                const f32x4 g0 = *(const f32x4*)(gate + col), g1 = *(const f32x4*)(gate + col + 4);
#pragma unroll
                for (int ai = 0; ai < 2; ++ai)
#pragma unroll
                    for (int m = 0; m < 4; ++m) { const size_t o = (size_t)(ai * 128 + wr * 64 + m * 16 + fr) * D + col;
                        *(f32x4*)(xo + o) = *(const f32x4*)(xo + o) + g0 * acc[ai][bj][m][0];
                        *(f32x4*)(xo + o + 4) = *(const f32x4*)(xo + o + 4) + g1 * acc[ai][bj][m][1];
                        asm volatile("" ::: "memory"); __builtin_amdgcn_sched_barrier(0); } }
        }
    }
};

__device__ __forceinline__ int crow(int r, int hi) { return (r & 3) + 8 * (r >> 2) + 4 * hi; }
__device__ __forceinline__ s16x4 vtr(const LAS unsigned char* p) { typedef short v4i16_t __attribute__((ext_vector_type(4))); return __builtin_bit_cast(s16x4, __builtin_amdgcn_ds_read_tr16_b64_v4i16((LAS v4i16_t*)p)); }

__device__ __forceinline__ void attn_unit(Frame& F, int l, int b, int hkv, int qb, bool ctxq) {
    const int tid = F.tid, lane = F.lane, wid = F.wave, r32 = lane & 31, hi = lane >> 5;
    const int g = wid >> 1, qs = wid & 1, head = hkv * 4 + g;
    const bf16_t* Q = (const bf16_t*)(F.ws + WS_Q); const bf16_t* KB = (const bf16_t*)(F.ws + WS_KB); const bf16_t* VB = (const bf16_t*)(F.ws + WS_VB);
    const int q0 = qb * 64;
    const int qrow = (ctxq ? NL + b * CTXL : b * T) + q0 + qs * 32 + r32;
    bf16x8 qr[4];
#pragma unroll
    for (int d0 = 0; d0 < 4; ++d0) qr[d0] = *(const bf16x8*)(Q + (size_t)qrow * 512 + head * 64 + d0 * 16 + hi * 8);
    int jlo = 0, jhi = -1;
    if (!ctxq) { jlo = -2; jhi = 2; if (q0 + 64 * jlo < 0) jlo = -(q0 / 64); if (q0 + 64 * jhi >= T) jhi = (T - 64 - q0) / 64; }
    const int nloc = jhi - jlo + 1, ntile = nloc + 4;
    const float sinkv = F.in[9][l * 8 + head] * LOG2E;
    float mrun = sinkv, lrun = 1.0f;
    f32x16 o[2]; o[0] = f32x16{}; o[1] = f32x16{};
    const int kkey = lane, vkey = 16 * (wid & 3) + (lane >> 2);
    auto tile_row = [&](int ti) -> int { return ti < nloc ? b * T + q0 + 64 * (jlo + ti) : NL + b * CTXL + 64 * (ti - nloc); };
    u32x4 kreg, vreg;
    { const int r0 = tile_row(0); kreg = *(const u32x4*)(KB + (size_t)(r0 + kkey) * 128 + hkv * 64 + wid * 8); vreg = *(const u32x4*)(VB + (size_t)(r0 + vkey) * 128 + hkv * 64 + (wid >> 2) * 32 + (lane & 3) * 8); }
    for (int ti = 0; ti < ntile; ++ti) {
        LAS unsigned char* slot = F.lds + (ti & 1) * 16384;
        *(LAS u32x4*)(slot + wid * 1024 + lane * 16) = kreg;
        *(LAS u32x4*)(slot + 8192 + wid * 1024 + lane * 16) = vreg;
        __syncthreads();
        if (ti + 1 < ntile) { const int r0 = tile_row(ti + 1); kreg = *(const u32x4*)(KB + (size_t)(r0 + kkey) * 128 + hkv * 64 + wid * 8); vreg = *(const u32x4*)(VB + (size_t)(r0 + vkey) * 128 + hkv * 64 + (wid >> 2) * 32 + (lane & 3) * 8); }
        f32x16 p0 = f32x16{}, p1 = f32x16{};
        { const LAS unsigned char* kb = slot + hi * 1024 + r32 * 16;
#pragma unroll
          for (int d0 = 0; d0 < 4; ++d0) { const bf16x8 k0 = *(const LAS bf16x8*)(kb + d0 * 2048), k1 = *(const LAS bf16x8*)(kb + d0 * 2048 + 512);
              p0 = __builtin_amdgcn_mfma_f32_32x32x16_bf16(k0, qr[d0], p0, 0, 0, 0); p1 = __builtin_amdgcn_mfma_f32_32x32x16_bf16(k1, qr[d0], p1, 0, 0, 0); } }
        if (ti < nloc) { const int j = jlo + ti; const int qq = qs * 32 + r32;
            if (j == -2) {
#pragma unroll
                for (int r = 0; r < 16; ++r) { const int kk = crow(r, hi); if (kk < qq) p0[r] = -INFINITY; if (kk + 32 < qq) p1[r] = -INFINITY; } }
            else if (j == 2) {
#pragma unroll
                for (int r = 0; r < 16; ++r) { const int kk = crow(r, hi); if (kk > qq) p0[r] = -INFINITY; if (kk + 32 > qq) p1[r] = -INFINITY; } } }
        float mx = p0[0];
#pragma unroll
        for (int r = 1; r < 16; ++r) mx = fmaxf(mx, p0[r]);
#pragma unroll
        for (int r = 0; r < 16; ++r) mx = fmaxf(mx, p1[r]);
        mx = fmaxf(mx, __shfl_xor(mx, 32));
        const float mnew = fmaxf(mrun, mx), fsc = __builtin_amdgcn_exp2f(mrun - mnew);
        mrun = mnew;
        float rs = 0.f;
#pragma unroll
        for (int r = 0; r < 16; ++r) { p0[r] = __builtin_amdgcn_exp2f(p0[r] - mnew); p1[r] = __builtin_amdgcn_exp2f(p1[r] - mnew); rs += p0[r] + p1[r]; }
        rs += __shfl_xor(rs, 32);
        lrun = lrun * fsc + rs;
#pragma unroll
        for (int r = 0; r < 16; ++r) { o[0][r] *= fsc; o[1][r] *= fsc; }
        u32x4 pw[4];
        pw[0] = (u32x4){cvt_pk_bf16(p0[0], p0[1]), cvt_pk_bf16(p0[2], p0[3]), cvt_pk_bf16(p0[4], p0[5]), cvt_pk_bf16(p0[6], p0[7])};
        pw[1] = (u32x4){cvt_pk_bf16(p0[8], p0[9]), cvt_pk_bf16(p0[10], p0[11]), cvt_pk_bf16(p0[12], p0[13]), cvt_pk_bf16(p0[14], p0[15])};
        pw[2] = (u32x4){cvt_pk_bf16(p1[0], p1[1]), cvt_pk_bf16(p1[2], p1[3]), cvt_pk_bf16(p1[4], p1[5]), cvt_pk_bf16(p1[6], p1[7])};
        pw[3] = (u32x4){cvt_pk_bf16(p1[8], p1[9]), cvt_pk_bf16(p1[10], p1[11]), cvt_pk_bf16(p1[12], p1[13]), cvt_pk_bf16(p1[14], p1[15])};
        { const LAS unsigned char* vb = slot + 8192 + ((lane >> 4) & 1) * 32 + (lane & 3) * 8 + (4 * hi + ((lane & 15) >> 2)) * 64;
#pragma unroll
          for (int d0 = 0; d0 < 2; ++d0)
#pragma unroll
              for (int ks = 0; ks < 4; ++ks) { const s16x4 lo = vtr(vb + d0 * 4096 + ks * 1024), hh = vtr(vb + d0 * 4096 + ks * 1024 + 512);
                  const bf16x8 vf = (bf16x8){lo[0], lo[1], lo[2], lo[3], hh[0], hh[1], hh[2], hh[3]};
                  o[d0] = __builtin_amdgcn_mfma_f32_32x32x16_bf16(vf, __builtin_bit_cast(bf16x8, pw[ks]), o[d0], 0, 0, 0); } }
    }
    const float rl = 1.0f / lrun;
    bf16_t* orow = (bf16_t*)(F.ws + WS_FO) + (size_t)qrow * KM + 640 + head * 64;
#pragma unroll
    for (int d0 = 0; d0 < 2; ++d0)
#pragma unroll
        for (int rq = 0; rq < 4; ++rq) { u32x2 w; w.x = cvt_pk_bf16(o[d0][4 * rq] * rl, o[d0][4 * rq + 1] * rl); w.y = cvt_pk_bf16(o[d0][4 * rq + 2] * rl, o[d0][4 * rq + 3] * rl);
            *(u32x2*)(orow + 32 * d0 + 8 * rq + 4 * hi) = w; }
    __syncthreads();
}

__device__ __forceinline__ void attn_phase(Frame& F, int l, int part) {
    const int nlat = NB * 2 * 128;
    auto lat_unit = [&](int it) { const int qb = it & 127, hkv = (it >> 7) & 1, b = it >> 8; attn_unit(F, l, b, hkv, qb, false); };
    if (part == 0) {
        const bool extra = (l == 0) && F.G == 256 && ((F.bx >= 16 && F.bx < 24) || F.bx >= 240);
        if (!extra) for (int it = F.bx; it < 256; it += F.G) lat_unit(it);
        if (l == 0) for (int r = (F.bx + F.G - 240) % F.G; r < NB * 2 * 4; r += F.G) { const int qb = r & 3, hkv = (r >> 2) & 1, b = r >> 3; attn_unit(F, l, b, hkv, qb, true); }
    } else {
        const bool busy = (l == 0) && F.bx >= 128 && F.bx < 136;
        if (!busy) for (int it = 256 + F.bx; it < nlat; it += F.G) lat_unit(it);
        if (l == 0 && F.bx >= 136 && F.bx < 144) lat_unit(256 + F.bx - 8);
        if (l == 0 && F.G == 256 && F.bx >= 144 && F.bx < 168) { const int k = F.bx - 144; lat_unit(k < 8 ? 16 + k : 240 + (k - 8)); }
    }
}

#if !MK_MULTI
#define GRID_BAR() xcd_barrier(bar)
#else
#define GRID_BAR() do {} while (0)
#endif
#ifndef PH_MASK
#define PH_MASK 0xFFFFFu
#endif
#define IN(k) (((PH_MASK >> (k)) & 1u) && lo <= (k) && (k) < hi)
#define SEAM(k) do { if (IN((k) + 1)) GRID_BAR(); } while (0)
#ifndef REP_MASK
#define REP_MASK 0u
#endif
#define REPS(k) ((((REP_MASK) >> (k)) & 1u) ? 2 : 1)
template <int l, class BarT>
__device__ __forceinline__ void layer_phases(Frame& F, unsigned* ctl, const int lo, const int hi, const BarT& bar) {
        const int pb = 1 + 8 * l;
        bf16_t* H = (bf16_t*)(F.ws + WS_H);
        const float* xl_in = l == 0 ? F.in[0] : nullptr;
        bf16_t* XB = (bf16_t*)(F.ws + WS_XB);
        const float* xc_in = l == 0 ? F.in[2] : (const float*)(F.ws + WS_XC);
        float* xc = (float*)(F.ws + WS_XC);
        const float* mod_l = (const float*)ctl + CW_MOD + l * 3 * MODSZ;
        if (IN(pb + 0)) { for (int rep = 0; rep < REPS(pb + 0); ++rep) norm_phase<false, 3>(F, l, 0, xl_in, xc_in, NTOK, l == 1 ? (const float*)(F.ws + WS_TMPC2) : nullptr, nullptr); SEAM(pb + 0); }
        if (IN(pb + 1)) {
            for (int rep = 0; rep < REPS(pb + 1); ++rep) {
            { pg8::Gemm g{(const bf16_t*)(F.ws + WS_H8), (const bf16_t*)(F.ws + (l ? WS_WIN1 : WS_WIN0)) + (size_t)512 * D, D / 2, D / 2}; InprojSched S{F.G, F.bx, l}; EpiInproj E{F.ws, (const float*)(F.ws + WS_RS), (const float*)(F.ws + WS_CSI) + l * 2816}; pg8::NoGather R;
              pg8::gemm_phasei8(F.lds, g, S, E, R); }
            { pg8::Gemm g{(const bf16_t*)(F.ws + (l ? WS_WIN1 : WS_WIN0)), H, D, D}; UpermSched S{F.G, F.bx, l}; EpiUperm E{F.ws}; UpermRows R;
              pg8::gemm_phase(F.lds, g, S, E, R); }
            }
            SEAM(pb + 1);
        }
        if (IN(pb + 2)) {
            for (int rep = 0; rep < REPS(pb + 2); ++rep) {
            attn_phase(F, l, 0);
            { pg8::Gemm g{(const bf16_t*)(F.ws + WS_UP), (const bf16_t*)(F.ws + WS_FA64), 128, 128}; StepASched S{F.G, F.bx, l}; EpiStepA E{F.ws}; pg8::NoGather R;
              pg8::gemm_phase(F.lds, g, S, E, R); }
            if (l == 0) { pg8::Gemm g{(const bf16_t*)(F.ws + WS_VCT), (const bf16_t*)(F.ws + WS_TX), 512, 512}; GridSched S{2, 2, F.G, (F.bx + F.G - 16) % F.G, 256u * 512u * 2u, 256u * 512u * 2u}; EpiStepC<true> E{F.ws}; pg8::NoGather R;
              pg8::gemm_phase(F.lds, g, S, E, R); }
            }
            SEAM(pb + 2);
        }
        if (IN(pb + 3)) {
            for (int rep = 0; rep < REPS(pb + 3); ++rep) {
            { pg8::Gemm g{(const bf16_t*)(F.ws + WS_GP), (const bf16_t*)(F.ws + WS_TC), 256, 256}; GridSched S{128, 1, F.G, F.bx, 256u * 256u * 2u, 0u}; EpiStepC<false> E{F.ws}; pg8::NoGather R;
              pg8::gemm_phase(F.lds, g, S, E, R); }
            if (l == 0) { pg8::Gemm g{(const bf16_t*)(F.ws + WS_FO), (const bf16_t*)(F.ws + WS_WM0), KM, KM}; CtxSched S{F.G, (F.bx + F.G - 128) % F.G, 4, 256u * KM * 2u, 256u * KM * 2u, 1, 0u}; EpiMerge E{F.ws}; pg8::NoGather R;
              pg8::gemm_phase(F.lds, g, S, E, R); }
            attn_phase(F, l, 1);
            }
            SEAM(pb + 3);
        }
        if (IN(pb + 4)) {
            const int nM = 64;
            pg8::Gemm g{(const bf16_t*)(F.ws + WS_FO), (const bf16_t*)(F.ws + (l ? WS_WM1 : WS_WM0)), KM, KM}; GridSched S{nM, 4, F.G, F.bx, 256u * KM * 2u, 256u * KM * 2u}; EpiMerge E{F.ws}; pg8::NoGather R;
            for (int rep = 0; rep < REPS(pb + 4); ++rep) pg8::gemm_phase(F.lds, g, S, E, R);
            SEAM(pb + 4);
        }
        if (IN(pb + 5)) {
            EpiResid E{xl_in, XB, XB, xc_in, xc, mod_l, 2, (float*)(F.ws + WS_TMPC1)}; pg8::NoGather R;
            for (int rep = 0; rep < (l == 0 ? REPS(6) : 1); ++rep)
            { pg8::Gemm g{(const bf16_t*)(F.ws + WS_Y), (const bf16_t*)(F.ws + (l ? WS_WO1 : WS_WO0)), D, D}; GridSched S{64, 4, F.G, F.bx, 256u * D * 2u, 256u * D * 2u};
              pg8::gemm_phase(F.lds, g, S, E, R); }
            if (l == 0) { pg8::Gemm g{(const bf16_t*)(F.ws + WS_Y), (const bf16_t*)(F.ws + WS_WO0), D / 2, D}; CtxSched S{F.G, F.bx, 4, 256u * D * 2u, 256u * D * 2u, 2, (unsigned)D};
              pg8::gemm_phase(F.lds, g, S, E, R); }
            SEAM(pb + 5);
        }
        if (IN(pb + 6)) {
            if (l == 0) norm_phase<false, 2>(F, l, 1, nullptr, xc, NTOK, (const float*)(F.ws + WS_TMPC1), xc); else { norm_phase<true>(F, l, 1, nullptr, xc, NL); for (int rep = 0; rep < REPS(21); ++rep) moe_convert_all(F); }
            SEAM(pb + 6);
        }
#ifndef STREAM0
#define STREAM0 0
#endif
#ifndef STREAM1
#define STREAM1 0
#endif
        if (IN(pb + 7)) {
            volatile LAS unsigned* lw = (volatile LAS unsigned*)(F.lds + MISC_OFF) + 16;
            if (l == 0) {
#if STREAM0
                FfnStream<9, false> S;
#pragma unroll
                for (int g = 0; g < 9; ++g) { S.P[g] = g < 8 ? 8 : 2; S.rb[g] = 2048 * g; S.cn[g] = g < 8 ? 2048 : 512; }
                S.nNgu = 22; S.Kdn = DFF0; S.need = 22u * 8u; S.q = ctl + CW_QUEUE; S.lw = lw; S.rdy = ctl + CW_RDY; S.tmo = ctl + 2; S.finish_init(F.G);
                EpiFfn<false> E{F.ws, F.out, mod_l}; FfnRows<false> R{nullptr};
                pg8::gemm_stream(F.lds, (const char*)F.ws, S, E, R);
#else
                for (int rep = 0; rep < REPS(18); ++rep)
                { pg8::Gemm g{H, (const bf16_t*)(F.ws + WS_WGUD), D / 2, D / 2}; RowSched S{66, 22, F.G, F.bx, 256u * D, 256u * D}; EpiSwigluI8 E{(bf16_t*)(F.ws + WS_ACT), DFF0, (const float*)(F.ws + WS_RS), (const float*)(F.ws + WS_CSD)}; pg8::NoGather R;
                  pg8::gemm_phasei8(F.lds, g, S, E, R); }
                GRID_BAR();
                { EpiResid E{nullptr, XB, XB, xc, xc, mod_l, 5, (float*)(F.ws + WS_TMPC2)}; pg8::NoGather R;
                  { pg8::Gemm g{(const bf16_t*)(F.ws + WS_ACT), (const bf16_t*)(F.ws + WS_WDD), DFF0, DFF0}; GridSched S{64, 4, F.G, F.bx, 256u * DFF0 * 2u, 256u * DFF0 * 2u};
                    pg8::gemm_phase(F.lds, g, S, E, R); }
                  { pg8::Gemm g{(const bf16_t*)(F.ws + WS_ACT), (const bf16_t*)(F.ws + WS_WDD), DFF0 / 2, DFF0}; CtxSched S{F.G, F.bx, 4, 256u * DFF0 * 2u, 256u * DFF0 * 2u, 2, (unsigned)DFF0};
                    pg8::gemm_phase(F.lds, g, S, E, R); } }

#endif
            } else {
#if STREAM1
                FfnStream<8, true> S; { int bacc = 0;
#pragma unroll
                for (int e = 0; e < NE; ++e) { const int c = (int)ctl[CW_CNT + 64 * e]; S.cn[e] = c; S.P[e] = (c + 255) >> 8; S.rb[e] = bacc; bacc += ((c + 255) >> 8) << 8; } }
                S.nNgu = 28; S.Kdn = DFFE; S.need = 28u * 8u; S.q = ctl + CW_QUEUE + 64; S.lw = lw; S.rdy = ctl + CW_RDY + 64 * 80; S.tmo = ctl + 2; S.finish_init(F.G);
                EpiFfn<true> E{F.ws, F.out, mod_l}; FfnRows<true> R{(const int*)(F.ws + WS_LIST)};
                pg8::gemm_stream(F.lds, (const char*)F.ws, S, E, R);
#else
                for (int rep = 0; rep < REPS(19); ++rep)
                { pg8::Gemm g{H, (const bf16_t*)(F.ws + WS_WGUE), D / 2, D / 2}; MoeSched S; S.G = F.G; S.c = F.bx; S.nN = 28; S.ksplit = 1; S.trim = 0; S.khbytes = 0; S.bexp = 2u * DFFE * D; S.bbytes = 256u * D; S.arow_bytes = 0; S.a_slots = false; S.init(ctl + CW_CNT);
                  EpiSwiglu8 E{F.ws + WS_ACT, DFFE}; MoeRows R{(const int*)(F.ws + WS_LIST)};
                  pg8::gemm_phase8(F.lds, g, S, E, R); }
                GRID_BAR();
                { const int trim = moe_tail_panels(ctl + CW_CNT, F.G);
                  MoeSched S; S.G = F.G; S.c = F.bx; S.nN = 4; S.ksplit = 1; S.trim = trim; S.khbytes = 0; S.bexp = (unsigned)D * DFFE; S.bbytes = 256u * DFFE; S.arow_bytes = (unsigned)DFFE; S.a_slots = true; S.init(ctl + CW_CNT);
                  for (int rep = 0; rep < REPS(20); ++rep)
                  { pg8::Gemm g{(const bf16_t*)(F.ws + WS_ACT), (const bf16_t*)(F.ws + WS_WDE), DFFE / 2, DFFE / 2};
                    EpiBf16 E{(bf16_t*)(F.ws + WS_DOUT), (bf16_t*)(F.ws + WS_DOUT), D}; pg8::NoGather R;
                    pg8::gemm_phase8(F.lds, g, S, E, R); }
                  for (int rep = 0; rep < REPS(23); ++rep)
                  if (trim > 0) {
                    const int plast = (S.cnt[NE - 1] + 255) >> 8;
                    pg8::Gemm g{(const bf16_t*)(F.ws + WS_ACT), (const bf16_t*)(F.ws + WS_WDE), DFFE / 4, DFFE / 2};
                    MoeTailSched T{F.G, F.bx, trim, plast, S.base[NE - 1], (unsigned)D * DFFE};
                    EpiTail E{(bf16_t*)(F.ws + WS_DOUT), (bf16_t*)(F.ws + WS_DOUT1), S.base[NE - 1] + (plast - trim) * 256}; pg8::NoGather R;
                    pg8::gemm_phase8(F.lds, g, T, E, R); } }
#endif
            }
            SEAM(pb + 7);
        }
}

constexpr int NPHASE = 18;
__global__ void __launch_bounds__(NTHR, 2) fwd_kernel(Args args) {
    extern __shared__ __attribute__((aligned(16))) unsigned char lds_raw[];
    Frame F;
    F.lds = (LAS unsigned char*)lds_raw; F.ws = args.ws; F.in = args.in; F.out = args.out;
    F.tid = threadIdx.x; F.lane = F.tid & 63; F.wave = __builtin_amdgcn_readfirstlane(F.tid >> 6); F.G = gridDim.x; F.bx = blockIdx.x;
    volatile LAS unsigned* MISC = (volatile LAS unsigned*)(F.lds + MISC_OFF);
    if (F.tid < 32) MISC[F.tid] = 0u;
    __syncthreads();
    unsigned* ctl = (unsigned*)(F.ws + WS_CTL);
#if !MK_MULTI
    XcdBarrier bar = xcd_barrier_post(ctl + CW_BAR, MISC + 8);
#else
    XcdBarrier bar; bar.bar = ctl + CW_BAR; bar.x = 0; bar.st = MISC + 8;
#endif
    const int lo = args.ph_lo, hi = args.ph_hi;
    if (IN(0)) { for (int rep = 0; rep < REPS(0); ++rep) { p0_prologue(F); __syncthreads(); } SEAM(0); }
    layer_phases<0>(F, ctl, lo, hi, bar);
    layer_phases<1>(F, ctl, lo, hi, bar);
    if (IN(17)) for (int rep = 0; rep < REPS(17); ++rep) final_phase(F);
}

extern "C" void kernel_launch(void* const* d_in, const int* in_sizes, int n_in, void* d_out, int out_size, void* d_ws, size_t ws_size, hipStream_t stream) {
    static int grid = 0;
    if (grid == 0) {
        if (n_in != 21 || out_size != NL * D || ws_size < WS_END) { fprintf(stderr, "kernel_launch: unexpected problem (n_in %d out %d ws %zu)\n", n_in, out_size, ws_size); grid = -1; return; }
        int dev = 0, cus = 0;
        hipGetDevice(&dev); hipDeviceGetAttribute(&cus, hipDeviceAttributeMultiprocessorCount, dev);
        if (hipFuncSetAttribute((const void*)fwd_kernel, hipFuncAttributeMaxDynamicSharedMemorySize, LDS_BYTES) != hipSuccess) { fprintf(stderr, "kernel_launch: hipFuncSetAttribute failed\n"); grid = -1; return; }
        int per_cu = 0; (void)hipOccupancyMaxActiveBlocksPerMultiprocessor(&per_cu, (const void*)fwd_kernel, NTHR, LDS_BYTES); (void)hipGetLastError();
        grid = cus;
    }
    if (grid < 0) return;
    hipMemsetAsync((char*)d_ws + WS_CTL, 0, CTL_BYTES, stream);
#ifdef DBG_SCRUB
    hipMemsetAsync((char*)d_ws + CTL_BYTES, 0, WS_END - CTL_BYTES, stream);
#endif
    Args a{};
    for (int i = 0; i < 21; ++i) a.in[i] = (const float*)d_in[i];
    a.out = (float*)d_out; a.ws = (unsigned char*)d_ws;
#if MK_MULTI
    for (int p = 0; p < NPHASE; ++p) { a.ph_lo = p; a.ph_hi = p + 1; hipLaunchKernelGGL(fwd_kernel, dim3(grid), dim3(NTHR), LDS_BYTES, stream, a); }
#else
    a.ph_lo = 0; a.ph_hi = NPHASE;
    hipLaunchKernelGGL(fwd_kernel, dim3(grid), dim3(NTHR), LDS_BYTES, stream, a);
#endif
}
```

```cpp
#include <hip/hip_runtime.h>
#include <cstdio>
#include <cstdint>

#define LAS __attribute__((address_space(3)))
#define GAS __attribute__((address_space(1)))
typedef unsigned short bf16_t;
typedef short bf16x8 __attribute__((ext_vector_type(8)));
typedef short s16x4 __attribute__((ext_vector_type(4)));
typedef float f32x4 __attribute__((ext_vector_type(4)));
typedef float f32x2 __attribute__((ext_vector_type(2)));
typedef float f32x16 __attribute__((ext_vector_type(16)));
typedef unsigned u32x4 __attribute__((ext_vector_type(4)));
typedef unsigned u32x2 __attribute__((ext_vector_type(2)));

#ifndef MK_MULTI
#define MK_MULTI 0
#endif

constexpr int D = 1024, T = 8192, NB = 2, NL = NB * T, CTXL = 256, NC = NB * CTXL, NTOK = NL + NC;
constexpr int INW = 3328, OFFQ = 512, OFFK = 1024, OFFV = 1152, OFFG = 1280;
constexpr int DFF0 = 2816, DFFE = 3584, NE = 8;
constexpr int KM = 1152;
constexpr int MOE_ROWS = 2 * NL + NE * 256;
constexpr float EPS = 1e-6f;
constexpr float LOG2E = 1.4426950408889634f;
constexpr float QSCALE = 0.125f * LOG2E;

constexpr size_t MiB = 1u << 20, KiB = 1u << 10;
constexpr size_t WS_CTL = 0, CTL_BYTES = 1 * MiB;
constexpr size_t WS_ROPE = 1 * MiB, WS_TW = WS_ROPE + 32 * KiB, WS_FA64 = WS_ROPE + 96 * KiB, WS_TC = WS_ROPE + 160 * KiB, WS_TX = WS_ROPE + 288 * KiB;
constexpr size_t WS_H8 = 452 * MiB;
constexpr size_t WS_RSW = WS_ROPE + 960 * KiB;
constexpr int CW_RMAX = 131072;
constexpr size_t WS_CSI = WS_ROPE + 936 * KiB;
constexpr size_t WS_RS = WS_ROPE + 832 * KiB, WS_CSD = WS_ROPE + 912 * KiB;
constexpr size_t WS_TOKE = 2 * MiB, WS_TOKR = WS_TOKE + 128 * KiB, WS_TOKW = WS_TOKE + 256 * KiB, WS_LIST = WS_TOKE + 384 * KiB;
constexpr size_t WS_XC = 3 * MiB, WS_VCT = 5 * MiB;
constexpr size_t WS_WIN0 = 6 * MiB, WS_WM0 = WS_WIN0 + 13 * MiB / 2, WS_WO0 = 17 * MiB, WS_WGUD = 19 * MiB, WS_WDD = 30 * MiB;
constexpr size_t WS_WIN1 = 36 * MiB, WS_WM1 = WS_WIN1 + 13 * MiB / 2, WS_WO1 = 47 * MiB;
constexpr size_t WS_H = 49 * MiB;
constexpr size_t WS_DOUT = 6 * MiB;
constexpr size_t WS_WGUE = 82 * MiB, WS_WDE = 194 * MiB;
constexpr size_t WS_DOUT1 = WS_WGUE;
constexpr size_t WS_R1 = 250 * MiB;
constexpr size_t WS_UP = WS_R1, WS_Q = 266 * MiB, WS_KB = 283 * MiB, WS_VB = 288 * MiB, WS_GF = 293 * MiB, WS_GA = 326 * MiB, WS_GP = 359 * MiB, WS_FO = 375 * MiB, WS_Y = 413 * MiB;
constexpr size_t WS_ACT = WS_R1;
constexpr size_t WS_TMPC1 = 446 * MiB, WS_TMPC2 = 448 * MiB;
constexpr size_t WS_XB = 490 * MiB;
constexpr size_t WS_END = 523 * MiB;
static_assert(WS_DOUT + (size_t)MOE_ROWS * D * 2 <= WS_WGUE, "DOUT overlay");
static_assert(WS_ACT + (size_t)MOE_ROWS * DFFE * 2 <= WS_END, "ACT");
static_assert(WS_FO + (size_t)NTOK * KM * 2 <= WS_Y, "FO");
constexpr int CW_BAR = 4096, CW_CNT = 8192, CW_MOD = 16384;
constexpr int MODSZ = 6 * D;

constexpr int RING_BYTES = 131072, MISC_OFF = RING_BYTES + 320, LDS_BYTES = 147456;
constexpr int NWAVES = 8, NTHR = 512;

__device__ __forceinline__ unsigned f2bf(float f) { unsigned u = __builtin_bit_cast(unsigned, f); return (u + 0x7fffu + ((u >> 16) & 1u)) >> 16; }
__device__ __forceinline__ unsigned pk2(float lo, float hi) { return f2bf(lo) | (f2bf(hi) << 16); }
__device__ __forceinline__ unsigned pk4f8(float a, float b, float c, float d) { int w = __builtin_amdgcn_cvt_pk_fp8_f32(a, b, 0, false); w = __builtin_amdgcn_cvt_pk_fp8_f32(c, d, w, true); return (unsigned)w; }
__device__ __forceinline__ unsigned cvt_pk_bf16(float lo, float hi) { unsigned r; asm volatile("v_cvt_pk_bf16_f32 %0, %1, %2" : "=v"(r) : "v"(lo), "v"(hi)); return r; }
__device__ __forceinline__ unsigned pk4i8(float a, float b, float c, float d, float sc) {
    const unsigned ua = __builtin_bit_cast(unsigned, fmaf(a, sc, 12582912.0f)), ub = __builtin_bit_cast(unsigned, fmaf(b, sc, 12582912.0f)), uc = __builtin_bit_cast(unsigned, fmaf(c, sc, 12582912.0f)), ud = __builtin_bit_cast(unsigned, fmaf(d, sc, 12582912.0f));
    return (ua & 0xffu) | ((ub & 0xffu) << 8) | ((uc & 0xffu) << 16) | (ud << 24); }
__device__ __forceinline__ float bf2f(unsigned short h) { return __builtin_bit_cast(float, (unsigned)h << 16); }
__device__ __forceinline__ float bflo(unsigned w) { return __builtin_bit_cast(float, w << 16); }
__device__ __forceinline__ float bfhi(unsigned w) { return __builtin_bit_cast(float, w & 0xffff0000u); }
#define DPP_F(v, ctrl, rmask) __builtin_bit_cast(float, __builtin_amdgcn_update_dpp(0, __builtin_bit_cast(int, v), ctrl, rmask, 0xF, true))
__device__ __forceinline__ float wave_max(float v) {
    v = fmaxf(v, DPP_F(v, 0xB1, 0xF)); v = fmaxf(v, DPP_F(v, 0x4E, 0xF)); v = fmaxf(v, DPP_F(v, 0x141, 0xF)); v = fmaxf(v, DPP_F(v, 0x140, 0xF));
    v = fmaxf(v, DPP_F(v, 0x142, 0xA)); v = fmaxf(v, DPP_F(v, 0x143, 0xC));
    return __builtin_bit_cast(float, __builtin_amdgcn_readlane(__builtin_bit_cast(int, v), 63));
}
__device__ __forceinline__ float wave_sum(float v) {
    v += DPP_F(v, 0xB1, 0xF); v += DPP_F(v, 0x4E, 0xF); v += DPP_F(v, 0x141, 0xF); v += DPP_F(v, 0x140, 0xF);
    v += DPP_F(v, 0x142, 0xA); v += DPP_F(v, 0x143, 0xC);
    return __builtin_bit_cast(float, __builtin_amdgcn_readlane(__builtin_bit_cast(int, v), 63));
}
__device__ __forceinline__ float sigmoidf_(float x) { return __builtin_amdgcn_rcpf(1.0f + __builtin_amdgcn_exp2f(-x * LOG2E)); }
#define LDS_WAIT() asm volatile("s_waitcnt lgkmcnt(0)" ::: "memory")
#define VM_WAIT() asm volatile("s_waitcnt vmcnt(0)" ::: "memory")

#define XB_TMO      128
#define XB_XCNT(j)  (256  + 64 * (j))
#define XB_XSUB(j)  (1280 + 64 * (j))
#define XB_XGEN(j)  (2304 + 64 * (j))
#define XB_TOP      3328
#define XB_TOPGEN   3392
#define XCD_BAR_WORDS 3456
#define XB_SPIN_CAP (1u << 18)
__device__ __forceinline__ unsigned xb_ld(unsigned* p)              { return __hip_atomic_load(p, __ATOMIC_RELAXED, __HIP_MEMORY_SCOPE_AGENT); }
__device__ __forceinline__ unsigned xb_add(unsigned* p, unsigned v) { return __hip_atomic_fetch_add(p, v, __ATOMIC_RELAXED, __HIP_MEMORY_SCOPE_AGENT); }
__device__ __forceinline__ unsigned xb_xcc_id() { return (unsigned)__builtin_amdgcn_s_getreg((3 << 11) | 20) & 0xFu; }
#define XB_SPIN(cond, bar) do { unsigned _sp = 0; while (cond) { __builtin_amdgcn_s_sleep(1); \
    if ((++_sp & 255u) == 0u) { if (xb_ld(&(bar)[XB_TMO])) break; if (_sp > XB_SPIN_CAP) { atomicAdd(&(bar)[XB_TMO], 1u); break; } } } } while (0)
struct XcdBarrier { unsigned* bar; unsigned x; volatile LAS unsigned* st; };
__device__ __forceinline__ XcdBarrier xcd_barrier_post(unsigned* bar, volatile LAS unsigned* st) {
    XcdBarrier b; b.bar = bar; b.x = xb_xcc_id(); b.st = st;
    if (threadIdx.x == 0) (void)xb_add(&bar[XB_XCNT(b.x)], 1u);
    return b;
}
__device__ __forceinline__ void xcd_barrier_complete(unsigned* bar, unsigned x, unsigned& nloc, unsigned& nx) {
    const unsigned G = gridDim.x * gridDim.y * gridDim.z;
    unsigned sum, cnt, mine, sp = 0u;
    for (;;) {
        sum = 0u; cnt = 0u; mine = 0u;
#pragma unroll
        for (unsigned j = 0; j < 16; ++j) { const unsigned c = xb_ld(&bar[XB_XCNT(j)]); sum += c; cnt += (c > 0u) ? 1u : 0u; mine = (j == x) ? c : mine; }
        if (sum == G) break;
        __builtin_amdgcn_s_sleep(1);
        if ((++sp & 255u) == 0u) { if (xb_ld(&bar[XB_TMO])) break; if (sp > XB_SPIN_CAP) { atomicAdd(&bar[XB_TMO], 1u); break; } }
    }
    nloc = mine > 0u ? mine : 1u; nx = cnt > 0u ? cnt : 1u;
}
__device__ __forceinline__ void xcd_barrier(const XcdBarrier& b) {
    asm volatile("s_waitcnt vmcnt(0)" ::: "memory");
    __syncthreads();
    if (threadIdx.x == 0) {
        unsigned* bar = b.bar;
        __builtin_amdgcn_s_waitcnt(0);
        unsigned nloc = b.st[0], nx = b.st[1];
        if (nloc == 0u) { xcd_barrier_complete(bar, b.x, nloc, nx); b.st[0] = nloc; b.st[1] = nx; }
        const unsigned old = xb_add(&bar[XB_XSUB(b.x)], 1u);
        const unsigned gen = old / nloc;
        if (old + 1u == (gen + 1u) * nloc) {
            __builtin_amdgcn_fence(__ATOMIC_RELEASE, "agent");
            asm volatile("s_waitcnt vmcnt(0)" ::: "memory");
            const unsigned og = xb_add(&bar[XB_TOP], 1u);
            const unsigned tg = og / nx;
            if (og + 1u == (tg + 1u) * nx) xb_add(&bar[XB_TOPGEN], 1u);
            else XB_SPIN(xb_ld(&bar[XB_TOPGEN]) == tg, bar);
            __builtin_amdgcn_fence(__ATOMIC_ACQUIRE, "agent");
            xb_add(&bar[XB_XGEN(b.x)], 1u);
            asm volatile("s_waitcnt vmcnt(0)" ::: "memory");
        } else {
            XB_SPIN(xb_ld(&bar[XB_XGEN(b.x)]) == gen, bar);
            __builtin_amdgcn_fence(__ATOMIC_ACQUIRE, "agent");
            asm volatile("s_waitcnt vmcnt(0)" ::: "memory");
        }
    }
    __syncthreads();
}

#ifndef QGU
#define QGU 32
#endif
#ifndef QDN
#define QDN 64
#endif
#ifndef QACT
#define QACT 16
#endif
namespace pg8 {
constexpr int BM = 256, BK = 64, HALF = 128, HTB = HALF * BK * 2, STAGE_BYTES = 8 * HTB, NXCD = 8, WGM = 8;
__host__ __device__ __forceinline__ int lds_byte(int r, int c) { const int st = (r >> 4) * 2 + (c >> 5), rr = r & 15, cc = c & 31, ob = rr * 64 + cc * 2; return st * 1024 + (ob ^ (((ob >> 9) & 1) << 5)); }
__host__ __device__ __forceinline__ void stage_rc(int b, int& R, int& C) { const int st = b / 1024, sb = b % 1024, swz = sb ^ (((sb >> 9) & 1) << 5); R = (st >> 1) * 16 + swz / 64; C = (st & 1) * 32 + (swz % 64) / 2; }
__host__ __device__ __forceinline__ int perm32(int rho) { const int n = rho >> 4, i = rho & 15; return 8 * (i >> 2) + 4 * n + (i & 3); }

typedef int i32x8 __attribute__((ext_vector_type(8)));
typedef int i32x4 __attribute__((ext_vector_type(4)));
__device__ __forceinline__ i32x8 cat8(bf16x8 a, bf16x8 b) { return __builtin_shufflevector(__builtin_bit_cast(i32x4, a), __builtin_bit_cast(i32x4, b), 0, 1, 2, 3, 4, 5, 6, 7); }
struct Unit { unsigned aoff, boff; int pm, pn, kind, x0, x1, kh; };
struct Gemm { const bf16_t* A; const bf16_t* Bt; int K; int ld; };

__device__ __forceinline__ void swz_map(int L, int nM, int nN, int& pm, int& pn) {
    const int nwg = nM * nN; int wgid = L;
    { const int q = nwg / NXCD, r = nwg % NXCD, xcd = wgid % NXCD, off = wgid / NXCD; wgid = (xcd < r ? xcd * (q + 1) : r * (q + 1) + (xcd - r) * q) + off; }
    const int nig = WGM * nN, gid = wgid / nig, fm = gid * WGM, gsz = (nM - fm) < WGM ? (nM - fm) : WGM;
    pm = fm + ((wgid % nig) % gsz); pn = (wgid % nig) / gsz;
}

struct NoGather { static constexpr bool GA = false, GB = false;
    __device__ __forceinline__ unsigned arow(const Unit&, int) const { return 0u; }
    __device__ __forceinline__ unsigned brow(const Unit&, int) const { return 0u; } };

template <class S> struct var_k { static constexpr bool v = false; };
template <int F8, class Epi, class Sched, class Rows>
__device__ __forceinline__ void gemm_phase_t(LAS unsigned char* lds, const Gemm g, const Sched& S, const Epi& E, const Rows& RW) {
    int tid_ = threadIdx.x; asm volatile("" : "+v"(tid_));
    const int tid = tid_, wid = __builtin_amdgcn_readfirstlane(tid >> 6), lane = tid & 63, wr = wid >> 2, wc = wid & 3, fr = lane & 15, fq = lane >> 4;
    int K_ = g.K; asm volatile("" : "+s"(K_));
    const int K = K_, nt = K / BK;
    int sR[2], sRb[2], sC[2];
#pragma unroll
    for (int i = 0; i < 2; ++i) { int R, C; stage_rc(tid * 16 + i * 8192, R, C); sR[i] = R; sC[i] = C; sRb[i] = (R & ~31) + perm32(R & 31); }
    unsigned voffA[2], voffB[2];
    const int LD = g.ld;
#pragma unroll
    for (int i = 0; i < 2; ++i) { voffA[i] = (unsigned)(sR[i] * LD + sC[i]) * 2u; voffB[i] = (unsigned)(sRb[i] * LD + sC[i]) * 2u; }
    const size_t kstep = (size_t)(BK * 2);
    const size_t hstep = (size_t)HALF * LD * 2;
    const unsigned ldsw = (unsigned)wid * 1024u;
    const int aoff = lds_byte(wr * 64 + fr, fq * 8), boff = lds_byte(wc * 32 + fr, fq * 8);
    constexpr int NTHR_ = 512;
    LAS unsigned* stash = (LAS unsigned*)(lds + 131072 + 320 + 1024) + tid;
    struct Side { const char* base[2]; unsigned off[2][2]; };
#define PG8_SA(b, h) (((b) * 2 + (h)) * HTB)
#define PG8_SB(b, h) ((4 + (b) * 2 + (h)) * HTB)
#define PG8_STAGE(bufoff, side, h, kt) do { _Pragma("unroll") for (int _i = 0; _i < 2; ++_i) { unsigned _o = (side).off[h][_i]; asm volatile("" : "+v"(_o)); \
        __builtin_amdgcn_global_load_lds((const unsigned*)((side).base[h] + (size_t)(kt) * kstep + _o), (LAS unsigned*)(lds + (bufoff) + ldsw + _i * 8192), 16, 0, 0); } } while (0)
#define PG8_LDA(dst, b, h) do { _Pragma("unroll") for (int m = 0; m < 4; ++m) _Pragma("unroll") for (int k = 0; k < 2; ++k) dst[m][k] = *(const LAS bf16x8*)(lds + PG8_SA(b, h) + aoff + m * 2048 + k * 1024); } while (0)
#define PG8_LDB(dst, b, h) do { _Pragma("unroll") for (int n = 0; n < 2; ++n) _Pragma("unroll") for (int k = 0; k < 2; ++k) dst[n][k] = *(const LAS bf16x8*)(lds + PG8_SB(b, h) + boff + n * 2048 + k * 1024); } while (0)
#define PG8_MMA(ai, bj, At, Bt) do { __builtin_amdgcn_s_setprio(1); _Pragma("unroll") for (int m = 0; m < 4; ++m) _Pragma("unroll") for (int n = 0; n < 2; ++n) { \
        if constexpr (F8 == 1) acc[ai][bj][m][n] = __builtin_amdgcn_mfma_scale_f32_16x16x128_f8f6f4(cat8(Bt[n][0], Bt[n][1]), cat8(At[m][0], At[m][1]), acc[ai][bj][m][n], 0, 0, 0, 0, 0, 0); \
        else if constexpr (F8 == 2) { _Pragma("unroll") for (int k = 0; k < 2; ++k) acc[ai][bj][m][n] = __builtin_bit_cast(f32x4, __builtin_amdgcn_mfma_i32_16x16x64_i8(__builtin_bit_cast(i32x4, Bt[n][k]), __builtin_bit_cast(i32x4, At[m][k]), __builtin_bit_cast(i32x4, acc[ai][bj][m][n]), 0, 0, 0)); } \
        else { _Pragma("unroll") for (int k = 0; k < 2; ++k) acc[ai][bj][m][n] = __builtin_amdgcn_mfma_f32_16x16x32_bf16(Bt[n][k], At[m][k], acc[ai][bj][m][n], 0, 0, 0); } } __builtin_amdgcn_s_setprio(0); } while (0)
#define PG8_WAIT_V(n) asm volatile("s_waitcnt vmcnt(" #n ")" ::: "memory")
#define PG8_WAIT_L(n) asm volatile("s_waitcnt lgkmcnt(" #n ")" ::: "memory")
#define PG8_BAR __builtin_amdgcn_s_barrier()
#define PG8_SCHED __builtin_amdgcn_sched_barrier(0)
#define PG8_MKSIDES(u, sa, sb) do { \
        if constexpr (Rows::GA) { sa.base[0] = sa.base[1] = (const char*)g.A; int t2_ = tid; asm volatile("" : "+v"(t2_)); _Pragma("unroll") for (int i = 0; i < 2; ++i) { int R_, C_; stage_rc(t2_ * 16 + i * 8192, R_, C_); \
            _Pragma("unroll") for (int h = 0; h < 2; ++h) sa.off[h][i] = RW.arow(u, h * HALF + R_) + (unsigned)C_ * 2u; } } \
        else { sa.base[0] = (const char*)g.A + (u).aoff; sa.base[1] = sa.base[0] + hstep; _Pragma("unroll") for (int h = 0; h < 2; ++h) _Pragma("unroll") for (int i = 0; i < 2; ++i) sa.off[h][i] = voffA[i]; } \
        if constexpr (Rows::GB) { sb.base[0] = sb.base[1] = (const char*)g.Bt; _Pragma("unroll") for (int h = 0; h < 2; ++h) _Pragma("unroll") for (int i = 0; i < 2; ++i) sb.off[h][i] = RW.brow(u, h * HALF + sRb[i]) + (unsigned)sC[i] * 2u; } \
        else { sb.base[0] = (const char*)g.Bt + (u).boff; sb.base[1] = sb.base[0] + hstep; _Pragma("unroll") for (int h = 0; h < 2; ++h) _Pragma("unroll") for (int i = 0; i < 2; ++i) sb.off[h][i] = voffB[i]; } } while (0)
    Unit cur, nxt; int ui = 0;
    if (!S.next(0, cur)) return;
    f32x4 acc[2][2][4][2];
#pragma unroll
    for (int a = 0; a < 2; ++a)
#pragma unroll
        for (int b = 0; b < 2; ++b)
#pragma unroll
            for (int m = 0; m < 4; ++m)
#pragma unroll
                for (int n = 0; n < 2; ++n) acc[a][b][m][n] = (f32x4){0.f, 0.f, 0.f, 0.f};
    bf16x8 At[4][2], B0[2][2], B1[2][2];
    Side cA, cB, nA, nB;
    PG8_MKSIDES(cur, cA, cB);
    PG8_STAGE(PG8_SB(0, 0), cB, 0, 0); PG8_STAGE(PG8_SB(0, 1), cB, 1, 0); PG8_STAGE(PG8_SA(0, 0), cA, 0, 0); PG8_STAGE(PG8_SA(0, 1), cA, 1, 0);
    if (wr == 1) PG8_BAR;
    PG8_WAIT_V(2); PG8_BAR;
    PG8_STAGE(PG8_SB(1, 0), cB, 0, 1); PG8_STAGE(PG8_SA(1, 0), cA, 0, 1); PG8_STAGE(PG8_SB(1, 1), cB, 1, 1);
    PG8_WAIT_V(6); PG8_BAR;
    for (;;) {
        const bool has_next = S.next(ui + 1, nxt);
        if (has_next) { PG8_MKSIDES(nxt, nA, nB); } else { nA = cA; nB = cB; }
        if constexpr (Rows::GA) {
#pragma unroll
            for (int h = 0; h < 2; ++h)
#pragma unroll
                for (int i = 0; i < 2; ++i) stash[(h * 2 + i) * NTHR_] = nA.off[h][i]; }
        const int ntu = var_k<Sched>::v ? cur.x1 : nt;
        for (int t = 0; t < ntu; t += 2) {
            const bool last = (t == ntu - 2);
            if constexpr (Epi::MIDK > 0) { if (t == Epi::MIDK) E.mid(acc, cur, wr, wc, fr, fq); }
            Side a2, b2;
            a2.base[0] = last ? nA.base[0] : cA.base[0]; a2.base[1] = last ? nA.base[1] : cA.base[1];
            b2.base[0] = last ? nB.base[0] : cB.base[0]; b2.base[1] = last ? nB.base[1] : cB.base[1];
#pragma unroll
            for (int h = 0; h < 2; ++h)
#pragma unroll
                for (int i = 0; i < 2; ++i) { if constexpr (!Rows::GA) a2.off[h][i] = cA.off[h][i]; b2.off[h][i] = (Rows::GB && last) ? nB.off[h][i] : cB.off[h][i]; }
            const int k2 = last ? 0 : t + 2, k3 = k2 + 1;
            PG8_LDB(B0, 0, 0); PG8_LDB(B1, 0, 1); PG8_SCHED; PG8_LDA(At, 0, 0); PG8_STAGE(PG8_SA(1, 1), cA, 1, t + 1);
            if constexpr (Rows::GA) {
                if (last) {
#pragma unroll
                    for (int h = 0; h < 2; ++h)
#pragma unroll
                        for (int i = 0; i < 2; ++i) cA.off[h][i] = stash[(h * 2 + i) * NTHR_]; }
#pragma unroll
                for (int h = 0; h < 2; ++h)
#pragma unroll
                    for (int i = 0; i < 2; ++i) a2.off[h][i] = cA.off[h][i]; }
            PG8_WAIT_V(8); PG8_WAIT_L(0); PG8_BAR; PG8_MMA(0, 0, At, B0); PG8_MMA(0, 1, At, B1); PG8_BAR; PG8_SCHED;
            PG8_LDA(At, 0, 1); PG8_STAGE(PG8_SB(0, 0), b2, 0, k2); PG8_STAGE(PG8_SB(0, 1), b2, 1, k2); PG8_STAGE(PG8_SA(0, 0), a2, 0, k2);
            PG8_WAIT_V(8); PG8_WAIT_L(0); PG8_BAR; PG8_MMA(1, 0, At, B0); PG8_MMA(1, 1, At, B1); PG8_BAR; PG8_SCHED;
            PG8_LDB(B0, 1, 0); PG8_LDB(B1, 1, 1); PG8_SCHED; PG8_LDA(At, 1, 0); PG8_STAGE(PG8_SA(0, 1), a2, 1, k2);
            PG8_WAIT_V(8); PG8_WAIT_L(0); PG8_BAR; PG8_MMA(0, 0, At, B0); PG8_MMA(0, 1, At, B1); PG8_BAR; PG8_SCHED;
            PG8_LDA(At, 1, 1); PG8_STAGE(PG8_SB(1, 0), b2, 0, k3); PG8_STAGE(PG8_SB(1, 1), b2, 1, k3); PG8_STAGE(PG8_SA(1, 0), a2, 0, k3);
            PG8_WAIT_V(8); PG8_WAIT_L(0); PG8_BAR; PG8_MMA(1, 0, At, B0); PG8_MMA(1, 1, At, B1); PG8_BAR; PG8_SCHED;
        }
        if (wr == 0) PG8_BAR;
        E(acc, cur, wr, wc, fr, fq);
        if (!has_next) break;
#pragma unroll
        for (int a = 0; a < 2; ++a)
#pragma unroll
            for (int b = 0; b < 2; ++b)
#pragma unroll
                for (int m = 0; m < 4; ++m)
#pragma unroll
                    for (int n = 0; n < 2; ++n) acc[a][b][m][n] = (f32x4){0.f, 0.f, 0.f, 0.f};
        cur = nxt; if constexpr (Rows::GA) { cA.base[0] = nA.base[0]; cA.base[1] = nA.base[1]; } else cA = nA; cB = nB; ++ui;
        if (wr == 1) PG8_BAR;
    }
    PG8_WAIT_V(0);
    PG8_BAR;
#undef PG8_SA
#undef PG8_SB
#undef PG8_STAGE
#undef PG8_LDA
#undef PG8_LDB
#undef PG8_MMA
#undef PG8_WAIT_V
#undef PG8_WAIT_L
#undef PG8_BAR
#undef PG8_SCHED
#undef PG8_MKSIDES
}

template <class Epi, class Sched, class Rows>
__device__ __forceinline__ void gemm_phase(LAS unsigned char* lds, const Gemm g, const Sched& S, const Epi& E, const Rows& RW) { gemm_phase_t<0>(lds, g, S, E, RW); }
template <class Epi, class Sched, class Rows>
__device__ __forceinline__ void gemm_phase8(LAS unsigned char* lds, const Gemm g, const Sched& S, const Epi& E, const Rows& RW) { gemm_phase_t<1>(lds, g, S, E, RW); }
template <class Epi, class Sched, class Rows>
__device__ __forceinline__ void gemm_phasei8(LAS unsigned char* lds, const Gemm g, const Sched& S, const Epi& E, const Rows& RW) { gemm_phase_t<2>(lds, g, S, E, RW); }

struct SUnit { unsigned aoff, boff; int K; int pm, pn, kind, x0, x1, grp, dep, sig; };
__device__ __forceinline__ void st16_wt(unsigned char* wsbase, unsigned off, u32x4 v) {
    const __amdgpu_buffer_rsrc_t rsrc = __builtin_amdgcn_make_buffer_rsrc((void*)wsbase, 0, 0x7fffffff, 0x00020000);
    __builtin_amdgcn_raw_buffer_store_b128(v, rsrc, off, 0, 16); }

template <class Epi, class Sched, class Rows>
__device__ __forceinline__ void gemm_stream(LAS unsigned char* lds, const char* base, const Sched& S, const Epi& E, const Rows& RW) {
    int tid_ = threadIdx.x; asm volatile("" : "+v"(tid_));
    const int tid = tid_, wid = __builtin_amdgcn_readfirstlane(tid >> 6), lane = tid & 63, wr = wid >> 2, wc = wid & 3, fr = lane & 15, fq = lane >> 4;
    int sR[2], sRb[2], sC[2];
#pragma unroll
    for (int i = 0; i < 2; ++i) { int R, C; stage_rc(tid * 16 + i * 8192, R, C); sR[i] = R; sC[i] = C; sRb[i] = (R & ~31) + perm32(R & 31); }
    const size_t kstep = (size_t)(BK * 2);
    const unsigned ldsw = (unsigned)wid * 1024u;
    const int aoff = lds_byte(wr * 64 + fr, fq * 8), boff = lds_byte(wc * 32 + fr, fq * 8);
    struct Side { const char* base[2]; unsigned off[2][2]; };
#define PG8_SA(b, h) (((b) * 2 + (h)) * HTB)
#define PG8_SB(b, h) ((4 + (b) * 2 + (h)) * HTB)
#define PG8_STAGE(bufoff, side, h, kt) do { _Pragma("unroll") for (int _i = 0; _i < 2; ++_i) \
        __builtin_amdgcn_global_load_lds((const unsigned*)((side).base[h] + (size_t)(kt) * kstep + (side).off[h][_i]), (LAS unsigned*)(lds + (bufoff) + ldsw + _i * 8192), 16, 0, 0); } while (0)
#define PG8_LDA(dst, b, h) do { _Pragma("unroll") for (int m = 0; m < 4; ++m) _Pragma("unroll") for (int k = 0; k < 2; ++k) dst[m][k] = *(const LAS bf16x8*)(lds + PG8_SA(b, h) + aoff + m * 2048 + k * 1024); } while (0)
#define PG8_LDB(dst, b, h) do { _Pragma("unroll") for (int n = 0; n < 2; ++n) _Pragma("unroll") for (int k = 0; k < 2; ++k) dst[n][k] = *(const LAS bf16x8*)(lds + PG8_SB(b, h) + boff + n * 2048 + k * 1024); } while (0)
#define PG8_MMA(ai, bj, At, Bt) do { __builtin_amdgcn_s_setprio(1); _Pragma("unroll") for (int m = 0; m < 4; ++m) _Pragma("unroll") for (int n = 0; n < 2; ++n) _Pragma("unroll") for (int k = 0; k < 2; ++k) \
        acc[ai][bj][m][n] = __builtin_amdgcn_mfma_f32_16x16x32_bf16(Bt[n][k], At[m][k], acc[ai][bj][m][n], 0, 0, 0); __builtin_amdgcn_s_setprio(0); } while (0)
#define PG8_WAIT_V(n) asm volatile("s_waitcnt vmcnt(" #n ")" ::: "memory")
#define PG8_WAIT_L(n) asm volatile("s_waitcnt lgkmcnt(" #n ")" ::: "memory")
#define PG8_BAR __builtin_amdgcn_s_barrier()
#define PG8_SCHED __builtin_amdgcn_sched_barrier(0)
#define PG8_MKSIDES(un, sa, sb) do { const int K_ = (un).K; \
        if (RW.a_gather(un)) { sa.base[0] = sa.base[1] = base; _Pragma("unroll") for (int h = 0; h < 2; ++h) _Pragma("unroll") for (int i = 0; i < 2; ++i) sa.off[h][i] = RW.arow(un, h * HALF + sR[i]) + (unsigned)sC[i] * 2u; } \
        else { sa.base[0] = base + (un).aoff; sa.base[1] = sa.base[0] + (size_t)HALF * K_ * 2; _Pragma("unroll") for (int h = 0; h < 2; ++h) _Pragma("unroll") for (int i = 0; i < 2; ++i) sa.off[h][i] = (unsigned)(sR[i] * K_ + sC[i]) * 2u; } \
        sb.base[0] = base + (un).boff; sb.base[1] = sb.base[0] + (size_t)HALF * K_ * 2; _Pragma("unroll") for (int h = 0; h < 2; ++h) _Pragma("unroll") for (int i = 0; i < 2; ++i) sb.off[h][i] = (unsigned)(sRb[i] * K_ + sC[i]) * 2u; } while (0)
#define PG8_SIGNAL(idx) do { if (lane == 0) __hip_atomic_fetch_add(S.rdy + 64 * (idx), 1u, __ATOMIC_RELAXED, __HIP_MEMORY_SCOPE_AGENT); } while (0)
    SUnit cur, nxt;
    unsigned pend = 0u;
    const unsigned lw_addr = (unsigned)(size_t)S.lw;
    if (tid == 0) { S.lw[0] = __hip_atomic_fetch_add(S.q, 1u, __ATOMIC_RELAXED, __HIP_MEMORY_SCOPE_AGENT); pend = __hip_atomic_fetch_add(S.q, 1u, __ATOMIC_RELAXED, __HIP_MEMORY_SCOPE_AGENT); }
    __syncthreads();
    { const int L0 = __builtin_amdgcn_readfirstlane((int)S.lw[0]); if (!S.decode(L0, cur)) return; }
    f32x4 acc[2][2][4][2];
#pragma unroll
    for (int a = 0; a < 2; ++a)
#pragma unroll
        for (int b = 0; b < 2; ++b)
#pragma unroll
            for (int m = 0; m < 4; ++m)
#pragma unroll
                for (int n = 0; n < 2; ++n) acc[a][b][m][n] = (f32x4){0.f, 0.f, 0.f, 0.f};
    bf16x8 At[4][2], B0[2][2], B1[2][2];
    Side cA, cB, nA, nB;
    bool need_pro = true; int sig_idx = -1;
    PG8_MKSIDES(cur, cA, cB);
    for (;;) {
        if (need_pro) {
            if (cur.dep >= 0) S.a_ready(cur);
            PG8_STAGE(PG8_SB(0, 0), cB, 0, 0); PG8_STAGE(PG8_SB(0, 1), cB, 1, 0); PG8_STAGE(PG8_SA(0, 0), cA, 0, 0); PG8_STAGE(PG8_SA(0, 1), cA, 1, 0);
            if (wr == 1) PG8_BAR;
            PG8_WAIT_V(2); PG8_BAR;
            PG8_STAGE(PG8_SB(1, 0), cB, 0, 1); PG8_STAGE(PG8_SA(1, 0), cA, 0, 1); PG8_STAGE(PG8_SB(1, 1), cB, 1, 1);
            PG8_WAIT_V(6); PG8_BAR;
        }
        if (tid == 0) { asm volatile("s_nop 7\n\tds_write_b32 %1, %0\n\tglobal_atomic_add %0, %2, %3, %4 sc0" : "+v"(pend) : "v"(lw_addr), "v"(0u), "v"(1u), "s"(S.q) : "memory"); }
        PG8_WAIT_L(0); PG8_BAR; asm volatile("" ::: "memory");
        const int Ln = __builtin_amdgcn_readfirstlane((int)S.lw[0]);
        const bool has_next = S.decode(Ln, nxt), pre = has_next && nxt.dep < 0;
        if (pre) { PG8_MKSIDES(nxt, nA, nB); } else { nA = cA; nB = cB; }
        const int nt = cur.K / BK;
        for (int t = 0; t < nt; t += 2) {
            const bool last = (t == nt - 2);
            Side a2, b2;
            a2.base[0] = last ? nA.base[0] : cA.base[0]; a2.base[1] = last ? nA.base[1] : cA.base[1];
            b2.base[0] = last ? nB.base[0] : cB.base[0]; b2.base[1] = last ? nB.base[1] : cB.base[1];
#pragma unroll
            for (int h = 0; h < 2; ++h)
#pragma unroll
                for (int i = 0; i < 2; ++i) { a2.off[h][i] = last ? nA.off[h][i] : cA.off[h][i]; b2.off[h][i] = last ? nB.off[h][i] : cB.off[h][i]; }
            const int k2 = last ? 0 : t + 2, k3 = k2 + 1;
            if (t == 2 && sig_idx >= 0) { PG8_SIGNAL(sig_idx); sig_idx = -1; }
            PG8_LDB(B0, 0, 0); PG8_LDB(B1, 0, 1); PG8_SCHED; PG8_LDA(At, 0, 0); PG8_STAGE(PG8_SA(1, 1), cA, 1, t + 1);
            PG8_WAIT_V(8); PG8_WAIT_L(0); PG8_BAR; PG8_MMA(0, 0, At, B0); PG8_MMA(0, 1, At, B1); PG8_BAR; PG8_SCHED;
            PG8_LDA(At, 0, 1); PG8_STAGE(PG8_SB(0, 0), b2, 0, k2); PG8_STAGE(PG8_SB(0, 1), b2, 1, k2); PG8_STAGE(PG8_SA(0, 0), a2, 0, k2);
            PG8_WAIT_V(8); PG8_WAIT_L(0); PG8_BAR; PG8_MMA(1, 0, At, B0); PG8_MMA(1, 1, At, B1); PG8_BAR; PG8_SCHED;
            PG8_LDB(B0, 1, 0); PG8_LDB(B1, 1, 1); PG8_SCHED; PG8_LDA(At, 1, 0); PG8_STAGE(PG8_SA(0, 1), a2, 1, k2);
            PG8_WAIT_V(8); PG8_WAIT_L(0); PG8_BAR; PG8_MMA(0, 0, At, B0); PG8_MMA(0, 1, At, B1); PG8_BAR; PG8_SCHED;
            PG8_LDA(At, 1, 1); PG8_STAGE(PG8_SB(1, 0), b2, 0, k3); PG8_STAGE(PG8_SB(1, 1), b2, 1, k3); PG8_STAGE(PG8_SA(1, 0), a2, 0, k3);
            PG8_WAIT_V(8); PG8_WAIT_L(0); PG8_BAR; PG8_MMA(1, 0, At, B0); PG8_MMA(1, 1, At, B1); PG8_BAR; PG8_SCHED;
        }
        if (wr == 0) PG8_BAR;
        E(acc, cur, wr, wc, fr, fq);
        if (!has_next) { PG8_WAIT_V(0); if (cur.sig >= 0) PG8_SIGNAL(cur.sig); break; }
#pragma unroll
        for (int a = 0; a < 2; ++a)
#pragma unroll
            for (int b = 0; b < 2; ++b)
#pragma unroll
                for (int m = 0; m < 4; ++m)
#pragma unroll
                    for (int n = 0; n < 2; ++n) acc[a][b][m][n] = (f32x4){0.f, 0.f, 0.f, 0.f};
        if (pre) {
            sig_idx = cur.sig; need_pro = false; cur = nxt; cA = nA; cB = nB;
            if (wr == 1) PG8_BAR;
        } else {
            PG8_WAIT_V(0); if (cur.sig >= 0) PG8_SIGNAL(cur.sig);
            PG8_BAR; need_pro = true; cur = nxt; PG8_MKSIDES(cur, cA, cB);
        }
    }
    PG8_BAR;
#undef PG8_SA
#undef PG8_SB
#undef PG8_STAGE
#undef PG8_LDA
#undef PG8_LDB
#undef PG8_MMA
#undef PG8_WAIT_V
#undef PG8_WAIT_L
#undef PG8_BAR
#undef PG8_SCHED
#undef PG8_MKSIDES
#undef PG8_SIGNAL
}
}
using pg8::Unit;
using pg8::SUnit;

struct Args { const float* in[21]; float* out; unsigned char* ws; int ph_lo, ph_hi; };

struct Frame {
    LAS unsigned char* lds;
    unsigned char* ws;
    const float* const* in;
    float* out;
    int tid, lane, wave, G, bx;
};
__device__ __forceinline__ float* modp(const Frame& F, int l, int v) { return (float*)(F.ws + WS_CTL) + CW_MOD + (l * 3 + v) * MODSZ; }

__device__ __forceinline__ void p0_transpose_item(const float* W, int ldw, int k0, int c0, bf16_t* WT, int ldt, int drow, int lane) {
    const float* src = W + (size_t)k0 * ldw + c0 + lane;
    float v[64];
#pragma unroll
    for (int i = 0; i < 64; ++i) { v[i] = __builtin_nontemporal_load(src + (size_t)i * ldw); }
    bf16_t* dst = WT + (size_t)drow * ldt + k0;
#pragma unroll
    for (int j = 0; j < 8; ++j) { u32x4 o; o.x = pk2(v[8 * j], v[8 * j + 1]); o.y = pk2(v[8 * j + 2], v[8 * j + 3]); o.z = pk2(v[8 * j + 4], v[8 * j + 5]); o.w = pk2(v[8 * j + 6], v[8 * j + 7]);
        *(u32x4*)(dst + 8 * j) = o; }
}
template <int QS>
__device__ __forceinline__ void p0_transpose_item8(const float* W, int ldw, int k0, int c0, unsigned char* WT, int ldt, int drow, int lane) {
    const float* src = W + (size_t)k0 * ldw + c0 + lane;
    float v[64];
#pragma unroll
    for (int i = 0; i < 64; ++i) v[i] = __builtin_nontemporal_load(src + (size_t)i * ldw) * (float)QS;
    unsigned char* dst = WT + (size_t)drow * ldt + k0;
#pragma unroll
    for (int j = 0; j < 4; ++j) { u32x4 o; o.x = pk4f8(v[16 * j], v[16 * j + 1], v[16 * j + 2], v[16 * j + 3]); o.y = pk4f8(v[16 * j + 4], v[16 * j + 5], v[16 * j + 6], v[16 * j + 7]);
        o.z = pk4f8(v[16 * j + 8], v[16 * j + 9], v[16 * j + 10], v[16 * j + 11]); o.w = pk4f8(v[16 * j + 12], v[16 * j + 13], v[16 * j + 14], v[16 * j + 15]);
        *(u32x4*)(dst + 16 * j) = o; }
}

constexpr int CW_CONVQ = 12288 + 128;
constexpr int MOE_I_GE = 16 * 56, MOE_I_DE = 56 * 16, MOE_ITEMS = NE * (2 * MOE_I_GE + MOE_I_DE), MOE_BATCHES = MOE_ITEMS / 8;
__device__ __forceinline__ void moe_convert_batch(Frame& F, int which, int idx) {
    const float* const* in = F.in; const int ln = F.lane;
    int r = idx * 8 + F.wave;
    if (which == 0) { const int e = r / (2 * MOE_I_GE); r %= (2 * MOE_I_GE); const int up = r / MOE_I_GE; r %= MOE_I_GE; const int kb = r / 56, nb = r % 56, c0 = 64 * nb;
        p0_transpose_item8<QGU>(in[up ? 18 : 17] + (size_t)e * D * DFFE, DFFE, 64 * kb, c0, F.ws + WS_WGUE + (size_t)e * 2 * DFFE * D, D, (c0 >> 7) * 256 + up * 128 + (c0 & 127) + ln, ln); }
    else { const int e = r / MOE_I_DE; r %= MOE_I_DE; const int kb = r / 16, nb = r % 16;
        p0_transpose_item8<QDN>(in[19] + (size_t)e * DFFE * D, D, 64 * kb, 64 * nb, F.ws + WS_WDE + (size_t)e * D * DFFE, DFFE, 64 * nb + ln, ln); }
}
__device__ __forceinline__ void moe_convert(Frame& F, int which, int rep = 0) {
    volatile LAS unsigned* lw = (volatile LAS unsigned*)(F.lds + MISC_OFF) + 20;
    unsigned* q = (unsigned*)(F.ws + WS_CTL) + CW_CONVQ + 64 * which + 128 * rep;
    const int nb = which == 0 ? NE * 2 * MOE_I_GE / 8 : NE * MOE_I_DE / 8;
    for (;;) {
        __syncthreads();
        if (F.tid == 0) lw[0] = __hip_atomic_fetch_add(q, 1u, __ATOMIC_RELAXED, __HIP_MEMORY_SCOPE_AGENT);
        __syncthreads();
        const int idx = (int)lw[0];
        if (idx >= nb) break;
        moe_convert_batch(F, which, idx);
    }
    __syncthreads();
}

constexpr int MOE_P_GU = NE * 2 * 8 * 56, MOE_P_DN = NE * 28 * 16, MOE_PAIRS = MOE_P_GU + MOE_P_DN;
struct CvtItem { const float* src; unsigned char* dst; int ldw; float qs; };
__device__ __forceinline__ CvtItem moe_item(const Frame& F, int P, int half, int ln) {
    const float* const* in = F.in; CvtItem it;
    if (P < MOE_P_GU) { int r = P; const int e = r / (2 * 8 * 56); r %= (2 * 8 * 56); const int up = r / (8 * 56); r %= (8 * 56); const int kb = 2 * (r / 56) + half, nb = r % 56, c0 = 64 * nb;
        it.src = in[up ? 18 : 17] + (size_t)e * D * DFFE + (size_t)(64 * kb) * DFFE + c0 + ln; it.ldw = DFFE; it.qs = (float)QGU;
        it.dst = F.ws + WS_WGUE + (size_t)e * 2 * DFFE * D + (size_t)((c0 >> 7) * 256 + up * 128 + (c0 & 127) + ln) * D + 64 * kb; }
    else { int r = P - MOE_P_GU; const int e = r / (28 * 16); r %= (28 * 16); const int kb = 2 * (r / 16) + half, nb = r % 16;
        it.src = in[19] + (size_t)e * DFFE * D + (size_t)(64 * kb) * D + 64 * nb + ln; it.ldw = D; it.qs = (float)QDN;
        it.dst = F.ws + WS_WDE + (size_t)e * D * DFFE + (size_t)(64 * nb + ln) * DFFE + 64 * kb; }
    return it;
}
#define CVT_LOAD(v, it) do { _Pragma("unroll") for (int i_ = 0; i_ < 64; ++i_) v[i_] = __builtin_nontemporal_load((it).src + (size_t)i_ * (it).ldw); } while (0)
#define CVT_STORE(v, it) do { _Pragma("unroll") for (int j_ = 0; j_ < 4; ++j_) { u32x4 o_; const float q_ = (it).qs; \
        o_.x = pk4f8(v[16 * j_] * q_, v[16 * j_ + 1] * q_, v[16 * j_ + 2] * q_, v[16 * j_ + 3] * q_); o_.y = pk4f8(v[16 * j_ + 4] * q_, v[16 * j_ + 5] * q_, v[16 * j_ + 6] * q_, v[16 * j_ + 7] * q_); \
        o_.z = pk4f8(v[16 * j_ + 8] * q_, v[16 * j_ + 9] * q_, v[16 * j_ + 10] * q_, v[16 * j_ + 11] * q_); o_.w = pk4f8(v[16 * j_ + 12] * q_, v[16 * j_ + 13] * q_, v[16 * j_ + 14] * q_, v[16 * j_ + 15] * q_); \
        *(u32x4*)((it).dst + 16 * j_) = o_; } } while (0)
#ifndef MOE_PQ
#define MOE_PQ 9600
#endif
#ifndef MOE_QB
#define MOE_QB 1
#endif
#define MOE_QB_CO 0
#define MOE_QB_CD 3
#define MOE_QB_SC 1
__device__ __forceinline__ void moe_convert_q(Frame& F, int maxb, int qsel = 0) {
    int t_ = threadIdx.x; asm volatile("" : "+v"(t_)); const int ln = t_ & 63;
    volatile LAS unsigned* lw = (volatile LAS unsigned*)(F.lds + MISC_OFF) + 20;
    unsigned* q = (unsigned*)(F.ws + WS_CTL) + CW_CONVQ + 64 * qsel;
    const int p0_ = qsel ? MOE_PQ : 0, nb_ = (qsel ? MOE_PAIRS - MOE_PQ : MOE_PQ) / 8;
    for (int b = 0; b < maxb; ++b) {
        __syncthreads();
        if (F.tid == 0) lw[0] = __hip_atomic_fetch_add(q, 1u, __ATOMIC_RELAXED, __HIP_MEMORY_SCOPE_AGENT);
        __syncthreads();
        const int idx = (int)lw[0];
        if (idx >= nb_) break;
        const int P = p0_ + idx * 8 + F.wave;
        float va[64], vb[64];
        const CvtItem ia = moe_item(F, P, 0, ln), ib = moe_item(F, P, 1, ln);
        CVT_LOAD(va, ia); CVT_LOAD(vb, ib); CVT_STORE(va, ia); CVT_STORE(vb, ib);
    }
    __syncthreads();
}
__device__ __forceinline__ void moe_convert_all(Frame& F) {
    int t_ = threadIdx.x; asm volatile("" : "+v"(t_)); const int ln = t_ & 63;
    const int gw = F.bx * NWAVES + F.wave, NGW = F.G * NWAVES;
    float va[64], vb[64];
    int P = MOE_PQ + gw;
    CvtItem ia, ib;
    if (P < MOE_PAIRS) { ia = moe_item(F, P, 0, ln); CVT_LOAD(va, ia); }
    while (P < MOE_PAIRS) {
        ib = moe_item(F, P, 1, ln); CVT_LOAD(vb, ib);
        CVT_STORE(va, ia);
        const int Pn = P + NGW;
        if (Pn < MOE_PAIRS) { ia = moe_item(F, Pn, 0, ln); CVT_LOAD(va, ia); }
        CVT_STORE(vb, ib);
        P = Pn;
    }
}

__device__ __forceinline__ void p0_prologue(Frame& F) {
    const float* const* in = F.in;
    const int gw = F.bx * NWAVES + F.wave, NGW = F.G * NWAVES;
    {
        constexpr int I_IN = 16 * 44, I_O = 16 * 16, I_GD = 16 * 44, I_DD = 44 * 16;
        constexpr int N_A = 2 * I_O + I_DD;
        const int ln = F.lane;
        for (int it = gw; it < N_A; it += NGW) {
            int r = it;
            if (r < 2 * I_O) { const int l = r / I_O; r %= I_O; const int kb = r / 16, nb = r % 16;
                p0_transpose_item(in[12] + (size_t)l * D * D, D, 64 * kb, 64 * nb, (bf16_t*)(F.ws + (l ? WS_WO1 : WS_WO0)), D, 64 * nb + ln, ln); continue; }
            r -= 2 * I_O;
            { const int kb = r / 16, nb = r % 16;
              p0_transpose_item8<QDN>(in[15], D, 64 * kb, 64 * nb, F.ws + WS_WDD, DFF0, 64 * nb + ln, ln); }
        }
    }
    {
        LAS float* pm_ = (LAS float*)(F.lds + 65536);
        const int ln = F.lane;
        for (int it = F.G - 1 - F.bx; it < 4 * 44; it += F.G) {
            const float* src; int ldw, drow; unsigned char* dbase; float* csp;
            if (it < 2 * 44) { const int up = it / 44, c0 = 64 * (it % 44);
                src = in[up ? 14 : 13] + c0 + ln; ldw = DFF0; drow = (c0 >> 7) * 256 + up * 128 + (c0 & 127) + ln; dbase = F.ws + WS_WGUD; csp = (float*)(F.ws + WS_CSD); }
            else { const int l = (it - 2 * 44) / 44, c0 = 512 + 64 * (it % 44);
                const int n32 = ln & 31; const int dn = c0 < OFFV ? (ln & 32) + ((n32 < 16) ? 2 * n32 : 2 * (n32 - 16) + 1) : ln;
                drow = c0 + dn;
                if (c0 >= OFFG) { const int gcol = c0 - OFFG; drow = gcol < D ? OFFG + (gcol >> 7) * 256 + (gcol & 127) + ln : OFFG + ((gcol - D) >> 7) * 256 + 128 + ((gcol - D) & 127) + ln; }
                drow -= 512;
                src = in[8] + (size_t)l * D * INW + c0 + ln; ldw = INW; dbase = F.ws + (l ? WS_WIN1 : WS_WIN0) + (size_t)512 * D * 2; csp = (float*)(F.ws + WS_CSI) + l * 2816; }
            src += (size_t)(F.wave * 128) * ldw;
            float v[128]; float am = 0.f;
#pragma unroll
            for (int i = 0; i < 128; ++i) v[i] = __builtin_nontemporal_load(src + (size_t)i * ldw);
#pragma unroll
            for (int i = 0; i < 128; ++i) am = fmaxf(am, fabsf(v[i]));
            __syncthreads();
            pm_[F.wave * 64 + ln] = am;
            __syncthreads();
#pragma unroll
            for (int w = 0; w < 8; ++w) am = fmaxf(am, pm_[w * 64 + ln]);
            const float sc = am > 0.f ? 127.0f / am : 0.f;
            if (F.wave == 0) csp[drow] = am * (1.0f / 127.0f);
            unsigned char* dst = dbase + (size_t)drow * D + F.wave * 128;
#pragma unroll
            for (int j = 0; j < 8; ++j) { u32x4 o; o.x = pk4i8(v[16 * j], v[16 * j + 1], v[16 * j + 2], v[16 * j + 3], sc); o.y = pk4i8(v[16 * j + 4], v[16 * j + 5], v[16 * j + 6], v[16 * j + 7], sc);
                o.z = pk4i8(v[16 * j + 8], v[16 * j + 9], v[16 * j + 10], v[16 * j + 11], sc); o.w = pk4i8(v[16 * j + 12], v[16 * j + 13], v[16 * j + 14], v[16 * j + 15], sc);
                *(u32x4*)(dst + 16 * j) = o; }
        }
    }
    __syncthreads();
    {
        LAS float* wrow = (LAS float*)F.lds;
        LAS float* ctab = wrow + 4096;
        if (F.tid < 128) ctab[F.tid] = cospif((float)F.tid / 64.0f);
        for (int it = F.bx; it < 2 * 128; it += F.G) {
            const int l = it >> 7, d0 = (it & 127) * 8;
            __syncthreads();
            for (int i = F.tid; i < 4096; i += NTHR) wrow[i] = __builtin_nontemporal_load(in[8] + (size_t)l * D * INW + (size_t)(d0 + (i >> 9)) * INW + (i & 511));
            __syncthreads();
            const int r = F.tid, j = r >> 1, ri = r & 1, g = j >> 6, jj = j & 63;
            float a[8];
#pragma unroll
            for (int q = 0; q < 8; ++q) a[q] = 0.f;
            for (int cc = 0; cc < 128; ++cc) {
                float cf;
                if (jj == 0) cf = ri ? ((cc & 1) ? -1.f : 1.f) : 1.f;
                else { const int idx = (cc * jj) & 127; cf = ri ? -ctab[(idx - 32) & 127] : ctab[idx]; }
#pragma unroll
                for (int q = 0; q < 8; ++q) a[q] += cf * wrow[q * 512 + g * 128 + cc];
            }
            u32x4 o; o.x = pk2(a[0], a[1]); o.y = pk2(a[2], a[3]); o.z = pk2(a[4], a[5]); o.w = pk2(a[6], a[7]);
            *(u32x4*)((bf16_t*)(F.ws + (l ? WS_WIN1 : WS_WIN0)) + (size_t)r * D + d0) = o;
            { float am = 0.f;
#pragma unroll
              for (int q = 0; q < 4; ++q) { const unsigned w_ = q == 0 ? o.x : (q == 1 ? o.y : (q == 2 ? o.z : o.w)); am = fmaxf(am, fmaxf(fabsf(bflo(w_)), fabsf(bfhi(w_)))); }
              atomicMax((unsigned*)(F.ws + WS_CTL) + CW_RMAX + l * 512 + r, __builtin_bit_cast(unsigned, am)); }
        }
        __syncthreads();
    }
    const int gt = F.bx * NTHR + F.tid, NGT = F.G * NTHR;
    for (int it = gt; it < 2 * 1024 * 144; it += NGT) {
        const int l = it / (1024 * 144), r = it % (1024 * 144), kc = r / 1024, o = r % 1024;
        const float* wf = in[10] + (size_t)l * 512 * D; const float* wa = in[11] + (size_t)l * 512 * D;
        float v[8];
#pragma unroll
        for (int q = 0; q < 8; ++q) { const int k = kc * 8 + q; float x = 0.f;
            if (k < 512) { const int mm = k & 127; x = __builtin_nontemporal_load(wf + (size_t)k * D + o) * ((mm == 0 || mm == 64) ? 0.5f : 1.f); }
            else if (k < 520) { const int gg = (k - 512) >> 1, sgn = (k - 512) & 1; x = 0.5f * wf[(size_t)(gg * 128 + 64 * sgn) * D + o]; }
            else if (k >= 640) x = __builtin_nontemporal_load(wa + (size_t)(k - 640) * D + o);
            v[q] = x; }
        u32x4 w; w.x = pk2(v[0], v[1]); w.y = pk2(v[2], v[3]); w.z = pk2(v[4], v[5]); w.w = pk2(v[6], v[7]);
        *(u32x4*)((bf16_t*)(F.ws + (l ? WS_WM1 : WS_WM0)) + (size_t)o * KM + kc * 8) = w;
    }
    for (int it = gt; it < 192 * 16; it += NGT) {
        const int i = it & 15, p = it >> 4, pos = p < 128 ? p : p - 128;
        const float inv = powf(10000.0f, -(float)i / 16.0f), a = (float)pos * inv;
        ((f32x2*)(F.ws + WS_ROPE))[it] = (f32x2){cosf(a), sinf(a)};
    }
    for (int it = gt; it < 128 * 64; it += NGT) {
        const int t2 = it >> 6, k1 = it & 63; float s, c; sincospif((float)(t2 * k1) / 4096.0f, &s, &c);
        ((f32x2*)(F.ws + WS_TW))[it] = (f32x2){c, s};
    }
    for (int it = gt; it < 256 * 128; it += NGT) {
        const int nu = it >> 7, ka = it & 127; float v = 0.f;
        if (nu < 128) { const int k1 = nu >> 1, ro = nu & 1, ri = ka >> 6, t1 = ka & 63; float s, c; sincospif((float)((t1 * k1) & 63) / 32.0f, &s, &c);
            v = ro == 0 ? (ri == 0 ? c : s) : (ri == 0 ? -s : c); }
        ((bf16_t*)(F.ws + WS_FA64))[it] = (bf16_t)f2bf(v);
    }
    for (int it = gt; it < 256 * 256; it += NGT) {
        const int mu = it >> 8, la = it & 255, k2 = mu >> 1, ro = mu & 1, ri = la >> 7, t2 = la & 127; float s, c; sincospif((float)((t2 * k2) & 127) / 64.0f, &s, &c);
        const float v = (ro == 0 ? (ri == 0 ? c : s) : (ri == 0 ? -s : c)) * 0.0009765625f;
        ((bf16_t*)(F.ws + WS_TC))[it] = (bf16_t)f2bf(v);
    }
    for (int it = gt; it < 512 * 512; it += NGT) {
        const int mu = it >> 9, la = it & 511, k = mu >> 1, ro = mu & 1, ri = la >> 8, t = la & 255; float s, c; sincospif((float)((t * k) & 255) / 128.0f, &s, &c);
        const float v = (ro == 0 ? (ri == 0 ? c : s) : (ri == 0 ? -s : c)) * 0.005524271728019903f;
        ((bf16_t*)(F.ws + WS_TX))[it] = (bf16_t)f2bf(v);
    }
    __syncthreads();
    {
        LAS float* sl = (LAS float*)F.lds;
        LAS float* part = sl + 3 * D;
        for (int i = F.tid; i < 3 * D; i += NTHR) { const float c = i < 2 * D ? in[1][i] : in[3][i - 2 * D]; sl[i] = c / (1.0f + __expf(-c)); }
        __syncthreads();
        for (int it = F.bx; it < 2 * 96; it += F.G) {
            const int l = it / 96, n = (it % 96) * 64 + F.lane;
            const float* wm = in[4] + (size_t)l * D * MODSZ + (size_t)(F.wave * 128) * MODSZ + n;
            float a0 = 0.f, a1 = 0.f, a2 = 0.f;
#pragma unroll
            for (int d0 = 0; d0 < 128; d0 += 32) { float w[32];
#pragma unroll
                for (int q = 0; q < 32; ++q) w[q] = __builtin_nontemporal_load(wm + (size_t)(d0 + q) * MODSZ);
#pragma unroll
                for (int q = 0; q < 32; ++q) { const int d = F.wave * 128 + d0 + q; a0 += sl[d] * w[q]; a1 += sl[D + d] * w[q]; a2 += sl[2 * D + d] * w[q]; } }
            __syncthreads();
            part[(F.wave * 3 + 0) * 64 + F.lane] = a0; part[(F.wave * 3 + 1) * 64 + F.lane] = a1; part[(F.wave * 3 + 2) * 64 + F.lane] = a2;
            __syncthreads();
            if (F.tid < 192) { const int v = F.tid >> 6, ln = F.tid & 63; float sacc = in[5][l * MODSZ + (it % 96) * 64 + ln];
#pragma unroll
                for (int w = 0; w < 8; ++w) sacc += part[(w * 3 + v) * 64 + ln];
                modp(F, l, v)[(it % 96) * 64 + ln] = sacc; }
        }
    }
    for (int it = gt; it < NTOK * 15; it += NGT) { const int row = it / 15, c = it % 15;
        *(u32x4*)((bf16_t*)(F.ws + WS_FO) + (size_t)row * KM + 520 + c * 8) = (u32x4){0u, 0u, 0u, 0u}; }
}

__device__ __forceinline__ void quant_wu(Frame& F) {
    const unsigned* rmax = (const unsigned*)(F.ws + WS_CTL) + CW_RMAX;
    for (int hr = F.bx * NWAVES + F.wave; hr < 2 * 512 * 2; hr += F.G * NWAVES) {
        const int row = hr >> 1, half = hr & 1, l = row >> 9, r = row & 511;
        const float am = __builtin_bit_cast(float, rmax[row]), qs = am > 0.f ? 127.0f / am : 0.f;
        const int d = 512 * half + 8 * F.lane;
        const u32x4 w = *(const u32x4*)((const bf16_t*)(F.ws + (l ? WS_WIN1 : WS_WIN0)) + (size_t)r * D + d);
        u32x2 o; o.x = pk4i8(bflo(w.x), bfhi(w.x), bflo(w.y), bfhi(w.y), qs); o.y = pk4i8(bflo(w.z), bfhi(w.z), bflo(w.w), bfhi(w.w), qs);
        *(u32x2*)(F.ws + (l ? WS_WIN1 : WS_WIN0) + 4 * MiB + (size_t)r * D + d) = o;
        if (half == 0 && F.lane == 0) ((float*)(F.ws + WS_RSW))[row] = am * (1.0f / 127.0f);
    }
}

__device__ __forceinline__ const float* xrow_ptr(const Frame& F, int row, const float* xl) { return row < NL ? xl + (size_t)row * D : (const float*)(F.ws + WS_XC) + (size_t)(row - NL) * D; }

template <bool ROUTE, int OUTM = ROUTE ? 1 : 0>
__device__ __forceinline__ void norm_phase(Frame& F, int l, int which  , const float* xl, const float* xc, int nrows, const float* xcadd = nullptr, float* xcwb = nullptr) {
    const float* gvec = F.in[which ? 7 : 6] + l * D;
    LAS float* wr_l = (LAS float*)F.lds;
    constexpr int RMAX = 32;
    LAS int* pe = (LAS int*)(F.lds + 32768); LAS float* pw = (LAS float*)(F.lds + 32768 + 2048); LAS unsigned* lcnt = (LAS unsigned*)(F.lds + 32768 + 4096); LAS unsigned* gb = lcnt + 8;
    if (ROUTE) { for (int i = F.tid; i < D * NE; i += NTHR) wr_l[i] = F.in[16][i]; pe[F.tid] = -1; if (F.tid < 8) lcnt[F.tid] = 0u; __syncthreads(); }
    const int gw = F.bx * NWAVES + F.wave, NGW = F.G * NWAVES;
    int iter = 0;
    auto ldx = [&](int row, f32x4 (&x)[4]) {
        const bool fromb = row < NL && xl == nullptr;
        const float* xr = row < NL ? (fromb ? xc : xl + (size_t)row * D) : xc + (size_t)(row - NL) * D;
        const bf16_t* xbr = (const bf16_t*)(F.ws + WS_XB) + (size_t)row * D;
#pragma unroll
        for (int j = 0; j < 4; ++j) {
            if (fromb) { const u32x2 xb = __builtin_nontemporal_load((const u32x2*)(xbr + 256 * j + 4 * F.lane)); x[j] = (f32x4){bflo(xb.x), bfhi(xb.x), bflo(xb.y), bfhi(xb.y)}; }
            else x[j] = __builtin_nontemporal_load((const f32x4*)(xr + 256 * j + 4 * F.lane));
            if (row >= NL && xcadd) { x[j] = x[j] + *(const f32x4*)(xcadd + (size_t)(row - NL) * D + 256 * j + 4 * F.lane); if (xcwb) *(f32x4*)(xcwb + (size_t)(row - NL) * D + 256 * j + 4 * F.lane) = x[j]; } }
    };
    f32x4 x[4], xn[4];
    if (gw < nrows) ldx(gw, x);
    for (int row = gw; row < nrows; row += NGW, ++iter) {
        const int v = row < T ? 0 : (row < NL ? 1 : 2);
        const float* sh = modp(F, l, v) + (which ? 3 : 0) * D; const float* sc = sh + D;
        if (row + NGW < nrows) ldx(row + NGW, xn);
        float s = 0.f;
#pragma unroll
        for (int j = 0; j < 4; ++j) s += (x[j].x * x[j].x + x[j].y * x[j].y) + (x[j].z * x[j].z + x[j].w * x[j].w);
        const float r = 1.0f / sqrtf(wave_sum(s) * (1.f / D) + EPS);
        float lg[NE];
        if (ROUTE) {
#pragma unroll
            for (int e = 0; e < NE; ++e) lg[e] = 0.f; }
        bf16_t* hr = (bf16_t*)(F.ws + WS_H) + (size_t)row * D;
        f32x4 hh[4]; float amax = 0.f;
#pragma unroll
        for (int j = 0; j < 4; ++j) { const int c = 256 * j + 4 * F.lane;
            const f32x4 gg = *(const f32x4*)(gvec + c), s4 = *(const f32x4*)(sh + c), c4 = *(const f32x4*)(sc + c);
            f32x4 h = (x[j] * r) * gg; h = h * (c4 + 1.0f) + s4;
            if (OUTM == 1) *(unsigned*)((unsigned char*)(F.ws + WS_H) + (size_t)row * D + c) = pk4f8(h.x, h.y, h.z, h.w);
            else if (OUTM == 0) { u32x2 o; o.x = pk2(h.x, h.y); o.y = pk2(h.z, h.w); *(u32x2*)(hr + c) = o; }
            else { hh[j] = h; amax = fmaxf(fmaxf(amax, fmaxf(fabsf(h.x), fabsf(h.y))), fmaxf(fabsf(h.z), fabsf(h.w))); }
            if (ROUTE) {
#pragma unroll
                for (int q = 0; q < 4; ++q) { const float hv = h[q]; const LAS f32x4* w = (const LAS f32x4*)(wr_l + (c + q) * NE); const f32x4 w0 = w[0], w1 = w[1];
                    lg[0] += hv * w0.x; lg[1] += hv * w0.y; lg[2] += hv * w0.z; lg[3] += hv * w0.w; lg[4] += hv * w1.x; lg[5] += hv * w1.y; lg[6] += hv * w1.z; lg[7] += hv * w1.w; } }
        }
        if (OUTM >= 2) {
            amax = wave_max(amax);
            const float qs = amax > 0.f ? 127.0f / amax : 0.f;
            if (F.lane == 0) ((float*)(F.ws + WS_RS))[row] = amax * (1.0f / 127.0f);
#pragma unroll
            for (int j = 0; j < 4; ++j) *(unsigned*)((unsigned char*)(F.ws + (OUTM == 3 ? WS_H8 : WS_H)) + (size_t)row * D + 256 * j + 4 * F.lane) = pk4i8(hh[j].x, hh[j].y, hh[j].z, hh[j].w, qs);
        }
        if (ROUTE) {
#pragma unroll
            for (int e = 0; e < NE; ++e) lg[e] = wave_sum(lg[e]);
            if (F.lane == 0) {
                int e1 = 0; float v1 = lg[0];
#pragma unroll
                for (int e = 1; e < NE; ++e) if (lg[e] > v1) { v1 = lg[e]; e1 = e; }
                int e2 = -1; float v2 = -3.0e38f;
#pragma unroll
                for (int e = 0; e < NE; ++e) if (e != e1 && lg[e] > v2) { v2 = lg[e]; e2 = e; }
                const float p2 = __expf(v2 - v1), w1 = 1.f / (1.f + p2), w2 = p2 * w1;
                const int p = 2 * (F.wave * RMAX + iter);
                pe[p] = e1; pe[p + 1] = e2; pw[p] = w1; pw[p + 1] = w2;
            }
        }
#pragma unroll
        for (int j = 0; j < 4; ++j) x[j] = xn[j];
    }
    if (ROUTE) {
        __syncthreads();
        const int p = F.tid, e = pe[p]; unsigned lr = 0u;
        if (e >= 0) lr = __hip_atomic_fetch_add(lcnt + e, 1u, __ATOMIC_RELAXED, __HIP_MEMORY_SCOPE_WORKGROUP);
        __syncthreads();
        if (F.tid < NE && lcnt[F.tid] > 0u) gb[F.tid] = atomicAdd((unsigned*)(F.ws + WS_CTL) + CW_CNT + 64 * F.tid, lcnt[F.tid]);
        __syncthreads();
        if (e >= 0) {
            const int slot = p >> 1, row = F.bx * NWAVES + slot / RMAX + (slot % RMAX) * NGW, r = (int)(gb[e] + lr);
            int* toke = (int*)(F.ws + WS_TOKE); int* tokr = (int*)(F.ws + WS_TOKR); float* tokw = (float*)(F.ws + WS_TOKW); int* list = (int*)(F.ws + WS_LIST);
            toke[2 * row + (p & 1)] = e; tokr[2 * row + (p & 1)] = r; tokw[2 * row + (p & 1)] = pw[p]; list[e * NL + r] = row;
        }
        __syncthreads();
    }
}

constexpr int TAILQ_ROWS = 8 * 256;
__device__ __forceinline__ int moe_tail_panels(const unsigned* cw, int G) { int ptot = 0, plast = 0;
#pragma unroll
    for (int e = 0; e < NE; ++e) { const int p_ = ((int)cw[64 * e] + 255) >> 8; ptot += p_; plast = p_; }
    const int left = (4 * ptot) % G; int t = (left + 3) >> 2; if (4 * ptot < G) t = 0; if (t > plast) t = plast; if (t > 8) t = 8; return t; }
__device__ __forceinline__ void final_phase(Frame& F) {
    int t_ = threadIdx.x; asm volatile("" : "+v"(t_)); const int lane_ = t_ & 63;
    const int gw = F.bx * NWAVES + F.wave, NGW = F.G * NWAVES;
    const unsigned* cnt = (const unsigned*)(F.ws + WS_CTL) + CW_CNT;
    int base[NE]; { int b = 0;
#pragma unroll
        for (int e = 0; e < NE; ++e) { base[e] = b; b += ((int)cnt[64 * e] + 255) & ~255; } }
    const int* toke = (const int*)(F.ws + WS_TOKE); const int* tokr = (const int*)(F.ws + WS_TOKR); const float* tokw = (const float*)(F.ws + WS_TOKW);
    const bf16_t* dout = (const bf16_t*)(F.ws + WS_DOUT); const bf16_t* tq = (const bf16_t*)(F.ws + WS_DOUT1);
    const int trim_ = moe_tail_panels(cnt, F.G), trow0 = trim_ > 0 ? base[NE - 1] + ((((int)cnt[64 * (NE - 1)] + 255) >> 8) - trim_) * 256 : 0x7fffffff;
    struct RowIn { u32x2 a[4], b[4], xb[4]; const bf16_t* q1; const bf16_t* q2; float w1, w2; bool t1, t2; };
    auto ldrow = [&](int row, RowIn& R) {
        const int e1 = toke[2 * row], e2 = toke[2 * row + 1];
        int b1 = 0, b2 = 0;
#pragma unroll
        for (int e = 0; e < NE; ++e) { if (e == e1) b1 = base[e]; if (e == e2) b2 = base[e]; }
        const int r1_ = b1 + tokr[2 * row], r2_ = b2 + tokr[2 * row + 1];
        const bf16_t* d1 = dout + (size_t)r1_ * D; const bf16_t* d2 = dout + (size_t)r2_ * D;
        R.t1 = r1_ >= trow0; R.t2 = r2_ >= trow0;
        R.q1 = tq + (size_t)(R.t1 ? r1_ - trow0 : 0) * D; R.q2 = tq + (size_t)(R.t2 ? r2_ - trow0 : 0) * D;
        R.w1 = tokw[2 * row]; R.w2 = tokw[2 * row + 1];
#pragma unroll
        for (int j = 0; j < 4; ++j) { const int c = 256 * j + 4 * lane_;
            R.a[j] = __builtin_nontemporal_load((const u32x2*)(d1 + c)); R.b[j] = __builtin_nontemporal_load((const u32x2*)(d2 + c)); R.xb[j] = __builtin_nontemporal_load((const u32x2*)((const bf16_t*)(F.ws + WS_XB) + (size_t)row * D + c)); }
    };
    RowIn cur, nxt;
    if (gw < NL) ldrow(gw, cur);
    for (int row = gw; row < NL; row += NGW) {
        const int v = row < T ? 0 : 1;
        const float* ga2 = modp(F, 1, v) + 5 * D;
        if (row + NGW < NL) ldrow(row + NGW, nxt);
        float* xr = F.out + (size_t)row * D;
        f32x4 x[4]; float s = 0.f;
#pragma unroll
        for (int j = 0; j < 4; ++j) { const int c = 256 * j + 4 * lane_;
            const u32x2 a = cur.a[j], b = cur.b[j]; const f32x4 g4 = *(const f32x4*)(ga2 + c);
            f32x4 ya = (f32x4){bflo(a.x), bfhi(a.x), bflo(a.y), bfhi(a.y)}, yb = (f32x4){bflo(b.x), bfhi(b.x), bflo(b.y), bfhi(b.y)};
            if (cur.t1) { const u32x2 e_ = *(const u32x2*)(cur.q1 + c); ya = ya + (f32x4){bflo(e_.x), bfhi(e_.x), bflo(e_.y), bfhi(e_.y)}; }
            if (cur.t2) { const u32x2 e_ = *(const u32x2*)(cur.q2 + c); yb = yb + (f32x4){bflo(e_.x), bfhi(e_.x), bflo(e_.y), bfhi(e_.y)}; }
            const f32x4 y = (ya * cur.w1 + yb * cur.w2) * (1.0f / (float)(QDN * QACT));
            { const u32x2 xb = cur.xb[j]; x[j] = (f32x4){bflo(xb.x), bfhi(xb.x), bflo(xb.y), bfhi(xb.y)} + g4 * y; }
            s += (x[j].x * x[j].x + x[j].y * x[j].y) + (x[j].z * x[j].z + x[j].w * x[j].w); }
        const float r = 1.0f / sqrtf(wave_sum(s) * (1.f / D) + EPS);
#pragma unroll
        for (int j = 0; j < 4; ++j) { const int c = 256 * j + 4 * lane_; __builtin_nontemporal_store((x[j] * r) * *(const f32x4*)(F.in[20] + c), (f32x4*)(xr + c)); }
        cur = nxt;
    }
}

struct GridSched { int nM, nN, G, c; unsigned abytes, bbytes;
    __device__ __forceinline__ bool next(int i, Unit& u) const { const int L = i * G + c; if (L >= nM * nN) return false; pg8::swz_map(L, nM, nN, u.pm, u.pn); u.aoff = (unsigned)u.pm * abytes; u.boff = (unsigned)u.pn * bbytes; u.kind = 0; u.x0 = 0; u.x1 = 0; u.kh = 0; return true; } };

struct CtxSched { int G, c, nN; unsigned abytes, bbytes; int ksplit; unsigned khbytes;
    __device__ __forceinline__ bool next(int i, Unit& u) const { int L = i * G + c; if (L >= 2 * nN * ksplit) return false; u.kh = L / (2 * nN); L -= u.kh * 2 * nN; u.pm = 64 + L / nN; u.pn = L % nN;
        u.aoff = (unsigned)u.pm * abytes + (unsigned)u.kh * khbytes; u.boff = (unsigned)u.pn * bbytes + (unsigned)u.kh * khbytes; u.kind = 0; u.x0 = u.pm * 256; u.x1 = 0; return true; } };

struct CtxSplitSched { int G, c; unsigned abytes, bbytes, khbytes; int nk0, nk1;
    __device__ __forceinline__ bool next(int i, Unit& u) const { const int L = i * G + c; const bool ok = L < 16; const int Lc = ok ? L : 0;
        const int kh = Lc >> 3, r = Lc & 7, pm = 64 + (r >> 2), pn = r & 3;
        u.pm = pm; u.pn = pn; u.kh = kh; u.aoff = (unsigned)pm * abytes + (unsigned)kh * khbytes; u.boff = (unsigned)pn * bbytes + (unsigned)kh * khbytes; u.kind = 0; u.x0 = pm * 256; u.x1 = kh ? nk1 : nk0;
        return ok; } };
namespace pg8 { template <> struct var_k<CtxSplitSched> { static constexpr bool v = true; }; }
struct InprojSched { int G, c, l;
    __device__ __forceinline__ bool next(int i, Unit& u) const { const int L = i * G + c; const int nmain = 64 * 11;
        if (L < nmain) { pg8::swz_map(L, 64, 11, u.pm, u.pn); }
        else { const int r = L - nmain; if (l == 0) { if (r >= 22) return false; u.pm = 64 + r / 11; u.pn = r % 11; } else { if (r >= 2) return false; u.pm = 64 + r; u.pn = 2; } }
        u.aoff = (unsigned)u.pm * (256u * D); u.boff = (unsigned)u.pn * (256u * D); u.kind = 0; u.x0 = 0; u.x1 = 0; u.kh = 0; return true; } };

struct EpiInproj {
    static constexpr bool PERM = true; static constexpr int MIDK = 0;
    unsigned char* ws; const float* rs; const float* cs;
    __device__ __forceinline__ void operator()(const f32x4 (&acci)[2][2][4][2], const Unit& u, int wr, int wc, int fr, int fq) const {
        asm volatile("" : "+v"(fr), "+v"(fq));
        const int row0 = u.pm * 256 + wr * 64 + fr;
        const bool lat = u.pm < 64;
        const f32x2* rope = (const f32x2*)(ws + WS_ROPE);
        f32x4 csc[2][2]; float rsv[2][4];
#pragma unroll
        for (int bj = 0; bj < 2; ++bj) { const float* cp = cs + u.pn * 256 + bj * 128 + wc * 32 + 8 * fq; csc[bj][0] = *(const f32x4*)cp; csc[bj][1] = *(const f32x4*)(cp + 4); }
#pragma unroll
        for (int ai = 0; ai < 2; ++ai)
#pragma unroll
            for (int m = 0; m < 4; ++m) rsv[ai][m] = rs[row0 + ai * 128 + m * 16];
        asm volatile("" ::: "memory");
#pragma unroll
        for (int bj = 0; bj < 2; ++bj) {
            const int cl = u.pn * 256 + bj * 128 + wc * 32 + 8 * fq;
#pragma unroll
            for (int ai = 0; ai < 2; ++ai) {
                f32x4 rp0[4], rp1[4];
                if (cl < 640 && lat) {
#pragma unroll
                    for (int m = 0; m < 4; ++m) { const int row = row0 + ai * 128 + m * 16, t = row & (T - 1), prow = t >> 6, pcol = t & 63;
                        const int dh = cl & 63, i0 = (dh & 31) >> 1; const f32x2* rp = rope + ((dh < 32 ? prow : 128 + pcol) * 16 + i0);
                        rp0[m] = *(const f32x4*)rp; rp1[m] = *(const f32x4*)(rp + 2); }
                }
                asm volatile("" ::: "memory");
#pragma unroll
                for (int m = 0; m < 4; ++m) {
                    const int row = row0 + ai * 128 + m * 16;
                    const float rsc = rsv[ai][m];
                    f32x4 v0 = __builtin_convertvector(__builtin_bit_cast(pg8::i32x4, acci[ai][bj][m][0]), f32x4) * (csc[bj][0] * rsc);
                    f32x4 v1 = __builtin_convertvector(__builtin_bit_cast(pg8::i32x4, acci[ai][bj][m][1]), f32x4) * (csc[bj][1] * rsc);
                    bf16_t* dst;
                    if (cl < 640) {
                        if (lat) { const f32x2 c0 = (f32x2){rp0[m].x, rp0[m].y}, c1 = (f32x2){rp0[m].z, rp0[m].w}, c2 = (f32x2){rp1[m].x, rp1[m].y}, c3 = (f32x2){rp1[m].z, rp1[m].w};
                            f32x4 w0, w1; w0.x = v0.x * c0.x - v0.y * c0.y; w0.y = v0.x * c0.y + v0.y * c0.x; w0.z = v0.z * c1.x - v0.w * c1.y; w0.w = v0.z * c1.y + v0.w * c1.x;
                            w1.x = v1.x * c2.x - v1.y * c2.y; w1.y = v1.x * c2.y + v1.y * c2.x; w1.z = v1.z * c3.x - v1.w * c3.y; w1.w = v1.z * c3.y + v1.w * c3.x; v0 = w0; v1 = w1; }
                        if (cl < 512) { v0 = v0 * QSCALE; v1 = v1 * QSCALE; dst = (bf16_t*)(ws + WS_Q) + (size_t)row * 512 + cl; }
                        else dst = (bf16_t*)(ws + WS_KB) + (size_t)row * 128 + (cl - 512);
                    } else if (cl < 768) { dst = (bf16_t*)(ws + WS_VB) + (size_t)row * 128 + (cl - 640); }
                    else {
                        const int oc = (u.pn - 3) * 128 + wc * 32 + 8 * fq;
                        if (bj == 0) {
                            const f32x4 a0 = __builtin_convertvector(__builtin_bit_cast(pg8::i32x4, acci[ai][1][m][0]), f32x4) * (csc[1][0] * rsc), a1 = __builtin_convertvector(__builtin_bit_cast(pg8::i32x4, acci[ai][1][m][1]), f32x4) * (csc[1][1] * rsc);
#pragma unroll
                            for (int q = 0; q < 4; ++q) { v0[q] = sigmoidf_(v0[q]) * (1.0f + __builtin_amdgcn_exp2f(-a0[q] * LOG2E)); v1[q] = sigmoidf_(v1[q]) * (1.0f + __builtin_amdgcn_exp2f(-a1[q] * LOG2E)); }
                            dst = (bf16_t*)(ws + WS_GF) + (size_t)row * D + oc; }
                        else {
#pragma unroll
                            for (int q = 0; q < 4; ++q) { v0[q] = sigmoidf_(v0[q]); v1[q] = sigmoidf_(v1[q]); }
                            dst = (bf16_t*)(ws + WS_GA) + (size_t)row * D + oc; } }
                    u32x4 w; w.x = cvt_pk_bf16(v0[0], v0[1]); w.y = cvt_pk_bf16(v0[2], v0[3]); w.z = cvt_pk_bf16(v1[0], v1[1]); w.w = cvt_pk_bf16(v1[2], v1[3]);
                    *(u32x4*)dst = w;
                }
                asm volatile("" ::: "memory");
            }
        }
    }
};

struct UpermSched { int G, c, l;
    __device__ __forceinline__ bool next(int i, Unit& u) const { const int L = i * G + c; const int nn = l == 0 ? 66 : 64; if (L >= 2 * nn) return false;
        u.pm = L & 1; u.pn = L >> 1; u.aoff = (unsigned)u.pm * (256u * D); u.boff = 0; u.kind = 0; u.x0 = 0; u.x1 = 0; u.kh = 0; return true; } };
struct UpermRows { static constexpr bool GA = false, GB = true;
    __device__ __forceinline__ unsigned arow(const Unit&, int) const { return 0u; }
    __device__ __forceinline__ int trow(const Unit& u, int c) const { const int n = u.pn; int row;
        if (n < 64) { const int b = n >> 5, q = n & 31; row = b * T + 128 * (c & 63) + 4 * q + (c >> 6); } else row = NL + (n - 64) * 256 + c;
        return row; }
    __device__ __forceinline__ unsigned brow(const Unit& u, int c) const { return (unsigned)trow(u, c) * (unsigned)D; } };
struct EpiUperm {
    static constexpr bool PERM = true; static constexpr int MIDK = 0;
    unsigned char* ws; const float* rsw; const float* rsh;
    __device__ __forceinline__ void operator()(const f32x4 (&acc)[2][2][4][2], const Unit& u, int wr, int wc, int fr, int fq) const {
        asm volatile("" : "+v"(fr), "+v"(fq));
        const int n = u.pn; UpermRows RW;
        f32x4 hs[2][2]; float ws_[2][4];
#pragma unroll
        for (int bj = 0; bj < 2; ++bj)
#pragma unroll
            for (int k = 0; k < 2; ++k)
#pragma unroll
                for (int q = 0; q < 4; ++q) hs[bj][k][q] = rsh[RW.trow(u, bj * 128 + wc * 32 + 8 * fq + 4 * k + q)];
#pragma unroll
        for (int ai = 0; ai < 2; ++ai)
#pragma unroll
            for (int m = 0; m < 4; ++m) ws_[ai][m] = rsw[u.pm * 256 + ai * 128 + wr * 64 + m * 16 + fr];
        asm volatile("" ::: "memory");
#pragma unroll
        for (int ai = 0; ai < 2; ++ai)
#pragma unroll
            for (int m = 0; m < 4; ++m) { const int r = u.pm * 256 + ai * 128 + wr * 64 + m * 16 + fr, j = r >> 1, ri = r & 1;
#pragma unroll
                for (int bj = 0; bj < 2; ++bj) { const int c = bj * 128 + wc * 32 + 8 * fq;
                    const f32x4 v0 = __builtin_convertvector(__builtin_bit_cast(pg8::i32x4, acc[ai][bj][m][0]), f32x4) * (hs[bj][0] * ws_[ai][m]), v1 = __builtin_convertvector(__builtin_bit_cast(pg8::i32x4, acc[ai][bj][m][1]), f32x4) * (hs[bj][1] * ws_[ai][m]);
                    u32x4 w; w.x = cvt_pk_bf16(v0[0], v0[1]); w.y = cvt_pk_bf16(v0[2], v0[3]); w.z = cvt_pk_bf16(v1[0], v1[1]); w.w = cvt_pk_bf16(v1[2], v1[3]);
                    bf16_t* dst;
                    if (n < 64) { const int b = n >> 5, q = n & 31, t2 = 4 * q + (c >> 6), t1 = c & 63; dst = (bf16_t*)(ws + WS_UP) + ((size_t)((j * 2 + b) * 128 + t2) * 128 + ri * 64 + t1); }
                    else { const int b = n - 64; dst = (bf16_t*)(ws + WS_VCT) + ((size_t)((b * 256 + j) * 2 + ri) * 256 + c); }
                    *(u32x4*)dst = w; } }
    }
};

struct StepASched { int G, c, l;
    __device__ __forceinline__ bool next(int i, Unit& u) const { int L = i * G + c;
        if (l == 0 && G == 256) { if (c >= 16 && c < 20) return false; if (c >= 20 && c < 24) { if (i > 1) return false; L = i == 0 ? c : c - 4; } else if (i > 0) return false; }
        if (L >= 256) return false; pg8::swz_map(L, 256, 1, u.pm, u.pn); u.aoff = (unsigned)u.pm * (256u * 128u * 2u); u.boff = 0u; u.kind = 0; u.x0 = 0; u.x1 = 0; u.kh = 0; return true; } };

struct EpiStepA {
    static constexpr bool PERM = true; static constexpr int MIDK = 0;
    unsigned char* ws;
    __device__ __forceinline__ void operator()(const f32x4 (&acc)[2][2][4][2], const Unit& u, int wr, int wc, int fr, int fq) const {
        const f32x2* tw = (const f32x2*)(ws + WS_TW); bf16_t* gp = (bf16_t*)(ws + WS_GP);
        const int j = u.pm;
        f32x4 twv[4][2];
#pragma unroll
        for (int m = 0; m < 4; ++m)
#pragma unroll
            for (int n = 0; n < 2; ++n) twv[m][n] = *(const f32x4*)(tw + (wr * 64 + m * 16 + fr) * 64 + 16 * wc + 4 * fq + 2 * n);
        asm volatile("" ::: "memory");
#pragma unroll
        for (int ai = 0; ai < 2; ++ai)
#pragma unroll
            for (int m = 0; m < 4; ++m) { const int t2 = wr * 64 + m * 16 + fr, b = ai;
#pragma unroll
                for (int n = 0; n < 2; ++n) { const f32x4 v = acc[ai][0][m][n];
#pragma unroll
                    for (int p = 0; p < 2; ++p) { const int k1 = 16 * wc + 4 * fq + 2 * n + p; const f32x2 w = p ? (f32x2){twv[m][n].z, twv[m][n].w} : (f32x2){twv[m][n].x, twv[m][n].y};
                        const float gr = v[2 * p], gi = v[2 * p + 1];
                        const float orr = gr * w.x + gi * w.y, oi = gi * w.x - gr * w.y;
                        bf16_t* d = gp + ((size_t)((b * 64 + k1) * 256 + j) * 256 + t2);
                        d[0] = (bf16_t)f2bf(orr); d[128] = (bf16_t)f2bf(oi); } } }
    }
};
template <bool CTXV> struct EpiStepC {
    static constexpr bool PERM = true; static constexpr int MIDK = 0;
    unsigned char* ws;
    __device__ __forceinline__ void operator()(const f32x4 (&acc)[2][2][4][2], const Unit& u, int wr_, int wc_, int fr_, int fq_) const {
        int wr = wr_, wc = wc_, fr = fr_, fq = fq_, upm = u.pm, upn = u.pn;
        asm volatile("" : "+s"(wr), "+s"(wc), "+v"(fr), "+v"(fq), "+s"(upm), "+s"(upn));
        bf16_t* fo = (bf16_t*)(ws + WS_FO);
        const int NN = CTXV ? 256 : T;
        const int b = CTXV ? upm : (upm >> 6), k1 = CTXV ? 0 : (upm & 63), rowb = CTXV ? NL + b * 256 : b * T;
        const int own0 = wr * 128 + fr, mir0 = wr * 128 + 128 - fr;
        const int kk0 = (CTXV ? 128 * upn : 0) + 16 * wc + 4 * fq;
#pragma unroll
        for (int bj = 0; bj < 2; ++bj)
#pragma unroll
            for (int n = 0; n < 2; ++n)
#pragma unroll
                for (int p = 0; p < 2; ++p) {
                    const int kk = kk0 + 64 * bj + 2 * n + p;
                    const int k = CTXV ? kk : (k1 + 64 * kk), km = (NN - k) & (NN - 1);
                    const unsigned oo = (unsigned)(rowb + k) * KM, om = (unsigned)(rowb + km) * KM;
#pragma unroll
                    for (int ai = 0; ai < 2; ++ai)
#pragma unroll
                        for (int m = 0; m < 4; ++m) {
                            const f32x4 v = acc[ai][bj][m][n];
                            const bf16_t re = (bf16_t)f2bf(v[2 * p]);
                            if (m == 0 && fr == 0) { const int g = 2 * ai + wr; const bf16_t im = (bf16_t)f2bf(v[2 * p + 1]);
                                fo[oo + g * 128] = re; fo[om + 512 + 2 * g] = re; fo[oo + g * 128 + 64] = im; fo[om + 512 + 2 * g + 1] = im; }
                            else { fo[oo + own0 + ai * 256 + 16 * m] = re; fo[om + mir0 + ai * 256 - 16 * m] = re; }
                        }
                    asm volatile("" ::: "memory"); __builtin_amdgcn_sched_barrier(0);
                }
    }
};

struct EpiMerge {
    static constexpr bool PERM = true; static constexpr int MIDK = 10;
    unsigned char* ws;
    __device__ __forceinline__ void mid(f32x4 (&acc)[2][2][4][2], const Unit& u, int wr, int wc, int fr, int fq) const {
        asm volatile("" : "+v"(fr), "+v"(fq));
#pragma unroll
        for (int ai = 0; ai < 2; ++ai) {
            u32x4 gr[4][2];
#pragma unroll
            for (int m = 0; m < 4; ++m) { const size_t row = (size_t)(u.pm * 256 + ai * 128 + wr * 64 + m * 16 + fr);
#pragma unroll
                for (int bj = 0; bj < 2; ++bj) { const int col = u.pn * 256 + bj * 128 + wc * 32 + 8 * fq;
                    gr[m][bj] = *(const u32x4*)((const bf16_t*)(ws + WS_GF) + row * D + col); } }
            asm volatile("" ::: "memory");
#pragma unroll
            for (int m = 0; m < 4; ++m)
#pragma unroll
                for (int bj = 0; bj < 2; ++bj) { const u32x4 g_ = gr[m][bj];
                    const f32x4 r0 = (f32x4){bflo(g_.x), bfhi(g_.x), bflo(g_.y), bfhi(g_.y)}, r1 = (f32x4){bflo(g_.z), bfhi(g_.z), bflo(g_.w), bfhi(g_.w)};
                    acc[ai][bj][m][0] = acc[ai][bj][m][0] * r0; acc[ai][bj][m][1] = acc[ai][bj][m][1] * r1; }
            asm volatile("" ::: "memory");
        }
    }
    __device__ __forceinline__ void operator()(const f32x4 (&acc)[2][2][4][2], const Unit& u, int wr, int wc, int fr, int fq) const {
        asm volatile("" : "+v"(fr), "+v"(fq));
#pragma unroll
        for (int ai = 0; ai < 2; ++ai) {
            u32x4 gv[4][2];
#pragma unroll
            for (int m = 0; m < 4; ++m) { const size_t row = (size_t)(u.pm * 256 + ai * 128 + wr * 64 + m * 16 + fr);
#pragma unroll
                for (int bj = 0; bj < 2; ++bj) { const int col = u.pn * 256 + bj * 128 + wc * 32 + 8 * fq; gv[m][bj] = *(const u32x4*)((const bf16_t*)(ws + WS_GA) + row * D + col); } }
            asm volatile("" ::: "memory");
#pragma unroll
            for (int m = 0; m < 4; ++m) { const size_t row = (size_t)(u.pm * 256 + ai * 128 + wr * 64 + m * 16 + fr);
#pragma unroll
                for (int bj = 0; bj < 2; ++bj) { const int col = u.pn * 256 + bj * 128 + wc * 32 + 8 * fq;
                    const u32x4 ga = gv[m][bj];
                    const f32x4 a0 = acc[ai][bj][m][0], a1 = acc[ai][bj][m][1];
                    u32x4 w;
                    w.x = cvt_pk_bf16(bflo(ga.x) * a0[0], bfhi(ga.x) * a0[1]); w.y = cvt_pk_bf16(bflo(ga.y) * a0[2], bfhi(ga.y) * a0[3]);
                    w.z = cvt_pk_bf16(bflo(ga.z) * a1[0], bfhi(ga.z) * a1[1]); w.w = cvt_pk_bf16(bflo(ga.w) * a1[2], bfhi(ga.w) * a1[3]);
                    *(u32x4*)((bf16_t*)(ws + WS_Y) + row * D + col) = w; } }
            asm volatile("" ::: "memory");
        }
    }
};

struct EpiResid {
    static constexpr bool PERM = true; static constexpr int MIDK = 0;
    const float* xl_in32; const bf16_t* xl_inb; bf16_t* xl_out; const float* xc_in; float* xc_out; const float* mod_l; int chunk; float* tmpc; float ascale;
    __device__ __forceinline__ void operator()(const f32x4 (&acc)[2][2][4][2], const Unit& u, int wr, int wc, int fr, int fq) const {
        asm volatile("" : "+v"(fr), "+v"(fq));
        const int v = u.pm < 32 ? 0 : (u.pm < 64 ? 1 : 2);
        const float* gate = mod_l + v * MODSZ + chunk * D;
        const bool lat = u.pm < 64; const int rbase = lat ? u.pm * 256 : (u.pm - 64) * 256;
        const bool f32src = lat ? (xl_in32 != nullptr) : true;
#pragma unroll
        for (int bj = 0; bj < 2; ++bj) { const int col = u.pn * 256 + bj * 128 + wc * 32 + 8 * fq;
            const f32x4 g0 = *(const f32x4*)(gate + col) * ascale, g1 = *(const f32x4*)(gate + col + 4) * ascale;
#pragma unroll
            for (int ai = 0; ai < 2; ++ai) {
                f32x4 x0[4], x1[4];
                if (!(!lat && u.kh)) {
                    if (f32src) { const float* src = lat ? xl_in32 : xc_in;
#pragma unroll
                        for (int m = 0; m < 4; ++m) { const size_t o = (size_t)(rbase + ai * 128 + wr * 64 + m * 16 + fr) * D + col; x0[m] = __builtin_nontemporal_load((const f32x4*)(src + o)); x1[m] = __builtin_nontemporal_load((const f32x4*)(src + o + 4)); } }
                    else {
                        u32x4 xb[4];
#pragma unroll
                        for (int m = 0; m < 4; ++m) { const size_t o = (size_t)(rbase + ai * 128 + wr * 64 + m * 16 + fr) * D + col; xb[m] = *(const u32x4*)(xl_inb + o); }
                        asm volatile("" ::: "memory");
#pragma unroll
                        for (int m = 0; m < 4; ++m) { x0[m] = (f32x4){bflo(xb[m].x), bfhi(xb[m].x), bflo(xb[m].y), bfhi(xb[m].y)}; x1[m] = (f32x4){bflo(xb[m].z), bfhi(xb[m].z), bflo(xb[m].w), bfhi(xb[m].w)}; } }
                }
                asm volatile("" ::: "memory");
#pragma unroll
                for (int m = 0; m < 4; ++m) { const size_t o = (size_t)(rbase + ai * 128 + wr * 64 + m * 16 + fr) * D + col;
                    if (lat) {
                        const f32x4 y0 = x0[m] + g0 * acc[ai][bj][m][0], y1 = x1[m] + g1 * acc[ai][bj][m][1];
                        u32x4 w; w.x = cvt_pk_bf16(y0[0], y0[1]); w.y = cvt_pk_bf16(y0[2], y0[3]); w.z = cvt_pk_bf16(y1[0], y1[1]); w.w = cvt_pk_bf16(y1[2], y1[3]);
                        *(u32x4*)(xl_out + o) = w;
                    } else if (u.kh) { *(f32x4*)(tmpc + o) = g0 * acc[ai][bj][m][0]; *(f32x4*)(tmpc + o + 4) = g1 * acc[ai][bj][m][1]; }
                    else { *(f32x4*)(xc_out + o) = x0[m] + g0 * acc[ai][bj][m][0];
                           *(f32x4*)(xc_out + o + 4) = x1[m] + g1 * acc[ai][bj][m][1]; } }
                asm volatile("" ::: "memory");
            } }
    }
};

struct EpiSwiglu {
    static constexpr bool PERM = true; static constexpr int MIDK = 0;
    bf16_t* act; int ld;
    __device__ __forceinline__ void operator()(const f32x4 (&acc)[2][2][4][2], const Unit& u, int wr, int wc, int fr, int fq) const {
        const int col = u.pn * 128 + wc * 32 + 8 * fq;
#pragma unroll
        for (int ai = 0; ai < 2; ++ai)
#pragma unroll
            for (int m = 0; m < 4; ++m) { const size_t row = (size_t)(u.x0 + ai * 128 + wr * 64 + m * 16 + fr);
                float o[8];
#pragma unroll
                for (int n = 0; n < 2; ++n)
#pragma unroll
                    for (int q = 0; q < 4; ++q) { const float gv = acc[ai][0][m][n][q], uv = acc[ai][1][m][n][q]; o[4 * n + q] = gv * sigmoidf_(gv) * uv; }
                u32x4 w; w.x = cvt_pk_bf16(o[0], o[1]); w.y = cvt_pk_bf16(o[2], o[3]); w.z = cvt_pk_bf16(o[4], o[5]); w.w = cvt_pk_bf16(o[6], o[7]);
                *(u32x4*)(act + row * ld + col) = w; }
    }
};
struct EpiSwigluI8 {
    static constexpr bool PERM = true; static constexpr int MIDK = 0;
    bf16_t* act; int ld; const float* rs; const float* cs;
    __device__ __forceinline__ void operator()(const f32x4 (&acc)[2][2][4][2], const Unit& u, int wr, int wc, int fr, int fq) const {
        asm volatile("" : "+v"(fr), "+v"(fq));
        const int col = u.pn * 128 + wc * 32 + 8 * fq;
        const float* cg = cs + u.pn * 256 + wc * 32 + 8 * fq;
        f32x4 cgl[2], cgu[2];
        { const f32x4 g0 = *(const f32x4*)cg, g1 = *(const f32x4*)(cg + 4), u0 = *(const f32x4*)(cg + 128), u1 = *(const f32x4*)(cg + 132);
          cgl[0] = g0 * (-LOG2E); cgl[1] = g1 * (-LOG2E); cgu[0] = g0 * u0; cgu[1] = g1 * u1; }
        float rsv[2][4];
#pragma unroll
        for (int ai = 0; ai < 2; ++ai)
#pragma unroll
            for (int m = 0; m < 4; ++m) rsv[ai][m] = rs[(size_t)(u.x0 + ai * 128 + wr * 64 + m * 16 + fr)];
        asm volatile("" ::: "memory");
#pragma unroll
        for (int ai = 0; ai < 2; ++ai)
#pragma unroll
            for (int m = 0; m < 4; ++m) { const size_t row = (size_t)(u.x0 + ai * 128 + wr * 64 + m * 16 + fr);
                const float rsc = rsv[ai][m];
                f32x4 o[2];
#pragma unroll
                for (int n = 0; n < 2; ++n) {
                    const f32x4 g = __builtin_convertvector(__builtin_bit_cast(pg8::i32x4, acc[ai][0][m][n]), f32x4) * rsc, uu = __builtin_convertvector(__builtin_bit_cast(pg8::i32x4, acc[ai][1][m][n]), f32x4) * rsc;
                    f32x4 e = g * cgl[n];
#pragma unroll
                    for (int q = 0; q < 4; ++q) e[q] = __builtin_amdgcn_exp2f(e[q]);
                    f32x4 d = e + 1.0f;
#pragma unroll
                    for (int q = 0; q < 4; ++q) d[q] = __builtin_amdgcn_rcpf(d[q]);
                    o[n] = ((g * uu) * cgu[n]) * (d * (float)QACT);
#pragma unroll
                    for (int q = 0; q < 4; ++q) o[n][q] = __builtin_amdgcn_fmed3f(o[n][q], -448.0f, 448.0f); }
                u32x2 w; w.x = pk4f8(o[0][0], o[0][1], o[0][2], o[0][3]); w.y = pk4f8(o[1][0], o[1][1], o[1][2], o[1][3]);
                *(u32x2*)((unsigned char*)act + row * ld + col) = w; }
    }
};
struct EpiSwiglu8 {
    static constexpr bool PERM = true; static constexpr int MIDK = 0;
    unsigned char* act; int ld;
    __device__ __forceinline__ void operator()(const f32x4 (&acc)[2][2][4][2], const Unit& u, int wr, int wc, int fr, int fq) const {
        asm volatile("" : "+v"(fr), "+v"(fq));
        const int col = u.pn * 128 + wc * 32 + 8 * fq;
        constexpr float C1 = -LOG2E / (float)QGU, KD = (float)QGU * (float)QGU / (float)QACT;
#pragma unroll
        for (int ai = 0; ai < 2; ++ai)
#pragma unroll
            for (int m = 0; m < 4; ++m) { const size_t row = (size_t)(u.x0 + ai * 128 + wr * 64 + m * 16 + fr);
                f32x4 o[2];
#pragma unroll
                for (int n = 0; n < 2; ++n) { const f32x4 g = acc[ai][0][m][n], uu = acc[ai][1][m][n];
                    const f32x4 p = g * uu; f32x4 e = g * C1;
#pragma unroll
                    for (int q = 0; q < 4; ++q) e[q] = __builtin_amdgcn_exp2f(e[q]);
                    f32x4 d = e * KD + KD;
#pragma unroll
                    for (int q = 0; q < 4; ++q) d[q] = __builtin_amdgcn_rcpf(d[q]);
                    o[n] = p * d;
#pragma unroll
                    for (int q = 0; q < 4; ++q) o[n][q] = __builtin_amdgcn_fmed3f(o[n][q], -448.0f, 448.0f); }
                u32x2 w; w.x = pk4f8(o[0][0], o[0][1], o[0][2], o[0][3]); w.y = pk4f8(o[1][0], o[1][1], o[1][2], o[1][3]);
                *(u32x2*)(act + row * ld + col) = w; }
    }
};
struct EpiBf16 {
    static constexpr bool PERM = true; static constexpr int MIDK = 0;
    bf16_t* O0; bf16_t* O1; int ld;
    __device__ __forceinline__ void operator()(const f32x4 (&acc)[2][2][4][2], const Unit& u, int wr, int wc, int fr, int fq) const {
        asm volatile("" : "+v"(fr), "+v"(fq));
#pragma unroll
        for (int ai = 0; ai < 2; ++ai)
#pragma unroll
            for (int m = 0; m < 4; ++m) { const size_t row = (size_t)(u.x0 + ai * 128 + wr * 64 + m * 16 + fr);
#pragma unroll
                for (int bj = 0; bj < 2; ++bj) { const int col = u.pn * 256 + bj * 128 + wc * 32 + 8 * fq; const f32x4 v0 = acc[ai][bj][m][0], v1 = acc[ai][bj][m][1];
                    u32x4 w; w.x = cvt_pk_bf16(v0[0], v0[1]); w.y = cvt_pk_bf16(v0[2], v0[3]); w.z = cvt_pk_bf16(v1[0], v1[1]); w.w = cvt_pk_bf16(v1[2], v1[3]);
                    *(u32x4*)((u.kh ? O1 : O0) + row * ld + col) = w; } }
    }
};

struct RowSched { int nM, nN, G, c; unsigned abytes, bbytes;
    __device__ __forceinline__ bool next(int i, Unit& u) const { const int L = i * G + c; if (L >= nM * nN) return false; pg8::swz_map(L, nM, nN, u.pm, u.pn); u.aoff = (unsigned)u.pm * abytes; u.boff = (unsigned)u.pn * bbytes; u.kind = 0; u.x0 = u.pm * 256; u.x1 = 0; u.kh = 0; return true; } };

struct MoeSched { int G, c, nN, ksplit, trim; unsigned bexp, bbytes, arow_bytes, khbytes; bool a_slots; int cnt[NE], base[NE];
    __device__ __forceinline__ void init(const unsigned* cw) { int b = 0;
#pragma unroll
        for (int e = 0; e < NE; ++e) { cnt[e] = (int)cw[64 * e]; base[e] = b; b += (cnt[e] + 255) & ~255; } }
    __device__ __forceinline__ bool next(int i, Unit& u) const { int L = i * G + c; int e = 0;
        for (; e < NE; ++e) { const int nu = (((cnt[e] + 255) >> 8) - (e == NE - 1 ? trim : 0)) * nN * ksplit; if (L < nu) break; L -= nu; }
        if (e >= NE) return false;
        int cn = 0, bs = 0;
#pragma unroll
        for (int q = 0; q < NE; ++q) if (q == e) { cn = cnt[q]; bs = base[q]; }
        const int np_ = ((cn + 255) >> 8) - (e == NE - 1 ? trim : 0); const int nt_ = np_ * nN; u.kh = L / nt_; L -= u.kh * nt_;
        pg8::swz_map(L, np_, nN, u.pm, u.pn);
        u.kind = e; u.x1 = cn; u.x0 = bs + u.pm * 256;
        u.aoff = (a_slots ? (unsigned)u.x0 * arow_bytes : 0u) + (unsigned)u.kh * khbytes; u.boff = (unsigned)e * bexp + (unsigned)u.pn * bbytes + (unsigned)u.kh * khbytes; return true; } };
struct MoeTailSched { int G, c, trim, plast, rbase; unsigned bexp;
    __device__ __forceinline__ bool next(int i, Unit& u) const { int L = i * G + c; if (L >= 8 * trim) return false; u.kh = L / (4 * trim); L -= u.kh * 4 * trim;
        u.pm = plast - trim + (L >> 2); u.pn = L & 3; u.kind = NE - 1; u.x1 = 0; u.x0 = rbase + u.pm * 256;
        u.aoff = (unsigned)u.x0 * (unsigned)DFFE + (unsigned)u.kh * (DFFE / 2u); u.boff = (unsigned)(NE - 1) * bexp + (unsigned)u.pn * (256u * DFFE) + (unsigned)u.kh * (DFFE / 2u); return true; } };
struct EpiTail {
    static constexpr bool PERM = true; static constexpr int MIDK = 0;
    bf16_t* O0; bf16_t* Q; int row0;
    __device__ __forceinline__ void operator()(const f32x4 (&acc)[2][2][4][2], const Unit& u, int wr, int wc, int fr, int fq) const {
        asm volatile("" : "+v"(fr), "+v"(fq));
#pragma unroll
        for (int ai = 0; ai < 2; ++ai)
#pragma unroll
            for (int m = 0; m < 4; ++m) { const int row = u.x0 + ai * 128 + wr * 64 + m * 16 + fr;
                bf16_t* dst = u.kh == 0 ? O0 + (size_t)row * D : Q + ((size_t)(u.kh - 1) * TAILQ_ROWS + (size_t)(row - row0)) * D;
#pragma unroll
                for (int bj = 0; bj < 2; ++bj) { const int col = u.pn * 256 + bj * 128 + wc * 32 + 8 * fq; const f32x4 v0 = acc[ai][bj][m][0], v1 = acc[ai][bj][m][1];
                    u32x4 w; w.x = cvt_pk_bf16(v0[0], v0[1]); w.y = cvt_pk_bf16(v0[2], v0[3]); w.z = cvt_pk_bf16(v1[0], v1[1]); w.w = cvt_pk_bf16(v1[2], v1[3]);
                    *(u32x4*)(dst + col) = w; } }
    }
};
struct MoeRows { static constexpr bool GA = true, GB = false; const int* list;
    __device__ __forceinline__ unsigned arow(const Unit& u, int r) const { int idx = u.pm * 256 + r; idx = idx < u.x1 ? idx : u.x1 - 1; return (unsigned)list[u.kind * NL + idx] * (unsigned)D; }
    __device__ __forceinline__ unsigned brow(const Unit&, int) const { return 0u; } };


constexpr int CW_QUEUE = 12288, CW_RDY = 65536;
template <int NG, bool MOE> struct FfnStream {
    int P[NG], rb[NG], cn[NG];
    int f, nNgu, Kdn; unsigned need;
    unsigned* q; volatile LAS unsigned* lw; unsigned* rdy; unsigned* tmo;
    __device__ __forceinline__ void finish_init(int G) { int sacc = 0; f = NG;
#pragma unroll
        for (int g = NG - 1; g >= 0; --g) { if (f == g + 1 && sacc + P[g] * 4 <= G) { sacc += P[g] * 4; f = g; } }
        if (f > NG - 1) f = NG - 1; }
    __device__ __forceinline__ bool decode(int L, SUnit& u) const {
        int pos = L, kind = -1, grp = 0, j = 0;
#pragma unroll
        for (int g = 0; g < NG; ++g) {
            { const int n = P[g] * nNgu; if (kind < 0) { if (pos < n) { kind = 0; grp = g; j = pos; } else pos -= n; } }
            if (g >= 1 && (g - 1) < f) { const int n = P[g - 1] * 4; if (kind < 0) { if (pos < n) { kind = 1; grp = g - 1; j = pos; } else pos -= n; } }
        }
#pragma unroll
        for (int g = 0; g < NG; ++g) if (g >= f) { const int n = P[g] * 4; if (kind < 0) { if (pos < n) { kind = 1; grp = g; j = pos; } else pos -= n; } }
        if (kind < 0) return false;
        int nM = 0, rbase = 0, cnt = 0;
#pragma unroll
        for (int g = 0; g < NG; ++g) if (g == grp) { nM = P[g]; rbase = rb[g]; cnt = cn[g]; }
        const int nN = kind == 0 ? nNgu : 4;
        const int nig = 8 * nN, gid = j / nig, fm = gid * 8, gsz = (nM - fm) < 8 ? (nM - fm) : 8;
        u.pm = fm + ((j % nig) % gsz); u.pn = (j % nig) / gsz; u.kind = kind; u.grp = grp; u.x0 = rbase + u.pm * 256; u.x1 = cnt;
        const int gp = u.x0 >> 8;
        if (kind == 0) { u.K = D; u.dep = -1; u.sig = gp;
            u.aoff = (unsigned)WS_H + (unsigned)u.x0 * (D * 2u);
            u.boff = (MOE ? (unsigned)WS_WGUE + (unsigned)grp * (2u * DFFE * D * 2u) : (unsigned)WS_WGUD) + (unsigned)u.pn * (256u * D * 2u); }
        else { u.K = Kdn; u.dep = gp; u.sig = -1;
            u.aoff = (unsigned)WS_ACT + (unsigned)u.x0 * ((unsigned)Kdn * 2u);
            u.boff = (MOE ? (unsigned)WS_WDE + (unsigned)grp * ((unsigned)D * DFFE * 2u) : (unsigned)WS_WDD) + (unsigned)u.pn * (256u * (unsigned)Kdn * 2u); }
        return true;
    }
    __device__ __forceinline__ void a_ready(const SUnit& u) const {
        if (threadIdx.x < 64) {
            const unsigned long long t0 = __builtin_amdgcn_s_memrealtime(); unsigned polls = 0;
            while ((unsigned)__builtin_amdgcn_readfirstlane(__hip_atomic_load(rdy + 64 * u.dep, __ATOMIC_RELAXED, __HIP_MEMORY_SCOPE_AGENT)) < need) {
                if ((++polls & 255u) == 0u && __builtin_amdgcn_readfirstlane(__hip_atomic_load(tmo, __ATOMIC_RELAXED, __HIP_MEMORY_SCOPE_AGENT)) != 0u) break;
                if (__builtin_amdgcn_s_memrealtime() - t0 > 2000000ull) { if (threadIdx.x == 0) __hip_atomic_store(tmo, 1u, __ATOMIC_RELAXED, __HIP_MEMORY_SCOPE_AGENT); break; }
                __builtin_amdgcn_s_sleep(2); }
            __builtin_amdgcn_fence(__ATOMIC_ACQUIRE, "agent");
            asm volatile("s_waitcnt vmcnt(0)" ::: "memory");
        }
        asm volatile("" ::: "memory"); __builtin_amdgcn_s_barrier(); asm volatile("" ::: "memory");
    }
};
template <bool MOE> struct FfnRows { const int* list;
    __device__ __forceinline__ bool a_gather(const SUnit& u) const { return MOE && u.kind == 0; }
    __device__ __forceinline__ unsigned arow(const SUnit& u, int r) const { int idx = u.pm * 256 + r; idx = idx < u.x1 ? idx : u.x1 - 1; return (unsigned)WS_H + (unsigned)list[u.grp * NL + idx] * (D * 2u); } };

template <bool MOE> struct EpiFfn {
    static constexpr bool PERM = true; static constexpr int MIDK = 0;
    unsigned char* ws; float* xl; const float* mod_l;
    __device__ __forceinline__ void operator()(const f32x4 (&acc)[2][2][4][2], const SUnit& u, int wr, int wc, int fr, int fq) const {
        if (u.kind == 0) {
            constexpr int ld = MOE ? DFFE : DFF0;
            bf16_t* act = (bf16_t*)(ws + WS_ACT);
            const int col = u.pn * 128 + wc * 32 + 8 * fq;
#pragma unroll
            for (int ai = 0; ai < 2; ++ai)
#pragma unroll
                for (int m = 0; m < 4; ++m) { const size_t row = (size_t)(u.x0 + ai * 128 + wr * 64 + m * 16 + fr);
                    float o[8];
#pragma unroll
                    for (int n = 0; n < 2; ++n)
#pragma unroll
                        for (int q = 0; q < 4; ++q) { const float gv = acc[ai][0][m][n][q], uv = acc[ai][1][m][n][q]; o[4 * n + q] = gv * sigmoidf_(gv) * uv; }
                    u32x4 w; w.x = cvt_pk_bf16(o[0], o[1]); w.y = cvt_pk_bf16(o[2], o[3]); w.z = cvt_pk_bf16(o[4], o[5]); w.w = cvt_pk_bf16(o[6], o[7]);
                    pg8::st16_wt(ws, (unsigned)WS_ACT + ((unsigned)row * (unsigned)ld + (unsigned)col) * 2u, w); }
        } else if (MOE) {
            bf16_t* O = (bf16_t*)(ws + WS_DOUT);
#pragma unroll
            for (int ai = 0; ai < 2; ++ai)
#pragma unroll
                for (int m = 0; m < 4; ++m) { const size_t row = (size_t)(u.x0 + ai * 128 + wr * 64 + m * 16 + fr);
#pragma unroll
                    for (int bj = 0; bj < 2; ++bj) { const int col = u.pn * 256 + bj * 128 + wc * 32 + 8 * fq; const f32x4 v0 = acc[ai][bj][m][0], v1 = acc[ai][bj][m][1];
                        u32x4 w; w.x = cvt_pk_bf16(v0[0], v0[1]); w.y = cvt_pk_bf16(v0[2], v0[3]); w.z = cvt_pk_bf16(v1[0], v1[1]); w.w = cvt_pk_bf16(v1[2], v1[3]);
                        *(u32x4*)(O + row * D + col) = w; } }
        } else {
            asm volatile("" : "+v"(fr), "+v"(fq));
            const int pmg = u.x0 >> 8;
            const int v = pmg < 32 ? 0 : (pmg < 64 ? 1 : 2);
            const float* gate = mod_l + v * MODSZ + 5 * D;
            float* xo = pmg < 64 ? xl + (size_t)u.x0 * D : (float*)(ws + WS_XC) + (size_t)(u.x0 - NL) * D;
#pragma unroll
            for (int bj = 0; bj < 2; ++bj) { const int col = u.pn * 256 + bj * 128 + wc * 32 + 8 * fq;
                const f32x4 g0 = *(const f32x4*)(gate + col), g1 = *(const f32x4*)(gate + col + 4);
#pragma unroll
                for (int ai = 0; ai < 2; ++ai)
#pragma unroll
                    for (int m = 0; m < 4; ++m) { const size_t o = (size_t)(ai * 128 + wr * 64 + m * 16 + fr) * D + col;
                        *(f32x4*)(xo + o) = *(const f32x4*)(xo + o) + g0 * acc[ai][bj][m][0];
                        *(f32x4*)(xo + o + 4) = *(const f32x4*)(xo + o + 4) + g1 * acc[ai][bj][m][1];
                        asm volatile("" ::: "memory"); __builtin_amdgcn_sched_barrier(0); } }
        }
    }
};

namespace at2 {
typedef float f32x16 __attribute__((ext_vector_type(16)));
__device__ __forceinline__ int crow(int r,int hi){return (r&3)+8*(r>>2)+4*hi;}
#define SBAR() __builtin_amdgcn_sched_barrier(0)
template<int KIND> __device__ __forceinline__ void bmask(f32x16&p0,f32x16&p1,int qq,int hi){
  const float NEG=-INFINITY;
  #pragma unroll
  for(int r=0;r<16;++r){const int kk=crow(r,hi);
    if(KIND==0){ if(kk<qq)p0[r]=NEG; if(kk+32<qq)p1[r]=NEG; }
    else if(KIND==1){ if(kk>qq)p0[r]=NEG; if(kk+32>qq)p1[r]=NEG; }
    else { p0[r]=NEG; p1[r]=NEG; } }
}
constexpr int NSLOT=3, SLOTB=8192, NW=8;
constexpr int LDS_K=0, LDS_V=NSLOT*SLOTB, LDS_WS=2*NSLOT*SLOTB, LDS_OST=LDS_WS+NW*64*4, LDS_BYTES=LDS_OST+NW*4096;
__device__ __forceinline__ void glds16(const void*gsrc,unsigned lds_dst){unsigned keep;
  asm volatile("s_mov_b32 %0, m0\n\ts_mov_b32 m0, %2\n\ts_nop 0\n\tglobal_load_lds_dwordx4 %1, off\n\ts_mov_b32 m0, %0":"=&s"(keep):"v"(gsrc),"s"(lds_dst):"memory");}
__device__ __forceinline__ float max3f(float a,float b,float c){float r;asm("v_max3_f32 %0, %1, %2, %3":"=v"(r):"v"(a),"v"(b),"v"(c));return r;}
__device__ __forceinline__ float max2f(float a,float b){float r;asm("v_max_f32_e32 %0, %1, %2":"=v"(r):"v"(a),"v"(b));return r;}
__device__ __forceinline__ float fadd_s(float a,float b){float r;asm("v_add_f32_e32 %0, %1, %2":"=v"(r):"v"(a),"v"(b));return r;}
__device__ __forceinline__ float fsub_s(float a,float b){float r;asm("v_sub_f32_e32 %0, %1, %2":"=v"(r):"v"(a),"v"(b));return r;}
typedef float f32x2_t __attribute__((ext_vector_type(2))); typedef __bf16 bf16x2_t __attribute__((ext_vector_type(2)));
__device__ __forceinline__ unsigned cvtpk_s(float lo,float hi){f32x2_t v={lo,hi};bf16x2_t b=__builtin_convertvector(v,bf16x2_t);return __builtin_bit_cast(unsigned,b);}
#define WAIT_BAR(N) asm volatile("s_waitcnt vmcnt(" #N ") lgkmcnt(0)\n\ts_barrier":::"memory")

__device__ __forceinline__ void qkt(f32x16&p0,f32x16&p1,const char*Kslot,const bf16x8*qr,const f32x16&negm,int r32,int hi){
  const char*kb=Kslot+hi*1024+r32*16;
  #pragma unroll
  for(int d0=0;d0<4;++d0){
    const bf16x8 b0=*reinterpret_cast<const bf16x8*>(kb+d0*2048);
    const bf16x8 b1=*reinterpret_cast<const bf16x8*>(kb+d0*2048+512);
    if(d0==0){p0=__builtin_amdgcn_mfma_f32_32x32x16_bf16(b0,qr[0],negm,0,0,0);p1=__builtin_amdgcn_mfma_f32_32x32x16_bf16(b1,qr[0],negm,0,0,0);}
    else{p0=__builtin_amdgcn_mfma_f32_32x32x16_bf16(b0,qr[d0],p0,0,0,0);p1=__builtin_amdgcn_mfma_f32_32x32x16_bf16(b1,qr[d0],p1,0,0,0);}}
}
typedef __attribute__((address_space(3))) const char* lds_cptr;
typedef short v4i16_t __attribute__((ext_vector_type(4)));
__device__ __forceinline__ void kload8(bf16x8*kf,lds_cptr kp){
  kf[0]=*(const __attribute__((address_space(3))) bf16x8*)(kp);      kf[1]=*(const __attribute__((address_space(3))) bf16x8*)(kp+512);
  kf[2]=*(const __attribute__((address_space(3))) bf16x8*)(kp+2048); kf[3]=*(const __attribute__((address_space(3))) bf16x8*)(kp+2560);
  kf[4]=*(const __attribute__((address_space(3))) bf16x8*)(kp+4096); kf[5]=*(const __attribute__((address_space(3))) bf16x8*)(kp+4608);
  kf[6]=*(const __attribute__((address_space(3))) bf16x8*)(kp+6144); kf[7]=*(const __attribute__((address_space(3))) bf16x8*)(kp+6656);
}
__device__ __forceinline__ void kload2(bf16x8*kf,lds_cptr kp,int j){ kf[2*j]=*(const __attribute__((address_space(3))) bf16x8*)(kp+j*2048); kf[2*j+1]=*(const __attribute__((address_space(3))) bf16x8*)(kp+j*2048+512); }
__device__ __forceinline__ s16x4 vtr(lds_cptr p){ return __builtin_bit_cast(s16x4,__builtin_amdgcn_ds_read_tr16_b64_v4i16((__attribute__((address_space(3))) v4i16_t*)p)); }
__device__ __forceinline__ float rowmax(const f32x16&p0,const f32x16&p1){
  float a=max3f(p0[0],p0[1],p1[0]),b=max3f(p0[2],p0[3],p1[1]);a=max3f(a,p1[2],p1[3]);
  #pragma unroll
  for(int r=4;r<16;r+=4){a=max3f(a,p0[r],p0[r+1]);b=max3f(b,p0[r+2],p0[r+3]);a=max3f(a,p1[r],p1[r+1]);b=max3f(b,p1[r+2],p1[r+3]);}
  const float m=max2f(a,b);
  auto rr=__builtin_amdgcn_permlane32_swap(__float_as_uint(m),__float_as_uint(m),false,false);
  return max2f(__uint_as_float(rr[0]),__uint_as_float(rr[1]));
}
__device__ __forceinline__ void pv(f32x16*o,int vb,bf16x8 pa0,bf16x8 pa1,bf16x8 pa2,bf16x8 pa3){
  #pragma unroll
  for(int d0=0;d0<2;++d0){s16x4 lo[4],hi[4];
    #pragma unroll
    for(int ks=0;ks<4;++ks){
      asm volatile("ds_read_b64_tr_b16 %0,%1 offset:%c2":"=&v"(lo[ks]):"v"(vb),"i"(d0*4096+ks*1024):"memory");
      asm volatile("ds_read_b64_tr_b16 %0,%1 offset:%c2":"=&v"(hi[ks]):"v"(vb),"i"(d0*4096+ks*1024+512):"memory");}
    asm volatile("s_waitcnt lgkmcnt(0)":::"memory");SBAR();
    #define PK(k) (bf16x8){lo[k][0],lo[k][1],lo[k][2],lo[k][3],hi[k][0],hi[k][1],hi[k][2],hi[k][3]}
    o[d0]=__builtin_amdgcn_mfma_f32_32x32x16_bf16(pa0,PK(0),o[d0],0,0,0);
    o[d0]=__builtin_amdgcn_mfma_f32_32x32x16_bf16(pa1,PK(1),o[d0],0,0,0);
    o[d0]=__builtin_amdgcn_mfma_f32_32x32x16_bf16(pa2,PK(2),o[d0],0,0,0);
    o[d0]=__builtin_amdgcn_mfma_f32_32x32x16_bf16(pa3,PK(3),o[d0],0,0,0);
    #undef PK
  }
}

template<int THRL> __device__ __forceinline__ void attn_unit(unsigned char* ws, char* shm, const unsigned lds0, const float sinkv, int b, int hkv, int qb, bool ctxq){
  int tid_=threadIdx.x; asm volatile("":"+v"(tid_));
  const int tid=tid_,lane=tid&63,r32=lane&31,hi=lane>>5; const int wid=__builtin_amdgcn_readfirstlane(tid>>6);
  const int g_=wid>>1,qs=wid&1,head=hkv*4+g_;
  const bf16_t*Q=(const bf16_t*)(ws+WS_Q);const bf16_t*KB=(const bf16_t*)(ws+WS_KB);const bf16_t*VB=(const bf16_t*)(ws+WS_VB);
  const int q0=qb*64; const int qrow0=(ctxq?NL+b*CTXL:b*T)+q0;
  const bf16_t*Qw=Q+(size_t)(qrow0+qs*32)*512+head*64;
  int jlo=0,jhi=-1; if(!ctxq){jlo=-2;jhi=2; if(q0+64*jlo<0)jlo=-(q0/64); if(q0+64*jhi>=T)jhi=(T-64-q0)/64;}
  const int nloc=jhi-jlo+1, NTr=nloc+4, NT=(NTr+1)&~1;
  auto trow=[&](int t)->int{ if(ctxq)return NL+b*CTXL+64*t; if(t==0)return b*T+q0+64*jlo; if(t<=4)return NL+b*CTXL+64*(t-1); if(t<NTr)return b*T+q0+64*(jlo+t-4); return NL+b*CTXL; };
  const int qq=qs*32+r32;
  float*wsf=(float*)(shm+LDS_WS)+wid*64;
  const bf16_t*ksrc=KB+(size_t)lane*128+hkv*64+wid*8;
  const bf16_t*vsrc=VB+(size_t)(16*(wid&3)+(lane>>2))*128+hkv*64+(wid>>2)*32+(lane&3)*8;
  const unsigned kdst=lds0+LDS_K+wid*1024, vdst=lds0+LDS_V+wid*1024;
  #define DMA_K(t,slot) glds16(ksrc+(size_t)trow(t)*128,(unsigned)__builtin_amdgcn_readfirstlane(kdst+(slot)))
  #define DMA_V(t,slot) glds16(vsrc+(size_t)trow(t)*128,(unsigned)__builtin_amdgcn_readfirstlane(vdst+(slot)))
  const int vb0=(int)(lds0+LDS_V)+((lane>>4)&1)*32+(lane&3)*8+(4*hi+((lane&15)>>2))*64;
  const char*Kbase=shm+LDS_K; bf16x8 kf[8];
  const lds_cptr shm3=(lds_cptr)shm; const lds_cptr kp0=shm3+LDS_K+hi*1024+r32*16; const lds_cptr vp0=shm3+LDS_V+((lane>>4)&1)*32+(lane&3)*8+(4*hi+((lane&15)>>2))*64;
  DMA_K(0,0);DMA_V(0,0);DMA_K(1,SLOTB);
  bf16x8 qr[4];
  #pragma unroll
  for(int d0=0;d0<4;++d0)qr[d0]=*reinterpret_cast<const bf16x8*>(&Qw[(size_t)r32*512+d0*16+hi*8]);
  float mhat=0.f,l_reg=0.f;f32x16 o[2];o[0]=f32x16{};o[1]=f32x16{};const f32x16 negm=f32x16{};
  #define CMASK(P0,P1,t) do{const int t_=(t); if(t_==0&&jlo==-2)bmask<0>(P0,P1,qq,hi); else if(t_==NTr-1&&jhi==2)bmask<1>(P0,P1,qq,hi); else if(t_>=NTr)bmask<2>(P0,P1,qq,hi);}while(0)
  bool resc=false;
  #define START(P0,P1) do{ const float rm=__builtin_fmaxf(rowmax(P0,P1),sinkv); resc=false; \
    { const float dl=rm; mhat=fadd_s(mhat,dl); \
      _Pragma("unroll") for(int r=0;r<16;++r){P0[r]=fsub_s(P0[r],dl);P1[r]=fsub_s(P1[r],dl);} } \
    _Pragma("unroll") for(int r=0;r<16;++r)P0[r]=__builtin_amdgcn_exp2f(P0[r]); }while(0)
  #define RESC() do{ if(resc){ asm volatile("s_waitcnt lgkmcnt(0)":::"memory"); \
      _Pragma("unroll") for(int d_=0;d_<2;++d_) _Pragma("unroll") for(int r=0;r<16;++r)o[d_][r]*=wsf[crow(r,hi)]; } }while(0)
  f32x16 pA0,pA1,pB0,pB1;
  int sl_prev=0,sl_cur=0,sl_next=SLOTB;
  #define ROT() do{sl_prev=sl_cur;sl_cur=sl_next;sl_next=(sl_next==(NSLOT-1)*SLOTB)?0:sl_next+SLOTB;}while(0)
  DMA_K(2,2*SLOTB);
  WAIT_BAR(3);
  qkt(pA0,pA1,Kbase,qr,negm,r32,hi);asm volatile("s_nop 15\n\ts_nop 7":"+v"(pA0),"+v"(pA1));CMASK(pA0,pA1,0);
  START(pA0,pA1);
  l_reg=hi==0?__builtin_amdgcn_exp2f(sinkv-mhat):0.f;
  _Pragma("unroll") for(int r=0;r<16;++r)pA1[r]=__builtin_amdgcn_exp2f(pA1[r]);
  WAIT_BAR(0);
  DMA_K(3,0);DMA_V(1,SLOTB);
  ROT();
  kload8(kf,kp0+sl_cur);
  WAIT_BAR(2);
  s16x4 vlo[8],vhi[8]; u32x4 pw0,pw1,pw2,pw3;
  #define PKW(P,B) cvtpk_s(P[B],P[B+1])
  #define PAF(k) __builtin_bit_cast(bf16x8,pw##k)
  #define VFR(i) (bf16x8){vlo[i][0],vlo[i][1],vlo[i][2],vlo[i][3],vhi[i][0],vhi[i][1],vhi[i][2],vhi[i][3]}
  #define PIN(x) asm volatile("":"+v"(x))
  #define MX3(a,b,c) __builtin_fmaxf(__builtin_fmaxf((a),(b)),(c))
  #define GAPA(MF,A0,A1,A2,A3,W0,W1,PW) do{ MF; sacc+=A0; sacc+=A1; sacc+=A2; sacc+=A3; PIN(sacc); W0; W1; PIN(PW); SBAR(); }while(0)
  #define EX(v) __builtin_amdgcn_exp2f(v)
  #define GAPB(MF,X,B) do{ MF; X[B]=EX(X[B]-mhat); X[B+1]=EX(X[B+1]-mhat); X[B+2]=EX(X[B+2]-mhat); X[B+3]=EX(X[B+3]-mhat); PIN(X); SBAR(); }while(0)
  #define VRD(i) do{ vlo[i]=vtr(vp_+(((i)>>2)*4096+((i)&3)*1024)); vhi[i]=vtr(vp_+(((i)>>2)*4096+((i)&3)*1024+512)); }while(0)
  #define KRD(G,j) do{ if(G){ kload2(kf,kp0+sl_next,j); SBAR(); } }while(0)
  #define STEP(C0,C1,P0,P1,t,GK,GV,GL) do{ SBAR(); \
    const lds_cptr vp_=vp0+sl_prev; \
    VRD(0); SBAR(); float sacc=(P0[0]+P0[1]); \
    GAPA(C0=__builtin_amdgcn_mfma_f32_32x32x16_bf16(kf[0],qr[0],negm,0,0,0), P0[2],P0[3],P0[4],P0[5],     pw0[0]=PKW(P0,0), pw0[1]=PKW(P0,2), pw0); \
    VRD(4); SBAR(); GAPA(C1=__builtin_amdgcn_mfma_f32_32x32x16_bf16(kf[1],qr[0],negm,0,0,0), P0[6],P0[7],P0[8],P0[9],     pw0[2]=PKW(P0,4), pw0[3]=PKW(P0,6), pw0); \
    VRD(1); SBAR(); GAPA(C0=__builtin_amdgcn_mfma_f32_32x32x16_bf16(kf[2],qr[1],C0,0,0,0),   P0[10],P0[11],P0[12],P0[13], pw1[0]=PKW(P0,8), pw1[1]=PKW(P0,10), pw1); \
    VRD(5); SBAR(); GAPA(C1=__builtin_amdgcn_mfma_f32_32x32x16_bf16(kf[3],qr[1],C1,0,0,0),   P0[14],P0[15],P1[0],P1[1],   pw1[2]=PKW(P0,12),pw1[3]=PKW(P0,14), pw1); \
    VRD(2); SBAR(); GAPA(C0=__builtin_amdgcn_mfma_f32_32x32x16_bf16(kf[4],qr[2],C0,0,0,0),   P1[2],P1[3],P1[4],P1[5],     pw2[0]=PKW(P1,0), pw2[1]=PKW(P1,2), pw2); \
    VRD(6); SBAR(); GAPA(C1=__builtin_amdgcn_mfma_f32_32x32x16_bf16(kf[5],qr[2],C1,0,0,0),   P1[6],P1[7],P1[8],P1[9],     pw2[2]=PKW(P1,4), pw2[3]=PKW(P1,6), pw2); \
    VRD(3); SBAR(); GAPA(C0=__builtin_amdgcn_mfma_f32_32x32x16_bf16(kf[6],qr[3],C0,0,0,0),   P1[10],P1[11],P1[12],P1[13], pw3[0]=PKW(P1,8), pw3[1]=PKW(P1,10), pw3); \
    VRD(7); SBAR(); GAPA(C1=__builtin_amdgcn_mfma_f32_32x32x16_bf16(kf[7],qr[3],C1,0,0,0),   P1[14],P1[15],0.f,0.f,       pw3[2]=PKW(P1,12),pw3[3]=PKW(P1,14), pw3); \
    l_reg+=sacc; \
    if(GK){DMA_K((t)+3,sl_cur);} if(GV){DMA_V((t)+1,sl_next);} \
    CMASK(C0,C1,t); \
    { float a=MX3(C0[0],C0[1],C1[0]),b=MX3(C0[2],C0[3],C1[1]); a=MX3(a,C1[2],C1[3]); \
      _Pragma("unroll") for(int r=4;r<16;r+=4){a=MX3(a,C0[r],C0[r+1]);b=MX3(b,C0[r+2],C0[r+3]);a=MX3(a,C1[r],C1[r+1]);b=MX3(b,C1[r+2],C1[r+3]);} \
      float rm=__builtin_fmaxf(a,b); { auto rr=__builtin_amdgcn_permlane32_swap(__float_as_uint(rm),__float_as_uint(rm),false,false); rm=__builtin_fmaxf(__uint_as_float(rr[0]),__uint_as_float(rr[1])); } rm-=mhat; \
      resc=false; \
      if(__builtin_expect(__any(rm>(float)THRL),0)){ const float dl=__builtin_fmaxf(rm,0.f); mhat+=dl; \
        const float f=__builtin_amdgcn_exp2f(-dl); l_reg*=f; if(hi==0)wsf[r32]=f; resc=true; } } \
    SBAR(); \
    GAPB(o[0]=__builtin_amdgcn_mfma_f32_32x32x16_bf16(PAF(0),VFR(0),o[0],0,0,0), C0,0); \
    GAPB(o[1]=__builtin_amdgcn_mfma_f32_32x32x16_bf16(PAF(0),VFR(4),o[1],0,0,0), C0,4); \
    KRD(GL,0); GAPB(o[0]=__builtin_amdgcn_mfma_f32_32x32x16_bf16(PAF(1),VFR(1),o[0],0,0,0), C0,8); \
    KRD(GL,1); GAPB(o[1]=__builtin_amdgcn_mfma_f32_32x32x16_bf16(PAF(1),VFR(5),o[1],0,0,0), C0,12); \
    KRD(GL,2); GAPB(o[0]=__builtin_amdgcn_mfma_f32_32x32x16_bf16(PAF(2),VFR(2),o[0],0,0,0), C1,0); \
    KRD(GL,3); GAPB(o[1]=__builtin_amdgcn_mfma_f32_32x32x16_bf16(PAF(2),VFR(6),o[1],0,0,0), C1,4); \
    GAPB(o[0]=__builtin_amdgcn_mfma_f32_32x32x16_bf16(PAF(3),VFR(3),o[0],0,0,0), C1,8); \
    GAPB(o[1]=__builtin_amdgcn_mfma_f32_32x32x16_bf16(PAF(3),VFR(7),o[1],0,0,0), C1,12); \
    }while(0)
  int t=1;
  #undef CMASK
  #define CMASK(P0,P1,t) do{}while(0)
  for(;t+5<NT;t+=2){
    STEP(pB0,pB1,pA0,pA1,t,true,true,true);     WAIT_BAR(2); RESC(); ROT();
    STEP(pA0,pA1,pB0,pB1,t+1,true,true,true);   WAIT_BAR(2); RESC(); ROT();
  }
  #undef CMASK
  #define CMASK(P0,P1,t) do{const int t_=(t); if(t_==0&&jlo==-2)bmask<0>(P0,P1,qq,hi); else if(t_==NTr-1&&jhi==2)bmask<1>(P0,P1,qq,hi); else if(t_>=NTr)bmask<2>(P0,P1,qq,hi);}while(0)
  #define ENDW(tt) do{ if((tt)+3<NT){WAIT_BAR(2);} else if((tt)+2<NT){WAIT_BAR(1);} else {WAIT_BAR(0);} }while(0)
  for(;t+1<NT;t+=2){
    STEP(pB0,pB1,pA0,pA1,t,(t+3<NT),(t+1<NT),(t+1<NT));       ENDW(t);   RESC(); ROT();
    STEP(pA0,pA1,pB0,pB1,t+1,(t+4<NT),(t+2<NT),(t+2<NT));     ENDW(t+1); RESC(); ROT();
  }
  STEP(pB0,pB1,pA0,pA1,NT-1,false,false,false); RESC();
  { float sacc=pB0[0]+pB0[1]; _Pragma("unroll") for(int r=2;r<16;++r)sacc+=pB0[r]; _Pragma("unroll") for(int r=0;r<16;++r)sacc+=pB1[r]; l_reg+=sacc;
    pw0=(u32x4){PKW(pB0,0),PKW(pB0,2),PKW(pB0,4),PKW(pB0,6)};pw1=(u32x4){PKW(pB0,8),PKW(pB0,10),PKW(pB0,12),PKW(pB0,14)};pw2=(u32x4){PKW(pB1,0),PKW(pB1,2),PKW(pB1,4),PKW(pB1,6)};pw3=(u32x4){PKW(pB1,8),PKW(pB1,10),PKW(pB1,12),PKW(pB1,14)};
    SBAR(); pv(o,vb0+sl_cur,PAF(0),PAF(1),PAF(2),PAF(3)); }
  #undef PKW
  #undef PAF
  #undef VFR
  #undef PIN
  #undef MX3
  #undef GAPA
  #undef GAPB
  #undef EX
  #undef VRD
  #undef KRD
  #undef STEP
  #undef ENDW
  {auto rr=__builtin_amdgcn_permlane32_swap(__float_as_uint(l_reg),__float_as_uint(l_reg),false,false);l_reg=__uint_as_float(rr[0])+__uint_as_float(rr[1]);}
  if(hi==0)wsf[32+r32]=l_reg;asm volatile("s_waitcnt lgkmcnt(0)":::"memory");
  float rli[16];
  #pragma unroll
  for(int r=0;r<16;++r)rli[r]=__builtin_amdgcn_rcpf(wsf[32+crow(r,hi)]);
  bf16_t*Ow=(bf16_t*)(ws+WS_FO)+(size_t)(qrow0+qs*32)*KM+640+head*64;
  { bf16_t*stg=(bf16_t*)(shm+LDS_OST)+wid*2048;
    #pragma unroll
    for(int r=0;r<16;++r){const int orow=crow(r,hi);
      #pragma unroll
      for(int d0=0;d0<2;++d0)stg[orow*64+d0*32+r32]=(bf16_t)f2bf(o[d0][r]*rli[r]);}
    asm volatile("s_waitcnt lgkmcnt(0)":::"memory");
    #pragma unroll
    for(int i=0;i<4;++i){const int row=i*8+(lane>>3),ch=lane&7; const u32x4 v=*(const u32x4*)(stg+row*64+ch*8); *(u32x4*)(Ow+(size_t)row*KM+ch*8)=v;} }
  asm volatile("s_waitcnt lgkmcnt(0)\n\ts_barrier":::"memory");
  #undef DMA_K
  #undef DMA_V
  #undef CMASK
  #undef START
  #undef RESC
  #undef ROT
}
}
static_assert(at2::LDS_BYTES <= RING_BYTES, "attention scratch fits the staging ring");

__device__ __forceinline__ int crow(int r, int hi) { return (r & 3) + 8 * (r >> 2) + 4 * hi; }
__device__ __forceinline__ s16x4 vtr(const LAS unsigned char* p) { typedef short v4i16_t __attribute__((ext_vector_type(4))); return __builtin_bit_cast(s16x4, __builtin_amdgcn_ds_read_tr16_b64_v4i16((LAS v4i16_t*)p)); }

__device__ __forceinline__ void attn_unit(Frame& F, int l, int b, int hkv, int qb, bool ctxq) {
    const int tid = F.tid, lane = F.lane, wid = F.wave, r32 = lane & 31, hi = lane >> 5;
    const int g = wid >> 1, qs = wid & 1, head = hkv * 4 + g;
    const bf16_t* Q = (const bf16_t*)(F.ws + WS_Q); const bf16_t* KB = (const bf16_t*)(F.ws + WS_KB); const bf16_t* VB = (const bf16_t*)(F.ws + WS_VB);
    const int q0 = qb * 64;
    const int qrow = (ctxq ? NL + b * CTXL : b * T) + q0 + qs * 32 + r32;
    bf16x8 qr[4];
#pragma unroll
    for (int d0 = 0; d0 < 4; ++d0) qr[d0] = *(const bf16x8*)(Q + (size_t)qrow * 512 + head * 64 + d0 * 16 + hi * 8);
    int jlo = 0, jhi = -1;
    if (!ctxq) { jlo = -2; jhi = 2; if (q0 + 64 * jlo < 0) jlo = -(q0 / 64); if (q0 + 64 * jhi >= T) jhi = (T - 64 - q0) / 64; }
    const int nloc = jhi - jlo + 1, ntile = nloc + 4;
    const float sinkv = F.in[9][l * 8 + head] * LOG2E;
    float mrun = sinkv, lrun = 1.0f;
    f32x16 o[2]; o[0] = f32x16{}; o[1] = f32x16{};
    const int kkey = lane, vkey = 16 * (wid & 3) + (lane >> 2);
    auto tile_row = [&](int ti) -> int { return ti < nloc ? b * T + q0 + 64 * (jlo + ti) : NL + b * CTXL + 64 * (ti - nloc); };
    u32x4 kreg, vreg;
    { const int r0 = tile_row(0); kreg = *(const u32x4*)(KB + (size_t)(r0 + kkey) * 128 + hkv * 64 + wid * 8); vreg = *(const u32x4*)(VB + (size_t)(r0 + vkey) * 128 + hkv * 64 + (wid >> 2) * 32 + (lane & 3) * 8); }
    for (int ti = 0; ti < ntile; ++ti) {
        LAS unsigned char* slot = F.lds + (ti & 1) * 16384;
        *(LAS u32x4*)(slot + wid * 1024 + lane * 16) = kreg;
        *(LAS u32x4*)(slot + 8192 + wid * 1024 + lane * 16) = vreg;
        __syncthreads();
        if (ti + 1 < ntile) { const int r0 = tile_row(ti + 1); kreg = *(const u32x4*)(KB + (size_t)(r0 + kkey) * 128 + hkv * 64 + wid * 8); vreg = *(const u32x4*)(VB + (size_t)(r0 + vkey) * 128 + hkv * 64 + (wid >> 2) * 32 + (lane & 3) * 8); }
        f32x16 p0 = f32x16{}, p1 = f32x16{};
        { const LAS unsigned char* kb = slot + hi * 1024 + r32 * 16;
#pragma unroll
          for (int d0 = 0; d0 < 4; ++d0) { const bf16x8 k0 = *(const LAS bf16x8*)(kb + d0 * 2048), k1 = *(const LAS bf16x8*)(kb + d0 * 2048 + 512);
              p0 = __builtin_amdgcn_mfma_f32_32x32x16_bf16(k0, qr[d0], p0, 0, 0, 0); p1 = __builtin_amdgcn_mfma_f32_32x32x16_bf16(k1, qr[d0], p1, 0, 0, 0); } }
        if (ti < nloc) { const int j = jlo + ti; const int qq = qs * 32 + r32;
            if (j == -2) {
#pragma unroll
                for (int r = 0; r < 16; ++r) { const int kk = crow(r, hi); if (kk < qq) p0[r] = -INFINITY; if (kk + 32 < qq) p1[r] = -INFINITY; } }
            else if (j == 2) {
#pragma unroll
                for (int r = 0; r < 16; ++r) { const int kk = crow(r, hi); if (kk > qq) p0[r] = -INFINITY; if (kk + 32 > qq) p1[r] = -INFINITY; } } }
        float mx = p0[0];
#pragma unroll
        for (int r = 1; r < 16; ++r) mx = fmaxf(mx, p0[r]);
#pragma unroll
        for (int r = 0; r < 16; ++r) mx = fmaxf(mx, p1[r]);
        mx = fmaxf(mx, __shfl_xor(mx, 32));
        const float mnew = fmaxf(mrun, mx), fsc = __builtin_amdgcn_exp2f(mrun - mnew);
        mrun = mnew;
        float rs = 0.f;
#pragma unroll
        for (int r = 0; r < 16; ++r) { p0[r] = __builtin_amdgcn_exp2f(p0[r] - mnew); p1[r] = __builtin_amdgcn_exp2f(p1[r] - mnew); rs += p0[r] + p1[r]; }
        rs += __shfl_xor(rs, 32);
        lrun = lrun * fsc + rs;
#pragma unroll
        for (int r = 0; r < 16; ++r) { o[0][r] *= fsc; o[1][r] *= fsc; }
        u32x4 pw[4];
        pw[0] = (u32x4){cvt_pk_bf16(p0[0], p0[1]), cvt_pk_bf16(p0[2], p0[3]), cvt_pk_bf16(p0[4], p0[5]), cvt_pk_bf16(p0[6], p0[7])};
        pw[1] = (u32x4){cvt_pk_bf16(p0[8], p0[9]), cvt_pk_bf16(p0[10], p0[11]), cvt_pk_bf16(p0[12], p0[13]), cvt_pk_bf16(p0[14], p0[15])};
        pw[2] = (u32x4){cvt_pk_bf16(p1[0], p1[1]), cvt_pk_bf16(p1[2], p1[3]), cvt_pk_bf16(p1[4], p1[5]), cvt_pk_bf16(p1[6], p1[7])};
        pw[3] = (u32x4){cvt_pk_bf16(p1[8], p1[9]), cvt_pk_bf16(p1[10], p1[11]), cvt_pk_bf16(p1[12], p1[13]), cvt_pk_bf16(p1[14], p1[15])};
        { const LAS unsigned char* vb = slot + 8192 + ((lane >> 4) & 1) * 32 + (lane & 3) * 8 + (4 * hi + ((lane & 15) >> 2)) * 64;
#pragma unroll
          for (int d0 = 0; d0 < 2; ++d0)
#pragma unroll
              for (int ks = 0; ks < 4; ++ks) { const s16x4 lo = vtr(vb + d0 * 4096 + ks * 1024), hh = vtr(vb + d0 * 4096 + ks * 1024 + 512);
                  const bf16x8 vf = (bf16x8){lo[0], lo[1], lo[2], lo[3], hh[0], hh[1], hh[2], hh[3]};
                  o[d0] = __builtin_amdgcn_mfma_f32_32x32x16_bf16(vf, __builtin_bit_cast(bf16x8, pw[ks]), o[d0], 0, 0, 0); } }
    }
    const float rl = 1.0f / lrun;
    bf16_t* orow = (bf16_t*)(F.ws + WS_FO) + (size_t)qrow * KM + 640 + head * 64;
#pragma unroll
    for (int d0 = 0; d0 < 2; ++d0)
#pragma unroll
        for (int rq = 0; rq < 4; ++rq) { u32x2 w; w.x = cvt_pk_bf16(o[d0][4 * rq] * rl, o[d0][4 * rq + 1] * rl); w.y = cvt_pk_bf16(o[d0][4 * rq + 2] * rl, o[d0][4 * rq + 3] * rl);
            *(u32x2*)(orow + 32 * d0 + 8 * rq + 4 * hi) = w; }
    __syncthreads();
}

__device__ __forceinline__ void attn_unit_new(Frame& F, int l, int b, int hkv, int qb, bool ctxq) {
    const int wid = F.wave, head = hkv * 4 + (wid >> 1);
    at2::attn_unit<8>(F.ws, (char*)F.lds, (unsigned)(size_t)F.lds, F.in[9][l * 8 + head] * LOG2E, b, hkv, qb, ctxq);
}
#define attn_unit attn_unit_new
__device__ __forceinline__ void attn_phase(Frame& F, int l, int part) {
    const int nlat = NB * 2 * 128;
    auto lat_unit = [&](int it) { const int qb = it & 127, hkv = (it >> 7) & 1, b = it >> 8; attn_unit(F, l, b, hkv, qb, false); };
    if (part == 0) {
        const bool extra = (l == 0) && F.G == 256 && ((F.bx >= 16 && F.bx < 24) || F.bx >= 240);
        if (!extra) for (int it = F.bx; it < 256; it += F.G) lat_unit(it);
        if (l == 0) for (int r = (F.bx + F.G - 240) % F.G; r < NB * 2 * 4; r += F.G) { const int qb = r & 3, hkv = (r >> 2) & 1, b = r >> 3; attn_unit(F, l, b, hkv, qb, true); }
    } else {
        const bool busy = (l == 0) && F.bx >= 128 && F.bx < 136;
        if (!busy) for (int it = 256 + F.bx; it < nlat; it += F.G) lat_unit(it);
        if (l == 0 && F.bx >= 136 && F.bx < 144) lat_unit(256 + F.bx - 8);
        if (l == 0 && F.G == 256 && F.bx >= 144 && F.bx < 168) { const int k = F.bx - 144; lat_unit(k < 8 ? 16 + k : 240 + (k - 8)); }
    }
}

#if !MK_MULTI
#define GRID_BAR() xcd_barrier(bar)
#else
#define GRID_BAR() do {} while (0)
#endif
#ifndef PH_MASK
#define PH_MASK 0xFFFFFu
#endif
#define IN(k) (((PH_MASK >> (k)) & 1u) && lo <= (k) && (k) < hi)
#define SEAM(k) do { if (IN((k) + 1)) GRID_BAR(); } while (0)
#ifndef REP_MASK
#define REP_MASK 0u
#endif
#define REPS(k) ((((REP_MASK) >> (k)) & 1u) ? 2 : 1)
template <int l, class BarT>
__device__ __forceinline__ void layer_phases(Frame& F, unsigned* ctl, const int lo, const int hi, const BarT& bar) {
        const int pb = 1 + 8 * l;
        bf16_t* H = (bf16_t*)(F.ws + WS_H);
        const float* xl_in = l == 0 ? F.in[0] : nullptr;
        bf16_t* XB = (bf16_t*)(F.ws + WS_XB);
        const float* xc_in = l == 0 ? F.in[2] : (const float*)(F.ws + WS_XC);
        float* xc = (float*)(F.ws + WS_XC);
        const float* mod_l = (const float*)ctl + CW_MOD + l * 3 * MODSZ;
        if (IN(pb + 0)) { if (l == 0) quant_wu(F); for (int rep = 0; rep < REPS(pb + 0); ++rep) norm_phase<false, 3>(F, l, 0, xl_in, xc_in, NTOK, l == 1 ? (const float*)(F.ws + WS_TMPC2) : nullptr, nullptr); SEAM(pb + 0); }
        if (IN(pb + 1)) {
            for (int rep = 0; rep < REPS(pb + 1); ++rep) {
            { pg8::Gemm g{(const bf16_t*)(F.ws + WS_H8), (const bf16_t*)(F.ws + (l ? WS_WIN1 : WS_WIN0)) + (size_t)512 * D, D / 2, D / 2}; InprojSched S{F.G, F.bx, l}; EpiInproj E{F.ws, (const float*)(F.ws + WS_RS), (const float*)(F.ws + WS_CSI) + l * 2816}; pg8::NoGather R;
              pg8::gemm_phasei8(F.lds, g, S, E, R); }
            { pg8::Gemm g{(const bf16_t*)(F.ws + (l ? WS_WIN1 : WS_WIN0) + 4 * MiB), (const bf16_t*)(F.ws + WS_H8), D / 2, D / 2}; UpermSched S{F.G, F.bx, l}; EpiUperm E{F.ws, (const float*)(F.ws + WS_RSW) + l * 512, (const float*)(F.ws + WS_RS)}; UpermRows R;
              pg8::gemm_phasei8(F.lds, g, S, E, R);
              if (F.bx >= 2 * (l == 0 ? 66 : 64)) moe_convert_q(F, MOE_QB); }
            }
            SEAM(pb + 1);
        }
        if (IN(pb + 2)) {
            for (int rep = 0; rep < REPS(pb + 2); ++rep) {
            attn_phase(F, l, 0);
            { pg8::Gemm g{(const bf16_t*)(F.ws + WS_UP), (const bf16_t*)(F.ws + WS_FA64), 128, 128}; StepASched S{F.G, F.bx, l}; EpiStepA E{F.ws}; pg8::NoGather R;
              pg8::gemm_phase(F.lds, g, S, E, R); }
            if (l == 0) { pg8::Gemm g{(const bf16_t*)(F.ws + WS_VCT), (const bf16_t*)(F.ws + WS_TX), 512, 512}; GridSched S{2, 2, F.G, (F.bx + F.G - 16) % F.G, 256u * 512u * 2u, 256u * 512u * 2u}; EpiStepC<true> E{F.ws}; pg8::NoGather R;
              pg8::gemm_phase(F.lds, g, S, E, R); }
            }
            SEAM(pb + 2);
        }
        if (IN(pb + 3)) {
            for (int rep = 0; rep < REPS(pb + 3); ++rep) {
            { pg8::Gemm g{(const bf16_t*)(F.ws + WS_GP), (const bf16_t*)(F.ws + WS_TC), 256, 256}; GridSched S{128, 1, F.G, F.bx, 256u * 256u * 2u, 0u}; EpiStepC<false> E{F.ws}; pg8::NoGather R;
              pg8::gemm_phase(F.lds, g, S, E, R); }
            if (l == 0) { pg8::Gemm g{(const bf16_t*)(F.ws + WS_FO), (const bf16_t*)(F.ws + WS_WM0), KM, KM}; CtxSched S{F.G, (F.bx + F.G - 128) % F.G, 4, 256u * KM * 2u, 256u * KM * 2u, 1, 0u}; EpiMerge E{F.ws}; pg8::NoGather R;
              pg8::gemm_phase(F.lds, g, S, E, R); }
            attn_phase(F, l, 1);
            if (F.bx >= 128 && !(l == 0 && F.bx < 168)) moe_convert_q(F, MOE_QB_SC);
            }
            SEAM(pb + 3);
        }
        if (IN(pb + 4)) {
            const int nM = 64;
            pg8::Gemm g{(const bf16_t*)(F.ws + WS_FO), (const bf16_t*)(F.ws + (l ? WS_WM1 : WS_WM0)), KM, KM}; GridSched S{nM, 4, F.G, F.bx, 256u * KM * 2u, 256u * KM * 2u}; EpiMerge E{F.ws}; pg8::NoGather R;
            for (int rep = 0; rep < REPS(pb + 4); ++rep) pg8::gemm_phase(F.lds, g, S, E, R);
            SEAM(pb + 4);
        }
        if (IN(pb + 5)) {
            EpiResid E{xl_in, XB, XB, xc_in, xc, mod_l, 2, (float*)(F.ws + WS_TMPC1), 1.0f}; pg8::NoGather R;
            for (int rep = 0; rep < (l == 0 ? REPS(6) : 1); ++rep)
            { pg8::Gemm g{(const bf16_t*)(F.ws + WS_Y), (const bf16_t*)(F.ws + (l ? WS_WO1 : WS_WO0)), D, D}; GridSched S{64, 4, F.G, F.bx, 256u * D * 2u, 256u * D * 2u};
              pg8::gemm_phase(F.lds, g, S, E, R); }
            if (l == 0) { pg8::Gemm g{(const bf16_t*)(F.ws + WS_Y), (const bf16_t*)(F.ws + WS_WO0), D / 2, D}; CtxSched S{F.G, F.bx, 4, 256u * D * 2u, 256u * D * 2u, 2, (unsigned)D};
              pg8::gemm_phase(F.lds, g, S, E, R);
              if (F.bx >= 16) moe_convert_q(F, MOE_QB_CO); }
            SEAM(pb + 5);
        }
        if (IN(pb + 6)) {
            if (l == 0) norm_phase<false, 2>(F, l, 1, nullptr, xc, NTOK, (const float*)(F.ws + WS_TMPC1), xc); else { norm_phase<true>(F, l, 1, nullptr, xc, NL); moe_convert_q(F, 1 << 20); }
            SEAM(pb + 6);
        }
#ifndef STREAM0
#define STREAM0 0
#endif
#ifndef STREAM1
#define STREAM1 0
#endif
        if (IN(pb + 7)) {
            volatile LAS unsigned* lw = (volatile LAS unsigned*)(F.lds + MISC_OFF) + 16;
            if (l == 0) {
#if STREAM0
                FfnStream<9, false> S;
#pragma unroll
                for (int g = 0; g < 9; ++g) { S.P[g] = g < 8 ? 8 : 2; S.rb[g] = 2048 * g; S.cn[g] = g < 8 ? 2048 : 512; }
                S.nNgu = 22; S.Kdn = DFF0; S.need = 22u * 8u; S.q = ctl + CW_QUEUE; S.lw = lw; S.rdy = ctl + CW_RDY; S.tmo = ctl + 2; S.finish_init(F.G);
                EpiFfn<false> E{F.ws, F.out, mod_l}; FfnRows<false> R{nullptr};
                pg8::gemm_stream(F.lds, (const char*)F.ws, S, E, R);
#else
                for (int rep = 0; rep < REPS(18); ++rep)
                { pg8::Gemm g{H, (const bf16_t*)(F.ws + WS_WGUD), D / 2, D / 2}; RowSched S{66, 22, F.G, F.bx, 256u * D, 256u * D}; EpiSwigluI8 E{(bf16_t*)(F.ws + WS_ACT), DFF0, (const float*)(F.ws + WS_RS), (const float*)(F.ws + WS_CSD)}; pg8::NoGather R;
                  pg8::gemm_phasei8(F.lds, g, S, E, R); }
                if (F.bx >= (66 * 22) % F.G && (66 * 22) % F.G != 0) moe_convert_q(F, 1);
                GRID_BAR();
                { EpiResid E{nullptr, XB, XB, xc, xc, mod_l, 5, (float*)(F.ws + WS_TMPC2), 1.0f / (float)(QDN * QACT)}; pg8::NoGather R;
                  { pg8::Gemm g{(const bf16_t*)(F.ws + WS_ACT), (const bf16_t*)(F.ws + WS_WDD), DFF0 / 2, DFF0 / 2}; GridSched S{64, 4, F.G, F.bx, 256u * DFF0, 256u * DFF0};
                    pg8::gemm_phase8(F.lds, g, S, E, R); }
                  { pg8::Gemm g{(const bf16_t*)(F.ws + WS_ACT), (const bf16_t*)(F.ws + WS_WDD), DFF0 / 2, DFF0 / 2}; CtxSplitSched S{F.G, F.bx, 256u * DFF0, 256u * DFF0, 12u * 128u, 12, 10};
                    pg8::gemm_phase8(F.lds, g, S, E, R);
                    if (F.bx >= 16) moe_convert_q(F, MOE_QB_CD); } }

#endif
            } else {
#if STREAM1
                FfnStream<8, true> S; { int bacc = 0;
#pragma unroll
                for (int e = 0; e < NE; ++e) { const int c = (int)ctl[CW_CNT + 64 * e]; S.cn[e] = c; S.P[e] = (c + 255) >> 8; S.rb[e] = bacc; bacc += ((c + 255) >> 8) << 8; } }
                S.nNgu = 28; S.Kdn = DFFE; S.need = 28u * 8u; S.q = ctl + CW_QUEUE + 64; S.lw = lw; S.rdy = ctl + CW_RDY + 64 * 80; S.tmo = ctl + 2; S.finish_init(F.G);
                EpiFfn<true> E{F.ws, F.out, mod_l}; FfnRows<true> R{(const int*)(F.ws + WS_LIST)};
                pg8::gemm_stream(F.lds, (const char*)F.ws, S, E, R);
#else
                for (int rep = 0; rep < REPS(19); ++rep)
                { pg8::Gemm g{H, (const bf16_t*)(F.ws + WS_WGUE), D / 2, D / 2}; MoeSched S; S.G = F.G; S.c = F.bx; S.nN = 28; S.ksplit = 1; S.trim = 0; S.khbytes = 0; S.bexp = 2u * DFFE * D; S.bbytes = 256u * D; S.arow_bytes = 0; S.a_slots = false; S.init(ctl + CW_CNT);
                  EpiSwiglu8 E{F.ws + WS_ACT, DFFE}; MoeRows R{(const int*)(F.ws + WS_LIST)};
                  pg8::gemm_phase8(F.lds, g, S, E, R); }
                { int tot = 0;
#pragma unroll
                  for (int e = 0; e < NE; ++e) tot += (((int)ctl[CW_CNT + 64 * e] + 255) >> 8) * 28;
                  const int rem = tot % F.G;
                  if (rem == 0 || F.bx >= rem) moe_convert_q(F, 1 << 20, 1); }
                GRID_BAR();
                { const int trim = moe_tail_panels(ctl + CW_CNT, F.G);
                  MoeSched S; S.G = F.G; S.c = F.bx; S.nN = 4; S.ksplit = 1; S.trim = trim; S.khbytes = 0; S.bexp = (unsigned)D * DFFE; S.bbytes = 256u * DFFE; S.arow_bytes = (unsigned)DFFE; S.a_slots = true; S.init(ctl + CW_CNT);
                  for (int rep = 0; rep < REPS(20); ++rep)
                  { pg8::Gemm g{(const bf16_t*)(F.ws + WS_ACT), (const bf16_t*)(F.ws + WS_WDE), DFFE / 2, DFFE / 2};
                    EpiBf16 E{(bf16_t*)(F.ws + WS_DOUT), (bf16_t*)(F.ws + WS_DOUT), D}; pg8::NoGather R;
                    pg8::gemm_phase8(F.lds, g, S, E, R); }
                  for (int rep = 0; rep < REPS(23); ++rep)
                  if (trim > 0) {
                    const int plast = (S.cnt[NE - 1] + 255) >> 8;
                    pg8::Gemm g{(const bf16_t*)(F.ws + WS_ACT), (const bf16_t*)(F.ws + WS_WDE), DFFE / 4, DFFE / 2};
                    MoeTailSched T{F.G, F.bx, trim, plast, S.base[NE - 1], (unsigned)D * DFFE};
                    EpiTail E{(bf16_t*)(F.ws + WS_DOUT), (bf16_t*)(F.ws + WS_DOUT1), S.base[NE - 1] + (plast - trim) * 256}; pg8::NoGather R;
                    pg8::gemm_phase8(F.lds, g, T, E, R); } }
#endif
            }
            SEAM(pb + 7);
        }
}

constexpr int NPHASE = 18;
__global__ void __launch_bounds__(NTHR, 2) fwd_kernel(Args args) {
    extern __shared__ __attribute__((aligned(16))) unsigned char lds_raw[];
    Frame F;
    F.lds = (LAS unsigned char*)lds_raw; F.ws = args.ws; F.in = args.in; F.out = args.out;
    F.tid = threadIdx.x; F.lane = F.tid & 63; F.wave = __builtin_amdgcn_readfirstlane(F.tid >> 6); F.G = gridDim.x; F.bx = blockIdx.x;
    volatile LAS unsigned* MISC = (volatile LAS unsigned*)(F.lds + MISC_OFF);
    if (F.tid < 32) MISC[F.tid] = 0u;
    __syncthreads();
    unsigned* ctl = (unsigned*)(F.ws + WS_CTL);
#if !MK_MULTI
    XcdBarrier bar = xcd_barrier_post(ctl + CW_BAR, MISC + 8);
#else
    XcdBarrier bar; bar.bar = ctl + CW_BAR; bar.x = 0; bar.st = MISC + 8;
#endif
    const int lo = args.ph_lo, hi = args.ph_hi;
    if (IN(0)) { for (int rep = 0; rep < REPS(0); ++rep) { p0_prologue(F); __syncthreads(); } SEAM(0); }
    layer_phases<0>(F, ctl, lo, hi, bar);
    layer_phases<1>(F, ctl, lo, hi, bar);
    if (IN(17)) for (int rep = 0; rep < REPS(17); ++rep) final_phase(F);
}

extern "C" void kernel_launch(void* const* d_in, const int* in_sizes, int n_in, void* d_out, int out_size, void* d_ws, size_t ws_size, hipStream_t stream) {
    static int grid = 0;
    if (grid == 0) {
        if (n_in != 21 || out_size != NL * D || ws_size < WS_END) { fprintf(stderr, "kernel_launch: unexpected problem (n_in %d out %d ws %zu)\n", n_in, out_size, ws_size); grid = -1; return; }
        int dev = 0, cus = 0;
        hipGetDevice(&dev); hipDeviceGetAttribute(&cus, hipDeviceAttributeMultiprocessorCount, dev);
        if (hipFuncSetAttribute((const void*)fwd_kernel, hipFuncAttributeMaxDynamicSharedMemorySize, LDS_BYTES) != hipSuccess) { fprintf(stderr, "kernel_launch: hipFuncSetAttribute failed\n"); grid = -1; return; }
        int per_cu = 0; (void)hipOccupancyMaxActiveBlocksPerMultiprocessor(&per_cu, (const void*)fwd_kernel, NTHR, LDS_BYTES); (void)hipGetLastError();
        grid = cus;
    }
    if (grid < 0) return;
    hipMemsetAsync((char*)d_ws + WS_CTL, 0, CTL_BYTES, stream);
#ifdef DBG_SCRUB
    hipMemsetAsync((char*)d_ws + CTL_BYTES, 0, WS_END - CTL_BYTES, stream);
#endif
    Args a{};
    for (int i = 0; i < 21; ++i) a.in[i] = (const float*)d_in[i];
    a.out = (float*)d_out; a.ws = (unsigned char*)d_ws;
#if MK_MULTI
    for (int p = 0; p < NPHASE; ++p) { a.ph_lo = p; a.ph_hi = p + 1; hipLaunchKernelGGL(fwd_kernel, dim3(grid), dim3(NTHR), LDS_BYTES, stream, a); }
#else
    a.ph_lo = 0; a.ph_hi = NPHASE;
    hipLaunchKernelGGL(fwd_kernel, dim3(grid), dim3(NTHR), LDS_BYTES, stream, a);
#endif
}
```
